# Optimizing an MI355X kernel written in HIP

```python
import math
import jax
import jax.numpy as jnp
from jax import lax
import numpy as np

D_MODEL = 1024
BATCH = 1
SEQ = 16384
DEPTH = 4

GRID_W = 64
CTX_LEN = 256
Q_BLOCK = 128
ROPE_BASE = 10000.0
NORM_EPS = 1e-6

W_DIFF = 256
W_SSD = 256
W_S5 = 256
W_GQA = 256
D_MIX = W_DIFF + W_SSD + W_S5 + W_GQA

DIFF_HEADS = 4
DIFF_QK_DIM = 32
DIFF_V_DIM = 2 * DIFF_QK_DIM

SSD_HEAD_DIM = 64
SSD_HEADS = W_SSD // SSD_HEAD_DIM
SSD_GROUPS = 2
SSD_STATE = 128
SSD_CONV = 3
SSD_CHUNK = 128
SSD_XBC = W_SSD + 2 * SSD_GROUPS * SSD_STATE

S5_GROUP = 16
S5_GROUPS = W_S5 // S5_GROUP
S5_STATE = 64

GQA_HEADS = 4
GQA_KV_HEADS = 2
GQA_REP = GQA_HEADS // GQA_KV_HEADS
GQA_HEAD_DIM = W_GQA // GQA_HEADS

N_DIFF_IN = 3 * W_DIFF
N_SSD_IN = W_SSD + SSD_XBC + 2 * SSD_HEADS
N_S5_IN = W_S5
N_GQA_IN = (GQA_HEADS + 2 * GQA_KV_HEADS) * GQA_HEAD_DIM
D_IN = N_DIFF_IN + N_SSD_IN + N_S5_IN + N_GQA_IN

N_EXPERTS = 32
TOP_K = 4
D_EXPERT = D_MODEL
SWIGLU_LIMIT = 7.0
SWIGLU_ALPHA = 1.702
MOE_BLOCK = 128

kernel_name = 'hybrid_parallel_heads_diffusion_moe'


def rms_norm(x, w):
    xf = x.astype(jnp.float32)
    y = xf * lax.rsqrt(jnp.mean(xf * xf, axis=-1, keepdims=True) + NORM_EPS)
    return (y * w.astype(jnp.float32)).astype(x.dtype)


def modulate(h, shift, scale):
    return h * (1.0 + scale) + shift


def axial_rope_tables(row, col, head_dim):
    axis_dim = head_dim // 2
    inv_freq = ROPE_BASE ** (-jnp.arange(0, axis_dim, 2, dtype=jnp.float32) / axis_dim)
    ang_r = row.astype(jnp.float32)[:, None] * inv_freq
    ang_c = col.astype(jnp.float32)[:, None] * inv_freq
    return (jnp.cos(ang_r), jnp.sin(ang_r), jnp.cos(ang_c), jnp.sin(ang_c))


def _rotate_half(x, cos, sin):
    x1, x2 = jnp.split(x.astype(jnp.float32), 2, axis=-1)
    return jnp.concatenate([x1 * cos - x2 * sin, x1 * sin + x2 * cos], axis=-1)


def apply_axial_rope(x, rope):
    cos_r, sin_r, cos_c, sin_c = rope

    def expand(t):
        return t.reshape((1, t.shape[0]) + (1,) * (x.ndim - 3) + (t.shape[1],))

    x_row, x_col = jnp.split(x, 2, axis=-1)
    out = jnp.concatenate([_rotate_half(x_row, expand(cos_r), expand(sin_r)),
                           _rotate_half(x_col, expand(cos_c), expand(sin_c))], axis=-1)
    return out.astype(x.dtype)


def sweep_query_blocks(fn, q):
    b, t = q.shape[:2]
    nb = t // Q_BLOCK
    qb = jnp.moveaxis(q.reshape((b, nb, Q_BLOCK) + q.shape[2:]), 1, 0)
    ob = lax.map(fn, qb)
    return jnp.moveaxis(ob, 0, 1).reshape((b, t) + ob.shape[3:])


def diff_attention_mixer(uc, ul, rope, lq1, lk1, lq2, lk2, subln_w, lam_init, with_ctx):
    f32 = jnp.float32
    lam = (jnp.exp(jnp.sum(lq1.astype(f32) * lk1.astype(f32)))
           - jnp.exp(jnp.sum(lq2.astype(f32) * lk2.astype(f32))) + lam_init)
    scale = DIFF_QK_DIM ** -0.5

    def split_heads(u):
        b, t = u.shape[:2]
        q, k, v = jnp.split(u, 3, axis=-1)
        shp = (b, t, DIFF_HEADS, 2, DIFF_QK_DIM)
        return q.reshape(shp), k.reshape(shp), v.reshape(b, t, DIFF_HEADS, DIFF_V_DIM)

    qc, kc, vc = split_heads(uc)
    ql, kl, vl = split_heads(ul)
    ql = apply_axial_rope(ql, rope)
    kl = apply_axial_rope(kl, rope)
    k_all = jnp.concatenate([kc, kl], axis=1)
    v_all = jnp.concatenate([vc, vl], axis=1)

    def attend(q, k, v):
        s = jnp.einsum('bqhmd,bkhmd->bhmqk', q, k).astype(f32) * scale
        p = jax.nn.softmax(s, axis=-1)
        a = p[:, :, 0] - lam * p[:, :, 1]
        o = jnp.einsum('bhqk,bkhe->bqhe', a.astype(v.dtype), v)
        o = rms_norm(o, subln_w) * (1.0 - lam_init)
        return o.reshape(o.shape[:2] + (W_DIFF,))

    lat = sweep_query_blocks(lambda q: attend(q, k_all, v_all), ql)
    ctx_out = attend(qc, kc, vc) if with_ctx else None
    return ctx_out, lat


def depthwise_conv(x, w, bias):
    width = w.shape[0]
    y = lax.conv_general_dilated(x, w[:, None, :].astype(x.dtype), window_strides=(1,),
                                 padding=[(width // 2, width // 2)],
                                 dimension_numbers=('NWC', 'WIO', 'NWC'),
                                 feature_group_count=x.shape[-1])
    return y + bias.astype(x.dtype)


def segsum(x):
    t = x.shape[-1]
    cs = jnp.cumsum(x, axis=-1)
    diff = cs[..., :, None] - cs[..., None, :]
    return jnp.where(jnp.tril(jnp.ones((t, t), dtype=bool)), diff, -jnp.inf)


def ssd_scan(x, dt, a, bm, cm, init_state):
    b, t, h, p = x.shape
    nc = t // SSD_CHUNK
    rep = h // bm.shape[2]
    bm = jnp.repeat(bm, rep, axis=2)
    cm = jnp.repeat(cm, rep, axis=2)

    def chunk(v):
        return v.reshape((b, nc, SSD_CHUNK) + v.shape[2:])

    xdt = chunk(x * dt[..., None])
    bm, cm = chunk(bm), chunk(cm)
    adt = jnp.moveaxis(chunk(dt * a), -1, 1)
    a_cum = jnp.cumsum(adt, axis=-1)
    l_mat = jnp.exp(segsum(adt))
    y_diag = jnp.einsum('bclhn,bcshn,bhcls,bcshp->bclhp', cm, bm, l_mat, xdt)
    decay_states = jnp.exp(a_cum[..., -1:] - a_cum)
    states = jnp.einsum('bclhn,bhcl,bclhp->bchpn', bm, decay_states, xdt)
    states = jnp.concatenate([init_state[:, None], states], axis=1)
    decay_chunk = jnp.exp(segsum(jnp.pad(a_cum[..., -1], ((0, 0), (0, 0), (1, 0)))))
    new_states = jnp.einsum('bhzc,bchpn->bzhpn', decay_chunk, states)
    y_off = jnp.einsum('bclhn,bchpn,bhcl->bclhp', cm, new_states[:, :-1], jnp.exp(a_cum))
    return (y_diag + y_off).reshape(b, t, h, p), new_states[:, -1]


def ssd_mixer(uc, ul, conv_w, conv_b, dt_bias, a_log, d_skip, norm_w, with_ctx):
    f32 = jnp.float32
    a = -jnp.exp(a_log.astype(f32))
    gn = SSD_GROUPS * SSD_STATE

    def prep(u):
        b, t = u.shape[:2]
        z = u[..., :W_SSD]
        xbc = jax.nn.silu(depthwise_conv(u[..., W_SSD:W_SSD + SSD_XBC], conv_w, conv_b)).astype(f32)
        xs = xbc[..., :W_SSD].reshape(b, t, SSD_HEADS, SSD_HEAD_DIM)
        bm = xbc[..., W_SSD:W_SSD + gn].reshape(b, t, SSD_GROUPS, SSD_STATE)
        cm = xbc[..., W_SSD + gn:].reshape(b, t, SSD_GROUPS, SSD_STATE)
        dt = jax.nn.softplus(u[..., W_SSD + SSD_XBC:].astype(f32).reshape(b, t, 2, SSD_HEADS)
                             + dt_bias.astype(f32))
        return z, xs, bm, cm, dt

    def flip(v):
        return jnp.flip(v, axis=1)

    def bidir(xs, bm, cm, dt, s_f, s_b):
        y_f, fin_f = ssd_scan(xs, dt[:, :, 0], a[0], bm, cm, s_f)
        y_b, fin_b = ssd_scan(flip(xs), flip(dt[:, :, 1]), a[1], flip(bm), flip(cm), s_b)
        return y_f + flip(y_b), fin_f, fin_b

    def finish(y, xs, z):
        y = y + d_skip.astype(f32)[:, None] * xs
        y = y.reshape(y.shape[:2] + (W_SSD,))
        return rms_norm(y * jax.nn.silu(z.astype(f32)), norm_w).astype(z.dtype)

    zc, xc, bc, cc, dtc = prep(uc)
    zl, xl, bl, cl, dtl = prep(ul)
    zero = jnp.zeros((uc.shape[0], SSD_HEADS, SSD_HEAD_DIM, SSD_STATE), f32)
    yc, sc_f, sc_b = bidir(xc, bc, cc, dtc, zero, zero)
    yl, _, _ = bidir(xl, bl, cl, dtl, sc_f, sc_b)
    lat = finish(yl, xl, zl)
    ctx_out = finish(yc, xc, zc) if with_ctx else None
    return ctx_out, lat


def _linear_recurrence(bu, a, h0, reverse):
    edge = -1 if reverse else 0
    bu = bu.at[:, edge].add(a * h0)
    a_seq = jnp.broadcast_to(a, bu.shape)

    def combine(e1, e2):
        a1, b1 = e1
        a2, b2 = e2
        return a1 * a2, a2 * b1 + b2

    _, h = lax.associative_scan(combine, (a_seq, bu), reverse=reverse, axis=1)
    return h


def s5_mixer(uc, ul, lam_re, lam_im, log_dt, b_re, b_im, c_re, c_im, d_skip, w_glu, b_glu, with_ctx):
    f32 = jnp.float32
    lam = lax.complex(lam_re.astype(f32), lam_im.astype(f32))
    step = jnp.exp(log_dt.astype(f32))[..., None]
    a_bar = jnp.exp(lam * step)
    b_mat = lax.complex(b_re.astype(f32), b_im.astype(f32))
    b_bar = ((a_bar - 1.0) / lam)[..., None] * b_mat[None]
    c_mat = lax.complex(c_re.astype(f32), c_im.astype(f32))
    d_grp = d_skip.astype(f32).reshape(S5_GROUPS, S5_GROUP)

    def states(u, h0_f, h0_b):
        b, t = u.shape[:2]
        ug = u.astype(f32).reshape(b, t, S5_GROUPS, S5_GROUP)
        ucx = ug.astype(jnp.complex64)
        bu_f = jnp.einsum('gpc,btgc->btgp', b_bar[0], ucx)
        bu_b = jnp.einsum('gpc,btgc->btgp', b_bar[1], ucx)
        h_f = _linear_recurrence(bu_f, a_bar[0], h0_f, reverse=False)
        h_b = _linear_recurrence(bu_b, a_bar[1], h0_b, reverse=True)
        return ug, h_f, h_b

    def readout(ug, h_f, h_b, dtype):
        y = (jnp.real(jnp.einsum('gcp,btgp->btgc', c_mat[0], h_f))
             + jnp.real(jnp.einsum('gcp,btgp->btgc', c_mat[1], h_b)) + d_grp * ug)
        y = jax.nn.gelu(y.reshape(y.shape[:2] + (W_S5,)))
        return (y * jax.nn.sigmoid(y @ w_glu.astype(f32) + b_glu.astype(f32))).astype(dtype)

    zero = jnp.zeros((uc.shape[0], S5_GROUPS, S5_STATE), jnp.complex64)
    ugc, hc_f, hc_b = states(uc, zero, zero)
    ugl, hl_f, hl_b = states(ul, hc_f[:, -1], hc_b[:, 0])
    lat = readout(ugl, hl_f, hl_b, ul.dtype)
    ctx_out = readout(ugc, hc_f, hc_b, uc.dtype) if with_ctx else None
    return ctx_out, lat


def gqa_mixer(uc, ul, rope, q_norm_w, k_norm_w, with_ctx):
    nq = GQA_HEADS * GQA_HEAD_DIM
    nkv = GQA_KV_HEADS * GQA_HEAD_DIM
    scale = GQA_HEAD_DIM ** -0.5

    def split_heads(u):
        b, t = u.shape[:2]
        q = u[..., :nq].reshape(b, t, GQA_KV_HEADS, GQA_REP, GQA_HEAD_DIM)
        k = u[..., nq:nq + nkv].reshape(b, t, GQA_KV_HEADS, GQA_HEAD_DIM)
        v = u[..., nq + nkv:].reshape(b, t, GQA_KV_HEADS, GQA_HEAD_DIM)
        return rms_norm(q, q_norm_w), rms_norm(k, k_norm_w), v

    qc, kc, vc = split_heads(uc)
    ql, kl, vl = split_heads(ul)
    ql = apply_axial_rope(ql, rope)
    kl = apply_axial_rope(kl, rope)
    k_all = jnp.concatenate([kc, kl], axis=1)
    v_all = jnp.concatenate([vc, vl], axis=1)

    def attend(q, k, v):
        s = jnp.einsum('bqgrd,bkgd->bgrqk', q, k).astype(jnp.float32) * scale
        p = jax.nn.softmax(s, axis=-1)
        o = jnp.einsum('bgrqk,bkgd->bqgrd', p.astype(v.dtype), v)
        return o.reshape(o.shape[:2] + (W_GQA,))

    lat = sweep_query_blocks(lambda q: attend(q, k_all, v_all), ql)
    ctx_out = attend(qc, kc, vc) if with_ctx else None
    return ctx_out, lat


def moe_ffn(h, w_router, b_router, w_gate_up, b_gate_up, w_down, b_down):
    n, d = h.shape
    logits = (h @ w_router).astype(jnp.float32) + b_router.astype(jnp.float32)
    top_val, top_idx = lax.top_k(logits, TOP_K)
    gates = jax.nn.softmax(top_val, axis=-1)
    m = n * TOP_K
    expert = top_idx.reshape(-1)
    token = jnp.repeat(jnp.arange(n, dtype=jnp.int32), TOP_K)
    gate = gates.reshape(-1)
    order = jnp.argsort(expert)
    e_sorted = expert[order]
    counts = jnp.bincount(expert, length=N_EXPERTS)
    padded = (counts + MOE_BLOCK - 1) // MOE_BLOCK * MOE_BLOCK
    start = jnp.cumsum(counts) - counts
    pend = jnp.cumsum(padded)
    pstart = pend - padded
    dest = pstart[e_sorted] + jnp.arange(m, dtype=jnp.int32) - start[e_sorted]
    n_blocks = -(-(m + N_EXPERTS * (MOE_BLOCK - 1)) // MOE_BLOCK)
    cap = n_blocks * MOE_BLOCK
    slot_token = jnp.zeros((cap,), jnp.int32).at[dest].set(token[order])
    slot_gate = jnp.zeros((cap,), jnp.float32).at[dest].set(gate[order])
    block_expert = jnp.minimum(
        jnp.searchsorted(pend, jnp.arange(n_blocks, dtype=jnp.int32) * MOE_BLOCK, side='right'),
        N_EXPERTS - 1)
    xb = h[slot_token].reshape(n_blocks, MOE_BLOCK, d)

    def expert_block(args):
        xblk, e = args
        gu = xblk @ w_gate_up[e] + b_gate_up[e]
        g, u = gu[..., ::2], gu[..., 1::2]
        g = jnp.minimum(g, SWIGLU_LIMIT)
        u = jnp.clip(u, -SWIGLU_LIMIT, SWIGLU_LIMIT)
        act = g * jax.nn.sigmoid(SWIGLU_ALPHA * g) * (u + 1.0)
        return act @ w_down[e] + b_down[e]

    yb = lax.map(expert_block, (xb, block_expert))
    contrib = yb.reshape(cap, d) * slot_gate[:, None].astype(yb.dtype)
    return jnp.zeros_like(h).at[slot_token].add(contrib.astype(h.dtype))


def trunk_layer(xc, xl, c, c_ctx, rope_diff, rope_gqa, p, layer_idx, with_ctx):
    mod_l = (jax.nn.silu(c) @ p['w_ada'] + p['b_ada'])[:, None, :]
    mod_c = (jax.nn.silu(c_ctx) @ p['w_ada'] + p['b_ada'])[None, None, :]
    sh1_l, sc1_l, g1_l, sh2_l, sc2_l, g2_l = jnp.split(mod_l, 6, axis=-1)
    sh1_c, sc1_c, g1_c, sh2_c, sc2_c, g2_c = jnp.split(mod_c, 6, axis=-1)

    uc = modulate(rms_norm(xc, p['norm1_w']), sh1_c, sc1_c) @ p['w_in']
    ul = modulate(rms_norm(xl, p['norm1_w']), sh1_l, sc1_l) @ p['w_in']
    cuts = [N_DIFF_IN, N_DIFF_IN + N_SSD_IN, N_DIFF_IN + N_SSD_IN + N_S5_IN]
    uc_a, uc_b, uc_c, uc_d = jnp.split(uc, cuts, axis=-1)
    ul_a, ul_b, ul_c, ul_d = jnp.split(ul, cuts, axis=-1)

    lam_init = 0.8 - 0.6 * math.exp(-0.3 * layer_idx)
    ca, la = diff_attention_mixer(uc_a, ul_a, rope_diff, p['diff_lq1'], p['diff_lk1'], p['diff_lq2'],
                                  p['diff_lk2'], p['diff_subln_w'], lam_init, with_ctx)
    cb, lb = ssd_mixer(uc_b, ul_b, p['ssd_conv_w'], p['ssd_conv_b'], p['ssd_dt_bias'], p['ssd_a_log'],
                       p['ssd_d'], p['ssd_norm_w'], with_ctx)
    cc, lc = s5_mixer(uc_c, ul_c, p['s5_lam_re'], p['s5_lam_im'], p['s5_log_dt'], p['s5_b_re'], p['s5_b_im'],
                      p['s5_c_re'], p['s5_c_im'], p['s5_d'], p['s5_w_glu'], p['s5_b_glu'], with_ctx)
    cd, ld = gqa_mixer(uc_d, ul_d, rope_gqa, p['gqa_q_norm_w'], p['gqa_k_norm_w'], with_ctx)

    xl = xl + g1_l * (jnp.concatenate([la, lb, lc, ld], axis=-1) @ p['w_out'])
    hl = modulate(rms_norm(xl, p['norm2_w']), sh2_l, sc2_l)
    moe_args = (p['moe_w_router'], p['moe_b_router'], p['moe_w_gate_up'], p['moe_b_gate_up'],
                p['moe_w_down'], p['moe_b_down'])
    if not with_ctx:
        y = moe_ffn(hl.reshape(-1, hl.shape[-1]), *moe_args)
        return xc, xl + g2_l * y.reshape(xl.shape)
    xc = xc + g1_c * (jnp.concatenate([ca, cb, cc, cd], axis=-1) @ p['w_out'])
    hc = modulate(rms_norm(xc, p['norm2_w']), sh2_c, sc2_c)
    n_ctx = hc.shape[0] * hc.shape[1]
    y = moe_ffn(jnp.concatenate([hc.reshape(-1, hc.shape[-1]), hl.reshape(-1, hl.shape[-1])], axis=0),
                *moe_args)
    return xc + g2_c * y[:n_ctx].reshape(xc.shape), xl + g2_l * y[n_ctx:].reshape(xl.shape)


def setup_inputs(seed: int = 0) -> dict:
    key = jax.random.key(seed)
    keys = iter([jax.random.fold_in(key, i) for i in range(64)])
    f32 = jnp.float32
    L = DEPTH

    def normal(shape, std):
        return std * jax.random.normal(next(keys), shape, f32)

    def gain(shape):
        return 1.0 + normal(shape, 0.02)

    def log_uniform(shape, lo, hi):
        return jax.random.uniform(next(keys), shape, f32, math.log(lo), math.log(hi))

    ssd_dt = jnp.exp(log_uniform((L, 2, SSD_HEADS), 1e-3, 1e-1))
    ssd_a = jax.random.uniform(next(keys), (L, 2, SSD_HEADS), f32, 1.0, 16.0)
    s5_n = jnp.arange(S5_STATE, dtype=f32)
    return {
        'x': normal((BATCH, SEQ, D_MODEL), 1.0),
        'c': normal((BATCH, D_MODEL), 1.0),
        'ctx': normal((BATCH, CTX_LEN, D_MODEL), 1.0),
        'c_ctx': normal((D_MODEL,), 1.0),
        'w_ada': normal((L, D_MODEL, 6 * D_MODEL), 0.5 * D_MODEL ** -0.5),
        'b_ada': normal((L, 6 * D_MODEL), 0.02),
        'norm1_w': gain((L, D_MODEL)),
        'norm2_w': gain((L, D_MODEL)),
        'w_in': normal((L, D_MODEL, D_IN), D_MODEL ** -0.5),
        'w_out': normal((L, D_MIX, D_MODEL), D_MIX ** -0.5),
        'diff_lq1': normal((L, DIFF_QK_DIM), 0.1),
        'diff_lk1': normal((L, DIFF_QK_DIM), 0.1),
        'diff_lq2': normal((L, DIFF_QK_DIM), 0.1),
        'diff_lk2': normal((L, DIFF_QK_DIM), 0.1),
        'diff_subln_w': gain((L, DIFF_V_DIM)),
        'ssd_conv_w': normal((L, SSD_CONV, SSD_XBC), SSD_CONV ** -0.5),
        'ssd_conv_b': normal((L, SSD_XBC), 0.02),
        'ssd_dt_bias': ssd_dt + jnp.log(-jnp.expm1(-ssd_dt)),
        'ssd_a_log': jnp.log(ssd_a),
        'ssd_d': gain((L, SSD_HEADS)),
        'ssd_norm_w': gain((L, W_SSD)),
        's5_lam_re': -0.5 + normal((L, 2, S5_GROUPS, S5_STATE), 0.01),
        's5_lam_im': jnp.pi * s5_n + normal((L, 2, S5_GROUPS, S5_STATE), 0.01),
        's5_log_dt': log_uniform((L, 2, S5_GROUPS), 1e-3, 1e-1),
        's5_b_re': normal((L, S5_GROUPS, S5_STATE, S5_GROUP), (2 * S5_GROUP) ** -0.5),
        's5_b_im': normal((L, S5_GROUPS, S5_STATE, S5_GROUP), (2 * S5_GROUP) ** -0.5),
        's5_c_re': normal((L, 2, S5_GROUPS, S5_GROUP, S5_STATE), S5_STATE ** -0.5),
        's5_c_im': normal((L, 2, S5_GROUPS, S5_GROUP, S5_STATE), S5_STATE ** -0.5),
        's5_d': gain((L, W_S5)),
        's5_w_glu': normal((L, W_S5, W_S5), W_S5 ** -0.5),
        's5_b_glu': normal((L, W_S5), 0.02),
        'gqa_q_norm_w': gain((L, GQA_HEAD_DIM)),
        'gqa_k_norm_w': gain((L, GQA_HEAD_DIM)),
        'moe_w_router': normal((L, D_MODEL, N_EXPERTS), D_MODEL ** -0.5),
        'moe_b_router': normal((L, N_EXPERTS), 0.01),
        'moe_w_gate_up': normal((L, N_EXPERTS, D_MODEL, 2 * D_EXPERT), D_MODEL ** -0.5),
        'moe_b_gate_up': normal((L, N_EXPERTS, 2 * D_EXPERT), 0.01),
        'moe_w_down': normal((L, N_EXPERTS, D_EXPERT, D_MODEL), D_EXPERT ** -0.5),
        'moe_b_down': normal((L, N_EXPERTS, D_MODEL), 0.01),
        'final_norm_w': gain((D_MODEL,)),
    }


def reference(x, c, ctx, c_ctx, w_ada, b_ada, norm1_w, norm2_w, w_in, w_out,
              diff_lq1, diff_lk1, diff_lq2, diff_lk2, diff_subln_w,
              ssd_conv_w, ssd_conv_b, ssd_dt_bias, ssd_a_log, ssd_d, ssd_norm_w,
              s5_lam_re, s5_lam_im, s5_log_dt, s5_b_re, s5_b_im, s5_c_re, s5_c_im, s5_d, s5_w_glu, s5_b_glu,
              gqa_q_norm_w, gqa_k_norm_w,
              moe_w_router, moe_b_router, moe_w_gate_up, moe_b_gate_up, moe_w_down, moe_b_down,
              final_norm_w):
    seq = x.shape[1]
    rows = seq // GRID_W
    row = jnp.repeat(jnp.arange(rows, dtype=jnp.int32), GRID_W)
    col = jnp.tile(jnp.arange(GRID_W, dtype=jnp.int32), rows)
    rope_diff = axial_rope_tables(row, col, DIFF_QK_DIM)
    rope_gqa = axial_rope_tables(row, col, GQA_HEAD_DIM)
    xc, xl = ctx, x
    for i in range(DEPTH):
        p = {
            'w_ada': w_ada[i], 'b_ada': b_ada[i], 'norm1_w': norm1_w[i], 'norm2_w': norm2_w[i],
            'w_in': w_in[i], 'w_out': w_out[i],
            'diff_lq1': diff_lq1[i], 'diff_lk1': diff_lk1[i], 'diff_lq2': diff_lq2[i], 'diff_lk2': diff_lk2[i],
            'diff_subln_w': diff_subln_w[i],
            'ssd_conv_w': ssd_conv_w[i], 'ssd_conv_b': ssd_conv_b[i], 'ssd_dt_bias': ssd_dt_bias[i],
            'ssd_a_log': ssd_a_log[i], 'ssd_d': ssd_d[i], 'ssd_norm_w': ssd_norm_w[i],
            's5_lam_re': s5_lam_re[i], 's5_lam_im': s5_lam_im[i], 's5_log_dt': s5_log_dt[i],
            's5_b_re': s5_b_re[i], 's5_b_im': s5_b_im[i], 's5_c_re': s5_c_re[i], 's5_c_im': s5_c_im[i],
            's5_d': s5_d[i], 's5_w_glu': s5_w_glu[i], 's5_b_glu': s5_b_glu[i],
            'gqa_q_norm_w': gqa_q_norm_w[i], 'gqa_k_norm_w': gqa_k_norm_w[i],
            'moe_w_router': moe_w_router[i], 'moe_b_router': moe_b_router[i],
            'moe_w_gate_up': moe_w_gate_up[i], 'moe_b_gate_up': moe_b_gate_up[i],
            'moe_w_down': moe_w_down[i], 'moe_b_down': moe_b_down[i],
        }
        xc, xl = trunk_layer(xc, xl, c, c_ctx, rope_diff, rope_gqa, p, i, i < DEPTH - 1)
    return rms_norm(xl, final_norm_w)
```

```cpp
#include <hip/hip_runtime.h>
#include <cstdio>
#include <cstdint>

#define DI __device__ __forceinline__
typedef float f32x2 __attribute__((ext_vector_type(2)));
typedef float f32x16 __attribute__((ext_vector_type(16)));
typedef unsigned u32x2 __attribute__((ext_vector_type(2)));
typedef __bf16 hbf2 __attribute__((ext_vector_type(2)));

constexpr int DM = 1024, SEQ = 16384, CTX = 256, NT = SEQ + CTX, DEPTH = 4;
constexpr int DIN = 2568, NU = 2560;
constexpr int DT_COL = 1792;
constexpr int NEXP = 32, TOPK = 4;
constexpr int CAP = 292 * 256;
constexpr float EPS = 1e-6f;
constexpr float LOG2E = 1.4426950408889634f;
constexpr int NCH = NT / 128;
constexpr int S5L = 64, NC5 = NT / S5L;
constexpr int U_DQ = 0, U_DK = 256, U_DV = 512, U_Z = 768, U_XS = 1024, U_B = 1280, U_C = 1536, U_S5 = 1792, U_GQ = 2048, U_GK = 2304, U_GV = 2432;

enum { I_X = 0, I_C, I_CTX, I_CCTX, I_WADA, I_BADA, I_N1W, I_N2W, I_WIN, I_WOUT, I_LQ1, I_LK1, I_LQ2, I_LK2, I_SUBLN,
       I_CONVW, I_CONVB, I_DTB, I_ALOG, I_SSDD, I_SSDNW, I_LAMRE, I_LAMIM, I_LOGDT, I_BRE, I_BIM, I_CRE, I_CIM, I_S5D, I_WGLU, I_BGLU,
       I_QNW, I_KNW, I_WR, I_BR, I_WGU, I_BGU, I_WDN, I_BDN, I_FNW, N_IN };

constexpr size_t al256(size_t x) { return (x + 255) & ~(size_t)255; }
constexpr size_t WS_CTL   = 0;
constexpr size_t CTL_BYTES = 65536;
constexpr int CW_BAR = 0;
constexpr int CW_KMAX = 4096;
constexpr int CW_CNT = 4096 + 64;
constexpr int CW_Q0 = 4096 + 64 + 128;
constexpr size_t WS_MOD   = WS_CTL + CTL_BYTES;
constexpr size_t WS_ROPE  = al256(WS_MOD + (size_t)DEPTH * 2 * 6144 * 4);
constexpr size_t WS_LAM   = al256(WS_ROPE + 256 * 8 * 8 + 256 * 16 * 8);
constexpr size_t WS_WIN   = al256(WS_LAM + 256);
constexpr size_t WS_WOUT  = al256(WS_WIN + (size_t)DEPTH * NU * DM * 2);
constexpr size_t WS_WGU   = al256(WS_WOUT + (size_t)DEPTH * DM * DM * 2);
constexpr size_t WS_WDN   = al256(WS_WGU + (size_t)DEPTH * NEXP * 2048 * DM * 2);
constexpr size_t WS_WGLU  = al256(WS_WDN + (size_t)DEPTH * NEXP * DM * DM * 2);
constexpr size_t WS_KTAB  = al256(WS_WGLU + (size_t)DEPTH * 256 * 256 * 2);
constexpr size_t WS_CC5   = al256(WS_KTAB + (size_t)DEPTH * 16 * 3 * 64 * 256 * 2);
constexpr size_t WS_E5    = al256(WS_CC5 + (size_t)DEPTH * 16 * 1024 * 256 * 2);
constexpr size_t WS_APOW  = al256(WS_E5 + (size_t)DEPTH * 16 * 2 * 128 * 1024 * 2);
constexpr size_t WS_XA    = al256(WS_APOW + (size_t)DEPTH * 16 * 2 * 64 * 8);
constexpr size_t WS_XB    = al256(WS_XA + (size_t)NT * DM * 4);
constexpr size_t WS_H     = al256(WS_XB + (size_t)NT * DM * 4);
constexpr size_t WS_U     = al256(WS_H + (size_t)NT * DM * 2);
constexpr size_t WS_DTRAW = al256(WS_U + (size_t)NT * NU * 2);
constexpr size_t WS_QD    = al256(WS_DTRAW + (size_t)NT * 8 * 4);
constexpr size_t WS_KD    = al256(WS_QD + (size_t)4 * NT * 64 * 2);
constexpr size_t WS_VTD   = al256(WS_KD + (size_t)4 * NT * 64 * 2);
constexpr size_t WS_QG    = al256(WS_VTD + (size_t)4 * NT * 64 * 2);
constexpr size_t WS_KG    = al256(WS_QG + (size_t)4 * NT * 64 * 2);
constexpr size_t WS_VTG   = al256(WS_KG + (size_t)2 * NT * 64 * 2);
constexpr size_t WS_QND   = al256(WS_VTG + (size_t)2 * NT * 64 * 2);
constexpr size_t WS_QNG   = al256(WS_QND + (size_t)8 * NT * 4);
constexpr size_t WS_XST   = al256(WS_QNG + (size_t)4 * NT * 4);
constexpr size_t WS_BN    = al256(WS_XST + (size_t)NT * 256 * 2);
constexpr size_t WS_CN    = al256(WS_BN + (size_t)NT * 256 * 2);
constexpr size_t WS_DTV   = al256(WS_CN + (size_t)NT * 256 * 2);
constexpr size_t WS_CUM   = al256(WS_DTV + (size_t)NT * 8 * 4);
constexpr size_t WS_SLOC  = al256(WS_CUM + (size_t)NT * 8 * 4);
constexpr size_t WS_SIN   = al256(WS_SLOC + (size_t)NCH * 8 * 64 * 128 * 4);
constexpr size_t WS_YSSD  = al256(WS_SIN + (size_t)NCH * 8 * 64 * 128 * 2);
constexpr size_t WS_SSQ   = al256(WS_YSSD + (size_t)NT * 256 * 2);
constexpr size_t WS_HLOC  = al256(WS_SSQ + (size_t)NT * 4 * 4);
constexpr size_t WS_HIN   = al256(WS_HLOC + (size_t)NC5 * 4096 * 4);
constexpr size_t WS_YS5   = al256(WS_HIN + (size_t)NC5 * 4096 * 2);
constexpr size_t WS_MIX   = al256(WS_YS5 + (size_t)NT * 256 * 2);
constexpr size_t WS_TOPE  = al256(WS_MIX + (size_t)NT * DM * 2);
constexpr size_t WS_TOPP  = al256(WS_TOPE + (size_t)NT * 16);
constexpr size_t WS_TOPG  = al256(WS_TOPP + (size_t)NT * 16);
constexpr size_t WS_ASLOT = al256(WS_TOPG + (size_t)NT * 16);
constexpr size_t WS_ACT   = al256(WS_ASLOT + (size_t)CAP * DM * 2);
constexpr size_t WS_YB    = al256(WS_ACT + (size_t)CAP * DM * 2);
constexpr size_t WS_END   = al256(WS_YB + (size_t)CAP * DM * 2);

constexpr int LDS_BYTES = 160 * 1024;
constexpr int LDS_MISC = 128 * 1024;
#define LAS __attribute__((address_space(3)))

struct Args { const float* in[N_IN]; float* out; unsigned char* ws; int ph_lo, ph_hi; };

typedef unsigned short bf16_t;
typedef short bf16x8 __attribute__((ext_vector_type(8)));
typedef float f32x4 __attribute__((ext_vector_type(4)));
typedef unsigned u32x4 __attribute__((ext_vector_type(4)));

DI unsigned pk2(float lo, float hi) { f32x2 v = {lo, hi}; hbf2 b = __builtin_convertvector(v, hbf2); return __builtin_bit_cast(unsigned, b); }
DI bf16_t f2bf(float f) { return (bf16_t)(pk2(f, 0.f) & 0xffffu); }
DI float bf2f(bf16_t b) { return __uint_as_float(((unsigned)b) << 16); }
DI float bflo(unsigned u) { return __uint_as_float(u << 16); }
DI float bfhi(unsigned u) { return __uint_as_float(u & 0xffff0000u); }
DI f32x16 mfma32(bf16x8 a, bf16x8 b, f32x16 c) { return __builtin_amdgcn_mfma_f32_32x32x16_bf16(a, b, c, 0, 0, 0); }
DI int kperm(int m) { return (m & 0x13) | ((m & 4) << 1) | ((m & 8) >> 1); }
DI int crow(int i, int h) { return (i & 3) + 8 * (i >> 2) + 4 * h; }
DI bf16x8 ld8g(const bf16_t* p) { return *(const bf16x8*)p; }
DI float wave_sum(float v) {
#pragma unroll
    for (int o = 32; o > 0; o >>= 1) v += __shfl_xor(v, o);
    return v;
}
DI float wave_max(float v) {
#pragma unroll
    for (int o = 32; o > 0; o >>= 1) v = fmaxf(v, __shfl_xor(v, o));
    return v;
}
DI float silu_f(float x) { return x / (1.f + __expf(-x)); }
DI float sigmoid_f(float x) { return 1.f / (1.f + __expf(-x)); }
template <int S> DI bf16x8 pack_step(const f32x16& x) {
    u32x4 p;
    p[0] = pk2(x[8 * S + 0], x[8 * S + 1]); p[1] = pk2(x[8 * S + 2], x[8 * S + 3]);
    p[2] = pk2(x[8 * S + 4], x[8 * S + 5]); p[3] = pk2(x[8 * S + 6], x[8 * S + 7]);
    return __builtin_bit_cast(bf16x8, p);
}
DI f32x16 splat16(float v) { f32x16 r;
#pragma unroll
    for (int i = 0; i < 16; ++i) r[i] = v; return r; }
#define XB_TMO      128
#define XB_XCNT(j)  (256  + 64 * (j))
#define XB_XSUB(j)  (1280 + 64 * (j))
#define XB_XGEN(j)  (2304 + 64 * (j))
#define XB_TOP      3328
#define XB_TOPGEN   3392
#define XCD_BAR_WORDS 3456
#define XB_SPIN_CAP (1u << 18)
#define LAS __attribute__((address_space(3)))

__device__ __forceinline__ unsigned xb_ld(unsigned* p)              { return __hip_atomic_load(p, __ATOMIC_RELAXED, __HIP_MEMORY_SCOPE_AGENT); }
__device__ __forceinline__ unsigned xb_add(unsigned* p, unsigned v) { return __hip_atomic_fetch_add(p, v, __ATOMIC_RELAXED, __HIP_MEMORY_SCOPE_AGENT); }
__device__ __forceinline__ unsigned xb_xcc_id() { return (unsigned)__builtin_amdgcn_s_getreg((3 << 11) | 20) & 0xFu; }
#define XB_SPIN(cond, bar) do { unsigned _sp = 0; while (cond) { __builtin_amdgcn_s_sleep(1); \
    if ((++_sp & 255u) == 0u) { if (xb_ld(&(bar)[XB_TMO])) break; if (_sp > XB_SPIN_CAP) { atomicAdd(&(bar)[XB_TMO], 1u); break; } } } } while (0)

struct XcdBarrier {
    unsigned* bar; unsigned x;
    volatile LAS unsigned* st;
};

__device__ __forceinline__ XcdBarrier xcd_barrier_post(unsigned* bar, volatile LAS unsigned* st) {
    XcdBarrier b; b.bar = bar; b.x = xb_xcc_id(); b.st = st;
    if (threadIdx.x == 0) (void)xb_add(&bar[XB_XCNT(b.x)], 1u);
    return b;
}
__device__ __forceinline__ void xcd_barrier_complete(unsigned* bar, unsigned x, unsigned& nloc, unsigned& nx) {
    const unsigned G = gridDim.x * gridDim.y * gridDim.z;
    unsigned sum, cnt, mine, sp = 0u;
    for (;;) {
        sum = 0u; cnt = 0u; mine = 0u;
#pragma unroll
        for (unsigned j = 0; j < 16; ++j) { const unsigned c = xb_ld(&bar[XB_XCNT(j)]); sum += c; cnt += (c > 0u) ? 1u : 0u; mine = (j == x) ? c : mine; }
        if (sum == G) break;
        __builtin_amdgcn_s_sleep(1);
        if ((++sp & 255u) == 0u) { if (xb_ld(&bar[XB_TMO])) break; if (sp > XB_SPIN_CAP) { atomicAdd(&bar[XB_TMO], 1u); break; } }
    }
    nloc = mine > 0u ? mine : 1u; nx = cnt > 0u ? cnt : 1u;
}

__device__ __forceinline__ void xcd_barrier(const XcdBarrier& b) {
    asm volatile("s_waitcnt vmcnt(0)" ::: "memory");
    __syncthreads();
    if (threadIdx.x == 0) {
        unsigned* bar = b.bar;
        __builtin_amdgcn_s_waitcnt(0);
        unsigned nloc = b.st[0], nx = b.st[1];
        if (nloc == 0u) { xcd_barrier_complete(bar, b.x, nloc, nx); b.st[0] = nloc; b.st[1] = nx; }
        const unsigned old = xb_add(&bar[XB_XSUB(b.x)], 1u);
        const unsigned gen = old / nloc;
        if (old + 1u == (gen + 1u) * nloc) {
            __builtin_amdgcn_fence(__ATOMIC_RELEASE, "agent");
            asm volatile("s_waitcnt vmcnt(0)" ::: "memory");
            const unsigned og = xb_add(&bar[XB_TOP], 1u);
            const unsigned tg = og / nx;
            if (og + 1u == (tg + 1u) * nx) xb_add(&bar[XB_TOPGEN], 1u);
            else XB_SPIN(xb_ld(&bar[XB_TOPGEN]) == tg, bar);
            __builtin_amdgcn_fence(__ATOMIC_ACQUIRE, "agent");
            xb_add(&bar[XB_XGEN(b.x)], 1u);
            asm volatile("s_waitcnt vmcnt(0)" ::: "memory");
        } else {
            XB_SPIN(xb_ld(&bar[XB_XGEN(b.x)]) == gen, bar);
            __builtin_amdgcn_fence(__ATOMIC_ACQUIRE, "agent");
            asm volatile("s_waitcnt vmcnt(0)" ::: "memory");
        }
    }
    __syncthreads();
}
namespace pg8 {
#define PG8_LAS __attribute__((address_space(3)))
typedef unsigned short bf16_t;
typedef short bf16x8 __attribute__((ext_vector_type(8)));
typedef float f32x4 __attribute__((ext_vector_type(4)));
typedef unsigned u32x4 __attribute__((ext_vector_type(4)));
constexpr int BM = 256, BK = 64, HALF = 128, HTB = HALF * BK * 2  , STAGE_BYTES = 8 * HTB, NXCD = 8, WGM = 8;

__host__ __device__ __forceinline__ int lds_byte(int r, int c) { const int st = (r >> 4) * 2 + (c >> 5), rr = r & 15, cc = c & 31, ob = rr * 64 + cc * 2; return st * 1024 + (ob ^ (((ob >> 9) & 1) << 5)); }
__host__ __device__ __forceinline__ void stage_rc(int b, int& R, int& C) { const int st = b / 1024, sb = b % 1024, swz = sb ^ (((sb >> 9) & 1) << 5); R = (st >> 1) * 16 + swz / 64; C = (st & 1) * 32 + (swz % 64) / 2; }
__host__ __device__ __forceinline__ int perm32(int rho) { const int n = rho >> 4, i = rho & 15; return 8 * (i >> 2) + 4 * n + (i & 3); }

struct Unit { int pm, pn; long boff; };
struct Gemm { const bf16_t* A; const bf16_t* Bt; int M, N, K; };

struct StaticOrder {
    int nM, nN, nwg, G, c;
    __host__ __device__ void init(int M, int N, int G_, int c_) { nM = M / BM; nN = N / BM; nwg = nM * nN; G = G_; c = c_; }
    __host__ __device__ bool next(int i, Unit& u) const {
        const long L = (long)i * G + c; if (L >= nwg) return false;
        int wgid = (int)L; { const int q = nwg / NXCD, r = nwg % NXCD, xcd = wgid % NXCD, off = wgid / NXCD; wgid = (xcd < r ? xcd * (q + 1) : r * (q + 1) + (xcd - r) * q) + off; }
        const int nig = WGM * nN, gid = wgid / nig, fm = gid * WGM, gsz = (nM - fm) < WGM ? (nM - fm) : WGM;
        u.pm = fm + ((wgid % nig) % gsz); u.pn = (wgid % nig) / gsz; u.boff = 0; return true;
    }
    __device__ __forceinline__ void a_ready(const Unit&) const {}
    __device__ __forceinline__ void done(const Unit&) const {}
};
__device__ __forceinline__ unsigned cvt_pk_bf16(float lo, float hi) { unsigned r; asm volatile("v_cvt_pk_bf16_f32 %0, %1, %2" : "=v"(r) : "v"(lo), "v"(hi)); return r; }
template <class Epi, class Sched, bool STAMP = false>
__device__ __forceinline__ void gemm_phase(PG8_LAS unsigned char* lds, const Gemm g, const Sched& S, const Epi& E, unsigned long long* stamps = nullptr) {
    int tid_l = threadIdx.x; asm volatile("" : "+v"(tid_l)); const int tid = tid_l, wid = __builtin_amdgcn_readfirstlane(tid >> 6), lane = tid & 63, wr = wid >> 2, wc = wid & 3, fr = lane & 15, fq = lane >> 4;
    const int K = g.K, nt = K / BK;
    int ts_lo = 0, ts_hi = 0, nts = 0; const unsigned long long rt_entry = STAMP ? (unsigned long long)wall_clock64() : 0ull;
#define PG8_STAMP() do { if (STAMP && wid == 0 && nts < 64) { const unsigned long long _c = (unsigned long long)clock64(); \
        ts_lo = (lane == nts) ? (int)(unsigned)_c : ts_lo; ts_hi = (lane == nts) ? (int)(unsigned)(_c >> 32) : ts_hi; ++nts; } } while (0)
    PG8_STAMP();
    unsigned voffA[2], voffB[2];
#pragma unroll
    for (int i = 0; i < 2; ++i) { int R, C; stage_rc(tid * 16 + i * 8192, R, C); const int Rb = Epi::PERM ? ((R & ~31) + perm32(R & 31)) : R;
        voffA[i] = (unsigned)(R * K + C) * 2u; voffB[i] = (unsigned)(Rb * K + C) * 2u; }
    const size_t kstep = (size_t)(BK * 2);
    const size_t hstep = (size_t)HALF * K * 2;
    const size_t tstep = 2 * hstep;
    const unsigned ldsw = (unsigned)wid * 1024u;
    const int aoff = lds_byte(wr * 64 + fr, fq * 8), boff = lds_byte(wc * 32 + fr, fq * 8);
#define PG8_SA(b, h) (((b) * 2 + (h)) * HTB)
#define PG8_SB(b, h) ((4 + (b) * 2 + (h)) * HTB)
#define PG8_STAGE(bufoff, gbase, voff) do { _Pragma("unroll") for (int _i = 0; _i < 2; ++_i) \
        __builtin_amdgcn_global_load_lds((const unsigned*)((const char*)(gbase) + (voff)[_i]), (PG8_LAS unsigned*)(lds + (bufoff) + ldsw + _i * 8192), 16, 0, 0); } while (0)
#define PG8_LDA(dst, b, h) do { _Pragma("unroll") for (int m = 0; m < 4; ++m) _Pragma("unroll") for (int k = 0; k < 2; ++k) dst[m][k] = *(const PG8_LAS bf16x8*)(lds + PG8_SA(b, h) + aoff + m * 2048 + k * 1024); } while (0)
#define PG8_LDB(dst, b, h) do { _Pragma("unroll") for (int n = 0; n < 2; ++n) _Pragma("unroll") for (int k = 0; k < 2; ++k) dst[n][k] = *(const PG8_LAS bf16x8*)(lds + PG8_SB(b, h) + boff + n * 2048 + k * 1024); } while (0)
#define PG8_MMA(ai, bj, At, Bt) do { __builtin_amdgcn_s_setprio(1); _Pragma("unroll") for (int m = 0; m < 4; ++m) _Pragma("unroll") for (int n = 0; n < 2; ++n) _Pragma("unroll") for (int k = 0; k < 2; ++k) \
        acc[ai][bj][m][n] = __builtin_amdgcn_mfma_f32_16x16x32_bf16(Bt[n][k], At[m][k], acc[ai][bj][m][n], 0, 0, 0); __builtin_amdgcn_s_setprio(0); } while (0)
#define PG8_WAIT_V(n) asm volatile("s_waitcnt vmcnt(" #n ")" ::: "memory")
#define PG8_WAIT_L(n) asm volatile("s_waitcnt lgkmcnt(" #n ")" ::: "memory")
#define PG8_BAR __builtin_amdgcn_s_barrier()
#define PG8_SCHED __builtin_amdgcn_sched_barrier(0)
    Unit cur, nxt; int ui = 0;
    if (!S.next(0, cur)) return;
    f32x4 acc[2][2][4][2];
#pragma unroll
    for (int a = 0; a < 2; ++a)
#pragma unroll
        for (int b = 0; b < 2; ++b)
#pragma unroll
            for (int m = 0; m < 4; ++m)
#pragma unroll
                for (int n = 0; n < 2; ++n) acc[a][b][m][n] = (f32x4){0.f, 0.f, 0.f, 0.f};
    bf16x8 At[4][2], B0[2][2], B1[2][2];
    const char* cA = (const char*)g.A + (size_t)cur.pm * tstep; const char* cB = (const char*)g.Bt + (size_t)cur.pn * tstep + cur.boff;
    S.a_ready(cur);
    PG8_STAGE(PG8_SB(0, 0), cB, voffB); PG8_STAGE(PG8_SA(0, 0), cA, voffA); PG8_STAGE(PG8_SB(0, 1), cB + hstep, voffB); PG8_STAGE(PG8_SA(0, 1), cA + hstep, voffA);
    if (wr == 1) PG8_BAR;
    PG8_WAIT_V(4); PG8_BAR;
    PG8_STAGE(PG8_SB(1, 0), cB + kstep, voffB); PG8_STAGE(PG8_SA(1, 0), cA + kstep, voffA); PG8_STAGE(PG8_SB(1, 1), cB + hstep + kstep, voffB);
    PG8_WAIT_V(6); PG8_BAR;
    PG8_STAMP();
    for (;;) {
        const bool has_next = S.next(ui + 1, nxt);
        const char* nA = has_next ? (const char*)g.A + (size_t)nxt.pm * tstep : cA; const char* nB = has_next ? (const char*)g.Bt + (size_t)nxt.pn * tstep + nxt.boff : cB;
        for (int t = 0; t < nt; t += 2) {
            const bool last = (t == nt - 2);
            const char* a1 = cA + (size_t)(t + 1) * kstep;
            const char* a2 = last ? nA : cA + (size_t)(t + 2) * kstep; const char* b2 = last ? nB : cB + (size_t)(t + 2) * kstep;
            const char* a3 = a2 + kstep; const char* b3 = b2 + kstep;
            if (last && has_next) S.a_ready(nxt);
            PG8_LDB(B0, 0, 0); PG8_SCHED; PG8_LDA(At, 0, 0); PG8_STAGE(PG8_SA(1, 1), a1 + hstep, voffA);
            PG8_WAIT_L(8); PG8_BAR; PG8_WAIT_L(0); PG8_MMA(0, 0, At, B0); PG8_BAR; PG8_SCHED;
            PG8_LDB(B1, 0, 1); PG8_STAGE(PG8_SB(0, 0), b2, voffB);
            PG8_BAR; PG8_WAIT_L(0); PG8_MMA(0, 1, At, B1); PG8_BAR;
            PG8_LDA(At, 0, 1); PG8_STAGE(PG8_SA(0, 0), a2, voffA);
            PG8_BAR; PG8_WAIT_L(0); PG8_MMA(1, 0, At, B0); PG8_BAR; PG8_SCHED;
            PG8_STAGE(PG8_SB(0, 1), b2 + hstep, voffB);
            PG8_WAIT_V(6); PG8_BAR; PG8_MMA(1, 1, At, B1); PG8_BAR;
            PG8_LDB(B0, 1, 0); PG8_SCHED; PG8_LDA(At, 1, 0); PG8_STAGE(PG8_SA(0, 1), a2 + hstep, voffA);
            PG8_WAIT_L(8); PG8_BAR; PG8_WAIT_L(0); PG8_MMA(0, 0, At, B0); PG8_BAR; PG8_SCHED;
            PG8_LDB(B1, 1, 1); PG8_STAGE(PG8_SB(1, 0), b3, voffB);
            PG8_BAR; PG8_WAIT_L(0); PG8_MMA(0, 1, At, B1); PG8_BAR;
            PG8_LDA(At, 1, 1); PG8_STAGE(PG8_SA(1, 0), a3, voffA);
            PG8_BAR; PG8_WAIT_L(0); PG8_MMA(1, 0, At, B0); PG8_BAR; PG8_SCHED;
            PG8_STAGE(PG8_SB(1, 1), b3 + hstep, voffB);
            PG8_WAIT_V(6); PG8_BAR; PG8_MMA(1, 1, At, B1); PG8_BAR;
        }
        PG8_STAMP();
        if constexpr (!Epi::AFTER_DRAIN) { E(acc, cur, wr, wc, fr, fq); S.done(cur); }
        PG8_STAMP();
        if (!has_next) break;
#pragma unroll
        for (int a = 0; a < 2; ++a)
#pragma unroll
            for (int b = 0; b < 2; ++b)
#pragma unroll
                for (int m = 0; m < 4; ++m)
#pragma unroll
                    for (int n = 0; n < 2; ++n) acc[a][b][m][n] = (f32x4){0.f, 0.f, 0.f, 0.f};
        cur = nxt; cA = nA; cB = nB; ++ui;
    }
    PG8_WAIT_V(0);
    if (wr == 0) PG8_BAR;
    PG8_BAR;
    if constexpr (Epi::AFTER_DRAIN) { E.fused(acc, cur, wr, wc, fr, fq, lds, wid, lane); S.done(cur); }
    PG8_STAMP();
    if (STAMP && wid == 0) { stamps[lane] = lane < nts ? (((unsigned long long)(unsigned)ts_hi << 32) | (unsigned)ts_lo) : 0ull;
        if (lane == 62) stamps[62] = rt_entry; if (lane == 63) stamps[63] = (unsigned long long)wall_clock64(); }
#undef PG8_STAMP
#undef PG8_SA
#undef PG8_SB
#undef PG8_STAGE
#undef PG8_LDA
#undef PG8_LDB
#undef PG8_MMA
#undef PG8_WAIT_V
#undef PG8_WAIT_L
#undef PG8_BAR
#undef PG8_SCHED
}
}

struct Frame {
    LAS unsigned char* lds;
    const float* const __attribute__((address_space(4)))* in;
    unsigned char* ws;
    float* out;
    int tid, lane, wave, G, bid;
};
#define WSP(T, off) ((T*)(F.ws + (off)))

struct ConvItem { const float* src; bf16_t* dst; int ld, ncols, c0, k0, mode, kdim; };
DI int conv_dst_row(int mode, int c) {
    if (mode == 1) return c < DT_COL ? c : (c < DT_COL + 8 ? -1 : c - 8);
    if (mode == 2) { const int j = c >> 1, up = c & 1; return (j >> 7) * 256 + up * 128 + (j & 127); }
    return c;
}
constexpr int N_S5I = DEPTH * 16, N_ADA = DEPTH * 48, N_CV_WIN = DEPTH * 41 * 4, N_CV_WOUT = DEPTH * 16 * 4, N_CV_GU = DEPTH * NEXP * 32 * 4,
              N_CV_DN = DEPTH * NEXP * 16 * 4, N_CV_GLU = DEPTH * 4;
constexpr int N_CONV = N_CV_WIN + N_CV_WOUT + N_CV_GU + N_CV_DN + N_CV_GLU;
DI ConvItem conv_decode(const Frame& F, int it) {
    ConvItem c; c.kdim = DM;
    if (it < N_CV_WIN) { const int l = it / 164, r = it % 164; c.src = F.in[I_WIN] + (size_t)l * DM * DIN; c.dst = WSP(bf16_t, WS_WIN) + (size_t)l * NU * DM;
        c.ld = DIN; c.ncols = DIN; c.c0 = (r >> 2) * 64; c.k0 = (r & 3) * 256; c.mode = 1; return c; }
    it -= N_CV_WIN;
    if (it < N_CV_WOUT) { const int l = it / 64, r = it % 64; c.src = F.in[I_WOUT] + (size_t)l * DM * DM; c.dst = WSP(bf16_t, WS_WOUT) + (size_t)l * DM * DM;
        c.ld = DM; c.ncols = DM; c.c0 = (r >> 2) * 64; c.k0 = (r & 3) * 256; c.mode = 0; return c; }
    it -= N_CV_WOUT;
    if (it < N_CV_GU) { const int le = it / 128, r = it % 128; c.src = F.in[I_WGU] + (size_t)le * DM * 2048; c.dst = WSP(bf16_t, WS_WGU) + (size_t)le * 2048 * DM;
        c.ld = 2048; c.ncols = 2048; c.c0 = (r >> 2) * 64; c.k0 = (r & 3) * 256; c.mode = 2; return c; }
    it -= N_CV_GU;
    if (it < N_CV_DN) { const int le = it / 64, r = it % 64; c.src = F.in[I_WDN] + (size_t)le * DM * DM; c.dst = WSP(bf16_t, WS_WDN) + (size_t)le * DM * DM;
        c.ld = DM; c.ncols = DM; c.c0 = (r >> 2) * 64; c.k0 = (r & 3) * 256; c.mode = 0; return c; }
    it -= N_CV_DN;
    { const int l = it / 4, r = it % 4; c.src = F.in[I_WGLU] + (size_t)l * 256 * 256; c.dst = WSP(bf16_t, WS_WGLU) + (size_t)l * 256 * 256;
      c.ld = 256; c.ncols = 256; c.c0 = r * 64; c.k0 = 0; c.mode = 0; c.kdim = 256; return c; }
}
DI void conv_load(const ConvItem& c, int tid, f32x4 (&v)[8]) {
#pragma unroll
    for (int i = 0; i < 8; ++i) { const int idx = tid + 512 * i, k = idx >> 4, c4 = idx & 15; const int col = c.c0 + 4 * c4;
        v[i] = (col < c.ncols) ? *(const f32x4*)(c.src + (size_t)(c.k0 + k) * c.ld + col) : (f32x4){0.f, 0.f, 0.f, 0.f}; }
}
DI int q_next(const Frame& F, unsigned* ctr) {
    LAS int* slot = (LAS int*)(F.lds + LDS_BYTES - 16);
    __syncthreads();
    if (F.tid == 0) *slot = (int)__hip_atomic_fetch_add(ctr, 1u, __ATOMIC_RELAXED, __HIP_MEMORY_SCOPE_AGENT);
    __syncthreads();
    return *slot;
}
DI void p0_convert(const Frame& F, unsigned* ctr) {
    LAS float* T = (LAS float*)F.lds;
    const int tid = F.tid;
    f32x4 v[8];
    int it = q_next(F, ctr);
    if (it >= N_CONV) return;
    ConvItem cur = conv_decode(F, it);
    conv_load(cur, tid, v);
    for (;;) {
#pragma unroll
        for (int i = 0; i < 8; ++i) { const int idx = tid + 512 * i, k = idx >> 4, c4 = idx & 15;
            T[k * 65 + 4 * c4 + 0] = v[i][0]; T[k * 65 + 4 * c4 + 1] = v[i][1]; T[k * 65 + 4 * c4 + 2] = v[i][2]; T[k * 65 + 4 * c4 + 3] = v[i][3]; }
        __syncthreads();
        const int nit = q_next(F, ctr); const bool has_next = nit < N_CONV;
        ConvItem nxt = cur;
        if (has_next) { nxt = conv_decode(F, nit); conv_load(nxt, tid, v); }
#pragma unroll
        for (int i = 0; i < 4; ++i) { const int task = tid + 512 * i, c = task & 63, kc = task >> 6;
            const int col = cur.c0 + c; const int row = (col < cur.ncols) ? conv_dst_row(cur.mode, col) : -1;
            u32x4 o;
#pragma unroll
            for (int j = 0; j < 4; ++j) o[j] = pk2(T[(8 * kc + 2 * j) * 65 + c], T[(8 * kc + 2 * j + 1) * 65 + c]);
            if (row >= 0) *(u32x4*)(cur.dst + (size_t)row * cur.kdim + cur.k0 + 8 * kc) = o; }
        __syncthreads();
        if (!has_next) break;
        cur = nxt; it = nit;
    }
}
DI void p0_adaln(const Frame& F, int item) {
    const int l = item / 48, col0 = (item % 48) * 128, tid = F.tid, part = tid >> 5, ct = tid & 31;
    const float* W = F.in[I_WADA] + (size_t)l * DM * 6144 + col0 + 4 * ct;
    const float* cl = F.in[I_C]; const float* cc = F.in[I_CCTX];
    f32x4 al = {0.f, 0.f, 0.f, 0.f}, ac = {0.f, 0.f, 0.f, 0.f};
#pragma unroll 8
    for (int kk = 0; kk < 64; ++kk) { const int k = part * 64 + kk; const f32x4 w = *(const f32x4*)(W + (size_t)k * 6144);
        const float sl = silu_f(cl[k]), sc = silu_f(cc[k]); al += w * sl; ac += w * sc; }
    LAS float* R = (LAS float*)F.lds;
#pragma unroll
    for (int j = 0; j < 4; ++j) { R[(part * 32 + ct) * 8 + j] = al[j]; R[(part * 32 + ct) * 8 + 4 + j] = ac[j]; }
    __syncthreads();
    if (tid < 256) { const int v = tid >> 7, col = tid & 127; float s = 0.f;
#pragma unroll
        for (int p = 0; p < 16; ++p) s += R[(p * 32 + (col >> 2)) * 8 + v * 4 + (col & 3)];
        WSP(float, WS_MOD)[((size_t)l * 2 + v) * 6144 + col0 + col] = s + F.in[I_BADA][(size_t)l * 6144 + col0 + col]; }
    __syncthreads();
}
DI void p0_rope(const Frame& F) {
    f32x2* rd = WSP(f32x2, WS_ROPE); f32x2* rg = rd + 256 * 8;
    for (int i = F.tid; i < 256 * 8; i += 512) { const int pos = i >> 3, f = i & 7; const float inv = exp2f(-(float)(2 * f) / 16.f * 13.287712379549449f);
        float s, c; sincosf((float)pos * inv, &s, &c); rd[i] = (f32x2){c, s}; }
    if (F.tid < DEPTH) { const int l = F.tid; float s1 = 0.f, s2 = 0.f;
        for (int i = 0; i < 32; ++i) { s1 += F.in[I_LQ1][l * 32 + i] * F.in[I_LK1][l * 32 + i]; s2 += F.in[I_LQ2][l * 32 + i] * F.in[I_LK2][l * 32 + i]; }
        WSP(float, WS_LAM)[l] = __expf(s1) - __expf(s2) + (0.8f - 0.6f * __expf(-0.3f * (float)l)); }
    for (int i = F.tid; i < 256 * 16; i += 512) { const int pos = i >> 4, f = i & 15; const float inv = exp2f(-(float)(2 * f) / 32.f * 13.287712379549449f);
        float s, c; sincosf((float)pos * inv, &s, &c); rg[i] = (f32x2){c, s}; }
}
DI f32x2 cmul(f32x2 a, f32x2 b) { return (f32x2){a.x * b.x - a.y * b.y, a.x * b.y + a.y * b.x}; }
DI void p0_s5(const Frame& F, int item) {
    const int l = item >> 4, g = item & 15, tid = F.tid;
    LAS f32x2* PW = (LAS f32x2*)F.lds;
    LAS f32x2* BB = PW + 2 * 65 * 64;
    LAS f32x2* CM = BB + 2 * 64 * 16;
    LAS float* D0 = (LAS float*)(CM + 2 * 16 * 64);
    for (int i = tid; i < 2 * 65 * 64; i += 512) { const int dir = i / (65 * 64), n = (i / 64) % 65, p = i & 63;
        const size_t li = (((size_t)l * 2 + dir) * 16 + g) * 64 + p;
        const float step = __expf(F.in[I_LOGDT][((size_t)l * 2 + dir) * 16 + g]);
        const float tr = F.in[I_LAMRE][li] * step, ti = F.in[I_LAMIM][li] * step;
        float s, c; sincosf((float)n * ti, &s, &c); const float m = __expf((float)n * tr); PW[i] = (f32x2){m * c, m * s}; }
    __syncthreads();
    for (int i = tid; i < 2 * 64 * 16; i += 512) { const int dir = i >> 10, p = (i >> 4) & 63, c = i & 15;
        const size_t li = (((size_t)l * 2 + dir) * 16 + g) * 64 + p;
        const f32x2 lam = {F.in[I_LAMRE][li], F.in[I_LAMIM][li]}; const f32x2 a = PW[(dir * 65 + 1) * 64 + p];
        const f32x2 num = {a.x - 1.f, a.y}; const float den = lam.x * lam.x + lam.y * lam.y;
        const f32x2 q = {(num.x * lam.x + num.y * lam.y) / den, (num.y * lam.x - num.x * lam.y) / den};
        const size_t bi = (((size_t)l * 16 + g) * 64 + p) * 16 + c;
        BB[i] = cmul(q, (f32x2){F.in[I_BRE][bi], F.in[I_BIM][bi]}); }
    for (int i = tid; i < 2 * 16 * 64; i += 512) { const int dir = i >> 10, c = (i >> 6) & 15, p = i & 63;
        const size_t ci = ((((size_t)l * 2 + dir) * 16 + g) * 16 + c) * 64 + p; CM[i] = (f32x2){F.in[I_CRE][ci], F.in[I_CIM][ci]}; }
    __syncthreads();
    bf16_t* kt = WSP(bf16_t, WS_KTAB) + ((size_t)l * 16 + g) * 3 * 64 * 256;
    for (int i = tid; i < 2 * 64 * 256; i += 512) { const int dir = i >> 14, lag = (i >> 8) & 63, c = (i >> 4) & 15, cp = i & 15; float s = 0.f;
        for (int p = 0; p < 64; ++p) { const f32x2 w = cmul(PW[(dir * 65 + lag) * 64 + p], BB[(dir * 64 + p) * 16 + cp]); const f32x2 cm = CM[(dir * 16 + c) * 64 + p]; s += cm.x * w.x - cm.y * w.y; }
        kt[i] = f2bf(s); if (lag == 0) D0[dir * 256 + (i & 255)] = s; }
    __syncthreads();
    for (int i = tid; i < 256; i += 512) { const int c = i >> 4, cp = i & 15; kt[2 * 64 * 256 + i] = f2bf(D0[i] + D0[256 + i] + (c == cp ? F.in[I_S5D][(size_t)l * 256 + g * 16 + c] : 0.f)); }
    bf16_t* e5 = WSP(bf16_t, WS_E5) + ((size_t)l * 16 + g) * 2 * 128 * 1024;
    for (int i = tid; i < 2 * 128 * 1024; i += 512) { const int dir = i >> 17, m = (i >> 10) & 127, s = (i >> 4) & 63, cp = i & 15, p = m & 63;
        const int n = dir ? s : 63 - s; const f32x2 w = cmul(PW[(dir * 65 + n) * 64 + p], BB[(dir * 64 + p) * 16 + cp]); e5[i] = f2bf(m < 64 ? w.x : w.y); }
    bf16_t* cc5 = WSP(bf16_t, WS_CC5) + ((size_t)l * 16 + g) * 1024 * 256;
    for (int i = tid; i < 1024 * 256; i += 512) { const int row = i >> 8, col = i & 255, t = row >> 4, c = row & 15, dir = col >> 7, im = (col >> 6) & 1, p = col & 63;
        const int n = dir ? 64 - t : t + 1; const f32x2 w = cmul(CM[(dir * 16 + c) * 64 + p], PW[(dir * 65 + n) * 64 + p]); cc5[i] = f2bf(im ? -w.y : w.x); }
    f32x2* ap = WSP(f32x2, WS_APOW) + ((size_t)l * 16 + g) * 128;
    for (int i = tid; i < 128; i += 512) ap[i] = PW[((i >> 6) * 65 + 64) * 64 + (i & 63)];
    __syncthreads();
}
DI void p0_prologue(const Frame& F) {
    for (int it = F.bid; it < N_S5I + N_ADA + 1; it += F.G) {
        if (it < N_S5I) p0_s5(F, it); else if (it < N_S5I + N_ADA) p0_adaln(F, it - N_S5I); else p0_rope(F);
    }
    __syncthreads();
    p0_convert(F, WSP(unsigned, WS_CTL) + CW_Q0);
}

constexpr int RPB = 65;
template <bool FINAL>
DI void p1_norm(const Frame& F, int l) {
    LAS float* WDT = (LAS float*)F.lds;
    if (!FINAL) {
        for (int i = F.tid; i < 1024 * 8; i += 512) WDT[i] = F.in[I_WIN][(size_t)l * DM * DIN + (size_t)(i >> 3) * DIN + DT_COL + (i & 7)];
        __syncthreads();
    }
    const float* mod_cur = WSP(float, WS_MOD) + (size_t)(FINAL ? 0 : l) * 2 * 6144;
    const float* mod_prev = WSP(float, WS_MOD) + (size_t)(l > 0 ? l - 1 : 0) * 2 * 6144;
    const int lane = F.lane;
    for (int r = F.wave; r < RPB; r += 8) {
        const int row = F.bid * RPB + r; if (row >= NT) break;
        const int v = row < CTX ? 1 : 0;
        if (FINAL && v) continue;
        f32x4 x[4];
        if (l == 0) {
            const float* src = v ? F.in[I_CTX] + (size_t)row * DM : F.in[I_X] + (size_t)(row - CTX) * DM;
#pragma unroll
            for (int i = 0; i < 4; ++i) x[i] = *(const f32x4*)(src + 256 * i + 4 * lane);
        } else {
            const float* x1 = WSP(float, WS_XA) + (size_t)row * DM;
            const int* slots = WSP(int, WS_TOPP) + (size_t)row * 4; const float* gates = WSP(float, WS_TOPG) + (size_t)row * 4;
            const float* g2 = mod_prev + (size_t)v * 6144 + 5 * 1024;
            int sl[4]; float ga[4];
#pragma unroll
            for (int k = 0; k < 4; ++k) { sl[k] = slots[k]; ga[k] = gates[k]; }
#pragma unroll
            for (int i = 0; i < 4; ++i) { const int col = 256 * i + 4 * lane; f32x4 acc = {0.f, 0.f, 0.f, 0.f};
#pragma unroll
                for (int k = 0; k < 4; ++k) { const u32x2 y = *(const u32x2*)(WSP(bf16_t, WS_YB) + (size_t)sl[k] * DM + col);
                    acc[0] += ga[k] * bflo(y[0]); acc[1] += ga[k] * bfhi(y[0]); acc[2] += ga[k] * bflo(y[1]); acc[3] += ga[k] * bfhi(y[1]); }
                x[i] = *(const f32x4*)(x1 + col) + *(const f32x4*)(g2 + col) * acc;
                if (!FINAL) *(f32x4*)(WSP(float, WS_XB) + (size_t)row * DM + col) = x[i]; }
        }
        float ss = 0.f;
#pragma unroll
        for (int i = 0; i < 4; ++i) ss += x[i][0] * x[i][0] + x[i][1] * x[i][1] + x[i][2] * x[i][2] + x[i][3] * x[i][3];
        ss = wave_sum(ss);
        const float rs = __builtin_amdgcn_rsqf(ss * (1.f / 1024.f) + EPS);
        if (FINAL) {
#pragma unroll
            for (int i = 0; i < 4; ++i) { const int col = 256 * i + 4 * lane; *(f32x4*)(F.out + (size_t)(row - CTX) * DM + col) = x[i] * rs * *(const f32x4*)(F.in[I_FNW] + col); }
        } else {
            const float* nw = F.in[I_N1W] + (size_t)l * DM; const float* sh = mod_cur + (size_t)v * 6144; const float* sc = sh + 1024;
            float d[8] = {0.f, 0.f, 0.f, 0.f, 0.f, 0.f, 0.f, 0.f};
#pragma unroll
            for (int i = 0; i < 4; ++i) { const int col = 256 * i + 4 * lane;
                const f32x4 h = x[i] * rs * *(const f32x4*)(nw + col) * (*(const f32x4*)(sc + col) + 1.f) + *(const f32x4*)(sh + col);
                u32x2 o; o[0] = pk2(h[0], h[1]); o[1] = pk2(h[2], h[3]);
                *(u32x2*)(WSP(bf16_t, WS_H) + (size_t)row * DM + col) = o;
#pragma unroll
                for (int c = 0; c < 4; ++c) { const f32x4 w0 = *(const LAS f32x4*)(WDT + (col + c) * 8), w1 = *(const LAS f32x4*)(WDT + (col + c) * 8 + 4);
#pragma unroll
                    for (int j = 0; j < 4; ++j) { d[j] += h[c] * w0[j]; d[4 + j] += h[c] * w1[j]; } } }
#pragma unroll
            for (int j = 0; j < 8; ++j) d[j] = wave_sum(d[j]);
            if (lane == 0) { float* o = WSP(float, WS_DTRAW) + (size_t)row * 8;
                *(f32x4*)o = (f32x4){d[0], d[1], d[2], d[3]}; *(f32x4*)(o + 4) = (f32x4){d[4], d[5], d[6], d[7]}; }
        }
    }
    __syncthreads();
}

constexpr int WR_PITCH = 36;
DI void p7a_router(const Frame& F, int l) {
    LAS float* WR = (LAS float*)F.lds;
    LAS int* CNT = (LAS int*)(F.lds + 1024 * WR_PITCH * 4);
    LAS int* BASE = CNT + 32;
    LAS int* RI = BASE + 32;
    for (int i = F.tid; i < 1024 * 32; i += 512) WR[(i >> 5) * WR_PITCH + (i & 31)] = F.in[I_WR][(size_t)l * DM * 32 + i];
    if (F.tid < 32) CNT[F.tid] = 0;
    __syncthreads();
    const int lane = F.lane;
    const float* mod = WSP(float, WS_MOD) + (size_t)l * 2 * 6144;
    const float* nw = F.in[I_N2W] + (size_t)l * DM;
    const float br = F.in[I_BR][(size_t)l * 32 + (lane >> 1)];
    for (int r = F.wave; r < RPB; r += 8) {
        const int row = F.bid * RPB + r; if (row >= NT) break;
        const int v = row < CTX ? 1 : 0;
        const float* x1 = WSP(float, WS_XA) + (size_t)row * DM; const float* sh = mod + (size_t)v * 6144 + 3 * 1024; const float* sc = sh + 1024;
        f32x4 x[4]; float ss = 0.f;
#pragma unroll
        for (int i = 0; i < 4; ++i) { x[i] = *(const f32x4*)(x1 + 256 * i + 4 * lane); ss += x[i][0] * x[i][0] + x[i][1] * x[i][1] + x[i][2] * x[i][2] + x[i][3] * x[i][3]; }
        ss = wave_sum(ss);
        const float rs = __builtin_amdgcn_rsqf(ss * (1.f / 1024.f) + EPS);
        float lg[32];
#pragma unroll
        for (int e = 0; e < 32; ++e) lg[e] = 0.f;
#pragma unroll
        for (int i = 0; i < 4; ++i) { const int col = 256 * i + 4 * lane;
            const f32x4 h = x[i] * rs * *(const f32x4*)(nw + col) * (*(const f32x4*)(sc + col) + 1.f) + *(const f32x4*)(sh + col);
            u32x2 o; o[0] = pk2(h[0], h[1]); o[1] = pk2(h[2], h[3]);
            *(u32x2*)(WSP(bf16_t, WS_H) + (size_t)row * DM + col) = o;
#pragma unroll
            for (int c = 0; c < 4; ++c) {
#pragma unroll
                for (int q = 0; q < 8; ++q) { const f32x4 w = *(const LAS f32x4*)(WR + (col + c) * WR_PITCH + 4 * q);
#pragma unroll
                    for (int j = 0; j < 4; ++j) lg[4 * q + j] += h[c] * w[j]; } } }
        float a16[16], a8[8], a4[4], a2[2], a1;
        { const bool up = lane & 32;
#pragma unroll
          for (int j = 0; j < 16; ++j) { const float send = up ? lg[j] : lg[16 + j]; const float keep = up ? lg[16 + j] : lg[j]; a16[j] = keep + __shfl_xor(send, 32); } }
        { const bool up = lane & 16;
#pragma unroll
          for (int j = 0; j < 8; ++j) { const float send = up ? a16[j] : a16[8 + j]; const float keep = up ? a16[8 + j] : a16[j]; a8[j] = keep + __shfl_xor(send, 16); } }
        { const bool up = lane & 8;
#pragma unroll
          for (int j = 0; j < 4; ++j) { const float send = up ? a8[j] : a8[4 + j]; const float keep = up ? a8[4 + j] : a8[j]; a4[j] = keep + __shfl_xor(send, 8); } }
        { const bool up = lane & 4;
#pragma unroll
          for (int j = 0; j < 2; ++j) { const float send = up ? a4[j] : a4[2 + j]; const float keep = up ? a4[2 + j] : a4[j]; a2[j] = keep + __shfl_xor(send, 4); } }
        { const bool up = lane & 2; const float send = up ? a2[0] : a2[1]; const float keep = up ? a2[1] : a2[0]; a1 = keep + __shfl_xor(send, 2); }
        a1 += __shfl_xor(a1, 1);
        float val = a1 + br;
        int te[4]; float tv[4];
#pragma unroll
        for (int k = 0; k < 4; ++k) { const float m = wave_max(val); const unsigned long long bal = __ballot(val == m); const int sel = (int)__ffsll((long long)bal) - 1;
            te[k] = sel >> 1; tv[k] = m; if ((lane >> 1) == te[k]) val = -INFINITY; }
        if (lane == 0) { float g[4], s = 0.f;
#pragma unroll
            for (int k = 0; k < 4; ++k) { g[k] = __expf(tv[k] - tv[0]); s += g[k]; }
#pragma unroll
            for (int k = 0; k < 4; ++k) { const int pos = atomicAdd((int*)&CNT[te[k]], 1); RI[(r * 4 + k) * 3 + 0] = te[k]; RI[(r * 4 + k) * 3 + 1] = pos; RI[(r * 4 + k) * 3 + 2] = __float_as_int(g[k] / s); } }
    }
    __syncthreads();
    if (F.tid < 32) BASE[F.tid] = (int)__hip_atomic_fetch_add(WSP(unsigned, WS_CTL) + CW_CNT + l * 32 + F.tid, (unsigned)CNT[F.tid], __ATOMIC_RELAXED, __HIP_MEMORY_SCOPE_AGENT);
    __syncthreads();
    if (F.tid < RPB * 4) { const int r = F.tid >> 2, row = F.bid * RPB + r;
        if (row < NT) { const int e = RI[F.tid * 3], pos = RI[F.tid * 3 + 1];
            WSP(int, WS_TOPE)[(size_t)row * 4 + (F.tid & 3)] = e; WSP(int, WS_TOPP)[(size_t)row * 4 + (F.tid & 3)] = BASE[e] + pos; WSP(int, WS_TOPG)[(size_t)row * 4 + (F.tid & 3)] = RI[F.tid * 3 + 2]; } }
    __syncthreads();
}

DI int moe_tables(const Frame& F, int l) {
    LAS int* PST = (LAS int*)(F.lds + LDS_MISC);
    LAS int* T2E = PST + 64;
    __syncthreads();
    if (F.tid < 64) { const int e = F.tid & 31; const int c = (int)__hip_atomic_load(WSP(unsigned, WS_CTL) + CW_CNT + l * 32 + e, __ATOMIC_RELAXED, __HIP_MEMORY_SCOPE_AGENT);
        const int pad = (c + 255) & ~255; int incl = pad;
#pragma unroll
        for (int o = 1; o < 32; o <<= 1) { const int t = __shfl_up(incl, o, 32); if (e >= o) incl += t; }
        if (F.tid < 32) { PST[e] = incl - pad; if (e == 31) PST[32] = incl; } }
    __syncthreads();
    const int ntiles = PST[32] >> 8;
    for (int r = F.tid; r < ntiles; r += 512) { int e = 0;
        for (int q = 1; q < 32; ++q) if (PST[q] <= r * 256) e = q;
        T2E[r] = e; }
    __syncthreads();
    return ntiles;
}
DI void p7b_scatter(const Frame& F, int l) {
    (void)moe_tables(F, l);
    const LAS int* PST = (const LAS int*)(F.lds + LDS_MISC);
    for (int j = F.wave; j < RPB * 4; j += 8) { const int row = F.bid * RPB + (j >> 2), k = j & 3; if (row >= NT) break;
        const int e = WSP(int, WS_TOPE)[(size_t)row * 4 + k], pos = WSP(int, WS_TOPP)[(size_t)row * 4 + k]; const int slot = PST[e] + pos;
        const u32x4* src = (const u32x4*)(WSP(bf16_t, WS_H) + (size_t)row * DM); u32x4* dst = (u32x4*)(WSP(bf16_t, WS_ASLOT) + (size_t)slot * DM);
        const u32x4 a = src[F.lane], b = src[64 + F.lane]; dst[F.lane] = a; dst[64 + F.lane] = b;
        __builtin_amdgcn_s_waitcnt(0);
        if (F.lane == 0) WSP(int, WS_TOPP)[(size_t)row * 4 + k] = slot; }
    __syncthreads();
}

struct MoeOrder {
    int nN, ntiles, G, c; const LAS int* t2e; long estride;
    DI bool next(int i, pg8::Unit& u) const { const long L = (long)i * G + c; if (L >= (long)ntiles * nN) return false;
        u.pn = (int)(L % nN); u.pm = (int)(L / nN); u.boff = (long)t2e[u.pm] * estride; return true; }
    DI void a_ready(const pg8::Unit&) const {}
    DI void done(const pg8::Unit&) const {}
};
struct EpiU {
    static constexpr bool PERM = true, AFTER_DRAIN = false;
    bf16_t* O; int ldc;
    DI void operator()(const pg8::f32x4 (&acc)[2][2][4][2], const pg8::Unit& u, int wr, int wc, int fr, int fq) const {
        const int row0 = u.pm * 256 + wr * 64 + fr, col0 = u.pn * 256 + wc * 32 + 8 * fq;
#pragma unroll
        for (int ai = 0; ai < 2; ++ai)
#pragma unroll
            for (int m = 0; m < 4; ++m) { bf16_t* rowp = O + (size_t)(row0 + ai * 128 + m * 16) * ldc + col0;
#pragma unroll
                for (int bj = 0; bj < 2; ++bj) { const pg8::f32x4 v0 = acc[ai][bj][m][0], v1 = acc[ai][bj][m][1];
                    u32x4 w; w[0] = pk2(v0[0], v0[1]); w[1] = pk2(v0[2], v0[3]); w[2] = pk2(v1[0], v1[1]); w[3] = pk2(v1[2], v1[3]);
                    *(u32x4*)(rowp + bj * 128) = w; } }
    }
};
struct EpiRes {
    static constexpr bool PERM = false, AFTER_DRAIN = false;
    float* C; const float* res_lat; const float* res_ctx; const float* g1;
    DI void operator()(const pg8::f32x4 (&acc)[2][2][4][2], const pg8::Unit& u, int wr, int wc, int fr, int fq) const {
        const int row0 = u.pm * 256 + wr * 64 + fr, col0 = u.pn * 256 + wc * 32 + 4 * fq;
        const bool isctx = (u.pm == 0);
        const float* g = g1 + (isctx ? 6144 : 0);
        pg8::f32x4 gv[2][2];
#pragma unroll
        for (int bj = 0; bj < 2; ++bj)
#pragma unroll
            for (int n = 0; n < 2; ++n) gv[bj][n] = *(const pg8::f32x4*)(g + col0 + bj * 128 + n * 16);
#pragma unroll
        for (int ai = 0; ai < 2; ++ai)
#pragma unroll
            for (int m = 0; m < 4; ++m) { const int row = row0 + ai * 128 + m * 16;
                const float* rp = isctx ? res_ctx + (size_t)row * DM : res_lat + (size_t)(row - CTX) * DM; float* cp = C + (size_t)row * DM;
#pragma unroll
                for (int bj = 0; bj < 2; ++bj)
#pragma unroll
                    for (int n = 0; n < 2; ++n) { const int col = col0 + bj * 128 + n * 16;
                        *(pg8::f32x4*)(cp + col) = *(const pg8::f32x4*)(rp + col) + gv[bj][n] * acc[ai][bj][m][n]; } }
    }
};
struct EpiAct {
    static constexpr bool PERM = false, AFTER_DRAIN = false;
    bf16_t* O; const float* bias; const LAS int* t2e;
    DI void operator()(const pg8::f32x4 (&acc)[2][2][4][2], const pg8::Unit& u, int wr, int wc, int fr, int fq) const {
        const int row0 = u.pm * 256 + wr * 64 + fr, j0 = u.pn * 128 + wc * 32 + 4 * fq;
        const float* b = bias + (size_t)t2e[u.pm] * 2048;
        pg8::f32x4 bg[2], bu[2];
#pragma unroll
        for (int n = 0; n < 2; ++n) { const pg8::f32x4 t0 = *(const pg8::f32x4*)(b + 2 * (j0 + 16 * n)), t1 = *(const pg8::f32x4*)(b + 2 * (j0 + 16 * n) + 4);
            bg[n] = (pg8::f32x4){t0[0], t0[2], t1[0], t1[2]}; bu[n] = (pg8::f32x4){t0[1], t0[3], t1[1], t1[3]}; }
#pragma unroll
        for (int ai = 0; ai < 2; ++ai)
#pragma unroll
            for (int m = 0; m < 4; ++m) { bf16_t* rowp = O + (size_t)(row0 + ai * 128 + m * 16) * DM + j0;
#pragma unroll
                for (int n = 0; n < 2; ++n) { const pg8::f32x4 gq = acc[ai][0][m][n] + bg[n], uq = acc[ai][1][m][n] + bu[n]; float a[4];
#pragma unroll
                    for (int j = 0; j < 4; ++j) { const float gg = fminf(gq[j], 7.f), uu = fminf(fmaxf(uq[j], -7.f), 7.f); a[j] = gg * sigmoid_f(1.702f * gg) * (uu + 1.f); }
                    u32x2 w; w[0] = pk2(a[0], a[1]); w[1] = pk2(a[2], a[3]); *(u32x2*)(rowp + 16 * n) = w; } }
    }
};
struct EpiDown {
    static constexpr bool PERM = true, AFTER_DRAIN = false;
    bf16_t* O; const float* bias; const LAS int* t2e;
    DI void operator()(const pg8::f32x4 (&acc)[2][2][4][2], const pg8::Unit& u, int wr, int wc, int fr, int fq) const {
        const int row0 = u.pm * 256 + wr * 64 + fr, col0 = u.pn * 256 + wc * 32 + 8 * fq;
        const float* b = bias + (size_t)t2e[u.pm] * DM;
        pg8::f32x4 bv[2][2];
#pragma unroll
        for (int bj = 0; bj < 2; ++bj)
#pragma unroll
            for (int n = 0; n < 2; ++n) bv[bj][n] = *(const pg8::f32x4*)(b + col0 + bj * 128 + 4 * n);
#pragma unroll
        for (int ai = 0; ai < 2; ++ai)
#pragma unroll
            for (int m = 0; m < 4; ++m) { bf16_t* rowp = O + (size_t)(row0 + ai * 128 + m * 16) * DM + col0;
#pragma unroll
                for (int bj = 0; bj < 2; ++bj) { const pg8::f32x4 v0 = acc[ai][bj][m][0] + bv[bj][0], v1 = acc[ai][bj][m][1] + bv[bj][1];
                    u32x4 w; w[0] = pk2(v0[0], v0[1]); w[1] = pk2(v0[2], v0[3]); w[2] = pk2(v1[0], v1[1]); w[3] = pk2(v1[2], v1[3]);
                    *(u32x4*)(rowp + bj * 128) = w; } }
    }
};

template <int DIM> DI void rope_vec(float (&v)[DIM], const f32x2* tab_row, const f32x2* tab_col) {
    constexpr int Q = DIM / 4;
#pragma unroll
    for (int i = 0; i < Q; ++i) { const f32x2 r = tab_row[i], c = tab_col[i];
        const float a = v[i], b = v[Q + i]; v[i] = a * r.x - b * r.y; v[Q + i] = a * r.y + b * r.x;
        const float a2 = v[2 * Q + i], b2 = v[3 * Q + i]; v[2 * Q + i] = a2 * c.x - b2 * c.y; v[3 * Q + i] = a2 * c.y + b2 * c.x; }
}
template <int DIM> DI void load_vec(const bf16_t* p, float (&v)[DIM]) {
#pragma unroll
    for (int i = 0; i < DIM / 8; ++i) { const u32x4 w = *(const u32x4*)(p + 8 * i);
#pragma unroll
        for (int j = 0; j < 4; ++j) { v[8 * i + 2 * j] = bflo(w[j]); v[8 * i + 2 * j + 1] = bfhi(w[j]); } }
}
template <int DIM> DI float store_vec(bf16_t* p, const float (&v)[DIM]) {
    float ss = 0.f;
#pragma unroll
    for (int i = 0; i < DIM / 8; ++i) { u32x4 w;
#pragma unroll
        for (int j = 0; j < 4; ++j) { w[j] = pk2(v[8 * i + 2 * j], v[8 * i + 2 * j + 1]); const float a = bflo(w[j]), b = bfhi(w[j]); ss += a * a + b * b; }
        *(u32x4*)(p + 8 * i) = w; }
    return ss;
}
DI void p3_attn_prep(const Frame& F, int l, int item) {
    LAS unsigned* KMX = (LAS unsigned*)(F.lds + LDS_MISC);
    LAS bf16_t* VS = (LAS bf16_t*)F.lds;
    const int tid = F.tid, tok0 = item * 64;
    if (tid < 16) KMX[tid] = 0u;
    const bf16_t* U = WSP(bf16_t, WS_U);
    for (int i = tid; i < 64 * 48; i += 512) { const int t = i / 48, c8 = i % 48; const int col = c8 < 32 ? U_DV + 8 * c8 : U_GV + 8 * (c8 - 32);
        *(LAS u32x4*)(VS + t * 384 + 8 * c8) = *(const u32x4*)(U + (size_t)(tok0 + t) * NU + col); }
    __syncthreads();
    const f32x2* ropeD = WSP(f32x2, WS_ROPE); const f32x2* ropeG = ropeD + 256 * 8;
    const float qs_d = 0.17677669529663687f * LOG2E, qs_g = 0.125f * LOG2E;
    for (int task = tid; task < 64 * 22; task += 512) {
        const int t = task / 22, vi = task % 22, tok = tok0 + t; const bool lat = tok >= CTX; const int pos = tok - CTX, pr = lat ? pos >> 6 : 0, pc = lat ? pos & 63 : 0;
        const bf16_t* urow = U + (size_t)tok * NU;
        if (vi < 16) {
            const bool isk = vi >= 8; const int hm = vi & 7, h = hm >> 1, m = hm & 1;
            float v[32]; load_vec<32>(urow + (isk ? U_DK : U_DQ) + hm * 32, v);
            if (lat) rope_vec<32>(v, ropeD + pr * 8, ropeD + pc * 8);
            if (!isk) {
#pragma unroll
                for (int i = 0; i < 32; ++i) v[i] *= qs_d;
                const float ss = store_vec<32>(WSP(bf16_t, WS_QD) + ((size_t)h * NT + tok) * 64 + m * 32, v);
                WSP(float, WS_QND)[((size_t)h * 2 + m) * NT + tok] = sqrtf(ss);
            } else {
                const float ss = store_vec<32>(WSP(bf16_t, WS_KD) + ((size_t)h * NT + tok) * 64 + m * 32, v);
                __hip_atomic_fetch_max(KMX + hm, __float_as_uint(ss), __ATOMIC_RELAXED, __HIP_MEMORY_SCOPE_WORKGROUP);
            }
        } else {
            const bool isk = vi >= 20; const int h = isk ? vi - 20 : vi - 16;
            float v[64]; load_vec<64>(urow + (isk ? U_GK : U_GQ) + h * 64, v);
            float ss = 0.f;
#pragma unroll
            for (int i = 0; i < 64; ++i) ss += v[i] * v[i];
            const float rs = __builtin_amdgcn_rsqf(ss * (1.f / 64.f) + EPS);
            const float* nw = F.in[isk ? I_KNW : I_QNW] + (size_t)l * 64;
#pragma unroll
            for (int i = 0; i < 64; ++i) v[i] = v[i] * rs * nw[i];
            if (lat) rope_vec<64>(v, ropeG + pr * 16, ropeG + pc * 16);
            if (!isk) {
#pragma unroll
                for (int i = 0; i < 64; ++i) v[i] *= qs_g;
                const float s2 = store_vec<64>(WSP(bf16_t, WS_QG) + ((size_t)h * NT + tok) * 64, v);
                WSP(float, WS_QNG)[(size_t)h * NT + tok] = sqrtf(s2);
            } else {
                const float s2 = store_vec<64>(WSP(bf16_t, WS_KG) + ((size_t)h * NT + tok) * 64, v);
                __hip_atomic_fetch_max(KMX + 8 + h, __float_as_uint(s2), __ATOMIC_RELAXED, __HIP_MEMORY_SCOPE_WORKGROUP);
            }
        }
    }
    for (int i = tid; i < 384 * 8; i += 512) { const int c = i >> 3, o = i & 7; u32x4 w;
#pragma unroll
        for (int j = 0; j < 4; ++j) { const unsigned lo = VS[(8 * o + 2 * j) * 384 + c], hi = VS[(8 * o + 2 * j + 1) * 384 + c]; w[j] = lo | (hi << 16); }
        bf16_t* dst = c < 256 ? WSP(bf16_t, WS_VTD) + (size_t)c * NT : WSP(bf16_t, WS_VTG) + (size_t)(c - 256) * NT;
        *(u32x4*)(dst + tok0 + 8 * o) = w; }
    __syncthreads();
    if (tid < 10) __hip_atomic_fetch_max(WSP(unsigned, WS_CTL) + CW_KMAX + l * 16 + tid, KMX[tid], __ATOMIC_RELAXED, __HIP_MEMORY_SCOPE_AGENT);
    __syncthreads();
}

constexpr int N_S5H = 16 * 2 * 4 * 9;
DI void p3_s5_hloc(const Frame& F, int l, int wt) {
    const int nt = wt % 9, mt = (wt / 9) & 3, dir = (wt / 36) & 1, g = wt / 72, lane = F.lane, r = lane & 31, h = lane >> 5;
    const bf16_t* E = WSP(bf16_t, WS_E5) + ((((size_t)l * 16 + g) * 2 + dir) * 128 + mt * 32 + r) * 1024 + 8 * h;
    const int chunk = nt * 32 + r, cc = chunk < NC5 ? chunk : NC5 - 1;
    const bf16_t* Ub = WSP(bf16_t, WS_U) + (size_t)cc * S5L * NU + U_S5 + g * 16 + 8 * h;
    f32x16 acc = splat16(0.f);
#pragma unroll 8
    for (int ks = 0; ks < 64; ++ks) acc = mfma32(ld8g(E + ks * 16), ld8g(Ub + (size_t)ks * NU), acc);
    if (chunk < NC5) { float* o = WSP(float, WS_HLOC) + (size_t)chunk * 4096 + (g * 2 + dir) * 128 + mt * 32;
#pragma unroll
        for (int i = 0; i < 16; ++i) o[crow(i, h)] = acc[i]; }
}

constexpr int SP = 136;
DI void p3_ssd_prep(const Frame& F, int l, int c) {
    LAS bf16_t* XT = (LAS bf16_t*)F.lds;
    LAS bf16_t* BT = XT + 256 * SP;
    LAS float* DTL = (LAS float*)(BT + 256 * SP);
    LAS float* CML = DTL + 8 * 128;
    LAS float* WG = CML + 8 * 128;
    const int tid = F.tid, lane = F.lane, tok0 = c * 128;
    const int seq_lo = c < 2 ? 0 : CTX, seq_hi = c < 2 ? CTX : NT;
    const bf16_t* U = WSP(bf16_t, WS_U);
    const float* cw = F.in[I_CONVW] + (size_t)l * 3 * 768; const float* cb = F.in[I_CONVB] + (size_t)l * 768;
    for (int task = tid; task < 128 * 96; task += 512) { const int t = task & 127, cg = task >> 7, tok = tok0 + t, ch0 = cg * 8;
        const u32x4 z4 = {0u, 0u, 0u, 0u};
        const u32x4 xm = (tok - 1 >= seq_lo) ? *(const u32x4*)(U + (size_t)(tok - 1) * NU + U_XS + ch0) : z4;
        const u32x4 x0 = *(const u32x4*)(U + (size_t)tok * NU + U_XS + ch0);
        const u32x4 xp = (tok + 1 < seq_hi) ? *(const u32x4*)(U + (size_t)(tok + 1) * NU + U_XS + ch0) : z4;
        float y[8];
#pragma unroll
        for (int j = 0; j < 4; ++j) {
            const int ch = ch0 + 2 * j;
            const float a0 = bflo(xm[j]) * cw[ch] + bflo(x0[j]) * cw[768 + ch] + bflo(xp[j]) * cw[1536 + ch] + cb[ch];
            const float a1 = bfhi(xm[j]) * cw[ch + 1] + bfhi(x0[j]) * cw[768 + ch + 1] + bfhi(xp[j]) * cw[1536 + ch + 1] + cb[ch + 1];
            y[2 * j] = silu_f(a0); y[2 * j + 1] = silu_f(a1); }
        if (ch0 < 256) {
#pragma unroll
            for (int j = 0; j < 8; ++j) XT[(ch0 + j) * SP + t] = f2bf(y[j]);
        } else { u32x4 w;
#pragma unroll
            for (int j = 0; j < 4; ++j) w[j] = pk2(y[2 * j], y[2 * j + 1]);
            if (ch0 < 512) { *(u32x4*)(WSP(bf16_t, WS_BN) + (size_t)tok * 256 + ch0 - 256) = w;
#pragma unroll
                for (int j = 0; j < 8; ++j) BT[(ch0 - 256 + j) * SP + t] = f2bf(y[j]);
            } else *(u32x4*)(WSP(bf16_t, WS_CN) + (size_t)tok * 256 + ch0 - 512) = w; }
    }
    { const int j = F.wave, dir = j >> 2; const float bias = F.in[I_DTB][(size_t)l * 8 + j], a = -__expf(F.in[I_ALOG][(size_t)l * 8 + j]);
      float e[2], dtv[2];
#pragma unroll
      for (int q = 0; q < 2; ++q) { const int li = 2 * lane + q, t = dir ? 127 - li : li;
          const float x = WSP(float, WS_DTRAW)[(size_t)(tok0 + t) * 8 + j] + bias; dtv[q] = x > 20.f ? x : log1pf(__expf(x)); e[q] = dtv[q] * a * LOG2E; }
      float s = e[0] + e[1];
#pragma unroll
      for (int o = 1; o < 64; o <<= 1) { const float tv = __shfl_up(s, o); if (lane >= o) s += tv; }
      const float c1 = s, c0 = s - e[1];
#pragma unroll
      for (int q = 0; q < 2; ++q) { const int li = 2 * lane + q, t = dir ? 127 - li : li; const float cv = q ? c1 : c0;
          DTL[j * 128 + t] = dtv[q]; CML[j * 128 + t] = cv;
          WSP(float, WS_DTV)[((size_t)c * 8 + j) * 128 + t] = dtv[q]; WSP(float, WS_CUM)[((size_t)c * 8 + j) * 128 + t] = cv; }
    }
    __syncthreads();
    for (int i = tid; i < 8 * 128; i += 512) { const int j = i >> 7; const float tot = CML[j * 128 + ((j >> 2) ? 0 : 127)]; WG[i] = DTL[i] * __builtin_amdgcn_exp2f(tot - CML[i]); }
    for (int i = tid; i < 256 * 16; i += 512) { const int ch = i >> 4, o = i & 15; *(u32x4*)(WSP(bf16_t, WS_XST) + ((size_t)c * 256 + ch) * 128 + 8 * o) = *(const LAS u32x4*)(XT + ch * SP + 8 * o); }
    __syncthreads();
    { const int j = F.wave, hh = j & 3, g = hh >> 1, r = lane & 31, h = lane >> 5;
      f32x16 acc[2][4];
#pragma unroll
      for (int a = 0; a < 2; ++a)
#pragma unroll
          for (int b = 0; b < 4; ++b) acc[a][b] = splat16(0.f);
#pragma unroll 1
      for (int ks = 0; ks < 8; ++ks) {
          const f32x4 w0 = *(const LAS f32x4*)(WG + j * 128 + ks * 16 + 8 * h), w1 = *(const LAS f32x4*)(WG + j * 128 + ks * 16 + 8 * h + 4);
          bf16x8 af[2], bfr[4];
#pragma unroll
          for (int a = 0; a < 2; ++a) { const u32x4 x = *(const LAS u32x4*)(XT + (hh * 64 + a * 32 + r) * SP + ks * 16 + 8 * h); u32x4 o;
              o[0] = pk2(bflo(x[0]) * w0[0], bfhi(x[0]) * w0[1]); o[1] = pk2(bflo(x[1]) * w0[2], bfhi(x[1]) * w0[3]);
              o[2] = pk2(bflo(x[2]) * w1[0], bfhi(x[2]) * w1[1]); o[3] = pk2(bflo(x[3]) * w1[2], bfhi(x[3]) * w1[3]); af[a] = __builtin_bit_cast(bf16x8, o); }
#pragma unroll
          for (int b = 0; b < 4; ++b) bfr[b] = *(const LAS bf16x8*)(BT + (g * 128 + b * 32 + r) * SP + ks * 16 + 8 * h);
#pragma unroll
          for (int a = 0; a < 2; ++a)
#pragma unroll
              for (int b = 0; b < 4; ++b) acc[a][b] = mfma32(af[a], bfr[b], acc[a][b]);
      }
      float* o = WSP(float, WS_SLOC) + ((size_t)c * 8 + j) * 64 * 128;
#pragma unroll
      for (int a = 0; a < 2; ++a)
#pragma unroll
          for (int b = 0; b < 4; ++b)
#pragma unroll
              for (int i = 0; i < 16; ++i) o[(a * 32 + crow(i, h)) * 128 + b * 32 + r] = acc[a][b][i];
    }
    __syncthreads();
}

DI void p4_ssd_scan(const Frame& F, int l) {
    if (F.tid >= 256) return;
    const int el = F.bid * 256 + F.tid; if (el >= 65536) return;
    const int j = el >> 13;
    const int dir = j >> 2;
    const float* cum = WSP(float, WS_CUM); const float* sl = WSP(float, WS_SLOC); bf16_t* so = WSP(bf16_t, WS_SIN);
    const int eo = el & 8191;
    float s = 0.f;
#pragma unroll 5
    for (int i = 0; i < NCH; ++i) { const int c = dir ? (i < 2 ? 1 - i : NCH + 1 - i) : i;
        so[((size_t)c * 8 + j) * 8192 + eo] = f2bf(s);
        const float tot = cum[((size_t)c * 8 + j) * 128 + (dir ? 0 : 127)];
        s = s * __builtin_amdgcn_exp2f(tot) + sl[((size_t)c * 8 + j) * 8192 + eo]; }
}
DI void p4_s5_scan(const Frame& F, int l) {
    const int st = F.bid * 512 + F.tid; if (st >= 2048) return;
    const int g = st >> 7, dir = (st >> 6) & 1, p = st & 63;
    const f32x2 ap = WSP(f32x2, WS_APOW)[((size_t)l * 16 + g) * 128 + dir * 64 + p];
    const float* hl = WSP(float, WS_HLOC) + (g * 2 + dir) * 128 + p; bf16_t* ho = WSP(bf16_t, WS_HIN) + (g * 2 + dir) * 128 + p;
    f32x2 s = {0.f, 0.f};
#pragma unroll 5
    for (int i = 0; i < NC5; ++i) { const int c = dir ? (i < 4 ? 3 - i : NC5 + 3 - i) : i;
        ho[(size_t)c * 4096] = f2bf(s.x); ho[(size_t)c * 4096 + 64] = f2bf(s.y);
        const f32x2 loc = {hl[(size_t)c * 4096], hl[(size_t)c * 4096 + 64]};
        s = cmul(s, ap) + loc; }
}

constexpr int AP = 144;
struct AttnOut { bf16_t* mix; int col0; float lam, outscale; const float* subw; };
template <bool DIFF>
DI void attn_item(const Frame& F, const bf16_t* Q, const bf16_t* K, const bf16_t* Vt, const float* qn0, const float* qn1, float km0, float km1,
                  int q0, int nkeys, const AttnOut& ao) {
    LAS unsigned char* KB = F.lds;
    LAS unsigned char* VB = F.lds + 2 * 64 * AP;
    const int tid = F.tid, lane = F.lane, r = lane & 31, h = lane >> 5;
    const int qrow = q0 + F.wave * 32 + r;
    bf16x8 qf[4];
#pragma unroll
    for (int j = 0; j < 4; ++j) qf[j] = ld8g(Q + (size_t)qrow * 64 + j * 16 + 8 * h);
    const float sh0 = -qn0[qrow] * km0, sh1 = DIFF ? -qn1[qrow] * km1 : 0.f;
    f32x16 O0[2], O1[2];
#pragma unroll
    for (int d = 0; d < 2; ++d) { O0[d] = splat16(0.f); O1[d] = splat16(0.f); }
    float l0 = 0.f, l1 = 0.f;
    const int srow = tid >> 3, sch = tid & 7;
    const bf16_t* kg = K + (size_t)srow * 64 + sch * 8; const bf16_t* vg = Vt + (size_t)srow * NT + sch * 8;
    const int ntile = nkeys >> 6;
    u32x4 kreg = *(const u32x4*)kg, vreg = *(const u32x4*)vg;
    __syncthreads();
    *(LAS u32x4*)(KB + srow * AP + sch * 16) = kreg; *(LAS u32x4*)(VB + srow * AP + sch * 16) = vreg;
    __syncthreads();
    const int krow = kperm(r);
#pragma clang loop unroll(disable)
    for (int t = 0; t < ntile; ++t) {
        const int buf = t & 1;
        if (t + 1 < ntile) { kreg = *(const u32x4*)(kg + (size_t)(t + 1) * 64 * 64); vreg = *(const u32x4*)(vg + (size_t)(t + 1) * 64); }
        const LAS unsigned char* kb = KB + buf * 64 * AP; const LAS unsigned char* vb = VB + buf * 64 * AP;
#pragma unroll
        for (int sub = 0; sub < 2; ++sub) {
            bf16x8 kf[4];
#pragma unroll
            for (int j = 0; j < 4; ++j) kf[j] = *(const LAS bf16x8*)(kb + (sub * 32 + krow) * AP + j * 32 + h * 16);
            bf16x8 vf[2][2];
#pragma unroll
            for (int d = 0; d < 2; ++d)
#pragma unroll
                for (int s = 0; s < 2; ++s) vf[d][s] = *(const LAS bf16x8*)(vb + (d * 32 + r) * AP + (sub * 32 + s * 16 + h * 8) * 2);
            {   f32x16 S = splat16(sh0);
                S = mfma32(kf[0], qf[0], S); S = mfma32(kf[1], qf[1], S);
                if (!DIFF) { S = mfma32(kf[2], qf[2], S); S = mfma32(kf[3], qf[3], S); }
#pragma unroll
                for (int i = 0; i < 16; ++i) { S[i] = __builtin_amdgcn_exp2f(S[i]); l0 += S[i]; }
                const bf16x8 p0 = pack_step<0>(S), p1 = pack_step<1>(S);
#pragma unroll
                for (int d = 0; d < 2; ++d) { O0[d] = mfma32(vf[d][0], p0, O0[d]); O0[d] = mfma32(vf[d][1], p1, O0[d]); } }
            if (DIFF) { f32x16 S = splat16(sh1);
                S = mfma32(kf[2], qf[2], S); S = mfma32(kf[3], qf[3], S);
#pragma unroll
                for (int i = 0; i < 16; ++i) { S[i] = __builtin_amdgcn_exp2f(S[i]); l1 += S[i]; }
                const bf16x8 p0 = pack_step<0>(S), p1 = pack_step<1>(S);
#pragma unroll
                for (int d = 0; d < 2; ++d) { O1[d] = mfma32(vf[d][0], p0, O1[d]); O1[d] = mfma32(vf[d][1], p1, O1[d]); } }
        }
        if (t + 1 < ntile) { *(LAS u32x4*)(KB + (buf ^ 1) * 64 * AP + srow * AP + sch * 16) = kreg; *(LAS u32x4*)(VB + (buf ^ 1) * 64 * AP + srow * AP + sch * 16) = vreg; }
        __syncthreads();
    }
    const float* subw = ao.subw; bf16_t* mixp = ao.mix;
    asm volatile("" : "+s"(subw)); asm volatile("" : "+s"(mixp));
    l0 += __shfl_xor(l0, 32); const float i0 = 1.f / l0;
    float i1 = 0.f; if (DIFF) { l1 += __shfl_xor(l1, 32); i1 = ao.lam / l1; }
    float ss = 0.f;
#pragma unroll
    for (int d = 0; d < 2; ++d)
#pragma unroll
        for (int i = 0; i < 16; ++i) { float v = O0[d][i] * i0; if (DIFF) v -= O1[d][i] * i1; O0[d][i] = v; ss += v * v; }
    float sc = 1.f;
    if (DIFF) { ss += __shfl_xor(ss, 32); sc = __builtin_amdgcn_rsqf(ss * (1.f / 64.f) + EPS) * ao.outscale; }
    bf16_t* orow = mixp + (size_t)qrow * DM + ao.col0;
#pragma unroll
    for (int d = 0; d < 2; ++d)
#pragma unroll
        for (int gq = 0; gq < 4; ++gq) { const int dd = d * 32 + 8 * gq + 4 * h; float o[4];
#pragma unroll
            for (int j = 0; j < 4; ++j) { o[j] = O0[d][4 * gq + j] * sc; if (DIFF) o[j] *= subw[dd + j]; }
            u32x2 w; w[0] = pk2(o[0], o[1]); w[1] = pk2(o[2], o[3]); *(u32x2*)(orow + dd) = w; }
}
DI void p4_attn_diff(const Frame& F, int l, int it) {
    const bool isctx = it >= 256; const int hd = isctx ? it - 256 : it & 3, qb = isctx ? 0 : it >> 2;
    const unsigned* km = WSP(unsigned, WS_CTL) + CW_KMAX + l * 16;
    const float km0 = sqrtf(__uint_as_float(__hip_atomic_load(km + hd * 2, __ATOMIC_RELAXED, __HIP_MEMORY_SCOPE_AGENT)));
    const float km1 = sqrtf(__uint_as_float(__hip_atomic_load(km + hd * 2 + 1, __ATOMIC_RELAXED, __HIP_MEMORY_SCOPE_AGENT)));
    const float lam_init = 0.8f - 0.6f * __expf(-0.3f * (float)l);
    AttnOut ao; ao.mix = WSP(bf16_t, WS_MIX); ao.col0 = hd * 64; ao.lam = WSP(float, WS_LAM)[l]; ao.outscale = 1.f - lam_init; ao.subw = F.in[I_SUBLN] + (size_t)l * 64;
    attn_item<true>(F, WSP(bf16_t, WS_QD) + (size_t)hd * NT * 64, WSP(bf16_t, WS_KD) + (size_t)hd * NT * 64, WSP(bf16_t, WS_VTD) + (size_t)hd * 64 * NT,
                    WSP(float, WS_QND) + (size_t)(hd * 2) * NT, WSP(float, WS_QND) + (size_t)(hd * 2 + 1) * NT, km0, km1, isctx ? 0 : CTX + qb * 256, isctx ? CTX : NT, ao);
}
DI void p4_attn_gqa(const Frame& F, int l, int it) {
    const bool isctx = it >= 256; const int hq = isctx ? it - 256 : it & 3, qb = isctx ? 0 : it >> 2, g = hq >> 1;
    const unsigned* km = WSP(unsigned, WS_CTL) + CW_KMAX + l * 16;
    const float km0 = sqrtf(__uint_as_float(__hip_atomic_load(km + 8 + g, __ATOMIC_RELAXED, __HIP_MEMORY_SCOPE_AGENT)));
    AttnOut ao; ao.mix = WSP(bf16_t, WS_MIX); ao.col0 = 768 + hq * 64; ao.lam = 0.f; ao.outscale = 1.f; ao.subw = nullptr;
    attn_item<false>(F, WSP(bf16_t, WS_QG) + (size_t)hq * NT * 64, WSP(bf16_t, WS_KG) + (size_t)g * NT * 64, WSP(bf16_t, WS_VTG) + (size_t)g * 64 * NT,
                     WSP(float, WS_QNG) + (size_t)hq * NT, nullptr, km0, 0.f, isctx ? 0 : CTX + qb * 256, isctx ? CTX : NT, ao);
}

DI void p4_ssd_out(const Frame& F, int l, int c) {
    LAS float* DTL = (LAS float*)(F.lds + 2 * 2 * 64 * AP);
    LAS float* CML = DTL + 8 * 128;
    const int tid = F.tid, lane = F.lane, r = lane & 31, h = lane >> 5, tok0 = c * 128;
    __syncthreads();
    for (int i = tid; i < 1024; i += 512) { DTL[i] = WSP(float, WS_DTV)[(size_t)c * 1024 + i]; CML[i] = WSP(float, WS_CUM)[(size_t)c * 1024 + i]; }
    __syncthreads();
    const int hh = F.wave >> 1, lh = F.wave & 1, g = hh >> 1;
    const float Dh = F.in[I_SSDD][(size_t)l * 4 + hh];
    const bf16_t* CN = WSP(bf16_t, WS_CN); const bf16_t* BN = WSP(bf16_t, WS_BN);
    const bf16_t* XS = WSP(bf16_t, WS_XST) + ((size_t)c * 256 + hh * 64) * 128;
#pragma unroll 1
    for (int lt = 0; lt < 2; ++lt) {
        const int ll = 64 * lh + 32 * lt + r;
        bf16x8 cfr[8];
#pragma unroll
        for (int ks = 0; ks < 8; ++ks) cfr[ks] = ld8g(CN + (size_t)(tok0 + ll) * 256 + g * 128 + ks * 16 + 8 * h);
        const float cfl = CML[hh * 128 + ll], cbl = CML[(4 + hh) * 128 + ll], dsum = DTL[hh * 128 + ll] + DTL[(4 + hh) * 128 + ll];
        f32x16 Y[2];
        Y[0] = splat16(0.f); Y[1] = splat16(0.f);
#pragma unroll 1
        for (int st = 0; st < 4; ++st) {
            f32x16 G = splat16(0.f);
#pragma unroll
            for (int ks = 0; ks < 8; ++ks) G = mfma32(ld8g(BN + (size_t)(tok0 + 32 * st + kperm(r)) * 256 + g * 128 + ks * 16 + 8 * h), cfr[ks], G);
#pragma unroll
            for (int i = 0; i < 16; ++i) { const int s = 32 * st + kperm(crow(i, h));
                const float cfs = CML[hh * 128 + s], cbs = CML[(4 + hh) * 128 + s], dfs = DTL[hh * 128 + s], dbs = DTL[(4 + hh) * 128 + s];
                float fac;
                if (s < ll) fac = dfs * __builtin_amdgcn_exp2f(cfl - cfs);
                else if (s > ll) fac = dbs * __builtin_amdgcn_exp2f(cbl - cbs);
                else fac = dsum;
                G[i] = G[i] * fac + (s == ll ? Dh : 0.f); }
            const bf16x8 m0 = pack_step<0>(G), m1 = pack_step<1>(G);
#pragma unroll
            for (int pt = 0; pt < 2; ++pt) {
                Y[pt] = mfma32(ld8g(XS + (size_t)(pt * 32 + r) * 128 + 32 * st + 8 * h), m0, Y[pt]);
                Y[pt] = mfma32(ld8g(XS + (size_t)(pt * 32 + r) * 128 + 32 * st + 16 + 8 * h), m1, Y[pt]); }
        }
#pragma unroll
        for (int dir = 0; dir < 2; ++dir) {
            const bf16_t* S = WSP(bf16_t, WS_SIN) + ((size_t)c * 8 + dir * 4 + hh) * 8192;
            const float e = __builtin_amdgcn_exp2f(dir ? cbl : cfl);
#pragma unroll
            for (int pt = 0; pt < 2; ++pt) { f32x16 Z = splat16(0.f);
#pragma unroll
                for (int ks = 0; ks < 8; ++ks) Z = mfma32(ld8g(S + (size_t)(pt * 32 + r) * 128 + ks * 16 + 8 * h), cfr[ks], Z);
                Y[pt] += Z * e; }
        }
        const int tok = tok0 + ll; float ssq = 0.f;
        const bf16_t* zr = WSP(bf16_t, WS_U) + (size_t)tok * NU + U_Z + hh * 64; bf16_t* yo = WSP(bf16_t, WS_YSSD) + (size_t)tok * 256 + hh * 64;
#pragma unroll
        for (int pt = 0; pt < 2; ++pt)
#pragma unroll
            for (int gq = 0; gq < 4; ++gq) { const int p = pt * 32 + 8 * gq + 4 * h; const u32x2 zz = *(const u32x2*)(zr + p);
                const float z0 = bflo(zz[0]), z1 = bfhi(zz[0]), z2 = bflo(zz[1]), z3 = bfhi(zz[1]);
                const float y0 = Y[pt][4 * gq] * silu_f(z0), y1 = Y[pt][4 * gq + 1] * silu_f(z1), y2 = Y[pt][4 * gq + 2] * silu_f(z2), y3 = Y[pt][4 * gq + 3] * silu_f(z3);
                ssq += y0 * y0 + y1 * y1 + y2 * y2 + y3 * y3;
                u32x2 w; w[0] = pk2(y0, y1); w[1] = pk2(y2, y3); *(u32x2*)(yo + p) = w; }
        ssq += __shfl_xor(ssq, 32);
        if (h == 0) WSP(float, WS_SSQ)[(size_t)tok * 4 + hh] = ssq;
    }
}

constexpr int N_S5O = 16 * 32 * 9 / 8;
DI float gelu_tanh(float y) { const float u = 0.7978845608028654f * (y + 0.044715f * y * y * y); const float e = __expf(2.f * u); return 0.5f * y * (2.f - 2.f / (1.f + e)); }
DI void p4_s5_out(const Frame& F, int l, int item) {
    const int wt = item * 8 + F.wave, nt = wt % 9, mt = (wt / 9) & 31, g = wt / 288, lane = F.lane, r = lane & 31, h = lane >> 5;
    const int row = mt * 32 + r, t = row >> 4, ch = row & 15;
    const bf16_t* KT = WSP(bf16_t, WS_KTAB) + ((size_t)l * 16 + g) * 3 * 64 * 256 + ch * 16 + 8 * h;
    const int chunk = nt * 32 + r, cc = chunk < NC5 ? chunk : NC5 - 1;
    const bf16_t* Ub = WSP(bf16_t, WS_U) + (size_t)cc * S5L * NU + U_S5 + g * 16 + 8 * h;
    f32x16 acc = splat16(0.f);
#pragma unroll 8
    for (int s = 0; s < 64; ++s) { const int sel = s < t ? 0 : (s > t ? 1 : 2), lag = s < t ? t - s : (s > t ? s - t : 0);
        acc = mfma32(ld8g(KT + (size_t)(sel * 64 + lag) * 256), ld8g(Ub + (size_t)s * NU), acc); }
    const bf16_t* CC = WSP(bf16_t, WS_CC5) + (((size_t)l * 16 + g) * 1024 + row) * 256 + 8 * h;
    const bf16_t* HI = WSP(bf16_t, WS_HIN) + (size_t)cc * 4096 + g * 256 + 8 * h;
#pragma unroll
    for (int kc = 0; kc < 16; ++kc) acc = mfma32(ld8g(CC + kc * 16), ld8g(HI + kc * 16), acc);
    if (chunk < NC5) {
#pragma unroll
        for (int gq = 0; gq < 4; ++gq) { const int rr = mt * 32 + 8 * gq + 4 * h, tt = rr >> 4, c0 = rr & 15;
            u32x2 w; w[0] = pk2(gelu_tanh(acc[4 * gq]), gelu_tanh(acc[4 * gq + 1])); w[1] = pk2(gelu_tanh(acc[4 * gq + 2]), gelu_tanh(acc[4 * gq + 3]));
            *(u32x2*)(WSP(bf16_t, WS_YS5) + (size_t)(chunk * S5L + tt) * 256 + g * 16 + c0) = w; } }
}

DI void p5_finish(const Frame& F, int l) {
    const int lane = F.lane;
    for (int r = F.wave; r < RPB; r += 8) { const int row = F.bid * RPB + r; if (row >= NT) break;
        const f32x4 q = *(const f32x4*)(WSP(float, WS_SSQ) + (size_t)row * 4); const float rs = __builtin_amdgcn_rsqf((q[0] + q[1] + q[2] + q[3]) * (1.f / 256.f) + EPS);
        const u32x2 y = *(const u32x2*)(WSP(bf16_t, WS_YSSD) + (size_t)row * 256 + 4 * lane); const f32x4 nw = *(const f32x4*)(F.in[I_SSDNW] + (size_t)l * 256 + 4 * lane);
        u32x2 w; w[0] = pk2(bflo(y[0]) * rs * nw[0], bfhi(y[0]) * rs * nw[1]); w[1] = pk2(bflo(y[1]) * rs * nw[2], bfhi(y[1]) * rs * nw[3]);
        *(u32x2*)(WSP(bf16_t, WS_MIX) + (size_t)row * DM + 256 + 4 * lane) = w; }
    const int r = lane & 31, h = lane >> 5;
    const bf16_t* WG = WSP(bf16_t, WS_WGLU) + (size_t)l * 65536;
    for (int mt = F.bid * 8 + F.wave; mt < NT / 32; mt += F.G * 8) {
        const bf16_t* Y = WSP(bf16_t, WS_YS5) + (size_t)(mt * 32) * 256;
        bf16x8 af[16];
#pragma unroll
        for (int ks = 0; ks < 16; ++ks) af[ks] = ld8g(Y + (size_t)r * 256 + ks * 16 + 8 * h);
        for (int nt = 0; nt < 8; ++nt) { f32x16 acc = splat16(0.f);
#pragma unroll
            for (int ks = 0; ks < 16; ++ks) acc = mfma32(af[ks], ld8g(WG + (size_t)(nt * 32 + r) * 256 + ks * 16 + 8 * h), acc);
            const int n = nt * 32 + r; const float b = F.in[I_BGLU][(size_t)l * 256 + n];
#pragma unroll
            for (int i = 0; i < 16; ++i) { const int tok = mt * 32 + crow(i, h); const float yv = bf2f(Y[(size_t)crow(i, h) * 256 + n]);
                WSP(bf16_t, WS_MIX)[(size_t)tok * DM + 512 + n] = f2bf(yv * sigmoid_f(acc[i] + b)); } }
    }
    __syncthreads();
}

#ifndef PH_MASK
#define PH_MASK 0xFFFF
#endif
#define PHEN(k) ((PH_MASK >> (k)) & 1)
DI Frame launder(const Frame& F) { Frame G = F; int t = F.wave * 64 + (int)__builtin_amdgcn_mbcnt_hi(~0u, __builtin_amdgcn_mbcnt_lo(~0u, 0u)); unsigned char* w = F.ws; const float* const __attribute__((address_space(4)))* ip = F.in;
    int bb = F.bid, gg = F.G; LAS unsigned char* lp = F.lds; asm volatile("" : "+s"(lp)); G.lds = lp; asm volatile("" : "+v"(t)); asm volatile("" : "+s"(w)); asm volatile("" : "+s"(ip)); asm volatile("" : "+s"(bb)); asm volatile("" : "+s"(gg)); G.bid = bb; G.G = gg; G.tid = t; G.lane = t & 63; G.ws = w; G.in = ip; return G; }
DI int launder_s(int v) { asm volatile("" : "+s"(v)); return v; }
constexpr int NPL = 11, N_PHASES = 1 + DEPTH * NPL + 1;
__global__ void __launch_bounds__(512, 2) hybrid_fwd(Args args) {
    extern __shared__ __attribute__((aligned(16))) unsigned char lds_raw[];
    Frame F; F.lds = (LAS unsigned char*)lds_raw; F.in = (const float* const __attribute__((address_space(4)))*)__builtin_amdgcn_kernarg_segment_ptr(); F.ws = args.ws; F.out = args.out;
    F.tid = threadIdx.x; F.lane = F.tid & 63; F.wave = __builtin_amdgcn_readfirstlane(F.tid >> 6); F.G = gridDim.x; F.bid = blockIdx.x;
    const int lo = args.ph_lo, hi = args.ph_hi;
    volatile LAS unsigned* xbw = (volatile LAS unsigned*)(F.lds + LDS_BYTES - 64);
    if (F.tid == 0) { xbw[0] = 0u; xbw[1] = 0u; }
    __syncthreads();
    XcdBarrier bar; bar.bar = WSP(unsigned, WS_CTL) + CW_BAR; bar.x = 0; bar.st = xbw;
    if (hi - lo > 1) bar = xcd_barrier_post(WSP(unsigned, WS_CTL) + CW_BAR, xbw);
#define IN(k) (lo <= (k) && (k) < hi)
#define SEAM(k) do { if (IN(k) && IN((k) + 1)) xcd_barrier(bar); } while (0)
#define WSQ(T, off) ((T*)(Fq.ws + (off)))
#define LAUNDERED for (Frame Fq = launder(F), *once_ = &Fq; once_; once_ = nullptr) for (int lq = launder_s(l_cur), once2_ = 1; once2_; once2_ = 0)
    int ph = 0, l_cur = 0;
    if (PHEN(0) && IN(ph)) LAUNDERED { (void)lq; p0_prologue(Fq); }
    SEAM(ph); ++ph;
    { l_cur = 0;
        if (PHEN(1) && IN(ph)) LAUNDERED p1_norm<false>(Fq, lq);
        SEAM(ph); ++ph;
        if (PHEN(2) && IN(ph)) LAUNDERED { pg8::Gemm gm{WSQ(pg8::bf16_t, WS_H), WSQ(pg8::bf16_t, WS_WIN) + (size_t)lq * NU * DM, NT, NU, DM}; pg8::StaticOrder S; S.init(NT, NU, Fq.G, Fq.bid);
            EpiU E{WSQ(bf16_t, WS_U), NU}; pg8::gemm_phase<EpiU, pg8::StaticOrder>((PG8_LAS unsigned char*)Fq.lds, gm, S, E); }
        SEAM(ph); ++ph;
        if (PHEN(3) && IN(ph)) LAUNDERED {
            for (int idx = Fq.bid; idx < NCH + 260 + N_S5H / 8; idx += Fq.G) { const Frame Fi = launder(Fq);
                if (idx < NCH) p3_ssd_prep(Fi, lq, idx);
                else if (idx < NCH + 260) p3_attn_prep(Fi, lq, idx - NCH);
                else p3_s5_hloc(Fi, lq, (idx - NCH - 260) * 8 + Fi.wave);
            }
        }
        SEAM(ph); ++ph;
        if (PHEN(4) && IN(ph)) LAUNDERED { p4_ssd_scan(Fq, lq); p4_s5_scan(Fq, lq);
            for (int it = Fq.bid; it < 260; it += Fq.G) { const Frame Fi = launder(Fq); p4_attn_diff(Fi, lq, it); } }
        SEAM(ph); ++ph;
        if (PHEN(5) && IN(ph)) LAUNDERED {
            for (int it = Fq.bid; it < 260; it += Fq.G) { const Frame Fi = launder(Fq); p4_attn_gqa(Fi, lq, it); }
            for (int c = Fq.bid; c < NCH; c += Fq.G) { const Frame Fi = launder(Fq); p4_ssd_out(Fi, lq, c); }
            for (int it = Fq.bid; it < N_S5O; it += Fq.G) { const Frame Fi = launder(Fq); p4_s5_out(Fi, lq, it); }
        }
        SEAM(ph); ++ph;
        if (PHEN(6) && IN(ph)) LAUNDERED p5_finish(Fq, lq);
        SEAM(ph); ++ph;
        if (PHEN(7) && IN(ph)) LAUNDERED { pg8::Gemm gm{WSQ(pg8::bf16_t, WS_MIX), WSQ(pg8::bf16_t, WS_WOUT) + (size_t)lq * DM * DM, NT, DM, DM}; pg8::StaticOrder S; S.init(NT, DM, Fq.G, Fq.bid);
            EpiRes E; E.C = WSQ(float, WS_XA); E.g1 = WSQ(float, WS_MOD) + (size_t)lq * 2 * 6144 + 2 * 1024;
            if (lq == 0) { E.res_ctx = Fq.in[I_CTX]; E.res_lat = Fq.in[I_X]; } else { E.res_ctx = WSQ(float, WS_XB); E.res_lat = WSQ(float, WS_XB) + (size_t)CTX * DM; }
            pg8::gemm_phase<EpiRes, pg8::StaticOrder>((PG8_LAS unsigned char*)Fq.lds, gm, S, E); }
        SEAM(ph); ++ph;
        if (PHEN(8) && IN(ph)) LAUNDERED p7a_router(Fq, lq);
        SEAM(ph); ++ph;
        if (PHEN(9) && IN(ph)) LAUNDERED p7b_scatter(Fq, lq);
        SEAM(ph); ++ph;
        if (PHEN(10) && IN(ph)) LAUNDERED { const int ntiles = moe_tables(Fq, lq); const LAS int* t2e = (const LAS int*)(Fq.lds + LDS_MISC) + 64;
            pg8::Gemm gm{WSQ(pg8::bf16_t, WS_ASLOT), WSQ(pg8::bf16_t, WS_WGU) + (size_t)lq * NEXP * 2048 * DM, CAP, 2048, DM};
            MoeOrder S{8, ntiles, Fq.G, Fq.bid, t2e, (long)2048 * DM * 2};
            EpiAct E{WSQ(bf16_t, WS_ACT), Fq.in[I_BGU] + (size_t)lq * NEXP * 2048, t2e};
            pg8::gemm_phase<EpiAct, MoeOrder>((PG8_LAS unsigned char*)Fq.lds, gm, S, E); }
        SEAM(ph); ++ph;
        if (PHEN(11) && IN(ph)) LAUNDERED { const int ntiles = moe_tables(Fq, lq); const LAS int* t2e = (const LAS int*)(Fq.lds + LDS_MISC) + 64;
            pg8::Gemm gm{WSQ(pg8::bf16_t, WS_ACT), WSQ(pg8::bf16_t, WS_WDN) + (size_t)lq * NEXP * DM * DM, CAP, DM, DM};
            MoeOrder S{4, ntiles, Fq.G, Fq.bid, t2e, (long)DM * DM * 2};
            EpiDown E{WSQ(bf16_t, WS_YB), Fq.in[I_BDN] + (size_t)lq * NEXP * DM, t2e};
            pg8::gemm_phase<EpiDown, MoeOrder>((PG8_LAS unsigned char*)Fq.lds, gm, S, E); }
        SEAM(ph); ++ph;
    }
    { l_cur = 1;
        if (PHEN(1) && IN(ph)) LAUNDERED p1_norm<false>(Fq, lq);
        SEAM(ph); ++ph;
        if (PHEN(2) && IN(ph)) LAUNDERED { pg8::Gemm gm{WSQ(pg8::bf16_t, WS_H), WSQ(pg8::bf16_t, WS_WIN) + (size_t)lq * NU * DM, NT, NU, DM}; pg8::StaticOrder S; S.init(NT, NU, Fq.G, Fq.bid);
            EpiU E{WSQ(bf16_t, WS_U), NU}; pg8::gemm_phase<EpiU, pg8::StaticOrder>((PG8_LAS unsigned char*)Fq.lds, gm, S, E); }
        SEAM(ph); ++ph;
        if (PHEN(3) && IN(ph)) LAUNDERED {
            for (int idx = Fq.bid; idx < NCH + 260 + N_S5H / 8; idx += Fq.G) { const Frame Fi = launder(Fq);
                if (idx < NCH) p3_ssd_prep(Fi, lq, idx);
                else if (idx < NCH + 260) p3_attn_prep(Fi, lq, idx - NCH);
                else p3_s5_hloc(Fi, lq, (idx - NCH - 260) * 8 + Fi.wave);
            }
        }
        SEAM(ph); ++ph;
        if (PHEN(4) && IN(ph)) LAUNDERED { p4_ssd_scan(Fq, lq); p4_s5_scan(Fq, lq);
            for (int it = Fq.bid; it < 260; it += Fq.G) { const Frame Fi = launder(Fq); p4_attn_diff(Fi, lq, it); } }
        SEAM(ph); ++ph;
        if (PHEN(5) && IN(ph)) LAUNDERED {
            for (int it = Fq.bid; it < 260; it += Fq.G) { const Frame Fi = launder(Fq); p4_attn_gqa(Fi, lq, it); }
            for (int c = Fq.bid; c < NCH; c += Fq.G) { const Frame Fi = launder(Fq); p4_ssd_out(Fi, lq, c); }
            for (int it = Fq.bid; it < N_S5O; it += Fq.G) { const Frame Fi = launder(Fq); p4_s5_out(Fi, lq, it); }
        }
        SEAM(ph); ++ph;
        if (PHEN(6) && IN(ph)) LAUNDERED p5_finish(Fq, lq);
        SEAM(ph); ++ph;
        if (PHEN(7) && IN(ph)) LAUNDERED { pg8::Gemm gm{WSQ(pg8::bf16_t, WS_MIX), WSQ(pg8::bf16_t, WS_WOUT) + (size_t)lq * DM * DM, NT, DM, DM}; pg8::StaticOrder S; S.init(NT, DM, Fq.G, Fq.bid);
            EpiRes E; E.C = WSQ(float, WS_XA); E.g1 = WSQ(float, WS_MOD) + (size_t)lq * 2 * 6144 + 2 * 1024;
            if (lq == 0) { E.res_ctx = Fq.in[I_CTX]; E.res_lat = Fq.in[I_X]; } else { E.res_ctx = WSQ(float, WS_XB); E.res_lat = WSQ(float, WS_XB) + (size_t)CTX * DM; }
            pg8::gemm_phase<EpiRes, pg8::StaticOrder>((PG8_LAS unsigned char*)Fq.lds, gm, S, E); }
        SEAM(ph); ++ph;
        if (PHEN(8) && IN(ph)) LAUNDERED p7a_router(Fq, lq);
        SEAM(ph); ++ph;
        if (PHEN(9) && IN(ph)) LAUNDERED p7b_scatter(Fq, lq);
        SEAM(ph); ++ph;
        if (PHEN(10) && IN(ph)) LAUNDERED { const int ntiles = moe_tables(Fq, lq); const LAS int* t2e = (const LAS int*)(Fq.lds + LDS_MISC) + 64;
            pg8::Gemm gm{WSQ(pg8::bf16_t, WS_ASLOT), WSQ(pg8::bf16_t, WS_WGU) + (size_t)lq * NEXP * 2048 * DM, CAP, 2048, DM};
            MoeOrder S{8, ntiles, Fq.G, Fq.bid, t2e, (long)2048 * DM * 2};
            EpiAct E{WSQ(bf16_t, WS_ACT), Fq.in[I_BGU] + (size_t)lq * NEXP * 2048, t2e};
            pg8::gemm_phase<EpiAct, MoeOrder>((PG8_LAS unsigned char*)Fq.lds, gm, S, E); }
        SEAM(ph); ++ph;
        if (PHEN(11) && IN(ph)) LAUNDERED { const int ntiles = moe_tables(Fq, lq); const LAS int* t2e = (const LAS int*)(Fq.lds + LDS_MISC) + 64;
            pg8::Gemm gm{WSQ(pg8::bf16_t, WS_ACT), WSQ(pg8::bf16_t, WS_WDN) + (size_t)lq * NEXP * DM * DM, CAP, DM, DM};
            MoeOrder S{4, ntiles, Fq.G, Fq.bid, t2e, (long)DM * DM * 2};
            EpiDown E{WSQ(bf16_t, WS_YB), Fq.in[I_BDN] + (size_t)lq * NEXP * DM, t2e};
            pg8::gemm_phase<EpiDown, MoeOrder>((PG8_LAS unsigned char*)Fq.lds, gm, S, E); }
        SEAM(ph); ++ph;
    }
    { l_cur = 2;
        if (PHEN(1) && IN(ph)) LAUNDERED p1_norm<false>(Fq, lq);
        SEAM(ph); ++ph;
        if (PHEN(2) && IN(ph)) LAUNDERED { pg8::Gemm gm{WSQ(pg8::bf16_t, WS_H), WSQ(pg8::bf16_t, WS_WIN) + (size_t)lq * NU * DM, NT, NU, DM}; pg8::StaticOrder S; S.init(NT, NU, Fq.G, Fq.bid);
            EpiU E{WSQ(bf16_t, WS_U), NU}; pg8::gemm_phase<EpiU, pg8::StaticOrder>((PG8_LAS unsigned char*)Fq.lds, gm, S, E); }
        SEAM(ph); ++ph;
        if (PHEN(3) && IN(ph)) LAUNDERED {
            for (int idx = Fq.bid; idx < NCH + 260 + N_S5H / 8; idx += Fq.G) { const Frame Fi = launder(Fq);
                if (idx < NCH) p3_ssd_prep(Fi, lq, idx);
                else if (idx < NCH + 260) p3_attn_prep(Fi, lq, idx - NCH);
                else p3_s5_hloc(Fi, lq, (idx - NCH - 260) * 8 + Fi.wave);
            }
        }
        SEAM(ph); ++ph;
        if (PHEN(4) && IN(ph)) LAUNDERED { p4_ssd_scan(Fq, lq); p4_s5_scan(Fq, lq);
            for (int it = Fq.bid; it < 260; it += Fq.G) { const Frame Fi = launder(Fq); p4_attn_diff(Fi, lq, it); } }
        SEAM(ph); ++ph;
        if (PHEN(5) && IN(ph)) LAUNDERED {
            for (int it = Fq.bid; it < 260; it += Fq.G) { const Frame Fi = launder(Fq); p4_attn_gqa(Fi, lq, it); }
            for (int c = Fq.bid; c < NCH; c += Fq.G) { const Frame Fi = launder(Fq); p4_ssd_out(Fi, lq, c); }
            for (int it = Fq.bid; it < N_S5O; it += Fq.G) { const Frame Fi = launder(Fq); p4_s5_out(Fi, lq, it); }
        }
        SEAM(ph); ++ph;
        if (PHEN(6) && IN(ph)) LAUNDERED p5_finish(Fq, lq);
        SEAM(ph); ++ph;
        if (PHEN(7) && IN(ph)) LAUNDERED { pg8::Gemm gm{WSQ(pg8::bf16_t, WS_MIX), WSQ(pg8::bf16_t, WS_WOUT) + (size_t)lq * DM * DM, NT, DM, DM}; pg8::StaticOrder S; S.init(NT, DM, Fq.G, Fq.bid);
            EpiRes E; E.C = WSQ(float, WS_XA); E.g1 = WSQ(float, WS_MOD) + (size_t)lq * 2 * 6144 + 2 * 1024;
            if (lq == 0) { E.res_ctx = Fq.in[I_CTX]; E.res_lat = Fq.in[I_X]; } else { E.res_ctx = WSQ(float, WS_XB); E.res_lat = WSQ(float, WS_XB) + (size_t)CTX * DM; }
            pg8::gemm_phase<EpiRes, pg8::StaticOrder>((PG8_LAS unsigned char*)Fq.lds, gm, S, E); }
        SEAM(ph); ++ph;
        if (PHEN(8) && IN(ph)) LAUNDERED p7a_router(Fq, lq);
        SEAM(ph); ++ph;
        if (PHEN(9) && IN(ph)) LAUNDERED p7b_scatter(Fq, lq);
        SEAM(ph); ++ph;
        if (PHEN(10) && IN(ph)) LAUNDERED { const int ntiles = moe_tables(Fq, lq); const LAS int* t2e = (const LAS int*)(Fq.lds + LDS_MISC) + 64;
            pg8::Gemm gm{WSQ(pg8::bf16_t, WS_ASLOT), WSQ(pg8::bf16_t, WS_WGU) + (size_t)lq * NEXP * 2048 * DM, CAP, 2048, DM};
            MoeOrder S{8, ntiles, Fq.G, Fq.bid, t2e, (long)2048 * DM * 2};
            EpiAct E{WSQ(bf16_t, WS_ACT), Fq.in[I_BGU] + (size_t)lq * NEXP * 2048, t2e};
            pg8::gemm_phase<EpiAct, MoeOrder>((PG8_LAS unsigned char*)Fq.lds, gm, S, E); }
        SEAM(ph); ++ph;
        if (PHEN(11) && IN(ph)) LAUNDERED { const int ntiles = moe_tables(Fq, lq); const LAS int* t2e = (const LAS int*)(Fq.lds + LDS_MISC) + 64;
            pg8::Gemm gm{WSQ(pg8::bf16_t, WS_ACT), WSQ(pg8::bf16_t, WS_WDN) + (size_t)lq * NEXP * DM * DM, CAP, DM, DM};
            MoeOrder S{4, ntiles, Fq.G, Fq.bid, t2e, (long)DM * DM * 2};
            EpiDown E{WSQ(bf16_t, WS_YB), Fq.in[I_BDN] + (size_t)lq * NEXP * DM, t2e};
            pg8::gemm_phase<EpiDown, MoeOrder>((PG8_LAS unsigned char*)Fq.lds, gm, S, E); }
        SEAM(ph); ++ph;
    }
    { l_cur = 3;
        if (PHEN(1) && IN(ph)) LAUNDERED p1_norm<false>(Fq, lq);
        SEAM(ph); ++ph;
        if (PHEN(2) && IN(ph)) LAUNDERED { pg8::Gemm gm{WSQ(pg8::bf16_t, WS_H), WSQ(pg8::bf16_t, WS_WIN) + (size_t)lq * NU * DM, NT, NU, DM}; pg8::StaticOrder S; S.init(NT, NU, Fq.G, Fq.bid);
            EpiU E{WSQ(bf16_t, WS_U), NU}; pg8::gemm_phase<EpiU, pg8::StaticOrder>((PG8_LAS unsigned char*)Fq.lds, gm, S, E); }
        SEAM(ph); ++ph;
        if (PHEN(3) && IN(ph)) LAUNDERED {
            for (int idx = Fq.bid; idx < NCH + 260 + N_S5H / 8; idx += Fq.G) { const Frame Fi = launder(Fq);
                if (idx < NCH) p3_ssd_prep(Fi, lq, idx);
                else if (idx < NCH + 260) p3_attn_prep(Fi, lq, idx - NCH);
                else p3_s5_hloc(Fi, lq, (idx - NCH - 260) * 8 + Fi.wave);
            }
        }
        SEAM(ph); ++ph;
        if (PHEN(4) && IN(ph)) LAUNDERED { p4_ssd_scan(Fq, lq); p4_s5_scan(Fq, lq);
            for (int it = Fq.bid; it < 260; it += Fq.G) { const Frame Fi = launder(Fq); p4_attn_diff(Fi, lq, it); } }
        SEAM(ph); ++ph;
        if (PHEN(5) && IN(ph)) LAUNDERED {
            for (int it = Fq.bid; it < 260; it += Fq.G) { const Frame Fi = launder(Fq); p4_attn_gqa(Fi, lq, it); }
            for (int c = Fq.bid; c < NCH; c += Fq.G) { const Frame Fi = launder(Fq); p4_ssd_out(Fi, lq, c); }
            for (int it = Fq.bid; it < N_S5O; it += Fq.G) { const Frame Fi = launder(Fq); p4_s5_out(Fi, lq, it); }
        }
        SEAM(ph); ++ph;
        if (PHEN(6) && IN(ph)) LAUNDERED p5_finish(Fq, lq);
        SEAM(ph); ++ph;
        if (PHEN(7) && IN(ph)) LAUNDERED { pg8::Gemm gm{WSQ(pg8::bf16_t, WS_MIX), WSQ(pg8::bf16_t, WS_WOUT) + (size_t)lq * DM * DM, NT, DM, DM}; pg8::StaticOrder S; S.init(NT, DM, Fq.G, Fq.bid);
            EpiRes E; E.C = WSQ(float, WS_XA); E.g1 = WSQ(float, WS_MOD) + (size_t)lq * 2 * 6144 + 2 * 1024;
            if (lq == 0) { E.res_ctx = Fq.in[I_CTX]; E.res_lat = Fq.in[I_X]; } else { E.res_ctx = WSQ(float, WS_XB); E.res_lat = WSQ(float, WS_XB) + (size_t)CTX * DM; }
            pg8::gemm_phase<EpiRes, pg8::StaticOrder>((PG8_LAS unsigned char*)Fq.lds, gm, S, E); }
        SEAM(ph); ++ph;
        if (PHEN(8) && IN(ph)) LAUNDERED p7a_router(Fq, lq);
        SEAM(ph); ++ph;
        if (PHEN(9) && IN(ph)) LAUNDERED p7b_scatter(Fq, lq);
        SEAM(ph); ++ph;
        if (PHEN(10) && IN(ph)) LAUNDERED { const int ntiles = moe_tables(Fq, lq); const LAS int* t2e = (const LAS int*)(Fq.lds + LDS_MISC) + 64;
            pg8::Gemm gm{WSQ(pg8::bf16_t, WS_ASLOT), WSQ(pg8::bf16_t, WS_WGU) + (size_t)lq * NEXP * 2048 * DM, CAP, 2048, DM};
            MoeOrder S{8, ntiles, Fq.G, Fq.bid, t2e, (long)2048 * DM * 2};
            EpiAct E{WSQ(bf16_t, WS_ACT), Fq.in[I_BGU] + (size_t)lq * NEXP * 2048, t2e};
            pg8::gemm_phase<EpiAct, MoeOrder>((PG8_LAS unsigned char*)Fq.lds, gm, S, E); }
        SEAM(ph); ++ph;
        if (PHEN(11) && IN(ph)) LAUNDERED { const int ntiles = moe_tables(Fq, lq); const LAS int* t2e = (const LAS int*)(Fq.lds + LDS_MISC) + 64;
            pg8::Gemm gm{WSQ(pg8::bf16_t, WS_ACT), WSQ(pg8::bf16_t, WS_WDN) + (size_t)lq * NEXP * DM * DM, CAP, DM, DM};
            MoeOrder S{4, ntiles, Fq.G, Fq.bid, t2e, (long)DM * DM * 2};
            EpiDown E{WSQ(bf16_t, WS_YB), Fq.in[I_BDN] + (size_t)lq * NEXP * DM, t2e};
            pg8::gemm_phase<EpiDown, MoeOrder>((PG8_LAS unsigned char*)Fq.lds, gm, S, E); }
        SEAM(ph); ++ph;
    }
    if (PHEN(12) && IN(ph)) LAUNDERED { (void)lq; p1_norm<true>(Fq, DEPTH); }
#undef IN
#undef SEAM
}

#ifndef N_LAUNCH_MODE
#define N_LAUNCH_MODE 1
#endif
extern "C" void kernel_launch(void* const* d_in, const int* in_sizes, int n_in, void* d_out, int out_size, void* d_ws, size_t ws_size, hipStream_t stream) {
    static int grid = 0;
    if (grid == 0) {
        if (n_in != N_IN || out_size != SEQ * DM || ws_size < WS_END) { fprintf(stderr, "kernel_launch: unexpected shapes (n_in %d, out %d, ws %zu < %zu)\n", n_in, out_size, ws_size, (size_t)WS_END); grid = -1; return; }
        int dev = 0, cus = 0, per_cu = 0;
        if (hipGetDevice(&dev) != hipSuccess || hipDeviceGetAttribute(&cus, hipDeviceAttributeMultiprocessorCount, dev) != hipSuccess) { grid = -1; return; }
        if (hipFuncSetAttribute((const void*)hybrid_fwd, hipFuncAttributeMaxDynamicSharedMemorySize, LDS_BYTES) != hipSuccess) { fprintf(stderr, "kernel_launch: hipFuncSetAttribute failed\n"); grid = -1; return; }
        if (hipOccupancyMaxActiveBlocksPerMultiprocessor(&per_cu, (const void*)hybrid_fwd, 512, LDS_BYTES) != hipSuccess || per_cu < 1) { fprintf(stderr, "kernel_launch: occupancy query says %d\n", per_cu); }
        (void)hipGetLastError();
        grid = cus;
    }
    if (grid < 0) return;
    (void)hipMemsetAsync((char*)d_ws + WS_CTL, 0, CTL_BYTES, stream);
    Args a{};
    for (int i = 0; i < N_IN; ++i) a.in[i] = (const float*)d_in[i];
    a.out = (float*)d_out; a.ws = (unsigned char*)d_ws;
#if N_LAUNCH_MODE == 1
    a.ph_lo = 0; a.ph_hi = N_PHASES;
    hipLaunchKernelGGL(hybrid_fwd, dim3(grid), dim3(512), LDS_BYTES, stream, a);
#else
    for (int p = 0; p < N_PHASES; ++p) { a.ph_lo = p; a.ph_hi = p + 1; hipLaunchKernelGGL(hybrid_fwd, dim3(grid), dim3(512), LDS_BYTES, stream, a); }
#endif
}
```

```cpp
#include <hip/hip_runtime.h>
#include <cstdio>
#include <cstdint>

#define DI __device__ __forceinline__
typedef float f32x2 __attribute__((ext_vector_type(2)));
typedef float f32x16 __attribute__((ext_vector_type(16)));
typedef unsigned u32x2 __attribute__((ext_vector_type(2)));
typedef __bf16 hbf2 __attribute__((ext_vector_type(2)));

constexpr int DM = 1024, SEQ = 16384, CTX = 256, NT = SEQ + CTX, DEPTH = 4;
constexpr int DIN = 2568, NU = 2560;
constexpr int DT_COL = 1792;
constexpr int NEXP = 32, TOPK = 4;
constexpr int CAP = 292 * 256;
constexpr float EPS = 1e-6f;
constexpr float LOG2E = 1.4426950408889634f;
constexpr int NCH = NT / 128;
constexpr int S5L = 64, NC5 = NT / S5L;
constexpr int U_DQ = 0, U_DK = 256, U_DV = 512, U_Z = 768, U_XS = 1024, U_B = 1280, U_C = 1536, U_S5 = 1792, U_GQ = 2048, U_GK = 2304, U_GV = 2432;

enum { I_X = 0, I_C, I_CTX, I_CCTX, I_WADA, I_BADA, I_N1W, I_N2W, I_WIN, I_WOUT, I_LQ1, I_LK1, I_LQ2, I_LK2, I_SUBLN,
       I_CONVW, I_CONVB, I_DTB, I_ALOG, I_SSDD, I_SSDNW, I_LAMRE, I_LAMIM, I_LOGDT, I_BRE, I_BIM, I_CRE, I_CIM, I_S5D, I_WGLU, I_BGLU,
       I_QNW, I_KNW, I_WR, I_BR, I_WGU, I_BGU, I_WDN, I_BDN, I_FNW, N_IN };

constexpr size_t al256(size_t x) { return (x + 255) & ~(size_t)255; }
constexpr size_t WS_CTL   = 0;
constexpr size_t CTL_BYTES = 65536;
constexpr int CW_BAR = 0;
constexpr int CW_KMAX = 4096;
constexpr int CW_CNT = 4096 + 128;
constexpr int CW_Q0 = 4096 + 128 + 128;
constexpr size_t WS_MOD   = WS_CTL + CTL_BYTES;
constexpr size_t WS_ROPE  = al256(WS_MOD + (size_t)DEPTH * 2 * 6144 * 4);
constexpr size_t WS_LAM   = al256(WS_ROPE + 256 * 8 * 8 + 256 * 16 * 8);
constexpr size_t WS_WIN   = al256(WS_LAM + 256);
constexpr size_t WS_WOUT  = al256(WS_WIN + (size_t)DEPTH * NU * DM * 2);
constexpr size_t WS_WGU   = al256(WS_WOUT + (size_t)DEPTH * DM * DM * 2);
constexpr size_t WS_WDN   = al256(WS_WGU + (size_t)DEPTH * NEXP * 2048 * DM * 2);
constexpr size_t WS_WGLU  = al256(WS_WDN + (size_t)DEPTH * NEXP * DM * DM * 2);
constexpr size_t WS_KTAB  = al256(WS_WGLU + (size_t)DEPTH * 256 * 256 * 2);
constexpr size_t WS_CC5   = al256(WS_KTAB + (size_t)DEPTH * 16 * 3 * 64 * 256 * 2);
constexpr size_t WS_E5    = al256(WS_CC5 + (size_t)DEPTH * 16 * 1024 * 256 * 2);
constexpr size_t WS_APOW  = al256(WS_E5 + (size_t)DEPTH * 16 * 2 * 128 * 1024 * 2);
constexpr size_t WS_XA    = al256(WS_APOW + (size_t)DEPTH * 16 * 2 * 64 * 8);
constexpr size_t WS_XB    = al256(WS_XA + (size_t)NT * DM * 4);
constexpr size_t WS_H     = al256(WS_XB + (size_t)NT * DM * 4);
constexpr size_t WS_U     = al256(WS_H + (size_t)NT * DM * 2);
constexpr size_t WS_DTRAW = al256(WS_U + (size_t)NT * NU * 2);
constexpr size_t WS_QD    = al256(WS_DTRAW + (size_t)NT * 8 * 4);
constexpr size_t WS_KD    = al256(WS_QD + (size_t)4 * NT * 64 * 2);
constexpr size_t WS_VTD   = al256(WS_KD + (size_t)4 * NT * 64 * 2);
constexpr size_t WS_QG    = al256(WS_VTD + (size_t)4 * NT * 64 * 2);
constexpr size_t WS_KG    = al256(WS_QG + (size_t)4 * NT * 64 * 2);
constexpr size_t WS_VTG   = al256(WS_KG + (size_t)2 * NT * 64 * 2);
constexpr size_t WS_QND   = al256(WS_VTG + (size_t)2 * NT * 64 * 2);
constexpr size_t WS_QNG   = al256(WS_QND + (size_t)8 * NT * 4);
constexpr size_t WS_XST   = al256(WS_QNG + (size_t)4 * NT * 4);
constexpr size_t WS_BN    = al256(WS_XST + (size_t)NT * 256 * 2);
constexpr size_t WS_CN    = al256(WS_BN + (size_t)NT * 256 * 2);
constexpr size_t WS_DTV   = al256(WS_CN + (size_t)NT * 256 * 2);
constexpr size_t WS_CUM   = al256(WS_DTV + (size_t)NT * 8 * 4);
constexpr size_t WS_SLOC  = al256(WS_CUM + (size_t)NT * 8 * 4);
constexpr size_t WS_SIN   = al256(WS_SLOC + (size_t)NCH * 8 * 64 * 128 * 4);
constexpr size_t WS_YSSD  = al256(WS_SIN + (size_t)NCH * 8 * 64 * 128 * 2);
constexpr size_t WS_SSQ   = al256(WS_YSSD + (size_t)NT * 256 * 2);
constexpr size_t WS_HLOC  = al256(WS_SSQ + (size_t)NT * 4 * 4);
constexpr size_t WS_HIN   = al256(WS_HLOC + (size_t)NC5 * 4096 * 4);
constexpr size_t WS_YS5   = al256(WS_HIN + (size_t)NC5 * 4096 * 2);
constexpr size_t WS_US5   = al256(WS_YS5 + (size_t)NT * 256 * 2);
constexpr size_t WS_MIX   = al256(WS_US5 + (size_t)NT * 256 * 2);
constexpr size_t WS_TOPE  = al256(WS_MIX + (size_t)NT * DM * 2);
constexpr size_t WS_TOPP  = al256(WS_TOPE + (size_t)NT * 16);
constexpr size_t WS_TOPG  = al256(WS_TOPP + (size_t)NT * 16);
constexpr size_t WS_TOPS  = al256(WS_TOPG + (size_t)NT * 16);
constexpr size_t WS_ASLOT = al256(WS_TOPS + (size_t)NEXP * NT * 4);
constexpr size_t WS_ACT   = al256(WS_ASLOT + (size_t)CAP * DM * 2);
constexpr size_t WS_YB    = al256(WS_ACT + (size_t)CAP * DM * 2);
constexpr size_t WS_END   = al256(WS_YB + (size_t)CAP * DM * 2);

constexpr int LDS_BYTES = 160 * 1024;
constexpr int LDS_MISC = 128 * 1024;
#define LAS __attribute__((address_space(3)))
#define GAS __attribute__((address_space(1)))

struct Args { const float* in[N_IN]; float* out; unsigned char* ws; int ph_lo, ph_hi; };

typedef unsigned short bf16_t;
typedef short bf16x8 __attribute__((ext_vector_type(8)));
typedef float f32x4 __attribute__((ext_vector_type(4)));
typedef unsigned u32x4 __attribute__((ext_vector_type(4)));

DI unsigned pk2(float lo, float hi) { f32x2 v = {lo, hi}; hbf2 b = __builtin_convertvector(v, hbf2); return __builtin_bit_cast(unsigned, b); }
DI bf16_t f2bf(float f) { return (bf16_t)(pk2(f, 0.f) & 0xffffu); }
DI float bf2f(bf16_t b) { return __uint_as_float(((unsigned)b) << 16); }
DI float bflo(unsigned u) { return __uint_as_float(u << 16); }
DI float bfhi(unsigned u) { return __uint_as_float(u & 0xffff0000u); }
DI f32x16 mfma32(bf16x8 a, bf16x8 b, f32x16 c) { return __builtin_amdgcn_mfma_f32_32x32x16_bf16(a, b, c, 0, 0, 0); }
DI int kperm(int m) { return (m & 0x13) | ((m & 4) << 1) | ((m & 8) >> 1); }
DI int crow(int i, int h) { return (i & 3) + 8 * (i >> 2) + 4 * h; }
DI bf16x8 ld8g(const bf16_t* p) { return *(const bf16x8*)p; }
template <int CTRL> DI float dppf(float v) { return __builtin_bit_cast(float, __builtin_amdgcn_update_dpp(0, __builtin_bit_cast(int, v), CTRL, 0xF, 0xF, true)); }
DI float rlane(float v, int l) { return __builtin_bit_cast(float, __builtin_amdgcn_readlane(__builtin_bit_cast(int, v), l)); }
DI float wave_sum(float v) {
    v += dppf<0xB1>(v); v += dppf<0x4E>(v); v += dppf<0x141>(v); v += dppf<0x140>(v);
    return (rlane(v, 0) + rlane(v, 16)) + (rlane(v, 32) + rlane(v, 48));
}
DI float wave_max(float v) {
    v = fmaxf(v, dppf<0xB1>(v)); v = fmaxf(v, dppf<0x4E>(v)); v = fmaxf(v, dppf<0x141>(v)); v = fmaxf(v, dppf<0x140>(v));
    return fmaxf(fmaxf(rlane(v, 0), rlane(v, 16)), fmaxf(rlane(v, 32), rlane(v, 48)));
}
DI float silu_f(float x) { return x * __builtin_amdgcn_rcpf(1.f + __builtin_amdgcn_exp2f(-1.4426950408889634f * x)); }
DI float sigmoid_f(float x) { return __builtin_amdgcn_rcpf(1.f + __builtin_amdgcn_exp2f(-1.4426950408889634f * x)); }
template <int S> DI bf16x8 pack_step(const f32x16& x) {
    u32x4 p;
    p[0] = pk2(x[8 * S + 0], x[8 * S + 1]); p[1] = pk2(x[8 * S + 2], x[8 * S + 3]);
    p[2] = pk2(x[8 * S + 4], x[8 * S + 5]); p[3] = pk2(x[8 * S + 6], x[8 * S + 7]);
    return __builtin_bit_cast(bf16x8, p);
}
DI f32x16 splat16(float v) { f32x16 r;
#pragma unroll
    for (int i = 0; i < 16; ++i) r[i] = v; return r; }
#define XB_TMO      128
#define XB_XCNT(j)  (256  + 64 * (j))
#define XB_XSUB(j)  (1280 + 64 * (j))
#define XB_XGEN(j)  (2304 + 64 * (j))
#define XB_TOP      3328
#define XB_TOPGEN   3392
#define XCD_BAR_WORDS 3456
#define XB_SPIN_CAP (1u << 18)
#define LAS __attribute__((address_space(3)))

__device__ __forceinline__ unsigned xb_ld(unsigned* p)              { return __hip_atomic_load(p, __ATOMIC_RELAXED, __HIP_MEMORY_SCOPE_AGENT); }
__device__ __forceinline__ unsigned xb_add(unsigned* p, unsigned v) { return __hip_atomic_fetch_add(p, v, __ATOMIC_RELAXED, __HIP_MEMORY_SCOPE_AGENT); }
__device__ __forceinline__ unsigned xb_xcc_id() { return (unsigned)__builtin_amdgcn_s_getreg((3 << 11) | 20) & 0xFu; }
#define XB_SPIN(cond, bar) do { unsigned _sp = 0; while (cond) { __builtin_amdgcn_s_sleep(1); \
    if ((++_sp & 255u) == 0u) { if (xb_ld(&(bar)[XB_TMO])) break; if (_sp > XB_SPIN_CAP) { atomicAdd(&(bar)[XB_TMO], 1u); break; } } } } while (0)

struct XcdBarrier {
    unsigned* bar; unsigned x;
    volatile LAS unsigned* st;
};

__device__ __forceinline__ XcdBarrier xcd_barrier_post(unsigned* bar, volatile LAS unsigned* st) {
    XcdBarrier b; b.bar = bar; b.x = xb_xcc_id(); b.st = st;
    if (threadIdx.x == 0) (void)xb_add(&bar[XB_XCNT(b.x)], 1u);
    return b;
}
__device__ __forceinline__ void xcd_barrier_complete(unsigned* bar, unsigned x, unsigned& nloc, unsigned& nx) {
    const unsigned G = gridDim.x * gridDim.y * gridDim.z;
    unsigned sum, cnt, mine, sp = 0u;
    for (;;) {
        sum = 0u; cnt = 0u; mine = 0u;
#pragma unroll
        for (unsigned j = 0; j < 16; ++j) { const unsigned c = xb_ld(&bar[XB_XCNT(j)]); sum += c; cnt += (c > 0u) ? 1u : 0u; mine = (j == x) ? c : mine; }
        if (sum == G) break;
        __builtin_amdgcn_s_sleep(1);
        if ((++sp & 255u) == 0u) { if (xb_ld(&bar[XB_TMO])) break; if (sp > XB_SPIN_CAP) { atomicAdd(&bar[XB_TMO], 1u); break; } }
    }
    nloc = mine > 0u ? mine : 1u; nx = cnt > 0u ? cnt : 1u;
}

__device__ __forceinline__ void xcd_barrier(const XcdBarrier& b) {
    asm volatile("s_waitcnt vmcnt(0)" ::: "memory");
    __syncthreads();
    if (threadIdx.x == 0) {
        unsigned* bar = b.bar;
        __builtin_amdgcn_s_waitcnt(0);
        unsigned nloc = b.st[0], nx = b.st[1];
        if (nloc == 0u) { xcd_barrier_complete(bar, b.x, nloc, nx); b.st[0] = nloc; b.st[1] = nx; }
        const unsigned old = xb_add(&bar[XB_XSUB(b.x)], 1u);
        const unsigned gen = old / nloc;
        if (old + 1u == (gen + 1u) * nloc) {
            __builtin_amdgcn_fence(__ATOMIC_RELEASE, "agent");
            asm volatile("s_waitcnt vmcnt(0)" ::: "memory");
            const unsigned og = xb_add(&bar[XB_TOP], 1u);
            const unsigned tg = og / nx;
            if (og + 1u == (tg + 1u) * nx) xb_add(&bar[XB_TOPGEN], 1u);
            else XB_SPIN(xb_ld(&bar[XB_TOPGEN]) == tg, bar);
            __builtin_amdgcn_fence(__ATOMIC_ACQUIRE, "agent");
            xb_add(&bar[XB_XGEN(b.x)], 1u);
            asm volatile("s_waitcnt vmcnt(0)" ::: "memory");
        } else {
            XB_SPIN(xb_ld(&bar[XB_XGEN(b.x)]) == gen, bar);
            __builtin_amdgcn_fence(__ATOMIC_ACQUIRE, "agent");
            asm volatile("s_waitcnt vmcnt(0)" ::: "memory");
        }
    }
    __syncthreads();
}
namespace pg8 {
#define PG8_LAS __attribute__((address_space(3)))
typedef unsigned short bf16_t;
typedef short bf16x8 __attribute__((ext_vector_type(8)));
typedef float f32x4 __attribute__((ext_vector_type(4)));
typedef unsigned u32x4 __attribute__((ext_vector_type(4)));
constexpr int BM = 256, BK = 64, HALF = 128, HTB = HALF * BK * 2  , STAGE_BYTES = 8 * HTB, NXCD = 8, WGM = 8;

__host__ __device__ __forceinline__ int lds_byte(int r, int c) { const int st = (r >> 4) * 2 + (c >> 5), rr = r & 15, cc = c & 31, ob = rr * 64 + cc * 2; return st * 1024 + (ob ^ (((ob >> 9) & 1) << 5)); }
__host__ __device__ __forceinline__ void stage_rc(int b, int& R, int& C) { const int st = b / 1024, sb = b % 1024, swz = sb ^ (((sb >> 9) & 1) << 5); R = (st >> 1) * 16 + swz / 64; C = (st & 1) * 32 + (swz % 64) / 2; }
__host__ __device__ __forceinline__ int perm32(int rho) { const int n = rho >> 4, i = rho & 15; return 8 * (i >> 2) + 4 * n + (i & 3); }

struct Unit { int pm, pn; long boff; };
struct Gemm { const bf16_t* A; const bf16_t* Bt; int M, N, K; };

struct StaticOrder {
    int nM, nN, nwg, G, c;
    __host__ __device__ void init(int M, int N, int G_, int c_) { nM = M / BM; nN = N / BM; nwg = nM * nN; G = G_; c = c_; }
    __host__ __device__ bool next(int i, Unit& u) const {
        const long L = (long)i * G + c; if (L >= nwg) return false;
        int wgid = (int)L; { const int q = nwg / NXCD, r = nwg % NXCD, xcd = wgid % NXCD, off = wgid / NXCD; wgid = (xcd < r ? xcd * (q + 1) : r * (q + 1) + (xcd - r) * q) + off; }
        const int nig = WGM * nN, gid = wgid / nig, fm = gid * WGM, gsz = (nM - fm) < WGM ? (nM - fm) : WGM;
        u.pm = fm + ((wgid % nig) % gsz); u.pn = (wgid % nig) / gsz; u.boff = 0; return true;
    }
    __device__ __forceinline__ void a_ready(const Unit&) const {}
    __device__ __forceinline__ void done(const Unit&) const {}
};
__device__ __forceinline__ unsigned cvt_pk_bf16(float lo, float hi) { unsigned r; asm volatile("v_cvt_pk_bf16_f32 %0, %1, %2" : "=v"(r) : "v"(lo), "v"(hi)); return r; }
template <class Epi, class Sched, bool STAMP = false>
__device__ __forceinline__ void gemm_phase(PG8_LAS unsigned char* lds, const Gemm g, const Sched& S, const Epi& E, unsigned long long* stamps = nullptr) {
    int tid_l = threadIdx.x; asm volatile("" : "+v"(tid_l)); const int tid = tid_l, wid = __builtin_amdgcn_readfirstlane(tid >> 6), lane = tid & 63, wr = wid >> 2, wc = wid & 3, fr = lane & 15, fq = lane >> 4;
    const int K = g.K, nt = K / BK;
    int ts_lo = 0, ts_hi = 0, nts = 0; const unsigned long long rt_entry = STAMP ? (unsigned long long)wall_clock64() : 0ull;
#define PG8_STAMP() do { if (STAMP && wid == 0 && nts < 64) { const unsigned long long _c = (unsigned long long)clock64(); \
        ts_lo = (lane == nts) ? (int)(unsigned)_c : ts_lo; ts_hi = (lane == nts) ? (int)(unsigned)(_c >> 32) : ts_hi; ++nts; } } while (0)
    PG8_STAMP();
    unsigned voffA[2], voffB[2];
#pragma unroll
    for (int i = 0; i < 2; ++i) { int R, C; stage_rc(tid * 16 + i * 8192, R, C); const int Rb = Epi::PERM ? ((R & ~31) + perm32(R & 31)) : R;
        voffA[i] = (unsigned)(R * K + C) * 2u; voffB[i] = (unsigned)(Rb * K + C) * 2u; }
    const size_t kstep = (size_t)(BK * 2);
    const size_t hstep = (size_t)HALF * K * 2;
    const size_t tstep = 2 * hstep;
    const unsigned ldsw = (unsigned)wid * 1024u;
    const int aoff = lds_byte(wr * 64 + fr, fq * 8), boff = lds_byte(wc * 32 + fr, fq * 8);
#define PG8_SA(b, h) (((b) * 2 + (h)) * HTB)
#define PG8_SB(b, h) ((4 + (b) * 2 + (h)) * HTB)
#define PG8_STAGE(bufoff, gbase, voff) do { _Pragma("unroll") for (int _i = 0; _i < 2; ++_i) \
        __builtin_amdgcn_global_load_lds((const unsigned*)((const char*)(gbase) + (voff)[_i]), (PG8_LAS unsigned*)(lds + (bufoff) + ldsw + _i * 8192), 16, 0, 0); } while (0)
#define PG8_LDA(dst, b, h) do { _Pragma("unroll") for (int m = 0; m < 4; ++m) _Pragma("unroll") for (int k = 0; k < 2; ++k) dst[m][k] = *(const PG8_LAS bf16x8*)(lds + PG8_SA(b, h) + aoff + m * 2048 + k * 1024); } while (0)
#define PG8_LDB(dst, b, h) do { _Pragma("unroll") for (int n = 0; n < 2; ++n) _Pragma("unroll") for (int k = 0; k < 2; ++k) dst[n][k] = *(const PG8_LAS bf16x8*)(lds + PG8_SB(b, h) + boff + n * 2048 + k * 1024); } while (0)
#define PG8_MMA(ai, bj, At, Bt) do { __builtin_amdgcn_s_setprio(1); _Pragma("unroll") for (int m = 0; m < 4; ++m) _Pragma("unroll") for (int n = 0; n < 2; ++n) _Pragma("unroll") for (int k = 0; k < 2; ++k) \
        acc[ai][bj][m][n] = __builtin_amdgcn_mfma_f32_16x16x32_bf16(Bt[n][k], At[m][k], acc[ai][bj][m][n], 0, 0, 0); __builtin_amdgcn_s_setprio(0); } while (0)
#define PG8_WAIT_V(n) asm volatile("s_waitcnt vmcnt(" #n ")" ::: "memory")
#define PG8_WAIT_L(n) asm volatile("s_waitcnt lgkmcnt(" #n ")" ::: "memory")
#define PG8_BAR __builtin_amdgcn_s_barrier()
#define PG8_SCHED __builtin_amdgcn_sched_barrier(0)
    Unit cur, nxt; int ui = 0;
    if (!S.next(0, cur)) return;
    f32x4 acc[2][2][4][2];
#pragma unroll
    for (int a = 0; a < 2; ++a)
#pragma unroll
        for (int b = 0; b < 2; ++b)
#pragma unroll
            for (int m = 0; m < 4; ++m)
#pragma unroll
                for (int n = 0; n < 2; ++n) acc[a][b][m][n] = (f32x4){0.f, 0.f, 0.f, 0.f};
    bf16x8 At[4][2], B0[2][2], B1[2][2];
    const char* cA = (const char*)g.A + (size_t)cur.pm * tstep; const char* cB = (const char*)g.Bt + (size_t)cur.pn * tstep + cur.boff;
    S.a_ready(cur);
    PG8_STAGE(PG8_SB(0, 0), cB, voffB); PG8_STAGE(PG8_SA(0, 0), cA, voffA); PG8_STAGE(PG8_SB(0, 1), cB + hstep, voffB); PG8_STAGE(PG8_SA(0, 1), cA + hstep, voffA);
    if (wr == 1) PG8_BAR;
    PG8_WAIT_V(4); PG8_BAR;
    PG8_STAGE(PG8_SB(1, 0), cB + kstep, voffB); PG8_STAGE(PG8_SA(1, 0), cA + kstep, voffA); PG8_STAGE(PG8_SB(1, 1), cB + hstep + kstep, voffB);
    PG8_WAIT_V(6); PG8_BAR;
    PG8_STAMP();
    for (;;) {
        const bool has_next = S.next(ui + 1, nxt);
        const char* nA = has_next ? (const char*)g.A + (size_t)nxt.pm * tstep : cA; const char* nB = has_next ? (const char*)g.Bt + (size_t)nxt.pn * tstep + nxt.boff : cB;
        for (int t = 0; t < nt; t += 2) {
            const bool last = (t == nt - 2);
            const char* a1 = cA + (size_t)(t + 1) * kstep;
            const char* a2 = last ? nA : cA + (size_t)(t + 2) * kstep; const char* b2 = last ? nB : cB + (size_t)(t + 2) * kstep;
            const char* a3 = a2 + kstep; const char* b3 = b2 + kstep;
            if (last && has_next) S.a_ready(nxt);
            PG8_LDB(B0, 0, 0); PG8_SCHED; PG8_LDA(At, 0, 0); PG8_STAGE(PG8_SA(1, 1), a1 + hstep, voffA);
            PG8_WAIT_L(8); PG8_BAR; PG8_WAIT_L(0); PG8_MMA(0, 0, At, B0); PG8_BAR; PG8_SCHED;
            PG8_LDB(B1, 0, 1); PG8_STAGE(PG8_SB(0, 0), b2, voffB);
            PG8_BAR; PG8_WAIT_L(0); PG8_MMA(0, 1, At, B1); PG8_BAR;
            PG8_LDA(At, 0, 1); PG8_STAGE(PG8_SA(0, 0), a2, voffA);
            PG8_BAR; PG8_WAIT_L(0); PG8_MMA(1, 0, At, B0); PG8_BAR; PG8_SCHED;
            PG8_STAGE(PG8_SB(0, 1), b2 + hstep, voffB);
            PG8_WAIT_V(6); PG8_BAR; PG8_MMA(1, 1, At, B1); PG8_BAR;
            PG8_LDB(B0, 1, 0); PG8_SCHED; PG8_LDA(At, 1, 0); PG8_STAGE(PG8_SA(0, 1), a2 + hstep, voffA);
            PG8_WAIT_L(8); PG8_BAR; PG8_WAIT_L(0); PG8_MMA(0, 0, At, B0); PG8_BAR; PG8_SCHED;
            PG8_LDB(B1, 1, 1); PG8_STAGE(PG8_SB(1, 0), b3, voffB);
            PG8_BAR; PG8_WAIT_L(0); PG8_MMA(0, 1, At, B1); PG8_BAR;
            PG8_LDA(At, 1, 1); PG8_STAGE(PG8_SA(1, 0), a3, voffA);
            PG8_BAR; PG8_WAIT_L(0); PG8_MMA(1, 0, At, B0); PG8_BAR; PG8_SCHED;
            PG8_STAGE(PG8_SB(1, 1), b3 + hstep, voffB);
            PG8_WAIT_V(6); PG8_BAR; PG8_MMA(1, 1, At, B1); PG8_BAR;
        }
        PG8_STAMP();
        if constexpr (!Epi::AFTER_DRAIN) { E(acc, cur, wr, wc, fr, fq); S.done(cur); }
        PG8_STAMP();
        if (!has_next) break;
#pragma unroll
        for (int a = 0; a < 2; ++a)
#pragma unroll
            for (int b = 0; b < 2; ++b)
#pragma unroll
                for (int m = 0; m < 4; ++m)
#pragma unroll
                    for (int n = 0; n < 2; ++n) acc[a][b][m][n] = (f32x4){0.f, 0.f, 0.f, 0.f};
        cur = nxt; cA = nA; cB = nB; ++ui;
    }
    PG8_WAIT_V(0);
    if (wr == 0) PG8_BAR;
    PG8_BAR;
    if constexpr (Epi::AFTER_DRAIN) { E.fused(acc, cur, wr, wc, fr, fq, lds, wid, lane); S.done(cur); }
    PG8_STAMP();
    if (STAMP && wid == 0) { stamps[lane] = lane < nts ? (((unsigned long long)(unsigned)ts_hi << 32) | (unsigned)ts_lo) : 0ull;
        if (lane == 62) stamps[62] = rt_entry; if (lane == 63) stamps[63] = (unsigned long long)wall_clock64(); }
#undef PG8_STAMP
#undef PG8_SA
#undef PG8_SB
#undef PG8_STAGE
#undef PG8_LDA
#undef PG8_LDB
#undef PG8_MMA
#undef PG8_WAIT_V
#undef PG8_WAIT_L
#undef PG8_BAR
#undef PG8_SCHED
}
template <class Epi, class Sched, bool STAMP = false>
__device__ __forceinline__ void gemm_phase_gather(PG8_LAS unsigned char* lds, const Gemm g, const Sched& S, const Epi& E, const PG8_LAS int* rows, unsigned long long* stamps = nullptr) {
    int tid_l = threadIdx.x; asm volatile("" : "+v"(tid_l)); const int tid = tid_l, wid = __builtin_amdgcn_readfirstlane(tid >> 6), lane = tid & 63, wr = wid >> 2, wc = wid & 3, fr = lane & 15, fq = lane >> 4;
    const int K = g.K, nt = K / BK;
    int ts_lo = 0, ts_hi = 0, nts = 0; const unsigned long long rt_entry = STAMP ? (unsigned long long)wall_clock64() : 0ull;
#define PG8_STAMP() do { if (STAMP && wid == 0 && nts < 64) { const unsigned long long _c = (unsigned long long)clock64(); \
        ts_lo = (lane == nts) ? (int)(unsigned)_c : ts_lo; ts_hi = (lane == nts) ? (int)(unsigned)(_c >> 32) : ts_hi; ++nts; } } while (0)
    PG8_STAMP();
    unsigned voffA[2], voffB[2];
#pragma unroll
    for (int i = 0; i < 2; ++i) { int R, C; stage_rc(tid * 16 + i * 8192, R, C); const int Rb = Epi::PERM ? ((R & ~31) + perm32(R & 31)) : R;
        voffA[i] = (unsigned)(R * K + C) * 2u; voffB[i] = (unsigned)(Rb * K + C) * 2u; }
    int RA[2]; { int R_, C_; stage_rc(tid * 16, R_, C_); RA[0] = R_; stage_rc(tid * 16 + 8192, R_, C_); RA[1] = R_; }
    unsigned caoff[2]; { int R_, C_; stage_rc(tid * 16, R_, C_); caoff[0] = (unsigned)C_ * 2u; stage_rc(tid * 16 + 8192, R_, C_); caoff[1] = (unsigned)C_ * 2u; }
    unsigned offC[2][2], offN[2][2];
#define PG8_ROWOFF(dst, uidx) do { _Pragma("unroll") for (int _h = 0; _h < 2; ++_h) _Pragma("unroll") for (int _i = 0; _i < 2; ++_i) (dst)[_h][_i] = (unsigned)rows[(uidx) * 256 + _h * HALF + RA[_i]] * (unsigned)(K * 2) + caoff[_i]; } while (0)
    const size_t kstep = (size_t)(BK * 2);
    const size_t hstep = (size_t)HALF * K * 2;
    const size_t tstep = 2 * hstep;
    const unsigned ldsw = (unsigned)wid * 1024u;
    const int aoff = lds_byte(wr * 64 + fr, fq * 8), boff = lds_byte(wc * 32 + fr, fq * 8);
#define PG8_SA(b, h) (((b) * 2 + (h)) * HTB)
#define PG8_SB(b, h) ((4 + (b) * 2 + (h)) * HTB)
#define PG8_STAGE(bufoff, gbase, voff) do { _Pragma("unroll") for (int _i = 0; _i < 2; ++_i) \
        __builtin_amdgcn_global_load_lds((const unsigned*)((const char*)(gbase) + (voff)[_i]), (PG8_LAS unsigned*)(lds + (bufoff) + ldsw + _i * 8192), 16, 0, 0); } while (0)
#define PG8_LDA(dst, b, h) do { _Pragma("unroll") for (int m = 0; m < 4; ++m) _Pragma("unroll") for (int k = 0; k < 2; ++k) dst[m][k] = *(const PG8_LAS bf16x8*)(lds + PG8_SA(b, h) + aoff + m * 2048 + k * 1024); } while (0)
#define PG8_LDB(dst, b, h) do { _Pragma("unroll") for (int n = 0; n < 2; ++n) _Pragma("unroll") for (int k = 0; k < 2; ++k) dst[n][k] = *(const PG8_LAS bf16x8*)(lds + PG8_SB(b, h) + boff + n * 2048 + k * 1024); } while (0)
#define PG8_MMA(ai, bj, At, Bt) do { __builtin_amdgcn_s_setprio(1); _Pragma("unroll") for (int m = 0; m < 4; ++m) _Pragma("unroll") for (int n = 0; n < 2; ++n) _Pragma("unroll") for (int k = 0; k < 2; ++k) \
        acc[ai][bj][m][n] = __builtin_amdgcn_mfma_f32_16x16x32_bf16(Bt[n][k], At[m][k], acc[ai][bj][m][n], 0, 0, 0); __builtin_amdgcn_s_setprio(0); } while (0)
#define PG8_WAIT_V(n) asm volatile("s_waitcnt vmcnt(" #n ")" ::: "memory")
#define PG8_WAIT_L(n) asm volatile("s_waitcnt lgkmcnt(" #n ")" ::: "memory")
#define PG8_BAR __builtin_amdgcn_s_barrier()
#define PG8_SCHED __builtin_amdgcn_sched_barrier(0)
    Unit cur, nxt; int ui = 0;
    if (!S.next(0, cur)) return;
    f32x4 acc[2][2][4][2];
#pragma unroll
    for (int a = 0; a < 2; ++a)
#pragma unroll
        for (int b = 0; b < 2; ++b)
#pragma unroll
            for (int m = 0; m < 4; ++m)
#pragma unroll
                for (int n = 0; n < 2; ++n) acc[a][b][m][n] = (f32x4){0.f, 0.f, 0.f, 0.f};
    bf16x8 At[4][2], B0[2][2], B1[2][2];
    const char* cA = (const char*)g.A; PG8_ROWOFF(offC, 0); const char* cB = (const char*)g.Bt + (size_t)cur.pn * tstep + cur.boff;
    S.a_ready(cur);
    PG8_STAGE(PG8_SB(0, 0), cB, voffB); PG8_STAGE(PG8_SA(0, 0), cA, offC[0]); PG8_STAGE(PG8_SB(0, 1), cB + hstep, voffB); PG8_STAGE(PG8_SA(0, 1), cA, offC[1]);
    if (wr == 1) PG8_BAR;
    PG8_WAIT_V(4); PG8_BAR;
    PG8_STAGE(PG8_SB(1, 0), cB + kstep, voffB); PG8_STAGE(PG8_SA(1, 0), cA + kstep, offC[0]); PG8_STAGE(PG8_SB(1, 1), cB + hstep + kstep, voffB);
    PG8_WAIT_V(6); PG8_BAR;
    PG8_STAMP();
    for (;;) {
        const bool has_next = S.next(ui + 1, nxt);
        const char* nA = cA; if (has_next) PG8_ROWOFF(offN, ui + 1); else { offN[0][0] = offC[0][0]; offN[0][1] = offC[0][1]; offN[1][0] = offC[1][0]; offN[1][1] = offC[1][1]; } const char* nB = has_next ? (const char*)g.Bt + (size_t)nxt.pn * tstep + nxt.boff : cB;
        for (int t = 0; t < nt; t += 2) {
            const bool last = (t == nt - 2);
            const char* a1 = cA + (size_t)(t + 1) * kstep;
            const char* a2 = last ? nA : cA + (size_t)(t + 2) * kstep; const char* b2 = last ? nB : cB + (size_t)(t + 2) * kstep;
            const char* a3 = a2 + kstep; const char* b3 = b2 + kstep;
            if (last && has_next) S.a_ready(nxt);
            PG8_LDB(B0, 0, 0); PG8_SCHED; PG8_LDA(At, 0, 0); PG8_STAGE(PG8_SA(1, 1), a1, offC[1]);
            PG8_WAIT_L(8); PG8_BAR; PG8_WAIT_L(0); PG8_MMA(0, 0, At, B0); PG8_BAR; PG8_SCHED;
            PG8_LDB(B1, 0, 1); PG8_STAGE(PG8_SB(0, 0), b2, voffB);
            PG8_BAR; PG8_WAIT_L(0); PG8_MMA(0, 1, At, B1); PG8_BAR;
            PG8_LDA(At, 0, 1); { unsigned o2[2] = {last ? offN[0][0] : offC[0][0], last ? offN[0][1] : offC[0][1]}; PG8_STAGE(PG8_SA(0, 0), a2, o2); }
            PG8_BAR; PG8_WAIT_L(0); PG8_MMA(1, 0, At, B0); PG8_BAR; PG8_SCHED;
            PG8_STAGE(PG8_SB(0, 1), b2 + hstep, voffB);
            PG8_WAIT_V(6); PG8_BAR; PG8_MMA(1, 1, At, B1); PG8_BAR;
            PG8_LDB(B0, 1, 0); PG8_SCHED; PG8_LDA(At, 1, 0); { unsigned o2[2] = {last ? offN[1][0] : offC[1][0], last ? offN[1][1] : offC[1][1]}; PG8_STAGE(PG8_SA(0, 1), a2, o2); }
            PG8_WAIT_L(8); PG8_BAR; PG8_WAIT_L(0); PG8_MMA(0, 0, At, B0); PG8_BAR; PG8_SCHED;
            PG8_LDB(B1, 1, 1); PG8_STAGE(PG8_SB(1, 0), b3, voffB);
            PG8_BAR; PG8_WAIT_L(0); PG8_MMA(0, 1, At, B1); PG8_BAR;
            PG8_LDA(At, 1, 1); { unsigned o2[2] = {last ? offN[0][0] : offC[0][0], last ? offN[0][1] : offC[0][1]}; PG8_STAGE(PG8_SA(1, 0), a3, o2); }
            PG8_BAR; PG8_WAIT_L(0); PG8_MMA(1, 0, At, B0); PG8_BAR; PG8_SCHED;
            PG8_STAGE(PG8_SB(1, 1), b3 + hstep, voffB);
            PG8_WAIT_V(6); PG8_BAR; PG8_MMA(1, 1, At, B1); PG8_BAR;
        }
        PG8_STAMP();
        if constexpr (!Epi::AFTER_DRAIN) { E(acc, cur, wr, wc, fr, fq); S.done(cur); }
        PG8_STAMP();
        if (!has_next) break;
#pragma unroll
        for (int a = 0; a < 2; ++a)
#pragma unroll
            for (int b = 0; b < 2; ++b)
#pragma unroll
                for (int m = 0; m < 4; ++m)
#pragma unroll
                    for (int n = 0; n < 2; ++n) acc[a][b][m][n] = (f32x4){0.f, 0.f, 0.f, 0.f};
        cur = nxt; cA = nA; cB = nB; ++ui; offC[0][0] = offN[0][0]; offC[0][1] = offN[0][1]; offC[1][0] = offN[1][0]; offC[1][1] = offN[1][1];
    }
    PG8_WAIT_V(0);
    if (wr == 0) PG8_BAR;
    PG8_BAR;
    if constexpr (Epi::AFTER_DRAIN) { E.fused(acc, cur, wr, wc, fr, fq, lds, wid, lane); S.done(cur); }
    PG8_STAMP();
    if (STAMP && wid == 0) { stamps[lane] = lane < nts ? (((unsigned long long)(unsigned)ts_hi << 32) | (unsigned)ts_lo) : 0ull;
        if (lane == 62) stamps[62] = rt_entry; if (lane == 63) stamps[63] = (unsigned long long)wall_clock64(); }
#undef PG8_STAMP
#undef PG8_SA
#undef PG8_SB
#undef PG8_STAGE
#undef PG8_LDA
#undef PG8_LDB
#undef PG8_MMA
#undef PG8_WAIT_V
#undef PG8_WAIT_L
#undef PG8_BAR
#undef PG8_SCHED
#undef PG8_ROWOFF
}
}

struct Frame {
    LAS unsigned char* lds;
    const GAS float* const __attribute__((address_space(4)))* in;
    GAS unsigned char* ws;
    float* out;
    int tid, lane, wave, G, bid;
};
#define WSP(T, off) ((T*)(F.ws + (off)))

struct ConvItem { const float* src; bf16_t* dst; int ld, ncols, c0, k0, mode, kdim; };
DI int conv_dst_row(int mode, int c) {
    if (mode == 1) return c < DT_COL ? c : (c < DT_COL + 8 ? -1 : c - 8);
    if (mode == 2) { const int j = c >> 1, up = c & 1; return (j >> 7) * 256 + up * 128 + (j & 127); }
    return c;
}
constexpr int N_S5I = DEPTH * 16 * 4, N_ADA = DEPTH * 48, N_CV_WIN = DEPTH * 41 * 4, N_CV_WOUT = DEPTH * 16 * 4, N_CV_GU = DEPTH * NEXP * 32 * 4,
              N_CV_DN = DEPTH * NEXP * 16 * 4, N_CV_GLU = DEPTH * 4;
constexpr int N_CONV = N_CV_WIN + N_CV_WOUT + N_CV_GLU;
DI ConvItem conv_decode(const Frame& F, int it) {
    ConvItem c; c.kdim = DM;
    if (it < N_CV_WIN) { const int l = it / 164, r = it % 164; c.src = ((const float*)F.in[I_WIN]) + (size_t)l * DM * DIN; c.dst = WSP(bf16_t, WS_WIN) + (size_t)l * NU * DM;
        c.ld = DIN; c.ncols = DIN; c.c0 = (r >> 2) * 64; c.k0 = (r & 3) * 256; c.mode = 1; return c; }
    it -= N_CV_WIN;
    if (it < N_CV_WOUT) { const int l = it / 64, r = it % 64; c.src = ((const float*)F.in[I_WOUT]) + (size_t)l * DM * DM; c.dst = WSP(bf16_t, WS_WOUT) + (size_t)l * DM * DM;
        c.ld = DM; c.ncols = DM; c.c0 = (r >> 2) * 64; c.k0 = (r & 3) * 256; c.mode = 0; return c; }
    it -= N_CV_WOUT;
    { const int l = it / 4, r = it % 4; c.src = ((const float*)F.in[I_WGLU]) + (size_t)l * 256 * 256; c.dst = WSP(bf16_t, WS_WGLU) + (size_t)l * 256 * 256;
      c.ld = 256; c.ncols = 256; c.c0 = r * 64; c.k0 = 0; c.mode = 0; c.kdim = 256; return c; }
}
DI void conv_load(const ConvItem& c, int tid, f32x4 (&v)[8]) {
#pragma unroll
    for (int i = 0; i < 8; ++i) { const int idx = tid + 512 * i, k = idx >> 4, c4 = idx & 15; const int col = c.c0 + 4 * c4;
        v[i] = (col < c.ncols) ? *(const f32x4*)(c.src + (size_t)(c.k0 + k) * c.ld + col) : (f32x4){0.f, 0.f, 0.f, 0.f}; }
}
DI int q_next(const Frame& F, unsigned* ctr) {
    LAS int* slot = (LAS int*)(F.lds + LDS_BYTES - 16);
    __syncthreads();
    if (F.tid == 0) *slot = (int)__hip_atomic_fetch_add(ctr, 1u, __ATOMIC_RELAXED, __HIP_MEMORY_SCOPE_AGENT);
    __syncthreads();
    return *slot;
}
DI void p0_convert(const Frame& F, unsigned* ctr) {
    LAS float* T = (LAS float*)F.lds;
    const int tid = F.tid;
    f32x4 v[8];
    int it = q_next(F, ctr);
    if (it >= N_CONV) return;
    ConvItem cur = conv_decode(F, it);
    conv_load(cur, tid, v);
    for (;;) {
#pragma unroll
        for (int i = 0; i < 8; ++i) { const int idx = tid + 512 * i, k = idx >> 4, c4 = idx & 15;
            T[k * 65 + 4 * c4 + 0] = v[i][0]; T[k * 65 + 4 * c4 + 1] = v[i][1]; T[k * 65 + 4 * c4 + 2] = v[i][2]; T[k * 65 + 4 * c4 + 3] = v[i][3]; }
        __syncthreads();
        const int nit = q_next(F, ctr); const bool has_next = nit < N_CONV;
        ConvItem nxt = cur;
        if (has_next) { nxt = conv_decode(F, nit); conv_load(nxt, tid, v); }
#pragma unroll
        for (int i = 0; i < 4; ++i) { const int task = tid + 512 * i, c = task & 63, kc = task >> 6;
            const int col = cur.c0 + c; const int row = (col < cur.ncols) ? conv_dst_row(cur.mode, col) : -1;
            u32x4 o;
#pragma unroll
            for (int j = 0; j < 4; ++j) o[j] = pk2(T[(8 * kc + 2 * j) * 65 + c], T[(8 * kc + 2 * j + 1) * 65 + c]);
            if (row >= 0) *(u32x4*)(cur.dst + (size_t)row * cur.kdim + cur.k0 + 8 * kc) = o; }
        __syncthreads();
        if (!has_next) break;
        cur = nxt; it = nit;
    }
}
DI void p0_adaln(const Frame& F, int item) {
    const int l = item / 48, col0 = (item % 48) * 128, tid = F.tid, part = tid >> 5, ct = tid & 31;
    const float* W = ((const float*)F.in[I_WADA]) + (size_t)l * DM * 6144 + col0 + 4 * ct;
    const float* cl = ((const float*)F.in[I_C]); const float* cc = ((const float*)F.in[I_CCTX]);
    f32x4 al = {0.f, 0.f, 0.f, 0.f}, ac = {0.f, 0.f, 0.f, 0.f};
#pragma unroll 8
    for (int kk = 0; kk < 64; ++kk) { const int k = part * 64 + kk; const f32x4 w = *(const f32x4*)(W + (size_t)k * 6144);
        const float sl = silu_f(cl[k]), sc = silu_f(cc[k]); al += w * sl; ac += w * sc; }
    LAS float* R = (LAS float*)F.lds;
#pragma unroll
    for (int j = 0; j < 4; ++j) { R[(part * 32 + ct) * 8 + j] = al[j]; R[(part * 32 + ct) * 8 + 4 + j] = ac[j]; }
    __syncthreads();
    if (tid < 256) { const int v = tid >> 7, col = tid & 127; float s = 0.f;
#pragma unroll
        for (int p = 0; p < 16; ++p) s += R[(p * 32 + (col >> 2)) * 8 + v * 4 + (col & 3)];
        WSP(float, WS_MOD)[((size_t)l * 2 + v) * 6144 + col0 + col] = s + ((const float*)F.in[I_BADA])[(size_t)l * 6144 + col0 + col]; }
    __syncthreads();
}
DI void p0_rope(const Frame& F) {
    f32x2* rd = WSP(f32x2, WS_ROPE); f32x2* rg = rd + 256 * 8;
    for (int i = F.tid; i < 256 * 8; i += 512) { const int pos = i >> 3, f = i & 7; const float inv = exp2f(-(float)(2 * f) / 16.f * 13.287712379549449f);
        float s, c; sincosf((float)pos * inv, &s, &c); rd[i] = (f32x2){c, s}; }
    if (F.tid < DEPTH) { const int l = F.tid; float s1 = 0.f, s2 = 0.f;
        for (int i = 0; i < 32; ++i) { s1 += ((const float*)F.in[I_LQ1])[l * 32 + i] * ((const float*)F.in[I_LK1])[l * 32 + i]; s2 += ((const float*)F.in[I_LQ2])[l * 32 + i] * ((const float*)F.in[I_LK2])[l * 32 + i]; }
        WSP(float, WS_LAM)[l] = __expf(s1) - __expf(s2) + (0.8f - 0.6f * __expf(-0.3f * (float)l)); }
    for (int i = F.tid; i < 256 * 16; i += 512) { const int pos = i >> 4, f = i & 15; const float inv = exp2f(-(float)(2 * f) / 32.f * 13.287712379549449f);
        float s, c; sincosf((float)pos * inv, &s, &c); rg[i] = (f32x2){c, s}; }
}
DI f32x2 cmul(f32x2 a, f32x2 b) { return (f32x2){a.x * b.x - a.y * b.y, a.x * b.y + a.y * b.x}; }
DI void p0_s5(const Frame& F, int item4) {
    const int item = item4 >> 2, part = item4 & 3;
    const int l = item >> 4, g = item & 15, tid = F.tid;
    LAS f32x2* PW = (LAS f32x2*)F.lds;
    LAS f32x2* BB = PW + 2 * 65 * 64;
    LAS f32x2* CM = BB + 2 * 64 * 16;
    LAS float* D0 = (LAS float*)(CM + 2 * 16 * 64);
    for (int i = tid; i < 2 * 65 * 64; i += 512) { const int dir = i / (65 * 64), n = (i / 64) % 65, p = i & 63;
        const size_t li = (((size_t)l * 2 + dir) * 16 + g) * 64 + p;
        const float step = __expf(((const float*)F.in[I_LOGDT])[((size_t)l * 2 + dir) * 16 + g]);
        const float tr = ((const float*)F.in[I_LAMRE])[li] * step, ti = ((const float*)F.in[I_LAMIM])[li] * step;
        float s, c; sincosf((float)n * ti, &s, &c); const float m = __expf((float)n * tr); PW[i] = (f32x2){m * c, m * s}; }
    __syncthreads();
    for (int i = tid; i < 2 * 64 * 16; i += 512) { const int dir = i >> 10, p = (i >> 4) & 63, c = i & 15;
        const size_t li = (((size_t)l * 2 + dir) * 16 + g) * 64 + p;
        const f32x2 lam = {((const float*)F.in[I_LAMRE])[li], ((const float*)F.in[I_LAMIM])[li]}; const f32x2 a = PW[(dir * 65 + 1) * 64 + p];
        const f32x2 num = {a.x - 1.f, a.y}; const float den = lam.x * lam.x + lam.y * lam.y;
        const f32x2 q = {(num.x * lam.x + num.y * lam.y) / den, (num.y * lam.x - num.x * lam.y) / den};
        const size_t bi = (((size_t)l * 16 + g) * 64 + p) * 16 + c;
        BB[i] = cmul(q, (f32x2){((const float*)F.in[I_BRE])[bi], ((const float*)F.in[I_BIM])[bi]}); }
    for (int i = tid; i < 2 * 16 * 64; i += 512) { const int dir = i >> 10, c = (i >> 6) & 15, p = i & 63;
        const size_t ci = ((((size_t)l * 2 + dir) * 16 + g) * 16 + c) * 64 + p; CM[i] = (f32x2){((const float*)F.in[I_CRE])[ci], ((const float*)F.in[I_CIM])[ci]}; }
    __syncthreads();
    bf16_t* kt = WSP(bf16_t, WS_KTAB) + ((size_t)l * 16 + g) * 3 * 64 * 256;
    {
        const int dir = part >> 1, lag0 = (part & 1) * 32 + (tid >> 8), c = (tid >> 4) & 15, cp = tid & 15;
        float sk[16];
#pragma unroll
        for (int k = 0; k < 16; ++k) sk[k] = 0.f;
#pragma unroll 2
        for (int p = 0; p < 64; ++p) { const f32x2 tq = cmul(CM[(dir * 16 + c) * 64 + p], BB[(dir * 64 + p) * 16 + cp]);
#pragma unroll
            for (int k = 0; k < 16; ++k) { const f32x2 pw = PW[(dir * 65 + lag0 + 2 * k) * 64 + p]; sk[k] += tq.x * pw.x - tq.y * pw.y; } }
#pragma unroll
        for (int k = 0; k < 16; ++k) kt[part * 8192 + tid + 512 * k] = f2bf(sk[k]); }
    __syncthreads();
    if (part == 0) for (int i = tid; i < 256; i += 512) { const int c = i >> 4, cp = i & 15; float s = 0.f;
        for (int dir = 0; dir < 2; ++dir) for (int p = 0; p < 64; ++p) { const f32x2 w = BB[(dir * 64 + p) * 16 + cp]; const f32x2 cm = CM[(dir * 16 + c) * 64 + p]; s += cm.x * w.x - cm.y * w.y; }
        kt[2 * 64 * 256 + i] = f2bf(s + (c == cp ? ((const float*)F.in[I_S5D])[(size_t)l * 256 + g * 16 + c] : 0.f)); }
    bf16_t* e5 = WSP(bf16_t, WS_E5) + ((size_t)l * 16 + g) * 2 * 128 * 1024;
    for (int k = 0; k < 16; ++k) { const int j = part * 8192 + tid + 512 * k, cp0 = (j & 1) * 8, sq = (j >> 1) & 63, m = (j >> 7) & 127, dir = j >> 14, p = m & 63;
        const int n = dir ? sq : 63 - sq; const f32x2 pw = PW[(dir * 65 + n) * 64 + p];
        const LAS f32x4* b4 = (const LAS f32x4*)(BB + (dir * 64 + p) * 16 + cp0); float o[8];
#pragma unroll
        for (int q = 0; q < 4; ++q) { const f32x4 bv = b4[q];
            o[2 * q] = m < 64 ? pw.x * bv[0] - pw.y * bv[1] : pw.x * bv[1] + pw.y * bv[0]; o[2 * q + 1] = m < 64 ? pw.x * bv[2] - pw.y * bv[3] : pw.x * bv[3] + pw.y * bv[2]; }
        u32x4 w; w[0] = pk2(o[0], o[1]); w[1] = pk2(o[2], o[3]); w[2] = pk2(o[4], o[5]); w[3] = pk2(o[6], o[7]); *(u32x4*)(e5 + ((((size_t)(dir * 4 + (m >> 5)) * 64 + sq) * 64 + ((cp0 >> 3) * 32 + (m & 31))) * 8)) = w; }
    bf16_t* cc5 = WSP(bf16_t, WS_CC5) + ((size_t)l * 16 + g) * 1024 * 256;
    for (int k = 0; k < 16; ++k) { const int j = part * 8192 + tid + 512 * k, p0 = (j & 7) * 8, im = (j >> 3) & 1, dir = (j >> 4) & 1, row = j >> 5, t = row >> 4, c = row & 15;
        const int n = dir ? 64 - t : t + 1;
        const LAS f32x4* c4 = (const LAS f32x4*)(CM + (dir * 16 + c) * 64 + p0); const LAS f32x4* p4 = (const LAS f32x4*)(PW + (dir * 65 + n) * 64 + p0); float o[8];
#pragma unroll
        for (int q = 0; q < 4; ++q) { const f32x4 cv = c4[q], pv = p4[q];
            o[2 * q] = im ? -(cv[0] * pv[1] + cv[1] * pv[0]) : cv[0] * pv[0] - cv[1] * pv[1]; o[2 * q + 1] = im ? -(cv[2] * pv[3] + cv[3] * pv[2]) : cv[2] * pv[2] - cv[3] * pv[3]; }
        u32x4 w; w[0] = pk2(o[0], o[1]); w[1] = pk2(o[2], o[3]); w[2] = pk2(o[4], o[5]); w[3] = pk2(o[6], o[7]); *(u32x4*)(cc5 + (size_t)j * 8) = w; }
    f32x2* ap = WSP(f32x2, WS_APOW) + ((size_t)l * 16 + g) * 128;
    if (part == 0) for (int i = tid; i < 128; i += 512) ap[i] = PW[((i >> 6) * 65 + 64) * 64 + (i & 63)];
    __syncthreads();
}
DI void p0_prologue(const Frame& F, int rep = 0) {
    for (int it = F.bid; it < N_S5I; it += F.G) p0_s5(F, it);
    unsigned* qa = WSP(unsigned, WS_CTL) + CW_Q0 + 64 * (20 + rep);
    for (;;) { const int it = q_next(F, qa); if (it > N_ADA) break; if (it < N_ADA) p0_adaln(F, it); else p0_rope(F); }
    __syncthreads();
    p0_convert(F, WSP(unsigned, WS_CTL) + CW_Q0 + 64 * rep);
}

constexpr int RPB = 65;
DI int moe_tables(const Frame& F, int l);
template <bool FINAL>
DI void p1_norm(const Frame& F, int l) {
    if (l > 0) (void)moe_tables(F, l - 1);
    const LAS int* PSTL = (const LAS int*)(F.lds + LDS_MISC);
    LAS float* WDT = (LAS float*)F.lds;
    if (!FINAL) {
        for (int i = F.tid; i < 1024 * 8; i += 512) WDT[i] = ((const float*)F.in[I_WIN])[(size_t)l * DM * DIN + (size_t)(i >> 3) * DIN + DT_COL + (i & 7)];
        __syncthreads();
    }
    const float* mod_cur = WSP(float, WS_MOD) + (size_t)(FINAL ? 0 : l) * 2 * 6144;
    const float* mod_prev = WSP(float, WS_MOD) + (size_t)(l > 0 ? l - 1 : 0) * 2 * 6144;
    const int lane = F.lane;
    for (int r = F.wave; r < RPB; r += 8) {
        const int row = F.bid * RPB + r; if (row >= NT) break;
        const int v = row < CTX ? 1 : 0;
        if (FINAL && v) continue;
        f32x4 x[4];
        if (l == 0) {
            const float* src = v ? ((const float*)F.in[I_CTX]) + (size_t)row * DM : ((const float*)F.in[I_X]) + (size_t)(row - CTX) * DM;
#pragma unroll
            for (int i = 0; i < 4; ++i) x[i] = *(const f32x4*)(src + 256 * i + 4 * lane);
        } else {
            const float* x1 = WSP(float, WS_XA) + (size_t)row * DM;
            const int* tope = WSP(int, WS_TOPE) + (size_t)row * 4; const int* topp = WSP(int, WS_TOPP) + (size_t)row * 4; const float* gates = WSP(float, WS_TOPG) + (size_t)row * 4;
            const float* g2 = mod_prev + (size_t)v * 6144 + 5 * 1024;
            int sl[4]; float ga[4];
#pragma unroll
            for (int k = 0; k < 4; ++k) { sl[k] = PSTL[tope[k]] + topp[k]; ga[k] = gates[k]; }
#pragma unroll
            for (int i = 0; i < 4; ++i) { const int col = 256 * i + 4 * lane; f32x4 acc = {0.f, 0.f, 0.f, 0.f};
#pragma unroll
                for (int k = 0; k < 4; ++k) { const u32x2 y = *(const u32x2*)(WSP(bf16_t, WS_YB) + (size_t)sl[k] * DM + col);
                    acc[0] += ga[k] * bflo(y[0]); acc[1] += ga[k] * bfhi(y[0]); acc[2] += ga[k] * bflo(y[1]); acc[3] += ga[k] * bfhi(y[1]); }
                x[i] = *(const f32x4*)(x1 + col) + *(const f32x4*)(g2 + col) * acc;
                if (!FINAL) *(f32x4*)(WSP(float, WS_XB) + (size_t)row * DM + col) = x[i]; }
        }
        float ss = 0.f;
#pragma unroll
        for (int i = 0; i < 4; ++i) ss += x[i][0] * x[i][0] + x[i][1] * x[i][1] + x[i][2] * x[i][2] + x[i][3] * x[i][3];
        ss = wave_sum(ss);
        const float rs = __builtin_amdgcn_rsqf(ss * (1.f / 1024.f) + EPS);
        if (FINAL) {
#pragma unroll
            for (int i = 0; i < 4; ++i) { const int col = 256 * i + 4 * lane; *(f32x4*)(F.out + (size_t)(row - CTX) * DM + col) = x[i] * rs * *(const f32x4*)(((const float*)F.in[I_FNW]) + col); }
        } else {
            const float* nw = ((const float*)F.in[I_N1W]) + (size_t)l * DM; const float* sh = mod_cur + (size_t)v * 6144; const float* sc = sh + 1024;
            float d[8] = {0.f, 0.f, 0.f, 0.f, 0.f, 0.f, 0.f, 0.f};
#pragma unroll
            for (int i = 0; i < 4; ++i) { const int col = 256 * i + 4 * lane;
                const f32x4 h = x[i] * rs * *(const f32x4*)(nw + col) * (*(const f32x4*)(sc + col) + 1.f) + *(const f32x4*)(sh + col);
                u32x2 o; o[0] = pk2(h[0], h[1]); o[1] = pk2(h[2], h[3]);
                *(u32x2*)(WSP(bf16_t, WS_H) + (size_t)row * DM + col) = o;
#pragma unroll
                for (int c = 0; c < 4; ++c) { const f32x4 w0 = *(const LAS f32x4*)(WDT + (col + c) * 8), w1 = *(const LAS f32x4*)(WDT + (col + c) * 8 + 4);
#pragma unroll
                    for (int j = 0; j < 4; ++j) { d[j] += h[c] * w0[j]; d[4 + j] += h[c] * w1[j]; } } }
#pragma unroll
            for (int j = 0; j < 8; ++j) d[j] = wave_sum(d[j]);
            if (lane == 0) { float* o = WSP(float, WS_DTRAW) + (size_t)row * 8;
                *(f32x4*)o = (f32x4){d[0], d[1], d[2], d[3]}; *(f32x4*)(o + 4) = (f32x4){d[4], d[5], d[6], d[7]}; }
        }
    }
    __syncthreads();
}

constexpr int WR_PITCH = 36;
DI void p7a_router(const Frame& F, int l, int rep = 0) {
    LAS float* WR = (LAS float*)F.lds;
    LAS int* CNT = (LAS int*)(F.lds + 1024 * WR_PITCH * 4);
    LAS int* BASE = CNT + 32;
    LAS int* RI = BASE + 32;
    for (int i = F.tid; i < 1024 * 8; i += 512) *(LAS f32x4*)(WR + (i >> 3) * WR_PITCH + 4 * (i & 7)) = *(const f32x4*)(((const float*)F.in[I_WR]) + (size_t)l * DM * 32 + 4 * i);
    if (F.tid < 32) CNT[F.tid] = 0;
    __syncthreads();
    const int lane = F.lane;
    const float* mod = WSP(float, WS_MOD) + (size_t)l * 2 * 6144;
    const float* nw = ((const float*)F.in[I_N2W]) + (size_t)l * DM;
    const float br = ((const float*)F.in[I_BR])[(size_t)l * 32 + ((((lane >> 3) & 1) << 4) | (((lane >> 2) & 1) << 3) | (((lane >> 1) & 1) << 2) | ((lane & 1) << 1) | ((lane >> 5) & 1))];
    auto finish_row = [&](const f32x4 (&lgv)[8], int r, bool valid) __attribute__((always_inline)) {
        float lg[32];
#pragma unroll
        for (int q = 0; q < 8; ++q) { lg[4 * q] = lgv[q][0]; lg[4 * q + 1] = lgv[q][1]; lg[4 * q + 2] = lgv[q][2]; lg[4 * q + 3] = lgv[q][3]; }
        float a16[16], a8[8], a4[4], a2[2], a1;
        { const bool up = lane & 8;
#pragma unroll
          for (int j = 0; j < 16; ++j) { const float send = up ? lg[j] : lg[16 + j]; const float keep = up ? lg[16 + j] : lg[j]; a16[j] = keep + dppf<0x140>(send); } }
        { const bool up = lane & 4;
#pragma unroll
          for (int j = 0; j < 8; ++j) { const float send = up ? a16[j] : a16[8 + j]; const float keep = up ? a16[8 + j] : a16[j]; a8[j] = keep + dppf<0x141>(send); } }
        { const bool up = lane & 2;
#pragma unroll
          for (int j = 0; j < 4; ++j) { const float send = up ? a8[j] : a8[4 + j]; const float keep = up ? a8[4 + j] : a8[j]; a4[j] = keep + dppf<0x4E>(send); } }
        { const bool up = lane & 1;
#pragma unroll
          for (int j = 0; j < 2; ++j) { const float send = up ? a4[j] : a4[2 + j]; const float keep = up ? a4[2 + j] : a4[j]; a2[j] = keep + dppf<0xB1>(send); } }
        { const bool up = lane & 32; const float send = up ? a2[0] : a2[1]; const float keep = up ? a2[1] : a2[0]; a1 = keep + __shfl_xor(send, 32); }
        a1 += __shfl_xor(a1, 16);
        const int myexp = (((lane >> 3) & 1) << 4) | (((lane >> 2) & 1) << 3) | (((lane >> 1) & 1) << 2) | ((lane & 1) << 1) | ((lane >> 5) & 1);
        float val = a1 + br;
        int te[4]; float tv[4];
#pragma unroll
        for (int k = 0; k < 4; ++k) { const float m = wave_max(val); const unsigned long long bal = __ballot(val == m); const int sel = (int)__ffsll((long long)bal) - 1;
            te[k] = (((sel >> 3) & 1) << 4) | (((sel >> 2) & 1) << 3) | (((sel >> 1) & 1) << 2) | ((sel & 1) << 1) | ((sel >> 5) & 1); tv[k] = m; if (myexp == te[k]) val = -INFINITY; }
        if (lane == 0 && valid) { float g[4], s = 0.f;
#pragma unroll
            for (int k = 0; k < 4; ++k) { g[k] = __expf(tv[k] - tv[0]); s += g[k]; }
#pragma unroll
            for (int k = 0; k < 4; ++k) { const int pos = atomicAdd((int*)&CNT[te[k]], 1); RI[(r * 4 + k) * 3 + 0] = te[k]; RI[(r * 4 + k) * 3 + 1] = pos; RI[(r * 4 + k) * 3 + 2] = __float_as_int(g[k] / s); } }
    };
    for (int r0 = F.wave; r0 < RPB; r0 += 16) {
        const int rowA = F.bid * RPB + r0; if (rowA >= NT) break;
        const bool hasB = (r0 + 8 < RPB) && (rowA + 8 < NT);
        const int rowB = hasB ? rowA + 8 : rowA;
        const float* xA = WSP(float, WS_XA) + (size_t)rowA * DM; const float* shA = mod + (size_t)(rowA < CTX ? 1 : 0) * 6144 + 3 * 1024; const float* scA = shA + 1024;
        const float* xB = WSP(float, WS_XA) + (size_t)rowB * DM; const float* shB = mod + (size_t)(rowB < CTX ? 1 : 0) * 6144 + 3 * 1024; const float* scB = shB + 1024;
        f32x4 xa[4], xb[4]; float ssA = 0.f, ssB = 0.f;
#pragma unroll
        for (int i = 0; i < 4; ++i) { xa[i] = *(const f32x4*)(xA + 256 * i + 4 * lane); xb[i] = *(const f32x4*)(xB + 256 * i + 4 * lane);
            ssA += xa[i][0] * xa[i][0] + xa[i][1] * xa[i][1] + xa[i][2] * xa[i][2] + xa[i][3] * xa[i][3];
            ssB += xb[i][0] * xb[i][0] + xb[i][1] * xb[i][1] + xb[i][2] * xb[i][2] + xb[i][3] * xb[i][3]; }
        ssA = wave_sum(ssA); ssB = wave_sum(ssB);
        const float rsA = __builtin_amdgcn_rsqf(ssA * (1.f / 1024.f) + EPS), rsB = __builtin_amdgcn_rsqf(ssB * (1.f / 1024.f) + EPS);
        f32x4 lgA[8], lgB[8];
#pragma unroll
        for (int q = 0; q < 8; ++q) { lgA[q] = (f32x4){0.f, 0.f, 0.f, 0.f}; lgB[q] = (f32x4){0.f, 0.f, 0.f, 0.f}; }
#pragma unroll
        for (int i = 0; i < 4; ++i) { const int col = 256 * i + 4 * lane; const f32x4 nwv = *(const f32x4*)(nw + col);
            xa[i] = xa[i] * rsA * nwv * (*(const f32x4*)(scA + col) + 1.f) + *(const f32x4*)(shA + col);
            xb[i] = xb[i] * rsB * nwv * (*(const f32x4*)(scB + col) + 1.f) + *(const f32x4*)(shB + col);
            { u32x2 o; o[0] = pk2(xa[i][0], xa[i][1]); o[1] = pk2(xa[i][2], xa[i][3]); *(u32x2*)(WSP(bf16_t, WS_H) + (size_t)rowA * DM + col) = o; }
            if (hasB) { u32x2 o; o[0] = pk2(xb[i][0], xb[i][1]); o[1] = pk2(xb[i][2], xb[i][3]); *(u32x2*)(WSP(bf16_t, WS_H) + (size_t)rowB * DM + col) = o; } }
        __builtin_amdgcn_sched_barrier(0);
#pragma unroll
        for (int i = 0; i < 4; ++i) { const int col = 256 * i + 4 * lane;
#pragma unroll
            for (int c = 0; c < 4; ++c) {
                f32x4 w0[8];
#pragma unroll
                for (int q = 0; q < 8; ++q) w0[q] = *(const LAS f32x4*)(WR + (col + c) * WR_PITCH + 4 * q);
#pragma unroll
                for (int q = 0; q < 8; ++q) { lgA[q] += w0[q] * xa[i][c]; lgB[q] += w0[q] * xb[i][c]; }
#pragma unroll
                for (int q = 0; q < 8; ++q) asm volatile("" : "+v"(lgA[q]), "+v"(lgB[q]));
                } }
        finish_row(lgA, r0, true);
        finish_row(lgB, r0 + 8, hasB);
    }
    __syncthreads();
    if (F.tid < 32) BASE[F.tid] = (int)__hip_atomic_fetch_add(WSP(unsigned, WS_CTL) + (rep ? 4500 : CW_CNT) + l * 32 + F.tid, (unsigned)CNT[F.tid], __ATOMIC_RELAXED, __HIP_MEMORY_SCOPE_AGENT);
    __syncthreads();
    if (F.tid < RPB * 4) { const int r = F.tid >> 2, row = F.bid * RPB + r;
        if (row < NT) { const int e = RI[F.tid * 3], pos = RI[F.tid * 3 + 1];
            WSP(int, WS_TOPE)[(size_t)row * 4 + (F.tid & 3)] = e; WSP(int, WS_TOPP)[(size_t)row * 4 + (F.tid & 3)] = BASE[e] + pos; WSP(int, WS_TOPS)[(size_t)e * NT + BASE[e] + pos] = row; WSP(int, WS_TOPG)[(size_t)row * 4 + (F.tid & 3)] = RI[F.tid * 3 + 2]; } }
    __syncthreads();
}

DI int moe_tables(const Frame& F, int l) {
    LAS int* PST = (LAS int*)(F.lds + LDS_MISC);
    LAS int* T2E = PST + 64;
    __syncthreads();
    if (F.tid < 64) { const int e = F.tid & 31; const int c = (int)__hip_atomic_load(WSP(unsigned, WS_CTL) + CW_CNT + l * 32 + e, __ATOMIC_RELAXED, __HIP_MEMORY_SCOPE_AGENT);
        const int pad = (c + 255) & ~255; int incl = pad;
#pragma unroll
        for (int o = 1; o < 32; o <<= 1) { const int t = __shfl_up(incl, o, 32); if (e >= o) incl += t; }
        if (F.tid < 32) { PST[e] = incl - pad; if (e == 31) PST[32] = incl; PST[64 + 300 + e] = c; } }
    __syncthreads();
    const int ntiles = PST[32] >> 8;
    for (int r = F.tid; r < ntiles; r += 512) { int e = 0;
        for (int q = 1; q < 32; ++q) if (PST[q] <= r * 256) e = q;
        T2E[r] = e; }
    __syncthreads();
    return ntiles;
}
struct MoeOrder {
    int nN, ntiles, G, c; const LAS int* t2e; long estride;
#ifndef MOE_XMAJOR
#define MOE_XMAJOR 1
#endif
    DI bool unit(int i, int& pm, int& pn) const { const int j = c >> 3, per = G / nN, sh = (nN == 8) ? 3 : 2;
        pm = MOE_XMAJOR ? i * per + (c & 7) * (per >> 3) + (j >> sh) : i * per + (j >> sh) * 8 + (c & 7); pn = j & (nN - 1); return pm < ntiles; }
    DI bool next(int i, pg8::Unit& u) const { int pm, pn; if (!unit(i, pm, pn)) return false; u.pm = pm; u.pn = pn; u.boff = (long)t2e[pm] * estride; return true; }
    DI void a_ready(const pg8::Unit&) const {}
    DI void done(const pg8::Unit&) const {}
};
#ifndef STAG_INTRA
#define STAG_INTRA 1
#endif
DI void xcd_stagger(const Frame& F, int step_ticks) {
    const unsigned dl = (unsigned)(STAG_INTRA ? (F.bid >> 3) : (F.bid & 7)) * (unsigned)step_ticks;
    const unsigned long long t0 = __builtin_amdgcn_s_memrealtime();
    while ((unsigned)(__builtin_amdgcn_s_memrealtime() - t0) < dl) __builtin_amdgcn_s_sleep(32);
}
DI void moe_rows(const Frame& F, int l, int ntiles, int nN) {
    const LAS int* PST = (const LAS int*)(F.lds + LDS_MISC); const LAS int* T2E = PST + 64; const LAS int* CNTL = PST + 64 + 300;
    LAS int* ROWS = (LAS int*)(F.lds + LDS_MISC + 2048);
    const MoeOrder S{nN, ntiles, F.G, F.bid, T2E, 0};
    (void)l;
    int val[5]; bool ok[5], inb[5];
#pragma unroll
    for (int k = 0; k < 5; ++k) { const int idx = F.tid + 512 * k, i = idx >> 8, r = idx & 255; int pm, pn;
        ok[k] = S.unit(i, pm, pn); const int e = T2E[ok[k] ? pm : 0], p = ((ok[k] ? pm : 0) - (PST[e] >> 8)) * 256 + r;
        inb[k] = ok[k] && p < CNTL[e]; val[k] = WSP(int, WS_TOPS)[(size_t)e * NT + (inb[k] ? p : 0)]; }
#pragma unroll
    for (int k = 0; k < 5; ++k) if (ok[k]) ROWS[F.tid + 512 * k] = inb[k] ? val[k] : 0;
    __syncthreads();
}

constexpr int LDS_BIASL = LDS_MISC + 2048 + 10 * 1024;
DI void moe_bias(const Frame& F, int ntiles, int nN, const float* bias, int estride) {
    const LAS int* PST = (const LAS int*)(F.lds + LDS_MISC); const LAS int* T2E = PST + 64;
    LAS float* BL = (LAS float*)(F.lds + LDS_BIASL);
    const MoeOrder S{nN, ntiles, F.G, F.bid, T2E, 0};
    float val[5]; bool ok[5];
#pragma unroll
    for (int k = 0; k < 5; ++k) { const int idx = F.tid + 512 * k, i = idx >> 8, r = idx & 255; int pm, pn;
        ok[k] = S.unit(i, pm, pn); val[k] = bias[(size_t)T2E[ok[k] ? pm : 0] * estride + (ok[k] ? pn : 0) * 256 + r]; }
#pragma unroll
    for (int k = 0; k < 5; ++k) if (ok[k]) BL[F.tid + 512 * k] = val[k];
    __syncthreads();
}

#ifndef EPI_NT
#define EPI_NT 0
#endif
#if EPI_NT
#define EPI_STORE(p, v) __builtin_nontemporal_store((v), (p))
#else
#define EPI_STORE(p, v) (*(p) = (v))
#endif
struct EpiU {
    static constexpr bool PERM = true, AFTER_DRAIN = false;
    bf16_t* O; int ldc; bf16_t* us5;
    DI void operator()(const pg8::f32x4 (&acc)[2][2][4][2], const pg8::Unit& u, int wr, int wc, int fr, int fq) const {
        const int row0 = u.pm * 256 + wr * 64 + fr, col0 = u.pn * 256 + wc * 32 + 8 * fq;
        const bool s5 = (u.pn == U_S5 / 256);
#pragma unroll
        for (int ai = 0; ai < 2; ++ai)
#pragma unroll
            for (int m = 0; m < 4; ++m) { const int row = row0 + ai * 128 + m * 16; bf16_t* rowp = O + (size_t)row * ldc + col0;
#pragma unroll
                for (int bj = 0; bj < 2; ++bj) { const pg8::f32x4 v0 = acc[ai][bj][m][0], v1 = acc[ai][bj][m][1];
                    u32x4 w; w[0] = pk2(v0[0], v0[1]); w[1] = pk2(v0[2], v0[3]); w[2] = pk2(v1[0], v1[1]); w[3] = pk2(v1[2], v1[3]);
                    const int cl = wc * 32 + 8 * fq + bj * 128;
                    bf16_t* dst = s5 ? us5 + ((size_t)(cl >> 4) * NT + row) * 16 + (cl & 15) : rowp + bj * 128;
                    EPI_STORE((u32x4*)dst, w); } }
    }
};
struct EpiRes {
    static constexpr bool PERM = false, AFTER_DRAIN = false;
    float* C; const float* res_lat; const float* res_ctx; const float* g1;
    DI void operator()(const pg8::f32x4 (&acc)[2][2][4][2], const pg8::Unit& u, int wr, int wc, int fr, int fq) const {
        const int row0 = CTX + u.pm * 256 + wr * 64 + fr, col0 = u.pn * 256 + wc * 32 + 4 * fq;
        const bool isctx = false;
        const float* g = g1;
        pg8::f32x4 gv[2][2];
#pragma unroll
        for (int bj = 0; bj < 2; ++bj)
#pragma unroll
            for (int n = 0; n < 2; ++n) gv[bj][n] = *(const pg8::f32x4*)(g + col0 + bj * 128 + n * 16);
#pragma unroll
        for (int ai = 0; ai < 2; ++ai)
#pragma unroll
            for (int m = 0; m < 4; ++m) { const int row = row0 + ai * 128 + m * 16;
                const float* rp = isctx ? res_ctx + (size_t)row * DM : res_lat + (size_t)(row - CTX) * DM; float* cp = C + (size_t)row * DM;
#pragma unroll
                for (int bj = 0; bj < 2; ++bj)
#pragma unroll
                    for (int n = 0; n < 2; ++n) { const int col = col0 + bj * 128 + n * 16;
                        *(pg8::f32x4*)(cp + col) = *(const pg8::f32x4*)(rp + col) + gv[bj][n] * acc[ai][bj][m][n]; } }
    }
};
struct EpiAct {
    static constexpr bool PERM = true, AFTER_DRAIN = false;
    bf16_t* O; const LAS float* biasl;
    mutable int cnt = 0;
    DI void operator()(const pg8::f32x4 (&acc)[2][2][4][2], const pg8::Unit& u, int wr, int wc, int fr, int fq) const {
        const int row0 = u.pm * 256 + wr * 64 + fr, j0 = u.pn * 128 + wc * 32 + 8 * fq;
        const LAS float* b = biasl + cnt * 256 + 2 * (wc * 32 + 8 * fq); ++cnt;
        pg8::f32x4 bg[2], bu[2];
#pragma unroll
        for (int n = 0; n < 2; ++n) { const pg8::f32x4 t0 = *(const LAS pg8::f32x4*)(b + 8 * n), t1 = *(const LAS pg8::f32x4*)(b + 8 * n + 4);
            bg[n] = (pg8::f32x4){t0[0], t0[2], t1[0], t1[2]}; bu[n] = (pg8::f32x4){t0[1], t0[3], t1[1], t1[3]}; }
#pragma unroll
        for (int ai = 0; ai < 2; ++ai)
#pragma unroll
            for (int m = 0; m < 4; ++m) { bf16_t* rowp = O + (size_t)(row0 + ai * 128 + m * 16) * DM + j0; float a[8];
#pragma unroll
                for (int n = 0; n < 2; ++n) { const pg8::f32x4 gq = acc[ai][0][m][n] + bg[n], uq = acc[ai][1][m][n] + bu[n];
#pragma unroll
                    for (int j = 0; j < 4; ++j) { const float gg = fminf(gq[j], 7.f), uu = fminf(fmaxf(uq[j], -7.f), 7.f); a[4 * n + j] = gg * sigmoid_f(1.702f * gg) * (uu + 1.f); } }
                u32x4 w; w[0] = pk2(a[0], a[1]); w[1] = pk2(a[2], a[3]); w[2] = pk2(a[4], a[5]); w[3] = pk2(a[6], a[7]); EPI_STORE((u32x4*)rowp, w); }
    }
};
struct EpiDown {
    static constexpr bool PERM = true, AFTER_DRAIN = false;
    bf16_t* O; const LAS float* biasl;
    int skip = 0;
    bf16_t* dump = nullptr;
    mutable int cnt = 0;
    DI void operator()(const pg8::f32x4 (&acc)[2][2][4][2], const pg8::Unit& u, int wr, int wc, int fr, int fq) const {
#ifdef PH_REP
        if (skip == 3) {
            bf16_t* dp = dump + ((size_t)(blockIdx.x * 8 + wr * 4 + wc) * 1024 + (fq * 16 + fr)) * 8;
#pragma unroll
            for (int a = 0; a < 2; ++a)
#pragma unroll
                for (int m = 0; m < 4; ++m)
#pragma unroll
                    for (int b = 0; b < 2; ++b) { const pg8::f32x4 v0 = acc[a][b][m][0], v1 = acc[a][b][m][1];
                        u32x4 w; w[0] = pk2(v0[0], v0[1]); w[1] = pk2(v0[2], v0[3]); w[2] = pk2(v1[0], v1[1]); w[3] = pk2(v1[2], v1[3]);
                        *(u32x4*)(dp + ((a * 4 + m) * 2 + b) * 512) = w; }
            return; }
        if (skip == 4) {
            bf16_t* dp = dump + (size_t)blockIdx.x * 65536 + (wr * 64 + fr) * 256 + wc * 32 + 8 * fq;
#pragma unroll
            for (int a = 0; a < 2; ++a)
#pragma unroll
                for (int m = 0; m < 4; ++m)
#pragma unroll
                    for (int b = 0; b < 2; ++b) { const pg8::f32x4 v0 = acc[a][b][m][0], v1 = acc[a][b][m][1];
                        u32x4 w; w[0] = pk2(v0[0], v0[1]); w[1] = pk2(v0[2], v0[3]); w[2] = pk2(v1[0], v1[1]); w[3] = pk2(v1[2], v1[3]);
                        *(u32x4*)(dp + (a * 128 + m * 16) * 256 + b * 128) = w; }
            return; }
        if (skip == 1) {
#pragma unroll
            for (int a = 0; a < 2; ++a)
#pragma unroll
                for (int b = 0; b < 2; ++b)
#pragma unroll
                    for (int m = 0; m < 4; ++m) asm volatile("" :: "v"(acc[a][b][m][0]), "v"(acc[a][b][m][1]));
            return; }
#endif
        const int row0 = u.pm * 256 + wr * 64 + fr, col0 = u.pn * 256 + wc * 32 + 8 * fq;
        const LAS float* b = biasl + cnt * 256 - u.pn * 256; ++cnt;
        pg8::f32x4 bv[2][2];
#pragma unroll
        for (int bj = 0; bj < 2; ++bj)
#pragma unroll
            for (int n = 0; n < 2; ++n) bv[bj][n] = *(const LAS pg8::f32x4*)(b + col0 + bj * 128 + 4 * n);
#pragma unroll
        for (int ai = 0; ai < 2; ++ai)
#pragma unroll
            for (int m = 0; m < 4; ++m) { bf16_t* rowp = O + (size_t)(row0 + ai * 128 + m * 16) * DM + col0;
#pragma unroll
                for (int bj = 0; bj < 2; ++bj) { const pg8::f32x4 v0 = acc[ai][bj][m][0] + bv[bj][0], v1 = acc[ai][bj][m][1] + bv[bj][1];
                    u32x4 w; w[0] = pk2(v0[0], v0[1]); w[1] = pk2(v0[2], v0[3]); w[2] = pk2(v1[0], v1[1]); w[3] = pk2(v1[2], v1[3]);
                    if (skip == 2) asm volatile("" :: "v"(w)); else EPI_STORE((u32x4*)(rowp + bj * 128), w); } }
    }
};

DI void outproj_ctx(const Frame& F, int l, const float* res_ctx) {
    if (F.bid >= 256) return;
    const int mt = F.bid >> 5, nt = F.bid & 31, lane = F.lane, r = lane & 31, h = lane >> 5;
    const bf16_t* A = WSP(bf16_t, WS_MIX) + (size_t)(mt * 32 + r) * DM + F.wave * 128 + 8 * h;
    const bf16_t* B = WSP(bf16_t, WS_WOUT) + (size_t)l * DM * DM + (size_t)(nt * 32 + r) * DM + F.wave * 128 + 8 * h;
    f32x16 acc = splat16(0.f);
#pragma unroll
    for (int ks = 0; ks < 8; ++ks) acc = mfma32(ld8g(A + ks * 16), ld8g(B + ks * 16), acc);
    LAS float* R = (LAS float*)F.lds;
    __syncthreads();
#pragma unroll
    for (int i = 0; i < 16; ++i) R[(F.wave * 16 + i) * 64 + lane] = acc[i];
    __syncthreads();
    for (int e = F.tid; e < 1024; e += 512) { const int i = e >> 6, ln = e & 63; float s = 0.f;
#pragma unroll
        for (int w = 0; w < 8; ++w) s += R[(w * 16 + i) * 64 + ln];
        const int row = mt * 32 + crow(i, ln >> 5), col = nt * 32 + (ln & 31);
        WSP(float, WS_XA)[(size_t)row * DM + col] = res_ctx[(size_t)row * DM + col] + WSP(float, WS_MOD)[(size_t)l * 2 * 6144 + 6144 + 2 * 1024 + col] * s; }
    __syncthreads();
}

template <int DIM> DI void rope_vec(float (&v)[DIM], const f32x2* tab_row, const f32x2* tab_col) {
    constexpr int Q = DIM / 4;
#pragma unroll
    for (int i = 0; i < Q; ++i) { const f32x2 r = tab_row[i], c = tab_col[i];
        const float a = v[i], b = v[Q + i]; v[i] = a * r.x - b * r.y; v[Q + i] = a * r.y + b * r.x;
        const float a2 = v[2 * Q + i], b2 = v[3 * Q + i]; v[2 * Q + i] = a2 * c.x - b2 * c.y; v[3 * Q + i] = a2 * c.y + b2 * c.x; }
}
template <int DIM> DI void load_vec(const bf16_t* p, float (&v)[DIM]) {
#pragma unroll
    for (int i = 0; i < DIM / 8; ++i) { const u32x4 w = *(const u32x4*)(p + 8 * i);
#pragma unroll
        for (int j = 0; j < 4; ++j) { v[8 * i + 2 * j] = bflo(w[j]); v[8 * i + 2 * j + 1] = bfhi(w[j]); } }
}
template <int DIM> DI float store_vec(bf16_t* p, const float (&v)[DIM]) {
    float ss = 0.f;
#pragma unroll
    for (int i = 0; i < DIM / 8; ++i) { u32x4 w;
#pragma unroll
        for (int j = 0; j < 4; ++j) { w[j] = pk2(v[8 * i + 2 * j], v[8 * i + 2 * j + 1]); const float a = bflo(w[j]), b = bfhi(w[j]); ss += a * a + b * b; }
        *(u32x4*)(p + 8 * i) = w; }
    return ss;
}
DI void p3_attn_prep(const Frame& F, int l, int item) {
    LAS unsigned* KMX = (LAS unsigned*)(F.lds + LDS_MISC);
    LAS bf16_t* VS = (LAS bf16_t*)F.lds;
    const int tid = F.tid, tok0 = item * 64;
    if (tid < 32) KMX[tid] = 0u;
    const bf16_t* U = WSP(bf16_t, WS_U);
    for (int i = tid; i < 64 * 48; i += 512) { const int t = i / 48, c8 = i % 48; const int col = c8 < 32 ? U_DV + 8 * c8 : U_GV + 8 * (c8 - 32);
        *(LAS u32x4*)(VS + t * 384 + 8 * c8) = *(const u32x4*)(U + (size_t)(tok0 + t) * NU + col); }
    __syncthreads();
    const f32x2* ropeD = WSP(f32x2, WS_ROPE); const f32x2* ropeG = ropeD + 256 * 8;
    const float qs_d = 0.17677669529663687f * LOG2E, qs_g = 0.125f * LOG2E;
    for (int task = tid; task < 64 * 22; task += 512) {
        int t, vi;
        if (task < 1024) { t = task & 63; vi = task >> 6; } else if (task < 1280) { t = task & 63; vi = 16 + ((task - 1024) >> 6); } else { t = task & 63; vi = 20 + ((task - 1280) >> 6); }
        const int tok = tok0 + t; const bool lat = tok >= CTX; const int pos = tok - CTX, pr = lat ? pos >> 6 : 0, pc = lat ? pos & 63 : 0;
        const bf16_t* urow = U + (size_t)tok * NU;
        if (vi < 16) {
            const bool isk = vi >= 8; const int hm = vi & 7, h = hm >> 1, m = hm & 1;
            float v[32]; load_vec<32>(urow + (isk ? U_DK : U_DQ) + hm * 32, v);
            if (lat) rope_vec<32>(v, ropeD + pr * 8, ropeD + pc * 8);
            if (!isk) {
#pragma unroll
                for (int i = 0; i < 32; ++i) v[i] *= qs_d;
                const float ss = store_vec<32>(WSP(bf16_t, WS_QD) + ((size_t)h * NT + tok) * 64 + m * 32, v);
                WSP(float, WS_QND)[((size_t)h * 2 + m) * NT + tok] = sqrtf(ss);
                __hip_atomic_fetch_max(KMX + 10 + hm, __float_as_uint(ss), __ATOMIC_RELAXED, __HIP_MEMORY_SCOPE_WORKGROUP);
            } else {
                const float ss = store_vec<32>(WSP(bf16_t, WS_KD) + ((size_t)h * NT + tok) * 64 + m * 32, v);
                __hip_atomic_fetch_max(KMX + hm, __float_as_uint(ss), __ATOMIC_RELAXED, __HIP_MEMORY_SCOPE_WORKGROUP);
            }
        } else {
            const bool isk = vi >= 20; const int h = isk ? vi - 20 : vi - 16;
            float v[64]; load_vec<64>(urow + (isk ? U_GK : U_GQ) + h * 64, v);
            float ss = 0.f;
#pragma unroll
            for (int i = 0; i < 64; ++i) ss += v[i] * v[i];
            const float rs = __builtin_amdgcn_rsqf(ss * (1.f / 64.f) + EPS);
            const float* nw = ((const float*)F.in[isk ? I_KNW : I_QNW]) + (size_t)l * 64;
#pragma unroll
            for (int i = 0; i < 64; ++i) v[i] = v[i] * rs * nw[i];
            if (lat) rope_vec<64>(v, ropeG + pr * 16, ropeG + pc * 16);
            if (!isk) {
#pragma unroll
                for (int i = 0; i < 64; ++i) v[i] *= qs_g;
                const float s2 = store_vec<64>(WSP(bf16_t, WS_QG) + ((size_t)h * NT + tok) * 64, v);
                WSP(float, WS_QNG)[(size_t)h * NT + tok] = sqrtf(s2);
                __hip_atomic_fetch_max(KMX + 18 + h, __float_as_uint(s2), __ATOMIC_RELAXED, __HIP_MEMORY_SCOPE_WORKGROUP);
            } else {
                const float s2 = store_vec<64>(WSP(bf16_t, WS_KG) + ((size_t)h * NT + tok) * 64, v);
                __hip_atomic_fetch_max(KMX + 8 + h, __float_as_uint(s2), __ATOMIC_RELAXED, __HIP_MEMORY_SCOPE_WORKGROUP);
            }
        }
    }
    for (int i = tid; i < 384 * 8; i += 512) { const int c = i >> 3, o = i & 7; u32x4 w;
#pragma unroll
        for (int j = 0; j < 4; ++j) { const unsigned lo = VS[(8 * o + 2 * j) * 384 + c], hi = VS[(8 * o + 2 * j + 1) * 384 + c]; w[j] = lo | (hi << 16); }
        bf16_t* dst = c < 256 ? WSP(bf16_t, WS_VTD) + (size_t)c * NT : WSP(bf16_t, WS_VTG) + (size_t)(c - 256) * NT;
        *(u32x4*)(dst + tok0 + 8 * o) = w; }
    __syncthreads();
    if (tid < 22) __hip_atomic_fetch_max(WSP(unsigned, WS_CTL) + CW_KMAX + l * 32 + tid, KMX[tid], __ATOMIC_RELAXED, __HIP_MEMORY_SCOPE_AGENT);
    __syncthreads();
}

constexpr int UBP = 1032;
template <bool FROM_U>
DI void s5_stage_u(const Frame& F, int g, int nt) {
    LAS bf16_t* UB = (LAS bf16_t*)F.lds;
    __syncthreads();
    for (int i = F.tid; i < 32 * 128; i += 512) { const int n = i >> 7, p = i & 127; const int chunk = nt * 32 + n, cc = chunk < NC5 ? chunk : NC5 - 1;
        if (FROM_U) { const int s = p >> 1, hh = p & 1; *(LAS u32x4*)(UB + n * UBP + s * 16 + 8 * hh) = *(const u32x4*)(WSP(bf16_t, WS_U) + (size_t)(cc * S5L + s) * NU + U_S5 + g * 16 + 8 * hh); }
        else *(LAS u32x4*)(UB + n * UBP + 8 * p) = *(const u32x4*)(WSP(bf16_t, WS_US5) + ((size_t)g * NT + (size_t)cc * S5L) * 16 + 8 * p); }
    __syncthreads();
}
constexpr int N_S5H = 16 * 9;
DI void p3_s5_hloc(const Frame& F, int l, int item) {
    const int g = item / 9, nt = item % 9, dir = F.wave >> 2, mt = F.wave & 3, lane = F.lane, r = lane & 31, h = lane >> 5;
    s5_stage_u<false>(F, g, nt);
    const LAS bf16_t* UB = (const LAS bf16_t*)F.lds + r * UBP + 8 * h;
    const bf16_t* E = WSP(bf16_t, WS_E5) + ((size_t)l * 16 + g) * 2 * 128 * 1024 + ((size_t)(dir * 4 + mt) * 64 * 64 + lane) * 8;
    f32x16 acc = splat16(0.f);
#pragma unroll 16
    for (int ks = 0; ks < 64; ++ks) acc = mfma32(ld8g(E + ks * 512), *(const LAS bf16x8*)(UB + ks * 16), acc);
    const int chunk = nt * 32 + r;
    if (chunk < NC5) { float* o = WSP(float, WS_HLOC) + (size_t)chunk * 4096 + (g * 2 + dir) * 128 + mt * 32;
#pragma unroll
        for (int i = 0; i < 16; ++i) o[crow(i, h)] = acc[i]; }
}

constexpr int SP = 136;
DI void p3_ssd_prep(const Frame& F, int l, int c) {
    LAS bf16_t* XT = (LAS bf16_t*)F.lds;
    LAS bf16_t* BT = XT + 256 * SP;
    LAS float* DTL = (LAS float*)(BT + 256 * SP);
    LAS float* CML = DTL + 8 * 128;
    LAS float* WG = CML + 8 * 128;
    const int tid = F.tid, lane = F.lane, tok0 = c * 128;
    const int seq_lo = c < 2 ? 0 : CTX, seq_hi = c < 2 ? CTX : NT;
    const bf16_t* U = WSP(bf16_t, WS_U);
    const float* cw = ((const float*)F.in[I_CONVW]) + (size_t)l * 3 * 768; const float* cb = ((const float*)F.in[I_CONVB]) + (size_t)l * 768;
    constexpr int RP = 264;
    LAS bf16_t* RAW = XT;
    LAS f32x4* CWS = (LAS f32x4*)(WG + 8 * 128);
#pragma unroll 1
    for (int sec = 1; sec < 3; ++sec) {
        __syncthreads();
        if (tid < 256) CWS[tid] = (f32x4){cw[sec * 256 + tid], cw[768 + sec * 256 + tid], cw[1536 + sec * 256 + tid], cb[sec * 256 + tid]};
        for (int i = tid; i < 130 * 32; i += 512) { const int rr = i >> 5, p = i & 31, tok = tok0 - 1 + rr;
            const u32x4 v = (tok >= seq_lo && tok < seq_hi) ? *(const u32x4*)(U + (size_t)tok * NU + U_XS + sec * 256 + 8 * p) : (u32x4){0u, 0u, 0u, 0u};
            *(LAS u32x4*)(RAW + rr * RP + 8 * p) = v; }
        __syncthreads();
        for (int task = tid; task < 128 * 32; task += 512) { const int t = task & 127, cg = task >> 7, tok = tok0 + t, chl = cg * 8, ch0 = sec * 256 + chl;
            const u32x4 xm = *(const LAS u32x4*)(RAW + t * RP + chl), x0 = *(const LAS u32x4*)(RAW + (t + 1) * RP + chl), xp = *(const LAS u32x4*)(RAW + (t + 2) * RP + chl);
            float y[8]; (void)ch0;
#pragma unroll
            for (int j = 0; j < 4; ++j) { const f32x4 c0 = CWS[chl + 2 * j], c1 = CWS[chl + 2 * j + 1];
                const float a0 = bflo(xm[j]) * c0[0] + bflo(x0[j]) * c0[1] + bflo(xp[j]) * c0[2] + c0[3];
                const float a1 = bfhi(xm[j]) * c1[0] + bfhi(x0[j]) * c1[1] + bfhi(xp[j]) * c1[2] + c1[3];
                y[2 * j] = silu_f(a0); y[2 * j + 1] = silu_f(a1); }
            u32x4 w;
#pragma unroll
            for (int j = 0; j < 4; ++j) w[j] = pk2(y[2 * j], y[2 * j + 1]);
            if (sec == 1) { *(u32x4*)(WSP(bf16_t, WS_BN) + (size_t)tok * 256 + chl) = w;
#pragma unroll
                for (int j = 0; j < 8; ++j) BT[(chl + j) * SP + t] = f2bf(y[j]);
            } else *(u32x4*)(WSP(bf16_t, WS_CN) + (size_t)tok * 256 + chl) = w; }
    }
    __syncthreads();
    if (tid < 256) CWS[tid] = (f32x4){cw[tid], cw[768 + tid], cw[1536 + tid], cb[tid]};
    __syncthreads();
    for (int task = tid; task < 128 * 32; task += 512) { const int t = task & 127, cg = task >> 7, tok = tok0 + t, ch0 = cg * 8;
        const u32x4 z4 = {0u, 0u, 0u, 0u};
        const u32x4 xm = (tok - 1 >= seq_lo) ? *(const u32x4*)(U + (size_t)(tok - 1) * NU + U_XS + ch0) : z4;
        const u32x4 x0 = *(const u32x4*)(U + (size_t)tok * NU + U_XS + ch0);
        const u32x4 xp = (tok + 1 < seq_hi) ? *(const u32x4*)(U + (size_t)(tok + 1) * NU + U_XS + ch0) : z4;
#pragma unroll
        for (int j = 0; j < 4; ++j) { const f32x4 c0 = CWS[ch0 + 2 * j], c1 = CWS[ch0 + 2 * j + 1];
            const float a0 = bflo(xm[j]) * c0[0] + bflo(x0[j]) * c0[1] + bflo(xp[j]) * c0[2] + c0[3];
            const float a1 = bfhi(xm[j]) * c1[0] + bfhi(x0[j]) * c1[1] + bfhi(xp[j]) * c1[2] + c1[3];
            XT[(ch0 + 2 * j) * SP + t] = f2bf(silu_f(a0)); XT[(ch0 + 2 * j + 1) * SP + t] = f2bf(silu_f(a1)); }
    }
    { const int j = F.wave, dir = j >> 2; const float bias = ((const float*)F.in[I_DTB])[(size_t)l * 8 + j], a = -__expf(((const float*)F.in[I_ALOG])[(size_t)l * 8 + j]);
      float e[2], dtv[2];
#pragma unroll
      for (int q = 0; q < 2; ++q) { const int li = 2 * lane + q, t = dir ? 127 - li : li;
          const float x = WSP(float, WS_DTRAW)[(size_t)(tok0 + t) * 8 + j] + bias; dtv[q] = x > 20.f ? x : log1pf(__expf(x)); e[q] = dtv[q] * a * LOG2E; }
      float s = e[0] + e[1];
#pragma unroll
      for (int o = 1; o < 64; o <<= 1) { const float tv = __shfl_up(s, o); if (lane >= o) s += tv; }
      const float c1 = s, c0 = s - e[1];
#pragma unroll
      for (int q = 0; q < 2; ++q) { const int li = 2 * lane + q, t = dir ? 127 - li : li; const float cv = q ? c1 : c0;
          DTL[j * 128 + t] = dtv[q]; CML[j * 128 + t] = cv;
          WSP(float, WS_DTV)[((size_t)c * 8 + j) * 128 + t] = dtv[q]; WSP(float, WS_CUM)[((size_t)c * 8 + j) * 128 + t] = cv; }
    }
    __syncthreads();
    for (int i = tid; i < 8 * 128; i += 512) { const int j = i >> 7; const float tot = CML[j * 128 + ((j >> 2) ? 0 : 127)]; WG[i] = DTL[i] * __builtin_amdgcn_exp2f(tot - CML[i]); }
    for (int i = tid; i < 256 * 16; i += 512) { const int ch = i >> 4, o = i & 15; *(u32x4*)(WSP(bf16_t, WS_XST) + ((size_t)c * 256 + ch) * 128 + 8 * o) = *(const LAS u32x4*)(XT + ch * SP + 8 * o); }
    __syncthreads();
    { const int j = F.wave, hh = j & 3, g = hh >> 1, r = lane & 31, h = lane >> 5;
      f32x16 acc[2][4];
#pragma unroll
      for (int a = 0; a < 2; ++a)
#pragma unroll
          for (int b = 0; b < 4; ++b) acc[a][b] = splat16(0.f);
#pragma unroll 1
      for (int ks = 0; ks < 8; ++ks) {
          const f32x4 w0 = *(const LAS f32x4*)(WG + j * 128 + ks * 16 + 8 * h), w1 = *(const LAS f32x4*)(WG + j * 128 + ks * 16 + 8 * h + 4);
          bf16x8 af[2], bfr[4];
#pragma unroll
          for (int a = 0; a < 2; ++a) { const u32x4 x = *(const LAS u32x4*)(XT + (hh * 64 + a * 32 + r) * SP + ks * 16 + 8 * h); u32x4 o;
              o[0] = pk2(bflo(x[0]) * w0[0], bfhi(x[0]) * w0[1]); o[1] = pk2(bflo(x[1]) * w0[2], bfhi(x[1]) * w0[3]);
              o[2] = pk2(bflo(x[2]) * w1[0], bfhi(x[2]) * w1[1]); o[3] = pk2(bflo(x[3]) * w1[2], bfhi(x[3]) * w1[3]); af[a] = __builtin_bit_cast(bf16x8, o); }
#pragma unroll
          for (int b = 0; b < 4; ++b) bfr[b] = *(const LAS bf16x8*)(BT + (g * 128 + b * 32 + r) * SP + ks * 16 + 8 * h);
#pragma unroll
          for (int a = 0; a < 2; ++a)
#pragma unroll
              for (int b = 0; b < 4; ++b) acc[a][b] = mfma32(af[a], bfr[b], acc[a][b]);
      }
      float* o = WSP(float, WS_SLOC) + ((size_t)c * 8 + j) * 64 * 128;
#pragma unroll
      for (int a = 0; a < 2; ++a)
#pragma unroll
          for (int b = 0; b < 4; ++b)
#pragma unroll
              for (int i = 0; i < 16; ++i) o[(a * 32 + crow(i, h)) * 128 + b * 32 + r] = acc[a][b][i];
    }
    __syncthreads();
}

DI void p4_s5_scan_el(const Frame& F, int l, int st);
DI void p4_ssd_scan(const Frame& F, int l) {
    if (F.tid >= 256) { if (F.tid < 264) { const int st = F.bid * 8 + (F.tid - 256); if (st < 2048) p4_s5_scan_el(F, l, st); } return; }
    const int el = F.bid * 256 + F.tid; if (el >= 65536) return;
    const int j = el >> 13;
    const int dir = j >> 2;
    const float* cum = WSP(float, WS_CUM); const float* sl = WSP(float, WS_SLOC); bf16_t* so = WSP(bf16_t, WS_SIN);
    const int eo = el & 8191;
    float s = 0.f;
#pragma unroll 26
    for (int i = 0; i < NCH; ++i) { const int c = dir ? (i < 2 ? 1 - i : NCH + 1 - i) : i;
        so[((size_t)c * 8 + j) * 8192 + eo] = f2bf(s);
        const float tot = cum[((size_t)c * 8 + j) * 128 + (dir ? 0 : 127)];
        s = s * __builtin_amdgcn_exp2f(tot) + sl[((size_t)c * 8 + j) * 8192 + eo]; }
}
DI void p4_s5_scan_el(const Frame& F, int l, int st) {
    const int g = st >> 7, dir = (st >> 6) & 1, p = st & 63;
    const f32x2 ap = WSP(f32x2, WS_APOW)[((size_t)l * 16 + g) * 128 + dir * 64 + p];
    const float* hl = WSP(float, WS_HLOC) + (g * 2 + dir) * 128 + p; bf16_t* ho = WSP(bf16_t, WS_HIN) + (g * 2 + dir) * 128 + p;
    f32x2 s = {0.f, 0.f};
#pragma unroll 26
    for (int i = 0; i < NC5; ++i) { const int c = dir ? (i < 4 ? 3 - i : NC5 + 3 - i) : i;
        ho[(size_t)c * 4096] = f2bf(s.x); ho[(size_t)c * 4096 + 64] = f2bf(s.y);
        const f32x2 loc = {hl[(size_t)c * 4096], hl[(size_t)c * 4096 + 64]};
        s = cmul(s, ap) + loc; }
}


constexpr int CVJ_LDS = 72 * 1024;
struct CvTile { const float* src; bf16_t* dst; int ld, c0, k0, mode; };
DI CvTile cv_decode(const Frame& F, int l, int m) {
    const int e = m / 1536, r = m % 1536; CvTile c;
    if (r < 1024) { c.src = ((const float*)F.in[I_WGU]) + (size_t)(l * NEXP + e) * DM * 2048; c.dst = WSP(bf16_t, WS_WGU) + (size_t)(l * NEXP + e) * 2048 * DM; c.ld = 2048; c.c0 = (r >> 4) * 32; c.k0 = (r & 15) * 64; c.mode = 2; }
    else { const int q = r - 1024; c.src = ((const float*)F.in[I_WDN]) + (size_t)(l * NEXP + e) * DM * DM; c.dst = WSP(bf16_t, WS_WDN) + (size_t)(l * NEXP + e) * DM * DM; c.ld = DM; c.c0 = (q >> 4) * 32; c.k0 = (q & 15) * 64; c.mode = 0; }
    return c;
}
DI void cv_issue(const Frame& F, int l, int j, f32x4 (&v)[8]) {
    const CvTile c = cv_decode(F, l, (F.bid * 8 + F.wave) + 2048 * j);
    const float* s = c.src + (size_t)(c.k0 + (F.lane >> 3)) * c.ld + c.c0 + 4 * (F.lane & 7);
#pragma unroll
    for (int i = 0; i < 8; ++i) v[i] = *(const f32x4*)(s + (size_t)(8 * i) * c.ld);
}
DI void cv_stage(const Frame& F, const f32x4 (&v)[8]) {
    LAS unsigned char* base = F.lds + CVJ_LDS + F.wave * 8192 + F.lane * 16;
#pragma unroll
    for (int i = 0; i < 8; ++i) *(LAS f32x4*)(base + i * 1024) = v[i];
}
DI void cv_finish(const Frame& F, int l, int j) {
    const CvTile c = cv_decode(F, l, (F.bid * 8 + F.wave) + 2048 * j);
    const LAS float* T = (const LAS float*)(F.lds + CVJ_LDS + F.wave * 8192);
    const int col = F.lane & 31, kh = F.lane >> 5, row = conv_dst_row(c.mode, c.c0 + col);
    bf16_t* o = c.dst + (size_t)row * DM + c.k0 + kh * 32;
#pragma unroll
    for (int q = 0; q < 4; ++q) { u32x4 w;
#pragma unroll
        for (int i = 0; i < 4; ++i) w[i] = pk2(T[(kh * 32 + 8 * q + 2 * i) * 32 + col], T[(kh * 32 + 8 * q + 2 * i + 1) * 32 + col]);
        *(u32x4*)(o + 8 * q) = w; }
}
constexpr int AP = 144;
struct AttnOut { bf16_t* mix; int col0; float lam, outscale; const float* subw; };
#ifndef DIFF_KT
#define DIFF_KT 64
#endif
#ifndef ATT_SCALAR_SUM
#define ATT_SCALAR_SUM 0
#endif
#ifndef ATT_STATIC_PRIO
#define ATT_STATIC_PRIO 0
#endif
#if ATT_STATIC_PRIO
#define ATT_PRIO_HI do { } while (0)
#define ATT_PRIO_LO do { } while (0)
#else
#define ATT_PRIO_HI __builtin_amdgcn_s_setprio(1)
#define ATT_PRIO_LO __builtin_amdgcn_s_setprio(0)
#endif
template <bool DIFF, int KT>
DI void attn_item(const Frame& F, const bf16_t* Q, const bf16_t* K, const bf16_t* Vt, const float* qn0, const float* qn1, float km0, float km1,
                  int q0, int nkeys, const AttnOut& ao, int cv_l = -1) {
    constexpr int KTB = KT * AP, VPB = KT * 2 + 16, VTB = 64 * VPB, NP = KT / 64;
    LAS unsigned char* KB = F.lds;
    LAS unsigned char* VB = F.lds + 2 * KTB;
    const int tid = F.tid, lane = F.lane, r = lane & 31, h = lane >> 5;
    const int qrow = q0 + F.wave * 32 + r;
    bf16x8 qf[4];
#pragma unroll
    for (int j = 0; j < 4; ++j) qf[j] = ld8g(Q + (size_t)qrow * 64 + j * 16 + 8 * h);
    const float sh0 = -qn0[qrow] * km0, sh1 = DIFF ? -qn1[qrow] * km1 : 0.f;
    f32x16 O0[2], O1[2];
#pragma unroll
    for (int d = 0; d < 2; ++d) { O0[d] = splat16(0.f); O1[d] = splat16(0.f); }
    f32x2 l0v = {0.f, 0.f}, l1v = {0.f, 0.f};
    const int srow = tid >> 3, sch = tid & 7;
    const bf16_t* kg = K + (size_t)srow * 64 + sch * 8; const bf16_t* vg = Vt + (size_t)srow * NT + sch * 8;
    const int ntile = nkeys / KT;
    u32x4 kreg[NP], vreg[NP];
#pragma unroll
    for (int i = 0; i < NP; ++i) { kreg[i] = *(const u32x4*)(kg + (size_t)i * 64 * 64); vreg[i] = *(const u32x4*)(vg + i * 64); }
    __syncthreads();
#pragma unroll
    for (int i = 0; i < NP; ++i) { *(LAS u32x4*)(KB + (srow + 64 * i) * AP + sch * 16) = kreg[i]; *(LAS u32x4*)(VB + srow * VPB + (sch + 8 * i) * 16) = vreg[i]; }
    __syncthreads();
    const int krow = kperm(r);
    f32x4 cvv[8];
#pragma unroll
    for (int i = 0; i < 8; ++i) cvv[i] = (f32x4){0.f, 0.f, 0.f, 0.f};
    asm volatile("" :: "v"(qf[0]), "v"(qf[1]), "v"(qf[2]), "v"(qf[3]), "v"(sh0), "v"(sh1));
#if ATT_STATIC_PRIO
    if (F.wave >= 4) __builtin_amdgcn_s_setprio(1);
#endif
#pragma clang loop unroll(disable)
    for (int t = 0; t < ntile; ++t) {
        const int buf = t & 1;
        constexpr int CVP = KT == 64 ? 10 : 5;
        const int cv_tt = t - (F.bid % CVP), cv_tq = cv_tt / CVP, cv_tr = cv_tt - CVP * cv_tq;
        const bool cv_on = !DIFF && cv_l >= 0 && cv_tt >= 0 && cv_tq < 24;
        if (cv_on && cv_tr == 2) cv_finish(F, cv_l, cv_tq);
        if (t + 1 < ntile) {
#pragma unroll
            for (int i = 0; i < NP; ++i) { kreg[i] = *(const u32x4*)(kg + ((size_t)(t + 1) * KT + i * 64) * 64); vreg[i] = *(const u32x4*)(vg + (size_t)(t + 1) * KT + i * 64); } }
        if (cv_on && cv_tr == 0) cv_issue(F, cv_l, cv_tq, cvv);
        const LAS unsigned char* kb = KB + buf * KTB; const LAS unsigned char* vb = VB + buf * VTB;
#pragma unroll
        for (int sub = 0; sub < KT / 32; ++sub) {
            bf16x8 kf[4];
#pragma unroll
            for (int j = 0; j < 4; ++j) kf[j] = *(const LAS bf16x8*)(kb + (sub * 32 + krow) * AP + j * 32 + h * 16);
            bf16x8 vf[2][2];
#pragma unroll
            for (int d = 0; d < 2; ++d)
#pragma unroll
                for (int s = 0; s < 2; ++s) vf[d][s] = *(const LAS bf16x8*)(vb + (d * 32 + r) * VPB + (sub * 32 + s * 16 + h * 8) * 2);
            {   f32x16 S = splat16(sh0);
                ATT_PRIO_HI;
                S = mfma32(kf[0], qf[0], S); S = mfma32(kf[1], qf[1], S);
                if (!DIFF) { S = mfma32(kf[2], qf[2], S); S = mfma32(kf[3], qf[3], S); }
                ATT_PRIO_LO;
#pragma unroll
                for (int i = 0; i < 16; ++i) {
#if defined(ATTN_DUP) && ATTN_DUP
                    float x2 = S[i]; asm volatile("" : "+v"(x2)); const float e2 = __builtin_amdgcn_exp2f(x2); S[i] = 0.5f * (__builtin_amdgcn_exp2f(S[i]) + e2);
#else
                    S[i] = __builtin_amdgcn_exp2f(S[i]);
#endif
                    }
#pragma unroll
#if ATT_SCALAR_SUM
                for (int i = 0; i < 16; i += 2) { asm("v_add_f32 %0, %0, %1" : "+v"(l0v.x) : "v"(S[i])); asm("v_add_f32 %0, %0, %1" : "+v"(l0v.y) : "v"(S[i + 1])); }
#else
                for (int i = 0; i < 16; i += 2) l0v += (f32x2){S[i], S[i + 1]};
#endif
                const bf16x8 p0 = pack_step<0>(S), p1 = pack_step<1>(S);
                ATT_PRIO_HI;
#pragma unroll
                for (int d = 0; d < 2; ++d) { O0[d] = mfma32(vf[d][0], p0, O0[d]); O0[d] = mfma32(vf[d][1], p1, O0[d]); }
                ATT_PRIO_LO; }
            if (DIFF) { f32x16 S = splat16(sh1);
                ATT_PRIO_HI;
                S = mfma32(kf[2], qf[2], S); S = mfma32(kf[3], qf[3], S);
                ATT_PRIO_LO;
#pragma unroll
                for (int i = 0; i < 16; ++i) {
#if defined(ATTN_DUP) && ATTN_DUP
                    float x2 = S[i]; asm volatile("" : "+v"(x2)); const float e2 = __builtin_amdgcn_exp2f(x2); S[i] = 0.5f * (__builtin_amdgcn_exp2f(S[i]) + e2);
#else
                    S[i] = __builtin_amdgcn_exp2f(S[i]);
#endif
                    }
#pragma unroll
#if ATT_SCALAR_SUM
                for (int i = 0; i < 16; i += 2) { asm("v_add_f32 %0, %0, %1" : "+v"(l1v.x) : "v"(S[i])); asm("v_add_f32 %0, %0, %1" : "+v"(l1v.y) : "v"(S[i + 1])); }
#else
                for (int i = 0; i < 16; i += 2) l1v += (f32x2){S[i], S[i + 1]};
#endif
                const bf16x8 p0 = pack_step<0>(S), p1 = pack_step<1>(S);
                ATT_PRIO_HI;
#pragma unroll
                for (int d = 0; d < 2; ++d) { O1[d] = mfma32(vf[d][0], p0, O1[d]); O1[d] = mfma32(vf[d][1], p1, O1[d]); }
                ATT_PRIO_LO; }
        }
        if (t + 1 < ntile) {
#pragma unroll
            for (int i = 0; i < NP; ++i) { *(LAS u32x4*)(KB + (buf ^ 1) * KTB + (srow + 64 * i) * AP + sch * 16) = kreg[i]; *(LAS u32x4*)(VB + (buf ^ 1) * VTB + srow * VPB + (sch + 8 * i) * 16) = vreg[i]; } }
        if (cv_on && cv_tr == 1) cv_stage(F, cvv);
        __syncthreads();
    }
#if ATT_STATIC_PRIO
    __builtin_amdgcn_s_setprio(0);
#endif
    const GAS float* subw = (const GAS float*)ao.subw; GAS bf16_t* mixp = (GAS bf16_t*)ao.mix;
    asm volatile("" : "+s"(subw)); asm volatile("" : "+s"(mixp));
    float l0 = l0v.x + l0v.y, l1 = l1v.x + l1v.y;
    l0 += __shfl_xor(l0, 32); const float i0 = 1.f / l0;
    float i1 = 0.f; if (DIFF) { l1 += __shfl_xor(l1, 32); i1 = ao.lam / l1; }
    float ss = 0.f;
#pragma unroll
    for (int d = 0; d < 2; ++d)
#pragma unroll
        for (int i = 0; i < 16; ++i) { float v = O0[d][i] * i0; if (DIFF) v -= O1[d][i] * i1; O0[d][i] = v; ss += v * v; }
    float sc = 1.f;
    if (DIFF) { ss += __shfl_xor(ss, 32); sc = __builtin_amdgcn_rsqf(ss * (1.f / 64.f) + EPS) * ao.outscale; }
    GAS bf16_t* orow = mixp + (size_t)qrow * DM + ao.col0;
#pragma unroll
    for (int d = 0; d < 2; ++d)
#pragma unroll
        for (int gq = 0; gq < 4; ++gq) { const int dd = d * 32 + 8 * gq + 4 * h; float o[4];
#pragma unroll
            for (int j = 0; j < 4; ++j) { o[j] = O0[d][4 * gq + j] * sc; if (DIFF) o[j] *= subw[dd + j]; }
            u32x2 w; w[0] = pk2(o[0], o[1]); w[1] = pk2(o[2], o[3]); *(GAS u32x2*)(orow + dd) = w; }
}
DI void attn_item_diff2(const Frame& F, const bf16_t* Q, const bf16_t* K, const bf16_t* Vt, int q0, int nkeys, const AttnOut& ao) {
    LAS unsigned char* KB = F.lds;
    LAS unsigned char* VB = F.lds + 2 * 64 * AP;
    const int tid = F.tid, lane = F.lane, r = lane & 31, h = lane >> 5;
    const int qrow = q0 + F.wave * 32 + r;
    bf16x8 qf[4];
#pragma unroll
    for (int j = 0; j < 4; ++j) qf[j] = ld8g(Q + (size_t)qrow * 64 + j * 16 + 8 * h);
    const f32x16 zero16 = splat16(0.f);
    f32x16 O0[2], O1[2]; float l0 = 0.f, l1 = 0.f;
#pragma unroll
    for (int dd = 0; dd < 2; ++dd) { O0[dd] = zero16; O1[dd] = zero16; }
    const int srow = tid >> 3, sch = tid & 7;
    const bf16_t* kg = K + (size_t)srow * 64 + sch * 8; const bf16_t* vg = Vt + (size_t)srow * NT + sch * 8;
    const int ntile = nkeys >> 6;
    u32x4 kreg = *(const u32x4*)kg, vreg = *(const u32x4*)vg;
    __syncthreads();
    *(LAS u32x4*)(KB + srow * AP + sch * 16) = kreg; *(LAS u32x4*)(VB + srow * AP + sch * 16) = vreg;
    __syncthreads();
    const int krow = kperm(r);
    asm volatile("" :: "v"(qf[0]), "v"(qf[1]), "v"(qf[2]), "v"(qf[3]));
#pragma clang loop unroll(disable)
    for (int t = 0; t < ntile; ++t) {
        const int buf = t & 1;
        if (t + 1 < ntile) { kreg = *(const u32x4*)(kg + (size_t)(t + 1) * 64 * 64); vreg = *(const u32x4*)(vg + (size_t)(t + 1) * 64); }
        const LAS unsigned char* kb = KB + buf * 64 * AP; const LAS unsigned char* vb = VB + buf * 64 * AP;
        bf16x8 kfa[4], kfb[4], vfa[2][2], vfb[2][2];
#pragma unroll
        for (int j = 0; j < 4; ++j) kfa[j] = *(const LAS bf16x8*)(kb + krow * AP + j * 32 + h * 16);
#pragma unroll
        for (int dd = 0; dd < 2; ++dd)
#pragma unroll
            for (int s = 0; s < 2; ++s) vfa[dd][s] = *(const LAS bf16x8*)(vb + (dd * 32 + r) * AP + (s * 16 + h * 8) * 2);
        {   f32x16 S = mfma32(kfa[0], qf[0], zero16); S = mfma32(kfa[1], qf[1], S);
#pragma unroll
            for (int j = 0; j < 4; ++j) kfb[j] = *(const LAS bf16x8*)(kb + (32 + krow) * AP + j * 32 + h * 16);
#pragma unroll
            for (int i = 0; i < 16; ++i) { S[i] = __builtin_amdgcn_exp2f(S[i]); l0 += S[i]; }
            const bf16x8 p0 = pack_step<0>(S), p1 = pack_step<1>(S);

#pragma unroll
            for (int dd = 0; dd < 2; ++dd) { O0[dd] = mfma32(vfa[dd][0], p0, O0[dd]); O0[dd] = mfma32(vfa[dd][1], p1, O0[dd]); } }
        {   f32x16 S = mfma32(kfa[2], qf[2], zero16); S = mfma32(kfa[3], qf[3], S);
#pragma unroll
            for (int dd = 0; dd < 2; ++dd)
#pragma unroll
                for (int s = 0; s < 2; ++s) vfb[dd][s] = *(const LAS bf16x8*)(vb + (dd * 32 + r) * AP + (32 + s * 16 + h * 8) * 2);
#pragma unroll
            for (int i = 0; i < 16; ++i) { S[i] = __builtin_amdgcn_exp2f(S[i]); l1 += S[i]; }
            const bf16x8 p0 = pack_step<0>(S), p1 = pack_step<1>(S);

#pragma unroll
            for (int dd = 0; dd < 2; ++dd) { O1[dd] = mfma32(vfa[dd][0], p0, O1[dd]); O1[dd] = mfma32(vfa[dd][1], p1, O1[dd]); } }
        {   f32x16 S = mfma32(kfb[0], qf[0], zero16); S = mfma32(kfb[1], qf[1], S);
#pragma unroll
            for (int i = 0; i < 16; ++i) { S[i] = __builtin_amdgcn_exp2f(S[i]); l0 += S[i]; }
            const bf16x8 p0 = pack_step<0>(S), p1 = pack_step<1>(S);

#pragma unroll
            for (int dd = 0; dd < 2; ++dd) { O0[dd] = mfma32(vfb[dd][0], p0, O0[dd]); O0[dd] = mfma32(vfb[dd][1], p1, O0[dd]); } }
        {   f32x16 S = mfma32(kfb[2], qf[2], zero16); S = mfma32(kfb[3], qf[3], S);
#pragma unroll
            for (int i = 0; i < 16; ++i) { S[i] = __builtin_amdgcn_exp2f(S[i]); l1 += S[i]; }
            const bf16x8 p0 = pack_step<0>(S), p1 = pack_step<1>(S);

#pragma unroll
            for (int dd = 0; dd < 2; ++dd) { O1[dd] = mfma32(vfb[dd][0], p0, O1[dd]); O1[dd] = mfma32(vfb[dd][1], p1, O1[dd]); } }
        if (t + 1 < ntile) { *(LAS u32x4*)(KB + (buf ^ 1) * 64 * AP + srow * AP + sch * 16) = kreg; *(LAS u32x4*)(VB + (buf ^ 1) * 64 * AP + srow * AP + sch * 16) = vreg; }
        __syncthreads();
    }
    const GAS float* subw = (const GAS float*)ao.subw; GAS bf16_t* mixp = (GAS bf16_t*)ao.mix;
    asm volatile("" : "+s"(subw)); asm volatile("" : "+s"(mixp));
    l0 += __shfl_xor(l0, 32); l1 += __shfl_xor(l1, 32);
    const float i0 = 1.f / l0, i1 = ao.lam / l1;
    float ss = 0.f;
#pragma unroll
    for (int dd = 0; dd < 2; ++dd)
#pragma unroll
        for (int i = 0; i < 16; ++i) { const float v = O0[dd][i] * i0 - O1[dd][i] * i1; O0[dd][i] = v; ss += v * v; }
    ss += __shfl_xor(ss, 32);
    const float sc = __builtin_amdgcn_rsqf(ss * (1.f / 64.f) + EPS) * ao.outscale;
    GAS bf16_t* orow = mixp + (size_t)qrow * DM + ao.col0;
#pragma unroll
    for (int dd = 0; dd < 2; ++dd)
#pragma unroll
        for (int gq = 0; gq < 4; ++gq) { const int dcol = dd * 32 + 8 * gq + 4 * h; float o[4];
#pragma unroll
            for (int j = 0; j < 4; ++j) o[j] = O0[dd][4 * gq + j] * sc * subw[dcol + j];
            u32x2 w; w[0] = pk2(o[0], o[1]); w[1] = pk2(o[2], o[3]); *(GAS u32x2*)(orow + dcol) = w; }
}
constexpr int G3_KP = 144, G3_VP = 528;
constexpr int G3_KB = 256 * G3_KP, G3_VB = 64 * G3_VP;
DI void attn_item_gqa3(const Frame& F, const bf16_t* Q, const bf16_t* K, const bf16_t* Vt, int q0, int nkeys, const AttnOut& ao) {
    LAS unsigned char* KB = F.lds;
    LAS unsigned char* VB = F.lds + 2 * G3_KB;
    const int tid = F.tid, lane = F.lane, r = lane & 31, h = lane >> 5;
    const int qrow = q0 + F.wave * 32 + r;
    bf16x8 qf[4];
#pragma unroll
    for (int j = 0; j < 4; ++j) qf[j] = ld8g(Q + (size_t)qrow * 64 + j * 16 + 8 * h);
    const f32x16 zero16 = splat16(0.f);
    f32x16 O[2]; O[0] = zero16; O[1] = zero16;
    float l0 = 0.f;
    const int kr = tid >> 3, kc = tid & 7, vr = tid >> 5, vc = tid & 31;
    const bf16_t* kg = K + (size_t)kr * 64 + kc * 8; const bf16_t* vg = Vt + (size_t)vr * NT + vc * 8;
    const int kdst = kr * G3_KP + kc * 16, vdst = vr * G3_VP + vc * 16;
    const int ntile = nkeys >> 8;
    u32x4 sreg[4];
    __syncthreads();
#pragma unroll
    for (int i = 0; i < 4; ++i) sreg[i] = *(const u32x4*)(kg + (size_t)i * 64 * 64);
#pragma unroll
    for (int i = 0; i < 4; ++i) *(LAS u32x4*)(KB + kdst + i * 64 * G3_KP) = sreg[i];
#pragma unroll
    for (int i = 0; i < 4; ++i) sreg[i] = *(const u32x4*)(vg + (size_t)i * 16 * NT);
#pragma unroll
    for (int i = 0; i < 4; ++i) *(LAS u32x4*)(VB + vdst + i * 16 * G3_VP) = sreg[i];
    __syncthreads();
    const int koff = kperm(r) * G3_KP + h * 16, voff = r * G3_VP + h * 16;
    asm volatile("" :: "v"(qf[0]), "v"(qf[1]), "v"(qf[2]), "v"(qf[3]));
#pragma clang loop unroll(disable)
    for (int t = 0; t < ntile; ++t) {
        const int buf = t & 1;
        const bool more = t + 1 < ntile;
        if (more) {
#pragma unroll
            for (int i = 0; i < 4; ++i) sreg[i] = *(const u32x4*)(kg + ((size_t)(t + 1) * 256 + i * 64) * 64); }
        const LAS unsigned char* kb = KB + buf * G3_KB + koff; const LAS unsigned char* vb = VB + buf * G3_VB + voff;
        f32x16 Sc = zero16; bf16x8 pp0, pp1;
#pragma unroll
        for (int j = 0; j < 4; ++j) Sc = mfma32(*(const LAS bf16x8*)(kb + j * 32), qf[j], j ? Sc : zero16);
#pragma unroll
        for (int u = 0; u < 8; ++u) {
            f32x16 Sn = zero16;
            if (u + 1 < 8) {
#pragma unroll
                for (int j = 0; j < 4; ++j) Sn = mfma32(*(const LAS bf16x8*)(kb + (u + 1) * 32 * G3_KP + j * 32), qf[j], j ? Sn : zero16); }
            float ls = 0.f;
#pragma unroll
            for (int i = 0; i < 16; ++i) { Sc[i] = __builtin_amdgcn_exp2f(Sc[i]); ls += Sc[i]; }
            l0 += ls;
            const bf16x8 pc0 = pack_step<0>(Sc), pc1 = pack_step<1>(Sc);
            if (u > 0) {
#pragma unroll
                for (int dd = 0; dd < 2; ++dd) { O[dd] = mfma32(*(const LAS bf16x8*)(vb + dd * 32 * G3_VP + (u - 1) * 64), pp0, O[dd]); O[dd] = mfma32(*(const LAS bf16x8*)(vb + dd * 32 * G3_VP + (u - 1) * 64 + 32), pp1, O[dd]); } }
#pragma unroll
            for (int g = 0; g < 8; ++g) { __builtin_amdgcn_sched_group_barrier(0x8, 1, 0); __builtin_amdgcn_sched_group_barrier(0x2, 5, 0); }
            pp0 = pc0; pp1 = pc1; Sc = Sn;
            if (u == 3 && more) {
#pragma unroll
                for (int i = 0; i < 4; ++i) *(LAS u32x4*)(KB + (buf ^ 1) * G3_KB + kdst + i * 64 * G3_KP) = sreg[i];
#pragma unroll
                for (int i = 0; i < 4; ++i) sreg[i] = *(const u32x4*)(vg + (size_t)(t + 1) * 256 + (size_t)i * 16 * NT); }
        }
#pragma unroll
        for (int dd = 0; dd < 2; ++dd) { O[dd] = mfma32(*(const LAS bf16x8*)(vb + dd * 32 * G3_VP + 7 * 64), pp0, O[dd]); O[dd] = mfma32(*(const LAS bf16x8*)(vb + dd * 32 * G3_VP + 7 * 64 + 32), pp1, O[dd]); }
        if (more) {
#pragma unroll
            for (int i = 0; i < 4; ++i) *(LAS u32x4*)(VB + (buf ^ 1) * G3_VB + vdst + i * 16 * G3_VP) = sreg[i]; }
        __syncthreads();
    }
    GAS bf16_t* mixp = (GAS bf16_t*)ao.mix;
    asm volatile("" : "+s"(mixp));
    l0 += __shfl_xor(l0, 32); const float i0 = 1.f / l0;
    GAS bf16_t* orow = mixp + (size_t)qrow * DM + ao.col0;
#pragma unroll
    for (int dd = 0; dd < 2; ++dd)
#pragma unroll
        for (int gq = 0; gq < 4; ++gq) { const int dcol = dd * 32 + 8 * gq + 4 * h;
            u32x2 w; w[0] = pk2(O[dd][4 * gq] * i0, O[dd][4 * gq + 1] * i0); w[1] = pk2(O[dd][4 * gq + 2] * i0, O[dd][4 * gq + 3] * i0); *(GAS u32x2*)(orow + dcol) = w; }
}
#define FENCE __builtin_amdgcn_sched_barrier(0)
#define G4_UNIT(u, HASQK, HASPV) do { \
            f32x16 Sn = zero16; \
            if (HASQK) Sn = mfma32(kfA[0], qf[0], zero16); \
            FENCE; Sc[0] = __builtin_amdgcn_exp2f(Sc[0]); Sc[1] = __builtin_amdgcn_exp2f(Sc[1]); Sc[2] = __builtin_amdgcn_exp2f(Sc[2]); FENCE; \
            if (HASQK) Sn = mfma32(kfA[1], qf[1], Sn); \
            FENCE; Sc[3] = __builtin_amdgcn_exp2f(Sc[3]); Sc[4] = __builtin_amdgcn_exp2f(Sc[4]); Sc[5] = __builtin_amdgcn_exp2f(Sc[5]); FENCE; \
            if (HASQK) Sn = mfma32(kfA[2], qf[2], Sn); \
            FENCE; Sc[6] = __builtin_amdgcn_exp2f(Sc[6]); Sc[7] = __builtin_amdgcn_exp2f(Sc[7]); Sc[8] = __builtin_amdgcn_exp2f(Sc[8]); FENCE; \
            if (HASQK) Sn = mfma32(kfA[3], qf[3], Sn); \
            FENCE; \
            if (HASQK) { _Pragma("unroll") for (int j = 0; j < 4; ++j) kfA[j] = *(const LAS bf16x8*)(kb + (((u) + 2) & 7) * 32 * G3_KP + j * 32); } \
            Sc[9] = __builtin_amdgcn_exp2f(Sc[9]); Sc[10] = __builtin_amdgcn_exp2f(Sc[10]); Sc[11] = __builtin_amdgcn_exp2f(Sc[11]); FENCE; \
            if (HASPV) O[0] = mfma32(vfA[0], pp0, O[0]); \
            FENCE; Sc[12] = __builtin_amdgcn_exp2f(Sc[12]); Sc[13] = __builtin_amdgcn_exp2f(Sc[13]); Sc[14] = __builtin_amdgcn_exp2f(Sc[14]); FENCE; \
            if (HASPV) O[0] = mfma32(vfA[1], pp1, O[0]); \
            FENCE; Sc[15] = __builtin_amdgcn_exp2f(Sc[15]); \
            l0 += (Sc[0] + Sc[1]) + (Sc[2] + Sc[3]); l1 += (Sc[4] + Sc[5]) + (Sc[6] + Sc[7]); FENCE; \
            if (HASPV) O[1] = mfma32(vfA[2], pp0, O[1]); \
            FENCE; l0 += (Sc[8] + Sc[9]) + (Sc[10] + Sc[11]); l1 += (Sc[12] + Sc[13]) + (Sc[14] + Sc[15]); \
            u32x4 pa; pa[0] = pk2(Sc[0], Sc[1]); pa[1] = pk2(Sc[2], Sc[3]); FENCE; \
            if (HASPV) O[1] = mfma32(vfA[3], pp1, O[1]); \
            FENCE; pa[2] = pk2(Sc[4], Sc[5]); pa[3] = pk2(Sc[6], Sc[7]); \
            u32x4 pb; pb[0] = pk2(Sc[8], Sc[9]); pb[1] = pk2(Sc[10], Sc[11]); pb[2] = pk2(Sc[12], Sc[13]); pb[3] = pk2(Sc[14], Sc[15]); FENCE; \
            pp0 = __builtin_bit_cast(bf16x8, pa); pp1 = __builtin_bit_cast(bf16x8, pb); Sc = Sn; \
            _Pragma("unroll") for (int j = 0; j < 4; ++j) vfA[j] = *(const LAS bf16x8*)(vb + (j >> 1) * 32 * G3_VP + (u) * 64 + (j & 1) * 32); \
            FENCE; } while (0)
DI void attn_item_gqa4(const Frame& F, const bf16_t* Q, const bf16_t* K, const bf16_t* Vt, int q0, int nkeys, const AttnOut& ao) {
    LAS unsigned char* KB = F.lds;
    LAS unsigned char* VB = F.lds + 2 * G3_KB;
    const int tid = F.tid, lane = F.lane, r = lane & 31, h = lane >> 5;
    const int qrow = q0 + F.wave * 32 + r;
    bf16x8 qf[4];
#pragma unroll
    for (int j = 0; j < 4; ++j) qf[j] = ld8g(Q + (size_t)qrow * 64 + j * 16 + 8 * h);
    const f32x16 zero16 = splat16(0.f);
    f32x16 O[2]; O[0] = zero16; O[1] = zero16;
    float l0 = 0.f, l1 = 0.f;
    const int kr = tid >> 3, kc = tid & 7, vr = tid >> 5, vc = tid & 31;
    const bf16_t* kg = K + (size_t)kr * 64 + kc * 8; const bf16_t* vg = Vt + (size_t)vr * NT + vc * 8;
    const int kdst = kr * G3_KP + kc * 16, vdst = vr * G3_VP + vc * 16;
    const int ntile = nkeys >> 8;
    u32x4 sreg[4];
    __syncthreads();
#pragma unroll
    for (int i = 0; i < 4; ++i) sreg[i] = *(const u32x4*)(kg + (size_t)i * 64 * 64);
#pragma unroll
    for (int i = 0; i < 4; ++i) *(LAS u32x4*)(KB + kdst + i * 64 * G3_KP) = sreg[i];
#pragma unroll
    for (int i = 0; i < 4; ++i) sreg[i] = *(const u32x4*)(vg + (size_t)i * 16 * NT);
#pragma unroll
    for (int i = 0; i < 4; ++i) *(LAS u32x4*)(VB + vdst + i * 16 * G3_VP) = sreg[i];
    __syncthreads();
    const int koff = kperm(r) * G3_KP + h * 16, voff = r * G3_VP + h * 16;
    asm volatile("" :: "v"(qf[0]), "v"(qf[1]), "v"(qf[2]), "v"(qf[3]));
#pragma clang loop unroll(disable)
    for (int t = 0; t < ntile; ++t) {
        const int buf = t & 1;
        const bool more = t + 1 < ntile;
        if (more) {
#pragma unroll
            for (int i = 0; i < 4; ++i) sreg[i] = *(const u32x4*)(kg + ((size_t)(t + 1) * 256 + i * 64) * 64); }
        const LAS unsigned char* kb = KB + buf * G3_KB + koff; const LAS unsigned char* vb = VB + buf * G3_VB + voff;
        bf16x8 kfA[4], kfB[4], vfA[4], pp0, pp1;
#pragma unroll
        for (int j = 0; j < 4; ++j) kfB[j] = *(const LAS bf16x8*)(kb + j * 32);
#pragma unroll
        for (int j = 0; j < 4; ++j) kfA[j] = *(const LAS bf16x8*)(kb + 32 * G3_KP + j * 32);
        f32x16 Sc = mfma32(kfB[0], qf[0], zero16); Sc = mfma32(kfB[1], qf[1], Sc); Sc = mfma32(kfB[2], qf[2], Sc); Sc = mfma32(kfB[3], qf[3], Sc);
        FENCE;
        G4_UNIT(0, true, false);
#pragma clang loop unroll(disable)
        for (int u = 1; u < 7; ++u) {
            G4_UNIT(u, true, true);
            if (u == 3 && more) {
#pragma unroll
                for (int i = 0; i < 4; ++i) *(LAS u32x4*)(KB + (buf ^ 1) * G3_KB + kdst + i * 64 * G3_KP) = sreg[i];
#pragma unroll
                for (int i = 0; i < 4; ++i) sreg[i] = *(const u32x4*)(vg + (size_t)(t + 1) * 256 + (size_t)i * 16 * NT); }
        }
        G4_UNIT(7, false, true);
        O[0] = mfma32(vfA[0], pp0, O[0]); O[0] = mfma32(vfA[1], pp1, O[0]); O[1] = mfma32(vfA[2], pp0, O[1]); O[1] = mfma32(vfA[3], pp1, O[1]);
        if (more) {
#pragma unroll
            for (int i = 0; i < 4; ++i) *(LAS u32x4*)(VB + (buf ^ 1) * G3_VB + vdst + i * 16 * G3_VP) = sreg[i]; }
        __syncthreads();
    }
    GAS bf16_t* mixp = (GAS bf16_t*)ao.mix;
    asm volatile("" : "+s"(mixp));
    int lz = 0; asm volatile("" : "+v"(lz));
    const int lane2 = (int)__builtin_amdgcn_mbcnt_hi(~0u, __builtin_amdgcn_mbcnt_lo(~0u, 0u)) + lz, h2 = lane2 >> 5, qrow2 = q0 + F.wave * 32 + (lane2 & 31);
    l0 += l1; l0 += __shfl_xor(l0, 32); const float i0 = 1.f / l0;
    GAS bf16_t* orow = mixp + (size_t)qrow2 * DM + ao.col0;
#pragma unroll
    for (int dd = 0; dd < 2; ++dd)
#pragma unroll
        for (int gq = 0; gq < 4; ++gq) { const int dcol = dd * 32 + 8 * gq + 4 * h2;
            u32x2 w; w[0] = pk2(O[dd][4 * gq] * i0, O[dd][4 * gq + 1] * i0); w[1] = pk2(O[dd][4 * gq + 2] * i0, O[dd][4 * gq + 3] * i0); *(GAS u32x2*)(orow + dcol) = w; }
}
DI void p4_attn_diff(const Frame& F, int l, int it) {
    const bool isctx = it >= 256; const int hd = isctx ? it - 256 : it & 3, qb = isctx ? 0 : it >> 2;
    const unsigned* km = WSP(unsigned, WS_CTL) + CW_KMAX + l * 32;
    const float km0 = sqrtf(__uint_as_float(__hip_atomic_load(km + hd * 2, __ATOMIC_RELAXED, __HIP_MEMORY_SCOPE_AGENT)));
    const float km1 = sqrtf(__uint_as_float(__hip_atomic_load(km + hd * 2 + 1, __ATOMIC_RELAXED, __HIP_MEMORY_SCOPE_AGENT)));
    const float lam_init = 0.8f - 0.6f * __expf(-0.3f * (float)l);
    AttnOut ao; ao.mix = WSP(bf16_t, WS_MIX); ao.col0 = hd * 64; ao.lam = WSP(float, WS_LAM)[l]; ao.outscale = 1.f - lam_init; ao.subw = ((const float*)F.in[I_SUBLN]) + (size_t)l * 64;
    const float qm0 = sqrtf(__uint_as_float(__hip_atomic_load(km + 10 + hd * 2, __ATOMIC_RELAXED, __HIP_MEMORY_SCOPE_AGENT))), qm1 = sqrtf(__uint_as_float(__hip_atomic_load(km + 10 + hd * 2 + 1, __ATOMIC_RELAXED, __HIP_MEMORY_SCOPE_AGENT)));
    if (false && qm0 * km0 <= 100.f && qm1 * km1 <= 100.f)
        attn_item_diff2(F, WSP(bf16_t, WS_QD) + (size_t)hd * NT * 64, WSP(bf16_t, WS_KD) + (size_t)hd * NT * 64, WSP(bf16_t, WS_VTD) + (size_t)hd * 64 * NT, isctx ? 0 : CTX + qb * 256, isctx ? CTX : NT, ao);
    else
    attn_item<true, DIFF_KT>(F, WSP(bf16_t, WS_QD) + (size_t)hd * NT * 64, WSP(bf16_t, WS_KD) + (size_t)hd * NT * 64, WSP(bf16_t, WS_VTD) + (size_t)hd * 64 * NT,
                    WSP(float, WS_QND) + (size_t)(hd * 2) * NT, WSP(float, WS_QND) + (size_t)(hd * 2 + 1) * NT, km0, km1, isctx ? 0 : CTX + qb * 256, isctx ? CTX : NT, ao);
}
#ifndef GQA_KT_V
#define GQA_KT_V 64
#endif
constexpr int GQA_KT = GQA_KT_V;
DI bool gqa_fast_ok(const Frame& F, int l) {
    const unsigned* km = WSP(unsigned, WS_CTL) + CW_KMAX + l * 32; bool ok = true;
    for (int hq = 0; hq < 4; ++hq) { const float k = sqrtf(__uint_as_float(__hip_atomic_load(km + 8 + (hq >> 1), __ATOMIC_RELAXED, __HIP_MEMORY_SCOPE_AGENT))), q = sqrtf(__uint_as_float(__hip_atomic_load(km + 18 + hq, __ATOMIC_RELAXED, __HIP_MEMORY_SCOPE_AGENT)));
        ok = ok && (q * k <= 100.f); }
    return ok;
}
template <bool FAST>
DI void p4_attn_gqa(const Frame& F, int l, int it) {
    const bool isctx = it >= 256; const int hq = isctx ? it - 256 : it & 3, qb = isctx ? 0 : it >> 2, g = hq >> 1;
    AttnOut ao; ao.mix = WSP(bf16_t, WS_MIX); ao.col0 = 768 + hq * 64; ao.lam = 0.f; ao.outscale = 1.f; ao.subw = nullptr;
    if (FAST) attn_item_gqa4(F, WSP(bf16_t, WS_QG) + (size_t)hq * NT * 64, WSP(bf16_t, WS_KG) + (size_t)g * NT * 64, WSP(bf16_t, WS_VTG) + (size_t)g * 64 * NT, isctx ? 0 : CTX + qb * 256, isctx ? CTX : NT, ao);
    else { const unsigned* km = WSP(unsigned, WS_CTL) + CW_KMAX + l * 32;
        const float km0 = sqrtf(__uint_as_float(__hip_atomic_load(km + 8 + g, __ATOMIC_RELAXED, __HIP_MEMORY_SCOPE_AGENT)));
        attn_item<false, GQA_KT>(F, WSP(bf16_t, WS_QG) + (size_t)hq * NT * 64, WSP(bf16_t, WS_KG) + (size_t)g * NT * 64, WSP(bf16_t, WS_VTG) + (size_t)g * 64 * NT,
                         WSP(float, WS_QNG) + (size_t)hq * NT, nullptr, km0, 0.f, isctx ? 0 : CTX + qb * 256, isctx ? CTX : NT, ao, isctx ? -1 : l); }
}

DI void p4_ssd_out(const Frame& F, int l, int item) {
    const int c = item >> 1, lh = item & 1;
    LAS float* DTL = (LAS float*)(F.lds + 96 * 1024);
    LAS float* CML = DTL + 8 * 128;
    const int tid = F.tid, lane = F.lane, r = lane & 31, h = lane >> 5, tok0 = c * 128;
    __syncthreads();
    for (int i = tid; i < 1024; i += 512) { DTL[i] = WSP(float, WS_DTV)[(size_t)c * 1024 + i]; CML[i] = WSP(float, WS_CUM)[(size_t)c * 1024 + i]; }
    __syncthreads();
    const int hh = F.wave >> 1, g = hh >> 1;
    const float Dh = ((const float*)F.in[I_SSDD])[(size_t)l * 4 + hh];
    const bf16_t* CN = WSP(bf16_t, WS_CN); const bf16_t* BN = WSP(bf16_t, WS_BN);
    const bf16_t* XS = WSP(bf16_t, WS_XST) + ((size_t)c * 256 + hh * 64) * 128;
    { const int lt = F.wave & 1;
        const int ll = 64 * lh + 32 * lt + r;
        bf16x8 cfr[8];
#pragma unroll
        for (int ks = 0; ks < 8; ++ks) cfr[ks] = ld8g(CN + (size_t)(tok0 + ll) * 256 + g * 128 + ks * 16 + 8 * h);
        const float cfl = CML[hh * 128 + ll], cbl = CML[(4 + hh) * 128 + ll], dsum = DTL[hh * 128 + ll] + DTL[(4 + hh) * 128 + ll];
        f32x16 Y[2];
        Y[0] = splat16(0.f); Y[1] = splat16(0.f);
#pragma unroll
        for (int st = 0; st < 4; ++st) {
            f32x16 G = splat16(0.f);
#pragma unroll
            for (int ks = 0; ks < 8; ++ks) G = mfma32(ld8g(BN + (size_t)(tok0 + 32 * st + kperm(r)) * 256 + g * 128 + ks * 16 + 8 * h), cfr[ks], G);
#pragma unroll
            for (int i = 0; i < 16; ++i) { const int s = 32 * st + kperm(crow(i, h));
                const float cfs = CML[hh * 128 + s], cbs = CML[(4 + hh) * 128 + s], dfs = DTL[hh * 128 + s], dbs = DTL[(4 + hh) * 128 + s];
                float fac;
                if (s < ll) fac = dfs * __builtin_amdgcn_exp2f(cfl - cfs);
                else if (s > ll) fac = dbs * __builtin_amdgcn_exp2f(cbl - cbs);
                else fac = dsum;
                G[i] = G[i] * fac + (s == ll ? Dh : 0.f); }
            const bf16x8 m0 = pack_step<0>(G), m1 = pack_step<1>(G);
#pragma unroll
            for (int pt = 0; pt < 2; ++pt) {
                Y[pt] = mfma32(ld8g(XS + (size_t)(pt * 32 + r) * 128 + 32 * st + 8 * h), m0, Y[pt]);
                Y[pt] = mfma32(ld8g(XS + (size_t)(pt * 32 + r) * 128 + 32 * st + 16 + 8 * h), m1, Y[pt]); }
        }
#pragma unroll
        for (int dir = 0; dir < 2; ++dir) {
            const bf16_t* S = WSP(bf16_t, WS_SIN) + ((size_t)c * 8 + dir * 4 + hh) * 8192;
            const float e = __builtin_amdgcn_exp2f(dir ? cbl : cfl);
#pragma unroll
            for (int pt = 0; pt < 2; ++pt) { f32x16 Z = splat16(0.f);
#pragma unroll
                for (int ks = 0; ks < 8; ++ks) Z = mfma32(ld8g(S + (size_t)(pt * 32 + r) * 128 + ks * 16 + 8 * h), cfr[ks], Z);
                Y[pt] += Z * e; }
        }
        const int tok = tok0 + ll; float ssq = 0.f;
        const bf16_t* zr = WSP(bf16_t, WS_U) + (size_t)tok * NU + U_Z + hh * 64; bf16_t* yo = WSP(bf16_t, WS_YSSD) + (size_t)tok * 256 + hh * 64;
#pragma unroll
        for (int pt = 0; pt < 2; ++pt)
#pragma unroll
            for (int gq = 0; gq < 4; ++gq) { const int p = pt * 32 + 8 * gq + 4 * h; const u32x2 zz = *(const u32x2*)(zr + p);
                const float z0 = bflo(zz[0]), z1 = bfhi(zz[0]), z2 = bflo(zz[1]), z3 = bfhi(zz[1]);
                const float y0 = Y[pt][4 * gq] * silu_f(z0), y1 = Y[pt][4 * gq + 1] * silu_f(z1), y2 = Y[pt][4 * gq + 2] * silu_f(z2), y3 = Y[pt][4 * gq + 3] * silu_f(z3);
                ssq += y0 * y0 + y1 * y1 + y2 * y2 + y3 * y3;
                u32x2 w; w[0] = pk2(y0, y1); w[1] = pk2(y2, y3); *(u32x2*)(yo + p) = w; }
        ssq += __shfl_xor(ssq, 32);
        if (h == 0) WSP(float, WS_SSQ)[(size_t)tok * 4 + hh] = ssq;
    }
}

constexpr int N_S5O = 16 * 9 * 2;
DI float gelu_tanh(float y) { const float u = 0.7978845608028654f * (y + 0.044715f * y * y * y); const float e = __builtin_amdgcn_exp2f(2.8853900817779268f * u); return y * (1.f - __builtin_amdgcn_rcpf(1.f + e)); }
constexpr int HBP = 264;
DI void p4_s5_out(const Frame& F, int l, int item) {
    const int mh = item & 1, nt = (item >> 1) % 9, g = (item >> 1) / 9, lane = F.lane, r = lane & 31, h = lane >> 5;
    s5_stage_u<false>(F, g, nt);
    LAS bf16_t* HB = (LAS bf16_t*)F.lds + 32 * UBP;
    LAS bf16_t* KTL = (LAS bf16_t*)(F.lds + 84 * 1024);
    { const bf16_t* ktg = WSP(bf16_t, WS_KTAB) + ((size_t)l * 16 + g) * 3 * 64 * 256;
      for (int i = F.tid; i < (2 * 64 * 256 + 256) / 8; i += 512) *(LAS u32x4*)(KTL + 8 * i) = *(const u32x4*)(ktg + 8 * i); }
    for (int i = F.tid; i < 32 * 32; i += 512) { const int n = i >> 5, p = i & 31; const int chunk = nt * 32 + n, cc = chunk < NC5 ? chunk : NC5 - 1;
        *(LAS u32x4*)(HB + n * HBP + 8 * p) = *(const u32x4*)(WSP(bf16_t, WS_HIN) + (size_t)cc * 4096 + g * 256 + 8 * p); }
    __syncthreads();
    const LAS bf16_t* UB = (const LAS bf16_t*)F.lds + r * UBP + 8 * h; const LAS bf16_t* HBr = HB + r * HBP + 8 * h;
    const int chunk = nt * 32 + r;
#pragma unroll 1
    for (int mi = 0; mi < 2; ++mi) {
        const int mt = mh * 16 + F.wave * 2 + mi, row = mt * 32 + r, t = row >> 4, ch = row & 15;
        const LAS bf16_t* KT = KTL + ch * 16 + 8 * h;
        f32x16 acc = splat16(0.f);
#pragma unroll 16
        for (int s = 0; s < 64; ++s) { const int sel = s < t ? 0 : (s > t ? 1 : 2), lag = s < t ? t - s : (s > t ? s - t : 0);
            acc = mfma32(*(const LAS bf16x8*)(KT + (sel * 64 + lag) * 256), *(const LAS bf16x8*)(UB + s * 16), acc); }
        const bf16_t* CC = WSP(bf16_t, WS_CC5) + (((size_t)l * 16 + g) * 1024 + row) * 256 + 8 * h;
#pragma unroll
        for (int kc = 0; kc < 16; ++kc) acc = mfma32(ld8g(CC + kc * 16), *(const LAS bf16x8*)(HBr + kc * 16), acc);
        if (chunk < NC5) {
#pragma unroll
            for (int gq = 0; gq < 4; ++gq) { const int rr = mt * 32 + 8 * gq + 4 * h, tt = rr >> 4, c0 = rr & 15;
                u32x2 w; w[0] = pk2(gelu_tanh(acc[4 * gq]), gelu_tanh(acc[4 * gq + 1])); w[1] = pk2(gelu_tanh(acc[4 * gq + 2]), gelu_tanh(acc[4 * gq + 3]));
                *(u32x2*)(WSP(bf16_t, WS_YS5) + (size_t)(chunk * S5L + tt) * 256 + g * 16 + c0) = w; } }
    }
}

DI void p5_finish(const Frame& F, int l) {
    const int lane = F.lane;
    { const f32x4 nw = *(const f32x4*)(((const float*)F.in[I_SSDNW]) + (size_t)l * 256 + 4 * lane);
      f32x4 q[9]; u32x2 y[9];
#pragma unroll
      for (int k = 0; k < 9; ++k) { const int r = F.wave + 8 * k, row = F.bid * RPB + (r < RPB ? r : RPB - 1), rc = row < NT ? row : NT - 1;
          q[k] = *(const f32x4*)(WSP(float, WS_SSQ) + (size_t)rc * 4); y[k] = *(const u32x2*)(WSP(bf16_t, WS_YSSD) + (size_t)rc * 256 + 4 * lane); }
#pragma unroll
      for (int k = 0; k < 9; ++k) { const int r = F.wave + 8 * k, row = F.bid * RPB + r;
          if (r < RPB && row < NT) { const float rs = __builtin_amdgcn_rsqf((q[k][0] + q[k][1] + q[k][2] + q[k][3]) * (1.f / 256.f) + EPS);
              u32x2 w; w[0] = pk2(bflo(y[k][0]) * rs * nw[0], bfhi(y[k][0]) * rs * nw[1]); w[1] = pk2(bflo(y[k][1]) * rs * nw[2], bfhi(y[k][1]) * rs * nw[3]);
              *(u32x2*)(WSP(bf16_t, WS_MIX) + (size_t)row * DM + 256 + 4 * lane) = w; } } }
    const int r = lane & 31, h = lane >> 5, nt = F.wave;
    const bf16_t* WG = WSP(bf16_t, WS_WGLU) + (size_t)l * 65536;
    bf16x8 wf[16];
#pragma unroll
    for (int ks = 0; ks < 16; ++ks) wf[ks] = ld8g(WG + (size_t)(nt * 32 + r) * 256 + ks * 16 + 8 * h);
    f32x4 bb[4];
#pragma unroll
    for (int gq = 0; gq < 4; ++gq) bb[gq] = *(const f32x4*)(((const float*)F.in[I_BGLU]) + (size_t)l * 256 + nt * 32 + 8 * gq + 4 * h);
    for (int mt = F.bid; mt < NT / 32; mt += F.G) {
        const bf16_t* Y = WSP(bf16_t, WS_YS5) + (size_t)(mt * 32) * 256;
        bf16x8 af[16]; u32x2 yy[4];
#pragma unroll
        for (int ks = 0; ks < 16; ++ks) af[ks] = ld8g(Y + (size_t)r * 256 + ks * 16 + 8 * h);
#pragma unroll
        for (int gq = 0; gq < 4; ++gq) yy[gq] = *(const u32x2*)(Y + (size_t)r * 256 + nt * 32 + 8 * gq + 4 * h);
        const int tok = mt * 32 + r;
        f32x16 acc = splat16(0.f);
#pragma unroll
        for (int ks = 0; ks < 16; ++ks) acc = mfma32(wf[ks], af[ks], acc);
#pragma unroll
        for (int gq = 0; gq < 4; ++gq) { const int n0 = nt * 32 + 8 * gq + 4 * h;
            u32x2 w; w[0] = pk2(bflo(yy[gq][0]) * sigmoid_f(acc[4 * gq] + bb[gq][0]), bfhi(yy[gq][0]) * sigmoid_f(acc[4 * gq + 1] + bb[gq][1]));
            w[1] = pk2(bflo(yy[gq][1]) * sigmoid_f(acc[4 * gq + 2] + bb[gq][2]), bfhi(yy[gq][1]) * sigmoid_f(acc[4 * gq + 3] + bb[gq][3]));
            *(u32x2*)(WSP(bf16_t, WS_MIX) + (size_t)tok * DM + 512 + n0) = w; }
    }
    __syncthreads();
}

#ifndef PH_MASK
#define PH_MASK 0xFFFF
#endif
#define PHEN(k) ((PH_MASK >> (k)) & 1)
#ifndef PH_REP
#define PH_REP 0
#endif
#define NREP(k) (((PH_REP >> (k)) & 1) ? 2 : 1)
#ifndef STAG_GU
#define STAG_GU 0
#endif
#ifndef STAG_DN
#define STAG_DN 0
#endif
#ifndef REP_SKIP_STORES
#define REP_SKIP_STORES 0
#endif
DI Frame launder(const Frame& F) { Frame G = F; int t = F.wave * 64 + (int)__builtin_amdgcn_mbcnt_hi(~0u, __builtin_amdgcn_mbcnt_lo(~0u, 0u)); GAS unsigned char* w = F.ws; const GAS float* const __attribute__((address_space(4)))* ip = F.in;
    int bb = F.bid, gg = F.G; LAS unsigned char* lp = F.lds; asm volatile("" : "+s"(lp)); G.lds = lp; asm volatile("" : "+v"(t)); asm volatile("" : "+s"(w)); asm volatile("" : "+s"(ip)); asm volatile("" : "+s"(bb)); asm volatile("" : "+s"(gg)); G.bid = bb; G.G = gg; G.tid = t; G.lane = t & 63; G.ws = w; G.in = ip; return G; }
DI int launder_s(int v) { asm volatile("" : "+s"(v)); return v; }
constexpr int NPL = 10, N_PHASES = 1 + DEPTH * NPL + 1;
__global__ void __launch_bounds__(512, 2) hybrid_fwd(Args args) {
    extern __shared__ __attribute__((aligned(16))) unsigned char lds_raw[];
    Frame F; F.lds = (LAS unsigned char*)lds_raw; F.in = (const GAS float* const __attribute__((address_space(4)))*)__builtin_amdgcn_kernarg_segment_ptr(); F.ws = (GAS unsigned char*)args.ws; F.out = args.out;
    F.tid = threadIdx.x; F.lane = F.tid & 63; F.wave = __builtin_amdgcn_readfirstlane(F.tid >> 6); F.G = gridDim.x; F.bid = blockIdx.x;
    const int lo = args.ph_lo, hi = args.ph_hi;
    volatile LAS unsigned* xbw = (volatile LAS unsigned*)(F.lds + LDS_BYTES - 64);
    if (F.tid == 0) { xbw[0] = 0u; xbw[1] = 0u; }
    __syncthreads();
    XcdBarrier bar; bar.bar = WSP(unsigned, WS_CTL) + CW_BAR; bar.x = 0; bar.st = xbw;
    if (hi - lo > 1) bar = xcd_barrier_post(WSP(unsigned, WS_CTL) + CW_BAR, xbw);
#define IN(k) (lo <= (k) && (k) < hi)
#ifndef DIAG
#define DIAG 0
#endif
#if DIAG
    volatile LAS unsigned* dg = (volatile LAS unsigned*)(F.lds + LDS_BYTES - 192);
    if (F.tid < 16) dg[F.tid] = 0u;
    unsigned long long t_prev = __builtin_amdgcn_s_memrealtime();
#define DIAG_ACC(kind) do { if (blockIdx.x == 0 && threadIdx.x == 0) { const unsigned long long t_now = __builtin_amdgcn_s_memrealtime(); dg[kind] += (unsigned)(t_now - t_prev); t_prev = t_now; } } while (0)
#else
#define DIAG_ACC(kind) do { } while (0)
#endif
#define SEAM(k) do { if (IN(k) && IN((k) + 1)) xcd_barrier(bar); } while (0)
#define WSQ(T, off) ((T*)(Fq.ws + (off)))
#define LAUNDERED for (int rep_ = 0; rep_ < nrep_; ++rep_) for (Frame Fq = launder(F), *once_ = &Fq; once_; once_ = nullptr) for (int lq = launder_s(l_cur), once2_ = 1; once2_; once2_ = 0)
    int ph = 0, l_cur = 0, nrep_ = 1;
    nrep_ = NREP(0); if (PHEN(0) && IN(ph)) LAUNDERED { (void)lq; p0_prologue(Fq, rep_); }
    SEAM(ph); ++ph; DIAG_ACC(0);
    { l_cur = 0;
        nrep_ = NREP(1); if (PHEN(1) && IN(ph)) LAUNDERED p1_norm<false>(Fq, lq);
        SEAM(ph); ++ph; DIAG_ACC(1);
        nrep_ = NREP(2); if (PHEN(2) && IN(ph)) LAUNDERED { pg8::Gemm gm{WSQ(pg8::bf16_t, WS_H), WSQ(pg8::bf16_t, WS_WIN) + (size_t)lq * NU * DM, NT, NU, DM}; pg8::StaticOrder S; S.init(NT, NU, Fq.G, Fq.bid);
            EpiU E{WSQ(bf16_t, WS_U), NU, WSQ(bf16_t, WS_US5)}; pg8::gemm_phase<EpiU, pg8::StaticOrder>((PG8_LAS unsigned char*)Fq.lds, gm, S, E); }
        SEAM(ph); ++ph; DIAG_ACC(2);
        nrep_ = NREP(3); if (PHEN(3) && IN(ph)) LAUNDERED {
            unsigned* qctr = WSQ(unsigned, WS_CTL) + CW_Q0 + 64 * (2 + 2 * lq + rep_ * 8);
            for (;;) { const int idx = q_next(Fq, qctr); if (idx >= NCH + 260 + N_S5H) break; const Frame Fi = launder(Fq);
                if (idx < NCH) { for (int q_ = 0; q_ < NREP(21); ++q_) p3_ssd_prep(Fi, lq, idx); }
                else if (idx < NCH + 260) { for (int q_ = 0; q_ < NREP(22); ++q_) p3_attn_prep(Fi, lq, idx - NCH); }
                else { for (int q_ = 0; q_ < NREP(23); ++q_) p3_s5_hloc(Fi, lq, idx - NCH - 260); }
            }
        }
        SEAM(ph); ++ph; DIAG_ACC(3);
        nrep_ = NREP(4); if (PHEN(4) && IN(ph)) LAUNDERED { for (int q_ = 0; q_ < NREP(16); ++q_) p4_ssd_scan(Fq, lq);
            for (int q_ = 0; q_ < NREP(17); ++q_) for (int it = Fq.bid; it < 256; it += Fq.G) { const Frame Fi = launder(Fq); p4_attn_diff(Fi, lq, it); }
            unsigned* qctr = WSQ(unsigned, WS_CTL) + CW_Q0 + 64 * (10 + lq + rep_ * 8);
            for (;;) { const int idx = q_next(Fq, qctr); if (idx >= 4) break; const Frame Fi = launder(Fq);
                p4_attn_diff(Fi, lq, 256 + idx); } }
        SEAM(ph); ++ph; DIAG_ACC(4);
        nrep_ = NREP(5); if (PHEN(5) && IN(ph)) LAUNDERED {
            if (false && gqa_fast_ok(Fq, lq)) { for (int q_ = 0; q_ < NREP(18); ++q_) for (int it = Fq.bid; it < 256; it += Fq.G) { const Frame Fi = launder(Fq); p4_attn_gqa<true>(Fi, lq, it); } }
            else { for (int q_ = 0; q_ < NREP(18); ++q_) for (int it = Fq.bid; it < 256; it += Fq.G) { const Frame Fi = launder(Fq); p4_attn_gqa<false>(Fi, lq, it); } }
            { unsigned* qctr = WSQ(unsigned, WS_CTL) + CW_Q0 + 64 * (3 + 2 * lq + rep_ * 8);
              for (;;) { const int idx = q_next(Fq, qctr); if (idx >= 2 * NCH + N_S5O + 4) break; const Frame Fi = launder(Fq);
                  if (idx < 2 * NCH) p4_ssd_out(Fi, lq, idx); else if (idx < 2 * NCH + N_S5O) p4_s5_out(Fi, lq, idx - 2 * NCH); else p4_attn_gqa<false>(Fi, lq, 256 + idx - 2 * NCH - N_S5O); } }
        }
        SEAM(ph); ++ph; DIAG_ACC(5);
        nrep_ = NREP(6); if (PHEN(6) && IN(ph)) LAUNDERED p5_finish(Fq, lq);
        SEAM(ph); ++ph; DIAG_ACC(6);
        nrep_ = NREP(7); if (PHEN(7) && IN(ph)) LAUNDERED { pg8::Gemm gm{WSQ(pg8::bf16_t, WS_MIX) + (size_t)CTX * DM, WSQ(pg8::bf16_t, WS_WOUT) + (size_t)lq * DM * DM, SEQ, DM, DM}; pg8::StaticOrder S; S.init(SEQ, DM, Fq.G, Fq.bid);
            EpiRes E; E.C = WSQ(float, WS_XA); E.g1 = WSQ(float, WS_MOD) + (size_t)lq * 2 * 6144 + 2 * 1024;
            if (lq == 0) { E.res_ctx = ((const float*)Fq.in[I_CTX]); E.res_lat = ((const float*)Fq.in[I_X]); } else { E.res_ctx = WSQ(float, WS_XB); E.res_lat = WSQ(float, WS_XB) + (size_t)CTX * DM; }
            pg8::gemm_phase<EpiRes, pg8::StaticOrder>((PG8_LAS unsigned char*)Fq.lds, gm, S, E);
            if (lq < DEPTH - 1) outproj_ctx(Fq, lq, E.res_ctx); }
        SEAM(ph); ++ph; DIAG_ACC(7);
        nrep_ = NREP(8); if (PHEN(8) && IN(ph)) LAUNDERED p7a_router(Fq, lq, rep_);
        SEAM(ph); ++ph; DIAG_ACC(8);
        nrep_ = NREP(10); if (PHEN(10) && IN(ph)) LAUNDERED { const int ntiles = moe_tables(Fq, lq); const LAS int* t2e = (const LAS int*)(Fq.lds + LDS_MISC) + 64;
            moe_rows(Fq, lq, ntiles, 8);
            pg8::Gemm gm{WSQ(pg8::bf16_t, WS_H), WSQ(pg8::bf16_t, WS_WGU) + (size_t)lq * NEXP * 2048 * DM, CAP, 2048, DM};
            MoeOrder S{8, ntiles, Fq.G, Fq.bid, t2e, (long)2048 * DM * 2};
            moe_bias(Fq, ntiles, 8, ((const float*)Fq.in[I_BGU]) + (size_t)lq * NEXP * 2048, 2048);
            EpiAct E{WSQ(bf16_t, WS_ACT), (const LAS float*)(Fq.lds + LDS_BIASL)};
            if (STAG_GU) xcd_stagger(Fq, STAG_GU);
            pg8::gemm_phase_gather<EpiAct, MoeOrder>((PG8_LAS unsigned char*)Fq.lds, gm, S, E, (const PG8_LAS int*)(Fq.lds + LDS_MISC + 2048)); }
        SEAM(ph); ++ph; DIAG_ACC(10);
        nrep_ = NREP(11); if (PHEN(11) && IN(ph)) LAUNDERED { const int ntiles = moe_tables(Fq, lq); const LAS int* t2e = (const LAS int*)(Fq.lds + LDS_MISC) + 64;
            pg8::Gemm gm{WSQ(pg8::bf16_t, WS_ACT), WSQ(pg8::bf16_t, WS_WDN) + (size_t)lq * NEXP * DM * DM, CAP, DM, DM};
            MoeOrder S{4, ntiles, Fq.G, Fq.bid, t2e, (long)DM * DM * 2};
            moe_bias(Fq, ntiles, 4, ((const float*)Fq.in[I_BDN]) + (size_t)lq * NEXP * DM, DM);
            EpiDown E{WSQ(bf16_t, WS_YB), (const LAS float*)(Fq.lds + LDS_BIASL), REP_SKIP_STORES * rep_, WSQ(bf16_t, WS_U)};
            if (STAG_DN) xcd_stagger(Fq, STAG_DN);
            pg8::gemm_phase<EpiDown, MoeOrder>((PG8_LAS unsigned char*)Fq.lds, gm, S, E); }
        SEAM(ph); ++ph; DIAG_ACC(11);
    }
    { l_cur = 1;
        nrep_ = NREP(1); if (PHEN(1) && IN(ph)) LAUNDERED p1_norm<false>(Fq, lq);
        SEAM(ph); ++ph; DIAG_ACC(1);
        nrep_ = NREP(2); if (PHEN(2) && IN(ph)) LAUNDERED { pg8::Gemm gm{WSQ(pg8::bf16_t, WS_H), WSQ(pg8::bf16_t, WS_WIN) + (size_t)lq * NU * DM, NT, NU, DM}; pg8::StaticOrder S; S.init(NT, NU, Fq.G, Fq.bid);
            EpiU E{WSQ(bf16_t, WS_U), NU, WSQ(bf16_t, WS_US5)}; pg8::gemm_phase<EpiU, pg8::StaticOrder>((PG8_LAS unsigned char*)Fq.lds, gm, S, E); }
        SEAM(ph); ++ph; DIAG_ACC(2);
        nrep_ = NREP(3); if (PHEN(3) && IN(ph)) LAUNDERED {
            unsigned* qctr = WSQ(unsigned, WS_CTL) + CW_Q0 + 64 * (2 + 2 * lq + rep_ * 8);
            for (;;) { const int idx = q_next(Fq, qctr); if (idx >= NCH + 260 + N_S5H) break; const Frame Fi = launder(Fq);
                if (idx < NCH) { for (int q_ = 0; q_ < NREP(21); ++q_) p3_ssd_prep(Fi, lq, idx); }
                else if (idx < NCH + 260) { for (int q_ = 0; q_ < NREP(22); ++q_) p3_attn_prep(Fi, lq, idx - NCH); }
                else { for (int q_ = 0; q_ < NREP(23); ++q_) p3_s5_hloc(Fi, lq, idx - NCH - 260); }
            }
        }
        SEAM(ph); ++ph; DIAG_ACC(3);
        nrep_ = NREP(4); if (PHEN(4) && IN(ph)) LAUNDERED { for (int q_ = 0; q_ < NREP(16); ++q_) p4_ssd_scan(Fq, lq);
            for (int q_ = 0; q_ < NREP(17); ++q_) for (int it = Fq.bid; it < 256; it += Fq.G) { const Frame Fi = launder(Fq); p4_attn_diff(Fi, lq, it); }
            unsigned* qctr = WSQ(unsigned, WS_CTL) + CW_Q0 + 64 * (10 + lq + rep_ * 8);
            for (;;) { const int idx = q_next(Fq, qctr); if (idx >= 4) break; const Frame Fi = launder(Fq);
                p4_attn_diff(Fi, lq, 256 + idx); } }
        SEAM(ph); ++ph; DIAG_ACC(4);
        nrep_ = NREP(5); if (PHEN(5) && IN(ph)) LAUNDERED {
            if (false && gqa_fast_ok(Fq, lq)) { for (int q_ = 0; q_ < NREP(18); ++q_) for (int it = Fq.bid; it < 256; it += Fq.G) { const Frame Fi = launder(Fq); p4_attn_gqa<true>(Fi, lq, it); } }
            else { for (int q_ = 0; q_ < NREP(18); ++q_) for (int it = Fq.bid; it < 256; it += Fq.G) { const Frame Fi = launder(Fq); p4_attn_gqa<false>(Fi, lq, it); } }
            { unsigned* qctr = WSQ(unsigned, WS_CTL) + CW_Q0 + 64 * (3 + 2 * lq + rep_ * 8);
              for (;;) { const int idx = q_next(Fq, qctr); if (idx >= 2 * NCH + N_S5O + 4) break; const Frame Fi = launder(Fq);
                  if (idx < 2 * NCH) p4_ssd_out(Fi, lq, idx); else if (idx < 2 * NCH + N_S5O) p4_s5_out(Fi, lq, idx - 2 * NCH); else p4_attn_gqa<false>(Fi, lq, 256 + idx - 2 * NCH - N_S5O); } }
        }
        SEAM(ph); ++ph; DIAG_ACC(5);
        nrep_ = NREP(6); if (PHEN(6) && IN(ph)) LAUNDERED p5_finish(Fq, lq);
        SEAM(ph); ++ph; DIAG_ACC(6);
        nrep_ = NREP(7); if (PHEN(7) && IN(ph)) LAUNDERED { pg8::Gemm gm{WSQ(pg8::bf16_t, WS_MIX) + (size_t)CTX * DM, WSQ(pg8::bf16_t, WS_WOUT) + (size_t)lq * DM * DM, SEQ, DM, DM}; pg8::StaticOrder S; S.init(SEQ, DM, Fq.G, Fq.bid);
            EpiRes E; E.C = WSQ(float, WS_XA); E.g1 = WSQ(float, WS_MOD) + (size_t)lq * 2 * 6144 + 2 * 1024;
            if (lq == 0) { E.res_ctx = ((const float*)Fq.in[I_CTX]); E.res_lat = ((const float*)Fq.in[I_X]); } else { E.res_ctx = WSQ(float, WS_XB); E.res_lat = WSQ(float, WS_XB) + (size_t)CTX * DM; }
            pg8::gemm_phase<EpiRes, pg8::StaticOrder>((PG8_LAS unsigned char*)Fq.lds, gm, S, E);
            if (lq < DEPTH - 1) outproj_ctx(Fq, lq, E.res_ctx); }
        SEAM(ph); ++ph; DIAG_ACC(7);
        nrep_ = NREP(8); if (PHEN(8) && IN(ph)) LAUNDERED p7a_router(Fq, lq, rep_);
        SEAM(ph); ++ph; DIAG_ACC(8);
        nrep_ = NREP(10); if (PHEN(10) && IN(ph)) LAUNDERED { const int ntiles = moe_tables(Fq, lq); const LAS int* t2e = (const LAS int*)(Fq.lds + LDS_MISC) + 64;
            moe_rows(Fq, lq, ntiles, 8);
            pg8::Gemm gm{WSQ(pg8::bf16_t, WS_H), WSQ(pg8::bf16_t, WS_WGU) + (size_t)lq * NEXP * 2048 * DM, CAP, 2048, DM};
            MoeOrder S{8, ntiles, Fq.G, Fq.bid, t2e, (long)2048 * DM * 2};
            moe_bias(Fq, ntiles, 8, ((const float*)Fq.in[I_BGU]) + (size_t)lq * NEXP * 2048, 2048);
            EpiAct E{WSQ(bf16_t, WS_ACT), (const LAS float*)(Fq.lds + LDS_BIASL)};
            if (STAG_GU) xcd_stagger(Fq, STAG_GU);
            pg8::gemm_phase_gather<EpiAct, MoeOrder>((PG8_LAS unsigned char*)Fq.lds, gm, S, E, (const PG8_LAS int*)(Fq.lds + LDS_MISC + 2048)); }
        SEAM(ph); ++ph; DIAG_ACC(10);
        nrep_ = NREP(11); if (PHEN(11) && IN(ph)) LAUNDERED { const int ntiles = moe_tables(Fq, lq); const LAS int* t2e = (const LAS int*)(Fq.lds + LDS_MISC) + 64;
            pg8::Gemm gm{WSQ(pg8::bf16_t, WS_ACT), WSQ(pg8::bf16_t, WS_WDN) + (size_t)lq * NEXP * DM * DM, CAP, DM, DM};
            MoeOrder S{4, ntiles, Fq.G, Fq.bid, t2e, (long)DM * DM * 2};
            moe_bias(Fq, ntiles, 4, ((const float*)Fq.in[I_BDN]) + (size_t)lq * NEXP * DM, DM);
            EpiDown E{WSQ(bf16_t, WS_YB), (const LAS float*)(Fq.lds + LDS_BIASL), REP_SKIP_STORES * rep_, WSQ(bf16_t, WS_U)};
            if (STAG_DN) xcd_stagger(Fq, STAG_DN);
            pg8::gemm_phase<EpiDown, MoeOrder>((PG8_LAS unsigned char*)Fq.lds, gm, S, E); }
        SEAM(ph); ++ph; DIAG_ACC(11);
    }
    { l_cur = 2;
        nrep_ = NREP(1); if (PHEN(1) && IN(ph)) LAUNDERED p1_norm<false>(Fq, lq);
        SEAM(ph); ++ph; DIAG_ACC(1);
        nrep_ = NREP(2); if (PHEN(2) && IN(ph)) LAUNDERED { pg8::Gemm gm{WSQ(pg8::bf16_t, WS_H), WSQ(pg8::bf16_t, WS_WIN) + (size_t)lq * NU * DM, NT, NU, DM}; pg8::StaticOrder S; S.init(NT, NU, Fq.G, Fq.bid);
            EpiU E{WSQ(bf16_t, WS_U), NU, WSQ(bf16_t, WS_US5)}; pg8::gemm_phase<EpiU, pg8::StaticOrder>((PG8_LAS unsigned char*)Fq.lds, gm, S, E); }
        SEAM(ph); ++ph; DIAG_ACC(2);
        nrep_ = NREP(3); if (PHEN(3) && IN(ph)) LAUNDERED {
            unsigned* qctr = WSQ(unsigned, WS_CTL) + CW_Q0 + 64 * (2 + 2 * lq + rep_ * 8);
            for (;;) { const int idx = q_next(Fq, qctr); if (idx >= NCH + 260 + N_S5H) break; const Frame Fi = launder(Fq);
                if (idx < NCH) { for (int q_ = 0; q_ < NREP(21); ++q_) p3_ssd_prep(Fi, lq, idx); }
                else if (idx < NCH + 260) { for (int q_ = 0; q_ < NREP(22); ++q_) p3_attn_prep(Fi, lq, idx - NCH); }
                else { for (int q_ = 0; q_ < NREP(23); ++q_) p3_s5_hloc(Fi, lq, idx - NCH - 260); }
            }
        }
        SEAM(ph); ++ph; DIAG_ACC(3);
        nrep_ = NREP(4); if (PHEN(4) && IN(ph)) LAUNDERED { for (int q_ = 0; q_ < NREP(16); ++q_) p4_ssd_scan(Fq, lq);
            for (int q_ = 0; q_ < NREP(17); ++q_) for (int it = Fq.bid; it < 256; it += Fq.G) { const Frame Fi = launder(Fq); p4_attn_diff(Fi, lq, it); }
            unsigned* qctr = WSQ(unsigned, WS_CTL) + CW_Q0 + 64 * (10 + lq + rep_ * 8);
            for (;;) { const int idx = q_next(Fq, qctr); if (idx >= 4) break; const Frame Fi = launder(Fq);
                p4_attn_diff(Fi, lq, 256 + idx); } }
        SEAM(ph); ++ph; DIAG_ACC(4);
        nrep_ = NREP(5); if (PHEN(5) && IN(ph)) LAUNDERED {
            if (false && gqa_fast_ok(Fq, lq)) { for (int q_ = 0; q_ < NREP(18); ++q_) for (int it = Fq.bid; it < 256; it += Fq.G) { const Frame Fi = launder(Fq); p4_attn_gqa<true>(Fi, lq, it); } }
            else { for (int q_ = 0; q_ < NREP(18); ++q_) for (int it = Fq.bid; it < 256; it += Fq.G) { const Frame Fi = launder(Fq); p4_attn_gqa<false>(Fi, lq, it); } }
            { unsigned* qctr = WSQ(unsigned, WS_CTL) + CW_Q0 + 64 * (3 + 2 * lq + rep_ * 8);
              for (;;) { const int idx = q_next(Fq, qctr); if (idx >= 2 * NCH + N_S5O + 4) break; const Frame Fi = launder(Fq);
                  if (idx < 2 * NCH) p4_ssd_out(Fi, lq, idx); else if (idx < 2 * NCH + N_S5O) p4_s5_out(Fi, lq, idx - 2 * NCH); else p4_attn_gqa<false>(Fi, lq, 256 + idx - 2 * NCH - N_S5O); } }
        }
        SEAM(ph); ++ph; DIAG_ACC(5);
        nrep_ = NREP(6); if (PHEN(6) && IN(ph)) LAUNDERED p5_finish(Fq, lq);
        SEAM(ph); ++ph; DIAG_ACC(6);
        nrep_ = NREP(7); if (PHEN(7) && IN(ph)) LAUNDERED { pg8::Gemm gm{WSQ(pg8::bf16_t, WS_MIX) + (size_t)CTX * DM, WSQ(pg8::bf16_t, WS_WOUT) + (size_t)lq * DM * DM, SEQ, DM, DM}; pg8::StaticOrder S; S.init(SEQ, DM, Fq.G, Fq.bid);
            EpiRes E; E.C = WSQ(float, WS_XA); E.g1 = WSQ(float, WS_MOD) + (size_t)lq * 2 * 6144 + 2 * 1024;
            if (lq == 0) { E.res_ctx = ((const float*)Fq.in[I_CTX]); E.res_lat = ((const float*)Fq.in[I_X]); } else { E.res_ctx = WSQ(float, WS_XB); E.res_lat = WSQ(float, WS_XB) + (size_t)CTX * DM; }
            pg8::gemm_phase<EpiRes, pg8::StaticOrder>((PG8_LAS unsigned char*)Fq.lds, gm, S, E);
            if (lq < DEPTH - 1) outproj_ctx(Fq, lq, E.res_ctx); }
        SEAM(ph); ++ph; DIAG_ACC(7);
        nrep_ = NREP(8); if (PHEN(8) && IN(ph)) LAUNDERED p7a_router(Fq, lq, rep_);
        SEAM(ph); ++ph; DIAG_ACC(8);
        nrep_ = NREP(10); if (PHEN(10) && IN(ph)) LAUNDERED { const int ntiles = moe_tables(Fq, lq); const LAS int* t2e = (const LAS int*)(Fq.lds + LDS_MISC) + 64;
            moe_rows(Fq, lq, ntiles, 8);
            pg8::Gemm gm{WSQ(pg8::bf16_t, WS_H), WSQ(pg8::bf16_t, WS_WGU) + (size_t)lq * NEXP * 2048 * DM, CAP, 2048, DM};
            MoeOrder S{8, ntiles, Fq.G, Fq.bid, t2e, (long)2048 * DM * 2};
            moe_bias(Fq, ntiles, 8, ((const float*)Fq.in[I_BGU]) + (size_t)lq * NEXP * 2048, 2048);
            EpiAct E{WSQ(bf16_t, WS_ACT), (const LAS float*)(Fq.lds + LDS_BIASL)};
            if (STAG_GU) xcd_stagger(Fq, STAG_GU);
            pg8::gemm_phase_gather<EpiAct, MoeOrder>((PG8_LAS unsigned char*)Fq.lds, gm, S, E, (const PG8_LAS int*)(Fq.lds + LDS_MISC + 2048)); }
        SEAM(ph); ++ph; DIAG_ACC(10);
        nrep_ = NREP(11); if (PHEN(11) && IN(ph)) LAUNDERED { const int ntiles = moe_tables(Fq, lq); const LAS int* t2e = (const LAS int*)(Fq.lds + LDS_MISC) + 64;
            pg8::Gemm gm{WSQ(pg8::bf16_t, WS_ACT), WSQ(pg8::bf16_t, WS_WDN) + (size_t)lq * NEXP * DM * DM, CAP, DM, DM};
            MoeOrder S{4, ntiles, Fq.G, Fq.bid, t2e, (long)DM * DM * 2};
            moe_bias(Fq, ntiles, 4, ((const float*)Fq.in[I_BDN]) + (size_t)lq * NEXP * DM, DM);
            EpiDown E{WSQ(bf16_t, WS_YB), (const LAS float*)(Fq.lds + LDS_BIASL), REP_SKIP_STORES * rep_, WSQ(bf16_t, WS_U)};
            if (STAG_DN) xcd_stagger(Fq, STAG_DN);
            pg8::gemm_phase<EpiDown, MoeOrder>((PG8_LAS unsigned char*)Fq.lds, gm, S, E); }
        SEAM(ph); ++ph; DIAG_ACC(11);
    }
    { l_cur = 3;
        nrep_ = NREP(1); if (PHEN(1) && IN(ph)) LAUNDERED p1_norm<false>(Fq, lq);
        SEAM(ph); ++ph; DIAG_ACC(1);
        nrep_ = NREP(2); if (PHEN(2) && IN(ph)) LAUNDERED { pg8::Gemm gm{WSQ(pg8::bf16_t, WS_H), WSQ(pg8::bf16_t, WS_WIN) + (size_t)lq * NU * DM, NT, NU, DM}; pg8::StaticOrder S; S.init(NT, NU, Fq.G, Fq.bid);
            EpiU E{WSQ(bf16_t, WS_U), NU, WSQ(bf16_t, WS_US5)}; pg8::gemm_phase<EpiU, pg8::StaticOrder>((PG8_LAS unsigned char*)Fq.lds, gm, S, E); }
        SEAM(ph); ++ph; DIAG_ACC(2);
        nrep_ = NREP(3); if (PHEN(3) && IN(ph)) LAUNDERED {
            unsigned* qctr = WSQ(unsigned, WS_CTL) + CW_Q0 + 64 * (2 + 2 * lq + rep_ * 8);
            for (;;) { const int idx = q_next(Fq, qctr); if (idx >= NCH + 260 + N_S5H) break; const Frame Fi = launder(Fq);
                if (idx < NCH) { for (int q_ = 0; q_ < NREP(21); ++q_) p3_ssd_prep(Fi, lq, idx); }
                else if (idx < NCH + 260) { for (int q_ = 0; q_ < NREP(22); ++q_) p3_attn_prep(Fi, lq, idx - NCH); }
                else { for (int q_ = 0; q_ < NREP(23); ++q_) p3_s5_hloc(Fi, lq, idx - NCH - 260); }
            }
        }
        SEAM(ph); ++ph; DIAG_ACC(3);
        nrep_ = NREP(4); if (PHEN(4) && IN(ph)) LAUNDERED { for (int q_ = 0; q_ < NREP(16); ++q_) p4_ssd_scan(Fq, lq);
            for (int q_ = 0; q_ < NREP(17); ++q_) for (int it = Fq.bid; it < 256; it += Fq.G) { const Frame Fi = launder(Fq); p4_attn_diff(Fi, lq, it); }
            unsigned* qctr = WSQ(unsigned, WS_CTL) + CW_Q0 + 64 * (10 + lq + rep_ * 8);
            for (;;) { const int idx = q_next(Fq, qctr); if (idx >= 4) break; const Frame Fi = launder(Fq);
                p4_attn_diff(Fi, lq, 256 + idx); } }
        SEAM(ph); ++ph; DIAG_ACC(4);
        nrep_ = NREP(5); if (PHEN(5) && IN(ph)) LAUNDERED {
            if (false && gqa_fast_ok(Fq, lq)) { for (int q_ = 0; q_ < NREP(18); ++q_) for (int it = Fq.bid; it < 256; it += Fq.G) { const Frame Fi = launder(Fq); p4_attn_gqa<true>(Fi, lq, it); } }
            else { for (int q_ = 0; q_ < NREP(18); ++q_) for (int it = Fq.bid; it < 256; it += Fq.G) { const Frame Fi = launder(Fq); p4_attn_gqa<false>(Fi, lq, it); } }
            { unsigned* qctr = WSQ(unsigned, WS_CTL) + CW_Q0 + 64 * (3 + 2 * lq + rep_ * 8);
              for (;;) { const int idx = q_next(Fq, qctr); if (idx >= 2 * NCH + N_S5O + 4) break; const Frame Fi = launder(Fq);
                  if (idx < 2 * NCH) p4_ssd_out(Fi, lq, idx); else if (idx < 2 * NCH + N_S5O) p4_s5_out(Fi, lq, idx - 2 * NCH); else p4_attn_gqa<false>(Fi, lq, 256 + idx - 2 * NCH - N_S5O); } }
        }
        SEAM(ph); ++ph; DIAG_ACC(5);
        nrep_ = NREP(6); if (PHEN(6) && IN(ph)) LAUNDERED p5_finish(Fq, lq);
        SEAM(ph); ++ph; DIAG_ACC(6);
        nrep_ = NREP(7); if (PHEN(7) && IN(ph)) LAUNDERED { pg8::Gemm gm{WSQ(pg8::bf16_t, WS_MIX) + (size_t)CTX * DM, WSQ(pg8::bf16_t, WS_WOUT) + (size_t)lq * DM * DM, SEQ, DM, DM}; pg8::StaticOrder S; S.init(SEQ, DM, Fq.G, Fq.bid);
            EpiRes E; E.C = WSQ(float, WS_XA); E.g1 = WSQ(float, WS_MOD) + (size_t)lq * 2 * 6144 + 2 * 1024;
            if (lq == 0) { E.res_ctx = ((const float*)Fq.in[I_CTX]); E.res_lat = ((const float*)Fq.in[I_X]); } else { E.res_ctx = WSQ(float, WS_XB); E.res_lat = WSQ(float, WS_XB) + (size_t)CTX * DM; }
            pg8::gemm_phase<EpiRes, pg8::StaticOrder>((PG8_LAS unsigned char*)Fq.lds, gm, S, E);
            if (lq < DEPTH - 1) outproj_ctx(Fq, lq, E.res_ctx); }
        SEAM(ph); ++ph; DIAG_ACC(7);
        nrep_ = NREP(8); if (PHEN(8) && IN(ph)) LAUNDERED p7a_router(Fq, lq, rep_);
        SEAM(ph); ++ph; DIAG_ACC(8);
        nrep_ = NREP(10); if (PHEN(10) && IN(ph)) LAUNDERED { const int ntiles = moe_tables(Fq, lq); const LAS int* t2e = (const LAS int*)(Fq.lds + LDS_MISC) + 64;
            moe_rows(Fq, lq, ntiles, 8);
            pg8::Gemm gm{WSQ(pg8::bf16_t, WS_H), WSQ(pg8::bf16_t, WS_WGU) + (size_t)lq * NEXP * 2048 * DM, CAP, 2048, DM};
            MoeOrder S{8, ntiles, Fq.G, Fq.bid, t2e, (long)2048 * DM * 2};
            moe_bias(Fq, ntiles, 8, ((const float*)Fq.in[I_BGU]) + (size_t)lq * NEXP * 2048, 2048);
            EpiAct E{WSQ(bf16_t, WS_ACT), (const LAS float*)(Fq.lds + LDS_BIASL)};
            if (STAG_GU) xcd_stagger(Fq, STAG_GU);
            pg8::gemm_phase_gather<EpiAct, MoeOrder>((PG8_LAS unsigned char*)Fq.lds, gm, S, E, (const PG8_LAS int*)(Fq.lds + LDS_MISC + 2048)); }
        SEAM(ph); ++ph; DIAG_ACC(10);
        nrep_ = NREP(11); if (PHEN(11) && IN(ph)) LAUNDERED { const int ntiles = moe_tables(Fq, lq); const LAS int* t2e = (const LAS int*)(Fq.lds + LDS_MISC) + 64;
            pg8::Gemm gm{WSQ(pg8::bf16_t, WS_ACT), WSQ(pg8::bf16_t, WS_WDN) + (size_t)lq * NEXP * DM * DM, CAP, DM, DM};
            MoeOrder S{4, ntiles, Fq.G, Fq.bid, t2e, (long)DM * DM * 2};
            moe_bias(Fq, ntiles, 4, ((const float*)Fq.in[I_BDN]) + (size_t)lq * NEXP * DM, DM);
            EpiDown E{WSQ(bf16_t, WS_YB), (const LAS float*)(Fq.lds + LDS_BIASL), REP_SKIP_STORES * rep_, WSQ(bf16_t, WS_U)};
            if (STAG_DN) xcd_stagger(Fq, STAG_DN);
            pg8::gemm_phase<EpiDown, MoeOrder>((PG8_LAS unsigned char*)Fq.lds, gm, S, E); }
        SEAM(ph); ++ph; DIAG_ACC(11);
    }
#if DIAG
    if (blockIdx.x == 0 && threadIdx.x < 16) __hip_atomic_store((unsigned*)(F.ws + WS_CTL) + 5000 + threadIdx.x, dg[threadIdx.x], __ATOMIC_RELAXED, __HIP_MEMORY_SCOPE_AGENT);
    xcd_barrier(bar);
    { const unsigned* dgw = (const unsigned*)(F.ws + WS_CTL) + 5000;
      const float ta = (float)__hip_atomic_load(dgw + DIAG_A, __ATOMIC_RELAXED, __HIP_MEMORY_SCOPE_AGENT) * 0.01f;
      const float cval = sqrtf(ta * (1.f / DIAG_DIV));
      for (size_t i = (size_t)blockIdx.x * 512 + threadIdx.x; i < (size_t)SEQ * DM; i += (size_t)gridDim.x * 512) F.out[i] = cval; }
#else
    nrep_ = NREP(12); if (PHEN(12) && IN(ph)) LAUNDERED { (void)lq; p1_norm<true>(Fq, DEPTH); }
#endif
#undef IN
#undef SEAM
}

#ifndef N_LAUNCH_MODE
#define N_LAUNCH_MODE 1
#endif
extern "C" void kernel_launch(void* const* d_in, const int* in_sizes, int n_in, void* d_out, int out_size, void* d_ws, size_t ws_size, hipStream_t stream) {
    static int grid = 0;
    if (grid == 0) {
        if (n_in != N_IN || out_size != SEQ * DM || ws_size < WS_END) { fprintf(stderr, "kernel_launch: unexpected shapes (n_in %d, out %d, ws %zu < %zu)\n", n_in, out_size, ws_size, (size_t)WS_END); grid = -1; return; }
        int dev = 0, cus = 0, per_cu = 0;
        if (hipGetDevice(&dev) != hipSuccess || hipDeviceGetAttribute(&cus, hipDeviceAttributeMultiprocessorCount, dev) != hipSuccess) { grid = -1; return; }
        if (hipFuncSetAttribute((const void*)hybrid_fwd, hipFuncAttributeMaxDynamicSharedMemorySize, LDS_BYTES) != hipSuccess) { fprintf(stderr, "kernel_launch: hipFuncSetAttribute failed\n"); grid = -1; return; }
        if (hipOccupancyMaxActiveBlocksPerMultiprocessor(&per_cu, (const void*)hybrid_fwd, 512, LDS_BYTES) != hipSuccess || per_cu < 1) { fprintf(stderr, "kernel_launch: occupancy query says %d\n", per_cu); }
        (void)hipGetLastError();
        grid = cus;
    }
    if (grid < 0) return;
    (void)hipMemsetAsync((char*)d_ws + WS_CTL, 0, CTL_BYTES, stream);
    Args a{};
    for (int i = 0; i < N_IN; ++i) a.in[i] = (const float*)d_in[i];
    a.out = (float*)d_out; a.ws = (unsigned char*)d_ws;
#if N_LAUNCH_MODE == 1
    a.ph_lo = 0; a.ph_hi = N_PHASES;
    hipLaunchKernelGGL(hybrid_fwd, dim3(grid), dim3(512), LDS_BYTES, stream, a);
#else
    for (int p = 0; p < N_PHASES; ++p) { a.ph_lo = p; a.ph_hi = p + 1; hipLaunchKernelGGL(hybrid_fwd, dim3(grid), dim3(512), LDS_BYTES, stream, a); }
#endif
}
```

```cpp
#include <hip/hip_runtime.h>
#include <cstdio>
#include <cstdint>

#define DI __device__ __forceinline__
typedef float f32x2 __attribute__((ext_vector_type(2)));
typedef float f32x16 __attribute__((ext_vector_type(16)));
typedef unsigned u32x2 __attribute__((ext_vector_type(2)));
typedef __bf16 hbf2 __attribute__((ext_vector_type(2)));

constexpr int DM = 1024, SEQ = 16384, CTX = 256, NT = SEQ + CTX, DEPTH = 4;
constexpr int DIN = 2568, NU = 2560;
constexpr int DT_COL = 1792;
constexpr int NEXP = 32, TOPK = 4;
constexpr int CAP = 292 * 256;
constexpr float EPS = 1e-6f;
constexpr float LOG2E = 1.4426950408889634f;
constexpr int NCH = NT / 128;
constexpr int S5L = 64, NC5 = NT / S5L;
constexpr int U_DQ = 0, U_DK = 256, U_DV = 512, U_Z = 768, U_XS = 1024, U_B = 1280, U_C = 1536, U_S5 = 1792, U_GQ = 2048, U_GK = 2304, U_GV = 2432;

enum { I_X = 0, I_C, I_CTX, I_CCTX, I_WADA, I_BADA, I_N1W, I_N2W, I_WIN, I_WOUT, I_LQ1, I_LK1, I_LQ2, I_LK2, I_SUBLN,
       I_CONVW, I_CONVB, I_DTB, I_ALOG, I_SSDD, I_SSDNW, I_LAMRE, I_LAMIM, I_LOGDT, I_BRE, I_BIM, I_CRE, I_CIM, I_S5D, I_WGLU, I_BGLU,
       I_QNW, I_KNW, I_WR, I_BR, I_WGU, I_BGU, I_WDN, I_BDN, I_FNW, N_IN };

constexpr size_t al256(size_t x) { return (x + 255) & ~(size_t)255; }
constexpr size_t WS_CTL   = 0;
constexpr size_t CTL_BYTES = 65536;
constexpr int CW_BAR = 0;
constexpr int CW_KMAX = 4096;
constexpr int CW_CNT = 4096 + 128;
constexpr int CW_Q0 = 4096 + 128 + 128;
constexpr size_t WS_MOD   = WS_CTL + CTL_BYTES;
constexpr size_t WS_ROPE  = al256(WS_MOD + (size_t)DEPTH * 2 * 6144 * 4);
constexpr size_t WS_LAM   = al256(WS_ROPE + 256 * 8 * 8 + 256 * 16 * 8);
constexpr size_t WS_WIN   = al256(WS_LAM + 256);
constexpr size_t WS_WOUT  = al256(WS_WIN + (size_t)DEPTH * NU * DM * 2);
constexpr size_t WS_WGU   = al256(WS_WOUT + (size_t)DEPTH * DM * DM * 2);
constexpr size_t WS_WDN   = al256(WS_WGU + (size_t)DEPTH * NEXP * 2048 * DM * 2);
constexpr size_t WS_WGLU  = al256(WS_WDN + (size_t)DEPTH * NEXP * DM * DM * 2);
constexpr size_t WS_KTAB  = al256(WS_WGLU + (size_t)DEPTH * 256 * 256 * 2);
constexpr size_t WS_CC5   = al256(WS_KTAB + (size_t)DEPTH * 16 * 3 * 64 * 256 * 2);
constexpr size_t WS_E5    = al256(WS_CC5 + (size_t)DEPTH * 16 * 1024 * 256 * 2);
constexpr size_t WS_APOW  = al256(WS_E5 + (size_t)DEPTH * 16 * 2 * 128 * 1024 * 2);
constexpr size_t WS_XA    = al256(WS_APOW + (size_t)DEPTH * 16 * 2 * 64 * 8);
constexpr size_t WS_XB    = al256(WS_XA + (size_t)NT * DM * 4);
constexpr size_t WS_H     = al256(WS_XB + (size_t)NT * DM * 4);
constexpr size_t WS_U     = al256(WS_H + (size_t)NT * DM * 2);
constexpr size_t WS_DTRAW = al256(WS_U + (size_t)NT * NU * 2);
constexpr size_t WS_QD    = al256(WS_DTRAW + (size_t)NT * 8 * 4);
constexpr size_t WS_KD    = al256(WS_QD + (size_t)4 * NT * 64 * 2);
constexpr size_t WS_VTD   = al256(WS_KD + (size_t)4 * NT * 64 * 2);
constexpr size_t WS_QG    = al256(WS_VTD + (size_t)4 * NT * 64 * 2);
constexpr size_t WS_KG    = al256(WS_QG + (size_t)4 * NT * 64 * 2);
constexpr size_t WS_VTG   = al256(WS_KG + (size_t)2 * NT * 64 * 2);
constexpr size_t WS_QND   = al256(WS_VTG + (size_t)2 * NT * 64 * 2);
constexpr size_t WS_QNG   = al256(WS_QND + (size_t)8 * NT * 4);
constexpr size_t WS_XST   = al256(WS_QNG + (size_t)4 * NT * 4);
constexpr size_t WS_BN    = al256(WS_XST + (size_t)NT * 256 * 2);
constexpr size_t WS_CN    = al256(WS_BN + (size_t)NT * 256 * 2);
constexpr size_t WS_DTV   = al256(WS_CN + (size_t)NT * 256 * 2);
constexpr size_t WS_CUM   = al256(WS_DTV + (size_t)NT * 8 * 4);
constexpr size_t WS_SLOC  = al256(WS_CUM + (size_t)NT * 8 * 4);
constexpr size_t WS_SIN   = al256(WS_SLOC + (size_t)NCH * 8 * 64 * 128 * 4);
constexpr size_t WS_YSSD  = al256(WS_SIN + (size_t)NCH * 8 * 64 * 128 * 2);
constexpr size_t WS_SSQ   = al256(WS_YSSD + (size_t)NT * 256 * 2);
constexpr size_t WS_HLOC  = al256(WS_SSQ + (size_t)NT * 4 * 4);
constexpr size_t WS_HIN   = al256(WS_HLOC + (size_t)NC5 * 4096 * 4);
constexpr size_t WS_YS5   = al256(WS_HIN + (size_t)NC5 * 4096 * 2);
constexpr size_t WS_US5   = al256(WS_YS5 + (size_t)NT * 256 * 2);
constexpr size_t WS_MIX   = al256(WS_US5 + (size_t)NT * 256 * 2);
constexpr size_t WS_TOPE  = al256(WS_MIX + (size_t)NT * DM * 2);
constexpr size_t WS_TOPP  = al256(WS_TOPE + (size_t)NT * 16);
constexpr size_t WS_TOPG  = al256(WS_TOPP + (size_t)NT * 16);
constexpr size_t WS_TOPS  = al256(WS_TOPG + (size_t)NT * 16);
constexpr size_t WS_ASLOT = al256(WS_TOPS + (size_t)NEXP * NT * 4);
constexpr size_t WS_ACT   = al256(WS_ASLOT + (size_t)CAP * DM * 2);
constexpr size_t WS_YB    = al256(WS_ACT + (size_t)CAP * DM * 2);
constexpr size_t WS_END   = al256(WS_YB + (size_t)CAP * DM * 2);

constexpr int LDS_BYTES = 160 * 1024;
constexpr int LDS_MISC = 128 * 1024;
#define LAS __attribute__((address_space(3)))
#define GAS __attribute__((address_space(1)))

struct Args { const float* in[N_IN]; float* out; unsigned char* ws; int ph_lo, ph_hi; };

typedef unsigned short bf16_t;
typedef short bf16x8 __attribute__((ext_vector_type(8)));
typedef float f32x4 __attribute__((ext_vector_type(4)));
typedef unsigned u32x4 __attribute__((ext_vector_type(4)));

DI unsigned pk2(float lo, float hi) { f32x2 v = {lo, hi}; hbf2 b = __builtin_convertvector(v, hbf2); return __builtin_bit_cast(unsigned, b); }
DI bf16_t f2bf(float f) { return (bf16_t)(pk2(f, 0.f) & 0xffffu); }
DI float bf2f(bf16_t b) { return __uint_as_float(((unsigned)b) << 16); }
DI float bflo(unsigned u) { return __uint_as_float(u << 16); }
DI float bfhi(unsigned u) { return __uint_as_float(u & 0xffff0000u); }
DI f32x16 mfma32(bf16x8 a, bf16x8 b, f32x16 c) { return __builtin_amdgcn_mfma_f32_32x32x16_bf16(a, b, c, 0, 0, 0); }
DI int kperm(int m) { return (m & 0x13) | ((m & 4) << 1) | ((m & 8) >> 1); }
DI int crow(int i, int h) { return (i & 3) + 8 * (i >> 2) + 4 * h; }
DI bf16x8 ld8g(const bf16_t* p) { return *(const bf16x8*)p; }
template <int CTRL> DI float dppf(float v) { return __builtin_bit_cast(float, __builtin_amdgcn_update_dpp(0, __builtin_bit_cast(int, v), CTRL, 0xF, 0xF, true)); }
DI float rlane(float v, int l) { return __builtin_bit_cast(float, __builtin_amdgcn_readlane(__builtin_bit_cast(int, v), l)); }
DI float wave_sum(float v) {
    v += dppf<0xB1>(v); v += dppf<0x4E>(v); v += dppf<0x141>(v); v += dppf<0x140>(v);
    return (rlane(v, 0) + rlane(v, 16)) + (rlane(v, 32) + rlane(v, 48));
}
DI float wave_max(float v) {
    v = fmaxf(v, dppf<0xB1>(v)); v = fmaxf(v, dppf<0x4E>(v)); v = fmaxf(v, dppf<0x141>(v)); v = fmaxf(v, dppf<0x140>(v));
    return fmaxf(fmaxf(rlane(v, 0), rlane(v, 16)), fmaxf(rlane(v, 32), rlane(v, 48)));
}
DI float silu_f(float x) { return x * __builtin_amdgcn_rcpf(1.f + __builtin_amdgcn_exp2f(-1.4426950408889634f * x)); }
DI float sigmoid_f(float x) { return __builtin_amdgcn_rcpf(1.f + __builtin_amdgcn_exp2f(-1.4426950408889634f * x)); }
template <int S> DI bf16x8 pack_step(const f32x16& x) {
    u32x4 p;
    p[0] = pk2(x[8 * S + 0], x[8 * S + 1]); p[1] = pk2(x[8 * S + 2], x[8 * S + 3]);
    p[2] = pk2(x[8 * S + 4], x[8 * S + 5]); p[3] = pk2(x[8 * S + 6], x[8 * S + 7]);
    return __builtin_bit_cast(bf16x8, p);
}
DI f32x16 splat16(float v) { f32x16 r;
#pragma unroll
    for (int i = 0; i < 16; ++i) r[i] = v; return r; }
#define XB_TMO      128
#define XB_XCNT(j)  (256  + 64 * (j))
#define XB_XSUB(j)  (1280 + 64 * (j))
#define XB_XGEN(j)  (2304 + 64 * (j))
#define XB_TOP      3328
#define XB_TOPGEN   3392
#define XCD_BAR_WORDS 3456
#define XB_SPIN_CAP (1u << 18)
#define LAS __attribute__((address_space(3)))

__device__ __forceinline__ unsigned xb_ld(unsigned* p)              { return __hip_atomic_load(p, __ATOMIC_RELAXED, __HIP_MEMORY_SCOPE_AGENT); }
__device__ __forceinline__ unsigned xb_add(unsigned* p, unsigned v) { return __hip_atomic_fetch_add(p, v, __ATOMIC_RELAXED, __HIP_MEMORY_SCOPE_AGENT); }
__device__ __forceinline__ unsigned xb_xcc_id() { return (unsigned)__builtin_amdgcn_s_getreg((3 << 11) | 20) & 0xFu; }
#define XB_SPIN(cond, bar) do { unsigned _sp = 0; while (cond) { __builtin_amdgcn_s_sleep(1); \
    if ((++_sp & 255u) == 0u) { if (xb_ld(&(bar)[XB_TMO])) break; if (_sp > XB_SPIN_CAP) { atomicAdd(&(bar)[XB_TMO], 1u); break; } } } } while (0)

struct XcdBarrier {
    unsigned* bar; unsigned x;
    volatile LAS unsigned* st;
};

__device__ __forceinline__ XcdBarrier xcd_barrier_post(unsigned* bar, volatile LAS unsigned* st) {
    XcdBarrier b; b.bar = bar; b.x = xb_xcc_id(); b.st = st;
    if (threadIdx.x == 0) (void)xb_add(&bar[XB_XCNT(b.x)], 1u);
    return b;
}
__device__ __forceinline__ void xcd_barrier_complete(unsigned* bar, unsigned x, unsigned& nloc, unsigned& nx) {
    const unsigned G = gridDim.x * gridDim.y * gridDim.z;
    unsigned sum, cnt, mine, sp = 0u;
    for (;;) {
        sum = 0u; cnt = 0u; mine = 0u;
#pragma unroll
        for (unsigned j = 0; j < 16; ++j) { const unsigned c = xb_ld(&bar[XB_XCNT(j)]); sum += c; cnt += (c > 0u) ? 1u : 0u; mine = (j == x) ? c : mine; }
        if (sum == G) break;
        __builtin_amdgcn_s_sleep(1);
        if ((++sp & 255u) == 0u) { if (xb_ld(&bar[XB_TMO])) break; if (sp > XB_SPIN_CAP) { atomicAdd(&bar[XB_TMO], 1u); break; } }
    }
    nloc = mine > 0u ? mine : 1u; nx = cnt > 0u ? cnt : 1u;
}

__device__ __forceinline__ void xcd_barrier(const XcdBarrier& b) {
    asm volatile("s_waitcnt vmcnt(0)" ::: "memory");
    __syncthreads();
    if (threadIdx.x == 0) {
        unsigned* bar = b.bar;
        __builtin_amdgcn_s_waitcnt(0);
        unsigned nloc = b.st[0], nx = b.st[1];
        if (nloc == 0u) { xcd_barrier_complete(bar, b.x, nloc, nx); b.st[0] = nloc; b.st[1] = nx; }
        const unsigned old = xb_add(&bar[XB_XSUB(b.x)], 1u);
        const unsigned gen = old / nloc;
        if (old + 1u == (gen + 1u) * nloc) {
            __builtin_amdgcn_fence(__ATOMIC_RELEASE, "agent");
            asm volatile("s_waitcnt vmcnt(0)" ::: "memory");
            const unsigned og = xb_add(&bar[XB_TOP], 1u);
            const unsigned tg = og / nx;
            if (og + 1u == (tg + 1u) * nx) xb_add(&bar[XB_TOPGEN], 1u);
            else XB_SPIN(xb_ld(&bar[XB_TOPGEN]) == tg, bar);
            __builtin_amdgcn_fence(__ATOMIC_ACQUIRE, "agent");
            xb_add(&bar[XB_XGEN(b.x)], 1u);
            asm volatile("s_waitcnt vmcnt(0)" ::: "memory");
        } else {
            XB_SPIN(xb_ld(&bar[XB_XGEN(b.x)]) == gen, bar);
            __builtin_amdgcn_fence(__ATOMIC_ACQUIRE, "agent");
            asm volatile("s_waitcnt vmcnt(0)" ::: "memory");
        }
    }
    __syncthreads();
}
namespace pg8 {
#define PG8_LAS __attribute__((address_space(3)))
typedef unsigned short bf16_t;
typedef short bf16x8 __attribute__((ext_vector_type(8)));
typedef float f32x4 __attribute__((ext_vector_type(4)));
typedef unsigned u32x4 __attribute__((ext_vector_type(4)));
constexpr int BM = 256, BK = 64, HALF = 128, HTB = HALF * BK * 2  , STAGE_BYTES = 8 * HTB, NXCD = 8, WGM = 8;

__host__ __device__ __forceinline__ int lds_byte(int r, int c) { const int st = (r >> 4) * 2 + (c >> 5), rr = r & 15, cc = c & 31, ob = rr * 64 + cc * 2; return st * 1024 + (ob ^ (((ob >> 9) & 1) << 5)); }
__host__ __device__ __forceinline__ void stage_rc(int b, int& R, int& C) { const int st = b / 1024, sb = b % 1024, swz = sb ^ (((sb >> 9) & 1) << 5); R = (st >> 1) * 16 + swz / 64; C = (st & 1) * 32 + (swz % 64) / 2; }
__host__ __device__ __forceinline__ int perm32(int rho) { const int n = rho >> 4, i = rho & 15; return 8 * (i >> 2) + 4 * n + (i & 3); }

struct Unit { int pm, pn; long boff; };
struct Gemm { const bf16_t* A; const bf16_t* Bt; int M, N, K; };

struct StaticOrder {
    int nM, nN, nwg, G, c;
    __host__ __device__ void init(int M, int N, int G_, int c_) { nM = M / BM; nN = N / BM; nwg = nM * nN; G = G_; c = c_; }
    __host__ __device__ bool next(int i, Unit& u) const {
        const long L = (long)i * G + c; if (L >= nwg) return false;
        int wgid = (int)L; { const int q = nwg / NXCD, r = nwg % NXCD, xcd = wgid % NXCD, off = wgid / NXCD; wgid = (xcd < r ? xcd * (q + 1) : r * (q + 1) + (xcd - r) * q) + off; }
        const int nig = WGM * nN, gid = wgid / nig, fm = gid * WGM, gsz = (nM - fm) < WGM ? (nM - fm) : WGM;
        u.pm = fm + ((wgid % nig) % gsz); u.pn = (wgid % nig) / gsz; u.boff = 0; return true;
    }
    __device__ __forceinline__ void a_ready(const Unit&) const {}
    __device__ __forceinline__ void done(const Unit&) const {}
};
__device__ __forceinline__ unsigned cvt_pk_bf16(float lo, float hi) { unsigned r; asm volatile("v_cvt_pk_bf16_f32 %0, %1, %2" : "=v"(r) : "v"(lo), "v"(hi)); return r; }
template <class Epi, class Sched, bool STAMP = false>
__device__ __forceinline__ void gemm_phase(PG8_LAS unsigned char* lds, const Gemm g, const Sched& S, const Epi& E, unsigned long long* stamps = nullptr) {
    int tid_l = threadIdx.x; asm volatile("" : "+v"(tid_l)); const int tid = tid_l, wid = __builtin_amdgcn_readfirstlane(tid >> 6), lane = tid & 63, wr = wid >> 2, wc = wid & 3, fr = lane & 15, fq = lane >> 4;
    const int K = g.K, nt = K / BK;
    int ts_lo = 0, ts_hi = 0, nts = 0; const unsigned long long rt_entry = STAMP ? (unsigned long long)wall_clock64() : 0ull;
#define PG8_STAMP() do { if (STAMP && wid == 0 && nts < 64) { const unsigned long long _c = (unsigned long long)clock64(); \
        ts_lo = (lane == nts) ? (int)(unsigned)_c : ts_lo; ts_hi = (lane == nts) ? (int)(unsigned)(_c >> 32) : ts_hi; ++nts; } } while (0)
    PG8_STAMP();
    unsigned voffA[2], voffB[2];
#pragma unroll
    for (int i = 0; i < 2; ++i) { int R, C; stage_rc(tid * 16 + i * 8192, R, C); const int Rb = Epi::PERM ? ((R & ~31) + perm32(R & 31)) : R;
        voffA[i] = (unsigned)(R * K + C) * 2u; voffB[i] = (unsigned)(Rb * K + C) * 2u; }
    const size_t kstep = (size_t)(BK * 2);
    const size_t hstep = (size_t)HALF * K * 2;
    const size_t tstep = 2 * hstep;
    const unsigned ldsw = (unsigned)wid * 1024u;
    const int aoff = lds_byte(wr * 64 + fr, fq * 8), boff = lds_byte(wc * 32 + fr, fq * 8);
#define PG8_SA(b, h) (((b) * 2 + (h)) * HTB)
#define PG8_SB(b, h) ((4 + (b) * 2 + (h)) * HTB)
#define PG8_STAGE(bufoff, gbase, voff) do { _Pragma("unroll") for (int _i = 0; _i < 2; ++_i) \
        __builtin_amdgcn_global_load_lds((const unsigned*)((const char*)(gbase) + (voff)[_i]), (PG8_LAS unsigned*)(lds + (bufoff) + ldsw + _i * 8192), 16, 0, 0); } while (0)
#define PG8_LDA(dst, b, h) do { _Pragma("unroll") for (int m = 0; m < 4; ++m) _Pragma("unroll") for (int k = 0; k < 2; ++k) dst[m][k] = *(const PG8_LAS bf16x8*)(lds + PG8_SA(b, h) + aoff + m * 2048 + k * 1024); } while (0)
#define PG8_LDB(dst, b, h) do { _Pragma("unroll") for (int n = 0; n < 2; ++n) _Pragma("unroll") for (int k = 0; k < 2; ++k) dst[n][k] = *(const PG8_LAS bf16x8*)(lds + PG8_SB(b, h) + boff + n * 2048 + k * 1024); } while (0)
#define PG8_MMA(ai, bj, At, Bt) do { __builtin_amdgcn_s_setprio(1); _Pragma("unroll") for (int m = 0; m < 4; ++m) _Pragma("unroll") for (int n = 0; n < 2; ++n) _Pragma("unroll") for (int k = 0; k < 2; ++k) \
        acc[ai][bj][m][n] = __builtin_amdgcn_mfma_f32_16x16x32_bf16(Bt[n][k], At[m][k], acc[ai][bj][m][n], 0, 0, 0); __builtin_amdgcn_s_setprio(0); } while (0)
#define PG8_WAIT_V(n) asm volatile("s_waitcnt vmcnt(" #n ")" ::: "memory")
#define PG8_WAIT_L(n) asm volatile("s_waitcnt lgkmcnt(" #n ")" ::: "memory")
#define PG8_BAR __builtin_amdgcn_s_barrier()
#define PG8_SCHED __builtin_amdgcn_sched_barrier(0)
    Unit cur, nxt; int ui = 0;
    if (!S.next(0, cur)) return;
    f32x4 acc[2][2][4][2];
#pragma unroll
    for (int a = 0; a < 2; ++a)
#pragma unroll
        for (int b = 0; b < 2; ++b)
#pragma unroll
            for (int m = 0; m < 4; ++m)
#pragma unroll
                for (int n = 0; n < 2; ++n) acc[a][b][m][n] = (f32x4){0.f, 0.f, 0.f, 0.f};
    bf16x8 At[4][2], B0[2][2], B1[2][2];
    const char* cA = (const char*)g.A + (size_t)cur.pm * tstep; const char* cB = (const char*)g.Bt + (size_t)cur.pn * tstep + cur.boff;
    S.a_ready(cur);
    PG8_STAGE(PG8_SB(0, 0), cB, voffB); PG8_STAGE(PG8_SA(0, 0), cA, voffA); PG8_STAGE(PG8_SB(0, 1), cB + hstep, voffB); PG8_STAGE(PG8_SA(0, 1), cA + hstep, voffA);
    if (wr == 1) PG8_BAR;
    PG8_WAIT_V(4); PG8_BAR;
    PG8_STAGE(PG8_SB(1, 0), cB + kstep, voffB); PG8_STAGE(PG8_SA(1, 0), cA + kstep, voffA); PG8_STAGE(PG8_SB(1, 1), cB + hstep + kstep, voffB);
    PG8_WAIT_V(6); PG8_BAR;
    PG8_STAMP();
    for (;;) {
        const bool has_next = S.next(ui + 1, nxt);
        const char* nA = has_next ? (const char*)g.A + (size_t)nxt.pm * tstep : cA; const char* nB = has_next ? (const char*)g.Bt + (size_t)nxt.pn * tstep + nxt.boff : cB;
        for (int t = 0; t < nt; t += 2) {
            const bool last = (t == nt - 2);
            const char* a1 = cA + (size_t)(t + 1) * kstep;
            const char* a2 = last ? nA : cA + (size_t)(t + 2) * kstep; const char* b2 = last ? nB : cB + (size_t)(t + 2) * kstep;
            const char* a3 = a2 + kstep; const char* b3 = b2 + kstep;
            if (last && has_next) S.a_ready(nxt);
            PG8_LDB(B0, 0, 0); PG8_SCHED; PG8_LDA(At, 0, 0); PG8_STAGE(PG8_SA(1, 1), a1 + hstep, voffA);
            PG8_WAIT_L(8); PG8_BAR; PG8_WAIT_L(0); PG8_MMA(0, 0, At, B0); PG8_BAR; PG8_SCHED;
            PG8_LDB(B1, 0, 1); PG8_STAGE(PG8_SB(0, 0), b2, voffB);
            PG8_BAR; PG8_WAIT_L(0); PG8_MMA(0, 1, At, B1); PG8_BAR;
            PG8_LDA(At, 0, 1); PG8_STAGE(PG8_SA(0, 0), a2, voffA);
            PG8_BAR; PG8_WAIT_L(0); PG8_MMA(1, 0, At, B0); PG8_BAR; PG8_SCHED;
            PG8_STAGE(PG8_SB(0, 1), b2 + hstep, voffB);
            PG8_WAIT_V(6); PG8_BAR; PG8_MMA(1, 1, At, B1); PG8_BAR;
            PG8_LDB(B0, 1, 0); PG8_SCHED; PG8_LDA(At, 1, 0); PG8_STAGE(PG8_SA(0, 1), a2 + hstep, voffA);
            PG8_WAIT_L(8); PG8_BAR; PG8_WAIT_L(0); PG8_MMA(0, 0, At, B0); PG8_BAR; PG8_SCHED;
            PG8_LDB(B1, 1, 1); PG8_STAGE(PG8_SB(1, 0), b3, voffB);
            PG8_BAR; PG8_WAIT_L(0); PG8_MMA(0, 1, At, B1); PG8_BAR;
            PG8_LDA(At, 1, 1); PG8_STAGE(PG8_SA(1, 0), a3, voffA);
            PG8_BAR; PG8_WAIT_L(0); PG8_MMA(1, 0, At, B0); PG8_BAR; PG8_SCHED;
            PG8_STAGE(PG8_SB(1, 1), b3 + hstep, voffB);
            PG8_WAIT_V(6); PG8_BAR; PG8_MMA(1, 1, At, B1); PG8_BAR;
        }
        PG8_STAMP();
        if constexpr (!Epi::AFTER_DRAIN) { E(acc, cur, wr, wc, fr, fq); S.done(cur); }
        PG8_STAMP();
        if (!has_next) break;
#pragma unroll
        for (int a = 0; a < 2; ++a)
#pragma unroll
            for (int b = 0; b < 2; ++b)
#pragma unroll
                for (int m = 0; m < 4; ++m)
#pragma unroll
                    for (int n = 0; n < 2; ++n) acc[a][b][m][n] = (f32x4){0.f, 0.f, 0.f, 0.f};
        cur = nxt; cA = nA; cB = nB; ++ui;
    }
    PG8_WAIT_V(0);
    if (wr == 0) PG8_BAR;
    PG8_BAR;
    if constexpr (Epi::AFTER_DRAIN) { E.fused(acc, cur, wr, wc, fr, fq, lds, wid, lane); S.done(cur); }
    PG8_STAMP();
    if (STAMP && wid == 0) { stamps[lane] = lane < nts ? (((unsigned long long)(unsigned)ts_hi << 32) | (unsigned)ts_lo) : 0ull;
        if (lane == 62) stamps[62] = rt_entry; if (lane == 63) stamps[63] = (unsigned long long)wall_clock64(); }
#undef PG8_STAMP
#undef PG8_SA
#undef PG8_SB
#undef PG8_STAGE
#undef PG8_LDA
#undef PG8_LDB
#undef PG8_MMA
#undef PG8_WAIT_V
#undef PG8_WAIT_L
#undef PG8_BAR
#undef PG8_SCHED
}
template <class Epi, class Sched, bool STAMP = false>
__device__ __forceinline__ void gemm_phase_gather(PG8_LAS unsigned char* lds, const Gemm g, const Sched& S, const Epi& E, const PG8_LAS int* rows, unsigned long long* stamps = nullptr) {
    int tid_l = threadIdx.x; asm volatile("" : "+v"(tid_l)); const int tid = tid_l, wid = __builtin_amdgcn_readfirstlane(tid >> 6), lane = tid & 63, wr = wid >> 2, wc = wid & 3, fr = lane & 15, fq = lane >> 4;
    const int K = g.K, nt = K / BK;
    int ts_lo = 0, ts_hi = 0, nts = 0; const unsigned long long rt_entry = STAMP ? (unsigned long long)wall_clock64() : 0ull;
#define PG8_STAMP() do { if (STAMP && wid == 0 && nts < 64) { const unsigned long long _c = (unsigned long long)clock64(); \
        ts_lo = (lane == nts) ? (int)(unsigned)_c : ts_lo; ts_hi = (lane == nts) ? (int)(unsigned)(_c >> 32) : ts_hi; ++nts; } } while (0)
    PG8_STAMP();
    unsigned voffA[2], voffB[2];
#pragma unroll
    for (int i = 0; i < 2; ++i) { int R, C; stage_rc(tid * 16 + i * 8192, R, C); const int Rb = Epi::PERM ? ((R & ~31) + perm32(R & 31)) : R;
        voffA[i] = (unsigned)(R * K + C) * 2u; voffB[i] = (unsigned)(Rb * K + C) * 2u; }
    int RA[2]; { int R_, C_; stage_rc(tid * 16, R_, C_); RA[0] = R_; stage_rc(tid * 16 + 8192, R_, C_); RA[1] = R_; }
    unsigned caoff[2]; { int R_, C_; stage_rc(tid * 16, R_, C_); caoff[0] = (unsigned)C_ * 2u; stage_rc(tid * 16 + 8192, R_, C_); caoff[1] = (unsigned)C_ * 2u; }
    unsigned offC[2][2], offN[2][2];
#define PG8_ROWOFF(dst, uidx) do { _Pragma("unroll") for (int _h = 0; _h < 2; ++_h) _Pragma("unroll") for (int _i = 0; _i < 2; ++_i) (dst)[_h][_i] = (unsigned)rows[(uidx) * 256 + _h * HALF + RA[_i]] * (unsigned)(K * 2) + caoff[_i]; } while (0)
    const size_t kstep = (size_t)(BK * 2);
    const size_t hstep = (size_t)HALF * K * 2;
    const size_t tstep = 2 * hstep;
    const unsigned ldsw = (unsigned)wid * 1024u;
    const int aoff = lds_byte(wr * 64 + fr, fq * 8), boff = lds_byte(wc * 32 + fr, fq * 8);
#define PG8_SA(b, h) (((b) * 2 + (h)) * HTB)
#define PG8_SB(b, h) ((4 + (b) * 2 + (h)) * HTB)
#define PG8_STAGE(bufoff, gbase, voff) do { _Pragma("unroll") for (int _i = 0; _i < 2; ++_i) \
        __builtin_amdgcn_global_load_lds((const unsigned*)((const char*)(gbase) + (voff)[_i]), (PG8_LAS unsigned*)(lds + (bufoff) + ldsw + _i * 8192), 16, 0, 0); } while (0)
#define PG8_LDA(dst, b, h) do { _Pragma("unroll") for (int m = 0; m < 4; ++m) _Pragma("unroll") for (int k = 0; k < 2; ++k) dst[m][k] = *(const PG8_LAS bf16x8*)(lds + PG8_SA(b, h) + aoff + m * 2048 + k * 1024); } while (0)
#define PG8_LDB(dst, b, h) do { _Pragma("unroll") for (int n = 0; n < 2; ++n) _Pragma("unroll") for (int k = 0; k < 2; ++k) dst[n][k] = *(const PG8_LAS bf16x8*)(lds + PG8_SB(b, h) + boff + n * 2048 + k * 1024); } while (0)
#define PG8_MMA(ai, bj, At, Bt) do { __builtin_amdgcn_s_setprio(1); _Pragma("unroll") for (int m = 0; m < 4; ++m) _Pragma("unroll") for (int n = 0; n < 2; ++n) _Pragma("unroll") for (int k = 0; k < 2; ++k) \
        acc[ai][bj][m][n] = __builtin_amdgcn_mfma_f32_16x16x32_bf16(Bt[n][k], At[m][k], acc[ai][bj][m][n], 0, 0, 0); __builtin_amdgcn_s_setprio(0); } while (0)
#define PG8_WAIT_V(n) asm volatile("s_waitcnt vmcnt(" #n ")" ::: "memory")
#define PG8_WAIT_L(n) asm volatile("s_waitcnt lgkmcnt(" #n ")" ::: "memory")
#define PG8_BAR __builtin_amdgcn_s_barrier()
#define PG8_SCHED __builtin_amdgcn_sched_barrier(0)
    Unit cur, nxt; int ui = 0;
    if (!S.next(0, cur)) return;
    f32x4 acc[2][2][4][2];
#pragma unroll
    for (int a = 0; a < 2; ++a)
#pragma unroll
        for (int b = 0; b < 2; ++b)
#pragma unroll
            for (int m = 0; m < 4; ++m)
#pragma unroll
                for (int n = 0; n < 2; ++n) acc[a][b][m][n] = (f32x4){0.f, 0.f, 0.f, 0.f};
    bf16x8 At[4][2], B0[2][2], B1[2][2];
    const char* cA = (const char*)g.A; PG8_ROWOFF(offC, 0); const char* cB = (const char*)g.Bt + (size_t)cur.pn * tstep + cur.boff;
    S.a_ready(cur);
    PG8_STAGE(PG8_SB(0, 0), cB, voffB); PG8_STAGE(PG8_SA(0, 0), cA, offC[0]); PG8_STAGE(PG8_SB(0, 1), cB + hstep, voffB); PG8_STAGE(PG8_SA(0, 1), cA, offC[1]);
    if (wr == 1) PG8_BAR;
    PG8_WAIT_V(4); PG8_BAR;
    PG8_STAGE(PG8_SB(1, 0), cB + kstep, voffB); PG8_STAGE(PG8_SA(1, 0), cA + kstep, offC[0]); PG8_STAGE(PG8_SB(1, 1), cB + hstep + kstep, voffB);
    PG8_WAIT_V(6); PG8_BAR;
    PG8_STAMP();
    for (;;) {
        const bool has_next = S.next(ui + 1, nxt);
        const char* nA = cA; if (has_next) PG8_ROWOFF(offN, ui + 1); else { offN[0][0] = offC[0][0]; offN[0][1] = offC[0][1]; offN[1][0] = offC[1][0]; offN[1][1] = offC[1][1]; } const char* nB = has_next ? (const char*)g.Bt + (size_t)nxt.pn * tstep + nxt.boff : cB;
        for (int t = 0; t < nt; t += 2) {
            const bool last = (t == nt - 2);
            const char* a1 = cA + (size_t)(t + 1) * kstep;
            const char* a2 = last ? nA : cA + (size_t)(t + 2) * kstep; const char* b2 = last ? nB : cB + (size_t)(t + 2) * kstep;
            const char* a3 = a2 + kstep; const char* b3 = b2 + kstep;
            if (last && has_next) S.a_ready(nxt);
            PG8_LDB(B0, 0, 0); PG8_SCHED; PG8_LDA(At, 0, 0); PG8_STAGE(PG8_SA(1, 1), a1, offC[1]);
            PG8_WAIT_L(8); PG8_BAR; PG8_WAIT_L(0); PG8_MMA(0, 0, At, B0); PG8_BAR; PG8_SCHED;
            PG8_LDB(B1, 0, 1); PG8_STAGE(PG8_SB(0, 0), b2, voffB);
            PG8_BAR; PG8_WAIT_L(0); PG8_MMA(0, 1, At, B1); PG8_BAR;
            PG8_LDA(At, 0, 1); { unsigned o2[2] = {last ? offN[0][0] : offC[0][0], last ? offN[0][1] : offC[0][1]}; PG8_STAGE(PG8_SA(0, 0), a2, o2); }
            PG8_BAR; PG8_WAIT_L(0); PG8_MMA(1, 0, At, B0); PG8_BAR; PG8_SCHED;
            PG8_STAGE(PG8_SB(0, 1), b2 + hstep, voffB);
            PG8_WAIT_V(6); PG8_BAR; PG8_MMA(1, 1, At, B1); PG8_BAR;
            PG8_LDB(B0, 1, 0); PG8_SCHED; PG8_LDA(At, 1, 0); { unsigned o2[2] = {last ? offN[1][0] : offC[1][0], last ? offN[1][1] : offC[1][1]}; PG8_STAGE(PG8_SA(0, 1), a2, o2); }
            PG8_WAIT_L(8); PG8_BAR; PG8_WAIT_L(0); PG8_MMA(0, 0, At, B0); PG8_BAR; PG8_SCHED;
            PG8_LDB(B1, 1, 1); PG8_STAGE(PG8_SB(1, 0), b3, voffB);
            PG8_BAR; PG8_WAIT_L(0); PG8_MMA(0, 1, At, B1); PG8_BAR;
            PG8_LDA(At, 1, 1); { unsigned o2[2] = {last ? offN[0][0] : offC[0][0], last ? offN[0][1] : offC[0][1]}; PG8_STAGE(PG8_SA(1, 0), a3, o2); }
            PG8_BAR; PG8_WAIT_L(0); PG8_MMA(1, 0, At, B0); PG8_BAR; PG8_SCHED;
            PG8_STAGE(PG8_SB(1, 1), b3 + hstep, voffB);
            PG8_WAIT_V(6); PG8_BAR; PG8_MMA(1, 1, At, B1); PG8_BAR;
        }
        PG8_STAMP();
        if constexpr (!Epi::AFTER_DRAIN) { E(acc, cur, wr, wc, fr, fq); S.done(cur); }
        PG8_STAMP();
        if (!has_next) break;
#pragma unroll
        for (int a = 0; a < 2; ++a)
#pragma unroll
            for (int b = 0; b < 2; ++b)
#pragma unroll
                for (int m = 0; m < 4; ++m)
#pragma unroll
                    for (int n = 0; n < 2; ++n) acc[a][b][m][n] = (f32x4){0.f, 0.f, 0.f, 0.f};
        cur = nxt; cA = nA; cB = nB; ++ui; offC[0][0] = offN[0][0]; offC[0][1] = offN[0][1]; offC[1][0] = offN[1][0]; offC[1][1] = offN[1][1];
    }
    PG8_WAIT_V(0);
    if (wr == 0) PG8_BAR;
    PG8_BAR;
    if constexpr (Epi::AFTER_DRAIN) { E.fused(acc, cur, wr, wc, fr, fq, lds, wid, lane); S.done(cur); }
    PG8_STAMP();
    if (STAMP && wid == 0) { stamps[lane] = lane < nts ? (((unsigned long long)(unsigned)ts_hi << 32) | (unsigned)ts_lo) : 0ull;
        if (lane == 62) stamps[62] = rt_entry; if (lane == 63) stamps[63] = (unsigned long long)wall_clock64(); }
#undef PG8_STAMP
#undef PG8_SA
#undef PG8_SB
#undef PG8_STAGE
#undef PG8_LDA
#undef PG8_LDB
#undef PG8_MMA
#undef PG8_WAIT_V
#undef PG8_WAIT_L
#undef PG8_BAR
#undef PG8_SCHED
#undef PG8_ROWOFF
}
}

struct Frame {
    LAS unsigned char* lds;
    const GAS float* const __attribute__((address_space(4)))* in;
    GAS unsigned char* ws;
    float* out;
    int tid, lane, wave, G, bid;
};
#define WSP(T, off) ((T*)(F.ws + (off)))

struct ConvItem { const float* src; bf16_t* dst; int ld, ncols, c0, k0, mode, kdim; };
DI int conv_dst_row(int mode, int c) {
    if (mode == 1) return c < DT_COL ? c : (c < DT_COL + 8 ? -1 : c - 8);
    if (mode == 2) { const int j = c >> 1, up = c & 1; return (j >> 7) * 256 + up * 128 + (j & 127); }
    return c;
}
constexpr int N_S5I = DEPTH * 16 * 4, N_ADA = DEPTH * 48, N_CV_WIN = DEPTH * 41 * 4, N_CV_WOUT = DEPTH * 16 * 4, N_CV_GU = DEPTH * NEXP * 32 * 4,
              N_CV_DN = DEPTH * NEXP * 16 * 4, N_CV_GLU = DEPTH * 4;
constexpr int N_CONV = N_CV_WIN + N_CV_WOUT + N_CV_GLU;
DI ConvItem conv_decode(const Frame& F, int it) {
    ConvItem c; c.kdim = DM;
    if (it < N_CV_WIN) { const int l = it / 164, r = it % 164; c.src = ((const float*)F.in[I_WIN]) + (size_t)l * DM * DIN; c.dst = WSP(bf16_t, WS_WIN) + (size_t)l * NU * DM;
        c.ld = DIN; c.ncols = DIN; c.c0 = (r >> 2) * 64; c.k0 = (r & 3) * 256; c.mode = 1; return c; }
    it -= N_CV_WIN;
    if (it < N_CV_WOUT) { const int l = it / 64, r = it % 64; c.src = ((const float*)F.in[I_WOUT]) + (size_t)l * DM * DM; c.dst = WSP(bf16_t, WS_WOUT) + (size_t)l * DM * DM;
        c.ld = DM; c.ncols = DM; c.c0 = (r >> 2) * 64; c.k0 = (r & 3) * 256; c.mode = 0; return c; }
    it -= N_CV_WOUT;
    { const int l = it / 4, r = it % 4; c.src = ((const float*)F.in[I_WGLU]) + (size_t)l * 256 * 256; c.dst = WSP(bf16_t, WS_WGLU) + (size_t)l * 256 * 256;
      c.ld = 256; c.ncols = 256; c.c0 = r * 64; c.k0 = 0; c.mode = 0; c.kdim = 256; return c; }
}
DI void conv_load(const ConvItem& c, int tid, f32x4 (&v)[8]) {
#pragma unroll
    for (int i = 0; i < 8; ++i) { const int idx = tid + 512 * i, k = idx >> 4, c4 = idx & 15; const int col = c.c0 + 4 * c4;
        v[i] = (col < c.ncols) ? *(const f32x4*)(c.src + (size_t)(c.k0 + k) * c.ld + col) : (f32x4){0.f, 0.f, 0.f, 0.f}; }
}
DI int q_next(const Frame& F, unsigned* ctr) {
    LAS int* slot = (LAS int*)(F.lds + LDS_BYTES - 16);
    __syncthreads();
    if (F.tid == 0) *slot = (int)__hip_atomic_fetch_add(ctr, 1u, __ATOMIC_RELAXED, __HIP_MEMORY_SCOPE_AGENT);
    __syncthreads();
    return *slot;
}
DI void p0_convert(const Frame& F, unsigned* ctr) {
    LAS float* T = (LAS float*)F.lds;
    const int tid = F.tid;
    f32x4 v[8];
    int it = q_next(F, ctr);
    if (it >= N_CONV) return;
    ConvItem cur = conv_decode(F, it);
    conv_load(cur, tid, v);
    for (;;) {
#pragma unroll
        for (int i = 0; i < 8; ++i) { const int idx = tid + 512 * i, k = idx >> 4, c4 = idx & 15;
            T[k * 65 + 4 * c4 + 0] = v[i][0]; T[k * 65 + 4 * c4 + 1] = v[i][1]; T[k * 65 + 4 * c4 + 2] = v[i][2]; T[k * 65 + 4 * c4 + 3] = v[i][3]; }
        __syncthreads();
        const int nit = q_next(F, ctr); const bool has_next = nit < N_CONV;
        ConvItem nxt = cur;
        if (has_next) { nxt = conv_decode(F, nit); conv_load(nxt, tid, v); }
#pragma unroll
        for (int i = 0; i < 4; ++i) { const int task = tid + 512 * i, c = task & 63, kc = task >> 6;
            const int col = cur.c0 + c; const int row = (col < cur.ncols) ? conv_dst_row(cur.mode, col) : -1;
            u32x4 o;
#pragma unroll
            for (int j = 0; j < 4; ++j) o[j] = pk2(T[(8 * kc + 2 * j) * 65 + c], T[(8 * kc + 2 * j + 1) * 65 + c]);
            if (row >= 0) *(u32x4*)(cur.dst + (size_t)row * cur.kdim + cur.k0 + 8 * kc) = o; }
        __syncthreads();
        if (!has_next) break;
        cur = nxt; it = nit;
    }
}
DI void p0_adaln(const Frame& F, int item) {
    const int l = item / 48, col0 = (item % 48) * 128, tid = F.tid, part = tid >> 5, ct = tid & 31;
    const float* W = ((const float*)F.in[I_WADA]) + (size_t)l * DM * 6144 + col0 + 4 * ct;
    const float* cl = ((const float*)F.in[I_C]); const float* cc = ((const float*)F.in[I_CCTX]);
    f32x4 al = {0.f, 0.f, 0.f, 0.f}, ac = {0.f, 0.f, 0.f, 0.f};
#pragma unroll 8
    for (int kk = 0; kk < 64; ++kk) { const int k = part * 64 + kk; const f32x4 w = *(const f32x4*)(W + (size_t)k * 6144);
        const float sl = silu_f(cl[k]), sc = silu_f(cc[k]); al += w * sl; ac += w * sc; }
    LAS float* R = (LAS float*)F.lds;
#pragma unroll
    for (int j = 0; j < 4; ++j) { R[(part * 32 + ct) * 8 + j] = al[j]; R[(part * 32 + ct) * 8 + 4 + j] = ac[j]; }
    __syncthreads();
    if (tid < 256) { const int v = tid >> 7, col = tid & 127; float s = 0.f;
#pragma unroll
        for (int p = 0; p < 16; ++p) s += R[(p * 32 + (col >> 2)) * 8 + v * 4 + (col & 3)];
        WSP(float, WS_MOD)[((size_t)l * 2 + v) * 6144 + col0 + col] = s + ((const float*)F.in[I_BADA])[(size_t)l * 6144 + col0 + col]; }
    __syncthreads();
}
DI void p0_rope(const Frame& F) {
    f32x2* rd = WSP(f32x2, WS_ROPE); f32x2* rg = rd + 256 * 8;
    for (int i = F.tid; i < 256 * 8; i += 512) { const int pos = i >> 3, f = i & 7; const float inv = exp2f(-(float)(2 * f) / 16.f * 13.287712379549449f);
        float s, c; sincosf((float)pos * inv, &s, &c); rd[i] = (f32x2){c, s}; }
    if (F.tid < DEPTH) { const int l = F.tid; float s1 = 0.f, s2 = 0.f;
        for (int i = 0; i < 32; ++i) { s1 += ((const float*)F.in[I_LQ1])[l * 32 + i] * ((const float*)F.in[I_LK1])[l * 32 + i]; s2 += ((const float*)F.in[I_LQ2])[l * 32 + i] * ((const float*)F.in[I_LK2])[l * 32 + i]; }
        WSP(float, WS_LAM)[l] = __expf(s1) - __expf(s2) + (0.8f - 0.6f * __expf(-0.3f * (float)l)); }
    for (int i = F.tid; i < 256 * 16; i += 512) { const int pos = i >> 4, f = i & 15; const float inv = exp2f(-(float)(2 * f) / 32.f * 13.287712379549449f);
        float s, c; sincosf((float)pos * inv, &s, &c); rg[i] = (f32x2){c, s}; }
}
DI f32x2 cmul(f32x2 a, f32x2 b) { return (f32x2){a.x * b.x - a.y * b.y, a.x * b.y + a.y * b.x}; }
DI void p0_s5(const Frame& F, int item4) {
    const int item = item4 >> 2, part = item4 & 3;
    const int l = item >> 4, g = item & 15, tid = F.tid;
    LAS f32x2* PW = (LAS f32x2*)F.lds;
    LAS f32x2* BB = PW + 2 * 65 * 64;
    LAS f32x2* CM = BB + 2 * 64 * 16;
    LAS float* D0 = (LAS float*)(CM + 2 * 16 * 64);
    for (int i = tid; i < 2 * 65 * 64; i += 512) { const int dir = i / (65 * 64), n = (i / 64) % 65, p = i & 63;
        const size_t li = (((size_t)l * 2 + dir) * 16 + g) * 64 + p;
        const float step = __expf(((const float*)F.in[I_LOGDT])[((size_t)l * 2 + dir) * 16 + g]);
        const float tr = ((const float*)F.in[I_LAMRE])[li] * step, ti = ((const float*)F.in[I_LAMIM])[li] * step;
        float s, c; sincosf((float)n * ti, &s, &c); const float m = __expf((float)n * tr); PW[i] = (f32x2){m * c, m * s}; }
    __syncthreads();
    for (int i = tid; i < 2 * 64 * 16; i += 512) { const int dir = i >> 10, p = (i >> 4) & 63, c = i & 15;
        const size_t li = (((size_t)l * 2 + dir) * 16 + g) * 64 + p;
        const f32x2 lam = {((const float*)F.in[I_LAMRE])[li], ((const float*)F.in[I_LAMIM])[li]}; const f32x2 a = PW[(dir * 65 + 1) * 64 + p];
        const f32x2 num = {a.x - 1.f, a.y}; const float den = lam.x * lam.x + lam.y * lam.y;
        const f32x2 q = {(num.x * lam.x + num.y * lam.y) / den, (num.y * lam.x - num.x * lam.y) / den};
        const size_t bi = (((size_t)l * 16 + g) * 64 + p) * 16 + c;
        BB[i] = cmul(q, (f32x2){((const float*)F.in[I_BRE])[bi], ((const float*)F.in[I_BIM])[bi]}); }
    for (int i = tid; i < 2 * 16 * 64; i += 512) { const int dir = i >> 10, c = (i >> 6) & 15, p = i & 63;
        const size_t ci = ((((size_t)l * 2 + dir) * 16 + g) * 16 + c) * 64 + p; CM[i] = (f32x2){((const float*)F.in[I_CRE])[ci], ((const float*)F.in[I_CIM])[ci]}; }
    __syncthreads();
    bf16_t* kt = WSP(bf16_t, WS_KTAB) + ((size_t)l * 16 + g) * 3 * 64 * 256;
    {
        const int dir = part >> 1, lag0 = (part & 1) * 32 + (tid >> 8), c = (tid >> 4) & 15, cp = tid & 15;
        float sk[16];
#pragma unroll
        for (int k = 0; k < 16; ++k) sk[k] = 0.f;
#pragma unroll 2
        for (int p = 0; p < 64; ++p) { const f32x2 tq = cmul(CM[(dir * 16 + c) * 64 + p], BB[(dir * 64 + p) * 16 + cp]);
#pragma unroll
            for (int k = 0; k < 16; ++k) { const f32x2 pw = PW[(dir * 65 + lag0 + 2 * k) * 64 + p]; sk[k] += tq.x * pw.x - tq.y * pw.y; } }
#pragma unroll
        for (int k = 0; k < 16; ++k) kt[part * 8192 + tid + 512 * k] = f2bf(sk[k]); }
    __syncthreads();
    if (part == 0) for (int i = tid; i < 256; i += 512) { const int c = i >> 4, cp = i & 15; float s = 0.f;
        for (int dir = 0; dir < 2; ++dir) for (int p = 0; p < 64; ++p) { const f32x2 w = BB[(dir * 64 + p) * 16 + cp]; const f32x2 cm = CM[(dir * 16 + c) * 64 + p]; s += cm.x * w.x - cm.y * w.y; }
        kt[2 * 64 * 256 + i] = f2bf(s + (c == cp ? ((const float*)F.in[I_S5D])[(size_t)l * 256 + g * 16 + c] : 0.f)); }
    bf16_t* e5 = WSP(bf16_t, WS_E5) + ((size_t)l * 16 + g) * 2 * 128 * 1024;
    for (int k = 0; k < 16; ++k) { const int j = part * 8192 + tid + 512 * k, cp0 = (j & 1) * 8, sq = (j >> 1) & 63, m = (j >> 7) & 127, dir = j >> 14, p = m & 63;
        const int n = dir ? sq : 63 - sq; const f32x2 pw = PW[(dir * 65 + n) * 64 + p];
        const LAS f32x4* b4 = (const LAS f32x4*)(BB + (dir * 64 + p) * 16 + cp0); float o[8];
#pragma unroll
        for (int q = 0; q < 4; ++q) { const f32x4 bv = b4[q];
            o[2 * q] = m < 64 ? pw.x * bv[0] - pw.y * bv[1] : pw.x * bv[1] + pw.y * bv[0]; o[2 * q + 1] = m < 64 ? pw.x * bv[2] - pw.y * bv[3] : pw.x * bv[3] + pw.y * bv[2]; }
        u32x4 w; w[0] = pk2(o[0], o[1]); w[1] = pk2(o[2], o[3]); w[2] = pk2(o[4], o[5]); w[3] = pk2(o[6], o[7]); *(u32x4*)(e5 + ((((size_t)(dir * 4 + (m >> 5)) * 64 + sq) * 64 + ((cp0 >> 3) * 32 + (m & 31))) * 8)) = w; }
    bf16_t* cc5 = WSP(bf16_t, WS_CC5) + ((size_t)l * 16 + g) * 1024 * 256;
    for (int k = 0; k < 16; ++k) { const int j = part * 8192 + tid + 512 * k, p0 = (j & 7) * 8, im = (j >> 3) & 1, dir = (j >> 4) & 1, row = j >> 5, t = row >> 4, c = row & 15;
        const int n = dir ? 64 - t : t + 1;
        const LAS f32x4* c4 = (const LAS f32x4*)(CM + (dir * 16 + c) * 64 + p0); const LAS f32x4* p4 = (const LAS f32x4*)(PW + (dir * 65 + n) * 64 + p0); float o[8];
#pragma unroll
        for (int q = 0; q < 4; ++q) { const f32x4 cv = c4[q], pv = p4[q];
            o[2 * q] = im ? -(cv[0] * pv[1] + cv[1] * pv[0]) : cv[0] * pv[0] - cv[1] * pv[1]; o[2 * q + 1] = im ? -(cv[2] * pv[3] + cv[3] * pv[2]) : cv[2] * pv[2] - cv[3] * pv[3]; }
        u32x4 w; w[0] = pk2(o[0], o[1]); w[1] = pk2(o[2], o[3]); w[2] = pk2(o[4], o[5]); w[3] = pk2(o[6], o[7]); *(u32x4*)(cc5 + ((((size_t)(row >> 5) * 16 + (p0 >> 4) + 4 * im + 8 * dir) * 64 + (((p0 >> 3) & 1) * 32 + (row & 31))) * 8)) = w; }
    f32x2* ap = WSP(f32x2, WS_APOW) + ((size_t)l * 16 + g) * 128;
    if (part == 0) for (int i = tid; i < 128; i += 512) ap[i] = PW[((i >> 6) * 65 + 64) * 64 + (i & 63)];
    __syncthreads();
}
DI void p0_prologue(const Frame& F, int rep = 0) {
    for (int it = F.bid; it < N_S5I; it += F.G) p0_s5(F, it);
    unsigned* qa = WSP(unsigned, WS_CTL) + CW_Q0 + 64 * (20 + rep);
    for (;;) { const int it = q_next(F, qa); if (it > N_ADA) break; if (it < N_ADA) p0_adaln(F, it); else p0_rope(F); }
    __syncthreads();
    p0_convert(F, WSP(unsigned, WS_CTL) + CW_Q0 + 64 * rep);
}

constexpr int RPB = 65;
DI int moe_tables(const Frame& F, int l);
template <bool FINAL>
DI void p1_norm(const Frame& F, int l) {
    if (l > 0) (void)moe_tables(F, l - 1);
    const LAS int* PSTL = (const LAS int*)(F.lds + LDS_MISC);
    LAS float* WDT = (LAS float*)F.lds;
    if (!FINAL) {
        for (int i = F.tid; i < 1024 * 8; i += 512) WDT[i] = ((const float*)F.in[I_WIN])[(size_t)l * DM * DIN + (size_t)(i >> 3) * DIN + DT_COL + (i & 7)];
        __syncthreads();
    }
    const float* mod_cur = WSP(float, WS_MOD) + (size_t)(FINAL ? 0 : l) * 2 * 6144;
    const float* mod_prev = WSP(float, WS_MOD) + (size_t)(l > 0 ? l - 1 : 0) * 2 * 6144;
    const int lane = F.lane;
    for (int r = F.wave; r < RPB; r += 8) {
        const int row = F.bid * RPB + r; if (row >= NT) break;
        const int v = row < CTX ? 1 : 0;
        if (FINAL && v) continue;
        f32x4 x[4];
        if (l == 0) {
            const float* src = v ? ((const float*)F.in[I_CTX]) + (size_t)row * DM : ((const float*)F.in[I_X]) + (size_t)(row - CTX) * DM;
#pragma unroll
            for (int i = 0; i < 4; ++i) x[i] = *(const f32x4*)(src + 256 * i + 4 * lane);
        } else {
            const float* x1 = WSP(float, WS_XA) + (size_t)row * DM;
            const int* tope = WSP(int, WS_TOPE) + (size_t)row * 4; const int* topp = WSP(int, WS_TOPP) + (size_t)row * 4; const float* gates = WSP(float, WS_TOPG) + (size_t)row * 4;
            const float* g2 = mod_prev + (size_t)v * 6144 + 5 * 1024;
            int sl[4]; float ga[4];
#pragma unroll
            for (int k = 0; k < 4; ++k) { sl[k] = PSTL[tope[k]] + topp[k]; ga[k] = gates[k]; }
#pragma unroll
            for (int i = 0; i < 4; ++i) { const int col = 256 * i + 4 * lane; f32x4 acc = {0.f, 0.f, 0.f, 0.f};
#pragma unroll
                for (int k = 0; k < 4; ++k) { const u32x2 y = *(const u32x2*)(WSP(bf16_t, WS_YB) + (size_t)sl[k] * DM + col);
                    acc[0] += ga[k] * bflo(y[0]); acc[1] += ga[k] * bfhi(y[0]); acc[2] += ga[k] * bflo(y[1]); acc[3] += ga[k] * bfhi(y[1]); }
                x[i] = *(const f32x4*)(x1 + col) + *(const f32x4*)(g2 + col) * acc;
                if (!FINAL) *(f32x4*)(WSP(float, WS_XB) + (size_t)row * DM + col) = x[i]; }
        }
        float ss = 0.f;
#pragma unroll
        for (int i = 0; i < 4; ++i) ss += x[i][0] * x[i][0] + x[i][1] * x[i][1] + x[i][2] * x[i][2] + x[i][3] * x[i][3];
        ss = wave_sum(ss);
        const float rs = __builtin_amdgcn_rsqf(ss * (1.f / 1024.f) + EPS);
        if (FINAL) {
#pragma unroll
            for (int i = 0; i < 4; ++i) { const int col = 256 * i + 4 * lane; *(f32x4*)(F.out + (size_t)(row - CTX) * DM + col) = x[i] * rs * *(const f32x4*)(((const float*)F.in[I_FNW]) + col); }
        } else {
            const float* nw = ((const float*)F.in[I_N1W]) + (size_t)l * DM; const float* sh = mod_cur + (size_t)v * 6144; const float* sc = sh + 1024;
            float d[8] = {0.f, 0.f, 0.f, 0.f, 0.f, 0.f, 0.f, 0.f};
#pragma unroll
            for (int i = 0; i < 4; ++i) { const int col = 256 * i + 4 * lane;
                const f32x4 h = x[i] * rs * *(const f32x4*)(nw + col) * (*(const f32x4*)(sc + col) + 1.f) + *(const f32x4*)(sh + col);
                u32x2 o; o[0] = pk2(h[0], h[1]); o[1] = pk2(h[2], h[3]);
                *(u32x2*)(WSP(bf16_t, WS_H) + (size_t)row * DM + col) = o;
#pragma unroll
                for (int c = 0; c < 4; ++c) { const f32x4 w0 = *(const LAS f32x4*)(WDT + (col + c) * 8), w1 = *(const LAS f32x4*)(WDT + (col + c) * 8 + 4);
#pragma unroll
                    for (int j = 0; j < 4; ++j) { d[j] += h[c] * w0[j]; d[4 + j] += h[c] * w1[j]; } } }
#pragma unroll
            for (int j = 0; j < 8; ++j) d[j] = wave_sum(d[j]);
            if (lane == 0) { float* o = WSP(float, WS_DTRAW) + (size_t)row * 8;
                *(f32x4*)o = (f32x4){d[0], d[1], d[2], d[3]}; *(f32x4*)(o + 4) = (f32x4){d[4], d[5], d[6], d[7]}; }
        }
    }
    __syncthreads();
}

constexpr int WR_PITCH = 36;
DI void p7a_router(const Frame& F, int l, int rep = 0) {
    LAS float* WR = (LAS float*)F.lds;
    LAS int* CNT = (LAS int*)(F.lds + 1024 * WR_PITCH * 4);
    LAS int* BASE = CNT + 32;
    LAS int* RI = BASE + 32;
    for (int i = F.tid; i < 1024 * 8; i += 512) *(LAS f32x4*)(WR + (i >> 3) * WR_PITCH + 4 * (i & 7)) = *(const f32x4*)(((const float*)F.in[I_WR]) + (size_t)l * DM * 32 + 4 * i);
    if (F.tid < 32) CNT[F.tid] = 0;
    __syncthreads();
    const int lane = F.lane;
    const float* mod = WSP(float, WS_MOD) + (size_t)l * 2 * 6144;
    const float* nw = ((const float*)F.in[I_N2W]) + (size_t)l * DM;
    const float br = ((const float*)F.in[I_BR])[(size_t)l * 32 + ((((lane >> 3) & 1) << 4) | (((lane >> 2) & 1) << 3) | (((lane >> 1) & 1) << 2) | ((lane & 1) << 1) | ((lane >> 5) & 1))];
    auto finish_row = [&](const f32x4 (&lgv)[8], int r, bool valid) __attribute__((always_inline)) {
        float lg[32];
#pragma unroll
        for (int q = 0; q < 8; ++q) { lg[4 * q] = lgv[q][0]; lg[4 * q + 1] = lgv[q][1]; lg[4 * q + 2] = lgv[q][2]; lg[4 * q + 3] = lgv[q][3]; }
        float a16[16], a8[8], a4[4], a2[2], a1;
        { const bool up = lane & 8;
#pragma unroll
          for (int j = 0; j < 16; ++j) { const float send = up ? lg[j] : lg[16 + j]; const float keep = up ? lg[16 + j] : lg[j]; a16[j] = keep + dppf<0x140>(send); } }
        { const bool up = lane & 4;
#pragma unroll
          for (int j = 0; j < 8; ++j) { const float send = up ? a16[j] : a16[8 + j]; const float keep = up ? a16[8 + j] : a16[j]; a8[j] = keep + dppf<0x141>(send); } }
        { const bool up = lane & 2;
#pragma unroll
          for (int j = 0; j < 4; ++j) { const float send = up ? a8[j] : a8[4 + j]; const float keep = up ? a8[4 + j] : a8[j]; a4[j] = keep + dppf<0x4E>(send); } }
        { const bool up = lane & 1;
#pragma unroll
          for (int j = 0; j < 2; ++j) { const float send = up ? a4[j] : a4[2 + j]; const float keep = up ? a4[2 + j] : a4[j]; a2[j] = keep + dppf<0xB1>(send); } }
        { const bool up = lane & 32; const float send = up ? a2[0] : a2[1]; const float keep = up ? a2[1] : a2[0]; a1 = keep + __shfl_xor(send, 32); }
        a1 += __shfl_xor(a1, 16);
        const int myexp = (((lane >> 3) & 1) << 4) | (((lane >> 2) & 1) << 3) | (((lane >> 1) & 1) << 2) | ((lane & 1) << 1) | ((lane >> 5) & 1);
        float val = a1 + br;
        int te[4]; float tv[4];
#pragma unroll
        for (int k = 0; k < 4; ++k) { const float m = wave_max(val); const unsigned long long bal = __ballot(val == m); const int sel = (int)__ffsll((long long)bal) - 1;
            te[k] = (((sel >> 3) & 1) << 4) | (((sel >> 2) & 1) << 3) | (((sel >> 1) & 1) << 2) | ((sel & 1) << 1) | ((sel >> 5) & 1); tv[k] = m; if (myexp == te[k]) val = -INFINITY; }
        if (lane == 0 && valid) { float g[4], s = 0.f;
#pragma unroll
            for (int k = 0; k < 4; ++k) { g[k] = __expf(tv[k] - tv[0]); s += g[k]; }
#pragma unroll
            for (int k = 0; k < 4; ++k) { const int pos = atomicAdd((int*)&CNT[te[k]], 1); RI[(r * 4 + k) * 3 + 0] = te[k]; RI[(r * 4 + k) * 3 + 1] = pos; RI[(r * 4 + k) * 3 + 2] = __float_as_int(g[k] / s); } }
    };
    for (int r0 = F.wave; r0 < RPB; r0 += 16) {
        const int rowA = F.bid * RPB + r0; if (rowA >= NT) break;
        const bool hasB = (r0 + 8 < RPB) && (rowA + 8 < NT);
        const int rowB = hasB ? rowA + 8 : rowA;
        const float* xA = WSP(float, WS_XA) + (size_t)rowA * DM; const float* shA = mod + (size_t)(rowA < CTX ? 1 : 0) * 6144 + 3 * 1024; const float* scA = shA + 1024;
        const float* xB = WSP(float, WS_XA) + (size_t)rowB * DM; const float* shB = mod + (size_t)(rowB < CTX ? 1 : 0) * 6144 + 3 * 1024; const float* scB = shB + 1024;
        f32x4 xa[4], xb[4]; float ssA = 0.f, ssB = 0.f;
#pragma unroll
        for (int i = 0; i < 4; ++i) { xa[i] = *(const f32x4*)(xA + 256 * i + 4 * lane); xb[i] = *(const f32x4*)(xB + 256 * i + 4 * lane);
            ssA += xa[i][0] * xa[i][0] + xa[i][1] * xa[i][1] + xa[i][2] * xa[i][2] + xa[i][3] * xa[i][3];
            ssB += xb[i][0] * xb[i][0] + xb[i][1] * xb[i][1] + xb[i][2] * xb[i][2] + xb[i][3] * xb[i][3]; }
        ssA = wave_sum(ssA); ssB = wave_sum(ssB);
        const float rsA = __builtin_amdgcn_rsqf(ssA * (1.f / 1024.f) + EPS), rsB = __builtin_amdgcn_rsqf(ssB * (1.f / 1024.f) + EPS);
        f32x4 lgA[8], lgB[8];
#pragma unroll
        for (int q = 0; q < 8; ++q) { lgA[q] = (f32x4){0.f, 0.f, 0.f, 0.f}; lgB[q] = (f32x4){0.f, 0.f, 0.f, 0.f}; }
#pragma unroll
        for (int i = 0; i < 4; ++i) { const int col = 256 * i + 4 * lane; const f32x4 nwv = *(const f32x4*)(nw + col);
            xa[i] = xa[i] * rsA * nwv * (*(const f32x4*)(scA + col) + 1.f) + *(const f32x4*)(shA + col);
            xb[i] = xb[i] * rsB * nwv * (*(const f32x4*)(scB + col) + 1.f) + *(const f32x4*)(shB + col);
            { u32x2 o; o[0] = pk2(xa[i][0], xa[i][1]); o[1] = pk2(xa[i][2], xa[i][3]); *(u32x2*)(WSP(bf16_t, WS_H) + (size_t)rowA * DM + col) = o; }
            if (hasB) { u32x2 o; o[0] = pk2(xb[i][0], xb[i][1]); o[1] = pk2(xb[i][2], xb[i][3]); *(u32x2*)(WSP(bf16_t, WS_H) + (size_t)rowB * DM + col) = o; } }
        __builtin_amdgcn_sched_barrier(0);
#pragma unroll
        for (int i = 0; i < 4; ++i) { const int col = 256 * i + 4 * lane;
#pragma unroll
            for (int c = 0; c < 4; ++c) {
                f32x4 w0[8];
#pragma unroll
                for (int q = 0; q < 8; ++q) w0[q] = *(const LAS f32x4*)(WR + (col + c) * WR_PITCH + 4 * q);
#pragma unroll
                for (int q = 0; q < 8; ++q) { lgA[q] += w0[q] * xa[i][c]; lgB[q] += w0[q] * xb[i][c]; }
#pragma unroll
                for (int q = 0; q < 8; ++q) asm volatile("" : "+v"(lgA[q]), "+v"(lgB[q]));
                } }
        finish_row(lgA, r0, true);
        finish_row(lgB, r0 + 8, hasB);
    }
    __syncthreads();
    if (F.tid < 32) BASE[F.tid] = (int)__hip_atomic_fetch_add(WSP(unsigned, WS_CTL) + (rep ? 4500 : CW_CNT) + l * 32 + F.tid, (unsigned)CNT[F.tid], __ATOMIC_RELAXED, __HIP_MEMORY_SCOPE_AGENT);
    __syncthreads();
    if (F.tid < RPB * 4) { const int r = F.tid >> 2, row = F.bid * RPB + r;
        if (row < NT) { const int e = RI[F.tid * 3], pos = RI[F.tid * 3 + 1];
            WSP(int, WS_TOPE)[(size_t)row * 4 + (F.tid & 3)] = e; WSP(int, WS_TOPP)[(size_t)row * 4 + (F.tid & 3)] = BASE[e] + pos; WSP(int, WS_TOPS)[(size_t)e * NT + BASE[e] + pos] = row; WSP(int, WS_TOPG)[(size_t)row * 4 + (F.tid & 3)] = RI[F.tid * 3 + 2]; } }
    __syncthreads();
}

DI int moe_tables(const Frame& F, int l) {
    LAS int* PST = (LAS int*)(F.lds + LDS_MISC);
    LAS int* T2E = PST + 64;
    __syncthreads();
    if (F.tid < 64) { const int e = F.tid & 31; const int c = (int)__hip_atomic_load(WSP(unsigned, WS_CTL) + CW_CNT + l * 32 + e, __ATOMIC_RELAXED, __HIP_MEMORY_SCOPE_AGENT);
        const int pad = (c + 255) & ~255; int incl = pad;
#pragma unroll
        for (int o = 1; o < 32; o <<= 1) { const int t = __shfl_up(incl, o, 32); if (e >= o) incl += t; }
        if (F.tid < 32) { PST[e] = incl - pad; if (e == 31) PST[32] = incl; PST[64 + 300 + e] = c; } }
    __syncthreads();
    const int ntiles = PST[32] >> 8;
    for (int r = F.tid; r < ntiles; r += 512) { int e = 0;
        for (int q = 1; q < 32; ++q) if (PST[q] <= r * 256) e = q;
        T2E[r] = e; }
    __syncthreads();
    return ntiles;
}
struct MoeOrder {
    int nN, ntiles, G, c; const LAS int* t2e; long estride;
#ifndef MOE_XMAJOR
#define MOE_XMAJOR 1
#endif
    DI bool unit(int i, int& pm, int& pn) const { const int j = c >> 3, per = G / nN, sh = (nN == 8) ? 3 : 2;
        pm = MOE_XMAJOR ? i * per + (c & 7) * (per >> 3) + (j >> sh) : i * per + (j >> sh) * 8 + (c & 7); pn = j & (nN - 1); return pm < ntiles; }
    DI bool next(int i, pg8::Unit& u) const { int pm, pn; if (!unit(i, pm, pn)) return false; u.pm = pm; u.pn = pn; u.boff = (long)t2e[pm] * estride; return true; }
    DI void a_ready(const pg8::Unit&) const {}
    DI void done(const pg8::Unit&) const {}
};
#ifndef STAG_INTRA
#define STAG_INTRA 1
#endif
DI void xcd_stagger(const Frame& F, int step_ticks) {
    const unsigned dl = (unsigned)(STAG_INTRA ? (F.bid >> 3) : (F.bid & 7)) * (unsigned)step_ticks;
    const unsigned long long t0 = __builtin_amdgcn_s_memrealtime();
    while ((unsigned)(__builtin_amdgcn_s_memrealtime() - t0) < dl) __builtin_amdgcn_s_sleep(32);
}
DI void moe_rows(const Frame& F, int l, int ntiles, int nN) {
    const LAS int* PST = (const LAS int*)(F.lds + LDS_MISC); const LAS int* T2E = PST + 64; const LAS int* CNTL = PST + 64 + 300;
    LAS int* ROWS = (LAS int*)(F.lds + LDS_MISC + 2048);
    const MoeOrder S{nN, ntiles, F.G, F.bid, T2E, 0};
    (void)l;
    int val[5]; bool ok[5], inb[5];
#pragma unroll
    for (int k = 0; k < 5; ++k) { const int idx = F.tid + 512 * k, i = idx >> 8, r = idx & 255; int pm, pn;
        ok[k] = S.unit(i, pm, pn); const int e = T2E[ok[k] ? pm : 0], p = ((ok[k] ? pm : 0) - (PST[e] >> 8)) * 256 + r;
        inb[k] = ok[k] && p < CNTL[e]; val[k] = WSP(int, WS_TOPS)[(size_t)e * NT + (inb[k] ? p : 0)]; }
#pragma unroll
    for (int k = 0; k < 5; ++k) if (ok[k]) ROWS[F.tid + 512 * k] = inb[k] ? val[k] : 0;
    __syncthreads();
}

constexpr int LDS_BIASL = LDS_MISC + 2048 + 10 * 1024;
DI void moe_bias(const Frame& F, int ntiles, int nN, const float* bias, int estride) {
    const LAS int* PST = (const LAS int*)(F.lds + LDS_MISC); const LAS int* T2E = PST + 64;
    LAS float* BL = (LAS float*)(F.lds + LDS_BIASL);
    const MoeOrder S{nN, ntiles, F.G, F.bid, T2E, 0};
    float val[5]; bool ok[5];
#pragma unroll
    for (int k = 0; k < 5; ++k) { const int idx = F.tid + 512 * k, i = idx >> 8, r = idx & 255; int pm, pn;
        ok[k] = S.unit(i, pm, pn); val[k] = bias[(size_t)T2E[ok[k] ? pm : 0] * estride + (ok[k] ? pn : 0) * 256 + r]; }
#pragma unroll
    for (int k = 0; k < 5; ++k) if (ok[k]) BL[F.tid + 512 * k] = val[k];
    __syncthreads();
}

#ifndef EPI_NT
#define EPI_NT 0
#endif
#if EPI_NT
#define EPI_STORE(p, v) __builtin_nontemporal_store((v), (p))
#else
#define EPI_STORE(p, v) (*(p) = (v))
#endif
struct EpiU {
    static constexpr bool PERM = true, AFTER_DRAIN = false;
    bf16_t* O; int ldc; bf16_t* us5;
    DI void operator()(const pg8::f32x4 (&acc)[2][2][4][2], const pg8::Unit& u, int wr, int wc, int fr, int fq) const {
        const int row0 = u.pm * 256 + wr * 64 + fr, col0 = u.pn * 256 + wc * 32 + 8 * fq;
        const bool s5 = (u.pn == U_S5 / 256);
#pragma unroll
        for (int ai = 0; ai < 2; ++ai)
#pragma unroll
            for (int m = 0; m < 4; ++m) { const int row = row0 + ai * 128 + m * 16; bf16_t* rowp = O + (size_t)row * ldc + col0;
#pragma unroll
                for (int bj = 0; bj < 2; ++bj) { const pg8::f32x4 v0 = acc[ai][bj][m][0], v1 = acc[ai][bj][m][1];
                    u32x4 w; w[0] = pk2(v0[0], v0[1]); w[1] = pk2(v0[2], v0[3]); w[2] = pk2(v1[0], v1[1]); w[3] = pk2(v1[2], v1[3]);
                    const int cl = wc * 32 + 8 * fq + bj * 128;
                    bf16_t* dst = s5 ? us5 + ((size_t)(cl >> 4) * NT + row) * 16 + (cl & 15) : rowp + bj * 128;
                    EPI_STORE((u32x4*)dst, w); } }
    }
};
struct EpiRes {
    static constexpr bool PERM = false, AFTER_DRAIN = false;
    float* C; const float* res_lat; const float* res_ctx; const float* g1;
    DI void operator()(const pg8::f32x4 (&acc)[2][2][4][2], const pg8::Unit& u, int wr, int wc, int fr, int fq) const {
        const int row0 = CTX + u.pm * 256 + wr * 64 + fr, col0 = u.pn * 256 + wc * 32 + 4 * fq;
        const bool isctx = false;
        const float* g = g1;
        pg8::f32x4 gv[2][2];
#pragma unroll
        for (int bj = 0; bj < 2; ++bj)
#pragma unroll
            for (int n = 0; n < 2; ++n) gv[bj][n] = *(const pg8::f32x4*)(g + col0 + bj * 128 + n * 16);
#pragma unroll
        for (int ai = 0; ai < 2; ++ai)
#pragma unroll
            for (int m = 0; m < 4; ++m) { const int row = row0 + ai * 128 + m * 16;
                const float* rp = isctx ? res_ctx + (size_t)row * DM : res_lat + (size_t)(row - CTX) * DM; float* cp = C + (size_t)row * DM;
#pragma unroll
                for (int bj = 0; bj < 2; ++bj)
#pragma unroll
                    for (int n = 0; n < 2; ++n) { const int col = col0 + bj * 128 + n * 16;
                        *(pg8::f32x4*)(cp + col) = *(const pg8::f32x4*)(rp + col) + gv[bj][n] * acc[ai][bj][m][n]; } }
    }
};
struct EpiAct {
    static constexpr bool PERM = true, AFTER_DRAIN = false;
    bf16_t* O; const LAS float* biasl;
    mutable int cnt = 0;
    DI void operator()(const pg8::f32x4 (&acc)[2][2][4][2], const pg8::Unit& u, int wr, int wc, int fr, int fq) const {
        const int row0 = u.pm * 256 + wr * 64 + fr, j0 = u.pn * 128 + wc * 32 + 8 * fq;
        const LAS float* b = biasl + cnt * 256 + 2 * (wc * 32 + 8 * fq); ++cnt;
        pg8::f32x4 bg[2], bu[2];
#pragma unroll
        for (int n = 0; n < 2; ++n) { const pg8::f32x4 t0 = *(const LAS pg8::f32x4*)(b + 8 * n), t1 = *(const LAS pg8::f32x4*)(b + 8 * n + 4);
            bg[n] = (pg8::f32x4){t0[0], t0[2], t1[0], t1[2]}; bu[n] = (pg8::f32x4){t0[1], t0[3], t1[1], t1[3]}; }
#pragma unroll
        for (int ai = 0; ai < 2; ++ai)
#pragma unroll
            for (int m = 0; m < 4; ++m) { bf16_t* rowp = O + (size_t)(row0 + ai * 128 + m * 16) * DM + j0; float a[8];
#pragma unroll
                for (int n = 0; n < 2; ++n) { const pg8::f32x4 gq = acc[ai][0][m][n] + bg[n], uq = acc[ai][1][m][n] + bu[n];
#pragma unroll
                    for (int j = 0; j < 4; ++j) { const float gg = fminf(gq[j], 7.f), uu = fminf(fmaxf(uq[j], -7.f), 7.f); a[4 * n + j] = gg * sigmoid_f(1.702f * gg) * (uu + 1.f); } }
                u32x4 w; w[0] = pk2(a[0], a[1]); w[1] = pk2(a[2], a[3]); w[2] = pk2(a[4], a[5]); w[3] = pk2(a[6], a[7]); EPI_STORE((u32x4*)rowp, w); }
    }
};
struct EpiDown {
    static constexpr bool PERM = true, AFTER_DRAIN = false;
    bf16_t* O; const LAS float* biasl;
    int skip = 0;
    bf16_t* dump = nullptr;
    mutable int cnt = 0;
    DI void operator()(const pg8::f32x4 (&acc)[2][2][4][2], const pg8::Unit& u, int wr, int wc, int fr, int fq) const {
#ifdef PH_REP
        if (skip == 3) {
            bf16_t* dp = dump + ((size_t)(blockIdx.x * 8 + wr * 4 + wc) * 1024 + (fq * 16 + fr)) * 8;
#pragma unroll
            for (int a = 0; a < 2; ++a)
#pragma unroll
                for (int m = 0; m < 4; ++m)
#pragma unroll
                    for (int b = 0; b < 2; ++b) { const pg8::f32x4 v0 = acc[a][b][m][0], v1 = acc[a][b][m][1];
                        u32x4 w; w[0] = pk2(v0[0], v0[1]); w[1] = pk2(v0[2], v0[3]); w[2] = pk2(v1[0], v1[1]); w[3] = pk2(v1[2], v1[3]);
                        *(u32x4*)(dp + ((a * 4 + m) * 2 + b) * 512) = w; }
            return; }
        if (skip == 4) {
            bf16_t* dp = dump + (size_t)blockIdx.x * 65536 + (wr * 64 + fr) * 256 + wc * 32 + 8 * fq;
#pragma unroll
            for (int a = 0; a < 2; ++a)
#pragma unroll
                for (int m = 0; m < 4; ++m)
#pragma unroll
                    for (int b = 0; b < 2; ++b) { const pg8::f32x4 v0 = acc[a][b][m][0], v1 = acc[a][b][m][1];
                        u32x4 w; w[0] = pk2(v0[0], v0[1]); w[1] = pk2(v0[2], v0[3]); w[2] = pk2(v1[0], v1[1]); w[3] = pk2(v1[2], v1[3]);
                        *(u32x4*)(dp + (a * 128 + m * 16) * 256 + b * 128) = w; }
            return; }
        if (skip == 1) {
#pragma unroll
            for (int a = 0; a < 2; ++a)
#pragma unroll
                for (int b = 0; b < 2; ++b)
#pragma unroll
                    for (int m = 0; m < 4; ++m) asm volatile("" :: "v"(acc[a][b][m][0]), "v"(acc[a][b][m][1]));
            return; }
#endif
        const int row0 = u.pm * 256 + wr * 64 + fr, col0 = u.pn * 256 + wc * 32 + 8 * fq;
        const LAS float* b = biasl + cnt * 256 - u.pn * 256; ++cnt;
        pg8::f32x4 bv[2][2];
#pragma unroll
        for (int bj = 0; bj < 2; ++bj)
#pragma unroll
            for (int n = 0; n < 2; ++n) bv[bj][n] = *(const LAS pg8::f32x4*)(b + col0 + bj * 128 + 4 * n);
#pragma unroll
        for (int ai = 0; ai < 2; ++ai)
#pragma unroll
            for (int m = 0; m < 4; ++m) { bf16_t* rowp = O + (size_t)(row0 + ai * 128 + m * 16) * DM + col0;
#pragma unroll
                for (int bj = 0; bj < 2; ++bj) { const pg8::f32x4 v0 = acc[ai][bj][m][0] + bv[bj][0], v1 = acc[ai][bj][m][1] + bv[bj][1];
                    u32x4 w; w[0] = pk2(v0[0], v0[1]); w[1] = pk2(v0[2], v0[3]); w[2] = pk2(v1[0], v1[1]); w[3] = pk2(v1[2], v1[3]);
                    if (skip == 2) asm volatile("" :: "v"(w)); else EPI_STORE((u32x4*)(rowp + bj * 128), w); } }
    }
};

DI void outproj_ctx(const Frame& F, int l, const float* res_ctx) {
    if (F.bid >= 256) return;
    const int mt = F.bid >> 5, nt = F.bid & 31, lane = F.lane, r = lane & 31, h = lane >> 5;
    const bf16_t* A = WSP(bf16_t, WS_MIX) + (size_t)(mt * 32 + r) * DM + F.wave * 128 + 8 * h;
    const bf16_t* B = WSP(bf16_t, WS_WOUT) + (size_t)l * DM * DM + (size_t)(nt * 32 + r) * DM + F.wave * 128 + 8 * h;
    f32x16 acc = splat16(0.f);
#pragma unroll
    for (int ks = 0; ks < 8; ++ks) acc = mfma32(ld8g(A + ks * 16), ld8g(B + ks * 16), acc);
    LAS float* R = (LAS float*)F.lds;
    __syncthreads();
#pragma unroll
    for (int i = 0; i < 16; ++i) R[(F.wave * 16 + i) * 64 + lane] = acc[i];
    __syncthreads();
    for (int e = F.tid; e < 1024; e += 512) { const int i = e >> 6, ln = e & 63; float s = 0.f;
#pragma unroll
        for (int w = 0; w < 8; ++w) s += R[(w * 16 + i) * 64 + ln];
        const int row = mt * 32 + crow(i, ln >> 5), col = nt * 32 + (ln & 31);
        WSP(float, WS_XA)[(size_t)row * DM + col] = res_ctx[(size_t)row * DM + col] + WSP(float, WS_MOD)[(size_t)l * 2 * 6144 + 6144 + 2 * 1024 + col] * s; }
    __syncthreads();
}

template <int DIM> DI void rope_vec(float (&v)[DIM], const f32x2* tab_row, const f32x2* tab_col) {
    constexpr int Q = DIM / 4;
#pragma unroll
    for (int i = 0; i < Q; ++i) { const f32x2 r = tab_row[i], c = tab_col[i];
        const float a = v[i], b = v[Q + i]; v[i] = a * r.x - b * r.y; v[Q + i] = a * r.y + b * r.x;
        const float a2 = v[2 * Q + i], b2 = v[3 * Q + i]; v[2 * Q + i] = a2 * c.x - b2 * c.y; v[3 * Q + i] = a2 * c.y + b2 * c.x; }
}
template <int DIM> DI void load_vec(const bf16_t* p, float (&v)[DIM]) {
#pragma unroll
    for (int i = 0; i < DIM / 8; ++i) { const u32x4 w = *(const u32x4*)(p + 8 * i);
#pragma unroll
        for (int j = 0; j < 4; ++j) { v[8 * i + 2 * j] = bflo(w[j]); v[8 * i + 2 * j + 1] = bfhi(w[j]); } }
}
template <int DIM> DI float store_vec(bf16_t* p, const float (&v)[DIM]) {
    float ss = 0.f;
#pragma unroll
    for (int i = 0; i < DIM / 8; ++i) { u32x4 w;
#pragma unroll
        for (int j = 0; j < 4; ++j) { w[j] = pk2(v[8 * i + 2 * j], v[8 * i + 2 * j + 1]); const float a = bflo(w[j]), b = bfhi(w[j]); ss += a * a + b * b; }
        *(u32x4*)(p + 8 * i) = w; }
    return ss;
}
DI void p3_attn_prep(const Frame& F, int l, int item) {
    LAS unsigned* KMX = (LAS unsigned*)(F.lds + LDS_MISC);
    LAS bf16_t* VS = (LAS bf16_t*)F.lds;
    const int tid = F.tid, tok0 = item * 64;
    if (tid < 32) KMX[tid] = 0u;
    const bf16_t* U = WSP(bf16_t, WS_U);
    for (int i = tid; i < 64 * 48; i += 512) { const int t = i / 48, c8 = i % 48; const int col = c8 < 32 ? U_DV + 8 * c8 : U_GV + 8 * (c8 - 32);
        *(LAS u32x4*)(VS + t * 384 + 8 * c8) = *(const u32x4*)(U + (size_t)(tok0 + t) * NU + col); }
    __syncthreads();
    const f32x2* ropeD = WSP(f32x2, WS_ROPE); const f32x2* ropeG = ropeD + 256 * 8;
    const float qs_d = 0.17677669529663687f * LOG2E, qs_g = 0.125f * LOG2E;
    for (int task = tid; task < 64 * 22; task += 512) {
        int t, vi;
        if (task < 1024) { t = task & 63; vi = task >> 6; } else if (task < 1280) { t = task & 63; vi = 16 + ((task - 1024) >> 6); } else { t = task & 63; vi = 20 + ((task - 1280) >> 6); }
        const int tok = tok0 + t; const bool lat = tok >= CTX; const int pos = tok - CTX, pr = lat ? pos >> 6 : 0, pc = lat ? pos & 63 : 0;
        const bf16_t* urow = U + (size_t)tok * NU;
        if (vi < 16) {
            const bool isk = vi >= 8; const int hm = vi & 7, h = hm >> 1, m = hm & 1;
            float v[32]; load_vec<32>(urow + (isk ? U_DK : U_DQ) + hm * 32, v);
            if (lat) rope_vec<32>(v, ropeD + pr * 8, ropeD + pc * 8);
            if (!isk) {
#pragma unroll
                for (int i = 0; i < 32; ++i) v[i] *= qs_d;
                const float ss = store_vec<32>(WSP(bf16_t, WS_QD) + ((size_t)h * NT + tok) * 64 + m * 32, v);
                WSP(float, WS_QND)[((size_t)h * 2 + m) * NT + tok] = sqrtf(ss);
                __hip_atomic_fetch_max(KMX + 10 + hm, __float_as_uint(ss), __ATOMIC_RELAXED, __HIP_MEMORY_SCOPE_WORKGROUP);
            } else {
                const float ss = store_vec<32>(WSP(bf16_t, WS_KD) + ((size_t)h * NT + tok) * 64 + m * 32, v);
                __hip_atomic_fetch_max(KMX + hm, __float_as_uint(ss), __ATOMIC_RELAXED, __HIP_MEMORY_SCOPE_WORKGROUP);
            }
        } else {
            const bool isk = vi >= 20; const int h = isk ? vi - 20 : vi - 16;
            float v[64]; load_vec<64>(urow + (isk ? U_GK : U_GQ) + h * 64, v);
            float ss = 0.f;
#pragma unroll
            for (int i = 0; i < 64; ++i) ss += v[i] * v[i];
            const float rs = __builtin_amdgcn_rsqf(ss * (1.f / 64.f) + EPS);
            const float* nw = ((const float*)F.in[isk ? I_KNW : I_QNW]) + (size_t)l * 64;
#pragma unroll
            for (int i = 0; i < 64; ++i) v[i] = v[i] * rs * nw[i];
            if (lat) rope_vec<64>(v, ropeG + pr * 16, ropeG + pc * 16);
            if (!isk) {
#pragma unroll
                for (int i = 0; i < 64; ++i) v[i] *= qs_g;
                const float s2 = store_vec<64>(WSP(bf16_t, WS_QG) + ((size_t)h * NT + tok) * 64, v);
                WSP(float, WS_QNG)[(size_t)h * NT + tok] = sqrtf(s2);
                __hip_atomic_fetch_max(KMX + 18 + h, __float_as_uint(s2), __ATOMIC_RELAXED, __HIP_MEMORY_SCOPE_WORKGROUP);
            } else {
                const float s2 = store_vec<64>(WSP(bf16_t, WS_KG) + ((size_t)h * NT + tok) * 64, v);
                __hip_atomic_fetch_max(KMX + 8 + h, __float_as_uint(s2), __ATOMIC_RELAXED, __HIP_MEMORY_SCOPE_WORKGROUP);
            }
        }
    }
    for (int i = tid; i < 384 * 8; i += 512) { const int c = i >> 3, o = i & 7; u32x4 w;
#pragma unroll
        for (int j = 0; j < 4; ++j) { const unsigned lo = VS[(8 * o + 2 * j) * 384 + c], hi = VS[(8 * o + 2 * j + 1) * 384 + c]; w[j] = lo | (hi << 16); }
        bf16_t* dst = c < 256 ? WSP(bf16_t, WS_VTD) + (size_t)c * NT : WSP(bf16_t, WS_VTG) + (size_t)(c - 256) * NT;
        *(u32x4*)(dst + tok0 + 8 * o) = w; }
    __syncthreads();
    if (tid < 22) __hip_atomic_fetch_max(WSP(unsigned, WS_CTL) + CW_KMAX + l * 32 + tid, KMX[tid], __ATOMIC_RELAXED, __HIP_MEMORY_SCOPE_AGENT);
    __syncthreads();
}

constexpr int UBP = 1032;
template <bool FROM_U>
DI void s5_stage_u(const Frame& F, int g, int nt) {
    LAS bf16_t* UB = (LAS bf16_t*)F.lds;
    __syncthreads();
    for (int i = F.tid; i < 32 * 128; i += 512) { const int n = i >> 7, p = i & 127; const int chunk = nt * 32 + n, cc = chunk < NC5 ? chunk : NC5 - 1;
        if (FROM_U) { const int s = p >> 1, hh = p & 1; *(LAS u32x4*)(UB + n * UBP + s * 16 + 8 * hh) = *(const u32x4*)(WSP(bf16_t, WS_U) + (size_t)(cc * S5L + s) * NU + U_S5 + g * 16 + 8 * hh); }
        else *(LAS u32x4*)(UB + n * UBP + 8 * p) = *(const u32x4*)(WSP(bf16_t, WS_US5) + ((size_t)g * NT + (size_t)cc * S5L) * 16 + 8 * p); }
    __syncthreads();
}
constexpr int N_S5H = 16 * 9;
DI void p3_s5_hloc(const Frame& F, int l, int item) {
    const int g = item / 9, nt = item % 9, dir = F.wave >> 2, mt = F.wave & 3, lane = F.lane, r = lane & 31, h = lane >> 5;
    s5_stage_u<false>(F, g, nt);
    const LAS bf16_t* UB = (const LAS bf16_t*)F.lds + r * UBP + 8 * h;
    const bf16_t* E = WSP(bf16_t, WS_E5) + ((size_t)l * 16 + g) * 2 * 128 * 1024 + ((size_t)(dir * 4 + mt) * 64 * 64 + lane) * 8;
    f32x16 acc = splat16(0.f);
#pragma unroll 16
    for (int ks = 0; ks < 64; ++ks) acc = mfma32(ld8g(E + ks * 512), *(const LAS bf16x8*)(UB + ks * 16), acc);
    const int chunk = nt * 32 + r;
    if (chunk < NC5) { float* o = WSP(float, WS_HLOC) + (size_t)chunk * 4096 + (g * 2 + dir) * 128 + mt * 32;
#pragma unroll
        for (int i = 0; i < 16; ++i) o[crow(i, h)] = acc[i]; }
}

constexpr int SP = 136;
DI void p3_ssd_prep(const Frame& F, int l, int c) {
    LAS bf16_t* XT = (LAS bf16_t*)F.lds;
    LAS bf16_t* BT = XT + 256 * SP;
    LAS float* DTL = (LAS float*)(BT + 256 * SP);
    LAS float* CML = DTL + 8 * 128;
    LAS float* WG = CML + 8 * 128;
    const int tid = F.tid, lane = F.lane, tok0 = c * 128;
    const int seq_lo = c < 2 ? 0 : CTX, seq_hi = c < 2 ? CTX : NT;
    const bf16_t* U = WSP(bf16_t, WS_U);
    const float* cw = ((const float*)F.in[I_CONVW]) + (size_t)l * 3 * 768; const float* cb = ((const float*)F.in[I_CONVB]) + (size_t)l * 768;
    constexpr int RP = 264;
    LAS bf16_t* RAW = XT;
    LAS f32x4* CWS = (LAS f32x4*)(WG + 8 * 128);
#pragma unroll 1
    for (int sec = 1; sec < 3; ++sec) {
        __syncthreads();
        if (tid < 256) CWS[tid] = (f32x4){cw[sec * 256 + tid], cw[768 + sec * 256 + tid], cw[1536 + sec * 256 + tid], cb[sec * 256 + tid]};
        for (int i = tid; i < 130 * 32; i += 512) { const int rr = i >> 5, p = i & 31, tok = tok0 - 1 + rr;
            const u32x4 v = (tok >= seq_lo && tok < seq_hi) ? *(const u32x4*)(U + (size_t)tok * NU + U_XS + sec * 256 + 8 * p) : (u32x4){0u, 0u, 0u, 0u};
            *(LAS u32x4*)(RAW + rr * RP + 8 * p) = v; }
        __syncthreads();
        for (int task = tid; task < 128 * 32; task += 512) { const int t = task & 127, cg = task >> 7, tok = tok0 + t, chl = cg * 8, ch0 = sec * 256 + chl;
            const u32x4 xm = *(const LAS u32x4*)(RAW + t * RP + chl), x0 = *(const LAS u32x4*)(RAW + (t + 1) * RP + chl), xp = *(const LAS u32x4*)(RAW + (t + 2) * RP + chl);
            float y[8]; (void)ch0;
#pragma unroll
            for (int j = 0; j < 4; ++j) { const f32x4 c0 = CWS[chl + 2 * j], c1 = CWS[chl + 2 * j + 1];
                const float a0 = bflo(xm[j]) * c0[0] + bflo(x0[j]) * c0[1] + bflo(xp[j]) * c0[2] + c0[3];
                const float a1 = bfhi(xm[j]) * c1[0] + bfhi(x0[j]) * c1[1] + bfhi(xp[j]) * c1[2] + c1[3];
                y[2 * j] = silu_f(a0); y[2 * j + 1] = silu_f(a1); }
            u32x4 w;
#pragma unroll
            for (int j = 0; j < 4; ++j) w[j] = pk2(y[2 * j], y[2 * j + 1]);
            if (sec == 1) { *(u32x4*)(WSP(bf16_t, WS_BN) + (size_t)tok * 256 + chl) = w;
#pragma unroll
                for (int j = 0; j < 8; ++j) BT[(chl + j) * SP + t] = f2bf(y[j]);
            } else *(u32x4*)(WSP(bf16_t, WS_CN) + (size_t)tok * 256 + chl) = w; }
    }
    __syncthreads();
    if (tid < 256) CWS[tid] = (f32x4){cw[tid], cw[768 + tid], cw[1536 + tid], cb[tid]};
    __syncthreads();
    for (int task = tid; task < 128 * 32; task += 512) { const int t = task & 127, cg = task >> 7, tok = tok0 + t, ch0 = cg * 8;
        const u32x4 z4 = {0u, 0u, 0u, 0u};
        const u32x4 xm = (tok - 1 >= seq_lo) ? *(const u32x4*)(U + (size_t)(tok - 1) * NU + U_XS + ch0) : z4;
        const u32x4 x0 = *(const u32x4*)(U + (size_t)tok * NU + U_XS + ch0);
        const u32x4 xp = (tok + 1 < seq_hi) ? *(const u32x4*)(U + (size_t)(tok + 1) * NU + U_XS + ch0) : z4;
#pragma unroll
        for (int j = 0; j < 4; ++j) { const f32x4 c0 = CWS[ch0 + 2 * j], c1 = CWS[ch0 + 2 * j + 1];
            const float a0 = bflo(xm[j]) * c0[0] + bflo(x0[j]) * c0[1] + bflo(xp[j]) * c0[2] + c0[3];
            const float a1 = bfhi(xm[j]) * c1[0] + bfhi(x0[j]) * c1[1] + bfhi(xp[j]) * c1[2] + c1[3];
            XT[(ch0 + 2 * j) * SP + t] = f2bf(silu_f(a0)); XT[(ch0 + 2 * j + 1) * SP + t] = f2bf(silu_f(a1)); }
    }
    { const int j = F.wave, dir = j >> 2; const float bias = ((const float*)F.in[I_DTB])[(size_t)l * 8 + j], a = -__expf(((const float*)F.in[I_ALOG])[(size_t)l * 8 + j]);
      float e[2], dtv[2];
#pragma unroll
      for (int q = 0; q < 2; ++q) { const int li = 2 * lane + q, t = dir ? 127 - li : li;
          const float x = WSP(float, WS_DTRAW)[(size_t)(tok0 + t) * 8 + j] + bias; dtv[q] = x > 20.f ? x : log1pf(__expf(x)); e[q] = dtv[q] * a * LOG2E; }
      float s = e[0] + e[1];
#pragma unroll
      for (int o = 1; o < 64; o <<= 1) { const float tv = __shfl_up(s, o); if (lane >= o) s += tv; }
      const float c1 = s, c0 = s - e[1];
#pragma unroll
      for (int q = 0; q < 2; ++q) { const int li = 2 * lane + q, t = dir ? 127 - li : li; const float cv = q ? c1 : c0;
          DTL[j * 128 + t] = dtv[q]; CML[j * 128 + t] = cv;
          WSP(float, WS_DTV)[((size_t)c * 8 + j) * 128 + t] = dtv[q]; WSP(float, WS_CUM)[((size_t)c * 8 + j) * 128 + t] = cv; }
    }
    __syncthreads();
    for (int i = tid; i < 8 * 128; i += 512) { const int j = i >> 7; const float tot = CML[j * 128 + ((j >> 2) ? 0 : 127)]; WG[i] = DTL[i] * __builtin_amdgcn_exp2f(tot - CML[i]); }
    for (int i = tid; i < 256 * 16; i += 512) { const int ch = i >> 4, o = i & 15; *(u32x4*)(WSP(bf16_t, WS_XST) + ((size_t)c * 256 + ch) * 128 + 8 * o) = *(const LAS u32x4*)(XT + ch * SP + 8 * o); }
    __syncthreads();
    { const int j = F.wave, hh = j & 3, g = hh >> 1, r = lane & 31, h = lane >> 5;
      f32x16 acc[2][4];
#pragma unroll
      for (int a = 0; a < 2; ++a)
#pragma unroll
          for (int b = 0; b < 4; ++b) acc[a][b] = splat16(0.f);
#pragma unroll 1
      for (int ks = 0; ks < 8; ++ks) {
          const f32x4 w0 = *(const LAS f32x4*)(WG + j * 128 + ks * 16 + 8 * h), w1 = *(const LAS f32x4*)(WG + j * 128 + ks * 16 + 8 * h + 4);
          bf16x8 af[2], bfr[4];
#pragma unroll
          for (int a = 0; a < 2; ++a) { const u32x4 x = *(const LAS u32x4*)(XT + (hh * 64 + a * 32 + r) * SP + ks * 16 + 8 * h); u32x4 o;
              o[0] = pk2(bflo(x[0]) * w0[0], bfhi(x[0]) * w0[1]); o[1] = pk2(bflo(x[1]) * w0[2], bfhi(x[1]) * w0[3]);
              o[2] = pk2(bflo(x[2]) * w1[0], bfhi(x[2]) * w1[1]); o[3] = pk2(bflo(x[3]) * w1[2], bfhi(x[3]) * w1[3]); af[a] = __builtin_bit_cast(bf16x8, o); }
#pragma unroll
          for (int b = 0; b < 4; ++b) bfr[b] = *(const LAS bf16x8*)(BT + (g * 128 + b * 32 + r) * SP + ks * 16 + 8 * h);
#pragma unroll
          for (int a = 0; a < 2; ++a)
#pragma unroll
              for (int b = 0; b < 4; ++b) acc[a][b] = mfma32(af[a], bfr[b], acc[a][b]);
      }
      float* o = WSP(float, WS_SLOC) + ((size_t)c * 8 + j) * 64 * 128;
#pragma unroll
      for (int a = 0; a < 2; ++a)
#pragma unroll
          for (int b = 0; b < 4; ++b)
#pragma unroll
              for (int i = 0; i < 16; ++i) o[(a * 32 + crow(i, h)) * 128 + b * 32 + r] = acc[a][b][i];
    }
    __syncthreads();
}

DI void p4_s5_scan_el(const Frame& F, int l, int st);
DI void p4_ssd_scan(const Frame& F, int l) {
    if (F.tid >= 256) { if (F.tid < 264) { const int st = F.bid * 8 + (F.tid - 256); if (st < 2048) p4_s5_scan_el(F, l, st); } return; }
    const int el = F.bid * 256 + F.tid; if (el >= 65536) return;
    const int j = el >> 13;
    const int dir = j >> 2;
    const float* cum = WSP(float, WS_CUM); const float* sl = WSP(float, WS_SLOC); bf16_t* so = WSP(bf16_t, WS_SIN);
    const int eo = el & 8191;
    float s = 0.f;
#pragma unroll 26
    for (int i = 0; i < NCH; ++i) { const int c = dir ? (i < 2 ? 1 - i : NCH + 1 - i) : i;
        so[((size_t)c * 8 + j) * 8192 + eo] = f2bf(s);
        const float tot = cum[((size_t)c * 8 + j) * 128 + (dir ? 0 : 127)];
        s = s * __builtin_amdgcn_exp2f(tot) + sl[((size_t)c * 8 + j) * 8192 + eo]; }
}
DI void p4_s5_scan_el(const Frame& F, int l, int st) {
    const int g = st >> 7, dir = (st >> 6) & 1, p = st & 63;
    const f32x2 ap = WSP(f32x2, WS_APOW)[((size_t)l * 16 + g) * 128 + dir * 64 + p];
    const float* hl = WSP(float, WS_HLOC) + (g * 2 + dir) * 128 + p; bf16_t* ho = WSP(bf16_t, WS_HIN) + (g * 2 + dir) * 128 + p;
    f32x2 s = {0.f, 0.f};
#pragma unroll 26
    for (int i = 0; i < NC5; ++i) { const int c = dir ? (i < 4 ? 3 - i : NC5 + 3 - i) : i;
        ho[(size_t)c * 4096] = f2bf(s.x); ho[(size_t)c * 4096 + 64] = f2bf(s.y);
        const f32x2 loc = {hl[(size_t)c * 4096], hl[(size_t)c * 4096 + 64]};
        s = cmul(s, ap) + loc; }
}


constexpr int CVJ_LDS = 72 * 1024;
struct CvTile { const float* src; bf16_t* dst; int ld, c0, k0, mode; };
DI CvTile cv_decode(const Frame& F, int l, int m) {
    const int e = m / 1536, r = m % 1536; CvTile c;
    if (r < 1024) { c.src = ((const float*)F.in[I_WGU]) + (size_t)(l * NEXP + e) * DM * 2048; c.dst = WSP(bf16_t, WS_WGU) + (size_t)(l * NEXP + e) * 2048 * DM; c.ld = 2048; c.c0 = (r >> 4) * 32; c.k0 = (r & 15) * 64; c.mode = 2; }
    else { const int q = r - 1024; c.src = ((const float*)F.in[I_WDN]) + (size_t)(l * NEXP + e) * DM * DM; c.dst = WSP(bf16_t, WS_WDN) + (size_t)(l * NEXP + e) * DM * DM; c.ld = DM; c.c0 = (q >> 4) * 32; c.k0 = (q & 15) * 64; c.mode = 0; }
    return c;
}
DI void cv_issue(const Frame& F, int l, int j, f32x4 (&v)[8]) {
    const CvTile c = cv_decode(F, l, (F.bid * 8 + F.wave) + 2048 * j);
    const float* s = c.src + (size_t)(c.k0 + (F.lane >> 3)) * c.ld + c.c0 + 4 * (F.lane & 7);
#pragma unroll
    for (int i = 0; i < 8; ++i) v[i] = *(const f32x4*)(s + (size_t)(8 * i) * c.ld);
}
DI void cv_stage(const Frame& F, const f32x4 (&v)[8]) {
    LAS unsigned char* base = F.lds + CVJ_LDS + F.wave * 8192 + F.lane * 16;
#pragma unroll
    for (int i = 0; i < 8; ++i) *(LAS f32x4*)(base + i * 1024) = v[i];
}
DI void cv_finish(const Frame& F, int l, int j) {
    const CvTile c = cv_decode(F, l, (F.bid * 8 + F.wave) + 2048 * j);
    const LAS float* T = (const LAS float*)(F.lds + CVJ_LDS + F.wave * 8192);
    const int col = F.lane & 31, kh = F.lane >> 5, row = conv_dst_row(c.mode, c.c0 + col);
    bf16_t* o = c.dst + (size_t)row * DM + c.k0 + kh * 32;
#pragma unroll
    for (int q = 0; q < 4; ++q) { u32x4 w;
#pragma unroll
        for (int i = 0; i < 4; ++i) w[i] = pk2(T[(kh * 32 + 8 * q + 2 * i) * 32 + col], T[(kh * 32 + 8 * q + 2 * i + 1) * 32 + col]);
        *(u32x4*)(o + 8 * q) = w; }
}
constexpr int AP = 144;
struct AttnOut { bf16_t* mix; int col0; float lam, outscale; const float* subw; };
#ifndef DIFF_KT
#define DIFF_KT 64
#endif
#ifndef ATT_SCALAR_SUM
#define ATT_SCALAR_SUM 0
#endif
#ifndef ATT_STATIC_PRIO
#define ATT_STATIC_PRIO 0
#endif
#if ATT_STATIC_PRIO
#define ATT_PRIO_HI do { } while (0)
#define ATT_PRIO_LO do { } while (0)
#else
#define ATT_PRIO_HI __builtin_amdgcn_s_setprio(1)
#define ATT_PRIO_LO __builtin_amdgcn_s_setprio(0)
#endif
template <bool DIFF, int KT>
DI void attn_item(const Frame& F, const bf16_t* Q, const bf16_t* K, const bf16_t* Vt, const float* qn0, const float* qn1, float km0, float km1,
                  int q0, int nkeys, const AttnOut& ao, int cv_l = -1) {
    constexpr int KTB = KT * AP, VPB = KT * 2 + 16, VTB = 64 * VPB, NP = KT / 64;
    LAS unsigned char* KB = F.lds;
    LAS unsigned char* VB = F.lds + 2 * KTB;
    const int tid = F.tid, lane = F.lane, r = lane & 31, h = lane >> 5;
    const int qrow = q0 + F.wave * 32 + r;
    bf16x8 qf[4];
#pragma unroll
    for (int j = 0; j < 4; ++j) qf[j] = ld8g(Q + (size_t)qrow * 64 + j * 16 + 8 * h);
    const float sh0 = -qn0[qrow] * km0, sh1 = DIFF ? -qn1[qrow] * km1 : 0.f;
    f32x16 O0[2], O1[2];
#pragma unroll
    for (int d = 0; d < 2; ++d) { O0[d] = splat16(0.f); O1[d] = splat16(0.f); }
    f32x2 l0v = {0.f, 0.f}, l1v = {0.f, 0.f};
    const int srow = tid >> 3, sch = tid & 7;
    const bf16_t* kg = K + (size_t)srow * 64 + sch * 8; const bf16_t* vg = Vt + (size_t)srow * NT + sch * 8;
    const int ntile = nkeys / KT;
    u32x4 kreg[NP], vreg[NP];
#pragma unroll
    for (int i = 0; i < NP; ++i) { kreg[i] = *(const u32x4*)(kg + (size_t)i * 64 * 64); vreg[i] = *(const u32x4*)(vg + i * 64); }
    __syncthreads();
#pragma unroll
    for (int i = 0; i < NP; ++i) { *(LAS u32x4*)(KB + (srow + 64 * i) * AP + sch * 16) = kreg[i]; *(LAS u32x4*)(VB + srow * VPB + (sch + 8 * i) * 16) = vreg[i]; }
    __syncthreads();
    const int krow = kperm(r);
    f32x4 cvv[8];
#pragma unroll
    for (int i = 0; i < 8; ++i) cvv[i] = (f32x4){0.f, 0.f, 0.f, 0.f};
    asm volatile("" :: "v"(qf[0]), "v"(qf[1]), "v"(qf[2]), "v"(qf[3]), "v"(sh0), "v"(sh1));
#if ATT_STATIC_PRIO
    if (F.wave >= 4) __builtin_amdgcn_s_setprio(1);
#endif
#pragma clang loop unroll(disable)
    for (int t = 0; t < ntile; ++t) {
        const int buf = t & 1;
        constexpr int CVP = KT == 64 ? 10 : 5;
        const int cv_tt = t - (F.bid % CVP), cv_tq = cv_tt / CVP, cv_tr = cv_tt - CVP * cv_tq;
        const bool cv_on = !DIFF && cv_l >= 0 && cv_tt >= 0 && cv_tq < 24;
        if (cv_on && cv_tr == 2) cv_finish(F, cv_l, cv_tq);
        if (t + 1 < ntile) {
#pragma unroll
            for (int i = 0; i < NP; ++i) { kreg[i] = *(const u32x4*)(kg + ((size_t)(t + 1) * KT + i * 64) * 64); vreg[i] = *(const u32x4*)(vg + (size_t)(t + 1) * KT + i * 64); } }
        if (cv_on && cv_tr == 0) cv_issue(F, cv_l, cv_tq, cvv);
        const LAS unsigned char* kb = KB + buf * KTB; const LAS unsigned char* vb = VB + buf * VTB;
#pragma unroll
        for (int sub = 0; sub < KT / 32; ++sub) {
            bf16x8 kf[4];
#pragma unroll
            for (int j = 0; j < 4; ++j) kf[j] = *(const LAS bf16x8*)(kb + (sub * 32 + krow) * AP + j * 32 + h * 16);
            bf16x8 vf[2][2];
#pragma unroll
            for (int d = 0; d < 2; ++d)
#pragma unroll
                for (int s = 0; s < 2; ++s) vf[d][s] = *(const LAS bf16x8*)(vb + (d * 32 + r) * VPB + (sub * 32 + s * 16 + h * 8) * 2);
            {   f32x16 S = splat16(sh0);
                ATT_PRIO_HI;
                S = mfma32(kf[0], qf[0], S); S = mfma32(kf[1], qf[1], S);
                if (!DIFF) { S = mfma32(kf[2], qf[2], S); S = mfma32(kf[3], qf[3], S); }
                ATT_PRIO_LO;
#pragma unroll
                for (int i = 0; i < 16; ++i) {
#if defined(ATTN_DUP) && ATTN_DUP
                    float x2 = S[i]; asm volatile("" : "+v"(x2)); const float e2 = __builtin_amdgcn_exp2f(x2); S[i] = 0.5f * (__builtin_amdgcn_exp2f(S[i]) + e2);
#else
                    S[i] = __builtin_amdgcn_exp2f(S[i]);
#endif
                    }
#pragma unroll
#if ATT_SCALAR_SUM
                for (int i = 0; i < 16; i += 2) { asm("v_add_f32 %0, %0, %1" : "+v"(l0v.x) : "v"(S[i])); asm("v_add_f32 %0, %0, %1" : "+v"(l0v.y) : "v"(S[i + 1])); }
#else
                for (int i = 0; i < 16; i += 2) l0v += (f32x2){S[i], S[i + 1]};
#endif
                const bf16x8 p0 = pack_step<0>(S), p1 = pack_step<1>(S);
                ATT_PRIO_HI;
#pragma unroll
                for (int d = 0; d < 2; ++d) { O0[d] = mfma32(vf[d][0], p0, O0[d]); O0[d] = mfma32(vf[d][1], p1, O0[d]); }
                ATT_PRIO_LO; }
            if (DIFF) { f32x16 S = splat16(sh1);
                ATT_PRIO_HI;
                S = mfma32(kf[2], qf[2], S); S = mfma32(kf[3], qf[3], S);
                ATT_PRIO_LO;
#pragma unroll
                for (int i = 0; i < 16; ++i) {
#if defined(ATTN_DUP) && ATTN_DUP
                    float x2 = S[i]; asm volatile("" : "+v"(x2)); const float e2 = __builtin_amdgcn_exp2f(x2); S[i] = 0.5f * (__builtin_amdgcn_exp2f(S[i]) + e2);
#else
                    S[i] = __builtin_amdgcn_exp2f(S[i]);
#endif
                    }
#pragma unroll
#if ATT_SCALAR_SUM
                for (int i = 0; i < 16; i += 2) { asm("v_add_f32 %0, %0, %1" : "+v"(l1v.x) : "v"(S[i])); asm("v_add_f32 %0, %0, %1" : "+v"(l1v.y) : "v"(S[i + 1])); }
#else
                for (int i = 0; i < 16; i += 2) l1v += (f32x2){S[i], S[i + 1]};
#endif
                const bf16x8 p0 = pack_step<0>(S), p1 = pack_step<1>(S);
                ATT_PRIO_HI;
#pragma unroll
                for (int d = 0; d < 2; ++d) { O1[d] = mfma32(vf[d][0], p0, O1[d]); O1[d] = mfma32(vf[d][1], p1, O1[d]); }
                ATT_PRIO_LO; }
        }
        if (t + 1 < ntile) {
#pragma unroll
            for (int i = 0; i < NP; ++i) { *(LAS u32x4*)(KB + (buf ^ 1) * KTB + (srow + 64 * i) * AP + sch * 16) = kreg[i]; *(LAS u32x4*)(VB + (buf ^ 1) * VTB + srow * VPB + (sch + 8 * i) * 16) = vreg[i]; } }
        if (cv_on && cv_tr == 1) cv_stage(F, cvv);
        __syncthreads();
    }
#if ATT_STATIC_PRIO
    __builtin_amdgcn_s_setprio(0);
#endif
    const GAS float* subw = (const GAS float*)ao.subw; GAS bf16_t* mixp = (GAS bf16_t*)ao.mix;
    asm volatile("" : "+s"(subw)); asm volatile("" : "+s"(mixp));
    float l0 = l0v.x + l0v.y, l1 = l1v.x + l1v.y;
    l0 += __shfl_xor(l0, 32); const float i0 = 1.f / l0;
    float i1 = 0.f; if (DIFF) { l1 += __shfl_xor(l1, 32); i1 = ao.lam / l1; }
    float ss = 0.f;
#pragma unroll
    for (int d = 0; d < 2; ++d)
#pragma unroll
        for (int i = 0; i < 16; ++i) { float v = O0[d][i] * i0; if (DIFF) v -= O1[d][i] * i1; O0[d][i] = v; ss += v * v; }
    float sc = 1.f;
    if (DIFF) { ss += __shfl_xor(ss, 32); sc = __builtin_amdgcn_rsqf(ss * (1.f / 64.f) + EPS) * ao.outscale; }
    GAS bf16_t* orow = mixp + (size_t)qrow * DM + ao.col0;
#pragma unroll
    for (int d = 0; d < 2; ++d)
#pragma unroll
        for (int gq = 0; gq < 4; ++gq) { const int dd = d * 32 + 8 * gq + 4 * h; float o[4];
#pragma unroll
            for (int j = 0; j < 4; ++j) { o[j] = O0[d][4 * gq + j] * sc; if (DIFF) o[j] *= subw[dd + j]; }
            u32x2 w; w[0] = pk2(o[0], o[1]); w[1] = pk2(o[2], o[3]); *(GAS u32x2*)(orow + dd) = w; }
}
DI void attn_item_diff2(const Frame& F, const bf16_t* Q, const bf16_t* K, const bf16_t* Vt, int q0, int nkeys, const AttnOut& ao) {
    LAS unsigned char* KB = F.lds;
    LAS unsigned char* VB = F.lds + 2 * 64 * AP;
    const int tid = F.tid, lane = F.lane, r = lane & 31, h = lane >> 5;
    const int qrow = q0 + F.wave * 32 + r;
    bf16x8 qf[4];
#pragma unroll
    for (int j = 0; j < 4; ++j) qf[j] = ld8g(Q + (size_t)qrow * 64 + j * 16 + 8 * h);
    const f32x16 zero16 = splat16(0.f);
    f32x16 O0[2], O1[2]; float l0 = 0.f, l1 = 0.f;
#pragma unroll
    for (int dd = 0; dd < 2; ++dd) { O0[dd] = zero16; O1[dd] = zero16; }
    const int srow = tid >> 3, sch = tid & 7;
    const bf16_t* kg = K + (size_t)srow * 64 + sch * 8; const bf16_t* vg = Vt + (size_t)srow * NT + sch * 8;
    const int ntile = nkeys >> 6;
    u32x4 kreg = *(const u32x4*)kg, vreg = *(const u32x4*)vg;
    __syncthreads();
    *(LAS u32x4*)(KB + srow * AP + sch * 16) = kreg; *(LAS u32x4*)(VB + srow * AP + sch * 16) = vreg;
    __syncthreads();
    const int krow = kperm(r);
    asm volatile("" :: "v"(qf[0]), "v"(qf[1]), "v"(qf[2]), "v"(qf[3]));
#pragma clang loop unroll(disable)
    for (int t = 0; t < ntile; ++t) {
        const int buf = t & 1;
        if (t + 1 < ntile) { kreg = *(const u32x4*)(kg + (size_t)(t + 1) * 64 * 64); vreg = *(const u32x4*)(vg + (size_t)(t + 1) * 64); }
        const LAS unsigned char* kb = KB + buf * 64 * AP; const LAS unsigned char* vb = VB + buf * 64 * AP;
        bf16x8 kfa[4], kfb[4], vfa[2][2], vfb[2][2];
#pragma unroll
        for (int j = 0; j < 4; ++j) kfa[j] = *(const LAS bf16x8*)(kb + krow * AP + j * 32 + h * 16);
#pragma unroll
        for (int dd = 0; dd < 2; ++dd)
#pragma unroll
            for (int s = 0; s < 2; ++s) vfa[dd][s] = *(const LAS bf16x8*)(vb + (dd * 32 + r) * AP + (s * 16 + h * 8) * 2);
        {   f32x16 S = mfma32(kfa[0], qf[0], zero16); S = mfma32(kfa[1], qf[1], S);
#pragma unroll
            for (int j = 0; j < 4; ++j) kfb[j] = *(const LAS bf16x8*)(kb + (32 + krow) * AP + j * 32 + h * 16);
#pragma unroll
            for (int i = 0; i < 16; ++i) { S[i] = __builtin_amdgcn_exp2f(S[i]); l0 += S[i]; }
            const bf16x8 p0 = pack_step<0>(S), p1 = pack_step<1>(S);

#pragma unroll
            for (int dd = 0; dd < 2; ++dd) { O0[dd] = mfma32(vfa[dd][0], p0, O0[dd]); O0[dd] = mfma32(vfa[dd][1], p1, O0[dd]); } }
        {   f32x16 S = mfma32(kfa[2], qf[2], zero16); S = mfma32(kfa[3], qf[3], S);
#pragma unroll
            for (int dd = 0; dd < 2; ++dd)
#pragma unroll
                for (int s = 0; s < 2; ++s) vfb[dd][s] = *(const LAS bf16x8*)(vb + (dd * 32 + r) * AP + (32 + s * 16 + h * 8) * 2);
#pragma unroll
            for (int i = 0; i < 16; ++i) { S[i] = __builtin_amdgcn_exp2f(S[i]); l1 += S[i]; }
            const bf16x8 p0 = pack_step<0>(S), p1 = pack_step<1>(S);

#pragma unroll
            for (int dd = 0; dd < 2; ++dd) { O1[dd] = mfma32(vfa[dd][0], p0, O1[dd]); O1[dd] = mfma32(vfa[dd][1], p1, O1[dd]); } }
        {   f32x16 S = mfma32(kfb[0], qf[0], zero16); S = mfma32(kfb[1], qf[1], S);
#pragma unroll
            for (int i = 0; i < 16; ++i) { S[i] = __builtin_amdgcn_exp2f(S[i]); l0 += S[i]; }
            const bf16x8 p0 = pack_step<0>(S), p1 = pack_step<1>(S);

#pragma unroll
            for (int dd = 0; dd < 2; ++dd) { O0[dd] = mfma32(vfb[dd][0], p0, O0[dd]); O0[dd] = mfma32(vfb[dd][1], p1, O0[dd]); } }
        {   f32x16 S = mfma32(kfb[2], qf[2], zero16); S = mfma32(kfb[3], qf[3], S);
#pragma unroll
            for (int i = 0; i < 16; ++i) { S[i] = __builtin_amdgcn_exp2f(S[i]); l1 += S[i]; }
            const bf16x8 p0 = pack_step<0>(S), p1 = pack_step<1>(S);

#pragma unroll
            for (int dd = 0; dd < 2; ++dd) { O1[dd] = mfma32(vfb[dd][0], p0, O1[dd]); O1[dd] = mfma32(vfb[dd][1], p1, O1[dd]); } }
        if (t + 1 < ntile) { *(LAS u32x4*)(KB + (buf ^ 1) * 64 * AP + srow * AP + sch * 16) = kreg; *(LAS u32x4*)(VB + (buf ^ 1) * 64 * AP + srow * AP + sch * 16) = vreg; }
        __syncthreads();
    }
    const GAS float* subw = (const GAS float*)ao.subw; GAS bf16_t* mixp = (GAS bf16_t*)ao.mix;
    asm volatile("" : "+s"(subw)); asm volatile("" : "+s"(mixp));
    l0 += __shfl_xor(l0, 32); l1 += __shfl_xor(l1, 32);
    const float i0 = 1.f / l0, i1 = ao.lam / l1;
    float ss = 0.f;
#pragma unroll
    for (int dd = 0; dd < 2; ++dd)
#pragma unroll
        for (int i = 0; i < 16; ++i) { const float v = O0[dd][i] * i0 - O1[dd][i] * i1; O0[dd][i] = v; ss += v * v; }
    ss += __shfl_xor(ss, 32);
    const float sc = __builtin_amdgcn_rsqf(ss * (1.f / 64.f) + EPS) * ao.outscale;
    GAS bf16_t* orow = mixp + (size_t)qrow * DM + ao.col0;
#pragma unroll
    for (int dd = 0; dd < 2; ++dd)
#pragma unroll
        for (int gq = 0; gq < 4; ++gq) { const int dcol = dd * 32 + 8 * gq + 4 * h; float o[4];
#pragma unroll
            for (int j = 0; j < 4; ++j) o[j] = O0[dd][4 * gq + j] * sc * subw[dcol + j];
            u32x2 w; w[0] = pk2(o[0], o[1]); w[1] = pk2(o[2], o[3]); *(GAS u32x2*)(orow + dcol) = w; }
}
constexpr int G3_KP = 144, G3_VP = 528;
constexpr int G3_KB = 256 * G3_KP, G3_VB = 64 * G3_VP;
DI void attn_item_gqa3(const Frame& F, const bf16_t* Q, const bf16_t* K, const bf16_t* Vt, int q0, int nkeys, const AttnOut& ao) {
    LAS unsigned char* KB = F.lds;
    LAS unsigned char* VB = F.lds + 2 * G3_KB;
    const int tid = F.tid, lane = F.lane, r = lane & 31, h = lane >> 5;
    const int qrow = q0 + F.wave * 32 + r;
    bf16x8 qf[4];
#pragma unroll
    for (int j = 0; j < 4; ++j) qf[j] = ld8g(Q + (size_t)qrow * 64 + j * 16 + 8 * h);
    const f32x16 zero16 = splat16(0.f);
    f32x16 O[2]; O[0] = zero16; O[1] = zero16;
    float l0 = 0.f;
    const int kr = tid >> 3, kc = tid & 7, vr = tid >> 5, vc = tid & 31;
    const bf16_t* kg = K + (size_t)kr * 64 + kc * 8; const bf16_t* vg = Vt + (size_t)vr * NT + vc * 8;
    const int kdst = kr * G3_KP + kc * 16, vdst = vr * G3_VP + vc * 16;
    const int ntile = nkeys >> 8;
    u32x4 sreg[4];
    __syncthreads();
#pragma unroll
    for (int i = 0; i < 4; ++i) sreg[i] = *(const u32x4*)(kg + (size_t)i * 64 * 64);
#pragma unroll
    for (int i = 0; i < 4; ++i) *(LAS u32x4*)(KB + kdst + i * 64 * G3_KP) = sreg[i];
#pragma unroll
    for (int i = 0; i < 4; ++i) sreg[i] = *(const u32x4*)(vg + (size_t)i * 16 * NT);
#pragma unroll
    for (int i = 0; i < 4; ++i) *(LAS u32x4*)(VB + vdst + i * 16 * G3_VP) = sreg[i];
    __syncthreads();
    const int koff = kperm(r) * G3_KP + h * 16, voff = r * G3_VP + h * 16;
    asm volatile("" :: "v"(qf[0]), "v"(qf[1]), "v"(qf[2]), "v"(qf[3]));
#pragma clang loop unroll(disable)
    for (int t = 0; t < ntile; ++t) {
        const int buf = t & 1;
        const bool more = t + 1 < ntile;
        if (more) {
#pragma unroll
            for (int i = 0; i < 4; ++i) sreg[i] = *(const u32x4*)(kg + ((size_t)(t + 1) * 256 + i * 64) * 64); }
        const LAS unsigned char* kb = KB + buf * G3_KB + koff; const LAS unsigned char* vb = VB + buf * G3_VB + voff;
        f32x16 Sc = zero16; bf16x8 pp0, pp1;
#pragma unroll
        for (int j = 0; j < 4; ++j) Sc = mfma32(*(const LAS bf16x8*)(kb + j * 32), qf[j], j ? Sc : zero16);
#pragma unroll
        for (int u = 0; u < 8; ++u) {
            f32x16 Sn = zero16;
            if (u + 1 < 8) {
#pragma unroll
                for (int j = 0; j < 4; ++j) Sn = mfma32(*(const LAS bf16x8*)(kb + (u + 1) * 32 * G3_KP + j * 32), qf[j], j ? Sn : zero16); }
            float ls = 0.f;
#pragma unroll
            for (int i = 0; i < 16; ++i) { Sc[i] = __builtin_amdgcn_exp2f(Sc[i]); ls += Sc[i]; }
            l0 += ls;
            const bf16x8 pc0 = pack_step<0>(Sc), pc1 = pack_step<1>(Sc);
            if (u > 0) {
#pragma unroll
                for (int dd = 0; dd < 2; ++dd) { O[dd] = mfma32(*(const LAS bf16x8*)(vb + dd * 32 * G3_VP + (u - 1) * 64), pp0, O[dd]); O[dd] = mfma32(*(const LAS bf16x8*)(vb + dd * 32 * G3_VP + (u - 1) * 64 + 32), pp1, O[dd]); } }
#pragma unroll
            for (int g = 0; g < 8; ++g) { __builtin_amdgcn_sched_group_barrier(0x8, 1, 0); __builtin_amdgcn_sched_group_barrier(0x2, 5, 0); }
            pp0 = pc0; pp1 = pc1; Sc = Sn;
            if (u == 3 && more) {
#pragma unroll
                for (int i = 0; i < 4; ++i) *(LAS u32x4*)(KB + (buf ^ 1) * G3_KB + kdst + i * 64 * G3_KP) = sreg[i];
#pragma unroll
                for (int i = 0; i < 4; ++i) sreg[i] = *(const u32x4*)(vg + (size_t)(t + 1) * 256 + (size_t)i * 16 * NT); }
        }
#pragma unroll
        for (int dd = 0; dd < 2; ++dd) { O[dd] = mfma32(*(const LAS bf16x8*)(vb + dd * 32 * G3_VP + 7 * 64), pp0, O[dd]); O[dd] = mfma32(*(const LAS bf16x8*)(vb + dd * 32 * G3_VP + 7 * 64 + 32), pp1, O[dd]); }
        if (more) {
#pragma unroll
            for (int i = 0; i < 4; ++i) *(LAS u32x4*)(VB + (buf ^ 1) * G3_VB + vdst + i * 16 * G3_VP) = sreg[i]; }
        __syncthreads();
    }
    GAS bf16_t* mixp = (GAS bf16_t*)ao.mix;
    asm volatile("" : "+s"(mixp));
    l0 += __shfl_xor(l0, 32); const float i0 = 1.f / l0;
    GAS bf16_t* orow = mixp + (size_t)qrow * DM + ao.col0;
#pragma unroll
    for (int dd = 0; dd < 2; ++dd)
#pragma unroll
        for (int gq = 0; gq < 4; ++gq) { const int dcol = dd * 32 + 8 * gq + 4 * h;
            u32x2 w; w[0] = pk2(O[dd][4 * gq] * i0, O[dd][4 * gq + 1] * i0); w[1] = pk2(O[dd][4 * gq + 2] * i0, O[dd][4 * gq + 3] * i0); *(GAS u32x2*)(orow + dcol) = w; }
}
#define FENCE __builtin_amdgcn_sched_barrier(0)
#define G4_UNIT(u, HASQK, HASPV) do { \
            f32x16 Sn = zero16; \
            if (HASQK) Sn = mfma32(kfA[0], qf[0], zero16); \
            FENCE; Sc[0] = __builtin_amdgcn_exp2f(Sc[0]); Sc[1] = __builtin_amdgcn_exp2f(Sc[1]); Sc[2] = __builtin_amdgcn_exp2f(Sc[2]); FENCE; \
            if (HASQK) Sn = mfma32(kfA[1], qf[1], Sn); \
            FENCE; Sc[3] = __builtin_amdgcn_exp2f(Sc[3]); Sc[4] = __builtin_amdgcn_exp2f(Sc[4]); Sc[5] = __builtin_amdgcn_exp2f(Sc[5]); FENCE; \
            if (HASQK) Sn = mfma32(kfA[2], qf[2], Sn); \
            FENCE; Sc[6] = __builtin_amdgcn_exp2f(Sc[6]); Sc[7] = __builtin_amdgcn_exp2f(Sc[7]); Sc[8] = __builtin_amdgcn_exp2f(Sc[8]); FENCE; \
            if (HASQK) Sn = mfma32(kfA[3], qf[3], Sn); \
            FENCE; \
            if (HASQK) { _Pragma("unroll") for (int j = 0; j < 4; ++j) kfA[j] = *(const LAS bf16x8*)(kb + (((u) + 2) & 7) * 32 * G3_KP + j * 32); } \
            Sc[9] = __builtin_amdgcn_exp2f(Sc[9]); Sc[10] = __builtin_amdgcn_exp2f(Sc[10]); Sc[11] = __builtin_amdgcn_exp2f(Sc[11]); FENCE; \
            if (HASPV) O[0] = mfma32(vfA[0], pp0, O[0]); \
            FENCE; Sc[12] = __builtin_amdgcn_exp2f(Sc[12]); Sc[13] = __builtin_amdgcn_exp2f(Sc[13]); Sc[14] = __builtin_amdgcn_exp2f(Sc[14]); FENCE; \
            if (HASPV) O[0] = mfma32(vfA[1], pp1, O[0]); \
            FENCE; Sc[15] = __builtin_amdgcn_exp2f(Sc[15]); \
            l0 += (Sc[0] + Sc[1]) + (Sc[2] + Sc[3]); l1 += (Sc[4] + Sc[5]) + (Sc[6] + Sc[7]); FENCE; \
            if (HASPV) O[1] = mfma32(vfA[2], pp0, O[1]); \
            FENCE; l0 += (Sc[8] + Sc[9]) + (Sc[10] + Sc[11]); l1 += (Sc[12] + Sc[13]) + (Sc[14] + Sc[15]); \
            u32x4 pa; pa[0] = pk2(Sc[0], Sc[1]); pa[1] = pk2(Sc[2], Sc[3]); FENCE; \
            if (HASPV) O[1] = mfma32(vfA[3], pp1, O[1]); \
            FENCE; pa[2] = pk2(Sc[4], Sc[5]); pa[3] = pk2(Sc[6], Sc[7]); \
            u32x4 pb; pb[0] = pk2(Sc[8], Sc[9]); pb[1] = pk2(Sc[10], Sc[11]); pb[2] = pk2(Sc[12], Sc[13]); pb[3] = pk2(Sc[14], Sc[15]); FENCE; \
            pp0 = __builtin_bit_cast(bf16x8, pa); pp1 = __builtin_bit_cast(bf16x8, pb); Sc = Sn; \
            _Pragma("unroll") for (int j = 0; j < 4; ++j) vfA[j] = *(const LAS bf16x8*)(vb + (j >> 1) * 32 * G3_VP + (u) * 64 + (j & 1) * 32); \
            FENCE; } while (0)
DI void attn_item_gqa4(const Frame& F, const bf16_t* Q, const bf16_t* K, const bf16_t* Vt, int q0, int nkeys, const AttnOut& ao) {
    LAS unsigned char* KB = F.lds;
    LAS unsigned char* VB = F.lds + 2 * G3_KB;
    const int tid = F.tid, lane = F.lane, r = lane & 31, h = lane >> 5;
    const int qrow = q0 + F.wave * 32 + r;
    bf16x8 qf[4];
#pragma unroll
    for (int j = 0; j < 4; ++j) qf[j] = ld8g(Q + (size_t)qrow * 64 + j * 16 + 8 * h);
    const f32x16 zero16 = splat16(0.f);
    f32x16 O[2]; O[0] = zero16; O[1] = zero16;
    float l0 = 0.f, l1 = 0.f;
    const int kr = tid >> 3, kc = tid & 7, vr = tid >> 5, vc = tid & 31;
    const bf16_t* kg = K + (size_t)kr * 64 + kc * 8; const bf16_t* vg = Vt + (size_t)vr * NT + vc * 8;
    const int kdst = kr * G3_KP + kc * 16, vdst = vr * G3_VP + vc * 16;
    const int ntile = nkeys >> 8;
    u32x4 sreg[4];
    __syncthreads();
#pragma unroll
    for (int i = 0; i < 4; ++i) sreg[i] = *(const u32x4*)(kg + (size_t)i * 64 * 64);
#pragma unroll
    for (int i = 0; i < 4; ++i) *(LAS u32x4*)(KB + kdst + i * 64 * G3_KP) = sreg[i];
#pragma unroll
    for (int i = 0; i < 4; ++i) sreg[i] = *(const u32x4*)(vg + (size_t)i * 16 * NT);
#pragma unroll
    for (int i = 0; i < 4; ++i) *(LAS u32x4*)(VB + vdst + i * 16 * G3_VP) = sreg[i];
    __syncthreads();
    const int koff = kperm(r) * G3_KP + h * 16, voff = r * G3_VP + h * 16;
    asm volatile("" :: "v"(qf[0]), "v"(qf[1]), "v"(qf[2]), "v"(qf[3]));
#pragma clang loop unroll(disable)
    for (int t = 0; t < ntile; ++t) {
        const int buf = t & 1;
        const bool more = t + 1 < ntile;
        if (more) {
#pragma unroll
            for (int i = 0; i < 4; ++i) sreg[i] = *(const u32x4*)(kg + ((size_t)(t + 1) * 256 + i * 64) * 64); }
        const LAS unsigned char* kb = KB + buf * G3_KB + koff; const LAS unsigned char* vb = VB + buf * G3_VB + voff;
        bf16x8 kfA[4], kfB[4], vfA[4], pp0, pp1;
#pragma unroll
        for (int j = 0; j < 4; ++j) kfB[j] = *(const LAS bf16x8*)(kb + j * 32);
#pragma unroll
        for (int j = 0; j < 4; ++j) kfA[j] = *(const LAS bf16x8*)(kb + 32 * G3_KP + j * 32);
        f32x16 Sc = mfma32(kfB[0], qf[0], zero16); Sc = mfma32(kfB[1], qf[1], Sc); Sc = mfma32(kfB[2], qf[2], Sc); Sc = mfma32(kfB[3], qf[3], Sc);
        FENCE;
        G4_UNIT(0, true, false);
#pragma clang loop unroll(disable)
        for (int u = 1; u < 7; ++u) {
            G4_UNIT(u, true, true);
            if (u == 3 && more) {
#pragma unroll
                for (int i = 0; i < 4; ++i) *(LAS u32x4*)(KB + (buf ^ 1) * G3_KB + kdst + i * 64 * G3_KP) = sreg[i];
#pragma unroll
                for (int i = 0; i < 4; ++i) sreg[i] = *(const u32x4*)(vg + (size_t)(t + 1) * 256 + (size_t)i * 16 * NT); }
        }
        G4_UNIT(7, false, true);
        O[0] = mfma32(vfA[0], pp0, O[0]); O[0] = mfma32(vfA[1], pp1, O[0]); O[1] = mfma32(vfA[2], pp0, O[1]); O[1] = mfma32(vfA[3], pp1, O[1]);
        if (more) {
#pragma unroll
            for (int i = 0; i < 4; ++i) *(LAS u32x4*)(VB + (buf ^ 1) * G3_VB + vdst + i * 16 * G3_VP) = sreg[i]; }
        __syncthreads();
    }
    GAS bf16_t* mixp = (GAS bf16_t*)ao.mix;
    asm volatile("" : "+s"(mixp));
    int lz = 0; asm volatile("" : "+v"(lz));
    const int lane2 = (int)__builtin_amdgcn_mbcnt_hi(~0u, __builtin_amdgcn_mbcnt_lo(~0u, 0u)) + lz, h2 = lane2 >> 5, qrow2 = q0 + F.wave * 32 + (lane2 & 31);
    l0 += l1; l0 += __shfl_xor(l0, 32); const float i0 = 1.f / l0;
    GAS bf16_t* orow = mixp + (size_t)qrow2 * DM + ao.col0;
#pragma unroll
    for (int dd = 0; dd < 2; ++dd)
#pragma unroll
        for (int gq = 0; gq < 4; ++gq) { const int dcol = dd * 32 + 8 * gq + 4 * h2;
            u32x2 w; w[0] = pk2(O[dd][4 * gq] * i0, O[dd][4 * gq + 1] * i0); w[1] = pk2(O[dd][4 * gq + 2] * i0, O[dd][4 * gq + 3] * i0); *(GAS u32x2*)(orow + dcol) = w; }
}
DI void p4_attn_diff(const Frame& F, int l, int it) {
    const bool isctx = it >= 256; const int hd = isctx ? it - 256 : it & 3, qb = isctx ? 0 : it >> 2;
    const unsigned* km = WSP(unsigned, WS_CTL) + CW_KMAX + l * 32;
    const float km0 = sqrtf(__uint_as_float(__hip_atomic_load(km + hd * 2, __ATOMIC_RELAXED, __HIP_MEMORY_SCOPE_AGENT)));
    const float km1 = sqrtf(__uint_as_float(__hip_atomic_load(km + hd * 2 + 1, __ATOMIC_RELAXED, __HIP_MEMORY_SCOPE_AGENT)));
    const float lam_init = 0.8f - 0.6f * __expf(-0.3f * (float)l);
    AttnOut ao; ao.mix = WSP(bf16_t, WS_MIX); ao.col0 = hd * 64; ao.lam = WSP(float, WS_LAM)[l]; ao.outscale = 1.f - lam_init; ao.subw = ((const float*)F.in[I_SUBLN]) + (size_t)l * 64;
    const float qm0 = sqrtf(__uint_as_float(__hip_atomic_load(km + 10 + hd * 2, __ATOMIC_RELAXED, __HIP_MEMORY_SCOPE_AGENT))), qm1 = sqrtf(__uint_as_float(__hip_atomic_load(km + 10 + hd * 2 + 1, __ATOMIC_RELAXED, __HIP_MEMORY_SCOPE_AGENT)));
    if (false && qm0 * km0 <= 100.f && qm1 * km1 <= 100.f)
        attn_item_diff2(F, WSP(bf16_t, WS_QD) + (size_t)hd * NT * 64, WSP(bf16_t, WS_KD) + (size_t)hd * NT * 64, WSP(bf16_t, WS_VTD) + (size_t)hd * 64 * NT, isctx ? 0 : CTX + qb * 256, isctx ? CTX : NT, ao);
    else
    attn_item<true, DIFF_KT>(F, WSP(bf16_t, WS_QD) + (size_t)hd * NT * 64, WSP(bf16_t, WS_KD) + (size_t)hd * NT * 64, WSP(bf16_t, WS_VTD) + (size_t)hd * 64 * NT,
                    WSP(float, WS_QND) + (size_t)(hd * 2) * NT, WSP(float, WS_QND) + (size_t)(hd * 2 + 1) * NT, km0, km1, isctx ? 0 : CTX + qb * 256, isctx ? CTX : NT, ao);
}
#ifndef GQA_KT_V
#define GQA_KT_V 64
#endif
constexpr int GQA_KT = GQA_KT_V;
DI bool gqa_fast_ok(const Frame& F, int l) {
    const unsigned* km = WSP(unsigned, WS_CTL) + CW_KMAX + l * 32; bool ok = true;
    for (int hq = 0; hq < 4; ++hq) { const float k = sqrtf(__uint_as_float(__hip_atomic_load(km + 8 + (hq >> 1), __ATOMIC_RELAXED, __HIP_MEMORY_SCOPE_AGENT))), q = sqrtf(__uint_as_float(__hip_atomic_load(km + 18 + hq, __ATOMIC_RELAXED, __HIP_MEMORY_SCOPE_AGENT)));
        ok = ok && (q * k <= 100.f); }
    return ok;
}
template <bool FAST>
DI void p4_attn_gqa(const Frame& F, int l, int it) {
    const bool isctx = it >= 256; const int hq = isctx ? it - 256 : it & 3, qb = isctx ? 0 : it >> 2, g = hq >> 1;
    AttnOut ao; ao.mix = WSP(bf16_t, WS_MIX); ao.col0 = 768 + hq * 64; ao.lam = 0.f; ao.outscale = 1.f; ao.subw = nullptr;
    if (FAST) attn_item_gqa4(F, WSP(bf16_t, WS_QG) + (size_t)hq * NT * 64, WSP(bf16_t, WS_KG) + (size_t)g * NT * 64, WSP(bf16_t, WS_VTG) + (size_t)g * 64 * NT, isctx ? 0 : CTX + qb * 256, isctx ? CTX : NT, ao);
    else { const unsigned* km = WSP(unsigned, WS_CTL) + CW_KMAX + l * 32;
        const float km0 = sqrtf(__uint_as_float(__hip_atomic_load(km + 8 + g, __ATOMIC_RELAXED, __HIP_MEMORY_SCOPE_AGENT)));
        attn_item<false, GQA_KT>(F, WSP(bf16_t, WS_QG) + (size_t)hq * NT * 64, WSP(bf16_t, WS_KG) + (size_t)g * NT * 64, WSP(bf16_t, WS_VTG) + (size_t)g * 64 * NT,
                         WSP(float, WS_QNG) + (size_t)hq * NT, nullptr, km0, 0.f, isctx ? 0 : CTX + qb * 256, isctx ? CTX : NT, ao, isctx ? -1 : l); }
}

DI void p4_ssd_out(const Frame& F, int l, int item) {
    const int c = item >> 1, lh = item & 1;
    LAS float* DTL = (LAS float*)(F.lds + 96 * 1024);
    LAS float* CML = DTL + 8 * 128;
    const int tid = F.tid, lane = F.lane, r = lane & 31, h = lane >> 5, tok0 = c * 128;
    __syncthreads();
    for (int i = tid; i < 1024; i += 512) { DTL[i] = WSP(float, WS_DTV)[(size_t)c * 1024 + i]; CML[i] = WSP(float, WS_CUM)[(size_t)c * 1024 + i]; }
    __syncthreads();
    const int hh = F.wave >> 1, g = hh >> 1;
    const float Dh = ((const float*)F.in[I_SSDD])[(size_t)l * 4 + hh];
    const bf16_t* CN = WSP(bf16_t, WS_CN); const bf16_t* BN = WSP(bf16_t, WS_BN);
    const bf16_t* XS = WSP(bf16_t, WS_XST) + ((size_t)c * 256 + hh * 64) * 128;
    { const int lt = F.wave & 1;
        const int ll = 64 * lh + 32 * lt + r;
        bf16x8 cfr[8];
#pragma unroll
        for (int ks = 0; ks < 8; ++ks) cfr[ks] = ld8g(CN + (size_t)(tok0 + ll) * 256 + g * 128 + ks * 16 + 8 * h);
        const bf16_t* zr0 = WSP(bf16_t, WS_U) + (size_t)(tok0 + ll) * NU + U_Z + hh * 64;
        u32x2 zzv[2][4];
#pragma unroll
        for (int pt = 0; pt < 2; ++pt)
#pragma unroll
            for (int gq = 0; gq < 4; ++gq) zzv[pt][gq] = *(const u32x2*)(zr0 + pt * 32 + 8 * gq + 4 * h);
        const bf16_t* bnp = BN + (size_t)(tok0 + kperm(r)) * 256 + g * 128 + 8 * h;
        const bf16_t* xsp = XS + (size_t)r * 128 + 8 * h;
        bf16x8 bn[8], xs[4], bnn[8], xsn[4], sf0[2][8];
#pragma unroll
        for (int ks = 0; ks < 8; ++ks) bn[ks] = ld8g(bnp + ks * 16);
#pragma unroll
        for (int q = 0; q < 4; ++q) xs[q] = ld8g(xsp + (size_t)(q >> 1) * 32 * 128 + 16 * (q & 1));
        const float cfl = CML[hh * 128 + ll], cbl = CML[(4 + hh) * 128 + ll], dsum = DTL[hh * 128 + ll] + DTL[(4 + hh) * 128 + ll];
        f32x16 Y[2];
        Y[0] = splat16(0.f); Y[1] = splat16(0.f);
        const bf16_t* S0 = WSP(bf16_t, WS_SIN) + ((size_t)c * 8 + hh) * 8192 + (size_t)r * 128 + 8 * h;
#pragma unroll
        for (int st = 0; st < 4; ++st) {
            if (st < 3) {
#pragma unroll
                for (int ks = 0; ks < 8; ++ks) bnn[ks] = ld8g(bnp + (size_t)(st + 1) * 32 * 256 + ks * 16);
#pragma unroll
                for (int q = 0; q < 4; ++q) xsn[q] = ld8g(xsp + (size_t)(q >> 1) * 32 * 128 + 32 * (st + 1) + 16 * (q & 1));
            } else {
#pragma unroll
                for (int pt = 0; pt < 2; ++pt)
#pragma unroll
                    for (int ks = 0; ks < 8; ++ks) sf0[pt][ks] = ld8g(S0 + (size_t)pt * 32 * 128 + ks * 16);
            }
            f32x16 G = splat16(0.f);
#pragma unroll
            for (int ks = 0; ks < 8; ++ks) G = mfma32(bn[ks], cfr[ks], G);
#pragma unroll
            for (int i = 0; i < 16; ++i) { const int s = 32 * st + kperm(crow(i, h));
                const float cfs = CML[hh * 128 + s], cbs = CML[(4 + hh) * 128 + s], dfs = DTL[hh * 128 + s], dbs = DTL[(4 + hh) * 128 + s];
                float fac;
                if (s < ll) fac = dfs * __builtin_amdgcn_exp2f(cfl - cfs);
                else if (s > ll) fac = dbs * __builtin_amdgcn_exp2f(cbl - cbs);
                else fac = dsum;
                G[i] = G[i] * fac + (s == ll ? Dh : 0.f); }
            const bf16x8 m0 = pack_step<0>(G), m1 = pack_step<1>(G);
#pragma unroll
            for (int pt = 0; pt < 2; ++pt) { Y[pt] = mfma32(xs[pt * 2], m0, Y[pt]); Y[pt] = mfma32(xs[pt * 2 + 1], m1, Y[pt]); }
            if (st < 3) {
#pragma unroll
                for (int ks = 0; ks < 8; ++ks) bn[ks] = bnn[ks];
#pragma unroll
                for (int q = 0; q < 4; ++q) xs[q] = xsn[q]; }
        }
        { bf16x8 sf1[2][8];
#pragma unroll
          for (int pt = 0; pt < 2; ++pt)
#pragma unroll
              for (int ks = 0; ks < 8; ++ks) sf1[pt][ks] = ld8g(S0 + (size_t)4 * 8192 + (size_t)pt * 32 * 128 + ks * 16);
          const float e0 = __builtin_amdgcn_exp2f(cfl), e1 = __builtin_amdgcn_exp2f(cbl);
#pragma unroll
          for (int pt = 0; pt < 2; ++pt) { f32x16 Z = splat16(0.f);
#pragma unroll
              for (int ks = 0; ks < 8; ++ks) Z = mfma32(sf0[pt][ks], cfr[ks], Z);
              Y[pt] += Z * e0; }
#pragma unroll
          for (int pt = 0; pt < 2; ++pt) { f32x16 Z = splat16(0.f);
#pragma unroll
              for (int ks = 0; ks < 8; ++ks) Z = mfma32(sf1[pt][ks], cfr[ks], Z);
              Y[pt] += Z * e1; } }
        const int tok = tok0 + ll; float ssq = 0.f;
        bf16_t* yo = WSP(bf16_t, WS_YSSD) + (size_t)tok * 256 + hh * 64;
#pragma unroll
        for (int pt = 0; pt < 2; ++pt)
#pragma unroll
            for (int gq = 0; gq < 4; ++gq) { const int p = pt * 32 + 8 * gq + 4 * h; const u32x2 zz = zzv[pt][gq];
                const float z0 = bflo(zz[0]), z1 = bfhi(zz[0]), z2 = bflo(zz[1]), z3 = bfhi(zz[1]);
                const float y0 = Y[pt][4 * gq] * silu_f(z0), y1 = Y[pt][4 * gq + 1] * silu_f(z1), y2 = Y[pt][4 * gq + 2] * silu_f(z2), y3 = Y[pt][4 * gq + 3] * silu_f(z3);
                ssq += y0 * y0 + y1 * y1 + y2 * y2 + y3 * y3;
                u32x2 w; w[0] = pk2(y0, y1); w[1] = pk2(y2, y3); *(u32x2*)(yo + p) = w; }
        ssq += __shfl_xor(ssq, 32);
        if (h == 0) WSP(float, WS_SSQ)[(size_t)tok * 4 + hh] = ssq;
    }
}

constexpr int N_S5O = 16 * 9 * 2;
DI float gelu_tanh(float y) { const float u = 0.7978845608028654f * (y + 0.044715f * y * y * y); const float e = __builtin_amdgcn_exp2f(2.8853900817779268f * u); return y * (1.f - __builtin_amdgcn_rcpf(1.f + e)); }
constexpr int HBP = 264;
DI void p4_s5_out(const Frame& F, int l, int item) {
    const int mh = item & 1, nt = (item >> 1) % 9, g = (item >> 1) / 9, lane = F.lane, r = lane & 31, h = lane >> 5;
    s5_stage_u<false>(F, g, nt);
    LAS bf16_t* HB = (LAS bf16_t*)F.lds + 32 * UBP;
    LAS bf16_t* KTL = (LAS bf16_t*)(F.lds + 84 * 1024);
    { const bf16_t* ktg = WSP(bf16_t, WS_KTAB) + ((size_t)l * 16 + g) * 3 * 64 * 256;
      for (int i = F.tid; i < (2 * 64 * 256 + 256) / 8; i += 512) *(LAS u32x4*)(KTL + 8 * i) = *(const u32x4*)(ktg + 8 * i); }
    for (int i = F.tid; i < 32 * 32; i += 512) { const int n = i >> 5, p = i & 31; const int chunk = nt * 32 + n, cc = chunk < NC5 ? chunk : NC5 - 1;
        *(LAS u32x4*)(HB + n * HBP + 8 * p) = *(const u32x4*)(WSP(bf16_t, WS_HIN) + (size_t)cc * 4096 + g * 256 + 8 * p); }
    __syncthreads();
    const LAS bf16_t* UB = (const LAS bf16_t*)F.lds + r * UBP + 8 * h; const LAS bf16_t* HBr = HB + r * HBP + 8 * h;
    const int chunk = nt * 32 + r;
#pragma unroll 1
    for (int mi = 0; mi < 2; ++mi) {
        const int mt = mh * 16 + F.wave * 2 + mi, row = mt * 32 + r, t = row >> 4, ch = row & 15;
        const LAS bf16_t* KT = KTL + ch * 16 + 8 * h;
        const bf16_t* CC = WSP(bf16_t, WS_CC5) + ((size_t)l * 16 + g) * 1024 * 256 + ((size_t)mt * 16 * 64 + lane) * 8;
        bf16x8 ccf[16];
#pragma unroll
        for (int kc = 0; kc < 16; ++kc) ccf[kc] = ld8g(CC + kc * 512);
        f32x16 acc = splat16(0.f);
#pragma unroll 16
        for (int s = 0; s < 64; ++s) { const int sel = s < t ? 0 : (s > t ? 1 : 2), lag = s < t ? t - s : (s > t ? s - t : 0);
            acc = mfma32(*(const LAS bf16x8*)(KT + (sel * 64 + lag) * 256), *(const LAS bf16x8*)(UB + s * 16), acc); }
#pragma unroll
        for (int kc = 0; kc < 16; ++kc) acc = mfma32(ccf[kc], *(const LAS bf16x8*)(HBr + kc * 16), acc);
        if (chunk < NC5) {
#pragma unroll
            for (int gq = 0; gq < 4; ++gq) { const int rr = mt * 32 + 8 * gq + 4 * h, tt = rr >> 4, c0 = rr & 15;
                u32x2 w; w[0] = pk2(gelu_tanh(acc[4 * gq]), gelu_tanh(acc[4 * gq + 1])); w[1] = pk2(gelu_tanh(acc[4 * gq + 2]), gelu_tanh(acc[4 * gq + 3]));
                *(u32x2*)(WSP(bf16_t, WS_YS5) + (size_t)(chunk * S5L + tt) * 256 + g * 16 + c0) = w; } }
    }
}

DI void p5_finish(const Frame& F, int l) {
    const int lane = F.lane;
    { const f32x4 nw = *(const f32x4*)(((const float*)F.in[I_SSDNW]) + (size_t)l * 256 + 4 * lane);
      f32x4 q[9]; u32x2 y[9];
#pragma unroll
      for (int k = 0; k < 9; ++k) { const int r = F.wave + 8 * k, row = F.bid * RPB + (r < RPB ? r : RPB - 1), rc = row < NT ? row : NT - 1;
          q[k] = *(const f32x4*)(WSP(float, WS_SSQ) + (size_t)rc * 4); y[k] = *(const u32x2*)(WSP(bf16_t, WS_YSSD) + (size_t)rc * 256 + 4 * lane); }
#pragma unroll
      for (int k = 0; k < 9; ++k) { const int r = F.wave + 8 * k, row = F.bid * RPB + r;
          if (r < RPB && row < NT) { const float rs = __builtin_amdgcn_rsqf((q[k][0] + q[k][1] + q[k][2] + q[k][3]) * (1.f / 256.f) + EPS);
              u32x2 w; w[0] = pk2(bflo(y[k][0]) * rs * nw[0], bfhi(y[k][0]) * rs * nw[1]); w[1] = pk2(bflo(y[k][1]) * rs * nw[2], bfhi(y[k][1]) * rs * nw[3]);
              *(u32x2*)(WSP(bf16_t, WS_MIX) + (size_t)row * DM + 256 + 4 * lane) = w; } } }
    const int r = lane & 31, h = lane >> 5, nt = F.wave;
    const bf16_t* WG = WSP(bf16_t, WS_WGLU) + (size_t)l * 65536;
    bf16x8 wf[16];
#pragma unroll
    for (int ks = 0; ks < 16; ++ks) wf[ks] = ld8g(WG + (size_t)(nt * 32 + r) * 256 + ks * 16 + 8 * h);
    f32x4 bb[4];
#pragma unroll
    for (int gq = 0; gq < 4; ++gq) bb[gq] = *(const f32x4*)(((const float*)F.in[I_BGLU]) + (size_t)l * 256 + nt * 32 + 8 * gq + 4 * h);
    for (int mt = F.bid; mt < NT / 32; mt += F.G) {
        const bf16_t* Y = WSP(bf16_t, WS_YS5) + (size_t)(mt * 32) * 256;
        bf16x8 af[16]; u32x2 yy[4];
#pragma unroll
        for (int ks = 0; ks < 16; ++ks) af[ks] = ld8g(Y + (size_t)r * 256 + ks * 16 + 8 * h);
#pragma unroll
        for (int gq = 0; gq < 4; ++gq) yy[gq] = *(const u32x2*)(Y + (size_t)r * 256 + nt * 32 + 8 * gq + 4 * h);
        const int tok = mt * 32 + r;
        f32x16 acc = splat16(0.f);
#pragma unroll
        for (int ks = 0; ks < 16; ++ks) acc = mfma32(wf[ks], af[ks], acc);
#pragma unroll
        for (int gq = 0; gq < 4; ++gq) { const int n0 = nt * 32 + 8 * gq + 4 * h;
            u32x2 w; w[0] = pk2(bflo(yy[gq][0]) * sigmoid_f(acc[4 * gq] + bb[gq][0]), bfhi(yy[gq][0]) * sigmoid_f(acc[4 * gq + 1] + bb[gq][1]));
            w[1] = pk2(bflo(yy[gq][1]) * sigmoid_f(acc[4 * gq + 2] + bb[gq][2]), bfhi(yy[gq][1]) * sigmoid_f(acc[4 * gq + 3] + bb[gq][3]));
            *(u32x2*)(WSP(bf16_t, WS_MIX) + (size_t)tok * DM + 512 + n0) = w; }
    }
    __syncthreads();
}

#ifndef PH_MASK
#define PH_MASK 0xFFFF
#endif
#define PHEN(k) ((PH_MASK >> (k)) & 1)
#ifndef PH_REP
#define PH_REP 0
#endif
#define NREP(k) (((PH_REP >> (k)) & 1) ? 2 : 1)
#ifndef STAG_GU
#define STAG_GU 0
#endif
#ifndef STAG_DN
#define STAG_DN 0
#endif
#ifndef REP_SKIP_STORES
#define REP_SKIP_STORES 0
#endif
DI Frame launder(const Frame& F) { Frame G = F; int t = F.wave * 64 + (int)__builtin_amdgcn_mbcnt_hi(~0u, __builtin_amdgcn_mbcnt_lo(~0u, 0u)); GAS unsigned char* w = F.ws; const GAS float* const __attribute__((address_space(4)))* ip = F.in;
    int bb = F.bid, gg = F.G; LAS unsigned char* lp = F.lds; asm volatile("" : "+s"(lp)); G.lds = lp; asm volatile("" : "+v"(t)); asm volatile("" : "+s"(w)); asm volatile("" : "+s"(ip)); asm volatile("" : "+s"(bb)); asm volatile("" : "+s"(gg)); G.bid = bb; G.G = gg; G.tid = t; G.lane = t & 63; G.ws = w; G.in = ip; return G; }
DI int launder_s(int v) { asm volatile("" : "+s"(v)); return v; }
constexpr int NPL = 10, N_PHASES = 1 + DEPTH * NPL + 1;
__global__ void __launch_bounds__(512, 2) hybrid_fwd(Args args) {
    extern __shared__ __attribute__((aligned(16))) unsigned char lds_raw[];
    Frame F; F.lds = (LAS unsigned char*)lds_raw; F.in = (const GAS float* const __attribute__((address_space(4)))*)__builtin_amdgcn_kernarg_segment_ptr(); F.ws = (GAS unsigned char*)args.ws; F.out = args.out;
    F.tid = threadIdx.x; F.lane = F.tid & 63; F.wave = __builtin_amdgcn_readfirstlane(F.tid >> 6); F.G = gridDim.x; F.bid = blockIdx.x;
    const int lo = args.ph_lo, hi = args.ph_hi;
    volatile LAS unsigned* xbw = (volatile LAS unsigned*)(F.lds + LDS_BYTES - 64);
    if (F.tid == 0) { xbw[0] = 0u; xbw[1] = 0u; }
    __syncthreads();
    XcdBarrier bar; bar.bar = WSP(unsigned, WS_CTL) + CW_BAR; bar.x = 0; bar.st = xbw;
    if (hi - lo > 1) bar = xcd_barrier_post(WSP(unsigned, WS_CTL) + CW_BAR, xbw);
#define IN(k) (lo <= (k) && (k) < hi)
#ifndef DIAG
#define DIAG 0
#endif
#if DIAG
    volatile LAS unsigned* dg = (volatile LAS unsigned*)(F.lds + LDS_BYTES - 192);
    if (F.tid < 16) dg[F.tid] = 0u;
    unsigned long long t_prev = __builtin_amdgcn_s_memrealtime();
#define DIAG_ACC(kind) do { if (blockIdx.x == 0 && threadIdx.x == 0) { const unsigned long long t_now = __builtin_amdgcn_s_memrealtime(); dg[kind] += (unsigned)(t_now - t_prev); t_prev = t_now; } } while (0)
#else
#define DIAG_ACC(kind) do { } while (0)
#endif
#define SEAM(k) do { if (IN(k) && IN((k) + 1)) xcd_barrier(bar); } while (0)
#define WSQ(T, off) ((T*)(Fq.ws + (off)))
#define LAUNDERED for (int rep_ = 0; rep_ < nrep_; ++rep_) for (Frame Fq = launder(F), *once_ = &Fq; once_; once_ = nullptr) for (int lq = launder_s(l_cur), once2_ = 1; once2_; once2_ = 0)
    int ph = 0, l_cur = 0, nrep_ = 1;
    nrep_ = NREP(0); if (PHEN(0) && IN(ph)) LAUNDERED { (void)lq; p0_prologue(Fq, rep_); }
    SEAM(ph); ++ph; DIAG_ACC(0);
    { l_cur = 0;
        nrep_ = NREP(1); if (PHEN(1) && IN(ph)) LAUNDERED p1_norm<false>(Fq, lq);
        SEAM(ph); ++ph; DIAG_ACC(1);
        nrep_ = NREP(2); if (PHEN(2) && IN(ph)) LAUNDERED { pg8::Gemm gm{WSQ(pg8::bf16_t, WS_H), WSQ(pg8::bf16_t, WS_WIN) + (size_t)lq * NU * DM, NT, NU, DM}; pg8::StaticOrder S; S.init(NT, NU, Fq.G, Fq.bid);
            EpiU E{WSQ(bf16_t, WS_U), NU, WSQ(bf16_t, WS_US5)}; pg8::gemm_phase<EpiU, pg8::StaticOrder>((PG8_LAS unsigned char*)Fq.lds, gm, S, E); }
        SEAM(ph); ++ph; DIAG_ACC(2);
        nrep_ = NREP(3); if (PHEN(3) && IN(ph)) LAUNDERED {
            unsigned* qctr = WSQ(unsigned, WS_CTL) + CW_Q0 + 64 * (2 + 2 * lq + rep_ * 8);
            for (;;) { const int idx = q_next(Fq, qctr); if (idx >= NCH + 260 + N_S5H) break; const Frame Fi = launder(Fq);
                if (idx < NCH) { for (int q_ = 0; q_ < NREP(21); ++q_) p3_ssd_prep(Fi, lq, idx); }
                else if (idx < NCH + 260) { for (int q_ = 0; q_ < NREP(22); ++q_) p3_attn_prep(Fi, lq, idx - NCH); }
                else { for (int q_ = 0; q_ < NREP(23); ++q_) p3_s5_hloc(Fi, lq, idx - NCH - 260); }
            }
        }
        SEAM(ph); ++ph; DIAG_ACC(3);
        nrep_ = NREP(4); if (PHEN(4) && IN(ph)) LAUNDERED { for (int q_ = 0; q_ < NREP(16); ++q_) p4_ssd_scan(Fq, lq);
            for (int q_ = 0; q_ < NREP(17); ++q_) for (int it = Fq.bid; it < 256; it += Fq.G) { const Frame Fi = launder(Fq); p4_attn_diff(Fi, lq, it); }
            unsigned* qctr = WSQ(unsigned, WS_CTL) + CW_Q0 + 64 * (10 + lq + rep_ * 8);
            for (;;) { const int idx = q_next(Fq, qctr); if (idx >= 4) break; const Frame Fi = launder(Fq);
                p4_attn_diff(Fi, lq, 256 + idx); } }
        SEAM(ph); ++ph; DIAG_ACC(4);
        nrep_ = NREP(5); if (PHEN(5) && IN(ph)) LAUNDERED {
            if (false && gqa_fast_ok(Fq, lq)) { for (int q_ = 0; q_ < NREP(18); ++q_) for (int it = Fq.bid; it < 256; it += Fq.G) { const Frame Fi = launder(Fq); p4_attn_gqa<true>(Fi, lq, it); } }
            else { for (int q_ = 0; q_ < NREP(18); ++q_) for (int it = Fq.bid; it < 256; it += Fq.G) { const Frame Fi = launder(Fq); p4_attn_gqa<false>(Fi, lq, it); } }
            { unsigned* qctr = WSQ(unsigned, WS_CTL) + CW_Q0 + 64 * (3 + 2 * lq + rep_ * 8);
              for (;;) { const int idx = q_next(Fq, qctr); if (idx >= 2 * NCH + N_S5O + 4) break; const Frame Fi = launder(Fq);
                  if (idx < 2 * NCH) p4_ssd_out(Fi, lq, idx); else if (idx < 2 * NCH + N_S5O) p4_s5_out(Fi, lq, idx - 2 * NCH); else p4_attn_gqa<false>(Fi, lq, 256 + idx - 2 * NCH - N_S5O); } }
        }
        SEAM(ph); ++ph; DIAG_ACC(5);
        nrep_ = NREP(6); if (PHEN(6) && IN(ph)) LAUNDERED p5_finish(Fq, lq);
        SEAM(ph); ++ph; DIAG_ACC(6);
        nrep_ = NREP(7); if (PHEN(7) && IN(ph)) LAUNDERED { pg8::Gemm gm{WSQ(pg8::bf16_t, WS_MIX) + (size_t)CTX * DM, WSQ(pg8::bf16_t, WS_WOUT) + (size_t)lq * DM * DM, SEQ, DM, DM}; pg8::StaticOrder S; S.init(SEQ, DM, Fq.G, Fq.bid);
            EpiRes E; E.C = WSQ(float, WS_XA); E.g1 = WSQ(float, WS_MOD) + (size_t)lq * 2 * 6144 + 2 * 1024;
            if (lq == 0) { E.res_ctx = ((const float*)Fq.in[I_CTX]); E.res_lat = ((const float*)Fq.in[I_X]); } else { E.res_ctx = WSQ(float, WS_XB); E.res_lat = WSQ(float, WS_XB) + (size_t)CTX * DM; }
            pg8::gemm_phase<EpiRes, pg8::StaticOrder>((PG8_LAS unsigned char*)Fq.lds, gm, S, E);
            if (lq < DEPTH - 1) outproj_ctx(Fq, lq, E.res_ctx); }
        SEAM(ph); ++ph; DIAG_ACC(7);
        nrep_ = NREP(8); if (PHEN(8) && IN(ph)) LAUNDERED p7a_router(Fq, lq, rep_);
        SEAM(ph); ++ph; DIAG_ACC(8);
        nrep_ = NREP(10); if (PHEN(10) && IN(ph)) LAUNDERED { const int ntiles = moe_tables(Fq, lq); const LAS int* t2e = (const LAS int*)(Fq.lds + LDS_MISC) + 64;
            moe_rows(Fq, lq, ntiles, 8);
            pg8::Gemm gm{WSQ(pg8::bf16_t, WS_H), WSQ(pg8::bf16_t, WS_WGU) + (size_t)lq * NEXP * 2048 * DM, CAP, 2048, DM};
            MoeOrder S{8, ntiles, Fq.G, Fq.bid, t2e, (long)2048 * DM * 2};
            moe_bias(Fq, ntiles, 8, ((const float*)Fq.in[I_BGU]) + (size_t)lq * NEXP * 2048, 2048);
            EpiAct E{WSQ(bf16_t, WS_ACT), (const LAS float*)(Fq.lds + LDS_BIASL)};
            if (STAG_GU) xcd_stagger(Fq, STAG_GU);
            pg8::gemm_phase_gather<EpiAct, MoeOrder>((PG8_LAS unsigned char*)Fq.lds, gm, S, E, (const PG8_LAS int*)(Fq.lds + LDS_MISC + 2048)); }
        SEAM(ph); ++ph; DIAG_ACC(10);
        nrep_ = NREP(11); if (PHEN(11) && IN(ph)) LAUNDERED { const int ntiles = moe_tables(Fq, lq); const LAS int* t2e = (const LAS int*)(Fq.lds + LDS_MISC) + 64;
            pg8::Gemm gm{WSQ(pg8::bf16_t, WS_ACT), WSQ(pg8::bf16_t, WS_WDN) + (size_t)lq * NEXP * DM * DM, CAP, DM, DM};
            MoeOrder S{4, ntiles, Fq.G, Fq.bid, t2e, (long)DM * DM * 2};
            moe_bias(Fq, ntiles, 4, ((const float*)Fq.in[I_BDN]) + (size_t)lq * NEXP * DM, DM);
            EpiDown E{WSQ(bf16_t, WS_YB), (const LAS float*)(Fq.lds + LDS_BIASL), REP_SKIP_STORES * rep_, WSQ(bf16_t, WS_U)};
            if (STAG_DN) xcd_stagger(Fq, STAG_DN);
            pg8::gemm_phase<EpiDown, MoeOrder>((PG8_LAS unsigned char*)Fq.lds, gm, S, E); }
        SEAM(ph); ++ph; DIAG_ACC(11);
    }
    { l_cur = 1;
        nrep_ = NREP(1); if (PHEN(1) && IN(ph)) LAUNDERED p1_norm<false>(Fq, lq);
        SEAM(ph); ++ph; DIAG_ACC(1);
        nrep_ = NREP(2); if (PHEN(2) && IN(ph)) LAUNDERED { pg8::Gemm gm{WSQ(pg8::bf16_t, WS_H), WSQ(pg8::bf16_t, WS_WIN) + (size_t)lq * NU * DM, NT, NU, DM}; pg8::StaticOrder S; S.init(NT, NU, Fq.G, Fq.bid);
            EpiU E{WSQ(bf16_t, WS_U), NU, WSQ(bf16_t, WS_US5)}; pg8::gemm_phase<EpiU, pg8::StaticOrder>((PG8_LAS unsigned char*)Fq.lds, gm, S, E); }
        SEAM(ph); ++ph; DIAG_ACC(2);
        nrep_ = NREP(3); if (PHEN(3) && IN(ph)) LAUNDERED {
            unsigned* qctr = WSQ(unsigned, WS_CTL) + CW_Q0 + 64 * (2 + 2 * lq + rep_ * 8);
            for (;;) { const int idx = q_next(Fq, qctr); if (idx >= NCH + 260 + N_S5H) break; const Frame Fi = launder(Fq);
                if (idx < NCH) { for (int q_ = 0; q_ < NREP(21); ++q_) p3_ssd_prep(Fi, lq, idx); }
                else if (idx < NCH + 260) { for (int q_ = 0; q_ < NREP(22); ++q_) p3_attn_prep(Fi, lq, idx - NCH); }
                else { for (int q_ = 0; q_ < NREP(23); ++q_) p3_s5_hloc(Fi, lq, idx - NCH - 260); }
            }
        }
        SEAM(ph); ++ph; DIAG_ACC(3);
        nrep_ = NREP(4); if (PHEN(4) && IN(ph)) LAUNDERED { for (int q_ = 0; q_ < NREP(16); ++q_) p4_ssd_scan(Fq, lq);
            for (int q_ = 0; q_ < NREP(17); ++q_) for (int it = Fq.bid; it < 256; it += Fq.G) { const Frame Fi = launder(Fq); p4_attn_diff(Fi, lq, it); }
            unsigned* qctr = WSQ(unsigned, WS_CTL) + CW_Q0 + 64 * (10 + lq + rep_ * 8);
            for (;;) { const int idx = q_next(Fq, qctr); if (idx >= 4) break; const Frame Fi = launder(Fq);
                p4_attn_diff(Fi, lq, 256 + idx); } }
        SEAM(ph); ++ph; DIAG_ACC(4);
        nrep_ = NREP(5); if (PHEN(5) && IN(ph)) LAUNDERED {
            if (false && gqa_fast_ok(Fq, lq)) { for (int q_ = 0; q_ < NREP(18); ++q_) for (int it = Fq.bid; it < 256; it += Fq.G) { const Frame Fi = launder(Fq); p4_attn_gqa<true>(Fi, lq, it); } }
            else { for (int q_ = 0; q_ < NREP(18); ++q_) for (int it = Fq.bid; it < 256; it += Fq.G) { const Frame Fi = launder(Fq); p4_attn_gqa<false>(Fi, lq, it); } }
            { unsigned* qctr = WSQ(unsigned, WS_CTL) + CW_Q0 + 64 * (3 + 2 * lq + rep_ * 8);
              for (;;) { const int idx = q_next(Fq, qctr); if (idx >= 2 * NCH + N_S5O + 4) break; const Frame Fi = launder(Fq);
                  if (idx < 2 * NCH) p4_ssd_out(Fi, lq, idx); else if (idx < 2 * NCH + N_S5O) p4_s5_out(Fi, lq, idx - 2 * NCH); else p4_attn_gqa<false>(Fi, lq, 256 + idx - 2 * NCH - N_S5O); } }
        }
        SEAM(ph); ++ph; DIAG_ACC(5);
        nrep_ = NREP(6); if (PHEN(6) && IN(ph)) LAUNDERED p5_finish(Fq, lq);
        SEAM(ph); ++ph; DIAG_ACC(6);
        nrep_ = NREP(7); if (PHEN(7) && IN(ph)) LAUNDERED { pg8::Gemm gm{WSQ(pg8::bf16_t, WS_MIX) + (size_t)CTX * DM, WSQ(pg8::bf16_t, WS_WOUT) + (size_t)lq * DM * DM, SEQ, DM, DM}; pg8::StaticOrder S; S.init(SEQ, DM, Fq.G, Fq.bid);
            EpiRes E; E.C = WSQ(float, WS_XA); E.g1 = WSQ(float, WS_MOD) + (size_t)lq * 2 * 6144 + 2 * 1024;
            if (lq == 0) { E.res_ctx = ((const float*)Fq.in[I_CTX]); E.res_lat = ((const float*)Fq.in[I_X]); } else { E.res_ctx = WSQ(float, WS_XB); E.res_lat = WSQ(float, WS_XB) + (size_t)CTX * DM; }
            pg8::gemm_phase<EpiRes, pg8::StaticOrder>((PG8_LAS unsigned char*)Fq.lds, gm, S, E);
            if (lq < DEPTH - 1) outproj_ctx(Fq, lq, E.res_ctx); }
        SEAM(ph); ++ph; DIAG_ACC(7);
        nrep_ = NREP(8); if (PHEN(8) && IN(ph)) LAUNDERED p7a_router(Fq, lq, rep_);
        SEAM(ph); ++ph; DIAG_ACC(8);
        nrep_ = NREP(10); if (PHEN(10) && IN(ph)) LAUNDERED { const int ntiles = moe_tables(Fq, lq); const LAS int* t2e = (const LAS int*)(Fq.lds + LDS_MISC) + 64;
            moe_rows(Fq, lq, ntiles, 8);
            pg8::Gemm gm{WSQ(pg8::bf16_t, WS_H), WSQ(pg8::bf16_t, WS_WGU) + (size_t)lq * NEXP * 2048 * DM, CAP, 2048, DM};
            MoeOrder S{8, ntiles, Fq.G, Fq.bid, t2e, (long)2048 * DM * 2};
            moe_bias(Fq, ntiles, 8, ((const float*)Fq.in[I_BGU]) + (size_t)lq * NEXP * 2048, 2048);
            EpiAct E{WSQ(bf16_t, WS_ACT), (const LAS float*)(Fq.lds + LDS_BIASL)};
            if (STAG_GU) xcd_stagger(Fq, STAG_GU);
            pg8::gemm_phase_gather<EpiAct, MoeOrder>((PG8_LAS unsigned char*)Fq.lds, gm, S, E, (const PG8_LAS int*)(Fq.lds + LDS_MISC + 2048)); }
        SEAM(ph); ++ph; DIAG_ACC(10);
        nrep_ = NREP(11); if (PHEN(11) && IN(ph)) LAUNDERED { const int ntiles = moe_tables(Fq, lq); const LAS int* t2e = (const LAS int*)(Fq.lds + LDS_MISC) + 64;
            pg8::Gemm gm{WSQ(pg8::bf16_t, WS_ACT), WSQ(pg8::bf16_t, WS_WDN) + (size_t)lq * NEXP * DM * DM, CAP, DM, DM};
            MoeOrder S{4, ntiles, Fq.G, Fq.bid, t2e, (long)DM * DM * 2};
            moe_bias(Fq, ntiles, 4, ((const float*)Fq.in[I_BDN]) + (size_t)lq * NEXP * DM, DM);
            EpiDown E{WSQ(bf16_t, WS_YB), (const LAS float*)(Fq.lds + LDS_BIASL), REP_SKIP_STORES * rep_, WSQ(bf16_t, WS_U)};
            if (STAG_DN) xcd_stagger(Fq, STAG_DN);
            pg8::gemm_phase<EpiDown, MoeOrder>((PG8_LAS unsigned char*)Fq.lds, gm, S, E); }
        SEAM(ph); ++ph; DIAG_ACC(11);
    }
    { l_cur = 2;
        nrep_ = NREP(1); if (PHEN(1) && IN(ph)) LAUNDERED p1_norm<false>(Fq, lq);
        SEAM(ph); ++ph; DIAG_ACC(1);
        nrep_ = NREP(2); if (PHEN(2) && IN(ph)) LAUNDERED { pg8::Gemm gm{WSQ(pg8::bf16_t, WS_H), WSQ(pg8::bf16_t, WS_WIN) + (size_t)lq * NU * DM, NT, NU, DM}; pg8::StaticOrder S; S.init(NT, NU, Fq.G, Fq.bid);
            EpiU E{WSQ(bf16_t, WS_U), NU, WSQ(bf16_t, WS_US5)}; pg8::gemm_phase<EpiU, pg8::StaticOrder>((PG8_LAS unsigned char*)Fq.lds, gm, S, E); }
        SEAM(ph); ++ph; DIAG_ACC(2);
        nrep_ = NREP(3); if (PHEN(3) && IN(ph)) LAUNDERED {
            unsigned* qctr = WSQ(unsigned, WS_CTL) + CW_Q0 + 64 * (2 + 2 * lq + rep_ * 8);
            for (;;) { const int idx = q_next(Fq, qctr); if (idx >= NCH + 260 + N_S5H) break; const Frame Fi = launder(Fq);
                if (idx < NCH) { for (int q_ = 0; q_ < NREP(21); ++q_) p3_ssd_prep(Fi, lq, idx); }
                else if (idx < NCH + 260) { for (int q_ = 0; q_ < NREP(22); ++q_) p3_attn_prep(Fi, lq, idx - NCH); }
                else { for (int q_ = 0; q_ < NREP(23); ++q_) p3_s5_hloc(Fi, lq, idx - NCH - 260); }
            }
        }
        SEAM(ph); ++ph; DIAG_ACC(3);
        nrep_ = NREP(4); if (PHEN(4) && IN(ph)) LAUNDERED { for (int q_ = 0; q_ < NREP(16); ++q_) p4_ssd_scan(Fq, lq);
            for (int q_ = 0; q_ < NREP(17); ++q_) for (int it = Fq.bid; it < 256; it += Fq.G) { const Frame Fi = launder(Fq); p4_attn_diff(Fi, lq, it); }
            unsigned* qctr = WSQ(unsigned, WS_CTL) + CW_Q0 + 64 * (10 + lq + rep_ * 8);
            for (;;) { const int idx = q_next(Fq, qctr); if (idx >= 4) break; const Frame Fi = launder(Fq);
                p4_attn_diff(Fi, lq, 256 + idx); } }
        SEAM(ph); ++ph; DIAG_ACC(4);
        nrep_ = NREP(5); if (PHEN(5) && IN(ph)) LAUNDERED {
            if (false && gqa_fast_ok(Fq, lq)) { for (int q_ = 0; q_ < NREP(18); ++q_) for (int it = Fq.bid; it < 256; it += Fq.G) { const Frame Fi = launder(Fq); p4_attn_gqa<true>(Fi, lq, it); } }
            else { for (int q_ = 0; q_ < NREP(18); ++q_) for (int it = Fq.bid; it < 256; it += Fq.G) { const Frame Fi = launder(Fq); p4_attn_gqa<false>(Fi, lq, it); } }
            { unsigned* qctr = WSQ(unsigned, WS_CTL) + CW_Q0 + 64 * (3 + 2 * lq + rep_ * 8);
              for (;;) { const int idx = q_next(Fq, qctr); if (idx >= 2 * NCH + N_S5O + 4) break; const Frame Fi = launder(Fq);
                  if (idx < 2 * NCH) p4_ssd_out(Fi, lq, idx); else if (idx < 2 * NCH + N_S5O) p4_s5_out(Fi, lq, idx - 2 * NCH); else p4_attn_gqa<false>(Fi, lq, 256 + idx - 2 * NCH - N_S5O); } }
        }
        SEAM(ph); ++ph; DIAG_ACC(5);
        nrep_ = NREP(6); if (PHEN(6) && IN(ph)) LAUNDERED p5_finish(Fq, lq);
        SEAM(ph); ++ph; DIAG_ACC(6);
        nrep_ = NREP(7); if (PHEN(7) && IN(ph)) LAUNDERED { pg8::Gemm gm{WSQ(pg8::bf16_t, WS_MIX) + (size_t)CTX * DM, WSQ(pg8::bf16_t, WS_WOUT) + (size_t)lq * DM * DM, SEQ, DM, DM}; pg8::StaticOrder S; S.init(SEQ, DM, Fq.G, Fq.bid);
            EpiRes E; E.C = WSQ(float, WS_XA); E.g1 = WSQ(float, WS_MOD) + (size_t)lq * 2 * 6144 + 2 * 1024;
            if (lq == 0) { E.res_ctx = ((const float*)Fq.in[I_CTX]); E.res_lat = ((const float*)Fq.in[I_X]); } else { E.res_ctx = WSQ(float, WS_XB); E.res_lat = WSQ(float, WS_XB) + (size_t)CTX * DM; }
            pg8::gemm_phase<EpiRes, pg8::StaticOrder>((PG8_LAS unsigned char*)Fq.lds, gm, S, E);
            if (lq < DEPTH - 1) outproj_ctx(Fq, lq, E.res_ctx); }
        SEAM(ph); ++ph; DIAG_ACC(7);
        nrep_ = NREP(8); if (PHEN(8) && IN(ph)) LAUNDERED p7a_router(Fq, lq, rep_);
        SEAM(ph); ++ph; DIAG_ACC(8);
        nrep_ = NREP(10); if (PHEN(10) && IN(ph)) LAUNDERED { const int ntiles = moe_tables(Fq, lq); const LAS int* t2e = (const LAS int*)(Fq.lds + LDS_MISC) + 64;
            moe_rows(Fq, lq, ntiles, 8);
            pg8::Gemm gm{WSQ(pg8::bf16_t, WS_H), WSQ(pg8::bf16_t, WS_WGU) + (size_t)lq * NEXP * 2048 * DM, CAP, 2048, DM};
            MoeOrder S{8, ntiles, Fq.G, Fq.bid, t2e, (long)2048 * DM * 2};
            moe_bias(Fq, ntiles, 8, ((const float*)Fq.in[I_BGU]) + (size_t)lq * NEXP * 2048, 2048);
            EpiAct E{WSQ(bf16_t, WS_ACT), (const LAS float*)(Fq.lds + LDS_BIASL)};
            if (STAG_GU) xcd_stagger(Fq, STAG_GU);
            pg8::gemm_phase_gather<EpiAct, MoeOrder>((PG8_LAS unsigned char*)Fq.lds, gm, S, E, (const PG8_LAS int*)(Fq.lds + LDS_MISC + 2048)); }
        SEAM(ph); ++ph; DIAG_ACC(10);
        nrep_ = NREP(11); if (PHEN(11) && IN(ph)) LAUNDERED { const int ntiles = moe_tables(Fq, lq); const LAS int* t2e = (const LAS int*)(Fq.lds + LDS_MISC) + 64;
            pg8::Gemm gm{WSQ(pg8::bf16_t, WS_ACT), WSQ(pg8::bf16_t, WS_WDN) + (size_t)lq * NEXP * DM * DM, CAP, DM, DM};
            MoeOrder S{4, ntiles, Fq.G, Fq.bid, t2e, (long)DM * DM * 2};
            moe_bias(Fq, ntiles, 4, ((const float*)Fq.in[I_BDN]) + (size_t)lq * NEXP * DM, DM);
            EpiDown E{WSQ(bf16_t, WS_YB), (const LAS float*)(Fq.lds + LDS_BIASL), REP_SKIP_STORES * rep_, WSQ(bf16_t, WS_U)};
            if (STAG_DN) xcd_stagger(Fq, STAG_DN);
            pg8::gemm_phase<EpiDown, MoeOrder>((PG8_LAS unsigned char*)Fq.lds, gm, S, E); }
        SEAM(ph); ++ph; DIAG_ACC(11);
    }
    { l_cur = 3;
        nrep_ = NREP(1); if (PHEN(1) && IN(ph)) LAUNDERED p1_norm<false>(Fq, lq);
        SEAM(ph); ++ph; DIAG_ACC(1);
        nrep_ = NREP(2); if (PHEN(2) && IN(ph)) LAUNDERED { pg8::Gemm gm{WSQ(pg8::bf16_t, WS_H), WSQ(pg8::bf16_t, WS_WIN) + (size_t)lq * NU * DM, NT, NU, DM}; pg8::StaticOrder S; S.init(NT, NU, Fq.G, Fq.bid);
            EpiU E{WSQ(bf16_t, WS_U), NU, WSQ(bf16_t, WS_US5)}; pg8::gemm_phase<EpiU, pg8::StaticOrder>((PG8_LAS unsigned char*)Fq.lds, gm, S, E); }
        SEAM(ph); ++ph; DIAG_ACC(2);
        nrep_ = NREP(3); if (PHEN(3) && IN(ph)) LAUNDERED {
            unsigned* qctr = WSQ(unsigned, WS_CTL) + CW_Q0 + 64 * (2 + 2 * lq + rep_ * 8);
            for (;;) { const int idx = q_next(Fq, qctr); if (idx >= NCH + 260 + N_S5H) break; const Frame Fi = launder(Fq);
                if (idx < NCH) { for (int q_ = 0; q_ < NREP(21); ++q_) p3_ssd_prep(Fi, lq, idx); }
                else if (idx < NCH + 260) { for (int q_ = 0; q_ < NREP(22); ++q_) p3_attn_prep(Fi, lq, idx - NCH); }
                else { for (int q_ = 0; q_ < NREP(23); ++q_) p3_s5_hloc(Fi, lq, idx - NCH - 260); }
            }
        }
        SEAM(ph); ++ph; DIAG_ACC(3);
        nrep_ = NREP(4); if (PHEN(4) && IN(ph)) LAUNDERED { for (int q_ = 0; q_ < NREP(16); ++q_) p4_ssd_scan(Fq, lq);
            for (int q_ = 0; q_ < NREP(17); ++q_) for (int it = Fq.bid; it < 256; it += Fq.G) { const Frame Fi = launder(Fq); p4_attn_diff(Fi, lq, it); }
            unsigned* qctr = WSQ(unsigned, WS_CTL) + CW_Q0 + 64 * (10 + lq + rep_ * 8);
            for (;;) { const int idx = q_next(Fq, qctr); if (idx >= 4) break; const Frame Fi = launder(Fq);
                p4_attn_diff(Fi, lq, 256 + idx); } }
        SEAM(ph); ++ph; DIAG_ACC(4);
        nrep_ = NREP(5); if (PHEN(5) && IN(ph)) LAUNDERED {
            if (false && gqa_fast_ok(Fq, lq)) { for (int q_ = 0; q_ < NREP(18); ++q_) for (int it = Fq.bid; it < 256; it += Fq.G) { const Frame Fi = launder(Fq); p4_attn_gqa<true>(Fi, lq, it); } }
            else { for (int q_ = 0; q_ < NREP(18); ++q_) for (int it = Fq.bid; it < 256; it += Fq.G) { const Frame Fi = launder(Fq); p4_attn_gqa<false>(Fi, lq, it); } }
            { unsigned* qctr = WSQ(unsigned, WS_CTL) + CW_Q0 + 64 * (3 + 2 * lq + rep_ * 8);
              for (;;) { const int idx = q_next(Fq, qctr); if (idx >= 2 * NCH + N_S5O + 4) break; const Frame Fi = launder(Fq);
                  if (idx < 2 * NCH) p4_ssd_out(Fi, lq, idx); else if (idx < 2 * NCH + N_S5O) p4_s5_out(Fi, lq, idx - 2 * NCH); else p4_attn_gqa<false>(Fi, lq, 256 + idx - 2 * NCH - N_S5O); } }
        }
        SEAM(ph); ++ph; DIAG_ACC(5);
        nrep_ = NREP(6); if (PHEN(6) && IN(ph)) LAUNDERED p5_finish(Fq, lq);
        SEAM(ph); ++ph; DIAG_ACC(6);
        nrep_ = NREP(7); if (PHEN(7) && IN(ph)) LAUNDERED { pg8::Gemm gm{WSQ(pg8::bf16_t, WS_MIX) + (size_t)CTX * DM, WSQ(pg8::bf16_t, WS_WOUT) + (size_t)lq * DM * DM, SEQ, DM, DM}; pg8::StaticOrder S; S.init(SEQ, DM, Fq.G, Fq.bid);
            EpiRes E; E.C = WSQ(float, WS_XA); E.g1 = WSQ(float, WS_MOD) + (size_t)lq * 2 * 6144 + 2 * 1024;
            if (lq == 0) { E.res_ctx = ((const float*)Fq.in[I_CTX]); E.res_lat = ((const float*)Fq.in[I_X]); } else { E.res_ctx = WSQ(float, WS_XB); E.res_lat = WSQ(float, WS_XB) + (size_t)CTX * DM; }
            pg8::gemm_phase<EpiRes, pg8::StaticOrder>((PG8_LAS unsigned char*)Fq.lds, gm, S, E);
            if (lq < DEPTH - 1) outproj_ctx(Fq, lq, E.res_ctx); }
        SEAM(ph); ++ph; DIAG_ACC(7);
        nrep_ = NREP(8); if (PHEN(8) && IN(ph)) LAUNDERED p7a_router(Fq, lq, rep_);
        SEAM(ph); ++ph; DIAG_ACC(8);
        nrep_ = NREP(10); if (PHEN(10) && IN(ph)) LAUNDERED { const int ntiles = moe_tables(Fq, lq); const LAS int* t2e = (const LAS int*)(Fq.lds + LDS_MISC) + 64;
            moe_rows(Fq, lq, ntiles, 8);
            pg8::Gemm gm{WSQ(pg8::bf16_t, WS_H), WSQ(pg8::bf16_t, WS_WGU) + (size_t)lq * NEXP * 2048 * DM, CAP, 2048, DM};
            MoeOrder S{8, ntiles, Fq.G, Fq.bid, t2e, (long)2048 * DM * 2};
            moe_bias(Fq, ntiles, 8, ((const float*)Fq.in[I_BGU]) + (size_t)lq * NEXP * 2048, 2048);
            EpiAct E{WSQ(bf16_t, WS_ACT), (const LAS float*)(Fq.lds + LDS_BIASL)};
            if (STAG_GU) xcd_stagger(Fq, STAG_GU);
            pg8::gemm_phase_gather<EpiAct, MoeOrder>((PG8_LAS unsigned char*)Fq.lds, gm, S, E, (const PG8_LAS int*)(Fq.lds + LDS_MISC + 2048)); }
        SEAM(ph); ++ph; DIAG_ACC(10);
        nrep_ = NREP(11); if (PHEN(11) && IN(ph)) LAUNDERED { const int ntiles = moe_tables(Fq, lq); const LAS int* t2e = (const LAS int*)(Fq.lds + LDS_MISC) + 64;
            pg8::Gemm gm{WSQ(pg8::bf16_t, WS_ACT), WSQ(pg8::bf16_t, WS_WDN) + (size_t)lq * NEXP * DM * DM, CAP, DM, DM};
            MoeOrder S{4, ntiles, Fq.G, Fq.bid, t2e, (long)DM * DM * 2};
            moe_bias(Fq, ntiles, 4, ((const float*)Fq.in[I_BDN]) + (size_t)lq * NEXP * DM, DM);
            EpiDown E{WSQ(bf16_t, WS_YB), (const LAS float*)(Fq.lds + LDS_BIASL), REP_SKIP_STORES * rep_, WSQ(bf16_t, WS_U)};
            if (STAG_DN) xcd_stagger(Fq, STAG_DN);
            pg8::gemm_phase<EpiDown, MoeOrder>((PG8_LAS unsigned char*)Fq.lds, gm, S, E); }
        SEAM(ph); ++ph; DIAG_ACC(11);
    }
#if DIAG
    if (blockIdx.x == 0 && threadIdx.x < 16) __hip_atomic_store((unsigned*)(F.ws + WS_CTL) + 5000 + threadIdx.x, dg[threadIdx.x], __ATOMIC_RELAXED, __HIP_MEMORY_SCOPE_AGENT);
    xcd_barrier(bar);
    { const unsigned* dgw = (const unsigned*)(F.ws + WS_CTL) + 5000;
      const float ta = (float)__hip_atomic_load(dgw + DIAG_A, __ATOMIC_RELAXED, __HIP_MEMORY_SCOPE_AGENT) * 0.01f;
      const float cval = sqrtf(ta * (1.f / DIAG_DIV));
      for (size_t i = (size_t)blockIdx.x * 512 + threadIdx.x; i < (size_t)SEQ * DM; i += (size_t)gridDim.x * 512) F.out[i] = cval; }
#else
    nrep_ = NREP(12); if (PHEN(12) && IN(ph)) LAUNDERED { (void)lq; p1_norm<true>(Fq, DEPTH); }
#endif
#undef IN
#undef SEAM
}

#ifndef N_LAUNCH_MODE
#define N_LAUNCH_MODE 1
#endif
extern "C" void kernel_launch(void* const* d_in, const int* in_sizes, int n_in, void* d_out, int out_size, void* d_ws, size_t ws_size, hipStream_t stream) {
    static int grid = 0;
    if (grid == 0) {
        if (n_in != N_IN || out_size != SEQ * DM || ws_size < WS_END) { fprintf(stderr, "kernel_launch: unexpected shapes (n_in %d, out %d, ws %zu < %zu)\n", n_in, out_size, ws_size, (size_t)WS_END); grid = -1; return; }
        int dev = 0, cus = 0, per_cu = 0;
        if (hipGetDevice(&dev) != hipSuccess || hipDeviceGetAttribute(&cus, hipDeviceAttributeMultiprocessorCount, dev) != hipSuccess) { grid = -1; return; }
        if (hipFuncSetAttribute((const void*)hybrid_fwd, hipFuncAttributeMaxDynamicSharedMemorySize, LDS_BYTES) != hipSuccess) { fprintf(stderr, "kernel_launch: hipFuncSetAttribute failed\n"); grid = -1; return; }
        if (hipOccupancyMaxActiveBlocksPerMultiprocessor(&per_cu, (const void*)hybrid_fwd, 512, LDS_BYTES) != hipSuccess || per_cu < 1) { fprintf(stderr, "kernel_launch: occupancy query says %d\n", per_cu); }
        (void)hipGetLastError();
        grid = cus;
    }
    if (grid < 0) return;
    (void)hipMemsetAsync((char*)d_ws + WS_CTL, 0, CTL_BYTES, stream);
    Args a{};
    for (int i = 0; i < N_IN; ++i) a.in[i] = (const float*)d_in[i];
    a.out = (float*)d_out; a.ws = (unsigned char*)d_ws;
#if N_LAUNCH_MODE == 1
    a.ph_lo = 0; a.ph_hi = N_PHASES;
    hipLaunchKernelGGL(hybrid_fwd, dim3(grid), dim3(512), LDS_BYTES, stream, a);
#else
    for (int p = 0; p < N_PHASES; ++p) { a.ph_lo = p; a.ph_hi = p + 1; hipLaunchKernelGGL(hybrid_fwd, dim3(grid), dim3(512), LDS_BYTES, stream, a); }
#endif
}
```

```cpp
#include <hip/hip_runtime.h>
#include <cstdio>
#include <cstdint>

#define DI __device__ __forceinline__
typedef float f32x2 __attribute__((ext_vector_type(2)));
typedef float f32x16 __attribute__((ext_vector_type(16)));
typedef unsigned u32x2 __attribute__((ext_vector_type(2)));
typedef __bf16 hbf2 __attribute__((ext_vector_type(2)));

constexpr int DM = 1024, SEQ = 16384, CTX = 256, NT = SEQ + CTX, DEPTH = 4;
constexpr int DIN = 2568, NU = 2560;
constexpr int DT_COL = 1792;
constexpr int NEXP = 32, TOPK = 4;
constexpr int CAP = 292 * 256;
constexpr float EPS = 1e-6f;
constexpr float LOG2E = 1.4426950408889634f;
constexpr int NCH = NT / 128;
constexpr int S5L = 64, NC5 = NT / S5L;
constexpr int U_DQ = 0, U_DK = 256, U_DV = 512, U_Z = 768, U_XS = 1024, U_B = 1280, U_C = 1536, U_S5 = 1792, U_GQ = 2048, U_GK = 2304, U_GV = 2432;

enum { I_X = 0, I_C, I_CTX, I_CCTX, I_WADA, I_BADA, I_N1W, I_N2W, I_WIN, I_WOUT, I_LQ1, I_LK1, I_LQ2, I_LK2, I_SUBLN,
       I_CONVW, I_CONVB, I_DTB, I_ALOG, I_SSDD, I_SSDNW, I_LAMRE, I_LAMIM, I_LOGDT, I_BRE, I_BIM, I_CRE, I_CIM, I_S5D, I_WGLU, I_BGLU,
       I_QNW, I_KNW, I_WR, I_BR, I_WGU, I_BGU, I_WDN, I_BDN, I_FNW, N_IN };

constexpr size_t al256(size_t x) { return (x + 255) & ~(size_t)255; }
constexpr size_t WS_CTL   = 0;
constexpr size_t CTL_BYTES = 65536;
constexpr int CW_BAR = 0;
constexpr int CW_KMAX = 4096;
constexpr int CW_CNT = 4096 + 128;
constexpr int CW_Q0 = 4096 + 128 + 128;
constexpr size_t WS_MOD   = WS_CTL + CTL_BYTES;
constexpr size_t WS_ROPE  = al256(WS_MOD + (size_t)DEPTH * 2 * 6144 * 4);
constexpr size_t WS_LAM   = al256(WS_ROPE + 256 * 8 * 8 + 256 * 16 * 8);
constexpr size_t WS_WIN   = al256(WS_LAM + 256);
constexpr size_t WS_WOUT  = al256(WS_WIN + (size_t)DEPTH * NU * DM * 2);
constexpr size_t WS_WGU   = al256(WS_WOUT + (size_t)DEPTH * DM * DM * 2);
constexpr size_t WS_WDN   = al256(WS_WGU + (size_t)DEPTH * NEXP * 2048 * DM * 2);
constexpr size_t WS_WGLU  = al256(WS_WDN + (size_t)DEPTH * NEXP * DM * DM * 2);
constexpr size_t WS_KTAB  = al256(WS_WGLU + (size_t)DEPTH * 256 * 256 * 2);
constexpr size_t WS_CC5   = al256(WS_KTAB + (size_t)DEPTH * 16 * 3 * 64 * 256 * 2);
constexpr size_t WS_E5    = al256(WS_CC5 + (size_t)DEPTH * 16 * 1024 * 256 * 2);
constexpr size_t WS_APOW  = al256(WS_E5 + (size_t)DEPTH * 16 * 2 * 128 * 1024 * 2);
constexpr size_t WS_XA    = al256(WS_APOW + (size_t)DEPTH * 16 * 2 * 64 * 8);
constexpr size_t WS_XB    = al256(WS_XA + (size_t)NT * DM * 4);
constexpr size_t WS_H     = al256(WS_XB + (size_t)NT * DM * 4);
constexpr size_t WS_U     = al256(WS_H + (size_t)NT * DM * 2);
constexpr size_t WS_DTRAW = al256(WS_U + (size_t)NT * NU * 2);
constexpr size_t WS_QD    = al256(WS_DTRAW + (size_t)NT * 8 * 4);
constexpr size_t WS_KD    = al256(WS_QD + (size_t)4 * NT * 64 * 2);
constexpr size_t WS_VTD   = al256(WS_KD + (size_t)4 * NT * 64 * 2);
constexpr size_t WS_QG    = al256(WS_VTD + (size_t)4 * NT * 64 * 2);
constexpr size_t WS_KG    = al256(WS_QG + (size_t)4 * NT * 64 * 2);
constexpr size_t WS_VTG   = al256(WS_KG + (size_t)2 * NT * 64 * 2);
constexpr size_t WS_QND   = al256(WS_VTG + (size_t)2 * NT * 64 * 2);
constexpr size_t WS_QNG   = al256(WS_QND + (size_t)8 * NT * 4);
constexpr size_t WS_XST   = al256(WS_QNG + (size_t)4 * NT * 4);
constexpr size_t WS_BN    = al256(WS_XST + (size_t)NT * 256 * 2);
constexpr size_t WS_CN    = al256(WS_BN + (size_t)NT * 256 * 2);
constexpr size_t WS_DTV   = al256(WS_CN + (size_t)NT * 256 * 2);
constexpr size_t WS_CUM   = al256(WS_DTV + (size_t)NT * 8 * 4);
constexpr size_t WS_SLOC  = al256(WS_CUM + (size_t)NT * 8 * 4);
constexpr size_t WS_SIN   = al256(WS_SLOC + (size_t)NCH * 8 * 64 * 128 * 4);
constexpr size_t WS_YSSD  = al256(WS_SIN + (size_t)NCH * 8 * 64 * 128 * 2);
constexpr size_t WS_SSQ   = al256(WS_YSSD + (size_t)NT * 256 * 2);
constexpr size_t WS_HLOC  = al256(WS_SSQ + (size_t)NT * 4 * 4);
constexpr size_t WS_HIN   = al256(WS_HLOC + (size_t)NC5 * 4096 * 4);
constexpr size_t WS_YS5   = al256(WS_HIN + (size_t)NC5 * 4096 * 2);
constexpr size_t WS_US5   = al256(WS_YS5 + (size_t)NT * 256 * 2);
constexpr size_t WS_MIX   = al256(WS_US5 + (size_t)NT * 256 * 2);
constexpr size_t WS_TOPE  = al256(WS_MIX + (size_t)NT * DM * 2);
constexpr size_t WS_TOPP  = al256(WS_TOPE + (size_t)NT * 16);
constexpr size_t WS_TOPG  = al256(WS_TOPP + (size_t)NT * 16);
constexpr size_t WS_TOPS  = al256(WS_TOPG + (size_t)NT * 16);
constexpr size_t WS_ASLOT = al256(WS_TOPS + (size_t)NEXP * NT * 4);
constexpr size_t WS_ACT   = al256(WS_ASLOT + (size_t)CAP * DM * 2);
constexpr size_t WS_YB    = al256(WS_ACT + (size_t)CAP * DM * 2);
constexpr size_t WS_END   = al256(WS_YB + (size_t)CAP * DM * 2);

constexpr int LDS_BYTES = 160 * 1024;
constexpr int LDS_MISC = 128 * 1024;
#define LAS __attribute__((address_space(3)))
#define GAS __attribute__((address_space(1)))

struct Args { const float* in[N_IN]; float* out; unsigned char* ws; int ph_lo, ph_hi; };

typedef unsigned short bf16_t;
typedef short bf16x8 __attribute__((ext_vector_type(8)));
typedef float f32x4 __attribute__((ext_vector_type(4)));
typedef unsigned u32x4 __attribute__((ext_vector_type(4)));

DI unsigned pk2(float lo, float hi) { f32x2 v = {lo, hi}; hbf2 b = __builtin_convertvector(v, hbf2); return __builtin_bit_cast(unsigned, b); }
DI bf16_t f2bf(float f) { return (bf16_t)(pk2(f, 0.f) & 0xffffu); }
DI float bf2f(bf16_t b) { return __uint_as_float(((unsigned)b) << 16); }
DI float bflo(unsigned u) { return __uint_as_float(u << 16); }
DI float bfhi(unsigned u) { return __uint_as_float(u & 0xffff0000u); }
DI f32x16 mfma32(bf16x8 a, bf16x8 b, f32x16 c) { return __builtin_amdgcn_mfma_f32_32x32x16_bf16(a, b, c, 0, 0, 0); }
DI int kperm(int m) { return (m & 0x13) | ((m & 4) << 1) | ((m & 8) >> 1); }
DI int crow(int i, int h) { return (i & 3) + 8 * (i >> 2) + 4 * h; }
DI bf16x8 ld8g(const bf16_t* p) { return *(const bf16x8*)p; }
template <int CTRL> DI float dppf(float v) { return __builtin_bit_cast(float, __builtin_amdgcn_update_dpp(0, __builtin_bit_cast(int, v), CTRL, 0xF, 0xF, true)); }
DI float rlane(float v, int l) { return __builtin_bit_cast(float, __builtin_amdgcn_readlane(__builtin_bit_cast(int, v), l)); }
DI float wave_sum(float v) {
    v += dppf<0xB1>(v); v += dppf<0x4E>(v); v += dppf<0x141>(v); v += dppf<0x140>(v);
    return (rlane(v, 0) + rlane(v, 16)) + (rlane(v, 32) + rlane(v, 48));
}
DI float wave_max(float v) {
    v = fmaxf(v, dppf<0xB1>(v)); v = fmaxf(v, dppf<0x4E>(v)); v = fmaxf(v, dppf<0x141>(v)); v = fmaxf(v, dppf<0x140>(v));
    return fmaxf(fmaxf(rlane(v, 0), rlane(v, 16)), fmaxf(rlane(v, 32), rlane(v, 48)));
}
DI float silu_f(float x) { return x * __builtin_amdgcn_rcpf(1.f + __builtin_amdgcn_exp2f(-1.4426950408889634f * x)); }
DI float sigmoid_f(float x) { return __builtin_amdgcn_rcpf(1.f + __builtin_amdgcn_exp2f(-1.4426950408889634f * x)); }
template <int S> DI bf16x8 pack_step(const f32x16& x) {
    u32x4 p;
    p[0] = pk2(x[8 * S + 0], x[8 * S + 1]); p[1] = pk2(x[8 * S + 2], x[8 * S + 3]);
    p[2] = pk2(x[8 * S + 4], x[8 * S + 5]); p[3] = pk2(x[8 * S + 6], x[8 * S + 7]);
    return __builtin_bit_cast(bf16x8, p);
}
DI f32x16 splat16(float v) { f32x16 r;
#pragma unroll
    for (int i = 0; i < 16; ++i) r[i] = v; return r; }
#define XB_TMO      128
#define XB_XCNT(j)  (256  + 64 * (j))
#define XB_XSUB(j)  (1280 + 64 * (j))
#define XB_XGEN(j)  (2304 + 64 * (j))
#define XB_TOP      3328
#define XB_TOPGEN   3392
#define XCD_BAR_WORDS 3456
#define XB_SPIN_CAP (1u << 18)
#define LAS __attribute__((address_space(3)))

__device__ __forceinline__ unsigned xb_ld(unsigned* p)              { return __hip_atomic_load(p, __ATOMIC_RELAXED, __HIP_MEMORY_SCOPE_AGENT); }
__device__ __forceinline__ unsigned xb_add(unsigned* p, unsigned v) { return __hip_atomic_fetch_add(p, v, __ATOMIC_RELAXED, __HIP_MEMORY_SCOPE_AGENT); }
__device__ __forceinline__ unsigned xb_xcc_id() { return (unsigned)__builtin_amdgcn_s_getreg((3 << 11) | 20) & 0xFu; }
#define XB_SPIN(cond, bar) do { unsigned _sp = 0; while (cond) { __builtin_amdgcn_s_sleep(1); \
    if ((++_sp & 255u) == 0u) { if (xb_ld(&(bar)[XB_TMO])) break; if (_sp > XB_SPIN_CAP) { atomicAdd(&(bar)[XB_TMO], 1u); break; } } } } while (0)

struct XcdBarrier {
    unsigned* bar; unsigned x;
    volatile LAS unsigned* st;
};

__device__ __forceinline__ XcdBarrier xcd_barrier_post(unsigned* bar, volatile LAS unsigned* st) {
    XcdBarrier b; b.bar = bar; b.x = xb_xcc_id(); b.st = st;
    if (threadIdx.x == 0) (void)xb_add(&bar[XB_XCNT(b.x)], 1u);
    return b;
}
__device__ __forceinline__ void xcd_barrier_complete(unsigned* bar, unsigned x, unsigned& nloc, unsigned& nx) {
    const unsigned G = gridDim.x * gridDim.y * gridDim.z;
    unsigned sum, cnt, mine, sp = 0u;
    for (;;) {
        sum = 0u; cnt = 0u; mine = 0u;
#pragma unroll
        for (unsigned j = 0; j < 16; ++j) { const unsigned c = xb_ld(&bar[XB_XCNT(j)]); sum += c; cnt += (c > 0u) ? 1u : 0u; mine = (j == x) ? c : mine; }
        if (sum == G) break;
        __builtin_amdgcn_s_sleep(1);
        if ((++sp & 255u) == 0u) { if (xb_ld(&bar[XB_TMO])) break; if (sp > XB_SPIN_CAP) { atomicAdd(&bar[XB_TMO], 1u); break; } }
    }
    nloc = mine > 0u ? mine : 1u; nx = cnt > 0u ? cnt : 1u;
}

__device__ __forceinline__ void xcd_barrier(const XcdBarrier& b) {
    asm volatile("s_waitcnt vmcnt(0)" ::: "memory");
    __syncthreads();
    if (threadIdx.x == 0) {
        unsigned* bar = b.bar;
        __builtin_amdgcn_s_waitcnt(0);
        unsigned nloc = b.st[0], nx = b.st[1];
        if (nloc == 0u) { xcd_barrier_complete(bar, b.x, nloc, nx); b.st[0] = nloc; b.st[1] = nx; }
        const unsigned old = xb_add(&bar[XB_XSUB(b.x)], 1u);
        const unsigned gen = old / nloc;
        if (old + 1u == (gen + 1u) * nloc) {
            __builtin_amdgcn_fence(__ATOMIC_RELEASE, "agent");
            asm volatile("s_waitcnt vmcnt(0)" ::: "memory");
            const unsigned og = xb_add(&bar[XB_TOP], 1u);
            const unsigned tg = og / nx;
            if (og + 1u == (tg + 1u) * nx) xb_add(&bar[XB_TOPGEN], 1u);
            else XB_SPIN(xb_ld(&bar[XB_TOPGEN]) == tg, bar);
            __builtin_amdgcn_fence(__ATOMIC_ACQUIRE, "agent");
            xb_add(&bar[XB_XGEN(b.x)], 1u);
            asm volatile("s_waitcnt vmcnt(0)" ::: "memory");
        } else {
            XB_SPIN(xb_ld(&bar[XB_XGEN(b.x)]) == gen, bar);
            __builtin_amdgcn_fence(__ATOMIC_ACQUIRE, "agent");
            asm volatile("s_waitcnt vmcnt(0)" ::: "memory");
        }
    }
    __syncthreads();
}
namespace pg8 {
#define PG8_LAS __attribute__((address_space(3)))
typedef unsigned short bf16_t;
typedef short bf16x8 __attribute__((ext_vector_type(8)));
typedef float f32x4 __attribute__((ext_vector_type(4)));
typedef unsigned u32x4 __attribute__((ext_vector_type(4)));
constexpr int BM = 256, BK = 64, HALF = 128, HTB = HALF * BK * 2  , STAGE_BYTES = 8 * HTB, NXCD = 8, WGM = 8;

__host__ __device__ __forceinline__ int lds_byte(int r, int c) { const int st = (r >> 4) * 2 + (c >> 5), rr = r & 15, cc = c & 31, ob = rr * 64 + cc * 2; return st * 1024 + (ob ^ (((ob >> 9) & 1) << 5)); }
__host__ __device__ __forceinline__ void stage_rc(int b, int& R, int& C) { const int st = b / 1024, sb = b % 1024, swz = sb ^ (((sb >> 9) & 1) << 5); R = (st >> 1) * 16 + swz / 64; C = (st & 1) * 32 + (swz % 64) / 2; }
__host__ __device__ __forceinline__ int perm32(int rho) { const int n = rho >> 4, i = rho & 15; return 8 * (i >> 2) + 4 * n + (i & 3); }

struct Unit { int pm, pn; long boff; };
struct Gemm { const bf16_t* A; const bf16_t* Bt; int M, N, K; };

struct StaticOrder {
    int nM, nN, nwg, G, c;
    __host__ __device__ void init(int M, int N, int G_, int c_) { nM = M / BM; nN = N / BM; nwg = nM * nN; G = G_; c = c_; }
    __host__ __device__ bool next(int i, Unit& u) const {
        const long L = (long)i * G + c; if (L >= nwg) return false;
        int wgid = (int)L; { const int q = nwg / NXCD, r = nwg % NXCD, xcd = wgid % NXCD, off = wgid / NXCD; wgid = (xcd < r ? xcd * (q + 1) : r * (q + 1) + (xcd - r) * q) + off; }
        const int nig = WGM * nN, gid = wgid / nig, fm = gid * WGM, gsz = (nM - fm) < WGM ? (nM - fm) : WGM;
        u.pm = fm + ((wgid % nig) % gsz); u.pn = (wgid % nig) / gsz; u.boff = 0; return true;
    }
    __device__ __forceinline__ void a_ready(const Unit&) const {}
    __device__ __forceinline__ void done(const Unit&) const {}
};
__device__ __forceinline__ unsigned cvt_pk_bf16(float lo, float hi) { unsigned r; asm volatile("v_cvt_pk_bf16_f32 %0, %1, %2" : "=v"(r) : "v"(lo), "v"(hi)); return r; }
template <class Epi, class Sched, bool STAMP = false>
__device__ __forceinline__ void gemm_phase(PG8_LAS unsigned char* lds, const Gemm g, const Sched& S, const Epi& E, unsigned long long* stamps = nullptr) {
    int tid_l = threadIdx.x; asm volatile("" : "+v"(tid_l)); const int tid = tid_l, wid = __builtin_amdgcn_readfirstlane(tid >> 6), lane = tid & 63, wr = wid >> 2, wc = wid & 3, fr = lane & 15, fq = lane >> 4;
    const int K = g.K, nt = K / BK;
    int ts_lo = 0, ts_hi = 0, nts = 0; const unsigned long long rt_entry = STAMP ? (unsigned long long)wall_clock64() : 0ull;
#define PG8_STAMP() do { if (STAMP && wid == 0 && nts < 64) { const unsigned long long _c = (unsigned long long)clock64(); \
        ts_lo = (lane == nts) ? (int)(unsigned)_c : ts_lo; ts_hi = (lane == nts) ? (int)(unsigned)(_c >> 32) : ts_hi; ++nts; } } while (0)
    PG8_STAMP();
    unsigned voffA[2], voffB[2];
#pragma unroll
    for (int i = 0; i < 2; ++i) { int R, C; stage_rc(tid * 16 + i * 8192, R, C); const int Rb = Epi::PERM ? ((R & ~31) + perm32(R & 31)) : R;
        voffA[i] = (unsigned)(R * K + C) * 2u; voffB[i] = (unsigned)(Rb * K + C) * 2u; }
    const size_t kstep = (size_t)(BK * 2);
    const size_t hstep = (size_t)HALF * K * 2;
    const size_t tstep = 2 * hstep;
    const unsigned ldsw = (unsigned)wid * 1024u;
    const int aoff = lds_byte(wr * 64 + fr, fq * 8), boff = lds_byte(wc * 32 + fr, fq * 8);
#define PG8_SA(b, h) (((b) * 2 + (h)) * HTB)
#define PG8_SB(b, h) ((4 + (b) * 2 + (h)) * HTB)
#define PG8_STAGE(bufoff, gbase, voff) do { _Pragma("unroll") for (int _i = 0; _i < 2; ++_i) \
        __builtin_amdgcn_global_load_lds((const unsigned*)((const char*)(gbase) + (voff)[_i]), (PG8_LAS unsigned*)(lds + (bufoff) + ldsw + _i * 8192), 16, 0, 0); } while (0)
#define PG8_LDA(dst, b, h) do { _Pragma("unroll") for (int m = 0; m < 4; ++m) _Pragma("unroll") for (int k = 0; k < 2; ++k) dst[m][k] = *(const PG8_LAS bf16x8*)(lds + PG8_SA(b, h) + aoff + m * 2048 + k * 1024); } while (0)
#define PG8_LDB(dst, b, h) do { _Pragma("unroll") for (int n = 0; n < 2; ++n) _Pragma("unroll") for (int k = 0; k < 2; ++k) dst[n][k] = *(const PG8_LAS bf16x8*)(lds + PG8_SB(b, h) + boff + n * 2048 + k * 1024); } while (0)
#define PG8_MMA(ai, bj, At, Bt) do { __builtin_amdgcn_s_setprio(1); _Pragma("unroll") for (int m = 0; m < 4; ++m) _Pragma("unroll") for (int n = 0; n < 2; ++n) _Pragma("unroll") for (int k = 0; k < 2; ++k) \
        acc[ai][bj][m][n] = __builtin_amdgcn_mfma_f32_16x16x32_bf16(Bt[n][k], At[m][k], acc[ai][bj][m][n], 0, 0, 0); __builtin_amdgcn_s_setprio(0); } while (0)
#define PG8_WAIT_V(n) asm volatile("s_waitcnt vmcnt(" #n ")" ::: "memory")
#define PG8_WAIT_L(n) asm volatile("s_waitcnt lgkmcnt(" #n ")" ::: "memory")
#define PG8_BAR __builtin_amdgcn_s_barrier()
#define PG8_SCHED __builtin_amdgcn_sched_barrier(0)
    Unit cur, nxt; int ui = 0;
    if (!S.next(0, cur)) return;
    f32x4 acc[2][2][4][2];
#pragma unroll
    for (int a = 0; a < 2; ++a)
#pragma unroll
        for (int b = 0; b < 2; ++b)
#pragma unroll
            for (int m = 0; m < 4; ++m)
#pragma unroll
                for (int n = 0; n < 2; ++n) acc[a][b][m][n] = (f32x4){0.f, 0.f, 0.f, 0.f};
    bf16x8 At[4][2], B0[2][2], B1[2][2];
    const char* cA = (const char*)g.A + (size_t)cur.pm * tstep; const char* cB = (const char*)g.Bt + (size_t)cur.pn * tstep + cur.boff;
    S.a_ready(cur);
    PG8_STAGE(PG8_SB(0, 0), cB, voffB); PG8_STAGE(PG8_SA(0, 0), cA, voffA); PG8_STAGE(PG8_SB(0, 1), cB + hstep, voffB); PG8_STAGE(PG8_SA(0, 1), cA + hstep, voffA);
    if (wr == 1) PG8_BAR;
    PG8_WAIT_V(4); PG8_BAR;
    PG8_STAGE(PG8_SB(1, 0), cB + kstep, voffB); PG8_STAGE(PG8_SA(1, 0), cA + kstep, voffA); PG8_STAGE(PG8_SB(1, 1), cB + hstep + kstep, voffB);
    PG8_WAIT_V(6); PG8_BAR;
    PG8_STAMP();
    for (;;) {
        const bool has_next = S.next(ui + 1, nxt);
        const char* nA = has_next ? (const char*)g.A + (size_t)nxt.pm * tstep : cA; const char* nB = has_next ? (const char*)g.Bt + (size_t)nxt.pn * tstep + nxt.boff : cB;
        for (int t = 0; t < nt; t += 2) {
            const bool last = (t == nt - 2);
            const char* a1 = cA + (size_t)(t + 1) * kstep;
            const char* a2 = last ? nA : cA + (size_t)(t + 2) * kstep; const char* b2 = last ? nB : cB + (size_t)(t + 2) * kstep;
            const char* a3 = a2 + kstep; const char* b3 = b2 + kstep;
            if (last && has_next) S.a_ready(nxt);
            PG8_LDB(B0, 0, 0); PG8_SCHED; PG8_LDA(At, 0, 0); PG8_STAGE(PG8_SA(1, 1), a1 + hstep, voffA);
            PG8_WAIT_L(8); PG8_BAR; PG8_WAIT_L(0); PG8_MMA(0, 0, At, B0); PG8_BAR; PG8_SCHED;
            PG8_LDB(B1, 0, 1); PG8_STAGE(PG8_SB(0, 0), b2, voffB);
            PG8_BAR; PG8_WAIT_L(0); PG8_MMA(0, 1, At, B1); PG8_BAR;
            PG8_LDA(At, 0, 1); PG8_STAGE(PG8_SA(0, 0), a2, voffA);
            PG8_BAR; PG8_WAIT_L(0); PG8_MMA(1, 0, At, B0); PG8_BAR; PG8_SCHED;
            PG8_STAGE(PG8_SB(0, 1), b2 + hstep, voffB);
            PG8_WAIT_V(6); PG8_BAR; PG8_MMA(1, 1, At, B1); PG8_BAR;
            PG8_LDB(B0, 1, 0); PG8_SCHED; PG8_LDA(At, 1, 0); PG8_STAGE(PG8_SA(0, 1), a2 + hstep, voffA);
            PG8_WAIT_L(8); PG8_BAR; PG8_WAIT_L(0); PG8_MMA(0, 0, At, B0); PG8_BAR; PG8_SCHED;
            PG8_LDB(B1, 1, 1); PG8_STAGE(PG8_SB(1, 0), b3, voffB);
            PG8_BAR; PG8_WAIT_L(0); PG8_MMA(0, 1, At, B1); PG8_BAR;
            PG8_LDA(At, 1, 1); PG8_STAGE(PG8_SA(1, 0), a3, voffA);
            PG8_BAR; PG8_WAIT_L(0); PG8_MMA(1, 0, At, B0); PG8_BAR; PG8_SCHED;
            PG8_STAGE(PG8_SB(1, 1), b3 + hstep, voffB);
            PG8_WAIT_V(6); PG8_BAR; PG8_MMA(1, 1, At, B1); PG8_BAR;
        }
        PG8_STAMP();
        if constexpr (!Epi::AFTER_DRAIN) { E(acc, cur, wr, wc, fr, fq); S.done(cur); }
        PG8_STAMP();
        if (!has_next) break;
#pragma unroll
        for (int a = 0; a < 2; ++a)
#pragma unroll
            for (int b = 0; b < 2; ++b)
#pragma unroll
                for (int m = 0; m < 4; ++m)
#pragma unroll
                    for (int n = 0; n < 2; ++n) acc[a][b][m][n] = (f32x4){0.f, 0.f, 0.f, 0.f};
        cur = nxt; cA = nA; cB = nB; ++ui;
    }
    PG8_WAIT_V(0);
    if (wr == 0) PG8_BAR;
    PG8_BAR;
    if constexpr (Epi::AFTER_DRAIN) { E.fused(acc, cur, wr, wc, fr, fq, lds, wid, lane); S.done(cur); }
    PG8_STAMP();
    if (STAMP && wid == 0) { stamps[lane] = lane < nts ? (((unsigned long long)(unsigned)ts_hi << 32) | (unsigned)ts_lo) : 0ull;
        if (lane == 62) stamps[62] = rt_entry; if (lane == 63) stamps[63] = (unsigned long long)wall_clock64(); }
#undef PG8_STAMP
#undef PG8_SA
#undef PG8_SB
#undef PG8_STAGE
#undef PG8_LDA
#undef PG8_LDB
#undef PG8_MMA
#undef PG8_WAIT_V
#undef PG8_WAIT_L
#undef PG8_BAR
#undef PG8_SCHED
}
template <class Epi, class Sched, bool STAMP = false>
__device__ __forceinline__ void gemm_phase_gather(PG8_LAS unsigned char* lds, const Gemm g, const Sched& S, const Epi& E, const PG8_LAS int* rows, unsigned long long* stamps = nullptr) {
    int tid_l = threadIdx.x; asm volatile("" : "+v"(tid_l)); const int tid = tid_l, wid = __builtin_amdgcn_readfirstlane(tid >> 6), lane = tid & 63, wr = wid >> 2, wc = wid & 3, fr = lane & 15, fq = lane >> 4;
    const int K = g.K, nt = K / BK;
    int ts_lo = 0, ts_hi = 0, nts = 0; const unsigned long long rt_entry = STAMP ? (unsigned long long)wall_clock64() : 0ull;
#define PG8_STAMP() do { if (STAMP && wid == 0 && nts < 64) { const unsigned long long _c = (unsigned long long)clock64(); \
        ts_lo = (lane == nts) ? (int)(unsigned)_c : ts_lo; ts_hi = (lane == nts) ? (int)(unsigned)(_c >> 32) : ts_hi; ++nts; } } while (0)
    PG8_STAMP();
    unsigned voffA[2], voffB[2];
#pragma unroll
    for (int i = 0; i < 2; ++i) { int R, C; stage_rc(tid * 16 + i * 8192, R, C); const int Rb = Epi::PERM ? ((R & ~31) + perm32(R & 31)) : R;
        voffA[i] = (unsigned)(R * K + C) * 2u; voffB[i] = (unsigned)(Rb * K + C) * 2u; }
    int RA[2]; { int R_, C_; stage_rc(tid * 16, R_, C_); RA[0] = R_; stage_rc(tid * 16 + 8192, R_, C_); RA[1] = R_; }
    unsigned caoff[2]; { int R_, C_; stage_rc(tid * 16, R_, C_); caoff[0] = (unsigned)C_ * 2u; stage_rc(tid * 16 + 8192, R_, C_); caoff[1] = (unsigned)C_ * 2u; }
    unsigned offC[2][2], offN[2][2];
#define PG8_ROWOFF(dst, uidx) do { _Pragma("unroll") for (int _h = 0; _h < 2; ++_h) _Pragma("unroll") for (int _i = 0; _i < 2; ++_i) (dst)[_h][_i] = (unsigned)rows[(uidx) * 256 + _h * HALF + RA[_i]] * (unsigned)(K * 2) + caoff[_i]; } while (0)
    const size_t kstep = (size_t)(BK * 2);
    const size_t hstep = (size_t)HALF * K * 2;
    const size_t tstep = 2 * hstep;
    const unsigned ldsw = (unsigned)wid * 1024u;
    const int aoff = lds_byte(wr * 64 + fr, fq * 8), boff = lds_byte(wc * 32 + fr, fq * 8);
#define PG8_SA(b, h) (((b) * 2 + (h)) * HTB)
#define PG8_SB(b, h) ((4 + (b) * 2 + (h)) * HTB)
#define PG8_STAGE(bufoff, gbase, voff) do { _Pragma("unroll") for (int _i = 0; _i < 2; ++_i) \
        __builtin_amdgcn_global_load_lds((const unsigned*)((const char*)(gbase) + (voff)[_i]), (PG8_LAS unsigned*)(lds + (bufoff) + ldsw + _i * 8192), 16, 0, 0); } while (0)
#define PG8_LDA(dst, b, h) do { _Pragma("unroll") for (int m = 0; m < 4; ++m) _Pragma("unroll") for (int k = 0; k < 2; ++k) dst[m][k] = *(const PG8_LAS bf16x8*)(lds + PG8_SA(b, h) + aoff + m * 2048 + k * 1024); } while (0)
#define PG8_LDB(dst, b, h) do { _Pragma("unroll") for (int n = 0; n < 2; ++n) _Pragma("unroll") for (int k = 0; k < 2; ++k) dst[n][k] = *(const PG8_LAS bf16x8*)(lds + PG8_SB(b, h) + boff + n * 2048 + k * 1024); } while (0)
#define PG8_MMA(ai, bj, At, Bt) do { __builtin_amdgcn_s_setprio(1); _Pragma("unroll") for (int m = 0; m < 4; ++m) _Pragma("unroll") for (int n = 0; n < 2; ++n) _Pragma("unroll") for (int k = 0; k < 2; ++k) \
        acc[ai][bj][m][n] = __builtin_amdgcn_mfma_f32_16x16x32_bf16(Bt[n][k], At[m][k], acc[ai][bj][m][n], 0, 0, 0); __builtin_amdgcn_s_setprio(0); } while (0)
#define PG8_WAIT_V(n) asm volatile("s_waitcnt vmcnt(" #n ")" ::: "memory")
#define PG8_WAIT_L(n) asm volatile("s_waitcnt lgkmcnt(" #n ")" ::: "memory")
#define PG8_BAR __builtin_amdgcn_s_barrier()
#define PG8_SCHED __builtin_amdgcn_sched_barrier(0)
    Unit cur, nxt; int ui = 0;
    if (!S.next(0, cur)) return;
    f32x4 acc[2][2][4][2];
#pragma unroll
    for (int a = 0; a < 2; ++a)
#pragma unroll
        for (int b = 0; b < 2; ++b)
#pragma unroll
            for (int m = 0; m < 4; ++m)
#pragma unroll
                for (int n = 0; n < 2; ++n) acc[a][b][m][n] = (f32x4){0.f, 0.f, 0.f, 0.f};
    bf16x8 At[4][2], B0[2][2], B1[2][2];
    const char* cA = (const char*)g.A; PG8_ROWOFF(offC, 0); const char* cB = (const char*)g.Bt + (size_t)cur.pn * tstep + cur.boff;
    S.a_ready(cur);
    PG8_STAGE(PG8_SB(0, 0), cB, voffB); PG8_STAGE(PG8_SA(0, 0), cA, offC[0]); PG8_STAGE(PG8_SB(0, 1), cB + hstep, voffB); PG8_STAGE(PG8_SA(0, 1), cA, offC[1]);
    if (wr == 1) PG8_BAR;
    PG8_WAIT_V(4); PG8_BAR;
    PG8_STAGE(PG8_SB(1, 0), cB + kstep, voffB); PG8_STAGE(PG8_SA(1, 0), cA + kstep, offC[0]); PG8_STAGE(PG8_SB(1, 1), cB + hstep + kstep, voffB);
    PG8_WAIT_V(6); PG8_BAR;
    PG8_STAMP();
    for (;;) {
        const bool has_next = S.next(ui + 1, nxt);
        const char* nA = cA; if (has_next) PG8_ROWOFF(offN, ui + 1); else { offN[0][0] = offC[0][0]; offN[0][1] = offC[0][1]; offN[1][0] = offC[1][0]; offN[1][1] = offC[1][1]; } const char* nB = has_next ? (const char*)g.Bt + (size_t)nxt.pn * tstep + nxt.boff : cB;
        for (int t = 0; t < nt; t += 2) {
            const bool last = (t == nt - 2);
            const char* a1 = cA + (size_t)(t + 1) * kstep;
            const char* a2 = last ? nA : cA + (size_t)(t + 2) * kstep; const char* b2 = last ? nB : cB + (size_t)(t + 2) * kstep;
            const char* a3 = a2 + kstep; const char* b3 = b2 + kstep;
            if (last && has_next) S.a_ready(nxt);
            PG8_LDB(B0, 0, 0); PG8_SCHED; PG8_LDA(At, 0, 0); PG8_STAGE(PG8_SA(1, 1), a1, offC[1]);
            PG8_WAIT_L(8); PG8_BAR; PG8_WAIT_L(0); PG8_MMA(0, 0, At, B0); PG8_BAR; PG8_SCHED;
            PG8_LDB(B1, 0, 1); PG8_STAGE(PG8_SB(0, 0), b2, voffB);
            PG8_BAR; PG8_WAIT_L(0); PG8_MMA(0, 1, At, B1); PG8_BAR;
            PG8_LDA(At, 0, 1); { unsigned o2[2] = {last ? offN[0][0] : offC[0][0], last ? offN[0][1] : offC[0][1]}; PG8_STAGE(PG8_SA(0, 0), a2, o2); }
            PG8_BAR; PG8_WAIT_L(0); PG8_MMA(1, 0, At, B0); PG8_BAR; PG8_SCHED;
            PG8_STAGE(PG8_SB(0, 1), b2 + hstep, voffB);
            PG8_WAIT_V(6); PG8_BAR; PG8_MMA(1, 1, At, B1); PG8_BAR;
            PG8_LDB(B0, 1, 0); PG8_SCHED; PG8_LDA(At, 1, 0); { unsigned o2[2] = {last ? offN[1][0] : offC[1][0], last ? offN[1][1] : offC[1][1]}; PG8_STAGE(PG8_SA(0, 1), a2, o2); }
            PG8_WAIT_L(8); PG8_BAR; PG8_WAIT_L(0); PG8_MMA(0, 0, At, B0); PG8_BAR; PG8_SCHED;
            PG8_LDB(B1, 1, 1); PG8_STAGE(PG8_SB(1, 0), b3, voffB);
            PG8_BAR; PG8_WAIT_L(0); PG8_MMA(0, 1, At, B1); PG8_BAR;
            PG8_LDA(At, 1, 1); { unsigned o2[2] = {last ? offN[0][0] : offC[0][0], last ? offN[0][1] : offC[0][1]}; PG8_STAGE(PG8_SA(1, 0), a3, o2); }
            PG8_BAR; PG8_WAIT_L(0); PG8_MMA(1, 0, At, B0); PG8_BAR; PG8_SCHED;
            PG8_STAGE(PG8_SB(1, 1), b3 + hstep, voffB);
            PG8_WAIT_V(6); PG8_BAR; PG8_MMA(1, 1, At, B1); PG8_BAR;
        }
        PG8_STAMP();
        if constexpr (!Epi::AFTER_DRAIN) { E(acc, cur, wr, wc, fr, fq); S.done(cur); }
        PG8_STAMP();
        if (!has_next) break;
#pragma unroll
        for (int a = 0; a < 2; ++a)
#pragma unroll
            for (int b = 0; b < 2; ++b)
#pragma unroll
                for (int m = 0; m < 4; ++m)
#pragma unroll
                    for (int n = 0; n < 2; ++n) acc[a][b][m][n] = (f32x4){0.f, 0.f, 0.f, 0.f};
        cur = nxt; cA = nA; cB = nB; ++ui; offC[0][0] = offN[0][0]; offC[0][1] = offN[0][1]; offC[1][0] = offN[1][0]; offC[1][1] = offN[1][1];
    }
    PG8_WAIT_V(0);
    if (wr == 0) PG8_BAR;
    PG8_BAR;
    if constexpr (Epi::AFTER_DRAIN) { E.fused(acc, cur, wr, wc, fr, fq, lds, wid, lane); S.done(cur); }
    PG8_STAMP();
    if (STAMP && wid == 0) { stamps[lane] = lane < nts ? (((unsigned long long)(unsigned)ts_hi << 32) | (unsigned)ts_lo) : 0ull;
        if (lane == 62) stamps[62] = rt_entry; if (lane == 63) stamps[63] = (unsigned long long)wall_clock64(); }
#undef PG8_STAMP
#undef PG8_SA
#undef PG8_SB
#undef PG8_STAGE
#undef PG8_LDA
#undef PG8_LDB
#undef PG8_MMA
#undef PG8_WAIT_V
#undef PG8_WAIT_L
#undef PG8_BAR
#undef PG8_SCHED
#undef PG8_ROWOFF
}
}

struct Frame {
    LAS unsigned char* lds;
    const GAS float* const __attribute__((address_space(4)))* in;
    GAS unsigned char* ws;
    float* out;
    int tid, lane, wave, G, bid;
};
#define WSP(T, off) ((T*)(F.ws + (off)))

struct ConvItem { const float* src; bf16_t* dst; int ld, ncols, c0, k0, mode, kdim; };
DI int conv_dst_row(int mode, int c) {
    if (mode == 1) return c < DT_COL ? c : (c < DT_COL + 8 ? -1 : c - 8);
    if (mode == 2) { const int j = c >> 1, up = c & 1; return (j >> 7) * 256 + up * 128 + (j & 127); }
    return c;
}
constexpr int N_S5I = DEPTH * 16 * 4, N_ADA = DEPTH * 48, N_CV_WIN = DEPTH * 41 * 4, N_CV_WOUT = DEPTH * 16 * 4, N_CV_GU = DEPTH * NEXP * 32 * 4,
              N_CV_DN = DEPTH * NEXP * 16 * 4, N_CV_GLU = DEPTH * 4;
constexpr int N_CONV = N_CV_WIN + N_CV_WOUT + N_CV_GLU;
DI ConvItem conv_decode(const Frame& F, int it) {
    ConvItem c; c.kdim = DM;
    if (it < N_CV_WIN) { const int l = it / 164, r = it % 164; c.src = ((const float*)F.in[I_WIN]) + (size_t)l * DM * DIN; c.dst = WSP(bf16_t, WS_WIN) + (size_t)l * NU * DM;
        c.ld = DIN; c.ncols = DIN; c.c0 = (r >> 2) * 64; c.k0 = (r & 3) * 256; c.mode = 1; return c; }
    it -= N_CV_WIN;
    if (it < N_CV_WOUT) { const int l = it / 64, r = it % 64; c.src = ((const float*)F.in[I_WOUT]) + (size_t)l * DM * DM; c.dst = WSP(bf16_t, WS_WOUT) + (size_t)l * DM * DM;
        c.ld = DM; c.ncols = DM; c.c0 = (r >> 2) * 64; c.k0 = (r & 3) * 256; c.mode = 0; return c; }
    it -= N_CV_WOUT;
    { const int l = it / 4, r = it % 4; c.src = ((const float*)F.in[I_WGLU]) + (size_t)l * 256 * 256; c.dst = WSP(bf16_t, WS_WGLU) + (size_t)l * 256 * 256;
      c.ld = 256; c.ncols = 256; c.c0 = r * 64; c.k0 = 0; c.mode = 0; c.kdim = 256; return c; }
}
DI void conv_load(const ConvItem& c, int tid, f32x4 (&v)[8]) {
#pragma unroll
    for (int i = 0; i < 8; ++i) { const int idx = tid + 512 * i, k = idx >> 4, c4 = idx & 15; const int col = c.c0 + 4 * c4;
        v[i] = (col < c.ncols) ? *(const f32x4*)(c.src + (size_t)(c.k0 + k) * c.ld + col) : (f32x4){0.f, 0.f, 0.f, 0.f}; }
}
DI int q_next(const Frame& F, unsigned* ctr) {
    LAS int* slot = (LAS int*)(F.lds + LDS_BYTES - 16);
    __syncthreads();
    if (F.tid == 0) *slot = (int)__hip_atomic_fetch_add(ctr, 1u, __ATOMIC_RELAXED, __HIP_MEMORY_SCOPE_AGENT);
    __syncthreads();
    return *slot;
}
DI void p0_convert(const Frame& F, unsigned* ctr) {
    LAS float* T = (LAS float*)F.lds;
    const int tid = F.tid;
    f32x4 v[8];
    int it = q_next(F, ctr);
    if (it >= N_CONV) return;
    ConvItem cur = conv_decode(F, it);
    conv_load(cur, tid, v);
    for (;;) {
#pragma unroll
        for (int i = 0; i < 8; ++i) { const int idx = tid + 512 * i, k = idx >> 4, c4 = idx & 15;
            T[k * 65 + 4 * c4 + 0] = v[i][0]; T[k * 65 + 4 * c4 + 1] = v[i][1]; T[k * 65 + 4 * c4 + 2] = v[i][2]; T[k * 65 + 4 * c4 + 3] = v[i][3]; }
        __syncthreads();
        const int nit = q_next(F, ctr); const bool has_next = nit < N_CONV;
        ConvItem nxt = cur;
        if (has_next) { nxt = conv_decode(F, nit); conv_load(nxt, tid, v); }
#pragma unroll
        for (int i = 0; i < 4; ++i) { const int task = tid + 512 * i, c = task & 63, kc = task >> 6;
            const int col = cur.c0 + c; const int row = (col < cur.ncols) ? conv_dst_row(cur.mode, col) : -1;
            u32x4 o;
#pragma unroll
            for (int j = 0; j < 4; ++j) o[j] = pk2(T[(8 * kc + 2 * j) * 65 + c], T[(8 * kc + 2 * j + 1) * 65 + c]);
            if (row >= 0) *(u32x4*)(cur.dst + (size_t)row * cur.kdim + cur.k0 + 8 * kc) = o; }
        __syncthreads();
        if (!has_next) break;
        cur = nxt; it = nit;
    }
}
DI void p0_adaln(const Frame& F, int item) {
    const int l = item / 48, col0 = (item % 48) * 128, tid = F.tid, part = tid >> 5, ct = tid & 31;
    const float* W = ((const float*)F.in[I_WADA]) + (size_t)l * DM * 6144 + col0 + 4 * ct;
    const float* cl = ((const float*)F.in[I_C]); const float* cc = ((const float*)F.in[I_CCTX]);
    f32x4 al = {0.f, 0.f, 0.f, 0.f}, ac = {0.f, 0.f, 0.f, 0.f};
#pragma unroll 8
    for (int kk = 0; kk < 64; ++kk) { const int k = part * 64 + kk; const f32x4 w = *(const f32x4*)(W + (size_t)k * 6144);
        const float sl = silu_f(cl[k]), sc = silu_f(cc[k]); al += w * sl; ac += w * sc; }
    LAS float* R = (LAS float*)F.lds;
#pragma unroll
    for (int j = 0; j < 4; ++j) { R[(part * 32 + ct) * 8 + j] = al[j]; R[(part * 32 + ct) * 8 + 4 + j] = ac[j]; }
    __syncthreads();
    if (tid < 256) { const int v = tid >> 7, col = tid & 127; float s = 0.f;
#pragma unroll
        for (int p = 0; p < 16; ++p) s += R[(p * 32 + (col >> 2)) * 8 + v * 4 + (col & 3)];
        WSP(float, WS_MOD)[((size_t)l * 2 + v) * 6144 + col0 + col] = s + ((const float*)F.in[I_BADA])[(size_t)l * 6144 + col0 + col]; }
    __syncthreads();
}
DI void p0_rope(const Frame& F) {
    f32x2* rd = WSP(f32x2, WS_ROPE); f32x2* rg = rd + 256 * 8;
    for (int i = F.tid; i < 256 * 8; i += 512) { const int pos = i >> 3, f = i & 7; const float inv = exp2f(-(float)(2 * f) / 16.f * 13.287712379549449f);
        float s, c; sincosf((float)pos * inv, &s, &c); rd[i] = (f32x2){c, s}; }
    if (F.tid < DEPTH) { const int l = F.tid; float s1 = 0.f, s2 = 0.f;
        for (int i = 0; i < 32; ++i) { s1 += ((const float*)F.in[I_LQ1])[l * 32 + i] * ((const float*)F.in[I_LK1])[l * 32 + i]; s2 += ((const float*)F.in[I_LQ2])[l * 32 + i] * ((const float*)F.in[I_LK2])[l * 32 + i]; }
        WSP(float, WS_LAM)[l] = __expf(s1) - __expf(s2) + (0.8f - 0.6f * __expf(-0.3f * (float)l)); }
    for (int i = F.tid; i < 256 * 16; i += 512) { const int pos = i >> 4, f = i & 15; const float inv = exp2f(-(float)(2 * f) / 32.f * 13.287712379549449f);
        float s, c; sincosf((float)pos * inv, &s, &c); rg[i] = (f32x2){c, s}; }
}
DI f32x2 cmul(f32x2 a, f32x2 b) { return (f32x2){a.x * b.x - a.y * b.y, a.x * b.y + a.y * b.x}; }
DI void p0_s5(const Frame& F, int item4) {
    const int item = item4 >> 2, part = item4 & 3;
    const int l = item >> 4, g = item & 15, tid = F.tid;
    LAS f32x2* PW = (LAS f32x2*)F.lds;
    LAS f32x2* BB = PW + 2 * 65 * 64;
    LAS f32x2* CM = BB + 2 * 64 * 16;
    LAS float* D0 = (LAS float*)(CM + 2 * 16 * 64);
    for (int i = tid; i < 2 * 65 * 64; i += 512) { const int dir = i / (65 * 64), n = (i / 64) % 65, p = i & 63;
        const size_t li = (((size_t)l * 2 + dir) * 16 + g) * 64 + p;
        const float step = __expf(((const float*)F.in[I_LOGDT])[((size_t)l * 2 + dir) * 16 + g]);
        const float tr = ((const float*)F.in[I_LAMRE])[li] * step, ti = ((const float*)F.in[I_LAMIM])[li] * step;
        float s, c; sincosf((float)n * ti, &s, &c); const float m = __expf((float)n * tr); PW[i] = (f32x2){m * c, m * s}; }
    __syncthreads();
    for (int i = tid; i < 2 * 64 * 16; i += 512) { const int dir = i >> 10, p = (i >> 4) & 63, c = i & 15;
        const size_t li = (((size_t)l * 2 + dir) * 16 + g) * 64 + p;
        const f32x2 lam = {((const float*)F.in[I_LAMRE])[li], ((const float*)F.in[I_LAMIM])[li]}; const f32x2 a = PW[(dir * 65 + 1) * 64 + p];
        const f32x2 num = {a.x - 1.f, a.y}; const float den = lam.x * lam.x + lam.y * lam.y;
        const f32x2 q = {(num.x * lam.x + num.y * lam.y) / den, (num.y * lam.x - num.x * lam.y) / den};
        const size_t bi = (((size_t)l * 16 + g) * 64 + p) * 16 + c;
        BB[i] = cmul(q, (f32x2){((const float*)F.in[I_BRE])[bi], ((const float*)F.in[I_BIM])[bi]}); }
    for (int i = tid; i < 2 * 16 * 64; i += 512) { const int dir = i >> 10, c = (i >> 6) & 15, p = i & 63;
        const size_t ci = ((((size_t)l * 2 + dir) * 16 + g) * 16 + c) * 64 + p; CM[i] = (f32x2){((const float*)F.in[I_CRE])[ci], ((const float*)F.in[I_CIM])[ci]}; }
    __syncthreads();
    bf16_t* kt = WSP(bf16_t, WS_KTAB) + ((size_t)l * 16 + g) * 3 * 64 * 256;
    {
        const int dir = part >> 1, lag0 = (part & 1) * 32 + (tid >> 8), c = (tid >> 4) & 15, cp = tid & 15;
        float sk[16];
#pragma unroll
        for (int k = 0; k < 16; ++k) sk[k] = 0.f;
#pragma unroll 2
        for (int p = 0; p < 64; ++p) { const f32x2 tq = cmul(CM[(dir * 16 + c) * 64 + p], BB[(dir * 64 + p) * 16 + cp]);
#pragma unroll
            for (int k = 0; k < 16; ++k) { const f32x2 pw = PW[(dir * 65 + lag0 + 2 * k) * 64 + p]; sk[k] += tq.x * pw.x - tq.y * pw.y; } }
#pragma unroll
        for (int k = 0; k < 16; ++k) kt[part * 8192 + tid + 512 * k] = f2bf(sk[k]); }
    __syncthreads();
    if (part == 0) for (int i = tid; i < 256; i += 512) { const int c = i >> 4, cp = i & 15; float s = 0.f;
        for (int dir = 0; dir < 2; ++dir) for (int p = 0; p < 64; ++p) { const f32x2 w = BB[(dir * 64 + p) * 16 + cp]; const f32x2 cm = CM[(dir * 16 + c) * 64 + p]; s += cm.x * w.x - cm.y * w.y; }
        kt[2 * 64 * 256 + i] = f2bf(s + (c == cp ? ((const float*)F.in[I_S5D])[(size_t)l * 256 + g * 16 + c] : 0.f)); }
    bf16_t* e5 = WSP(bf16_t, WS_E5) + ((size_t)l * 16 + g) * 2 * 128 * 1024;
    for (int k = 0; k < 16; ++k) { const int j = part * 8192 + tid + 512 * k, cp0 = (j & 1) * 8, sq = (j >> 1) & 63, m = (j >> 7) & 127, dir = j >> 14, p = m & 63;
        const int n = dir ? sq : 63 - sq; const f32x2 pw = PW[(dir * 65 + n) * 64 + p];
        const LAS f32x4* b4 = (const LAS f32x4*)(BB + (dir * 64 + p) * 16 + cp0); float o[8];
#pragma unroll
        for (int q = 0; q < 4; ++q) { const f32x4 bv = b4[q];
            o[2 * q] = m < 64 ? pw.x * bv[0] - pw.y * bv[1] : pw.x * bv[1] + pw.y * bv[0]; o[2 * q + 1] = m < 64 ? pw.x * bv[2] - pw.y * bv[3] : pw.x * bv[3] + pw.y * bv[2]; }
        u32x4 w; w[0] = pk2(o[0], o[1]); w[1] = pk2(o[2], o[3]); w[2] = pk2(o[4], o[5]); w[3] = pk2(o[6], o[7]); *(u32x4*)(e5 + ((((size_t)(dir * 4 + (m >> 5)) * 64 + sq) * 64 + ((cp0 >> 3) * 32 + (m & 31))) * 8)) = w; }
    bf16_t* cc5 = WSP(bf16_t, WS_CC5) + ((size_t)l * 16 + g) * 1024 * 256;
    for (int k = 0; k < 16; ++k) { const int j = part * 8192 + tid + 512 * k, p0 = (j & 7) * 8, im = (j >> 3) & 1, dir = (j >> 4) & 1, row = j >> 5, t = row >> 4, c = row & 15;
        const int n = dir ? 64 - t : t + 1;
        const LAS f32x4* c4 = (const LAS f32x4*)(CM + (dir * 16 + c) * 64 + p0); const LAS f32x4* p4 = (const LAS f32x4*)(PW + (dir * 65 + n) * 64 + p0); float o[8];
#pragma unroll
        for (int q = 0; q < 4; ++q) { const f32x4 cv = c4[q], pv = p4[q];
            o[2 * q] = im ? -(cv[0] * pv[1] + cv[1] * pv[0]) : cv[0] * pv[0] - cv[1] * pv[1]; o[2 * q + 1] = im ? -(cv[2] * pv[3] + cv[3] * pv[2]) : cv[2] * pv[2] - cv[3] * pv[3]; }
        u32x4 w; w[0] = pk2(o[0], o[1]); w[1] = pk2(o[2], o[3]); w[2] = pk2(o[4], o[5]); w[3] = pk2(o[6], o[7]); *(u32x4*)(cc5 + ((((size_t)(row >> 5) * 16 + (p0 >> 4) + 4 * im + 8 * dir) * 64 + (((p0 >> 3) & 1) * 32 + (row & 31))) * 8)) = w; }
    f32x2* ap = WSP(f32x2, WS_APOW) + ((size_t)l * 16 + g) * 128;
    if (part == 0) for (int i = tid; i < 128; i += 512) ap[i] = PW[((i >> 6) * 65 + 64) * 64 + (i & 63)];
    __syncthreads();
}
DI void p0_prologue(const Frame& F, int rep = 0) {
    for (int it = F.bid; it < N_S5I; it += F.G) p0_s5(F, it);
    unsigned* qa = WSP(unsigned, WS_CTL) + CW_Q0 + 64 * (20 + rep);
    for (;;) { const int it = q_next(F, qa); if (it > N_ADA) break; if (it < N_ADA) p0_adaln(F, it); else p0_rope(F); }
    __syncthreads();
    p0_convert(F, WSP(unsigned, WS_CTL) + CW_Q0 + 64 * rep);
}

constexpr int RPB = 65;
DI int moe_tables(const Frame& F, int l);
template <bool FINAL>
DI void p1_norm(const Frame& F, int l) {
    if (l > 0) (void)moe_tables(F, l - 1);
    const LAS int* PSTL = (const LAS int*)(F.lds + LDS_MISC);
    LAS float* WDT = (LAS float*)F.lds;
    if (!FINAL) {
        for (int i = F.tid; i < 1024 * 8; i += 512) WDT[i] = ((const float*)F.in[I_WIN])[(size_t)l * DM * DIN + (size_t)(i >> 3) * DIN + DT_COL + (i & 7)];
        __syncthreads();
    }
    const float* mod_cur = WSP(float, WS_MOD) + (size_t)(FINAL ? 0 : l) * 2 * 6144;
    const float* mod_prev = WSP(float, WS_MOD) + (size_t)(l > 0 ? l - 1 : 0) * 2 * 6144;
    const int lane = F.lane;
    for (int r = F.wave; r < RPB; r += 8) {
        const int row = F.bid * RPB + r; if (row >= NT) break;
        const int v = row < CTX ? 1 : 0;
        if (FINAL && v) continue;
        f32x4 x[4];
        if (l == 0) {
            const float* src = v ? ((const float*)F.in[I_CTX]) + (size_t)row * DM : ((const float*)F.in[I_X]) + (size_t)(row - CTX) * DM;
#pragma unroll
            for (int i = 0; i < 4; ++i) x[i] = *(const f32x4*)(src + 256 * i + 4 * lane);
        } else {
            const float* x1 = WSP(float, WS_XA) + (size_t)row * DM;
            const int* tope = WSP(int, WS_TOPE) + (size_t)row * 4; const int* topp = WSP(int, WS_TOPP) + (size_t)row * 4; const float* gates = WSP(float, WS_TOPG) + (size_t)row * 4;
            const float* g2 = mod_prev + (size_t)v * 6144 + 5 * 1024;
            int sl[4]; float ga[4];
#pragma unroll
            for (int k = 0; k < 4; ++k) { sl[k] = PSTL[tope[k]] + topp[k]; ga[k] = gates[k]; }
#pragma unroll
            for (int i = 0; i < 4; ++i) { const int col = 256 * i + 4 * lane; f32x4 acc = {0.f, 0.f, 0.f, 0.f};
#pragma unroll
                for (int k = 0; k < 4; ++k) { const u32x2 y = *(const u32x2*)(WSP(bf16_t, WS_YB) + (size_t)sl[k] * DM + col);
                    acc[0] += ga[k] * bflo(y[0]); acc[1] += ga[k] * bfhi(y[0]); acc[2] += ga[k] * bflo(y[1]); acc[3] += ga[k] * bfhi(y[1]); }
                x[i] = *(const f32x4*)(x1 + col) + *(const f32x4*)(g2 + col) * acc;
                if (!FINAL) *(f32x4*)(WSP(float, WS_XB) + (size_t)row * DM + col) = x[i]; }
        }
        float ss = 0.f;
#pragma unroll
        for (int i = 0; i < 4; ++i) ss += x[i][0] * x[i][0] + x[i][1] * x[i][1] + x[i][2] * x[i][2] + x[i][3] * x[i][3];
        ss = wave_sum(ss);
        const float rs = __builtin_amdgcn_rsqf(ss * (1.f / 1024.f) + EPS);
        if (FINAL) {
#pragma unroll
            for (int i = 0; i < 4; ++i) { const int col = 256 * i + 4 * lane; *(f32x4*)(F.out + (size_t)(row - CTX) * DM + col) = x[i] * rs * *(const f32x4*)(((const float*)F.in[I_FNW]) + col); }
        } else {
            const float* nw = ((const float*)F.in[I_N1W]) + (size_t)l * DM; const float* sh = mod_cur + (size_t)v * 6144; const float* sc = sh + 1024;
            float d[8] = {0.f, 0.f, 0.f, 0.f, 0.f, 0.f, 0.f, 0.f};
#pragma unroll
            for (int i = 0; i < 4; ++i) { const int col = 256 * i + 4 * lane;
                const f32x4 h = x[i] * rs * *(const f32x4*)(nw + col) * (*(const f32x4*)(sc + col) + 1.f) + *(const f32x4*)(sh + col);
                u32x2 o; o[0] = pk2(h[0], h[1]); o[1] = pk2(h[2], h[3]);
                *(u32x2*)(WSP(bf16_t, WS_H) + (size_t)row * DM + col) = o;
#pragma unroll
                for (int c = 0; c < 4; ++c) { const f32x4 w0 = *(const LAS f32x4*)(WDT + (col + c) * 8), w1 = *(const LAS f32x4*)(WDT + (col + c) * 8 + 4);
#pragma unroll
                    for (int j = 0; j < 4; ++j) { d[j] += h[c] * w0[j]; d[4 + j] += h[c] * w1[j]; } } }
#pragma unroll
            for (int j = 0; j < 8; ++j) d[j] = wave_sum(d[j]);
            if (lane == 0) { float* o = WSP(float, WS_DTRAW) + (size_t)row * 8;
                *(f32x4*)o = (f32x4){d[0], d[1], d[2], d[3]}; *(f32x4*)(o + 4) = (f32x4){d[4], d[5], d[6], d[7]}; }
        }
    }
    __syncthreads();
}

constexpr int WR_PITCH = 36;
DI void p7a_router(const Frame& F, int l, int rep = 0) {
    LAS float* WR = (LAS float*)F.lds;
    LAS int* CNT = (LAS int*)(F.lds + 1024 * WR_PITCH * 4);
    LAS int* BASE = CNT + 32;
    LAS int* RI = BASE + 32;
    for (int i = F.tid; i < 1024 * 8; i += 512) *(LAS f32x4*)(WR + (i >> 3) * WR_PITCH + 4 * (i & 7)) = *(const f32x4*)(((const float*)F.in[I_WR]) + (size_t)l * DM * 32 + 4 * i);
    if (F.tid < 32) CNT[F.tid] = 0;
    __syncthreads();
    const int lane = F.lane;
    const float* mod = WSP(float, WS_MOD) + (size_t)l * 2 * 6144;
    const float* nw = ((const float*)F.in[I_N2W]) + (size_t)l * DM;
    const float br = ((const float*)F.in[I_BR])[(size_t)l * 32 + ((((lane >> 3) & 1) << 4) | (((lane >> 2) & 1) << 3) | (((lane >> 1) & 1) << 2) | ((lane & 1) << 1) | ((lane >> 5) & 1))];
    auto finish_row = [&](const f32x4 (&lgv)[8], int r, bool valid) __attribute__((always_inline)) {
        float lg[32];
#pragma unroll
        for (int q = 0; q < 8; ++q) { lg[4 * q] = lgv[q][0]; lg[4 * q + 1] = lgv[q][1]; lg[4 * q + 2] = lgv[q][2]; lg[4 * q + 3] = lgv[q][3]; }
        float a16[16], a8[8], a4[4], a2[2], a1;
        { const bool up = lane & 8;
#pragma unroll
          for (int j = 0; j < 16; ++j) { const float send = up ? lg[j] : lg[16 + j]; const float keep = up ? lg[16 + j] : lg[j]; a16[j] = keep + dppf<0x140>(send); } }
        { const bool up = lane & 4;
#pragma unroll
          for (int j = 0; j < 8; ++j) { const float send = up ? a16[j] : a16[8 + j]; const float keep = up ? a16[8 + j] : a16[j]; a8[j] = keep + dppf<0x141>(send); } }
        { const bool up = lane & 2;
#pragma unroll
          for (int j = 0; j < 4; ++j) { const float send = up ? a8[j] : a8[4 + j]; const float keep = up ? a8[4 + j] : a8[j]; a4[j] = keep + dppf<0x4E>(send); } }
        { const bool up = lane & 1;
#pragma unroll
          for (int j = 0; j < 2; ++j) { const float send = up ? a4[j] : a4[2 + j]; const float keep = up ? a4[2 + j] : a4[j]; a2[j] = keep + dppf<0xB1>(send); } }
        { const bool up = lane & 32; const float send = up ? a2[0] : a2[1]; const float keep = up ? a2[1] : a2[0]; a1 = keep + __shfl_xor(send, 32); }
        a1 += __shfl_xor(a1, 16);
        const int myexp = (((lane >> 3) & 1) << 4) | (((lane >> 2) & 1) << 3) | (((lane >> 1) & 1) << 2) | ((lane & 1) << 1) | ((lane >> 5) & 1);
        float val = a1 + br;
        int te[4]; float tv[4];
#pragma unroll
        for (int k = 0; k < 4; ++k) { const float m = wave_max(val); const unsigned long long bal = __ballot(val == m); const int sel = (int)__ffsll((long long)bal) - 1;
            te[k] = (((sel >> 3) & 1) << 4) | (((sel >> 2) & 1) << 3) | (((sel >> 1) & 1) << 2) | ((sel & 1) << 1) | ((sel >> 5) & 1); tv[k] = m; if (myexp == te[k]) val = -INFINITY; }
        if (lane == 0 && valid) { float g[4], s = 0.f;
#pragma unroll
            for (int k = 0; k < 4; ++k) { g[k] = __expf(tv[k] - tv[0]); s += g[k]; }
#pragma unroll
            for (int k = 0; k < 4; ++k) { const int pos = atomicAdd((int*)&CNT[te[k]], 1); RI[(r * 4 + k) * 3 + 0] = te[k]; RI[(r * 4 + k) * 3 + 1] = pos; RI[(r * 4 + k) * 3 + 2] = __float_as_int(g[k] / s); } }
    };
    for (int r0 = F.wave; r0 < RPB; r0 += 16) {
        const int rowA = F.bid * RPB + r0; if (rowA >= NT) break;
        const bool hasB = (r0 + 8 < RPB) && (rowA + 8 < NT);
        const int rowB = hasB ? rowA + 8 : rowA;
        const float* xA = WSP(float, WS_XA) + (size_t)rowA * DM; const float* shA = mod + (size_t)(rowA < CTX ? 1 : 0) * 6144 + 3 * 1024; const float* scA = shA + 1024;
        const float* xB = WSP(float, WS_XA) + (size_t)rowB * DM; const float* shB = mod + (size_t)(rowB < CTX ? 1 : 0) * 6144 + 3 * 1024; const float* scB = shB + 1024;
        f32x4 xa[4], xb[4]; float ssA = 0.f, ssB = 0.f;
#pragma unroll
        for (int i = 0; i < 4; ++i) { xa[i] = *(const f32x4*)(xA + 256 * i + 4 * lane); xb[i] = *(const f32x4*)(xB + 256 * i + 4 * lane);
            ssA += xa[i][0] * xa[i][0] + xa[i][1] * xa[i][1] + xa[i][2] * xa[i][2] + xa[i][3] * xa[i][3];
            ssB += xb[i][0] * xb[i][0] + xb[i][1] * xb[i][1] + xb[i][2] * xb[i][2] + xb[i][3] * xb[i][3]; }
        ssA = wave_sum(ssA); ssB = wave_sum(ssB);
        const float rsA = __builtin_amdgcn_rsqf(ssA * (1.f / 1024.f) + EPS), rsB = __builtin_amdgcn_rsqf(ssB * (1.f / 1024.f) + EPS);
        f32x4 lgA[8], lgB[8];
#pragma unroll
        for (int q = 0; q < 8; ++q) { lgA[q] = (f32x4){0.f, 0.f, 0.f, 0.f}; lgB[q] = (f32x4){0.f, 0.f, 0.f, 0.f}; }
#pragma unroll
        for (int i = 0; i < 4; ++i) { const int col = 256 * i + 4 * lane; const f32x4 nwv = *(const f32x4*)(nw + col);
            xa[i] = xa[i] * rsA * nwv * (*(const f32x4*)(scA + col) + 1.f) + *(const f32x4*)(shA + col);
            xb[i] = xb[i] * rsB * nwv * (*(const f32x4*)(scB + col) + 1.f) + *(const f32x4*)(shB + col);
            { u32x2 o; o[0] = pk2(xa[i][0], xa[i][1]); o[1] = pk2(xa[i][2], xa[i][3]); *(u32x2*)(WSP(bf16_t, WS_H) + (size_t)rowA * DM + col) = o; }
            if (hasB) { u32x2 o; o[0] = pk2(xb[i][0], xb[i][1]); o[1] = pk2(xb[i][2], xb[i][3]); *(u32x2*)(WSP(bf16_t, WS_H) + (size_t)rowB * DM + col) = o; } }
        __builtin_amdgcn_sched_barrier(0);
#pragma unroll
        for (int i = 0; i < 4; ++i) { const int col = 256 * i + 4 * lane;
#pragma unroll
            for (int c = 0; c < 4; ++c) {
                f32x4 w0[8];
#pragma unroll
                for (int q = 0; q < 8; ++q) w0[q] = *(const LAS f32x4*)(WR + (col + c) * WR_PITCH + 4 * q);
#pragma unroll
                for (int q = 0; q < 8; ++q) { lgA[q] += w0[q] * xa[i][c]; lgB[q] += w0[q] * xb[i][c]; }
#pragma unroll
                for (int q = 0; q < 8; ++q) asm volatile("" : "+v"(lgA[q]), "+v"(lgB[q]));
                } }
        finish_row(lgA, r0, true);
        finish_row(lgB, r0 + 8, hasB);
    }
    __syncthreads();
    if (F.tid < 32) BASE[F.tid] = (int)__hip_atomic_fetch_add(WSP(unsigned, WS_CTL) + (rep ? 4500 : CW_CNT) + l * 32 + F.tid, (unsigned)CNT[F.tid], __ATOMIC_RELAXED, __HIP_MEMORY_SCOPE_AGENT);
    __syncthreads();
    if (F.tid < RPB * 4) { const int r = F.tid >> 2, row = F.bid * RPB + r;
        if (row < NT) { const int e = RI[F.tid * 3], pos = RI[F.tid * 3 + 1];
            WSP(int, WS_TOPE)[(size_t)row * 4 + (F.tid & 3)] = e; WSP(int, WS_TOPP)[(size_t)row * 4 + (F.tid & 3)] = BASE[e] + pos; WSP(int, WS_TOPS)[(size_t)e * NT + BASE[e] + pos] = row; WSP(int, WS_TOPG)[(size_t)row * 4 + (F.tid & 3)] = RI[F.tid * 3 + 2]; } }
    __syncthreads();
}

DI int moe_tables(const Frame& F, int l) {
    LAS int* PST = (LAS int*)(F.lds + LDS_MISC);
    LAS int* T2E = PST + 64;
    __syncthreads();
    if (F.tid < 64) { const int e = F.tid & 31; const int c = (int)__hip_atomic_load(WSP(unsigned, WS_CTL) + CW_CNT + l * 32 + e, __ATOMIC_RELAXED, __HIP_MEMORY_SCOPE_AGENT);
        const int pad = (c + 255) & ~255; int incl = pad;
#pragma unroll
        for (int o = 1; o < 32; o <<= 1) { const int t = __shfl_up(incl, o, 32); if (e >= o) incl += t; }
        if (F.tid < 32) { PST[e] = incl - pad; if (e == 31) PST[32] = incl; PST[64 + 300 + e] = c; } }
    __syncthreads();
    const int ntiles = PST[32] >> 8;
    for (int r = F.tid; r < ntiles; r += 512) { int e = 0;
        for (int q = 1; q < 32; ++q) if (PST[q] <= r * 256) e = q;
        T2E[r] = e; }
    __syncthreads();
    return ntiles;
}
struct MoeOrder {
    int nN, ntiles, G, c; const LAS int* t2e; long estride;
#ifndef MOE_XMAJOR
#define MOE_XMAJOR 1
#endif
    DI bool unit(int i, int& pm, int& pn) const { const int j = c >> 3, per = G / nN, sh = (nN == 8) ? 3 : 2;
        pm = MOE_XMAJOR ? i * per + (c & 7) * (per >> 3) + (j >> sh) : i * per + (j >> sh) * 8 + (c & 7); pn = j & (nN - 1); return pm < ntiles; }
    DI bool next(int i, pg8::Unit& u) const { int pm, pn; if (!unit(i, pm, pn)) return false; u.pm = pm; u.pn = pn; u.boff = (long)t2e[pm] * estride; return true; }
    DI void a_ready(const pg8::Unit&) const {}
    DI void done(const pg8::Unit&) const {}
};
#ifndef STAG_INTRA
#define STAG_INTRA 1
#endif
DI void xcd_stagger(const Frame& F, int step_ticks) {
    const unsigned dl = (unsigned)(STAG_INTRA ? (F.bid >> 3) : (F.bid & 7)) * (unsigned)step_ticks;
    const unsigned long long t0 = __builtin_amdgcn_s_memrealtime();
    while ((unsigned)(__builtin_amdgcn_s_memrealtime() - t0) < dl) __builtin_amdgcn_s_sleep(32);
}
DI void moe_rows(const Frame& F, int l, int ntiles, int nN) {
    const LAS int* PST = (const LAS int*)(F.lds + LDS_MISC); const LAS int* T2E = PST + 64; const LAS int* CNTL = PST + 64 + 300;
    LAS int* ROWS = (LAS int*)(F.lds + LDS_MISC + 2048);
    const MoeOrder S{nN, ntiles, F.G, F.bid, T2E, 0};
    (void)l;
    int val[5]; bool ok[5], inb[5];
#pragma unroll
    for (int k = 0; k < 5; ++k) { const int idx = F.tid + 512 * k, i = idx >> 8, r = idx & 255; int pm, pn;
        ok[k] = S.unit(i, pm, pn); const int e = T2E[ok[k] ? pm : 0], p = ((ok[k] ? pm : 0) - (PST[e] >> 8)) * 256 + r;
        inb[k] = ok[k] && p < CNTL[e]; val[k] = WSP(int, WS_TOPS)[(size_t)e * NT + (inb[k] ? p : 0)]; }
#pragma unroll
    for (int k = 0; k < 5; ++k) if (ok[k]) ROWS[F.tid + 512 * k] = inb[k] ? val[k] : 0;
    __syncthreads();
}

constexpr int LDS_BIASL = LDS_MISC + 2048 + 10 * 1024;
DI void moe_bias(const Frame& F, int ntiles, int nN, const float* bias, int estride) {
    const LAS int* PST = (const LAS int*)(F.lds + LDS_MISC); const LAS int* T2E = PST + 64;
    LAS float* BL = (LAS float*)(F.lds + LDS_BIASL);
    const MoeOrder S{nN, ntiles, F.G, F.bid, T2E, 0};
    float val[5]; bool ok[5];
#pragma unroll
    for (int k = 0; k < 5; ++k) { const int idx = F.tid + 512 * k, i = idx >> 8, r = idx & 255; int pm, pn;
        ok[k] = S.unit(i, pm, pn); val[k] = bias[(size_t)T2E[ok[k] ? pm : 0] * estride + (ok[k] ? pn : 0) * 256 + r]; }
#pragma unroll
    for (int k = 0; k < 5; ++k) if (ok[k]) BL[F.tid + 512 * k] = val[k];
    __syncthreads();
}

#ifndef EPI_NT
#define EPI_NT 0
#endif
#if EPI_NT
#define EPI_STORE(p, v) __builtin_nontemporal_store((v), (p))
#else
#define EPI_STORE(p, v) (*(p) = (v))
#endif
struct EpiU {
    static constexpr bool PERM = true, AFTER_DRAIN = false;
    bf16_t* O; int ldc; bf16_t* us5;
    DI void operator()(const pg8::f32x4 (&acc)[2][2][4][2], const pg8::Unit& u, int wr, int wc, int fr, int fq) const {
        const int row0 = u.pm * 256 + wr * 64 + fr, col0 = u.pn * 256 + wc * 32 + 8 * fq;
        const bool s5 = (u.pn == U_S5 / 256);
#pragma unroll
        for (int ai = 0; ai < 2; ++ai)
#pragma unroll
            for (int m = 0; m < 4; ++m) { const int row = row0 + ai * 128 + m * 16; bf16_t* rowp = O + (size_t)row * ldc + col0;
#pragma unroll
                for (int bj = 0; bj < 2; ++bj) { const pg8::f32x4 v0 = acc[ai][bj][m][0], v1 = acc[ai][bj][m][1];
                    u32x4 w; w[0] = pk2(v0[0], v0[1]); w[1] = pk2(v0[2], v0[3]); w[2] = pk2(v1[0], v1[1]); w[3] = pk2(v1[2], v1[3]);
                    const int cl = wc * 32 + 8 * fq + bj * 128;
                    bf16_t* dst = s5 ? us5 + ((size_t)(cl >> 4) * NT + row) * 16 + (cl & 15) : rowp + bj * 128;
                    EPI_STORE((u32x4*)dst, w); } }
    }
};
struct EpiRes {
    static constexpr bool PERM = false, AFTER_DRAIN = false;
    float* C; const float* res_lat; const float* res_ctx; const float* g1;
    DI void operator()(const pg8::f32x4 (&acc)[2][2][4][2], const pg8::Unit& u, int wr, int wc, int fr, int fq) const {
        const int row0 = CTX + u.pm * 256 + wr * 64 + fr, col0 = u.pn * 256 + wc * 32 + 4 * fq;
        const float* g = g1; (void)res_ctx;
        pg8::f32x4 gv[2][2];
#pragma unroll
        for (int bj = 0; bj < 2; ++bj)
#pragma unroll
            for (int n = 0; n < 2; ++n) gv[bj][n] = *(const pg8::f32x4*)(g + col0 + bj * 128 + n * 16);
#pragma unroll
        for (int ai = 0; ai < 2; ++ai) {
            pg8::f32x4 rv[4][2][2];
#pragma unroll
            for (int m = 0; m < 4; ++m) { const float* rp = res_lat + (size_t)(row0 + ai * 128 + m * 16 - CTX) * DM + col0;
#pragma unroll
                for (int bj = 0; bj < 2; ++bj)
#pragma unroll
                    for (int n = 0; n < 2; ++n) rv[m][bj][n] = *(const pg8::f32x4*)(rp + bj * 128 + n * 16); }
            asm volatile("" :: "v"(rv[0][0][0]), "v"(rv[1][0][0]), "v"(rv[2][0][0]), "v"(rv[3][0][0]), "v"(rv[0][1][1]), "v"(rv[1][1][1]), "v"(rv[2][1][1]), "v"(rv[3][1][1]));
#pragma unroll
            for (int m = 0; m < 4; ++m) { float* cp = C + (size_t)(row0 + ai * 128 + m * 16) * DM + col0;
#pragma unroll
                for (int bj = 0; bj < 2; ++bj)
#pragma unroll
                    for (int n = 0; n < 2; ++n) *(pg8::f32x4*)(cp + bj * 128 + n * 16) = rv[m][bj][n] + gv[bj][n] * acc[ai][bj][m][n]; }
        }
    }
};
struct EpiAct {
    static constexpr bool PERM = true, AFTER_DRAIN = false;
    bf16_t* O; const LAS float* biasl;
    mutable int cnt = 0;
    DI void operator()(const pg8::f32x4 (&acc)[2][2][4][2], const pg8::Unit& u, int wr, int wc, int fr, int fq) const {
        const int row0 = u.pm * 256 + wr * 64 + fr, j0 = u.pn * 128 + wc * 32 + 8 * fq;
        const LAS float* b = biasl + cnt * 256 + 2 * (wc * 32 + 8 * fq); ++cnt;
        pg8::f32x4 bg[2], bu[2];
#pragma unroll
        for (int n = 0; n < 2; ++n) { const pg8::f32x4 t0 = *(const LAS pg8::f32x4*)(b + 8 * n), t1 = *(const LAS pg8::f32x4*)(b + 8 * n + 4);
            bg[n] = (pg8::f32x4){t0[0], t0[2], t1[0], t1[2]}; bu[n] = (pg8::f32x4){t0[1], t0[3], t1[1], t1[3]}; }
#pragma unroll
        for (int ai = 0; ai < 2; ++ai)
#pragma unroll
            for (int m = 0; m < 4; ++m) { bf16_t* rowp = O + (size_t)(row0 + ai * 128 + m * 16) * DM + j0; float a[8];
#pragma unroll
                for (int n = 0; n < 2; ++n) { const pg8::f32x4 gq = acc[ai][0][m][n] + bg[n], uq = acc[ai][1][m][n] + bu[n];
#pragma unroll
                    for (int j = 0; j < 4; ++j) { const float gg = fminf(gq[j], 7.f), uu = fminf(fmaxf(uq[j], -7.f), 7.f); a[4 * n + j] = gg * sigmoid_f(1.702f * gg) * (uu + 1.f); } }
                u32x4 w; w[0] = pk2(a[0], a[1]); w[1] = pk2(a[2], a[3]); w[2] = pk2(a[4], a[5]); w[3] = pk2(a[6], a[7]); EPI_STORE((u32x4*)rowp, w); }
    }
};
struct EpiDown {
    static constexpr bool PERM = true, AFTER_DRAIN = false;
    bf16_t* O; const LAS float* biasl;
    int skip = 0;
    bf16_t* dump = nullptr;
    mutable int cnt = 0;
    DI void operator()(const pg8::f32x4 (&acc)[2][2][4][2], const pg8::Unit& u, int wr, int wc, int fr, int fq) const {
#ifdef PH_REP
        if (skip == 3) {
            bf16_t* dp = dump + ((size_t)(blockIdx.x * 8 + wr * 4 + wc) * 1024 + (fq * 16 + fr)) * 8;
#pragma unroll
            for (int a = 0; a < 2; ++a)
#pragma unroll
                for (int m = 0; m < 4; ++m)
#pragma unroll
                    for (int b = 0; b < 2; ++b) { const pg8::f32x4 v0 = acc[a][b][m][0], v1 = acc[a][b][m][1];
                        u32x4 w; w[0] = pk2(v0[0], v0[1]); w[1] = pk2(v0[2], v0[3]); w[2] = pk2(v1[0], v1[1]); w[3] = pk2(v1[2], v1[3]);
                        *(u32x4*)(dp + ((a * 4 + m) * 2 + b) * 512) = w; }
            return; }
        if (skip == 4) {
            bf16_t* dp = dump + (size_t)blockIdx.x * 65536 + (wr * 64 + fr) * 256 + wc * 32 + 8 * fq;
#pragma unroll
            for (int a = 0; a < 2; ++a)
#pragma unroll
                for (int m = 0; m < 4; ++m)
#pragma unroll
                    for (int b = 0; b < 2; ++b) { const pg8::f32x4 v0 = acc[a][b][m][0], v1 = acc[a][b][m][1];
                        u32x4 w; w[0] = pk2(v0[0], v0[1]); w[1] = pk2(v0[2], v0[3]); w[2] = pk2(v1[0], v1[1]); w[3] = pk2(v1[2], v1[3]);
                        *(u32x4*)(dp + (a * 128 + m * 16) * 256 + b * 128) = w; }
            return; }
        if (skip == 1) {
#pragma unroll
            for (int a = 0; a < 2; ++a)
#pragma unroll
                for (int b = 0; b < 2; ++b)
#pragma unroll
                    for (int m = 0; m < 4; ++m) asm volatile("" :: "v"(acc[a][b][m][0]), "v"(acc[a][b][m][1]));
            return; }
#endif
        const int row0 = u.pm * 256 + wr * 64 + fr, col0 = u.pn * 256 + wc * 32 + 8 * fq;
        const LAS float* b = biasl + cnt * 256 - u.pn * 256; ++cnt;
        pg8::f32x4 bv[2][2];
#pragma unroll
        for (int bj = 0; bj < 2; ++bj)
#pragma unroll
            for (int n = 0; n < 2; ++n) bv[bj][n] = *(const LAS pg8::f32x4*)(b + col0 + bj * 128 + 4 * n);
#pragma unroll
        for (int ai = 0; ai < 2; ++ai)
#pragma unroll
            for (int m = 0; m < 4; ++m) { bf16_t* rowp = O + (size_t)(row0 + ai * 128 + m * 16) * DM + col0;
#pragma unroll
                for (int bj = 0; bj < 2; ++bj) { const pg8::f32x4 v0 = acc[ai][bj][m][0] + bv[bj][0], v1 = acc[ai][bj][m][1] + bv[bj][1];
                    u32x4 w; w[0] = pk2(v0[0], v0[1]); w[1] = pk2(v0[2], v0[3]); w[2] = pk2(v1[0], v1[1]); w[3] = pk2(v1[2], v1[3]);
                    if (skip == 2) asm volatile("" :: "v"(w)); else EPI_STORE((u32x4*)(rowp + bj * 128), w); } }
    }
};

DI void outproj_ctx(const Frame& F, int l, const float* res_ctx) {
    if (F.bid >= 256) return;
    const int mt = F.bid >> 5, nt = F.bid & 31, lane = F.lane, r = lane & 31, h = lane >> 5;
    const bf16_t* A = WSP(bf16_t, WS_MIX) + (size_t)(mt * 32 + r) * DM + F.wave * 128 + 8 * h;
    const bf16_t* B = WSP(bf16_t, WS_WOUT) + (size_t)l * DM * DM + (size_t)(nt * 32 + r) * DM + F.wave * 128 + 8 * h;
    f32x16 acc = splat16(0.f);
#pragma unroll
    for (int ks = 0; ks < 8; ++ks) acc = mfma32(ld8g(A + ks * 16), ld8g(B + ks * 16), acc);
    LAS float* R = (LAS float*)F.lds;
    __syncthreads();
#pragma unroll
    for (int i = 0; i < 16; ++i) R[(F.wave * 16 + i) * 64 + lane] = acc[i];
    __syncthreads();
    for (int e = F.tid; e < 1024; e += 512) { const int i = e >> 6, ln = e & 63; float s = 0.f;
#pragma unroll
        for (int w = 0; w < 8; ++w) s += R[(w * 16 + i) * 64 + ln];
        const int row = mt * 32 + crow(i, ln >> 5), col = nt * 32 + (ln & 31);
        WSP(float, WS_XA)[(size_t)row * DM + col] = res_ctx[(size_t)row * DM + col] + WSP(float, WS_MOD)[(size_t)l * 2 * 6144 + 6144 + 2 * 1024 + col] * s; }
    __syncthreads();
}

template <int DIM> DI void rope_vec(float (&v)[DIM], const f32x2* tab_row, const f32x2* tab_col) {
    constexpr int Q = DIM / 4;
#pragma unroll
    for (int i = 0; i < Q; ++i) { const f32x2 r = tab_row[i], c = tab_col[i];
        const float a = v[i], b = v[Q + i]; v[i] = a * r.x - b * r.y; v[Q + i] = a * r.y + b * r.x;
        const float a2 = v[2 * Q + i], b2 = v[3 * Q + i]; v[2 * Q + i] = a2 * c.x - b2 * c.y; v[3 * Q + i] = a2 * c.y + b2 * c.x; }
}
template <int DIM> DI void load_vec(const bf16_t* p, float (&v)[DIM]) {
#pragma unroll
    for (int i = 0; i < DIM / 8; ++i) { const u32x4 w = *(const u32x4*)(p + 8 * i);
#pragma unroll
        for (int j = 0; j < 4; ++j) { v[8 * i + 2 * j] = bflo(w[j]); v[8 * i + 2 * j + 1] = bfhi(w[j]); } }
}
template <int DIM> DI float store_vec(bf16_t* p, const float (&v)[DIM]) {
    float ss = 0.f;
#pragma unroll
    for (int i = 0; i < DIM / 8; ++i) { u32x4 w;
#pragma unroll
        for (int j = 0; j < 4; ++j) { w[j] = pk2(v[8 * i + 2 * j], v[8 * i + 2 * j + 1]); const float a = bflo(w[j]), b = bfhi(w[j]); ss += a * a + b * b; }
        *(u32x4*)(p + 8 * i) = w; }
    return ss;
}
DI void p3_attn_prep(const Frame& F, int l, int item) {
    LAS unsigned* KMX = (LAS unsigned*)(F.lds + LDS_MISC);
    LAS bf16_t* VS = (LAS bf16_t*)F.lds;
    const int tid = F.tid, tok0 = item * 64;
    if (tid < 32) KMX[tid] = 0u;
    const bf16_t* U = WSP(bf16_t, WS_U);
    for (int i = tid; i < 64 * 48; i += 512) { const int t = i / 48, c8 = i % 48; const int col = c8 < 32 ? U_DV + 8 * c8 : U_GV + 8 * (c8 - 32);
        *(LAS u32x4*)(VS + t * 384 + 8 * c8) = *(const u32x4*)(U + (size_t)(tok0 + t) * NU + col); }
    __syncthreads();
    const f32x2* ropeD = WSP(f32x2, WS_ROPE); const f32x2* ropeG = ropeD + 256 * 8;
    const float qs_d = 0.17677669529663687f * LOG2E, qs_g = 0.125f * LOG2E;
    for (int task = tid; task < 64 * 22; task += 512) {
        int t, vi;
        if (task < 1024) { t = task & 63; vi = task >> 6; } else if (task < 1280) { t = task & 63; vi = 16 + ((task - 1024) >> 6); } else { t = task & 63; vi = 20 + ((task - 1280) >> 6); }
        const int tok = tok0 + t; const bool lat = tok >= CTX; const int pos = tok - CTX, pr = lat ? pos >> 6 : 0, pc = lat ? pos & 63 : 0;
        const bf16_t* urow = U + (size_t)tok * NU;
        if (vi < 16) {
            const bool isk = vi >= 8; const int hm = vi & 7, h = hm >> 1, m = hm & 1;
            float v[32]; load_vec<32>(urow + (isk ? U_DK : U_DQ) + hm * 32, v);
            if (lat) rope_vec<32>(v, ropeD + pr * 8, ropeD + pc * 8);
            if (!isk) {
#pragma unroll
                for (int i = 0; i < 32; ++i) v[i] *= qs_d;
                const float ss = store_vec<32>(WSP(bf16_t, WS_QD) + ((size_t)h * NT + tok) * 64 + m * 32, v);
                WSP(float, WS_QND)[((size_t)h * 2 + m) * NT + tok] = sqrtf(ss);
                __hip_atomic_fetch_max(KMX + 10 + hm, __float_as_uint(ss), __ATOMIC_RELAXED, __HIP_MEMORY_SCOPE_WORKGROUP);
            } else {
                const float ss = store_vec<32>(WSP(bf16_t, WS_KD) + ((size_t)h * NT + tok) * 64 + m * 32, v);
                __hip_atomic_fetch_max(KMX + hm, __float_as_uint(ss), __ATOMIC_RELAXED, __HIP_MEMORY_SCOPE_WORKGROUP);
            }
        } else {
            const bool isk = vi >= 20; const int h = isk ? vi - 20 : vi - 16;
            float v[64]; load_vec<64>(urow + (isk ? U_GK : U_GQ) + h * 64, v);
            float ss = 0.f;
#pragma unroll
            for (int i = 0; i < 64; ++i) ss += v[i] * v[i];
            const float rs = __builtin_amdgcn_rsqf(ss * (1.f / 64.f) + EPS);
            const float* nw = ((const float*)F.in[isk ? I_KNW : I_QNW]) + (size_t)l * 64;
#pragma unroll
            for (int i = 0; i < 64; ++i) v[i] = v[i] * rs * nw[i];
            if (lat) rope_vec<64>(v, ropeG + pr * 16, ropeG + pc * 16);
            if (!isk) {
#pragma unroll
                for (int i = 0; i < 64; ++i) v[i] *= qs_g;
                const float s2 = store_vec<64>(WSP(bf16_t, WS_QG) + ((size_t)h * NT + tok) * 64, v);
                WSP(float, WS_QNG)[(size_t)h * NT + tok] = sqrtf(s2);
                __hip_atomic_fetch_max(KMX + 18 + h, __float_as_uint(s2), __ATOMIC_RELAXED, __HIP_MEMORY_SCOPE_WORKGROUP);
            } else {
                const float s2 = store_vec<64>(WSP(bf16_t, WS_KG) + ((size_t)h * NT + tok) * 64, v);
                __hip_atomic_fetch_max(KMX + 8 + h, __float_as_uint(s2), __ATOMIC_RELAXED, __HIP_MEMORY_SCOPE_WORKGROUP);
            }
        }
    }
    for (int i = tid; i < 384 * 8; i += 512) { const int c = i >> 3, o = i & 7; u32x4 w;
#pragma unroll
        for (int j = 0; j < 4; ++j) { const unsigned lo = VS[(8 * o + 2 * j) * 384 + c], hi = VS[(8 * o + 2 * j + 1) * 384 + c]; w[j] = lo | (hi << 16); }
        bf16_t* dst = c < 256 ? WSP(bf16_t, WS_VTD) + (size_t)c * NT : WSP(bf16_t, WS_VTG) + (size_t)(c - 256) * NT;
        *(u32x4*)(dst + tok0 + 8 * o) = w; }
    __syncthreads();
    if (tid < 22) __hip_atomic_fetch_max(WSP(unsigned, WS_CTL) + CW_KMAX + l * 32 + tid, KMX[tid], __ATOMIC_RELAXED, __HIP_MEMORY_SCOPE_AGENT);
    __syncthreads();
}

constexpr int UBP = 1032;
template <bool FROM_U>
DI void s5_stage_u(const Frame& F, int g, int nt) {
    LAS bf16_t* UB = (LAS bf16_t*)F.lds;
    __syncthreads();
    for (int i = F.tid; i < 32 * 128; i += 512) { const int n = i >> 7, p = i & 127; const int chunk = nt * 32 + n, cc = chunk < NC5 ? chunk : NC5 - 1;
        if (FROM_U) { const int s = p >> 1, hh = p & 1; *(LAS u32x4*)(UB + n * UBP + s * 16 + 8 * hh) = *(const u32x4*)(WSP(bf16_t, WS_U) + (size_t)(cc * S5L + s) * NU + U_S5 + g * 16 + 8 * hh); }
        else *(LAS u32x4*)(UB + n * UBP + 8 * p) = *(const u32x4*)(WSP(bf16_t, WS_US5) + ((size_t)g * NT + (size_t)cc * S5L) * 16 + 8 * p); }
    __syncthreads();
}
constexpr int N_S5H = 16 * 9;
DI void p3_s5_hloc(const Frame& F, int l, int item) {
    const int g = item / 9, nt = item % 9, dir = F.wave >> 2, mt = F.wave & 3, lane = F.lane, r = lane & 31, h = lane >> 5;
    s5_stage_u<false>(F, g, nt);
    const LAS bf16_t* UB = (const LAS bf16_t*)F.lds + r * UBP + 8 * h;
    const bf16_t* E = WSP(bf16_t, WS_E5) + ((size_t)l * 16 + g) * 2 * 128 * 1024 + ((size_t)(dir * 4 + mt) * 64 * 64 + lane) * 8;
    f32x16 acc = splat16(0.f);
#pragma unroll 16
    for (int ks = 0; ks < 64; ++ks) acc = mfma32(ld8g(E + ks * 512), *(const LAS bf16x8*)(UB + ks * 16), acc);
    const int chunk = nt * 32 + r;
    if (chunk < NC5) { float* o = WSP(float, WS_HLOC) + (size_t)chunk * 4096 + (g * 2 + dir) * 128 + mt * 32;
#pragma unroll
        for (int i = 0; i < 16; ++i) o[crow(i, h)] = acc[i]; }
}

constexpr int SP = 136;
DI void p3_ssd_prep(const Frame& F, int l, int c) {
    LAS bf16_t* XT = (LAS bf16_t*)F.lds;
    LAS bf16_t* BT = XT + 256 * SP;
    LAS float* DTL = (LAS float*)(BT + 256 * SP);
    LAS float* CML = DTL + 8 * 128;
    LAS float* WG = CML + 8 * 128;
    const int tid = F.tid, lane = F.lane, tok0 = c * 128;
    const int seq_lo = c < 2 ? 0 : CTX, seq_hi = c < 2 ? CTX : NT;
    const bf16_t* U = WSP(bf16_t, WS_U);
    const float* cw = ((const float*)F.in[I_CONVW]) + (size_t)l * 3 * 768; const float* cb = ((const float*)F.in[I_CONVB]) + (size_t)l * 768;
    constexpr int RP = 264;
    LAS bf16_t* RAW = XT;
    LAS f32x4* CWS = (LAS f32x4*)(WG + 8 * 128);
#pragma unroll 1
    for (int sec = 1; sec < 3; ++sec) {
        __syncthreads();
        if (tid < 256) CWS[tid] = (f32x4){cw[sec * 256 + tid], cw[768 + sec * 256 + tid], cw[1536 + sec * 256 + tid], cb[sec * 256 + tid]};
        for (int i = tid; i < 130 * 32; i += 512) { const int rr = i >> 5, p = i & 31, tok = tok0 - 1 + rr;
            const u32x4 v = (tok >= seq_lo && tok < seq_hi) ? *(const u32x4*)(U + (size_t)tok * NU + U_XS + sec * 256 + 8 * p) : (u32x4){0u, 0u, 0u, 0u};
            *(LAS u32x4*)(RAW + rr * RP + 8 * p) = v; }
        __syncthreads();
        for (int task = tid; task < 128 * 32; task += 512) { const int t = task & 127, cg = task >> 7, tok = tok0 + t, chl = cg * 8, ch0 = sec * 256 + chl;
            const u32x4 xm = *(const LAS u32x4*)(RAW + t * RP + chl), x0 = *(const LAS u32x4*)(RAW + (t + 1) * RP + chl), xp = *(const LAS u32x4*)(RAW + (t + 2) * RP + chl);
            float y[8]; (void)ch0;
#pragma unroll
            for (int j = 0; j < 4; ++j) { const f32x4 c0 = CWS[chl + 2 * j], c1 = CWS[chl + 2 * j + 1];
                const float a0 = bflo(xm[j]) * c0[0] + bflo(x0[j]) * c0[1] + bflo(xp[j]) * c0[2] + c0[3];
                const float a1 = bfhi(xm[j]) * c1[0] + bfhi(x0[j]) * c1[1] + bfhi(xp[j]) * c1[2] + c1[3];
                y[2 * j] = silu_f(a0); y[2 * j + 1] = silu_f(a1); }
            u32x4 w;
#pragma unroll
            for (int j = 0; j < 4; ++j) w[j] = pk2(y[2 * j], y[2 * j + 1]);
            if (sec == 1) { *(u32x4*)(WSP(bf16_t, WS_BN) + (size_t)tok * 256 + chl) = w;
#pragma unroll
                for (int j = 0; j < 8; ++j) BT[(chl + j) * SP + t] = f2bf(y[j]);
            } else *(u32x4*)(WSP(bf16_t, WS_CN) + (size_t)tok * 256 + chl) = w; }
    }
    __syncthreads();
    if (tid < 256) CWS[tid] = (f32x4){cw[tid], cw[768 + tid], cw[1536 + tid], cb[tid]};
    __syncthreads();
    for (int task = tid; task < 128 * 32; task += 512) { const int t = task & 127, cg = task >> 7, tok = tok0 + t, ch0 = cg * 8;
        const u32x4 z4 = {0u, 0u, 0u, 0u};
        const u32x4 xm = (tok - 1 >= seq_lo) ? *(const u32x4*)(U + (size_t)(tok - 1) * NU + U_XS + ch0) : z4;
        const u32x4 x0 = *(const u32x4*)(U + (size_t)tok * NU + U_XS + ch0);
        const u32x4 xp = (tok + 1 < seq_hi) ? *(const u32x4*)(U + (size_t)(tok + 1) * NU + U_XS + ch0) : z4;
#pragma unroll
        for (int j = 0; j < 4; ++j) { const f32x4 c0 = CWS[ch0 + 2 * j], c1 = CWS[ch0 + 2 * j + 1];
            const float a0 = bflo(xm[j]) * c0[0] + bflo(x0[j]) * c0[1] + bflo(xp[j]) * c0[2] + c0[3];
            const float a1 = bfhi(xm[j]) * c1[0] + bfhi(x0[j]) * c1[1] + bfhi(xp[j]) * c1[2] + c1[3];
            XT[(ch0 + 2 * j) * SP + t] = f2bf(silu_f(a0)); XT[(ch0 + 2 * j + 1) * SP + t] = f2bf(silu_f(a1)); }
    }
    { const int j = F.wave, dir = j >> 2; const float bias = ((const float*)F.in[I_DTB])[(size_t)l * 8 + j], a = -__expf(((const float*)F.in[I_ALOG])[(size_t)l * 8 + j]);
      float e[2], dtv[2];
#pragma unroll
      for (int q = 0; q < 2; ++q) { const int li = 2 * lane + q, t = dir ? 127 - li : li;
          const float x = WSP(float, WS_DTRAW)[(size_t)(tok0 + t) * 8 + j] + bias; dtv[q] = x > 20.f ? x : log1pf(__expf(x)); e[q] = dtv[q] * a * LOG2E; }
      float s = e[0] + e[1];
#pragma unroll
      for (int o = 1; o < 64; o <<= 1) { const float tv = __shfl_up(s, o); if (lane >= o) s += tv; }
      const float c1 = s, c0 = s - e[1];
#pragma unroll
      for (int q = 0; q < 2; ++q) { const int li = 2 * lane + q, t = dir ? 127 - li : li; const float cv = q ? c1 : c0;
          DTL[j * 128 + t] = dtv[q]; CML[j * 128 + t] = cv;
          WSP(float, WS_DTV)[((size_t)c * 8 + j) * 128 + t] = dtv[q]; WSP(float, WS_CUM)[((size_t)c * 8 + j) * 128 + t] = cv; }
    }
    __syncthreads();
    for (int i = tid; i < 8 * 128; i += 512) { const int j = i >> 7; const float tot = CML[j * 128 + ((j >> 2) ? 0 : 127)]; WG[i] = DTL[i] * __builtin_amdgcn_exp2f(tot - CML[i]); }
    for (int i = tid; i < 256 * 16; i += 512) { const int ch = i >> 4, o = i & 15; *(u32x4*)(WSP(bf16_t, WS_XST) + ((size_t)c * 256 + ch) * 128 + 8 * o) = *(const LAS u32x4*)(XT + ch * SP + 8 * o); }
    __syncthreads();
    { const int j = F.wave, hh = j & 3, g = hh >> 1, r = lane & 31, h = lane >> 5;
      f32x16 acc[2][4];
#pragma unroll
      for (int a = 0; a < 2; ++a)
#pragma unroll
          for (int b = 0; b < 4; ++b) acc[a][b] = splat16(0.f);
#pragma unroll 1
      for (int ks = 0; ks < 8; ++ks) {
          const f32x4 w0 = *(const LAS f32x4*)(WG + j * 128 + ks * 16 + 8 * h), w1 = *(const LAS f32x4*)(WG + j * 128 + ks * 16 + 8 * h + 4);
          bf16x8 af[2], bfr[4];
#pragma unroll
          for (int a = 0; a < 2; ++a) { const u32x4 x = *(const LAS u32x4*)(XT + (hh * 64 + a * 32 + r) * SP + ks * 16 + 8 * h); u32x4 o;
              o[0] = pk2(bflo(x[0]) * w0[0], bfhi(x[0]) * w0[1]); o[1] = pk2(bflo(x[1]) * w0[2], bfhi(x[1]) * w0[3]);
              o[2] = pk2(bflo(x[2]) * w1[0], bfhi(x[2]) * w1[1]); o[3] = pk2(bflo(x[3]) * w1[2], bfhi(x[3]) * w1[3]); af[a] = __builtin_bit_cast(bf16x8, o); }
#pragma unroll
          for (int b = 0; b < 4; ++b) bfr[b] = *(const LAS bf16x8*)(BT + (g * 128 + b * 32 + r) * SP + ks * 16 + 8 * h);
#pragma unroll
          for (int a = 0; a < 2; ++a)
#pragma unroll
              for (int b = 0; b < 4; ++b) acc[a][b] = mfma32(af[a], bfr[b], acc[a][b]);
      }
      float* o = WSP(float, WS_SLOC) + ((size_t)c * 8 + j) * 64 * 128;
#pragma unroll
      for (int a = 0; a < 2; ++a)
#pragma unroll
          for (int b = 0; b < 4; ++b)
#pragma unroll
              for (int i = 0; i < 16; ++i) o[(a * 32 + crow(i, h)) * 128 + b * 32 + r] = acc[a][b][i];
    }
    __syncthreads();
}

DI void p4_s5_scan_el(const Frame& F, int l, int st);
DI void p4_ssd_scan(const Frame& F, int l) {
    if (F.tid >= 256) { if (F.tid < 264) { const int st = F.bid * 8 + (F.tid - 256); if (st < 2048) p4_s5_scan_el(F, l, st); } return; }
    const int el = F.bid * 256 + F.tid; if (el >= 65536) return;
    const int j = el >> 13;
    const int dir = j >> 2;
    const float* cum = WSP(float, WS_CUM); const float* sl = WSP(float, WS_SLOC); bf16_t* so = WSP(bf16_t, WS_SIN);
    const int eo = el & 8191;
    float s = 0.f;
#pragma unroll 26
    for (int i = 0; i < NCH; ++i) { const int c = dir ? (i < 2 ? 1 - i : NCH + 1 - i) : i;
        so[((size_t)c * 8 + j) * 8192 + eo] = f2bf(s);
        const float tot = cum[((size_t)c * 8 + j) * 128 + (dir ? 0 : 127)];
        s = s * __builtin_amdgcn_exp2f(tot) + sl[((size_t)c * 8 + j) * 8192 + eo]; }
}
DI void p4_s5_scan_el(const Frame& F, int l, int st) {
    const int g = st >> 7, dir = (st >> 6) & 1, p = st & 63;
    const f32x2 ap = WSP(f32x2, WS_APOW)[((size_t)l * 16 + g) * 128 + dir * 64 + p];
    const float* hl = WSP(float, WS_HLOC) + (g * 2 + dir) * 128 + p; bf16_t* ho = WSP(bf16_t, WS_HIN) + (g * 2 + dir) * 128 + p;
    f32x2 s = {0.f, 0.f};
#pragma unroll 26
    for (int i = 0; i < NC5; ++i) { const int c = dir ? (i < 4 ? 3 - i : NC5 + 3 - i) : i;
        ho[(size_t)c * 4096] = f2bf(s.x); ho[(size_t)c * 4096 + 64] = f2bf(s.y);
        const f32x2 loc = {hl[(size_t)c * 4096], hl[(size_t)c * 4096 + 64]};
        s = cmul(s, ap) + loc; }
}


constexpr int CVJ_LDS = 72 * 1024;
struct CvTile { const float* src; bf16_t* dst; int ld, c0, k0, mode; };
DI CvTile cv_decode(const Frame& F, int l, int m) {
    const int e = m / 1536, r = m % 1536; CvTile c;
    if (r < 1024) { c.src = ((const float*)F.in[I_WGU]) + (size_t)(l * NEXP + e) * DM * 2048; c.dst = WSP(bf16_t, WS_WGU) + (size_t)(l * NEXP + e) * 2048 * DM; c.ld = 2048; c.c0 = (r >> 4) * 32; c.k0 = (r & 15) * 64; c.mode = 2; }
    else { const int q = r - 1024; c.src = ((const float*)F.in[I_WDN]) + (size_t)(l * NEXP + e) * DM * DM; c.dst = WSP(bf16_t, WS_WDN) + (size_t)(l * NEXP + e) * DM * DM; c.ld = DM; c.c0 = (q >> 4) * 32; c.k0 = (q & 15) * 64; c.mode = 0; }
    return c;
}
DI void cv_issue(const Frame& F, int l, int j, f32x4 (&v)[8]) {
    const CvTile c = cv_decode(F, l, (F.bid * 8 + F.wave) + 2048 * j);
    const float* s = c.src + (size_t)(c.k0 + (F.lane >> 3)) * c.ld + c.c0 + 4 * (F.lane & 7);
#pragma unroll
    for (int i = 0; i < 8; ++i) v[i] = *(const f32x4*)(s + (size_t)(8 * i) * c.ld);
}
DI void cv_stage(const Frame& F, const f32x4 (&v)[8]) {
    LAS unsigned char* base = F.lds + CVJ_LDS + F.wave * 8192 + F.lane * 16;
#pragma unroll
    for (int i = 0; i < 8; ++i) *(LAS f32x4*)(base + i * 1024) = v[i];
}
DI void cv_finish(const Frame& F, int l, int j) {
    const CvTile c = cv_decode(F, l, (F.bid * 8 + F.wave) + 2048 * j);
    const LAS float* T = (const LAS float*)(F.lds + CVJ_LDS + F.wave * 8192);
    const int col = F.lane & 31, kh = F.lane >> 5, row = conv_dst_row(c.mode, c.c0 + col);
    bf16_t* o = c.dst + (size_t)row * DM + c.k0 + kh * 32;
#pragma unroll
    for (int q = 0; q < 4; ++q) { u32x4 w;
#pragma unroll
        for (int i = 0; i < 4; ++i) w[i] = pk2(T[(kh * 32 + 8 * q + 2 * i) * 32 + col], T[(kh * 32 + 8 * q + 2 * i + 1) * 32 + col]);
        *(u32x4*)(o + 8 * q) = w; }
}
constexpr int AP = 144;
struct AttnOut { bf16_t* mix; int col0; float lam, outscale; const float* subw; };
#ifndef DIFF_KT
#define DIFF_KT 64
#endif
#ifndef ATT_SCALAR_SUM
#define ATT_SCALAR_SUM 0
#endif
#ifndef ATT_STATIC_PRIO
#define ATT_STATIC_PRIO 0
#endif
#if ATT_STATIC_PRIO
#define ATT_PRIO_HI do { } while (0)
#define ATT_PRIO_LO do { } while (0)
#else
#define ATT_PRIO_HI __builtin_amdgcn_s_setprio(1)
#define ATT_PRIO_LO __builtin_amdgcn_s_setprio(0)
#endif
template <bool DIFF, int KT>
DI void attn_item(const Frame& F, const bf16_t* Q, const bf16_t* K, const bf16_t* Vt, const float* qn0, const float* qn1, float km0, float km1,
                  int q0, int nkeys, const AttnOut& ao, int cv_l = -1) {
    constexpr int KTB = KT * AP, VPB = KT * 2 + 16, VTB = 64 * VPB, NP = KT / 64;
    LAS unsigned char* KB = F.lds;
    LAS unsigned char* VB = F.lds + 2 * KTB;
    const int tid = F.tid, lane = F.lane, r = lane & 31, h = lane >> 5;
    const int qrow = q0 + F.wave * 32 + r;
    bf16x8 qf[4];
#pragma unroll
    for (int j = 0; j < 4; ++j) qf[j] = ld8g(Q + (size_t)qrow * 64 + j * 16 + 8 * h);
    const float sh0 = -qn0[qrow] * km0, sh1 = DIFF ? -qn1[qrow] * km1 : 0.f;
    f32x16 O0[2], O1[2];
#pragma unroll
    for (int d = 0; d < 2; ++d) { O0[d] = splat16(0.f); O1[d] = splat16(0.f); }
    f32x2 l0v = {0.f, 0.f}, l1v = {0.f, 0.f};
    const int srow = tid >> 3, sch = tid & 7;
    const bf16_t* kg = K + (size_t)srow * 64 + sch * 8; const bf16_t* vg = Vt + (size_t)srow * NT + sch * 8;
    const int ntile = nkeys / KT;
    u32x4 kreg[NP], vreg[NP];
#pragma unroll
    for (int i = 0; i < NP; ++i) { kreg[i] = *(const u32x4*)(kg + (size_t)i * 64 * 64); vreg[i] = *(const u32x4*)(vg + i * 64); }
    __syncthreads();
#pragma unroll
    for (int i = 0; i < NP; ++i) { *(LAS u32x4*)(KB + (srow + 64 * i) * AP + sch * 16) = kreg[i]; *(LAS u32x4*)(VB + srow * VPB + (sch + 8 * i) * 16) = vreg[i]; }
    __syncthreads();
    const int krow = kperm(r);
    f32x4 cvv[8];
#pragma unroll
    for (int i = 0; i < 8; ++i) cvv[i] = (f32x4){0.f, 0.f, 0.f, 0.f};
    asm volatile("" :: "v"(qf[0]), "v"(qf[1]), "v"(qf[2]), "v"(qf[3]), "v"(sh0), "v"(sh1));
#if ATT_STATIC_PRIO
    if (F.wave >= 4) __builtin_amdgcn_s_setprio(1);
#endif
#pragma clang loop unroll(disable)
    for (int t = 0; t < ntile; ++t) {
        const int buf = t & 1;
        constexpr int CVP = KT == 64 ? 10 : 5;
        const int cv_tt = t - (F.bid % CVP), cv_tq = cv_tt / CVP, cv_tr = cv_tt - CVP * cv_tq;
        const bool cv_on = !DIFF && cv_l >= 0 && cv_tt >= 0 && cv_tq < 24;
        if (cv_on && cv_tr == 2) cv_finish(F, cv_l, cv_tq);
        if (t + 1 < ntile) {
#pragma unroll
            for (int i = 0; i < NP; ++i) { kreg[i] = *(const u32x4*)(kg + ((size_t)(t + 1) * KT + i * 64) * 64); vreg[i] = *(const u32x4*)(vg + (size_t)(t + 1) * KT + i * 64); } }
        if (cv_on && cv_tr == 0) cv_issue(F, cv_l, cv_tq, cvv);
        const LAS unsigned char* kb = KB + buf * KTB; const LAS unsigned char* vb = VB + buf * VTB;
#pragma unroll
        for (int sub = 0; sub < KT / 32; ++sub) {
            bf16x8 kf[4];
#pragma unroll
            for (int j = 0; j < 4; ++j) kf[j] = *(const LAS bf16x8*)(kb + (sub * 32 + krow) * AP + j * 32 + h * 16);
            bf16x8 vf[2][2];
#pragma unroll
            for (int d = 0; d < 2; ++d)
#pragma unroll
                for (int s = 0; s < 2; ++s) vf[d][s] = *(const LAS bf16x8*)(vb + (d * 32 + r) * VPB + (sub * 32 + s * 16 + h * 8) * 2);
            {   f32x16 S = splat16(sh0);
                ATT_PRIO_HI;
                S = mfma32(kf[0], qf[0], S); S = mfma32(kf[1], qf[1], S);
                if (!DIFF) { S = mfma32(kf[2], qf[2], S); S = mfma32(kf[3], qf[3], S); }
                ATT_PRIO_LO;
#pragma unroll
                for (int i = 0; i < 16; ++i) {
#if defined(ATTN_DUP) && ATTN_DUP
                    float x2 = S[i]; asm volatile("" : "+v"(x2)); const float e2 = __builtin_amdgcn_exp2f(x2); S[i] = 0.5f * (__builtin_amdgcn_exp2f(S[i]) + e2);
#else
                    S[i] = __builtin_amdgcn_exp2f(S[i]);
#endif
                    }
#pragma unroll
#if ATT_SCALAR_SUM
                for (int i = 0; i < 16; i += 2) { asm("v_add_f32 %0, %0, %1" : "+v"(l0v.x) : "v"(S[i])); asm("v_add_f32 %0, %0, %1" : "+v"(l0v.y) : "v"(S[i + 1])); }
#else
                for (int i = 0; i < 16; i += 2) l0v += (f32x2){S[i], S[i + 1]};
#endif
                const bf16x8 p0 = pack_step<0>(S), p1 = pack_step<1>(S);
                ATT_PRIO_HI;
#pragma unroll
                for (int d = 0; d < 2; ++d) { O0[d] = mfma32(vf[d][0], p0, O0[d]); O0[d] = mfma32(vf[d][1], p1, O0[d]); }
                ATT_PRIO_LO; }
            if (DIFF) { f32x16 S = splat16(sh1);
                ATT_PRIO_HI;
                S = mfma32(kf[2], qf[2], S); S = mfma32(kf[3], qf[3], S);
                ATT_PRIO_LO;
#pragma unroll
                for (int i = 0; i < 16; ++i) {
#if defined(ATTN_DUP) && ATTN_DUP
                    float x2 = S[i]; asm volatile("" : "+v"(x2)); const float e2 = __builtin_amdgcn_exp2f(x2); S[i] = 0.5f * (__builtin_amdgcn_exp2f(S[i]) + e2);
#else
                    S[i] = __builtin_amdgcn_exp2f(S[i]);
#endif
                    }
#pragma unroll
#if ATT_SCALAR_SUM
                for (int i = 0; i < 16; i += 2) { asm("v_add_f32 %0, %0, %1" : "+v"(l1v.x) : "v"(S[i])); asm("v_add_f32 %0, %0, %1" : "+v"(l1v.y) : "v"(S[i + 1])); }
#else
                for (int i = 0; i < 16; i += 2) l1v += (f32x2){S[i], S[i + 1]};
#endif
                const bf16x8 p0 = pack_step<0>(S), p1 = pack_step<1>(S);
                ATT_PRIO_HI;
#pragma unroll
                for (int d = 0; d < 2; ++d) { O1[d] = mfma32(vf[d][0], p0, O1[d]); O1[d] = mfma32(vf[d][1], p1, O1[d]); }
                ATT_PRIO_LO; }
        }
        if (t + 1 < ntile) {
#pragma unroll
            for (int i = 0; i < NP; ++i) { *(LAS u32x4*)(KB + (buf ^ 1) * KTB + (srow + 64 * i) * AP + sch * 16) = kreg[i]; *(LAS u32x4*)(VB + (buf ^ 1) * VTB + srow * VPB + (sch + 8 * i) * 16) = vreg[i]; } }
        if (cv_on && cv_tr == 1) cv_stage(F, cvv);
        __syncthreads();
    }
#if ATT_STATIC_PRIO
    __builtin_amdgcn_s_setprio(0);
#endif
    const GAS float* subw = (const GAS float*)ao.subw; GAS bf16_t* mixp = (GAS bf16_t*)ao.mix;
    asm volatile("" : "+s"(subw)); asm volatile("" : "+s"(mixp));
    float l0 = l0v.x + l0v.y, l1 = l1v.x + l1v.y;
    l0 += __shfl_xor(l0, 32); const float i0 = 1.f / l0;
    float i1 = 0.f; if (DIFF) { l1 += __shfl_xor(l1, 32); i1 = ao.lam / l1; }
    float ss = 0.f;
#pragma unroll
    for (int d = 0; d < 2; ++d)
#pragma unroll
        for (int i = 0; i < 16; ++i) { float v = O0[d][i] * i0; if (DIFF) v -= O1[d][i] * i1; O0[d][i] = v; ss += v * v; }
    float sc = 1.f;
    if (DIFF) { ss += __shfl_xor(ss, 32); sc = __builtin_amdgcn_rsqf(ss * (1.f / 64.f) + EPS) * ao.outscale; }
    GAS bf16_t* orow = mixp + (size_t)qrow * DM + ao.col0;
#pragma unroll
    for (int d = 0; d < 2; ++d)
#pragma unroll
        for (int gq = 0; gq < 4; ++gq) { const int dd = d * 32 + 8 * gq + 4 * h; float o[4];
#pragma unroll
            for (int j = 0; j < 4; ++j) { o[j] = O0[d][4 * gq + j] * sc; if (DIFF) o[j] *= subw[dd + j]; }
            u32x2 w; w[0] = pk2(o[0], o[1]); w[1] = pk2(o[2], o[3]); *(GAS u32x2*)(orow + dd) = w; }
}
DI void attn_item_diff2(const Frame& F, const bf16_t* Q, const bf16_t* K, const bf16_t* Vt, int q0, int nkeys, const AttnOut& ao) {
    LAS unsigned char* KB = F.lds;
    LAS unsigned char* VB = F.lds + 2 * 64 * AP;
    const int tid = F.tid, lane = F.lane, r = lane & 31, h = lane >> 5;
    const int qrow = q0 + F.wave * 32 + r;
    bf16x8 qf[4];
#pragma unroll
    for (int j = 0; j < 4; ++j) qf[j] = ld8g(Q + (size_t)qrow * 64 + j * 16 + 8 * h);
    const f32x16 zero16 = splat16(0.f);
    f32x16 O0[2], O1[2]; float l0 = 0.f, l1 = 0.f;
#pragma unroll
    for (int dd = 0; dd < 2; ++dd) { O0[dd] = zero16; O1[dd] = zero16; }
    const int srow = tid >> 3, sch = tid & 7;
    const bf16_t* kg = K + (size_t)srow * 64 + sch * 8; const bf16_t* vg = Vt + (size_t)srow * NT + sch * 8;
    const int ntile = nkeys >> 6;
    u32x4 kreg = *(const u32x4*)kg, vreg = *(const u32x4*)vg;
    __syncthreads();
    *(LAS u32x4*)(KB + srow * AP + sch * 16) = kreg; *(LAS u32x4*)(VB + srow * AP + sch * 16) = vreg;
    __syncthreads();
    const int krow = kperm(r);
    asm volatile("" :: "v"(qf[0]), "v"(qf[1]), "v"(qf[2]), "v"(qf[3]));
#pragma clang loop unroll(disable)
    for (int t = 0; t < ntile; ++t) {
        const int buf = t & 1;
        if (t + 1 < ntile) { kreg = *(const u32x4*)(kg + (size_t)(t + 1) * 64 * 64); vreg = *(const u32x4*)(vg + (size_t)(t + 1) * 64); }
        const LAS unsigned char* kb = KB + buf * 64 * AP; const LAS unsigned char* vb = VB + buf * 64 * AP;
        bf16x8 kfa[4], kfb[4], vfa[2][2], vfb[2][2];
#pragma unroll
        for (int j = 0; j < 4; ++j) kfa[j] = *(const LAS bf16x8*)(kb + krow * AP + j * 32 + h * 16);
#pragma unroll
        for (int dd = 0; dd < 2; ++dd)
#pragma unroll
            for (int s = 0; s < 2; ++s) vfa[dd][s] = *(const LAS bf16x8*)(vb + (dd * 32 + r) * AP + (s * 16 + h * 8) * 2);
        {   f32x16 S = mfma32(kfa[0], qf[0], zero16); S = mfma32(kfa[1], qf[1], S);
#pragma unroll
            for (int j = 0; j < 4; ++j) kfb[j] = *(const LAS bf16x8*)(kb + (32 + krow) * AP + j * 32 + h * 16);
#pragma unroll
            for (int i = 0; i < 16; ++i) { S[i] = __builtin_amdgcn_exp2f(S[i]); l0 += S[i]; }
            const bf16x8 p0 = pack_step<0>(S), p1 = pack_step<1>(S);

#pragma unroll
            for (int dd = 0; dd < 2; ++dd) { O0[dd] = mfma32(vfa[dd][0], p0, O0[dd]); O0[dd] = mfma32(vfa[dd][1], p1, O0[dd]); } }
        {   f32x16 S = mfma32(kfa[2], qf[2], zero16); S = mfma32(kfa[3], qf[3], S);
#pragma unroll
            for (int dd = 0; dd < 2; ++dd)
#pragma unroll
                for (int s = 0; s < 2; ++s) vfb[dd][s] = *(const LAS bf16x8*)(vb + (dd * 32 + r) * AP + (32 + s * 16 + h * 8) * 2);
#pragma unroll
            for (int i = 0; i < 16; ++i) { S[i] = __builtin_amdgcn_exp2f(S[i]); l1 += S[i]; }
            const bf16x8 p0 = pack_step<0>(S), p1 = pack_step<1>(S);

#pragma unroll
            for (int dd = 0; dd < 2; ++dd) { O1[dd] = mfma32(vfa[dd][0], p0, O1[dd]); O1[dd] = mfma32(vfa[dd][1], p1, O1[dd]); } }
        {   f32x16 S = mfma32(kfb[0], qf[0], zero16); S = mfma32(kfb[1], qf[1], S);
#pragma unroll
            for (int i = 0; i < 16; ++i) { S[i] = __builtin_amdgcn_exp2f(S[i]); l0 += S[i]; }
            const bf16x8 p0 = pack_step<0>(S), p1 = pack_step<1>(S);

#pragma unroll
            for (int dd = 0; dd < 2; ++dd) { O0[dd] = mfma32(vfb[dd][0], p0, O0[dd]); O0[dd] = mfma32(vfb[dd][1], p1, O0[dd]); } }
        {   f32x16 S = mfma32(kfb[2], qf[2], zero16); S = mfma32(kfb[3], qf[3], S);
#pragma unroll
            for (int i = 0; i < 16; ++i) { S[i] = __builtin_amdgcn_exp2f(S[i]); l1 += S[i]; }
            const bf16x8 p0 = pack_step<0>(S), p1 = pack_step<1>(S);

#pragma unroll
            for (int dd = 0; dd < 2; ++dd) { O1[dd] = mfma32(vfb[dd][0], p0, O1[dd]); O1[dd] = mfma32(vfb[dd][1], p1, O1[dd]); } }
        if (t + 1 < ntile) { *(LAS u32x4*)(KB + (buf ^ 1) * 64 * AP + srow * AP + sch * 16) = kreg; *(LAS u32x4*)(VB + (buf ^ 1) * 64 * AP + srow * AP + sch * 16) = vreg; }
        __syncthreads();
    }
    const GAS float* subw = (const GAS float*)ao.subw; GAS bf16_t* mixp = (GAS bf16_t*)ao.mix;
    asm volatile("" : "+s"(subw)); asm volatile("" : "+s"(mixp));
    l0 += __shfl_xor(l0, 32); l1 += __shfl_xor(l1, 32);
    const float i0 = 1.f / l0, i1 = ao.lam / l1;
    float ss = 0.f;
#pragma unroll
    for (int dd = 0; dd < 2; ++dd)
#pragma unroll
        for (int i = 0; i < 16; ++i) { const float v = O0[dd][i] * i0 - O1[dd][i] * i1; O0[dd][i] = v; ss += v * v; }
    ss += __shfl_xor(ss, 32);
    const float sc = __builtin_amdgcn_rsqf(ss * (1.f / 64.f) + EPS) * ao.outscale;
    GAS bf16_t* orow = mixp + (size_t)qrow * DM + ao.col0;
#pragma unroll
    for (int dd = 0; dd < 2; ++dd)
#pragma unroll
        for (int gq = 0; gq < 4; ++gq) { const int dcol = dd * 32 + 8 * gq + 4 * h; float o[4];
#pragma unroll
            for (int j = 0; j < 4; ++j) o[j] = O0[dd][4 * gq + j] * sc * subw[dcol + j];
            u32x2 w; w[0] = pk2(o[0], o[1]); w[1] = pk2(o[2], o[3]); *(GAS u32x2*)(orow + dcol) = w; }
}
constexpr int G3_KP = 144, G3_VP = 528;
constexpr int G3_KB = 256 * G3_KP, G3_VB = 64 * G3_VP;
DI void attn_item_gqa3(const Frame& F, const bf16_t* Q, const bf16_t* K, const bf16_t* Vt, int q0, int nkeys, const AttnOut& ao) {
    LAS unsigned char* KB = F.lds;
    LAS unsigned char* VB = F.lds + 2 * G3_KB;
    const int tid = F.tid, lane = F.lane, r = lane & 31, h = lane >> 5;
    const int qrow = q0 + F.wave * 32 + r;
    bf16x8 qf[4];
#pragma unroll
    for (int j = 0; j < 4; ++j) qf[j] = ld8g(Q + (size_t)qrow * 64 + j * 16 + 8 * h);
    const f32x16 zero16 = splat16(0.f);
    f32x16 O[2]; O[0] = zero16; O[1] = zero16;
    float l0 = 0.f;
    const int kr = tid >> 3, kc = tid & 7, vr = tid >> 5, vc = tid & 31;
    const bf16_t* kg = K + (size_t)kr * 64 + kc * 8; const bf16_t* vg = Vt + (size_t)vr * NT + vc * 8;
    const int kdst = kr * G3_KP + kc * 16, vdst = vr * G3_VP + vc * 16;
    const int ntile = nkeys >> 8;
    u32x4 sreg[4];
    __syncthreads();
#pragma unroll
    for (int i = 0; i < 4; ++i) sreg[i] = *(const u32x4*)(kg + (size_t)i * 64 * 64);
#pragma unroll
    for (int i = 0; i < 4; ++i) *(LAS u32x4*)(KB + kdst + i * 64 * G3_KP) = sreg[i];
#pragma unroll
    for (int i = 0; i < 4; ++i) sreg[i] = *(const u32x4*)(vg + (size_t)i * 16 * NT);
#pragma unroll
    for (int i = 0; i < 4; ++i) *(LAS u32x4*)(VB + vdst + i * 16 * G3_VP) = sreg[i];
    __syncthreads();
    const int koff = kperm(r) * G3_KP + h * 16, voff = r * G3_VP + h * 16;
    asm volatile("" :: "v"(qf[0]), "v"(qf[1]), "v"(qf[2]), "v"(qf[3]));
#pragma clang loop unroll(disable)
    for (int t = 0; t < ntile; ++t) {
        const int buf = t & 1;
        const bool more = t + 1 < ntile;
        if (more) {
#pragma unroll
            for (int i = 0; i < 4; ++i) sreg[i] = *(const u32x4*)(kg + ((size_t)(t + 1) * 256 + i * 64) * 64); }
        const LAS unsigned char* kb = KB + buf * G3_KB + koff; const LAS unsigned char* vb = VB + buf * G3_VB + voff;
        f32x16 Sc = zero16; bf16x8 pp0, pp1;
#pragma unroll
        for (int j = 0; j < 4; ++j) Sc = mfma32(*(const LAS bf16x8*)(kb + j * 32), qf[j], j ? Sc : zero16);
#pragma unroll
        for (int u = 0; u < 8; ++u) {
            f32x16 Sn = zero16;
            if (u + 1 < 8) {
#pragma unroll
                for (int j = 0; j < 4; ++j) Sn = mfma32(*(const LAS bf16x8*)(kb + (u + 1) * 32 * G3_KP + j * 32), qf[j], j ? Sn : zero16); }
            float ls = 0.f;
#pragma unroll
            for (int i = 0; i < 16; ++i) { Sc[i] = __builtin_amdgcn_exp2f(Sc[i]); ls += Sc[i]; }
            l0 += ls;
            const bf16x8 pc0 = pack_step<0>(Sc), pc1 = pack_step<1>(Sc);
            if (u > 0) {
#pragma unroll
                for (int dd = 0; dd < 2; ++dd) { O[dd] = mfma32(*(const LAS bf16x8*)(vb + dd * 32 * G3_VP + (u - 1) * 64), pp0, O[dd]); O[dd] = mfma32(*(const LAS bf16x8*)(vb + dd * 32 * G3_VP + (u - 1) * 64 + 32), pp1, O[dd]); } }
#pragma unroll
            for (int g = 0; g < 8; ++g) { __builtin_amdgcn_sched_group_barrier(0x8, 1, 0); __builtin_amdgcn_sched_group_barrier(0x2, 5, 0); }
            pp0 = pc0; pp1 = pc1; Sc = Sn;
            if (u == 3 && more) {
#pragma unroll
                for (int i = 0; i < 4; ++i) *(LAS u32x4*)(KB + (buf ^ 1) * G3_KB + kdst + i * 64 * G3_KP) = sreg[i];
#pragma unroll
                for (int i = 0; i < 4; ++i) sreg[i] = *(const u32x4*)(vg + (size_t)(t + 1) * 256 + (size_t)i * 16 * NT); }
        }
#pragma unroll
        for (int dd = 0; dd < 2; ++dd) { O[dd] = mfma32(*(const LAS bf16x8*)(vb + dd * 32 * G3_VP + 7 * 64), pp0, O[dd]); O[dd] = mfma32(*(const LAS bf16x8*)(vb + dd * 32 * G3_VP + 7 * 64 + 32), pp1, O[dd]); }
        if (more) {
#pragma unroll
            for (int i = 0; i < 4; ++i) *(LAS u32x4*)(VB + (buf ^ 1) * G3_VB + vdst + i * 16 * G3_VP) = sreg[i]; }
        __syncthreads();
    }
    GAS bf16_t* mixp = (GAS bf16_t*)ao.mix;
    asm volatile("" : "+s"(mixp));
    l0 += __shfl_xor(l0, 32); const float i0 = 1.f / l0;
    GAS bf16_t* orow = mixp + (size_t)qrow * DM + ao.col0;
#pragma unroll
    for (int dd = 0; dd < 2; ++dd)
#pragma unroll
        for (int gq = 0; gq < 4; ++gq) { const int dcol = dd * 32 + 8 * gq + 4 * h;
            u32x2 w; w[0] = pk2(O[dd][4 * gq] * i0, O[dd][4 * gq + 1] * i0); w[1] = pk2(O[dd][4 * gq + 2] * i0, O[dd][4 * gq + 3] * i0); *(GAS u32x2*)(orow + dcol) = w; }
}
#define FENCE __builtin_amdgcn_sched_barrier(0)
#define G4_UNIT(u, HASQK, HASPV) do { \
            f32x16 Sn = zero16; \
            if (HASQK) Sn = mfma32(kfA[0], qf[0], zero16); \
            FENCE; Sc[0] = __builtin_amdgcn_exp2f(Sc[0]); Sc[1] = __builtin_amdgcn_exp2f(Sc[1]); Sc[2] = __builtin_amdgcn_exp2f(Sc[2]); FENCE; \
            if (HASQK) Sn = mfma32(kfA[1], qf[1], Sn); \
            FENCE; Sc[3] = __builtin_amdgcn_exp2f(Sc[3]); Sc[4] = __builtin_amdgcn_exp2f(Sc[4]); Sc[5] = __builtin_amdgcn_exp2f(Sc[5]); FENCE; \
            if (HASQK) Sn = mfma32(kfA[2], qf[2], Sn); \
            FENCE; Sc[6] = __builtin_amdgcn_exp2f(Sc[6]); Sc[7] = __builtin_amdgcn_exp2f(Sc[7]); Sc[8] = __builtin_amdgcn_exp2f(Sc[8]); FENCE; \
            if (HASQK) Sn = mfma32(kfA[3], qf[3], Sn); \
            FENCE; \
            if (HASQK) { _Pragma("unroll") for (int j = 0; j < 4; ++j) kfA[j] = *(const LAS bf16x8*)(kb + (((u) + 2) & 7) * 32 * G3_KP + j * 32); } \
            Sc[9] = __builtin_amdgcn_exp2f(Sc[9]); Sc[10] = __builtin_amdgcn_exp2f(Sc[10]); Sc[11] = __builtin_amdgcn_exp2f(Sc[11]); FENCE; \
            if (HASPV) O[0] = mfma32(vfA[0], pp0, O[0]); \
            FENCE; Sc[12] = __builtin_amdgcn_exp2f(Sc[12]); Sc[13] = __builtin_amdgcn_exp2f(Sc[13]); Sc[14] = __builtin_amdgcn_exp2f(Sc[14]); FENCE; \
            if (HASPV) O[0] = mfma32(vfA[1], pp1, O[0]); \
            FENCE; Sc[15] = __builtin_amdgcn_exp2f(Sc[15]); \
            l0 += (Sc[0] + Sc[1]) + (Sc[2] + Sc[3]); l1 += (Sc[4] + Sc[5]) + (Sc[6] + Sc[7]); FENCE; \
            if (HASPV) O[1] = mfma32(vfA[2], pp0, O[1]); \
            FENCE; l0 += (Sc[8] + Sc[9]) + (Sc[10] + Sc[11]); l1 += (Sc[12] + Sc[13]) + (Sc[14] + Sc[15]); \
            u32x4 pa; pa[0] = pk2(Sc[0], Sc[1]); pa[1] = pk2(Sc[2], Sc[3]); FENCE; \
            if (HASPV) O[1] = mfma32(vfA[3], pp1, O[1]); \
            FENCE; pa[2] = pk2(Sc[4], Sc[5]); pa[3] = pk2(Sc[6], Sc[7]); \
            u32x4 pb; pb[0] = pk2(Sc[8], Sc[9]); pb[1] = pk2(Sc[10], Sc[11]); pb[2] = pk2(Sc[12], Sc[13]); pb[3] = pk2(Sc[14], Sc[15]); FENCE; \
            pp0 = __builtin_bit_cast(bf16x8, pa); pp1 = __builtin_bit_cast(bf16x8, pb); Sc = Sn; \
            _Pragma("unroll") for (int j = 0; j < 4; ++j) vfA[j] = *(const LAS bf16x8*)(vb + (j >> 1) * 32 * G3_VP + (u) * 64 + (j & 1) * 32); \
            FENCE; } while (0)
DI void attn_item_gqa4(const Frame& F, const bf16_t* Q, const bf16_t* K, const bf16_t* Vt, int q0, int nkeys, const AttnOut& ao) {
    LAS unsigned char* KB = F.lds;
    LAS unsigned char* VB = F.lds + 2 * G3_KB;
    const int tid = F.tid, lane = F.lane, r = lane & 31, h = lane >> 5;
    const int qrow = q0 + F.wave * 32 + r;
    bf16x8 qf[4];
#pragma unroll
    for (int j = 0; j < 4; ++j) qf[j] = ld8g(Q + (size_t)qrow * 64 + j * 16 + 8 * h);
    const f32x16 zero16 = splat16(0.f);
    f32x16 O[2]; O[0] = zero16; O[1] = zero16;
    float l0 = 0.f, l1 = 0.f;
    const int kr = tid >> 3, kc = tid & 7, vr = tid >> 5, vc = tid & 31;
    const bf16_t* kg = K + (size_t)kr * 64 + kc * 8; const bf16_t* vg = Vt + (size_t)vr * NT + vc * 8;
    const int kdst = kr * G3_KP + kc * 16, vdst = vr * G3_VP + vc * 16;
    const int ntile = nkeys >> 8;
    u32x4 sreg[4];
    __syncthreads();
#pragma unroll
    for (int i = 0; i < 4; ++i) sreg[i] = *(const u32x4*)(kg + (size_t)i * 64 * 64);
#pragma unroll
    for (int i = 0; i < 4; ++i) *(LAS u32x4*)(KB + kdst + i * 64 * G3_KP) = sreg[i];
#pragma unroll
    for (int i = 0; i < 4; ++i) sreg[i] = *(const u32x4*)(vg + (size_t)i * 16 * NT);
#pragma unroll
    for (int i = 0; i < 4; ++i) *(LAS u32x4*)(VB + vdst + i * 16 * G3_VP) = sreg[i];
    __syncthreads();
    const int koff = kperm(r) * G3_KP + h * 16, voff = r * G3_VP + h * 16;
    asm volatile("" :: "v"(qf[0]), "v"(qf[1]), "v"(qf[2]), "v"(qf[3]));
#pragma clang loop unroll(disable)
    for (int t = 0; t < ntile; ++t) {
        const int buf = t & 1;
        const bool more = t + 1 < ntile;
        if (more) {
#pragma unroll
            for (int i = 0; i < 4; ++i) sreg[i] = *(const u32x4*)(kg + ((size_t)(t + 1) * 256 + i * 64) * 64); }
        const LAS unsigned char* kb = KB + buf * G3_KB + koff; const LAS unsigned char* vb = VB + buf * G3_VB + voff;
        bf16x8 kfA[4], kfB[4], vfA[4], pp0, pp1;
#pragma unroll
        for (int j = 0; j < 4; ++j) kfB[j] = *(const LAS bf16x8*)(kb + j * 32);
#pragma unroll
        for (int j = 0; j < 4; ++j) kfA[j] = *(const LAS bf16x8*)(kb + 32 * G3_KP + j * 32);
        f32x16 Sc = mfma32(kfB[0], qf[0], zero16); Sc = mfma32(kfB[1], qf[1], Sc); Sc = mfma32(kfB[2], qf[2], Sc); Sc = mfma32(kfB[3], qf[3], Sc);
        FENCE;
        G4_UNIT(0, true, false);
#pragma clang loop unroll(disable)
        for (int u = 1; u < 7; ++u) {
            G4_UNIT(u, true, true);
            if (u == 3 && more) {
#pragma unroll
                for (int i = 0; i < 4; ++i) *(LAS u32x4*)(KB + (buf ^ 1) * G3_KB + kdst + i * 64 * G3_KP) = sreg[i];
#pragma unroll
                for (int i = 0; i < 4; ++i) sreg[i] = *(const u32x4*)(vg + (size_t)(t + 1) * 256 + (size_t)i * 16 * NT); }
        }
        G4_UNIT(7, false, true);
        O[0] = mfma32(vfA[0], pp0, O[0]); O[0] = mfma32(vfA[1], pp1, O[0]); O[1] = mfma32(vfA[2], pp0, O[1]); O[1] = mfma32(vfA[3], pp1, O[1]);
        if (more) {
#pragma unroll
            for (int i = 0; i < 4; ++i) *(LAS u32x4*)(VB + (buf ^ 1) * G3_VB + vdst + i * 16 * G3_VP) = sreg[i]; }
        __syncthreads();
    }
    GAS bf16_t* mixp = (GAS bf16_t*)ao.mix;
    asm volatile("" : "+s"(mixp));
    int lz = 0; asm volatile("" : "+v"(lz));
    const int lane2 = (int)__builtin_amdgcn_mbcnt_hi(~0u, __builtin_amdgcn_mbcnt_lo(~0u, 0u)) + lz, h2 = lane2 >> 5, qrow2 = q0 + F.wave * 32 + (lane2 & 31);
    l0 += l1; l0 += __shfl_xor(l0, 32); const float i0 = 1.f / l0;
    GAS bf16_t* orow = mixp + (size_t)qrow2 * DM + ao.col0;
#pragma unroll
    for (int dd = 0; dd < 2; ++dd)
#pragma unroll
        for (int gq = 0; gq < 4; ++gq) { const int dcol = dd * 32 + 8 * gq + 4 * h2;
            u32x2 w; w[0] = pk2(O[dd][4 * gq] * i0, O[dd][4 * gq + 1] * i0); w[1] = pk2(O[dd][4 * gq + 2] * i0, O[dd][4 * gq + 3] * i0); *(GAS u32x2*)(orow + dcol) = w; }
}
DI void p4_attn_diff(const Frame& F, int l, int it) {
    const bool isctx = it >= 256; const int hd = isctx ? it - 256 : it & 3, qb = isctx ? 0 : it >> 2;
    const unsigned* km = WSP(unsigned, WS_CTL) + CW_KMAX + l * 32;
    const float km0 = sqrtf(__uint_as_float(__hip_atomic_load(km + hd * 2, __ATOMIC_RELAXED, __HIP_MEMORY_SCOPE_AGENT)));
    const float km1 = sqrtf(__uint_as_float(__hip_atomic_load(km + hd * 2 + 1, __ATOMIC_RELAXED, __HIP_MEMORY_SCOPE_AGENT)));
    const float lam_init = 0.8f - 0.6f * __expf(-0.3f * (float)l);
    AttnOut ao; ao.mix = WSP(bf16_t, WS_MIX); ao.col0 = hd * 64; ao.lam = WSP(float, WS_LAM)[l]; ao.outscale = 1.f - lam_init; ao.subw = ((const float*)F.in[I_SUBLN]) + (size_t)l * 64;
    const float qm0 = sqrtf(__uint_as_float(__hip_atomic_load(km + 10 + hd * 2, __ATOMIC_RELAXED, __HIP_MEMORY_SCOPE_AGENT))), qm1 = sqrtf(__uint_as_float(__hip_atomic_load(km + 10 + hd * 2 + 1, __ATOMIC_RELAXED, __HIP_MEMORY_SCOPE_AGENT)));
    if (false && qm0 * km0 <= 100.f && qm1 * km1 <= 100.f)
        attn_item_diff2(F, WSP(bf16_t, WS_QD) + (size_t)hd * NT * 64, WSP(bf16_t, WS_KD) + (size_t)hd * NT * 64, WSP(bf16_t, WS_VTD) + (size_t)hd * 64 * NT, isctx ? 0 : CTX + qb * 256, isctx ? CTX : NT, ao);
    else
    attn_item<true, DIFF_KT>(F, WSP(bf16_t, WS_QD) + (size_t)hd * NT * 64, WSP(bf16_t, WS_KD) + (size_t)hd * NT * 64, WSP(bf16_t, WS_VTD) + (size_t)hd * 64 * NT,
                    WSP(float, WS_QND) + (size_t)(hd * 2) * NT, WSP(float, WS_QND) + (size_t)(hd * 2 + 1) * NT, km0, km1, isctx ? 0 : CTX + qb * 256, isctx ? CTX : NT, ao);
}
#ifndef GQA_KT_V
#define GQA_KT_V 64
#endif
constexpr int GQA_KT = GQA_KT_V;
DI bool gqa_fast_ok(const Frame& F, int l) {
    const unsigned* km = WSP(unsigned, WS_CTL) + CW_KMAX + l * 32; bool ok = true;
    for (int hq = 0; hq < 4; ++hq) { const float k = sqrtf(__uint_as_float(__hip_atomic_load(km + 8 + (hq >> 1), __ATOMIC_RELAXED, __HIP_MEMORY_SCOPE_AGENT))), q = sqrtf(__uint_as_float(__hip_atomic_load(km + 18 + hq, __ATOMIC_RELAXED, __HIP_MEMORY_SCOPE_AGENT)));
        ok = ok && (q * k <= 100.f); }
    return ok;
}
template <bool FAST>
DI void p4_attn_gqa(const Frame& F, int l, int it) {
    const bool isctx = it >= 256; const int hq = isctx ? it - 256 : it & 3, qb = isctx ? 0 : it >> 2, g = hq >> 1;
    AttnOut ao; ao.mix = WSP(bf16_t, WS_MIX); ao.col0 = 768 + hq * 64; ao.lam = 0.f; ao.outscale = 1.f; ao.subw = nullptr;
    if (FAST) attn_item_gqa4(F, WSP(bf16_t, WS_QG) + (size_t)hq * NT * 64, WSP(bf16_t, WS_KG) + (size_t)g * NT * 64, WSP(bf16_t, WS_VTG) + (size_t)g * 64 * NT, isctx ? 0 : CTX + qb * 256, isctx ? CTX : NT, ao);
    else { const unsigned* km = WSP(unsigned, WS_CTL) + CW_KMAX + l * 32;
        const float km0 = sqrtf(__uint_as_float(__hip_atomic_load(km + 8 + g, __ATOMIC_RELAXED, __HIP_MEMORY_SCOPE_AGENT)));
        attn_item<false, GQA_KT>(F, WSP(bf16_t, WS_QG) + (size_t)hq * NT * 64, WSP(bf16_t, WS_KG) + (size_t)g * NT * 64, WSP(bf16_t, WS_VTG) + (size_t)g * 64 * NT,
                         WSP(float, WS_QNG) + (size_t)hq * NT, nullptr, km0, 0.f, isctx ? 0 : CTX + qb * 256, isctx ? CTX : NT, ao, isctx ? -1 : l); }
}

DI void p4_ssd_out(const Frame& F, int l, int item) {
    const int c = item >> 1, lh = item & 1;
    LAS float* DTL = (LAS float*)(F.lds + 96 * 1024);
    LAS float* CML = DTL + 8 * 128;
    const int tid = F.tid, lane = F.lane, r = lane & 31, h = lane >> 5, tok0 = c * 128;
    __syncthreads();
    for (int i = tid; i < 1024; i += 512) { DTL[i] = WSP(float, WS_DTV)[(size_t)c * 1024 + i]; CML[i] = WSP(float, WS_CUM)[(size_t)c * 1024 + i]; }
    __syncthreads();
    const int hh = F.wave >> 1, g = hh >> 1;
    const float Dh = ((const float*)F.in[I_SSDD])[(size_t)l * 4 + hh];
    const bf16_t* CN = WSP(bf16_t, WS_CN); const bf16_t* BN = WSP(bf16_t, WS_BN);
    const bf16_t* XS = WSP(bf16_t, WS_XST) + ((size_t)c * 256 + hh * 64) * 128;
    { const int lt = F.wave & 1;
        const int ll = 64 * lh + 32 * lt + r;
        bf16x8 cfr[8];
#pragma unroll
        for (int ks = 0; ks < 8; ++ks) cfr[ks] = ld8g(CN + (size_t)(tok0 + ll) * 256 + g * 128 + ks * 16 + 8 * h);
        const bf16_t* zr0 = WSP(bf16_t, WS_U) + (size_t)(tok0 + ll) * NU + U_Z + hh * 64;
        u32x2 zzv[2][4];
#pragma unroll
        for (int pt = 0; pt < 2; ++pt)
#pragma unroll
            for (int gq = 0; gq < 4; ++gq) zzv[pt][gq] = *(const u32x2*)(zr0 + pt * 32 + 8 * gq + 4 * h);
        const bf16_t* bnp = BN + (size_t)(tok0 + kperm(r)) * 256 + g * 128 + 8 * h;
        const bf16_t* xsp = XS + (size_t)r * 128 + 8 * h;
        bf16x8 bn[8], xs[4], bnn[8], xsn[4], sf0[2][8];
#pragma unroll
        for (int ks = 0; ks < 8; ++ks) bn[ks] = ld8g(bnp + ks * 16);
#pragma unroll
        for (int q = 0; q < 4; ++q) xs[q] = ld8g(xsp + (size_t)(q >> 1) * 32 * 128 + 16 * (q & 1));
        const float cfl = CML[hh * 128 + ll], cbl = CML[(4 + hh) * 128 + ll], dsum = DTL[hh * 128 + ll] + DTL[(4 + hh) * 128 + ll];
        f32x16 Y[2];
        Y[0] = splat16(0.f); Y[1] = splat16(0.f);
        const bf16_t* S0 = WSP(bf16_t, WS_SIN) + ((size_t)c * 8 + hh) * 8192 + (size_t)r * 128 + 8 * h;
#pragma unroll
        for (int st = 0; st < 4; ++st) {
            if (st < 3) {
#pragma unroll
                for (int ks = 0; ks < 8; ++ks) bnn[ks] = ld8g(bnp + (size_t)(st + 1) * 32 * 256 + ks * 16);
#pragma unroll
                for (int q = 0; q < 4; ++q) xsn[q] = ld8g(xsp + (size_t)(q >> 1) * 32 * 128 + 32 * (st + 1) + 16 * (q & 1));
            } else {
#pragma unroll
                for (int pt = 0; pt < 2; ++pt)
#pragma unroll
                    for (int ks = 0; ks < 8; ++ks) sf0[pt][ks] = ld8g(S0 + (size_t)pt * 32 * 128 + ks * 16);
            }
            f32x16 G = splat16(0.f);
#pragma unroll
            for (int ks = 0; ks < 8; ++ks) G = mfma32(bn[ks], cfr[ks], G);
#pragma unroll
            for (int i = 0; i < 16; ++i) { const int s = 32 * st + kperm(crow(i, h));
                const float cfs = CML[hh * 128 + s], cbs = CML[(4 + hh) * 128 + s], dfs = DTL[hh * 128 + s], dbs = DTL[(4 + hh) * 128 + s];
                float fac;
                if (s < ll) fac = dfs * __builtin_amdgcn_exp2f(cfl - cfs);
                else if (s > ll) fac = dbs * __builtin_amdgcn_exp2f(cbl - cbs);
                else fac = dsum;
                G[i] = G[i] * fac + (s == ll ? Dh : 0.f); }
            const bf16x8 m0 = pack_step<0>(G), m1 = pack_step<1>(G);
#pragma unroll
            for (int pt = 0; pt < 2; ++pt) { Y[pt] = mfma32(xs[pt * 2], m0, Y[pt]); Y[pt] = mfma32(xs[pt * 2 + 1], m1, Y[pt]); }
            if (st < 3) {
#pragma unroll
                for (int ks = 0; ks < 8; ++ks) bn[ks] = bnn[ks];
#pragma unroll
                for (int q = 0; q < 4; ++q) xs[q] = xsn[q]; }
        }
        { bf16x8 sf1[2][8];
#pragma unroll
          for (int pt = 0; pt < 2; ++pt)
#pragma unroll
              for (int ks = 0; ks < 8; ++ks) sf1[pt][ks] = ld8g(S0 + (size_t)4 * 8192 + (size_t)pt * 32 * 128 + ks * 16);
          const float e0 = __builtin_amdgcn_exp2f(cfl), e1 = __builtin_amdgcn_exp2f(cbl);
#pragma unroll
          for (int pt = 0; pt < 2; ++pt) { f32x16 Z = splat16(0.f);
#pragma unroll
              for (int ks = 0; ks < 8; ++ks) Z = mfma32(sf0[pt][ks], cfr[ks], Z);
              Y[pt] += Z * e0; }
#pragma unroll
          for (int pt = 0; pt < 2; ++pt) { f32x16 Z = splat16(0.f);
#pragma unroll
              for (int ks = 0; ks < 8; ++ks) Z = mfma32(sf1[pt][ks], cfr[ks], Z);
              Y[pt] += Z * e1; } }
        const int tok = tok0 + ll; float ssq = 0.f;
        bf16_t* yo = WSP(bf16_t, WS_YSSD) + (size_t)tok * 256 + hh * 64;
#pragma unroll
        for (int pt = 0; pt < 2; ++pt)
#pragma unroll
            for (int gq = 0; gq < 4; ++gq) { const int p = pt * 32 + 8 * gq + 4 * h; const u32x2 zz = zzv[pt][gq];
                const float z0 = bflo(zz[0]), z1 = bfhi(zz[0]), z2 = bflo(zz[1]), z3 = bfhi(zz[1]);
                const float y0 = Y[pt][4 * gq] * silu_f(z0), y1 = Y[pt][4 * gq + 1] * silu_f(z1), y2 = Y[pt][4 * gq + 2] * silu_f(z2), y3 = Y[pt][4 * gq + 3] * silu_f(z3);
                ssq += y0 * y0 + y1 * y1 + y2 * y2 + y3 * y3;
                u32x2 w; w[0] = pk2(y0, y1); w[1] = pk2(y2, y3); *(u32x2*)(yo + p) = w; }
        ssq += __shfl_xor(ssq, 32);
        if (h == 0) WSP(float, WS_SSQ)[(size_t)tok * 4 + hh] = ssq;
    }
}

constexpr int N_S5O = 16 * 9 * 2;
DI float gelu_tanh(float y) { const float u = 0.7978845608028654f * (y + 0.044715f * y * y * y); const float e = __builtin_amdgcn_exp2f(2.8853900817779268f * u); return y * (1.f - __builtin_amdgcn_rcpf(1.f + e)); }
constexpr int HBP = 264;
DI void p4_s5_out(const Frame& F, int l, int item) {
    const int mh = item & 1, nt = (item >> 1) % 9, g = (item >> 1) / 9, lane = F.lane, r = lane & 31, h = lane >> 5;
    s5_stage_u<false>(F, g, nt);
    LAS bf16_t* HB = (LAS bf16_t*)F.lds + 32 * UBP;
    LAS bf16_t* KTL = (LAS bf16_t*)(F.lds + 84 * 1024);
    { const bf16_t* ktg = WSP(bf16_t, WS_KTAB) + ((size_t)l * 16 + g) * 3 * 64 * 256;
      for (int i = F.tid; i < (2 * 64 * 256 + 256) / 8; i += 512) *(LAS u32x4*)(KTL + 8 * i) = *(const u32x4*)(ktg + 8 * i); }
    for (int i = F.tid; i < 32 * 32; i += 512) { const int n = i >> 5, p = i & 31; const int chunk = nt * 32 + n, cc = chunk < NC5 ? chunk : NC5 - 1;
        *(LAS u32x4*)(HB + n * HBP + 8 * p) = *(const u32x4*)(WSP(bf16_t, WS_HIN) + (size_t)cc * 4096 + g * 256 + 8 * p); }
    __syncthreads();
    const LAS bf16_t* UB = (const LAS bf16_t*)F.lds + r * UBP + 8 * h; const LAS bf16_t* HBr = HB + r * HBP + 8 * h;
    const int chunk = nt * 32 + r;
#pragma unroll 1
    for (int mi = 0; mi < 2; ++mi) {
        const int mt = mh * 16 + F.wave * 2 + mi, row = mt * 32 + r, t = row >> 4, ch = row & 15;
        const LAS bf16_t* KT = KTL + ch * 16 + 8 * h;
        const bf16_t* CC = WSP(bf16_t, WS_CC5) + ((size_t)l * 16 + g) * 1024 * 256 + ((size_t)mt * 16 * 64 + lane) * 8;
        bf16x8 ccf[16];
#pragma unroll
        for (int kc = 0; kc < 16; ++kc) ccf[kc] = ld8g(CC + kc * 512);
        f32x16 acc = splat16(0.f);
#pragma unroll 16
        for (int s = 0; s < 64; ++s) { const int sel = s < t ? 0 : (s > t ? 1 : 2), lag = s < t ? t - s : (s > t ? s - t : 0);
            acc = mfma32(*(const LAS bf16x8*)(KT + (sel * 64 + lag) * 256), *(const LAS bf16x8*)(UB + s * 16), acc); }
#pragma unroll
        for (int kc = 0; kc < 16; ++kc) acc = mfma32(ccf[kc], *(const LAS bf16x8*)(HBr + kc * 16), acc);
        if (chunk < NC5) {
#pragma unroll
            for (int gq = 0; gq < 4; ++gq) { const int rr = mt * 32 + 8 * gq + 4 * h, tt = rr >> 4, c0 = rr & 15;
                u32x2 w; w[0] = pk2(gelu_tanh(acc[4 * gq]), gelu_tanh(acc[4 * gq + 1])); w[1] = pk2(gelu_tanh(acc[4 * gq + 2]), gelu_tanh(acc[4 * gq + 3]));
                *(u32x2*)(WSP(bf16_t, WS_YS5) + (size_t)(chunk * S5L + tt) * 256 + g * 16 + c0) = w; } }
    }
}

DI void p5_finish(const Frame& F, int l) {
    const int lane = F.lane;
    { const f32x4 nw = *(const f32x4*)(((const float*)F.in[I_SSDNW]) + (size_t)l * 256 + 4 * lane);
      f32x4 q[9]; u32x2 y[9];
#pragma unroll
      for (int k = 0; k < 9; ++k) { const int r = F.wave + 8 * k, row = F.bid * RPB + (r < RPB ? r : RPB - 1), rc = row < NT ? row : NT - 1;
          q[k] = *(const f32x4*)(WSP(float, WS_SSQ) + (size_t)rc * 4); y[k] = *(const u32x2*)(WSP(bf16_t, WS_YSSD) + (size_t)rc * 256 + 4 * lane); }
#pragma unroll
      for (int k = 0; k < 9; ++k) { const int r = F.wave + 8 * k, row = F.bid * RPB + r;
          if (r < RPB && row < NT) { const float rs = __builtin_amdgcn_rsqf((q[k][0] + q[k][1] + q[k][2] + q[k][3]) * (1.f / 256.f) + EPS);
              u32x2 w; w[0] = pk2(bflo(y[k][0]) * rs * nw[0], bfhi(y[k][0]) * rs * nw[1]); w[1] = pk2(bflo(y[k][1]) * rs * nw[2], bfhi(y[k][1]) * rs * nw[3]);
              *(u32x2*)(WSP(bf16_t, WS_MIX) + (size_t)row * DM + 256 + 4 * lane) = w; } } }
    const int r = lane & 31, h = lane >> 5, nt = F.wave;
    const bf16_t* WG = WSP(bf16_t, WS_WGLU) + (size_t)l * 65536;
    bf16x8 wf[16];
#pragma unroll
    for (int ks = 0; ks < 16; ++ks) wf[ks] = ld8g(WG + (size_t)(nt * 32 + r) * 256 + ks * 16 + 8 * h);
    f32x4 bb[4];
#pragma unroll
    for (int gq = 0; gq < 4; ++gq) bb[gq] = *(const f32x4*)(((const float*)F.in[I_BGLU]) + (size_t)l * 256 + nt * 32 + 8 * gq + 4 * h);
    for (int mt = F.bid; mt < NT / 32; mt += F.G) {
        const bf16_t* Y = WSP(bf16_t, WS_YS5) + (size_t)(mt * 32) * 256;
        bf16x8 af[16]; u32x2 yy[4];
#pragma unroll
        for (int ks = 0; ks < 16; ++ks) af[ks] = ld8g(Y + (size_t)r * 256 + ks * 16 + 8 * h);
#pragma unroll
        for (int gq = 0; gq < 4; ++gq) yy[gq] = *(const u32x2*)(Y + (size_t)r * 256 + nt * 32 + 8 * gq + 4 * h);
        const int tok = mt * 32 + r;
        f32x16 acc = splat16(0.f);
#pragma unroll
        for (int ks = 0; ks < 16; ++ks) acc = mfma32(wf[ks], af[ks], acc);
#pragma unroll
        for (int gq = 0; gq < 4; ++gq) { const int n0 = nt * 32 + 8 * gq + 4 * h;
            u32x2 w; w[0] = pk2(bflo(yy[gq][0]) * sigmoid_f(acc[4 * gq] + bb[gq][0]), bfhi(yy[gq][0]) * sigmoid_f(acc[4 * gq + 1] + bb[gq][1]));
            w[1] = pk2(bflo(yy[gq][1]) * sigmoid_f(acc[4 * gq + 2] + bb[gq][2]), bfhi(yy[gq][1]) * sigmoid_f(acc[4 * gq + 3] + bb[gq][3]));
            *(u32x2*)(WSP(bf16_t, WS_MIX) + (size_t)tok * DM + 512 + n0) = w; }
    }
    __syncthreads();
}

#ifndef PH_MASK
#define PH_MASK 0xFFFF
#endif
#define PHEN(k) ((PH_MASK >> (k)) & 1)
#ifndef PH_REP
#define PH_REP 0
#endif
#define NREP(k) (((PH_REP >> (k)) & 1) ? 2 : 1)
#ifndef STAG_GU
#define STAG_GU 0
#endif
#ifndef STAG_DN
#define STAG_DN 0
#endif
#ifndef REP_SKIP_STORES
#define REP_SKIP_STORES 0
#endif
DI Frame launder(const Frame& F) { Frame G = F; int t = F.wave * 64 + (int)__builtin_amdgcn_mbcnt_hi(~0u, __builtin_amdgcn_mbcnt_lo(~0u, 0u)); GAS unsigned char* w = F.ws; const GAS float* const __attribute__((address_space(4)))* ip = F.in;
    int bb = F.bid, gg = F.G; LAS unsigned char* lp = F.lds; asm volatile("" : "+s"(lp)); G.lds = lp; asm volatile("" : "+v"(t)); asm volatile("" : "+s"(w)); asm volatile("" : "+s"(ip)); asm volatile("" : "+s"(bb)); asm volatile("" : "+s"(gg)); G.bid = bb; G.G = gg; G.tid = t; G.lane = t & 63; G.ws = w; G.in = ip; return G; }
DI int launder_s(int v) { asm volatile("" : "+s"(v)); return v; }
constexpr int NPL = 10, N_PHASES = 1 + DEPTH * NPL + 1;
__global__ void __launch_bounds__(512, 2) hybrid_fwd(Args args) {
    extern __shared__ __attribute__((aligned(16))) unsigned char lds_raw[];
    Frame F; F.lds = (LAS unsigned char*)lds_raw; F.in = (const GAS float* const __attribute__((address_space(4)))*)__builtin_amdgcn_kernarg_segment_ptr(); F.ws = (GAS unsigned char*)args.ws; F.out = args.out;
    F.tid = threadIdx.x; F.lane = F.tid & 63; F.wave = __builtin_amdgcn_readfirstlane(F.tid >> 6); F.G = gridDim.x; F.bid = blockIdx.x;
    const int lo = args.ph_lo, hi = args.ph_hi;
    volatile LAS unsigned* xbw = (volatile LAS unsigned*)(F.lds + LDS_BYTES - 64);
    if (F.tid == 0) { xbw[0] = 0u; xbw[1] = 0u; }
    __syncthreads();
    XcdBarrier bar; bar.bar = WSP(unsigned, WS_CTL) + CW_BAR; bar.x = 0; bar.st = xbw;
    if (hi - lo > 1) bar = xcd_barrier_post(WSP(unsigned, WS_CTL) + CW_BAR, xbw);
#define IN(k) (lo <= (k) && (k) < hi)
#ifndef DIAG
#define DIAG 0
#endif
#if DIAG
    volatile LAS unsigned* dg = (volatile LAS unsigned*)(F.lds + LDS_BYTES - 192);
    if (F.tid < 16) dg[F.tid] = 0u;
    unsigned long long t_prev = __builtin_amdgcn_s_memrealtime();
#define DIAG_ACC(kind) do { if (blockIdx.x == 0 && threadIdx.x == 0) { const unsigned long long t_now = __builtin_amdgcn_s_memrealtime(); dg[kind] += (unsigned)(t_now - t_prev); t_prev = t_now; } } while (0)
#else
#define DIAG_ACC(kind) do { } while (0)
#endif
#define SEAM(k) do { if (IN(k) && IN((k) + 1)) xcd_barrier(bar); } while (0)
#define WSQ(T, off) ((T*)(Fq.ws + (off)))
#define LAUNDERED for (int rep_ = 0; rep_ < nrep_; ++rep_) for (Frame Fq = launder(F), *once_ = &Fq; once_; once_ = nullptr) for (int lq = launder_s(l_cur), once2_ = 1; once2_; once2_ = 0)
    int ph = 0, l_cur = 0, nrep_ = 1;
    nrep_ = NREP(0); if (PHEN(0) && IN(ph)) LAUNDERED { (void)lq; p0_prologue(Fq, rep_); }
    SEAM(ph); ++ph; DIAG_ACC(0);
    { l_cur = 0;
        nrep_ = NREP(1); if (PHEN(1) && IN(ph)) LAUNDERED p1_norm<false>(Fq, lq);
        SEAM(ph); ++ph; DIAG_ACC(1);
        nrep_ = NREP(2); if (PHEN(2) && IN(ph)) LAUNDERED { pg8::Gemm gm{WSQ(pg8::bf16_t, WS_H), WSQ(pg8::bf16_t, WS_WIN) + (size_t)lq * NU * DM, NT, NU, DM}; pg8::StaticOrder S; S.init(NT, NU, Fq.G, Fq.bid);
            EpiU E{WSQ(bf16_t, WS_U), NU, WSQ(bf16_t, WS_US5)}; pg8::gemm_phase<EpiU, pg8::StaticOrder>((PG8_LAS unsigned char*)Fq.lds, gm, S, E); }
        SEAM(ph); ++ph; DIAG_ACC(2);
        nrep_ = NREP(3); if (PHEN(3) && IN(ph)) LAUNDERED {
            unsigned* qctr = WSQ(unsigned, WS_CTL) + CW_Q0 + 64 * (2 + 2 * lq + rep_ * 8);
            for (;;) { const int idx = q_next(Fq, qctr); if (idx >= NCH + 260 + N_S5H) break; const Frame Fi = launder(Fq);
                if (idx < NCH) { for (int q_ = 0; q_ < NREP(21); ++q_) p3_ssd_prep(Fi, lq, idx); }
                else if (idx < NCH + 260) { for (int q_ = 0; q_ < NREP(22); ++q_) p3_attn_prep(Fi, lq, idx - NCH); }
                else { for (int q_ = 0; q_ < NREP(23); ++q_) p3_s5_hloc(Fi, lq, idx - NCH - 260); }
            }
        }
        SEAM(ph); ++ph; DIAG_ACC(3);
        nrep_ = NREP(4); if (PHEN(4) && IN(ph)) LAUNDERED { for (int q_ = 0; q_ < NREP(16); ++q_) p4_ssd_scan(Fq, lq);
            for (int q_ = 0; q_ < NREP(17); ++q_) for (int it = Fq.bid; it < 256; it += Fq.G) { const Frame Fi = launder(Fq); p4_attn_diff(Fi, lq, it); }
            unsigned* qctr = WSQ(unsigned, WS_CTL) + CW_Q0 + 64 * (10 + lq + rep_ * 8);
            for (;;) { const int idx = q_next(Fq, qctr); if (idx >= 4) break; const Frame Fi = launder(Fq);
                p4_attn_diff(Fi, lq, 256 + idx); } }
        SEAM(ph); ++ph; DIAG_ACC(4);
        nrep_ = NREP(5); if (PHEN(5) && IN(ph)) LAUNDERED {
            if (false && gqa_fast_ok(Fq, lq)) { for (int q_ = 0; q_ < NREP(18); ++q_) for (int it = Fq.bid; it < 256; it += Fq.G) { const Frame Fi = launder(Fq); p4_attn_gqa<true>(Fi, lq, it); } }
            else { for (int q_ = 0; q_ < NREP(18); ++q_) for (int it = Fq.bid; it < 256; it += Fq.G) { const Frame Fi = launder(Fq); p4_attn_gqa<false>(Fi, lq, it); } }
            { unsigned* qctr = WSQ(unsigned, WS_CTL) + CW_Q0 + 64 * (3 + 2 * lq + rep_ * 8);
              for (;;) { const int idx = q_next(Fq, qctr); if (idx >= 2 * NCH + N_S5O + 4) break; const Frame Fi = launder(Fq);
                  if (idx < 2 * NCH) p4_ssd_out(Fi, lq, idx); else if (idx < 2 * NCH + N_S5O) p4_s5_out(Fi, lq, idx - 2 * NCH); else p4_attn_gqa<false>(Fi, lq, 256 + idx - 2 * NCH - N_S5O); } }
        }
        SEAM(ph); ++ph; DIAG_ACC(5);
        nrep_ = NREP(6); if (PHEN(6) && IN(ph)) LAUNDERED p5_finish(Fq, lq);
        SEAM(ph); ++ph; DIAG_ACC(6);
        nrep_ = NREP(7); if (PHEN(7) && IN(ph)) LAUNDERED { pg8::Gemm gm{WSQ(pg8::bf16_t, WS_MIX) + (size_t)CTX * DM, WSQ(pg8::bf16_t, WS_WOUT) + (size_t)lq * DM * DM, SEQ, DM, DM}; pg8::StaticOrder S; S.init(SEQ, DM, Fq.G, Fq.bid);
            EpiRes E; E.C = WSQ(float, WS_XA); E.g1 = WSQ(float, WS_MOD) + (size_t)lq * 2 * 6144 + 2 * 1024;
            if (lq == 0) { E.res_ctx = ((const float*)Fq.in[I_CTX]); E.res_lat = ((const float*)Fq.in[I_X]); } else { E.res_ctx = WSQ(float, WS_XB); E.res_lat = WSQ(float, WS_XB) + (size_t)CTX * DM; }
            pg8::gemm_phase<EpiRes, pg8::StaticOrder>((PG8_LAS unsigned char*)Fq.lds, gm, S, E);
            if (lq < DEPTH - 1) outproj_ctx(Fq, lq, E.res_ctx); }
        SEAM(ph); ++ph; DIAG_ACC(7);
        nrep_ = NREP(8); if (PHEN(8) && IN(ph)) LAUNDERED p7a_router(Fq, lq, rep_);
        SEAM(ph); ++ph; DIAG_ACC(8);
        nrep_ = NREP(10); if (PHEN(10) && IN(ph)) LAUNDERED { const int ntiles = moe_tables(Fq, lq); const LAS int* t2e = (const LAS int*)(Fq.lds + LDS_MISC) + 64;
            moe_rows(Fq, lq, ntiles, 8);
            pg8::Gemm gm{WSQ(pg8::bf16_t, WS_H), WSQ(pg8::bf16_t, WS_WGU) + (size_t)lq * NEXP * 2048 * DM, CAP, 2048, DM};
            MoeOrder S{8, ntiles, Fq.G, Fq.bid, t2e, (long)2048 * DM * 2};
            moe_bias(Fq, ntiles, 8, ((const float*)Fq.in[I_BGU]) + (size_t)lq * NEXP * 2048, 2048);
            EpiAct E{WSQ(bf16_t, WS_ACT), (const LAS float*)(Fq.lds + LDS_BIASL)};
            if (STAG_GU) xcd_stagger(Fq, STAG_GU);
            pg8::gemm_phase_gather<EpiAct, MoeOrder>((PG8_LAS unsigned char*)Fq.lds, gm, S, E, (const PG8_LAS int*)(Fq.lds + LDS_MISC + 2048)); }
        SEAM(ph); ++ph; DIAG_ACC(10);
        nrep_ = NREP(11); if (PHEN(11) && IN(ph)) LAUNDERED { const int ntiles = moe_tables(Fq, lq); const LAS int* t2e = (const LAS int*)(Fq.lds + LDS_MISC) + 64;
            pg8::Gemm gm{WSQ(pg8::bf16_t, WS_ACT), WSQ(pg8::bf16_t, WS_WDN) + (size_t)lq * NEXP * DM * DM, CAP, DM, DM};
            MoeOrder S{4, ntiles, Fq.G, Fq.bid, t2e, (long)DM * DM * 2};
            moe_bias(Fq, ntiles, 4, ((const float*)Fq.in[I_BDN]) + (size_t)lq * NEXP * DM, DM);
            EpiDown E{WSQ(bf16_t, WS_YB), (const LAS float*)(Fq.lds + LDS_BIASL), REP_SKIP_STORES * rep_, WSQ(bf16_t, WS_U)};
            if (STAG_DN) xcd_stagger(Fq, STAG_DN);
            pg8::gemm_phase<EpiDown, MoeOrder>((PG8_LAS unsigned char*)Fq.lds, gm, S, E); }
        SEAM(ph); ++ph; DIAG_ACC(11);
    }
    { l_cur = 1;
        nrep_ = NREP(1); if (PHEN(1) && IN(ph)) LAUNDERED p1_norm<false>(Fq, lq);
        SEAM(ph); ++ph; DIAG_ACC(1);
        nrep_ = NREP(2); if (PHEN(2) && IN(ph)) LAUNDERED { pg8::Gemm gm{WSQ(pg8::bf16_t, WS_H), WSQ(pg8::bf16_t, WS_WIN) + (size_t)lq * NU * DM, NT, NU, DM}; pg8::StaticOrder S; S.init(NT, NU, Fq.G, Fq.bid);
            EpiU E{WSQ(bf16_t, WS_U), NU, WSQ(bf16_t, WS_US5)}; pg8::gemm_phase<EpiU, pg8::StaticOrder>((PG8_LAS unsigned char*)Fq.lds, gm, S, E); }
        SEAM(ph); ++ph; DIAG_ACC(2);
        nrep_ = NREP(3); if (PHEN(3) && IN(ph)) LAUNDERED {
            unsigned* qctr = WSQ(unsigned, WS_CTL) + CW_Q0 + 64 * (2 + 2 * lq + rep_ * 8);
            for (;;) { const int idx = q_next(Fq, qctr); if (idx >= NCH + 260 + N_S5H) break; const Frame Fi = launder(Fq);
                if (idx < NCH) { for (int q_ = 0; q_ < NREP(21); ++q_) p3_ssd_prep(Fi, lq, idx); }
                else if (idx < NCH + 260) { for (int q_ = 0; q_ < NREP(22); ++q_) p3_attn_prep(Fi, lq, idx - NCH); }
                else { for (int q_ = 0; q_ < NREP(23); ++q_) p3_s5_hloc(Fi, lq, idx - NCH - 260); }
            }
        }
        SEAM(ph); ++ph; DIAG_ACC(3);
        nrep_ = NREP(4); if (PHEN(4) && IN(ph)) LAUNDERED { for (int q_ = 0; q_ < NREP(16); ++q_) p4_ssd_scan(Fq, lq);
            for (int q_ = 0; q_ < NREP(17); ++q_) for (int it = Fq.bid; it < 256; it += Fq.G) { const Frame Fi = launder(Fq); p4_attn_diff(Fi, lq, it); }
            unsigned* qctr = WSQ(unsigned, WS_CTL) + CW_Q0 + 64 * (10 + lq + rep_ * 8);
            for (;;) { const int idx = q_next(Fq, qctr); if (idx >= 4) break; const Frame Fi = launder(Fq);
                p4_attn_diff(Fi, lq, 256 + idx); } }
        SEAM(ph); ++ph; DIAG_ACC(4);
        nrep_ = NREP(5); if (PHEN(5) && IN(ph)) LAUNDERED {
            if (false && gqa_fast_ok(Fq, lq)) { for (int q_ = 0; q_ < NREP(18); ++q_) for (int it = Fq.bid; it < 256; it += Fq.G) { const Frame Fi = launder(Fq); p4_attn_gqa<true>(Fi, lq, it); } }
            else { for (int q_ = 0; q_ < NREP(18); ++q_) for (int it = Fq.bid; it < 256; it += Fq.G) { const Frame Fi = launder(Fq); p4_attn_gqa<false>(Fi, lq, it); } }
            { unsigned* qctr = WSQ(unsigned, WS_CTL) + CW_Q0 + 64 * (3 + 2 * lq + rep_ * 8);
              for (;;) { const int idx = q_next(Fq, qctr); if (idx >= 2 * NCH + N_S5O + 4) break; const Frame Fi = launder(Fq);
                  if (idx < 2 * NCH) p4_ssd_out(Fi, lq, idx); else if (idx < 2 * NCH + N_S5O) p4_s5_out(Fi, lq, idx - 2 * NCH); else p4_attn_gqa<false>(Fi, lq, 256 + idx - 2 * NCH - N_S5O); } }
        }
        SEAM(ph); ++ph; DIAG_ACC(5);
        nrep_ = NREP(6); if (PHEN(6) && IN(ph)) LAUNDERED p5_finish(Fq, lq);
        SEAM(ph); ++ph; DIAG_ACC(6);
        nrep_ = NREP(7); if (PHEN(7) && IN(ph)) LAUNDERED { pg8::Gemm gm{WSQ(pg8::bf16_t, WS_MIX) + (size_t)CTX * DM, WSQ(pg8::bf16_t, WS_WOUT) + (size_t)lq * DM * DM, SEQ, DM, DM}; pg8::StaticOrder S; S.init(SEQ, DM, Fq.G, Fq.bid);
            EpiRes E; E.C = WSQ(float, WS_XA); E.g1 = WSQ(float, WS_MOD) + (size_t)lq * 2 * 6144 + 2 * 1024;
            if (lq == 0) { E.res_ctx = ((const float*)Fq.in[I_CTX]); E.res_lat = ((const float*)Fq.in[I_X]); } else { E.res_ctx = WSQ(float, WS_XB); E.res_lat = WSQ(float, WS_XB) + (size_t)CTX * DM; }
            pg8::gemm_phase<EpiRes, pg8::StaticOrder>((PG8_LAS unsigned char*)Fq.lds, gm, S, E);
            if (lq < DEPTH - 1) outproj_ctx(Fq, lq, E.res_ctx); }
        SEAM(ph); ++ph; DIAG_ACC(7);
        nrep_ = NREP(8); if (PHEN(8) && IN(ph)) LAUNDERED p7a_router(Fq, lq, rep_);
        SEAM(ph); ++ph; DIAG_ACC(8);
        nrep_ = NREP(10); if (PHEN(10) && IN(ph)) LAUNDERED { const int ntiles = moe_tables(Fq, lq); const LAS int* t2e = (const LAS int*)(Fq.lds + LDS_MISC) + 64;
            moe_rows(Fq, lq, ntiles, 8);
            pg8::Gemm gm{WSQ(pg8::bf16_t, WS_H), WSQ(pg8::bf16_t, WS_WGU) + (size_t)lq * NEXP * 2048 * DM, CAP, 2048, DM};
            MoeOrder S{8, ntiles, Fq.G, Fq.bid, t2e, (long)2048 * DM * 2};
            moe_bias(Fq, ntiles, 8, ((const float*)Fq.in[I_BGU]) + (size_t)lq * NEXP * 2048, 2048);
            EpiAct E{WSQ(bf16_t, WS_ACT), (const LAS float*)(Fq.lds + LDS_BIASL)};
            if (STAG_GU) xcd_stagger(Fq, STAG_GU);
            pg8::gemm_phase_gather<EpiAct, MoeOrder>((PG8_LAS unsigned char*)Fq.lds, gm, S, E, (const PG8_LAS int*)(Fq.lds + LDS_MISC + 2048)); }
        SEAM(ph); ++ph; DIAG_ACC(10);
        nrep_ = NREP(11); if (PHEN(11) && IN(ph)) LAUNDERED { const int ntiles = moe_tables(Fq, lq); const LAS int* t2e = (const LAS int*)(Fq.lds + LDS_MISC) + 64;
            pg8::Gemm gm{WSQ(pg8::bf16_t, WS_ACT), WSQ(pg8::bf16_t, WS_WDN) + (size_t)lq * NEXP * DM * DM, CAP, DM, DM};
            MoeOrder S{4, ntiles, Fq.G, Fq.bid, t2e, (long)DM * DM * 2};
            moe_bias(Fq, ntiles, 4, ((const float*)Fq.in[I_BDN]) + (size_t)lq * NEXP * DM, DM);
            EpiDown E{WSQ(bf16_t, WS_YB), (const LAS float*)(Fq.lds + LDS_BIASL), REP_SKIP_STORES * rep_, WSQ(bf16_t, WS_U)};
            if (STAG_DN) xcd_stagger(Fq, STAG_DN);
            pg8::gemm_phase<EpiDown, MoeOrder>((PG8_LAS unsigned char*)Fq.lds, gm, S, E); }
        SEAM(ph); ++ph; DIAG_ACC(11);
    }
    { l_cur = 2;
        nrep_ = NREP(1); if (PHEN(1) && IN(ph)) LAUNDERED p1_norm<false>(Fq, lq);
        SEAM(ph); ++ph; DIAG_ACC(1);
        nrep_ = NREP(2); if (PHEN(2) && IN(ph)) LAUNDERED { pg8::Gemm gm{WSQ(pg8::bf16_t, WS_H), WSQ(pg8::bf16_t, WS_WIN) + (size_t)lq * NU * DM, NT, NU, DM}; pg8::StaticOrder S; S.init(NT, NU, Fq.G, Fq.bid);
            EpiU E{WSQ(bf16_t, WS_U), NU, WSQ(bf16_t, WS_US5)}; pg8::gemm_phase<EpiU, pg8::StaticOrder>((PG8_LAS unsigned char*)Fq.lds, gm, S, E); }
        SEAM(ph); ++ph; DIAG_ACC(2);
        nrep_ = NREP(3); if (PHEN(3) && IN(ph)) LAUNDERED {
            unsigned* qctr = WSQ(unsigned, WS_CTL) + CW_Q0 + 64 * (2 + 2 * lq + rep_ * 8);
            for (;;) { const int idx = q_next(Fq, qctr); if (idx >= NCH + 260 + N_S5H) break; const Frame Fi = launder(Fq);
                if (idx < NCH) { for (int q_ = 0; q_ < NREP(21); ++q_) p3_ssd_prep(Fi, lq, idx); }
                else if (idx < NCH + 260) { for (int q_ = 0; q_ < NREP(22); ++q_) p3_attn_prep(Fi, lq, idx - NCH); }
                else { for (int q_ = 0; q_ < NREP(23); ++q_) p3_s5_hloc(Fi, lq, idx - NCH - 260); }
            }
        }
        SEAM(ph); ++ph; DIAG_ACC(3);
        nrep_ = NREP(4); if (PHEN(4) && IN(ph)) LAUNDERED { for (int q_ = 0; q_ < NREP(16); ++q_) p4_ssd_scan(Fq, lq);
            for (int q_ = 0; q_ < NREP(17); ++q_) for (int it = Fq.bid; it < 256; it += Fq.G) { const Frame Fi = launder(Fq); p4_attn_diff(Fi, lq, it); }
            unsigned* qctr = WSQ(unsigned, WS_CTL) + CW_Q0 + 64 * (10 + lq + rep_ * 8);
            for (;;) { const int idx = q_next(Fq, qctr); if (idx >= 4) break; const Frame Fi = launder(Fq);
                p4_attn_diff(Fi, lq, 256 + idx); } }
        SEAM(ph); ++ph; DIAG_ACC(4);
        nrep_ = NREP(5); if (PHEN(5) && IN(ph)) LAUNDERED {
            if (false && gqa_fast_ok(Fq, lq)) { for (int q_ = 0; q_ < NREP(18); ++q_) for (int it = Fq.bid; it < 256; it += Fq.G) { const Frame Fi = launder(Fq); p4_attn_gqa<true>(Fi, lq, it); } }
            else { for (int q_ = 0; q_ < NREP(18); ++q_) for (int it = Fq.bid; it < 256; it += Fq.G) { const Frame Fi = launder(Fq); p4_attn_gqa<false>(Fi, lq, it); } }
            { unsigned* qctr = WSQ(unsigned, WS_CTL) + CW_Q0 + 64 * (3 + 2 * lq + rep_ * 8);
              for (;;) { const int idx = q_next(Fq, qctr); if (idx >= 2 * NCH + N_S5O + 4) break; const Frame Fi = launder(Fq);
                  if (idx < 2 * NCH) p4_ssd_out(Fi, lq, idx); else if (idx < 2 * NCH + N_S5O) p4_s5_out(Fi, lq, idx - 2 * NCH); else p4_attn_gqa<false>(Fi, lq, 256 + idx - 2 * NCH - N_S5O); } }
        }
        SEAM(ph); ++ph; DIAG_ACC(5);
        nrep_ = NREP(6); if (PHEN(6) && IN(ph)) LAUNDERED p5_finish(Fq, lq);
        SEAM(ph); ++ph; DIAG_ACC(6);
        nrep_ = NREP(7); if (PHEN(7) && IN(ph)) LAUNDERED { pg8::Gemm gm{WSQ(pg8::bf16_t, WS_MIX) + (size_t)CTX * DM, WSQ(pg8::bf16_t, WS_WOUT) + (size_t)lq * DM * DM, SEQ, DM, DM}; pg8::StaticOrder S; S.init(SEQ, DM, Fq.G, Fq.bid);
            EpiRes E; E.C = WSQ(float, WS_XA); E.g1 = WSQ(float, WS_MOD) + (size_t)lq * 2 * 6144 + 2 * 1024;
            if (lq == 0) { E.res_ctx = ((const float*)Fq.in[I_CTX]); E.res_lat = ((const float*)Fq.in[I_X]); } else { E.res_ctx = WSQ(float, WS_XB); E.res_lat = WSQ(float, WS_XB) + (size_t)CTX * DM; }
            pg8::gemm_phase<EpiRes, pg8::StaticOrder>((PG8_LAS unsigned char*)Fq.lds, gm, S, E);
            if (lq < DEPTH - 1) outproj_ctx(Fq, lq, E.res_ctx); }
        SEAM(ph); ++ph; DIAG_ACC(7);
        nrep_ = NREP(8); if (PHEN(8) && IN(ph)) LAUNDERED p7a_router(Fq, lq, rep_);
        SEAM(ph); ++ph; DIAG_ACC(8);
        nrep_ = NREP(10); if (PHEN(10) && IN(ph)) LAUNDERED { const int ntiles = moe_tables(Fq, lq); const LAS int* t2e = (const LAS int*)(Fq.lds + LDS_MISC) + 64;
            moe_rows(Fq, lq, ntiles, 8);
            pg8::Gemm gm{WSQ(pg8::bf16_t, WS_H), WSQ(pg8::bf16_t, WS_WGU) + (size_t)lq * NEXP * 2048 * DM, CAP, 2048, DM};
            MoeOrder S{8, ntiles, Fq.G, Fq.bid, t2e, (long)2048 * DM * 2};
            moe_bias(Fq, ntiles, 8, ((const float*)Fq.in[I_BGU]) + (size_t)lq * NEXP * 2048, 2048);
            EpiAct E{WSQ(bf16_t, WS_ACT), (const LAS float*)(Fq.lds + LDS_BIASL)};
            if (STAG_GU) xcd_stagger(Fq, STAG_GU);
            pg8::gemm_phase_gather<EpiAct, MoeOrder>((PG8_LAS unsigned char*)Fq.lds, gm, S, E, (const PG8_LAS int*)(Fq.lds + LDS_MISC + 2048)); }
        SEAM(ph); ++ph; DIAG_ACC(10);
        nrep_ = NREP(11); if (PHEN(11) && IN(ph)) LAUNDERED { const int ntiles = moe_tables(Fq, lq); const LAS int* t2e = (const LAS int*)(Fq.lds + LDS_MISC) + 64;
            pg8::Gemm gm{WSQ(pg8::bf16_t, WS_ACT), WSQ(pg8::bf16_t, WS_WDN) + (size_t)lq * NEXP * DM * DM, CAP, DM, DM};
            MoeOrder S{4, ntiles, Fq.G, Fq.bid, t2e, (long)DM * DM * 2};
            moe_bias(Fq, ntiles, 4, ((const float*)Fq.in[I_BDN]) + (size_t)lq * NEXP * DM, DM);
            EpiDown E{WSQ(bf16_t, WS_YB), (const LAS float*)(Fq.lds + LDS_BIASL), REP_SKIP_STORES * rep_, WSQ(bf16_t, WS_U)};
            if (STAG_DN) xcd_stagger(Fq, STAG_DN);
            pg8::gemm_phase<EpiDown, MoeOrder>((PG8_LAS unsigned char*)Fq.lds, gm, S, E); }
        SEAM(ph); ++ph; DIAG_ACC(11);
    }
    { l_cur = 3;
        nrep_ = NREP(1); if (PHEN(1) && IN(ph)) LAUNDERED p1_norm<false>(Fq, lq);
        SEAM(ph); ++ph; DIAG_ACC(1);
        nrep_ = NREP(2); if (PHEN(2) && IN(ph)) LAUNDERED { pg8::Gemm gm{WSQ(pg8::bf16_t, WS_H), WSQ(pg8::bf16_t, WS_WIN) + (size_t)lq * NU * DM, NT, NU, DM}; pg8::StaticOrder S; S.init(NT, NU, Fq.G, Fq.bid);
            EpiU E{WSQ(bf16_t, WS_U), NU, WSQ(bf16_t, WS_US5)}; pg8::gemm_phase<EpiU, pg8::StaticOrder>((PG8_LAS unsigned char*)Fq.lds, gm, S, E); }
        SEAM(ph); ++ph; DIAG_ACC(2);
        nrep_ = NREP(3); if (PHEN(3) && IN(ph)) LAUNDERED {
            unsigned* qctr = WSQ(unsigned, WS_CTL) + CW_Q0 + 64 * (2 + 2 * lq + rep_ * 8);
            for (;;) { const int idx = q_next(Fq, qctr); if (idx >= NCH + 260 + N_S5H) break; const Frame Fi = launder(Fq);
                if (idx < NCH) { for (int q_ = 0; q_ < NREP(21); ++q_) p3_ssd_prep(Fi, lq, idx); }
                else if (idx < NCH + 260) { for (int q_ = 0; q_ < NREP(22); ++q_) p3_attn_prep(Fi, lq, idx - NCH); }
                else { for (int q_ = 0; q_ < NREP(23); ++q_) p3_s5_hloc(Fi, lq, idx - NCH - 260); }
            }
        }
        SEAM(ph); ++ph; DIAG_ACC(3);
        nrep_ = NREP(4); if (PHEN(4) && IN(ph)) LAUNDERED { for (int q_ = 0; q_ < NREP(16); ++q_) p4_ssd_scan(Fq, lq);
            for (int q_ = 0; q_ < NREP(17); ++q_) for (int it = Fq.bid; it < 256; it += Fq.G) { const Frame Fi = launder(Fq); p4_attn_diff(Fi, lq, it); }
            unsigned* qctr = WSQ(unsigned, WS_CTL) + CW_Q0 + 64 * (10 + lq + rep_ * 8);
            for (;;) { const int idx = q_next(Fq, qctr); if (idx >= 4) break; const Frame Fi = launder(Fq);
                p4_attn_diff(Fi, lq, 256 + idx); } }
        SEAM(ph); ++ph; DIAG_ACC(4);
        nrep_ = NREP(5); if (PHEN(5) && IN(ph)) LAUNDERED {
            if (false && gqa_fast_ok(Fq, lq)) { for (int q_ = 0; q_ < NREP(18); ++q_) for (int it = Fq.bid; it < 256; it += Fq.G) { const Frame Fi = launder(Fq); p4_attn_gqa<true>(Fi, lq, it); } }
            else { for (int q_ = 0; q_ < NREP(18); ++q_) for (int it = Fq.bid; it < 256; it += Fq.G) { const Frame Fi = launder(Fq); p4_attn_gqa<false>(Fi, lq, it); } }
            { unsigned* qctr = WSQ(unsigned, WS_CTL) + CW_Q0 + 64 * (3 + 2 * lq + rep_ * 8);
              for (;;) { const int idx = q_next(Fq, qctr); if (idx >= 2 * NCH + N_S5O + 4) break; const Frame Fi = launder(Fq);
                  if (idx < 2 * NCH) p4_ssd_out(Fi, lq, idx); else if (idx < 2 * NCH + N_S5O) p4_s5_out(Fi, lq, idx - 2 * NCH); else p4_attn_gqa<false>(Fi, lq, 256 + idx - 2 * NCH - N_S5O); } }
        }
        SEAM(ph); ++ph; DIAG_ACC(5);
        nrep_ = NREP(6); if (PHEN(6) && IN(ph)) LAUNDERED p5_finish(Fq, lq);
        SEAM(ph); ++ph; DIAG_ACC(6);
        nrep_ = NREP(7); if (PHEN(7) && IN(ph)) LAUNDERED { pg8::Gemm gm{WSQ(pg8::bf16_t, WS_MIX) + (size_t)CTX * DM, WSQ(pg8::bf16_t, WS_WOUT) + (size_t)lq * DM * DM, SEQ, DM, DM}; pg8::StaticOrder S; S.init(SEQ, DM, Fq.G, Fq.bid);
            EpiRes E; E.C = WSQ(float, WS_XA); E.g1 = WSQ(float, WS_MOD) + (size_t)lq * 2 * 6144 + 2 * 1024;
            if (lq == 0) { E.res_ctx = ((const float*)Fq.in[I_CTX]); E.res_lat = ((const float*)Fq.in[I_X]); } else { E.res_ctx = WSQ(float, WS_XB); E.res_lat = WSQ(float, WS_XB) + (size_t)CTX * DM; }
            pg8::gemm_phase<EpiRes, pg8::StaticOrder>((PG8_LAS unsigned char*)Fq.lds, gm, S, E);
            if (lq < DEPTH - 1) outproj_ctx(Fq, lq, E.res_ctx); }
        SEAM(ph); ++ph; DIAG_ACC(7);
        nrep_ = NREP(8); if (PHEN(8) && IN(ph)) LAUNDERED p7a_router(Fq, lq, rep_);
        SEAM(ph); ++ph; DIAG_ACC(8);
        nrep_ = NREP(10); if (PHEN(10) && IN(ph)) LAUNDERED { const int ntiles = moe_tables(Fq, lq); const LAS int* t2e = (const LAS int*)(Fq.lds + LDS_MISC) + 64;
            moe_rows(Fq, lq, ntiles, 8);
            pg8::Gemm gm{WSQ(pg8::bf16_t, WS_H), WSQ(pg8::bf16_t, WS_WGU) + (size_t)lq * NEXP * 2048 * DM, CAP, 2048, DM};
            MoeOrder S{8, ntiles, Fq.G, Fq.bid, t2e, (long)2048 * DM * 2};
            moe_bias(Fq, ntiles, 8, ((const float*)Fq.in[I_BGU]) + (size_t)lq * NEXP * 2048, 2048);
            EpiAct E{WSQ(bf16_t, WS_ACT), (const LAS float*)(Fq.lds + LDS_BIASL)};
            if (STAG_GU) xcd_stagger(Fq, STAG_GU);
            pg8::gemm_phase_gather<EpiAct, MoeOrder>((PG8_LAS unsigned char*)Fq.lds, gm, S, E, (const PG8_LAS int*)(Fq.lds + LDS_MISC + 2048)); }
        SEAM(ph); ++ph; DIAG_ACC(10);
        nrep_ = NREP(11); if (PHEN(11) && IN(ph)) LAUNDERED { const int ntiles = moe_tables(Fq, lq); const LAS int* t2e = (const LAS int*)(Fq.lds + LDS_MISC) + 64;
            pg8::Gemm gm{WSQ(pg8::bf16_t, WS_ACT), WSQ(pg8::bf16_t, WS_WDN) + (size_t)lq * NEXP * DM * DM, CAP, DM, DM};
            MoeOrder S{4, ntiles, Fq.G, Fq.bid, t2e, (long)DM * DM * 2};
            moe_bias(Fq, ntiles, 4, ((const float*)Fq.in[I_BDN]) + (size_t)lq * NEXP * DM, DM);
            EpiDown E{WSQ(bf16_t, WS_YB), (const LAS float*)(Fq.lds + LDS_BIASL), REP_SKIP_STORES * rep_, WSQ(bf16_t, WS_U)};
            if (STAG_DN) xcd_stagger(Fq, STAG_DN);
            pg8::gemm_phase<EpiDown, MoeOrder>((PG8_LAS unsigned char*)Fq.lds, gm, S, E); }
        SEAM(ph); ++ph; DIAG_ACC(11);
    }
#if DIAG
    if (blockIdx.x == 0 && threadIdx.x < 16) __hip_atomic_store((unsigned*)(F.ws + WS_CTL) + 5000 + threadIdx.x, dg[threadIdx.x], __ATOMIC_RELAXED, __HIP_MEMORY_SCOPE_AGENT);
    xcd_barrier(bar);
    { const unsigned* dgw = (const unsigned*)(F.ws + WS_CTL) + 5000;
      const float ta = (float)__hip_atomic_load(dgw + DIAG_A, __ATOMIC_RELAXED, __HIP_MEMORY_SCOPE_AGENT) * 0.01f;
      const float cval = sqrtf(ta * (1.f / DIAG_DIV));
      for (size_t i = (size_t)blockIdx.x * 512 + threadIdx.x; i < (size_t)SEQ * DM; i += (size_t)gridDim.x * 512) F.out[i] = cval; }
#else
    nrep_ = NREP(12); if (PHEN(12) && IN(ph)) LAUNDERED { (void)lq; p1_norm<true>(Fq, DEPTH); }
#endif
#undef IN
#undef SEAM
}

#ifndef N_LAUNCH_MODE
#define N_LAUNCH_MODE 1
#endif
extern "C" void kernel_launch(void* const* d_in, const int* in_sizes, int n_in, void* d_out, int out_size, void* d_ws, size_t ws_size, hipStream_t stream) {
    static int grid = 0;
    if (grid == 0) {
        if (n_in != N_IN || out_size != SEQ * DM || ws_size < WS_END) { fprintf(stderr, "kernel_launch: unexpected shapes (n_in %d, out %d, ws %zu < %zu)\n", n_in, out_size, ws_size, (size_t)WS_END); grid = -1; return; }
        int dev = 0, cus = 0, per_cu = 0;
        if (hipGetDevice(&dev) != hipSuccess || hipDeviceGetAttribute(&cus, hipDeviceAttributeMultiprocessorCount, dev) != hipSuccess) { grid = -1; return; }
        if (hipFuncSetAttribute((const void*)hybrid_fwd, hipFuncAttributeMaxDynamicSharedMemorySize, LDS_BYTES) != hipSuccess) { fprintf(stderr, "kernel_launch: hipFuncSetAttribute failed\n"); grid = -1; return; }
        if (hipOccupancyMaxActiveBlocksPerMultiprocessor(&per_cu, (const void*)hybrid_fwd, 512, LDS_BYTES) != hipSuccess || per_cu < 1) { fprintf(stderr, "kernel_launch: occupancy query says %d\n", per_cu); }
        (void)hipGetLastError();
        grid = cus;
    }
    if (grid < 0) return;
    (void)hipMemsetAsync((char*)d_ws + WS_CTL, 0, CTL_BYTES, stream);
    Args a{};
    for (int i = 0; i < N_IN; ++i) a.in[i] = (const float*)d_in[i];
    a.out = (float*)d_out; a.ws = (unsigned char*)d_ws;
#if N_LAUNCH_MODE == 1
    a.ph_lo = 0; a.ph_hi = N_PHASES;
    hipLaunchKernelGGL(hybrid_fwd, dim3(grid), dim3(512), LDS_BYTES, stream, a);
#else
    for (int p = 0; p < N_PHASES; ++p) { a.ph_lo = p; a.ph_hi = p + 1; hipLaunchKernelGGL(hybrid_fwd, dim3(grid), dim3(512), LDS_BYTES, stream, a); }
#endif
}
```

```cpp
#include <hip/hip_runtime.h>
#include <cstdio>
#include <cstdint>

#define DI __device__ __forceinline__
typedef float f32x2 __attribute__((ext_vector_type(2)));
typedef float f32x16 __attribute__((ext_vector_type(16)));
typedef unsigned u32x2 __attribute__((ext_vector_type(2)));
typedef __bf16 hbf2 __attribute__((ext_vector_type(2)));

constexpr int DM = 1024, SEQ = 16384, CTX = 256, NT = SEQ + CTX, DEPTH = 4;
constexpr int DIN = 2568, NU = 2560;
constexpr int DT_COL = 1792;
constexpr int NEXP = 32, TOPK = 4;
constexpr int CAP = 292 * 256;
constexpr float EPS = 1e-6f;
constexpr float LOG2E = 1.4426950408889634f;
constexpr int NCH = NT / 128;
constexpr int S5L = 64, NC5 = NT / S5L;
constexpr int U_DQ = 0, U_DK = 256, U_DV = 512, U_Z = 768, U_XS = 1024, U_B = 1280, U_C = 1536, U_S5 = 1792, U_GQ = 2048, U_GK = 2304, U_GV = 2432;

enum { I_X = 0, I_C, I_CTX, I_CCTX, I_WADA, I_BADA, I_N1W, I_N2W, I_WIN, I_WOUT, I_LQ1, I_LK1, I_LQ2, I_LK2, I_SUBLN,
       I_CONVW, I_CONVB, I_DTB, I_ALOG, I_SSDD, I_SSDNW, I_LAMRE, I_LAMIM, I_LOGDT, I_BRE, I_BIM, I_CRE, I_CIM, I_S5D, I_WGLU, I_BGLU,
       I_QNW, I_KNW, I_WR, I_BR, I_WGU, I_BGU, I_WDN, I_BDN, I_FNW, N_IN };

constexpr size_t al256(size_t x) { return (x + 255) & ~(size_t)255; }
constexpr size_t WS_CTL   = 0;
constexpr size_t CTL_BYTES = 65536;
constexpr int CW_BAR = 0;
constexpr int CW_KMAX = 4096;
constexpr int CW_CNT = 4096 + 128;
constexpr int CW_Q0 = 4096 + 128 + 128;
constexpr size_t WS_MOD   = WS_CTL + CTL_BYTES;
constexpr size_t WS_ROPE  = al256(WS_MOD + (size_t)DEPTH * 2 * 6144 * 4);
constexpr size_t WS_LAM   = al256(WS_ROPE + 256 * 8 * 8 + 256 * 16 * 8);
constexpr size_t WS_WIN   = al256(WS_LAM + 256);
constexpr size_t WS_WOUT  = al256(WS_WIN + (size_t)DEPTH * NU * DM * 2);
constexpr size_t WS_WGU   = al256(WS_WOUT + (size_t)DEPTH * DM * DM * 2);
constexpr size_t WS_WDN   = al256(WS_WGU + (size_t)DEPTH * NEXP * 2048 * DM * 2);
constexpr size_t WS_WGLU  = al256(WS_WDN + (size_t)DEPTH * NEXP * DM * DM * 2);
constexpr size_t WS_KTAB  = al256(WS_WGLU + (size_t)DEPTH * 256 * 256 * 2);
constexpr size_t WS_CC5   = al256(WS_KTAB + (size_t)DEPTH * 16 * 3 * 64 * 256 * 2);
constexpr size_t WS_E5    = al256(WS_CC5 + (size_t)DEPTH * 16 * 1024 * 256 * 2);
constexpr size_t WS_APOW  = al256(WS_E5 + (size_t)DEPTH * 16 * 2 * 128 * 1024 * 2);
constexpr size_t WS_XA    = al256(WS_APOW + (size_t)DEPTH * 16 * 2 * 64 * 8);
constexpr size_t WS_XB    = al256(WS_XA + (size_t)NT * DM * 4);
constexpr size_t WS_H     = al256(WS_XB + (size_t)NT * DM * 4);
constexpr size_t WS_U     = al256(WS_H + (size_t)NT * DM * 2);
constexpr size_t WS_DTRAW = al256(WS_U + (size_t)NT * NU * 2);
constexpr size_t WS_QD    = al256(WS_DTRAW + (size_t)NT * 8 * 4);
constexpr size_t WS_KD    = al256(WS_QD + (size_t)4 * NT * 64 * 2);
constexpr size_t WS_VTD   = al256(WS_KD + (size_t)4 * NT * 64 * 2);
constexpr size_t WS_QG    = al256(WS_VTD + (size_t)4 * NT * 64 * 2);
constexpr size_t WS_KG    = al256(WS_QG + (size_t)4 * NT * 64 * 2);
constexpr size_t WS_VTG   = al256(WS_KG + (size_t)2 * NT * 64 * 2);
constexpr size_t WS_QND   = al256(WS_VTG + (size_t)2 * NT * 64 * 2);
constexpr size_t WS_QNG   = al256(WS_QND + (size_t)8 * NT * 4);
constexpr size_t WS_XST   = al256(WS_QNG + (size_t)4 * NT * 4);
constexpr size_t WS_BN    = al256(WS_XST + (size_t)NT * 256 * 2);
constexpr size_t WS_CN    = al256(WS_BN + (size_t)NT * 256 * 2);
constexpr size_t WS_DTV   = al256(WS_CN + (size_t)NT * 256 * 2);
constexpr size_t WS_CUM   = al256(WS_DTV + (size_t)NT * 8 * 4);
constexpr size_t WS_SLOC  = al256(WS_CUM + (size_t)NT * 8 * 4);
constexpr size_t WS_SIN   = al256(WS_SLOC + (size_t)NCH * 8 * 64 * 128 * 4);
constexpr size_t WS_YSSD  = al256(WS_SIN + (size_t)NCH * 8 * 64 * 128 * 2);
constexpr size_t WS_SSQ   = al256(WS_YSSD + (size_t)NT * 256 * 2);
constexpr size_t WS_HLOC  = al256(WS_SSQ + (size_t)NT * 4 * 4);
constexpr size_t WS_HIN   = al256(WS_HLOC + (size_t)NC5 * 4096 * 4);
constexpr size_t WS_YS5   = al256(WS_HIN + (size_t)NC5 * 4096 * 2);
constexpr size_t WS_US5   = al256(WS_YS5 + (size_t)NT * 256 * 2);
constexpr size_t WS_MIX   = al256(WS_US5 + (size_t)NT * 256 * 2);
constexpr size_t WS_TOPE  = al256(WS_MIX + (size_t)NT * DM * 2);
constexpr size_t WS_TOPP  = al256(WS_TOPE + (size_t)NT * 16);
constexpr size_t WS_TOPG  = al256(WS_TOPP + (size_t)NT * 16);
constexpr size_t WS_TOPS  = al256(WS_TOPG + (size_t)NT * 16);
constexpr size_t WS_ASLOT = al256(WS_TOPS + (size_t)NEXP * NT * 4);
constexpr size_t WS_ACT   = al256(WS_ASLOT + (size_t)CAP * DM * 2);
constexpr size_t WS_YB    = al256(WS_ACT + (size_t)CAP * DM * 2);
constexpr size_t WS_END   = al256(WS_YB + (size_t)CAP * DM * 2);

constexpr int LDS_BYTES = 160 * 1024;
constexpr int LDS_MISC = 128 * 1024;
#define LAS __attribute__((address_space(3)))
#define GAS __attribute__((address_space(1)))

struct Args { const float* in[N_IN]; float* out; unsigned char* ws; int ph_lo, ph_hi; };

typedef unsigned short bf16_t;
typedef short bf16x8 __attribute__((ext_vector_type(8)));
typedef float f32x4 __attribute__((ext_vector_type(4)));
typedef unsigned u32x4 __attribute__((ext_vector_type(4)));

DI unsigned pk2(float lo, float hi) { f32x2 v = {lo, hi}; hbf2 b = __builtin_convertvector(v, hbf2); return __builtin_bit_cast(unsigned, b); }
DI bf16_t f2bf(float f) { return (bf16_t)(pk2(f, 0.f) & 0xffffu); }
DI float bf2f(bf16_t b) { return __uint_as_float(((unsigned)b) << 16); }
DI float bflo(unsigned u) { return __uint_as_float(u << 16); }
DI float bfhi(unsigned u) { return __uint_as_float(u & 0xffff0000u); }
DI f32x16 mfma32(bf16x8 a, bf16x8 b, f32x16 c) { return __builtin_amdgcn_mfma_f32_32x32x16_bf16(a, b, c, 0, 0, 0); }
DI int kperm(int m) { return (m & 0x13) | ((m & 4) << 1) | ((m & 8) >> 1); }
DI int crow(int i, int h) { return (i & 3) + 8 * (i >> 2) + 4 * h; }
DI bf16x8 ld8g(const bf16_t* p) { return *(const bf16x8*)p; }
template <int CTRL> DI float dppf(float v) { return __builtin_bit_cast(float, __builtin_amdgcn_update_dpp(0, __builtin_bit_cast(int, v), CTRL, 0xF, 0xF, true)); }
DI float rlane(float v, int l) { return __builtin_bit_cast(float, __builtin_amdgcn_readlane(__builtin_bit_cast(int, v), l)); }
DI float wave_sum(float v) {
    v += dppf<0xB1>(v); v += dppf<0x4E>(v); v += dppf<0x141>(v); v += dppf<0x140>(v);
    return (rlane(v, 0) + rlane(v, 16)) + (rlane(v, 32) + rlane(v, 48));
}
DI float wave_max(float v) {
    v = fmaxf(v, dppf<0xB1>(v)); v = fmaxf(v, dppf<0x4E>(v)); v = fmaxf(v, dppf<0x141>(v)); v = fmaxf(v, dppf<0x140>(v));
    return fmaxf(fmaxf(rlane(v, 0), rlane(v, 16)), fmaxf(rlane(v, 32), rlane(v, 48)));
}
DI float silu_f(float x) { return x * __builtin_amdgcn_rcpf(1.f + __builtin_amdgcn_exp2f(-1.4426950408889634f * x)); }
DI float sigmoid_f(float x) { return __builtin_amdgcn_rcpf(1.f + __builtin_amdgcn_exp2f(-1.4426950408889634f * x)); }
template <int S> DI bf16x8 pack_step(const f32x16& x) {
    u32x4 p;
    p[0] = pk2(x[8 * S + 0], x[8 * S + 1]); p[1] = pk2(x[8 * S + 2], x[8 * S + 3]);
    p[2] = pk2(x[8 * S + 4], x[8 * S + 5]); p[3] = pk2(x[8 * S + 6], x[8 * S + 7]);
    return __builtin_bit_cast(bf16x8, p);
}
DI f32x16 splat16(float v) { f32x16 r;
#pragma unroll
    for (int i = 0; i < 16; ++i) r[i] = v; return r; }
#define XB_TMO      128
#define XB_XCNT(j)  (256  + 64 * (j))
#define XB_XSUB(j)  (1280 + 64 * (j))
#define XB_XGEN(j)  (2304 + 64 * (j))
#define XB_TOP      3328
#define XB_TOPGEN   3392
#define XCD_BAR_WORDS 3456
#define XB_SPIN_CAP (1u << 18)
#define LAS __attribute__((address_space(3)))

__device__ __forceinline__ unsigned xb_ld(unsigned* p)              { return __hip_atomic_load(p, __ATOMIC_RELAXED, __HIP_MEMORY_SCOPE_AGENT); }
__device__ __forceinline__ unsigned xb_add(unsigned* p, unsigned v) { return __hip_atomic_fetch_add(p, v, __ATOMIC_RELAXED, __HIP_MEMORY_SCOPE_AGENT); }
__device__ __forceinline__ unsigned xb_xcc_id() { return (unsigned)__builtin_amdgcn_s_getreg((3 << 11) | 20) & 0xFu; }
#define XB_SPIN(cond, bar) do { unsigned _sp = 0; while (cond) { __builtin_amdgcn_s_sleep(1); \
    if ((++_sp & 255u) == 0u) { if (xb_ld(&(bar)[XB_TMO])) break; if (_sp > XB_SPIN_CAP) { atomicAdd(&(bar)[XB_TMO], 1u); break; } } } } while (0)

struct XcdBarrier {
    unsigned* bar; unsigned x;
    volatile LAS unsigned* st;
};

__device__ __forceinline__ XcdBarrier xcd_barrier_post(unsigned* bar, volatile LAS unsigned* st) {
    XcdBarrier b; b.bar = bar; b.x = xb_xcc_id(); b.st = st;
    if (threadIdx.x == 0) (void)xb_add(&bar[XB_XCNT(b.x)], 1u);
    return b;
}
__device__ __forceinline__ void xcd_barrier_complete(unsigned* bar, unsigned x, unsigned& nloc, unsigned& nx) {
    const unsigned G = gridDim.x * gridDim.y * gridDim.z;
    unsigned sum, cnt, mine, sp = 0u;
    for (;;) {
        sum = 0u; cnt = 0u; mine = 0u;
#pragma unroll
        for (unsigned j = 0; j < 16; ++j) { const unsigned c = xb_ld(&bar[XB_XCNT(j)]); sum += c; cnt += (c > 0u) ? 1u : 0u; mine = (j == x) ? c : mine; }
        if (sum == G) break;
        __builtin_amdgcn_s_sleep(1);
        if ((++sp & 255u) == 0u) { if (xb_ld(&bar[XB_TMO])) break; if (sp > XB_SPIN_CAP) { atomicAdd(&bar[XB_TMO], 1u); break; } }
    }
    nloc = mine > 0u ? mine : 1u; nx = cnt > 0u ? cnt : 1u;
}

__device__ __forceinline__ void xcd_barrier(const XcdBarrier& b) {
    asm volatile("s_waitcnt vmcnt(0)" ::: "memory");
    __syncthreads();
    if (threadIdx.x == 0) {
        unsigned* bar = b.bar;
        __builtin_amdgcn_s_waitcnt(0);
        unsigned nloc = b.st[0], nx = b.st[1];
        if (nloc == 0u) { xcd_barrier_complete(bar, b.x, nloc, nx); b.st[0] = nloc; b.st[1] = nx; }
        const unsigned old = xb_add(&bar[XB_XSUB(b.x)], 1u);
        const unsigned gen = old / nloc;
        if (old + 1u == (gen + 1u) * nloc) {
            __builtin_amdgcn_fence(__ATOMIC_RELEASE, "agent");
            asm volatile("s_waitcnt vmcnt(0)" ::: "memory");
            const unsigned og = xb_add(&bar[XB_TOP], 1u);
            const unsigned tg = og / nx;
            if (og + 1u == (tg + 1u) * nx) xb_add(&bar[XB_TOPGEN], 1u);
            else XB_SPIN(xb_ld(&bar[XB_TOPGEN]) == tg, bar);
            __builtin_amdgcn_fence(__ATOMIC_ACQUIRE, "agent");
            xb_add(&bar[XB_XGEN(b.x)], 1u);
            asm volatile("s_waitcnt vmcnt(0)" ::: "memory");
        } else {
            XB_SPIN(xb_ld(&bar[XB_XGEN(b.x)]) == gen, bar);
            __builtin_amdgcn_fence(__ATOMIC_ACQUIRE, "agent");
            asm volatile("s_waitcnt vmcnt(0)" ::: "memory");
        }
    }
    __syncthreads();
}
namespace pg8 {
#define PG8_LAS __attribute__((address_space(3)))
typedef unsigned short bf16_t;
typedef short bf16x8 __attribute__((ext_vector_type(8)));
typedef float f32x4 __attribute__((ext_vector_type(4)));
typedef unsigned u32x4 __attribute__((ext_vector_type(4)));
constexpr int BM = 256, BK = 64, HALF = 128, HTB = HALF * BK * 2  , STAGE_BYTES = 8 * HTB, NXCD = 8, WGM = 8;

__host__ __device__ __forceinline__ int lds_byte(int r, int c) { const int st = (r >> 4) * 2 + (c >> 5), rr = r & 15, cc = c & 31, ob = rr * 64 + cc * 2; return st * 1024 + (ob ^ (((ob >> 9) & 1) << 5)); }
__host__ __device__ __forceinline__ void stage_rc(int b, int& R, int& C) { const int st = b / 1024, sb = b % 1024, swz = sb ^ (((sb >> 9) & 1) << 5); R = (st >> 1) * 16 + swz / 64; C = (st & 1) * 32 + (swz % 64) / 2; }
__host__ __device__ __forceinline__ int perm32(int rho) { const int n = rho >> 4, i = rho & 15; return 8 * (i >> 2) + 4 * n + (i & 3); }

struct Unit { int pm, pn; long boff; };
struct Gemm { const bf16_t* A; const bf16_t* Bt; int M, N, K; };

struct StaticOrder {
    int nM, nN, nwg, G, c;
    __host__ __device__ void init(int M, int N, int G_, int c_) { nM = M / BM; nN = N / BM; nwg = nM * nN; G = G_; c = c_; }
    __host__ __device__ bool next(int i, Unit& u) const {
        const long L = (long)i * G + c; if (L >= nwg) return false;
        int wgid = (int)L; { const int q = nwg / NXCD, r = nwg % NXCD, xcd = wgid % NXCD, off = wgid / NXCD; wgid = (xcd < r ? xcd * (q + 1) : r * (q + 1) + (xcd - r) * q) + off; }
        const int nig = WGM * nN, gid = wgid / nig, fm = gid * WGM, gsz = (nM - fm) < WGM ? (nM - fm) : WGM;
        u.pm = fm + ((wgid % nig) % gsz); u.pn = (wgid % nig) / gsz; u.boff = 0; return true;
    }
    __device__ __forceinline__ void a_ready(const Unit&) const {}
    __device__ __forceinline__ void done(const Unit&) const {}
};
__device__ __forceinline__ unsigned cvt_pk_bf16(float lo, float hi) { unsigned r; asm volatile("v_cvt_pk_bf16_f32 %0, %1, %2" : "=v"(r) : "v"(lo), "v"(hi)); return r; }
template <class Epi, class Sched, bool STAMP = false>
__device__ __forceinline__ void gemm_phase(PG8_LAS unsigned char* lds, const Gemm g, const Sched& S, const Epi& E, unsigned long long* stamps = nullptr) {
    int tid_l = threadIdx.x; asm volatile("" : "+v"(tid_l)); const int tid = tid_l, wid = __builtin_amdgcn_readfirstlane(tid >> 6), lane = tid & 63, wr = wid >> 2, wc = wid & 3, fr = lane & 15, fq = lane >> 4;
    const int K = g.K, nt = K / BK;
    int ts_lo = 0, ts_hi = 0, nts = 0; const unsigned long long rt_entry = STAMP ? (unsigned long long)wall_clock64() : 0ull;
#define PG8_STAMP() do { if (STAMP && wid == 0 && nts < 64) { const unsigned long long _c = (unsigned long long)clock64(); \
        ts_lo = (lane == nts) ? (int)(unsigned)_c : ts_lo; ts_hi = (lane == nts) ? (int)(unsigned)(_c >> 32) : ts_hi; ++nts; } } while (0)
    PG8_STAMP();
    unsigned voffA[2], voffB[2];
#pragma unroll
    for (int i = 0; i < 2; ++i) { int R, C; stage_rc(tid * 16 + i * 8192, R, C); const int Rb = Epi::PERM ? ((R & ~31) + perm32(R & 31)) : R;
        voffA[i] = (unsigned)(R * K + C) * 2u; voffB[i] = (unsigned)(Rb * K + C) * 2u; }
    const size_t kstep = (size_t)(BK * 2);
    const size_t hstep = (size_t)HALF * K * 2;
    const size_t tstep = 2 * hstep;
    const unsigned ldsw = (unsigned)wid * 1024u;
    const int aoff = lds_byte(wr * 64 + fr, fq * 8), boff = lds_byte(wc * 32 + fr, fq * 8);
#define PG8_SA(b, h) (((b) * 2 + (h)) * HTB)
#define PG8_SB(b, h) ((4 + (b) * 2 + (h)) * HTB)
#define PG8_STAGE(bufoff, gbase, voff) do { _Pragma("unroll") for (int _i = 0; _i < 2; ++_i) \
        __builtin_amdgcn_global_load_lds((const unsigned*)((const char*)(gbase) + (voff)[_i]), (PG8_LAS unsigned*)(lds + (bufoff) + ldsw + _i * 8192), 16, 0, 0); } while (0)
#define PG8_LDA(dst, b, h) do { _Pragma("unroll") for (int m = 0; m < 4; ++m) _Pragma("unroll") for (int k = 0; k < 2; ++k) dst[m][k] = *(const PG8_LAS bf16x8*)(lds + PG8_SA(b, h) + aoff + m * 2048 + k * 1024); } while (0)
#define PG8_LDB(dst, b, h) do { _Pragma("unroll") for (int n = 0; n < 2; ++n) _Pragma("unroll") for (int k = 0; k < 2; ++k) dst[n][k] = *(const PG8_LAS bf16x8*)(lds + PG8_SB(b, h) + boff + n * 2048 + k * 1024); } while (0)
#define PG8_MMA(ai, bj, At, Bt) do { __builtin_amdgcn_s_setprio(1); _Pragma("unroll") for (int m = 0; m < 4; ++m) _Pragma("unroll") for (int n = 0; n < 2; ++n) _Pragma("unroll") for (int k = 0; k < 2; ++k) \
        acc[ai][bj][m][n] = __builtin_amdgcn_mfma_f32_16x16x32_bf16(Bt[n][k], At[m][k], acc[ai][bj][m][n], 0, 0, 0); __builtin_amdgcn_s_setprio(0); } while (0)
#define PG8_WAIT_V(n) asm volatile("s_waitcnt vmcnt(" #n ")" ::: "memory")
#define PG8_WAIT_L(n) asm volatile("s_waitcnt lgkmcnt(" #n ")" ::: "memory")
#define PG8_BAR __builtin_amdgcn_s_barrier()
#define PG8_SCHED __builtin_amdgcn_sched_barrier(0)
    Unit cur, nxt; int ui = 0;
    if (!S.next(0, cur)) return;
    f32x4 acc[2][2][4][2];
#pragma unroll
    for (int a = 0; a < 2; ++a)
#pragma unroll
        for (int b = 0; b < 2; ++b)
#pragma unroll
            for (int m = 0; m < 4; ++m)
#pragma unroll
                for (int n = 0; n < 2; ++n) acc[a][b][m][n] = (f32x4){0.f, 0.f, 0.f, 0.f};
    bf16x8 At[4][2], B0[2][2], B1[2][2];
    const char* cA = (const char*)g.A + (size_t)cur.pm * tstep; const char* cB = (const char*)g.Bt + (size_t)cur.pn * tstep + cur.boff;
    S.a_ready(cur);
    PG8_STAGE(PG8_SB(0, 0), cB, voffB); PG8_STAGE(PG8_SA(0, 0), cA, voffA); PG8_STAGE(PG8_SB(0, 1), cB + hstep, voffB); PG8_STAGE(PG8_SA(0, 1), cA + hstep, voffA);
    if (wr == 1) PG8_BAR;
    PG8_WAIT_V(4); PG8_BAR;
    PG8_STAGE(PG8_SB(1, 0), cB + kstep, voffB); PG8_STAGE(PG8_SA(1, 0), cA + kstep, voffA); PG8_STAGE(PG8_SB(1, 1), cB + hstep + kstep, voffB);
    PG8_WAIT_V(6); PG8_BAR;
    PG8_STAMP();
    for (;;) {
        const bool has_next = S.next(ui + 1, nxt);
        const char* nA = has_next ? (const char*)g.A + (size_t)nxt.pm * tstep : cA; const char* nB = has_next ? (const char*)g.Bt + (size_t)nxt.pn * tstep + nxt.boff : cB;
        for (int t = 0; t < nt; t += 2) {
            const bool last = (t == nt - 2);
            const char* a1 = cA + (size_t)(t + 1) * kstep;
            const char* a2 = last ? nA : cA + (size_t)(t + 2) * kstep; const char* b2 = last ? nB : cB + (size_t)(t + 2) * kstep;
            const char* a3 = a2 + kstep; const char* b3 = b2 + kstep;
            if (last && has_next) S.a_ready(nxt);
            PG8_LDB(B0, 0, 0); PG8_SCHED; PG8_LDA(At, 0, 0); PG8_STAGE(PG8_SA(1, 1), a1 + hstep, voffA);
            PG8_WAIT_L(8); PG8_BAR; PG8_WAIT_L(0); PG8_MMA(0, 0, At, B0); PG8_BAR; PG8_SCHED;
            PG8_LDB(B1, 0, 1); PG8_STAGE(PG8_SB(0, 0), b2, voffB);
            PG8_BAR; PG8_WAIT_L(0); PG8_MMA(0, 1, At, B1); PG8_BAR;
            PG8_LDA(At, 0, 1); PG8_STAGE(PG8_SA(0, 0), a2, voffA);
            PG8_BAR; PG8_WAIT_L(0); PG8_MMA(1, 0, At, B0); PG8_BAR; PG8_SCHED;
            PG8_STAGE(PG8_SB(0, 1), b2 + hstep, voffB);
            PG8_WAIT_V(6); PG8_BAR; PG8_MMA(1, 1, At, B1); PG8_BAR;
            PG8_LDB(B0, 1, 0); PG8_SCHED; PG8_LDA(At, 1, 0); PG8_STAGE(PG8_SA(0, 1), a2 + hstep, voffA);
            PG8_WAIT_L(8); PG8_BAR; PG8_WAIT_L(0); PG8_MMA(0, 0, At, B0); PG8_BAR; PG8_SCHED;
            PG8_LDB(B1, 1, 1); PG8_STAGE(PG8_SB(1, 0), b3, voffB);
            PG8_BAR; PG8_WAIT_L(0); PG8_MMA(0, 1, At, B1); PG8_BAR;
            PG8_LDA(At, 1, 1); PG8_STAGE(PG8_SA(1, 0), a3, voffA);
            PG8_BAR; PG8_WAIT_L(0); PG8_MMA(1, 0, At, B0); PG8_BAR; PG8_SCHED;
            PG8_STAGE(PG8_SB(1, 1), b3 + hstep, voffB);
            PG8_WAIT_V(6); PG8_BAR; PG8_MMA(1, 1, At, B1); PG8_BAR;
        }
        PG8_STAMP();
        if constexpr (!Epi::AFTER_DRAIN) { E(acc, cur, wr, wc, fr, fq); S.done(cur); }
        PG8_STAMP();
        if (!has_next) break;
#pragma unroll
        for (int a = 0; a < 2; ++a)
#pragma unroll
            for (int b = 0; b < 2; ++b)
#pragma unroll
                for (int m = 0; m < 4; ++m)
#pragma unroll
                    for (int n = 0; n < 2; ++n) acc[a][b][m][n] = (f32x4){0.f, 0.f, 0.f, 0.f};
        cur = nxt; cA = nA; cB = nB; ++ui;
    }
    PG8_WAIT_V(0);
    if (wr == 0) PG8_BAR;
    PG8_BAR;
    if constexpr (Epi::AFTER_DRAIN) { E.fused(acc, cur, wr, wc, fr, fq, lds, wid, lane); S.done(cur); }
    PG8_STAMP();
    if (STAMP && wid == 0) { stamps[lane] = lane < nts ? (((unsigned long long)(unsigned)ts_hi << 32) | (unsigned)ts_lo) : 0ull;
        if (lane == 62) stamps[62] = rt_entry; if (lane == 63) stamps[63] = (unsigned long long)wall_clock64(); }
#undef PG8_STAMP
#undef PG8_SA
#undef PG8_SB
#undef PG8_STAGE
#undef PG8_LDA
#undef PG8_LDB
#undef PG8_MMA
#undef PG8_WAIT_V
#undef PG8_WAIT_L
#undef PG8_BAR
#undef PG8_SCHED
}
template <class Epi, class Sched, bool STAMP = false>
__device__ __forceinline__ void gemm_phase_gather(PG8_LAS unsigned char* lds, const Gemm g, const Sched& S, const Epi& E, const PG8_LAS int* rows, unsigned long long* stamps = nullptr) {
    int tid_l = threadIdx.x; asm volatile("" : "+v"(tid_l)); const int tid = tid_l, wid = __builtin_amdgcn_readfirstlane(tid >> 6), lane = tid & 63, wr = wid >> 2, wc = wid & 3, fr = lane & 15, fq = lane >> 4;
    const int K = g.K, nt = K / BK;
    int ts_lo = 0, ts_hi = 0, nts = 0; const unsigned long long rt_entry = STAMP ? (unsigned long long)wall_clock64() : 0ull;
#define PG8_STAMP() do { if (STAMP && wid == 0 && nts < 64) { const unsigned long long _c = (unsigned long long)clock64(); \
        ts_lo = (lane == nts) ? (int)(unsigned)_c : ts_lo; ts_hi = (lane == nts) ? (int)(unsigned)(_c >> 32) : ts_hi; ++nts; } } while (0)
    PG8_STAMP();
    unsigned voffA[2], voffB[2];
#pragma unroll
    for (int i = 0; i < 2; ++i) { int R, C; stage_rc(tid * 16 + i * 8192, R, C); const int Rb = Epi::PERM ? ((R & ~31) + perm32(R & 31)) : R;
        voffA[i] = (unsigned)(R * K + C) * 2u; voffB[i] = (unsigned)(Rb * K + C) * 2u; }
    int RA[2]; { int R_, C_; stage_rc(tid * 16, R_, C_); RA[0] = R_; stage_rc(tid * 16 + 8192, R_, C_); RA[1] = R_; }
    unsigned caoff[2]; { int R_, C_; stage_rc(tid * 16, R_, C_); caoff[0] = (unsigned)C_ * 2u; stage_rc(tid * 16 + 8192, R_, C_); caoff[1] = (unsigned)C_ * 2u; }
    unsigned offC[2][2], offN[2][2];
#define PG8_ROWOFF(dst, uidx) do { _Pragma("unroll") for (int _h = 0; _h < 2; ++_h) _Pragma("unroll") for (int _i = 0; _i < 2; ++_i) (dst)[_h][_i] = (unsigned)rows[(uidx) * 256 + _h * HALF + RA[_i]] * (unsigned)(K * 2) + caoff[_i]; } while (0)
    const size_t kstep = (size_t)(BK * 2);
    const size_t hstep = (size_t)HALF * K * 2;
    const size_t tstep = 2 * hstep;
    const unsigned ldsw = (unsigned)wid * 1024u;
    const int aoff = lds_byte(wr * 64 + fr, fq * 8), boff = lds_byte(wc * 32 + fr, fq * 8);
#define PG8_SA(b, h) (((b) * 2 + (h)) * HTB)
#define PG8_SB(b, h) ((4 + (b) * 2 + (h)) * HTB)
#define PG8_STAGE(bufoff, gbase, voff) do { _Pragma("unroll") for (int _i = 0; _i < 2; ++_i) \
        __builtin_amdgcn_global_load_lds((const unsigned*)((const char*)(gbase) + (voff)[_i]), (PG8_LAS unsigned*)(lds + (bufoff) + ldsw + _i * 8192), 16, 0, 0); } while (0)
#define PG8_LDA(dst, b, h) do { _Pragma("unroll") for (int m = 0; m < 4; ++m) _Pragma("unroll") for (int k = 0; k < 2; ++k) dst[m][k] = *(const PG8_LAS bf16x8*)(lds + PG8_SA(b, h) + aoff + m * 2048 + k * 1024); } while (0)
#define PG8_LDB(dst, b, h) do { _Pragma("unroll") for (int n = 0; n < 2; ++n) _Pragma("unroll") for (int k = 0; k < 2; ++k) dst[n][k] = *(const PG8_LAS bf16x8*)(lds + PG8_SB(b, h) + boff + n * 2048 + k * 1024); } while (0)
#define PG8_MMA(ai, bj, At, Bt) do { __builtin_amdgcn_s_setprio(1); _Pragma("unroll") for (int m = 0; m < 4; ++m) _Pragma("unroll") for (int n = 0; n < 2; ++n) _Pragma("unroll") for (int k = 0; k < 2; ++k) \
        acc[ai][bj][m][n] = __builtin_amdgcn_mfma_f32_16x16x32_bf16(Bt[n][k], At[m][k], acc[ai][bj][m][n], 0, 0, 0); __builtin_amdgcn_s_setprio(0); } while (0)
#define PG8_WAIT_V(n) asm volatile("s_waitcnt vmcnt(" #n ")" ::: "memory")
#define PG8_WAIT_L(n) asm volatile("s_waitcnt lgkmcnt(" #n ")" ::: "memory")
#define PG8_BAR __builtin_amdgcn_s_barrier()
#define PG8_SCHED __builtin_amdgcn_sched_barrier(0)
    Unit cur, nxt; int ui = 0;
    if (!S.next(0, cur)) return;
    f32x4 acc[2][2][4][2];
#pragma unroll
    for (int a = 0; a < 2; ++a)
#pragma unroll
        for (int b = 0; b < 2; ++b)
#pragma unroll
            for (int m = 0; m < 4; ++m)
#pragma unroll
                for (int n = 0; n < 2; ++n) acc[a][b][m][n] = (f32x4){0.f, 0.f, 0.f, 0.f};
    bf16x8 At[4][2], B0[2][2], B1[2][2];
    const char* cA = (const char*)g.A; PG8_ROWOFF(offC, 0); const char* cB = (const char*)g.Bt + (size_t)cur.pn * tstep + cur.boff;
    S.a_ready(cur);
    PG8_STAGE(PG8_SB(0, 0), cB, voffB); PG8_STAGE(PG8_SA(0, 0), cA, offC[0]); PG8_STAGE(PG8_SB(0, 1), cB + hstep, voffB); PG8_STAGE(PG8_SA(0, 1), cA, offC[1]);
    if (wr == 1) PG8_BAR;
    PG8_WAIT_V(4); PG8_BAR;
    PG8_STAGE(PG8_SB(1, 0), cB + kstep, voffB); PG8_STAGE(PG8_SA(1, 0), cA + kstep, offC[0]); PG8_STAGE(PG8_SB(1, 1), cB + hstep + kstep, voffB);
    PG8_WAIT_V(6); PG8_BAR;
    PG8_STAMP();
    for (;;) {
        const bool has_next = S.next(ui + 1, nxt);
        const char* nA = cA; if (has_next) PG8_ROWOFF(offN, ui + 1); else { offN[0][0] = offC[0][0]; offN[0][1] = offC[0][1]; offN[1][0] = offC[1][0]; offN[1][1] = offC[1][1]; } const char* nB = has_next ? (const char*)g.Bt + (size_t)nxt.pn * tstep + nxt.boff : cB;
        for (int t = 0; t < nt; t += 2) {
            const bool last = (t == nt - 2);
            const char* a1 = cA + (size_t)(t + 1) * kstep;
            const char* a2 = last ? nA : cA + (size_t)(t + 2) * kstep; const char* b2 = last ? nB : cB + (size_t)(t + 2) * kstep;
            const char* a3 = a2 + kstep; const char* b3 = b2 + kstep;
            if (last && has_next) S.a_ready(nxt);
            PG8_LDB(B0, 0, 0); PG8_SCHED; PG8_LDA(At, 0, 0); PG8_STAGE(PG8_SA(1, 1), a1, offC[1]);
            PG8_WAIT_L(8); PG8_BAR; PG8_WAIT_L(0); PG8_MMA(0, 0, At, B0); PG8_BAR; PG8_SCHED;
            PG8_LDB(B1, 0, 1); PG8_STAGE(PG8_SB(0, 0), b2, voffB);
            PG8_BAR; PG8_WAIT_L(0); PG8_MMA(0, 1, At, B1); PG8_BAR;
            PG8_LDA(At, 0, 1); { unsigned o2[2] = {last ? offN[0][0] : offC[0][0], last ? offN[0][1] : offC[0][1]}; PG8_STAGE(PG8_SA(0, 0), a2, o2); }
            PG8_BAR; PG8_WAIT_L(0); PG8_MMA(1, 0, At, B0); PG8_BAR; PG8_SCHED;
            PG8_STAGE(PG8_SB(0, 1), b2 + hstep, voffB);
            PG8_WAIT_V(6); PG8_BAR; PG8_MMA(1, 1, At, B1); PG8_BAR;
            PG8_LDB(B0, 1, 0); PG8_SCHED; PG8_LDA(At, 1, 0); { unsigned o2[2] = {last ? offN[1][0] : offC[1][0], last ? offN[1][1] : offC[1][1]}; PG8_STAGE(PG8_SA(0, 1), a2, o2); }
            PG8_WAIT_L(8); PG8_BAR; PG8_WAIT_L(0); PG8_MMA(0, 0, At, B0); PG8_BAR; PG8_SCHED;
            PG8_LDB(B1, 1, 1); PG8_STAGE(PG8_SB(1, 0), b3, voffB);
            PG8_BAR; PG8_WAIT_L(0); PG8_MMA(0, 1, At, B1); PG8_BAR;
            PG8_LDA(At, 1, 1); { unsigned o2[2] = {last ? offN[0][0] : offC[0][0], last ? offN[0][1] : offC[0][1]}; PG8_STAGE(PG8_SA(1, 0), a3, o2); }
            PG8_BAR; PG8_WAIT_L(0); PG8_MMA(1, 0, At, B0); PG8_BAR; PG8_SCHED;
            PG8_STAGE(PG8_SB(1, 1), b3 + hstep, voffB);
            PG8_WAIT_V(6); PG8_BAR; PG8_MMA(1, 1, At, B1); PG8_BAR;
        }
        PG8_STAMP();
        if constexpr (!Epi::AFTER_DRAIN) { E(acc, cur, wr, wc, fr, fq); S.done(cur); }
        PG8_STAMP();
        if (!has_next) break;
#pragma unroll
        for (int a = 0; a < 2; ++a)
#pragma unroll
            for (int b = 0; b < 2; ++b)
#pragma unroll
                for (int m = 0; m < 4; ++m)
#pragma unroll
                    for (int n = 0; n < 2; ++n) acc[a][b][m][n] = (f32x4){0.f, 0.f, 0.f, 0.f};
        cur = nxt; cA = nA; cB = nB; ++ui; offC[0][0] = offN[0][0]; offC[0][1] = offN[0][1]; offC[1][0] = offN[1][0]; offC[1][1] = offN[1][1];
    }
    PG8_WAIT_V(0);
    if (wr == 0) PG8_BAR;
    PG8_BAR;
    if constexpr (Epi::AFTER_DRAIN) { E.fused(acc, cur, wr, wc, fr, fq, lds, wid, lane); S.done(cur); }
    PG8_STAMP();
    if (STAMP && wid == 0) { stamps[lane] = lane < nts ? (((unsigned long long)(unsigned)ts_hi << 32) | (unsigned)ts_lo) : 0ull;
        if (lane == 62) stamps[62] = rt_entry; if (lane == 63) stamps[63] = (unsigned long long)wall_clock64(); }
#undef PG8_STAMP
#undef PG8_SA
#undef PG8_SB
#undef PG8_STAGE
#undef PG8_LDA
#undef PG8_LDB
#undef PG8_MMA
#undef PG8_WAIT_V
#undef PG8_WAIT_L
#undef PG8_BAR
#undef PG8_SCHED
#undef PG8_ROWOFF
}
}

struct Frame {
    LAS unsigned char* lds;
    const GAS float* const __attribute__((address_space(4)))* in;
    GAS unsigned char* ws;
    float* out;
    int tid, lane, wave, G, bid;
};
#define WSP(T, off) ((T*)(F.ws + (off)))

struct ConvItem { const float* src; bf16_t* dst; int ld, ncols, c0, k0, mode, kdim; };
DI int conv_dst_row(int mode, int c) {
    if (mode == 1) return c < DT_COL ? c : (c < DT_COL + 8 ? -1 : c - 8);
    if (mode == 2) { const int j = c >> 1, up = c & 1; return (j >> 7) * 256 + up * 128 + (j & 127); }
    return c;
}
constexpr int N_S5I = DEPTH * 16 * 4, N_ADA = DEPTH * 48, N_CV_WIN = DEPTH * 41 * 4, N_CV_WOUT = DEPTH * 16 * 4, N_CV_GU = DEPTH * NEXP * 32 * 4,
              N_CV_DN = DEPTH * NEXP * 16 * 4, N_CV_GLU = DEPTH * 4;
constexpr int N_CONV = N_CV_WIN + N_CV_WOUT + N_CV_GLU;
DI ConvItem conv_decode(const Frame& F, int it) {
    ConvItem c; c.kdim = DM;
    if (it < N_CV_WIN) { const int l = it / 164, r = it % 164; c.src = ((const float*)F.in[I_WIN]) + (size_t)l * DM * DIN; c.dst = WSP(bf16_t, WS_WIN) + (size_t)l * NU * DM;
        c.ld = DIN; c.ncols = DIN; c.c0 = (r >> 2) * 64; c.k0 = (r & 3) * 256; c.mode = 1; return c; }
    it -= N_CV_WIN;
    if (it < N_CV_WOUT) { const int l = it / 64, r = it % 64; c.src = ((const float*)F.in[I_WOUT]) + (size_t)l * DM * DM; c.dst = WSP(bf16_t, WS_WOUT) + (size_t)l * DM * DM;
        c.ld = DM; c.ncols = DM; c.c0 = (r >> 2) * 64; c.k0 = (r & 3) * 256; c.mode = 0; return c; }
    it -= N_CV_WOUT;
    { const int l = it / 4, r = it % 4; c.src = ((const float*)F.in[I_WGLU]) + (size_t)l * 256 * 256; c.dst = WSP(bf16_t, WS_WGLU) + (size_t)l * 256 * 256;
      c.ld = 256; c.ncols = 256; c.c0 = r * 64; c.k0 = 0; c.mode = 0; c.kdim = 256; return c; }
}
DI void conv_load(const ConvItem& c, int tid, f32x4 (&v)[8]) {
#pragma unroll
    for (int i = 0; i < 8; ++i) { const int idx = tid + 512 * i, k = idx >> 4, c4 = idx & 15; const int col = c.c0 + 4 * c4;
        v[i] = (col < c.ncols) ? *(const f32x4*)(c.src + (size_t)(c.k0 + k) * c.ld + col) : (f32x4){0.f, 0.f, 0.f, 0.f}; }
}
DI int q_next(const Frame& F, unsigned* ctr) {
    LAS int* slot = (LAS int*)(F.lds + LDS_BYTES - 16);
    __syncthreads();
    if (F.tid == 0) *slot = (int)__hip_atomic_fetch_add(ctr, 1u, __ATOMIC_RELAXED, __HIP_MEMORY_SCOPE_AGENT);
    __syncthreads();
    return *slot;
}
DI void p0_convert(const Frame& F, unsigned* ctr) {
    LAS float* T = (LAS float*)F.lds;
    const int tid = F.tid;
    f32x4 v[8];
    int it = q_next(F, ctr);
    if (it >= N_CONV) return;
    ConvItem cur = conv_decode(F, it);
    conv_load(cur, tid, v);
    for (;;) {
#pragma unroll
        for (int i = 0; i < 8; ++i) { const int idx = tid + 512 * i, k = idx >> 4, c4 = idx & 15;
            T[k * 65 + 4 * c4 + 0] = v[i][0]; T[k * 65 + 4 * c4 + 1] = v[i][1]; T[k * 65 + 4 * c4 + 2] = v[i][2]; T[k * 65 + 4 * c4 + 3] = v[i][3]; }
        __syncthreads();
        const int nit = q_next(F, ctr); const bool has_next = nit < N_CONV;
        ConvItem nxt = cur;
        if (has_next) { nxt = conv_decode(F, nit); conv_load(nxt, tid, v); }
#pragma unroll
        for (int i = 0; i < 4; ++i) { const int task = tid + 512 * i, c = task & 63, kc = task >> 6;
            const int col = cur.c0 + c; const int row = (col < cur.ncols) ? conv_dst_row(cur.mode, col) : -1;
            u32x4 o;
#pragma unroll
            for (int j = 0; j < 4; ++j) o[j] = pk2(T[(8 * kc + 2 * j) * 65 + c], T[(8 * kc + 2 * j + 1) * 65 + c]);
            if (row >= 0) *(u32x4*)(cur.dst + (size_t)row * cur.kdim + cur.k0 + 8 * kc) = o; }
        __syncthreads();
        if (!has_next) break;
        cur = nxt; it = nit;
    }
}
DI void p0_adaln(const Frame& F, int item) {
    const int l = item / 48, col0 = (item % 48) * 128, tid = F.tid, part = tid >> 5, ct = tid & 31;
    const float* W = ((const float*)F.in[I_WADA]) + (size_t)l * DM * 6144 + col0 + 4 * ct;
    const float* cl = ((const float*)F.in[I_C]); const float* cc = ((const float*)F.in[I_CCTX]);
    f32x4 al = {0.f, 0.f, 0.f, 0.f}, ac = {0.f, 0.f, 0.f, 0.f};
#pragma unroll 8
    for (int kk = 0; kk < 64; ++kk) { const int k = part * 64 + kk; const f32x4 w = *(const f32x4*)(W + (size_t)k * 6144);
        const float sl = silu_f(cl[k]), sc = silu_f(cc[k]); al += w * sl; ac += w * sc; }
    LAS float* R = (LAS float*)F.lds;
#pragma unroll
    for (int j = 0; j < 4; ++j) { R[(part * 32 + ct) * 8 + j] = al[j]; R[(part * 32 + ct) * 8 + 4 + j] = ac[j]; }
    __syncthreads();
    if (tid < 256) { const int v = tid >> 7, col = tid & 127; float s = 0.f;
#pragma unroll
        for (int p = 0; p < 16; ++p) s += R[(p * 32 + (col >> 2)) * 8 + v * 4 + (col & 3)];
        WSP(float, WS_MOD)[((size_t)l * 2 + v) * 6144 + col0 + col] = s + ((const float*)F.in[I_BADA])[(size_t)l * 6144 + col0 + col]; }
    __syncthreads();
}
DI void p0_rope(const Frame& F) {
    f32x2* rd = WSP(f32x2, WS_ROPE); f32x2* rg = rd + 256 * 8;
    for (int i = F.tid; i < 256 * 8; i += 512) { const int pos = i >> 3, f = i & 7; const float inv = exp2f(-(float)(2 * f) / 16.f * 13.287712379549449f);
        float s, c; sincosf((float)pos * inv, &s, &c); rd[i] = (f32x2){c, s}; }
    if (F.tid < DEPTH) { const int l = F.tid; float s1 = 0.f, s2 = 0.f;
        for (int i = 0; i < 32; ++i) { s1 += ((const float*)F.in[I_LQ1])[l * 32 + i] * ((const float*)F.in[I_LK1])[l * 32 + i]; s2 += ((const float*)F.in[I_LQ2])[l * 32 + i] * ((const float*)F.in[I_LK2])[l * 32 + i]; }
        WSP(float, WS_LAM)[l] = __expf(s1) - __expf(s2) + (0.8f - 0.6f * __expf(-0.3f * (float)l)); }
    for (int i = F.tid; i < 256 * 16; i += 512) { const int pos = i >> 4, f = i & 15; const float inv = exp2f(-(float)(2 * f) / 32.f * 13.287712379549449f);
        float s, c; sincosf((float)pos * inv, &s, &c); rg[i] = (f32x2){c, s}; }
}
DI f32x2 cmul(f32x2 a, f32x2 b) { return (f32x2){a.x * b.x - a.y * b.y, a.x * b.y + a.y * b.x}; }
DI void p0_s5(const Frame& F, int item4) {
    const int item = item4 >> 2, part = item4 & 3;
    const int l = item >> 4, g = item & 15, tid = F.tid;
    LAS f32x2* PW = (LAS f32x2*)F.lds;
    LAS f32x2* BB = PW + 2 * 65 * 64;
    LAS f32x2* CM = BB + 2 * 64 * 16;
    LAS float* D0 = (LAS float*)(CM + 2 * 16 * 64);
    for (int i = tid; i < 2 * 65 * 64; i += 512) { const int dir = i / (65 * 64), n = (i / 64) % 65, p = i & 63;
        const size_t li = (((size_t)l * 2 + dir) * 16 + g) * 64 + p;
        const float step = __expf(((const float*)F.in[I_LOGDT])[((size_t)l * 2 + dir) * 16 + g]);
        const float tr = ((const float*)F.in[I_LAMRE])[li] * step, ti = ((const float*)F.in[I_LAMIM])[li] * step;
        float s, c; sincosf((float)n * ti, &s, &c); const float m = __expf((float)n * tr); PW[i] = (f32x2){m * c, m * s}; }
    __syncthreads();
    for (int i = tid; i < 2 * 64 * 16; i += 512) { const int dir = i >> 10, p = (i >> 4) & 63, c = i & 15;
        const size_t li = (((size_t)l * 2 + dir) * 16 + g) * 64 + p;
        const f32x2 lam = {((const float*)F.in[I_LAMRE])[li], ((const float*)F.in[I_LAMIM])[li]}; const f32x2 a = PW[(dir * 65 + 1) * 64 + p];
        const f32x2 num = {a.x - 1.f, a.y}; const float den = lam.x * lam.x + lam.y * lam.y;
        const f32x2 q = {(num.x * lam.x + num.y * lam.y) / den, (num.y * lam.x - num.x * lam.y) / den};
        const size_t bi = (((size_t)l * 16 + g) * 64 + p) * 16 + c;
        BB[i] = cmul(q, (f32x2){((const float*)F.in[I_BRE])[bi], ((const float*)F.in[I_BIM])[bi]}); }
    for (int i = tid; i < 2 * 16 * 64; i += 512) { const int dir = i >> 10, c = (i >> 6) & 15, p = i & 63;
        const size_t ci = ((((size_t)l * 2 + dir) * 16 + g) * 16 + c) * 64 + p; CM[i] = (f32x2){((const float*)F.in[I_CRE])[ci], ((const float*)F.in[I_CIM])[ci]}; }
    __syncthreads();
    bf16_t* kt = WSP(bf16_t, WS_KTAB) + ((size_t)l * 16 + g) * 3 * 64 * 256;
    {
        const int dir = part >> 1, lag0 = (part & 1) * 32 + (tid >> 8), c = (tid >> 4) & 15, cp = tid & 15;
        float sk[16];
#pragma unroll
        for (int k = 0; k < 16; ++k) sk[k] = 0.f;
#pragma unroll 2
        for (int p = 0; p < 64; ++p) { const f32x2 tq = cmul(CM[(dir * 16 + c) * 64 + p], BB[(dir * 64 + p) * 16 + cp]);
#pragma unroll
            for (int k = 0; k < 16; ++k) { const f32x2 pw = PW[(dir * 65 + lag0 + 2 * k) * 64 + p]; sk[k] += tq.x * pw.x - tq.y * pw.y; } }
#pragma unroll
        for (int k = 0; k < 16; ++k) kt[part * 8192 + tid + 512 * k] = f2bf(sk[k]); }
    __syncthreads();
    if (part == 0) for (int i = tid; i < 256; i += 512) { const int c = i >> 4, cp = i & 15; float s = 0.f;
        for (int dir = 0; dir < 2; ++dir) for (int p = 0; p < 64; ++p) { const f32x2 w = BB[(dir * 64 + p) * 16 + cp]; const f32x2 cm = CM[(dir * 16 + c) * 64 + p]; s += cm.x * w.x - cm.y * w.y; }
        kt[2 * 64 * 256 + i] = f2bf(s + (c == cp ? ((const float*)F.in[I_S5D])[(size_t)l * 256 + g * 16 + c] : 0.f)); }
    bf16_t* e5 = WSP(bf16_t, WS_E5) + ((size_t)l * 16 + g) * 2 * 128 * 1024;
    for (int k = 0; k < 16; ++k) { const int j = part * 8192 + tid + 512 * k, cp0 = (j & 1) * 8, sq = (j >> 1) & 63, m = (j >> 7) & 127, dir = j >> 14, p = m & 63;
        const int n = dir ? sq : 63 - sq; const f32x2 pw = PW[(dir * 65 + n) * 64 + p];
        const LAS f32x4* b4 = (const LAS f32x4*)(BB + (dir * 64 + p) * 16 + cp0); float o[8];
#pragma unroll
        for (int q = 0; q < 4; ++q) { const f32x4 bv = b4[q];
            o[2 * q] = m < 64 ? pw.x * bv[0] - pw.y * bv[1] : pw.x * bv[1] + pw.y * bv[0]; o[2 * q + 1] = m < 64 ? pw.x * bv[2] - pw.y * bv[3] : pw.x * bv[3] + pw.y * bv[2]; }
        u32x4 w; w[0] = pk2(o[0], o[1]); w[1] = pk2(o[2], o[3]); w[2] = pk2(o[4], o[5]); w[3] = pk2(o[6], o[7]); *(u32x4*)(e5 + ((((size_t)(dir * 4 + (m >> 5)) * 64 + sq) * 64 + ((cp0 >> 3) * 32 + (m & 31))) * 8)) = w; }
    bf16_t* cc5 = WSP(bf16_t, WS_CC5) + ((size_t)l * 16 + g) * 1024 * 256;
    for (int k = 0; k < 16; ++k) { const int j = part * 8192 + tid + 512 * k, p0 = (j & 7) * 8, im = (j >> 3) & 1, dir = (j >> 4) & 1, row = j >> 5, t = row >> 4, c = row & 15;
        const int n = dir ? 64 - t : t + 1;
        const LAS f32x4* c4 = (const LAS f32x4*)(CM + (dir * 16 + c) * 64 + p0); const LAS f32x4* p4 = (const LAS f32x4*)(PW + (dir * 65 + n) * 64 + p0); float o[8];
#pragma unroll
        for (int q = 0; q < 4; ++q) { const f32x4 cv = c4[q], pv = p4[q];
            o[2 * q] = im ? -(cv[0] * pv[1] + cv[1] * pv[0]) : cv[0] * pv[0] - cv[1] * pv[1]; o[2 * q + 1] = im ? -(cv[2] * pv[3] + cv[3] * pv[2]) : cv[2] * pv[2] - cv[3] * pv[3]; }
        u32x4 w; w[0] = pk2(o[0], o[1]); w[1] = pk2(o[2], o[3]); w[2] = pk2(o[4], o[5]); w[3] = pk2(o[6], o[7]); *(u32x4*)(cc5 + ((((size_t)(row >> 5) * 16 + (p0 >> 4) + 4 * im + 8 * dir) * 64 + (((p0 >> 3) & 1) * 32 + (row & 31))) * 8)) = w; }
    f32x2* ap = WSP(f32x2, WS_APOW) + ((size_t)l * 16 + g) * 128;
    if (part == 0) for (int i = tid; i < 128; i += 512) ap[i] = PW[((i >> 6) * 65 + 64) * 64 + (i & 63)];
    __syncthreads();
}
DI void p0_prologue(const Frame& F, int rep = 0) {
    for (int it = F.bid; it < N_S5I; it += F.G) p0_s5(F, it);
    unsigned* qa = WSP(unsigned, WS_CTL) + CW_Q0 + 64 * (20 + rep);
    for (;;) { const int it = q_next(F, qa); if (it > N_ADA) break; if (it < N_ADA) p0_adaln(F, it); else p0_rope(F); }
    __syncthreads();
    p0_convert(F, WSP(unsigned, WS_CTL) + CW_Q0 + 64 * rep);
}

constexpr int RPB = 65;
DI int moe_tables(const Frame& F, int l);
template <bool FINAL>
DI void p1_norm(const Frame& F, int l) {
    if (l > 0) (void)moe_tables(F, l - 1);
    const LAS int* PSTL = (const LAS int*)(F.lds + LDS_MISC);
    LAS float* WDT = (LAS float*)F.lds;
    if (!FINAL) {
        for (int i = F.tid; i < 1024 * 8; i += 512) WDT[i] = ((const float*)F.in[I_WIN])[(size_t)l * DM * DIN + (size_t)(i >> 3) * DIN + DT_COL + (i & 7)];
        __syncthreads();
    }
    const float* mod_cur = WSP(float, WS_MOD) + (size_t)(FINAL ? 0 : l) * 2 * 6144;
    const float* mod_prev = WSP(float, WS_MOD) + (size_t)(l > 0 ? l - 1 : 0) * 2 * 6144;
    const int lane = F.lane;
    int slv = 0, gav = 0;
    if (l > 0 && lane < 36) { const int rr = F.wave + 8 * (lane >> 2), rw = F.bid * RPB + rr;
        if (rr < RPB && rw < NT) { slv = PSTL[WSP(int, WS_TOPE)[(size_t)rw * 4 + (lane & 3)]] + WSP(int, WS_TOPP)[(size_t)rw * 4 + (lane & 3)]; gav = WSP(int, WS_TOPG)[(size_t)rw * 4 + (lane & 3)]; } }
    f32x4 xn[4]; u32x2 yn[4][4];
    auto issue_row = [&](int n) __attribute__((always_inline)) {
        const int rr = F.wave + 8 * n, rw0 = F.bid * RPB + rr, rw = (rr < RPB && rw0 < NT) ? rw0 : F.bid * RPB + F.wave;
        if (l == 0) { const float* src = rw < CTX ? ((const float*)F.in[I_CTX]) + (size_t)rw * DM : ((const float*)F.in[I_X]) + (size_t)(rw - CTX) * DM;
#pragma unroll
            for (int i = 0; i < 4; ++i) xn[i] = *(const f32x4*)(src + 256 * i + 4 * lane);
        } else { const float* x1 = WSP(float, WS_XA) + (size_t)rw * DM;
#pragma unroll
            for (int i = 0; i < 4; ++i) xn[i] = *(const f32x4*)(x1 + 256 * i + 4 * lane);
#pragma unroll
            for (int k = 0; k < 4; ++k) { const int slk = __builtin_amdgcn_readlane(slv, 4 * n + k);
#pragma unroll
                for (int i = 0; i < 4; ++i) yn[i][k] = *(const u32x2*)(WSP(bf16_t, WS_YB) + (size_t)slk * DM + 256 * i + 4 * lane); } } };
    issue_row(0);
#pragma unroll 1
    for (int n = 0; n < 9; ++n) {
        const int r = F.wave + 8 * n; if (r >= RPB) break;
        const int row = F.bid * RPB + r; if (row >= NT) break;
        const int v = row < CTX ? 1 : 0;
        f32x4 x[4]; u32x2 yc[4][4];
#pragma unroll
        for (int i = 0; i < 4; ++i) { x[i] = xn[i];
#pragma unroll
            for (int k = 0; k < 4; ++k) yc[i][k] = yn[i][k]; }
        float ga[4];
#pragma unroll
        for (int k = 0; k < 4; ++k) ga[k] = __int_as_float(__builtin_amdgcn_readlane(gav, 4 * n + k));
        asm volatile("" :: "v"(x[0]), "v"(x[1]), "v"(x[2]), "v"(x[3]));
        if (n < 8) issue_row(n + 1);
        if (FINAL && v) continue;
        if (l > 0) {
            const float* g2 = mod_prev + (size_t)v * 6144 + 5 * 1024;
#pragma unroll
            for (int i = 0; i < 4; ++i) { const int col = 256 * i + 4 * lane; f32x4 acc = {0.f, 0.f, 0.f, 0.f};
#pragma unroll
                for (int k = 0; k < 4; ++k) { const u32x2 y = yc[i][k];
                    acc[0] += ga[k] * bflo(y[0]); acc[1] += ga[k] * bfhi(y[0]); acc[2] += ga[k] * bflo(y[1]); acc[3] += ga[k] * bfhi(y[1]); }
                x[i] = x[i] + *(const f32x4*)(g2 + col) * acc;
                if (!FINAL) *(f32x4*)(WSP(float, WS_XB) + (size_t)row * DM + col) = x[i]; }
        }
        float ss = 0.f;
#pragma unroll
        for (int i = 0; i < 4; ++i) ss += x[i][0] * x[i][0] + x[i][1] * x[i][1] + x[i][2] * x[i][2] + x[i][3] * x[i][3];
        ss = wave_sum(ss);
        const float rs = __builtin_amdgcn_rsqf(ss * (1.f / 1024.f) + EPS);
        if (FINAL) {
#pragma unroll
            for (int i = 0; i < 4; ++i) { const int col = 256 * i + 4 * lane; *(f32x4*)(F.out + (size_t)(row - CTX) * DM + col) = x[i] * rs * *(const f32x4*)(((const float*)F.in[I_FNW]) + col); }
        } else {
            const float* nw = ((const float*)F.in[I_N1W]) + (size_t)l * DM; const float* sh = mod_cur + (size_t)v * 6144; const float* sc = sh + 1024;
            float d[8] = {0.f, 0.f, 0.f, 0.f, 0.f, 0.f, 0.f, 0.f};
#pragma unroll
            for (int i = 0; i < 4; ++i) { const int col = 256 * i + 4 * lane;
                const f32x4 h = x[i] * rs * *(const f32x4*)(nw + col) * (*(const f32x4*)(sc + col) + 1.f) + *(const f32x4*)(sh + col);
                u32x2 o; o[0] = pk2(h[0], h[1]); o[1] = pk2(h[2], h[3]);
                *(u32x2*)(WSP(bf16_t, WS_H) + (size_t)row * DM + col) = o;
#pragma unroll
                for (int c = 0; c < 4; ++c) { const f32x4 w0 = *(const LAS f32x4*)(WDT + (col + c) * 8), w1 = *(const LAS f32x4*)(WDT + (col + c) * 8 + 4);
#pragma unroll
                    for (int j = 0; j < 4; ++j) { d[j] += h[c] * w0[j]; d[4 + j] += h[c] * w1[j]; } } }
#pragma unroll
            for (int j = 0; j < 8; ++j) d[j] = wave_sum(d[j]);
            if (lane == 0) { float* o = WSP(float, WS_DTRAW) + (size_t)row * 8;
                *(f32x4*)o = (f32x4){d[0], d[1], d[2], d[3]}; *(f32x4*)(o + 4) = (f32x4){d[4], d[5], d[6], d[7]}; }
        }
    }
    __syncthreads();
}

constexpr int WR_PITCH = 36;
DI void p7a_router(const Frame& F, int l, int rep = 0) {
    LAS float* WR = (LAS float*)F.lds;
    LAS int* CNT = (LAS int*)(F.lds + 1024 * WR_PITCH * 4);
    LAS int* BASE = CNT + 32;
    LAS int* RI = BASE + 32;
    for (int i = F.tid; i < 1024 * 8; i += 512) *(LAS f32x4*)(WR + (i >> 3) * WR_PITCH + 4 * (i & 7)) = *(const f32x4*)(((const float*)F.in[I_WR]) + (size_t)l * DM * 32 + 4 * i);
    if (F.tid < 32) CNT[F.tid] = 0;
    __syncthreads();
    const int lane = F.lane;
    const float* mod = WSP(float, WS_MOD) + (size_t)l * 2 * 6144;
    const float* nw = ((const float*)F.in[I_N2W]) + (size_t)l * DM;
    const float br = ((const float*)F.in[I_BR])[(size_t)l * 32 + ((((lane >> 3) & 1) << 4) | (((lane >> 2) & 1) << 3) | (((lane >> 1) & 1) << 2) | ((lane & 1) << 1) | ((lane >> 5) & 1))];
    auto finish_row = [&](const f32x4 (&lgv)[8], int r, bool valid) __attribute__((always_inline)) {
        float lg[32];
#pragma unroll
        for (int q = 0; q < 8; ++q) { lg[4 * q] = lgv[q][0]; lg[4 * q + 1] = lgv[q][1]; lg[4 * q + 2] = lgv[q][2]; lg[4 * q + 3] = lgv[q][3]; }
        float a16[16], a8[8], a4[4], a2[2], a1;
        { const bool up = lane & 8;
#pragma unroll
          for (int j = 0; j < 16; ++j) { const float send = up ? lg[j] : lg[16 + j]; const float keep = up ? lg[16 + j] : lg[j]; a16[j] = keep + dppf<0x140>(send); } }
        { const bool up = lane & 4;
#pragma unroll
          for (int j = 0; j < 8; ++j) { const float send = up ? a16[j] : a16[8 + j]; const float keep = up ? a16[8 + j] : a16[j]; a8[j] = keep + dppf<0x141>(send); } }
        { const bool up = lane & 2;
#pragma unroll
          for (int j = 0; j < 4; ++j) { const float send = up ? a8[j] : a8[4 + j]; const float keep = up ? a8[4 + j] : a8[j]; a4[j] = keep + dppf<0x4E>(send); } }
        { const bool up = lane & 1;
#pragma unroll
          for (int j = 0; j < 2; ++j) { const float send = up ? a4[j] : a4[2 + j]; const float keep = up ? a4[2 + j] : a4[j]; a2[j] = keep + dppf<0xB1>(send); } }
        { const bool up = lane & 32; const float send = up ? a2[0] : a2[1]; const float keep = up ? a2[1] : a2[0]; a1 = keep + __shfl_xor(send, 32); }
        a1 += __shfl_xor(a1, 16);
        const int myexp = (((lane >> 3) & 1) << 4) | (((lane >> 2) & 1) << 3) | (((lane >> 1) & 1) << 2) | ((lane & 1) << 1) | ((lane >> 5) & 1);
        float val = a1 + br;
        int te[4]; float tv[4];
#pragma unroll
        for (int k = 0; k < 4; ++k) { const float m = wave_max(val); const unsigned long long bal = __ballot(val == m); const int sel = (int)__ffsll((long long)bal) - 1;
            te[k] = (((sel >> 3) & 1) << 4) | (((sel >> 2) & 1) << 3) | (((sel >> 1) & 1) << 2) | ((sel & 1) << 1) | ((sel >> 5) & 1); tv[k] = m; if (myexp == te[k]) val = -INFINITY; }
        if (lane == 0 && valid) { float g[4], s = 0.f;
#pragma unroll
            for (int k = 0; k < 4; ++k) { g[k] = __expf(tv[k] - tv[0]); s += g[k]; }
#pragma unroll
            for (int k = 0; k < 4; ++k) { const int pos = atomicAdd((int*)&CNT[te[k]], 1); RI[(r * 4 + k) * 3 + 0] = te[k]; RI[(r * 4 + k) * 3 + 1] = pos; RI[(r * 4 + k) * 3 + 2] = __float_as_int(g[k] / s); } }
    };
    for (int r0 = F.wave; r0 < RPB; r0 += 16) {
        const int rowA = F.bid * RPB + r0; if (rowA >= NT) break;
        const bool hasB = (r0 + 8 < RPB) && (rowA + 8 < NT);
        const int rowB = hasB ? rowA + 8 : rowA;
        const float* xA = WSP(float, WS_XA) + (size_t)rowA * DM; const float* shA = mod + (size_t)(rowA < CTX ? 1 : 0) * 6144 + 3 * 1024; const float* scA = shA + 1024;
        const float* xB = WSP(float, WS_XA) + (size_t)rowB * DM; const float* shB = mod + (size_t)(rowB < CTX ? 1 : 0) * 6144 + 3 * 1024; const float* scB = shB + 1024;
        f32x4 xa[4], xb[4]; float ssA = 0.f, ssB = 0.f;
#pragma unroll
        for (int i = 0; i < 4; ++i) { xa[i] = *(const f32x4*)(xA + 256 * i + 4 * lane); xb[i] = *(const f32x4*)(xB + 256 * i + 4 * lane);
            ssA += xa[i][0] * xa[i][0] + xa[i][1] * xa[i][1] + xa[i][2] * xa[i][2] + xa[i][3] * xa[i][3];
            ssB += xb[i][0] * xb[i][0] + xb[i][1] * xb[i][1] + xb[i][2] * xb[i][2] + xb[i][3] * xb[i][3]; }
        ssA = wave_sum(ssA); ssB = wave_sum(ssB);
        const float rsA = __builtin_amdgcn_rsqf(ssA * (1.f / 1024.f) + EPS), rsB = __builtin_amdgcn_rsqf(ssB * (1.f / 1024.f) + EPS);
        f32x4 lgA[8], lgB[8];
#pragma unroll
        for (int q = 0; q < 8; ++q) { lgA[q] = (f32x4){0.f, 0.f, 0.f, 0.f}; lgB[q] = (f32x4){0.f, 0.f, 0.f, 0.f}; }
#pragma unroll
        for (int i = 0; i < 4; ++i) { const int col = 256 * i + 4 * lane; const f32x4 nwv = *(const f32x4*)(nw + col);
            xa[i] = xa[i] * rsA * nwv * (*(const f32x4*)(scA + col) + 1.f) + *(const f32x4*)(shA + col);
            xb[i] = xb[i] * rsB * nwv * (*(const f32x4*)(scB + col) + 1.f) + *(const f32x4*)(shB + col);
            { u32x2 o; o[0] = pk2(xa[i][0], xa[i][1]); o[1] = pk2(xa[i][2], xa[i][3]); *(u32x2*)(WSP(bf16_t, WS_H) + (size_t)rowA * DM + col) = o; }
            if (hasB) { u32x2 o; o[0] = pk2(xb[i][0], xb[i][1]); o[1] = pk2(xb[i][2], xb[i][3]); *(u32x2*)(WSP(bf16_t, WS_H) + (size_t)rowB * DM + col) = o; } }
        __builtin_amdgcn_sched_barrier(0);
#pragma unroll
        for (int i = 0; i < 4; ++i) { const int col = 256 * i + 4 * lane;
#pragma unroll
            for (int c = 0; c < 4; ++c) {
                f32x4 w0[8];
#pragma unroll
                for (int q = 0; q < 8; ++q) w0[q] = *(const LAS f32x4*)(WR + (col + c) * WR_PITCH + 4 * q);
#pragma unroll
                for (int q = 0; q < 8; ++q) { lgA[q] += w0[q] * xa[i][c]; lgB[q] += w0[q] * xb[i][c]; }
#pragma unroll
                for (int q = 0; q < 8; ++q) asm volatile("" : "+v"(lgA[q]), "+v"(lgB[q]));
                } }
        finish_row(lgA, r0, true);
        finish_row(lgB, r0 + 8, hasB);
    }
    __syncthreads();
    if (F.tid < 32) BASE[F.tid] = (int)__hip_atomic_fetch_add(WSP(unsigned, WS_CTL) + (rep ? 4500 : CW_CNT) + l * 32 + F.tid, (unsigned)CNT[F.tid], __ATOMIC_RELAXED, __HIP_MEMORY_SCOPE_AGENT);
    __syncthreads();
    if (F.tid < RPB * 4) { const int r = F.tid >> 2, row = F.bid * RPB + r;
        if (row < NT) { const int e = RI[F.tid * 3], pos = RI[F.tid * 3 + 1];
            WSP(int, WS_TOPE)[(size_t)row * 4 + (F.tid & 3)] = e; WSP(int, WS_TOPP)[(size_t)row * 4 + (F.tid & 3)] = BASE[e] + pos; WSP(int, WS_TOPS)[(size_t)e * NT + BASE[e] + pos] = row; WSP(int, WS_TOPG)[(size_t)row * 4 + (F.tid & 3)] = RI[F.tid * 3 + 2]; } }
    __syncthreads();
}

DI int moe_tables(const Frame& F, int l) {
    LAS int* PST = (LAS int*)(F.lds + LDS_MISC);
    LAS int* T2E = PST + 64;
    __syncthreads();
    if (F.tid < 64) { const int e = F.tid & 31; const int c = (int)__hip_atomic_load(WSP(unsigned, WS_CTL) + CW_CNT + l * 32 + e, __ATOMIC_RELAXED, __HIP_MEMORY_SCOPE_AGENT);
        const int pad = (c + 255) & ~255; int incl = pad;
#pragma unroll
        for (int o = 1; o < 32; o <<= 1) { const int t = __shfl_up(incl, o, 32); if (e >= o) incl += t; }
        if (F.tid < 32) { PST[e] = incl - pad; if (e == 31) PST[32] = incl; PST[64 + 300 + e] = c; } }
    __syncthreads();
    const int ntiles = PST[32] >> 8;
    for (int r = F.tid; r < ntiles; r += 512) { int e = 0;
        for (int q = 1; q < 32; ++q) if (PST[q] <= r * 256) e = q;
        T2E[r] = e; }
    __syncthreads();
    return ntiles;
}
struct MoeOrder {
    int nN, ntiles, G, c; const LAS int* t2e; long estride;
#ifndef MOE_XMAJOR
#define MOE_XMAJOR 1
#endif
    DI bool unit(int i, int& pm, int& pn) const { const int j = c >> 3, per = G / nN, sh = (nN == 8) ? 3 : 2;
        pm = MOE_XMAJOR ? i * per + (c & 7) * (per >> 3) + (j >> sh) : i * per + (j >> sh) * 8 + (c & 7); pn = j & (nN - 1); return pm < ntiles; }
    DI bool next(int i, pg8::Unit& u) const { int pm, pn; if (!unit(i, pm, pn)) return false; u.pm = pm; u.pn = pn; u.boff = (long)t2e[pm] * estride; return true; }
    DI void a_ready(const pg8::Unit&) const {}
    DI void done(const pg8::Unit&) const {}
};
#ifndef STAG_INTRA
#define STAG_INTRA 1
#endif
DI void xcd_stagger(const Frame& F, int step_ticks) {
    const unsigned dl = (unsigned)(STAG_INTRA ? (F.bid >> 3) : (F.bid & 7)) * (unsigned)step_ticks;
    const unsigned long long t0 = __builtin_amdgcn_s_memrealtime();
    while ((unsigned)(__builtin_amdgcn_s_memrealtime() - t0) < dl) __builtin_amdgcn_s_sleep(32);
}
DI void moe_rows(const Frame& F, int l, int ntiles, int nN) {
    const LAS int* PST = (const LAS int*)(F.lds + LDS_MISC); const LAS int* T2E = PST + 64; const LAS int* CNTL = PST + 64 + 300;
    LAS int* ROWS = (LAS int*)(F.lds + LDS_MISC + 2048);
    const MoeOrder S{nN, ntiles, F.G, F.bid, T2E, 0};
    (void)l;
    int val[5]; bool ok[5], inb[5];
#pragma unroll
    for (int k = 0; k < 5; ++k) { const int idx = F.tid + 512 * k, i = idx >> 8, r = idx & 255; int pm, pn;
        ok[k] = S.unit(i, pm, pn); const int e = T2E[ok[k] ? pm : 0], p = ((ok[k] ? pm : 0) - (PST[e] >> 8)) * 256 + r;
        inb[k] = ok[k] && p < CNTL[e]; val[k] = WSP(int, WS_TOPS)[(size_t)e * NT + (inb[k] ? p : 0)]; }
#pragma unroll
    for (int k = 0; k < 5; ++k) if (ok[k]) ROWS[F.tid + 512 * k] = inb[k] ? val[k] : 0;
    __syncthreads();
}

constexpr int LDS_BIASL = LDS_MISC + 2048 + 10 * 1024;
DI void moe_bias(const Frame& F, int ntiles, int nN, const float* bias, int estride) {
    const LAS int* PST = (const LAS int*)(F.lds + LDS_MISC); const LAS int* T2E = PST + 64;
    LAS float* BL = (LAS float*)(F.lds + LDS_BIASL);
    const MoeOrder S{nN, ntiles, F.G, F.bid, T2E, 0};
    float val[5]; bool ok[5];
#pragma unroll
    for (int k = 0; k < 5; ++k) { const int idx = F.tid + 512 * k, i = idx >> 8, r = idx & 255; int pm, pn;
        ok[k] = S.unit(i, pm, pn); val[k] = bias[(size_t)T2E[ok[k] ? pm : 0] * estride + (ok[k] ? pn : 0) * 256 + r]; }
#pragma unroll
    for (int k = 0; k < 5; ++k) if (ok[k]) BL[F.tid + 512 * k] = val[k];
    __syncthreads();
}

#ifndef EPI_NT
#define EPI_NT 0
#endif
#if EPI_NT
#define EPI_STORE(p, v) __builtin_nontemporal_store((v), (p))
#else
#define EPI_STORE(p, v) (*(p) = (v))
#endif
struct EpiU {
    static constexpr bool PERM = true, AFTER_DRAIN = false;
    bf16_t* O; int ldc; bf16_t* us5;
    DI void operator()(const pg8::f32x4 (&acc)[2][2][4][2], const pg8::Unit& u, int wr, int wc, int fr, int fq) const {
        const int row0 = u.pm * 256 + wr * 64 + fr, col0 = u.pn * 256 + wc * 32 + 8 * fq;
        const bool s5 = (u.pn == U_S5 / 256);
#pragma unroll
        for (int ai = 0; ai < 2; ++ai)
#pragma unroll
            for (int m = 0; m < 4; ++m) { const int row = row0 + ai * 128 + m * 16; bf16_t* rowp = O + (size_t)row * ldc + col0;
#pragma unroll
                for (int bj = 0; bj < 2; ++bj) { const pg8::f32x4 v0 = acc[ai][bj][m][0], v1 = acc[ai][bj][m][1];
                    u32x4 w; w[0] = pk2(v0[0], v0[1]); w[1] = pk2(v0[2], v0[3]); w[2] = pk2(v1[0], v1[1]); w[3] = pk2(v1[2], v1[3]);
                    const int cl = wc * 32 + 8 * fq + bj * 128;
                    bf16_t* dst = s5 ? us5 + ((size_t)(cl >> 4) * NT + row) * 16 + (cl & 15) : rowp + bj * 128;
                    EPI_STORE((u32x4*)dst, w); } }
    }
};
struct EpiRes {
    static constexpr bool PERM = false, AFTER_DRAIN = false;
    float* C; const float* res_lat; const float* res_ctx; const float* g1;
    DI void operator()(const pg8::f32x4 (&acc)[2][2][4][2], const pg8::Unit& u, int wr, int wc, int fr, int fq) const {
        const int row0 = CTX + u.pm * 256 + wr * 64 + fr, col0 = u.pn * 256 + wc * 32 + 4 * fq;
        const float* g = g1; (void)res_ctx;
        pg8::f32x4 gv[2][2];
#pragma unroll
        for (int bj = 0; bj < 2; ++bj)
#pragma unroll
            for (int n = 0; n < 2; ++n) gv[bj][n] = *(const pg8::f32x4*)(g + col0 + bj * 128 + n * 16);
#pragma unroll
        for (int ai = 0; ai < 2; ++ai) {
            pg8::f32x4 rv[4][2][2];
#pragma unroll
            for (int m = 0; m < 4; ++m) { const float* rp = res_lat + (size_t)(row0 + ai * 128 + m * 16 - CTX) * DM + col0;
#pragma unroll
                for (int bj = 0; bj < 2; ++bj)
#pragma unroll
                    for (int n = 0; n < 2; ++n) rv[m][bj][n] = *(const pg8::f32x4*)(rp + bj * 128 + n * 16); }
            asm volatile("" :: "v"(rv[0][0][0]), "v"(rv[1][0][0]), "v"(rv[2][0][0]), "v"(rv[3][0][0]), "v"(rv[0][1][1]), "v"(rv[1][1][1]), "v"(rv[2][1][1]), "v"(rv[3][1][1]));
#pragma unroll
            for (int m = 0; m < 4; ++m) { float* cp = C + (size_t)(row0 + ai * 128 + m * 16) * DM + col0;
#pragma unroll
                for (int bj = 0; bj < 2; ++bj)
#pragma unroll
                    for (int n = 0; n < 2; ++n) *(pg8::f32x4*)(cp + bj * 128 + n * 16) = rv[m][bj][n] + gv[bj][n] * acc[ai][bj][m][n]; }
        }
    }
};
struct EpiAct {
    static constexpr bool PERM = true, AFTER_DRAIN = false;
    bf16_t* O; const LAS float* biasl;
    mutable int cnt = 0;
    DI void operator()(const pg8::f32x4 (&acc)[2][2][4][2], const pg8::Unit& u, int wr, int wc, int fr, int fq) const {
        const int row0 = u.pm * 256 + wr * 64 + fr, j0 = u.pn * 128 + wc * 32 + 8 * fq;
        const LAS float* b = biasl + cnt * 256 + 2 * (wc * 32 + 8 * fq); ++cnt;
        pg8::f32x4 bg[2], bu[2];
#pragma unroll
        for (int n = 0; n < 2; ++n) { const pg8::f32x4 t0 = *(const LAS pg8::f32x4*)(b + 8 * n), t1 = *(const LAS pg8::f32x4*)(b + 8 * n + 4);
            bg[n] = (pg8::f32x4){t0[0], t0[2], t1[0], t1[2]}; bu[n] = (pg8::f32x4){t0[1], t0[3], t1[1], t1[3]}; }
#pragma unroll
        for (int ai = 0; ai < 2; ++ai)
#pragma unroll
            for (int m = 0; m < 4; ++m) { bf16_t* rowp = O + (size_t)(row0 + ai * 128 + m * 16) * DM + j0; float a[8];
#pragma unroll
                for (int n = 0; n < 2; ++n) { const pg8::f32x4 gq = acc[ai][0][m][n] + bg[n], uq = acc[ai][1][m][n] + bu[n];
#pragma unroll
                    for (int j = 0; j < 4; ++j) { const float gg = fminf(gq[j], 7.f), uu = fminf(fmaxf(uq[j], -7.f), 7.f); a[4 * n + j] = gg * sigmoid_f(1.702f * gg) * (uu + 1.f); } }
                u32x4 w; w[0] = pk2(a[0], a[1]); w[1] = pk2(a[2], a[3]); w[2] = pk2(a[4], a[5]); w[3] = pk2(a[6], a[7]); EPI_STORE((u32x4*)rowp, w); }
    }
};
struct EpiDown {
    static constexpr bool PERM = true, AFTER_DRAIN = false;
    bf16_t* O; const LAS float* biasl;
    int skip = 0;
    bf16_t* dump = nullptr;
    mutable int cnt = 0;
    DI void operator()(const pg8::f32x4 (&acc)[2][2][4][2], const pg8::Unit& u, int wr, int wc, int fr, int fq) const {
#ifdef PH_REP
        if (skip == 3) {
            bf16_t* dp = dump + ((size_t)(blockIdx.x * 8 + wr * 4 + wc) * 1024 + (fq * 16 + fr)) * 8;
#pragma unroll
            for (int a = 0; a < 2; ++a)
#pragma unroll
                for (int m = 0; m < 4; ++m)
#pragma unroll
                    for (int b = 0; b < 2; ++b) { const pg8::f32x4 v0 = acc[a][b][m][0], v1 = acc[a][b][m][1];
                        u32x4 w; w[0] = pk2(v0[0], v0[1]); w[1] = pk2(v0[2], v0[3]); w[2] = pk2(v1[0], v1[1]); w[3] = pk2(v1[2], v1[3]);
                        *(u32x4*)(dp + ((a * 4 + m) * 2 + b) * 512) = w; }
            return; }
        if (skip == 4) {
            bf16_t* dp = dump + (size_t)blockIdx.x * 65536 + (wr * 64 + fr) * 256 + wc * 32 + 8 * fq;
#pragma unroll
            for (int a = 0; a < 2; ++a)
#pragma unroll
                for (int m = 0; m < 4; ++m)
#pragma unroll
                    for (int b = 0; b < 2; ++b) { const pg8::f32x4 v0 = acc[a][b][m][0], v1 = acc[a][b][m][1];
                        u32x4 w; w[0] = pk2(v0[0], v0[1]); w[1] = pk2(v0[2], v0[3]); w[2] = pk2(v1[0], v1[1]); w[3] = pk2(v1[2], v1[3]);
                        *(u32x4*)(dp + (a * 128 + m * 16) * 256 + b * 128) = w; }
            return; }
        if (skip == 1) {
#pragma unroll
            for (int a = 0; a < 2; ++a)
#pragma unroll
                for (int b = 0; b < 2; ++b)
#pragma unroll
                    for (int m = 0; m < 4; ++m) asm volatile("" :: "v"(acc[a][b][m][0]), "v"(acc[a][b][m][1]));
            return; }
#endif
        const int row0 = u.pm * 256 + wr * 64 + fr, col0 = u.pn * 256 + wc * 32 + 8 * fq;
        const LAS float* b = biasl + cnt * 256 - u.pn * 256; ++cnt;
        pg8::f32x4 bv[2][2];
#pragma unroll
        for (int bj = 0; bj < 2; ++bj)
#pragma unroll
            for (int n = 0; n < 2; ++n) bv[bj][n] = *(const LAS pg8::f32x4*)(b + col0 + bj * 128 + 4 * n);
#pragma unroll
        for (int ai = 0; ai < 2; ++ai)
#pragma unroll
            for (int m = 0; m < 4; ++m) { bf16_t* rowp = O + (size_t)(row0 + ai * 128 + m * 16) * DM + col0;
#pragma unroll
                for (int bj = 0; bj < 2; ++bj) { const pg8::f32x4 v0 = acc[ai][bj][m][0] + bv[bj][0], v1 = acc[ai][bj][m][1] + bv[bj][1];
                    u32x4 w; w[0] = pk2(v0[0], v0[1]); w[1] = pk2(v0[2], v0[3]); w[2] = pk2(v1[0], v1[1]); w[3] = pk2(v1[2], v1[3]);
                    if (skip == 2) asm volatile("" :: "v"(w)); else EPI_STORE((u32x4*)(rowp + bj * 128), w); } }
    }
};

DI void outproj_ctx(const Frame& F, int l, const float* res_ctx) {
    if (F.bid >= 256) return;
    const int mt = F.bid >> 5, nt = F.bid & 31, lane = F.lane, r = lane & 31, h = lane >> 5;
    const bf16_t* A = WSP(bf16_t, WS_MIX) + (size_t)(mt * 32 + r) * DM + F.wave * 128 + 8 * h;
    const bf16_t* B = WSP(bf16_t, WS_WOUT) + (size_t)l * DM * DM + (size_t)(nt * 32 + r) * DM + F.wave * 128 + 8 * h;
    f32x16 acc = splat16(0.f);
#pragma unroll
    for (int ks = 0; ks < 8; ++ks) acc = mfma32(ld8g(A + ks * 16), ld8g(B + ks * 16), acc);
    LAS float* R = (LAS float*)F.lds;
    __syncthreads();
#pragma unroll
    for (int i = 0; i < 16; ++i) R[(F.wave * 16 + i) * 64 + lane] = acc[i];
    __syncthreads();
    for (int e = F.tid; e < 1024; e += 512) { const int i = e >> 6, ln = e & 63; float s = 0.f;
#pragma unroll
        for (int w = 0; w < 8; ++w) s += R[(w * 16 + i) * 64 + ln];
        const int row = mt * 32 + crow(i, ln >> 5), col = nt * 32 + (ln & 31);
        WSP(float, WS_XA)[(size_t)row * DM + col] = res_ctx[(size_t)row * DM + col] + WSP(float, WS_MOD)[(size_t)l * 2 * 6144 + 6144 + 2 * 1024 + col] * s; }
    __syncthreads();
}

template <int DIM> DI void rope_vec(float (&v)[DIM], const f32x2* tab_row, const f32x2* tab_col) {
    constexpr int Q = DIM / 4;
#pragma unroll
    for (int i = 0; i < Q; ++i) { const f32x2 r = tab_row[i], c = tab_col[i];
        const float a = v[i], b = v[Q + i]; v[i] = a * r.x - b * r.y; v[Q + i] = a * r.y + b * r.x;
        const float a2 = v[2 * Q + i], b2 = v[3 * Q + i]; v[2 * Q + i] = a2 * c.x - b2 * c.y; v[3 * Q + i] = a2 * c.y + b2 * c.x; }
}
template <int DIM> DI void load_vec(const bf16_t* p, float (&v)[DIM]) {
#pragma unroll
    for (int i = 0; i < DIM / 8; ++i) { const u32x4 w = *(const u32x4*)(p + 8 * i);
#pragma unroll
        for (int j = 0; j < 4; ++j) { v[8 * i + 2 * j] = bflo(w[j]); v[8 * i + 2 * j + 1] = bfhi(w[j]); } }
}
template <int DIM> DI float store_vec(bf16_t* p, const float (&v)[DIM]) {
    float ss = 0.f;
#pragma unroll
    for (int i = 0; i < DIM / 8; ++i) { u32x4 w;
#pragma unroll
        for (int j = 0; j < 4; ++j) { w[j] = pk2(v[8 * i + 2 * j], v[8 * i + 2 * j + 1]); const float a = bflo(w[j]), b = bfhi(w[j]); ss += a * a + b * b; }
        *(u32x4*)(p + 8 * i) = w; }
    return ss;
}
DI void p3_attn_prep(const Frame& F, int l, int item) {
    LAS unsigned* KMX = (LAS unsigned*)(F.lds + LDS_MISC);
    LAS bf16_t* VS = (LAS bf16_t*)F.lds;
    const int tid = F.tid, tok0 = item * 64;
    if (tid < 32) KMX[tid] = 0u;
    const bf16_t* U = WSP(bf16_t, WS_U);
    for (int i = tid; i < 64 * 48; i += 512) { const int t = i / 48, c8 = i % 48; const int col = c8 < 32 ? U_DV + 8 * c8 : U_GV + 8 * (c8 - 32);
        *(LAS u32x4*)(VS + t * 384 + 8 * c8) = *(const u32x4*)(U + (size_t)(tok0 + t) * NU + col); }
    __syncthreads();
    const f32x2* ropeD = WSP(f32x2, WS_ROPE); const f32x2* ropeG = ropeD + 256 * 8;
    const float qs_d = 0.17677669529663687f * LOG2E, qs_g = 0.125f * LOG2E;
    for (int task = tid; task < 64 * 22; task += 512) {
        int t, vi;
        if (task < 1024) { t = task & 63; vi = task >> 6; } else if (task < 1280) { t = task & 63; vi = 16 + ((task - 1024) >> 6); } else { t = task & 63; vi = 20 + ((task - 1280) >> 6); }
        const int tok = tok0 + t; const bool lat = tok >= CTX; const int pos = tok - CTX, pr = lat ? pos >> 6 : 0, pc = lat ? pos & 63 : 0;
        const bf16_t* urow = U + (size_t)tok * NU;
        if (vi < 16) {
            const bool isk = vi >= 8; const int hm = vi & 7, h = hm >> 1, m = hm & 1;
            float v[32]; load_vec<32>(urow + (isk ? U_DK : U_DQ) + hm * 32, v);
            if (lat) rope_vec<32>(v, ropeD + pr * 8, ropeD + pc * 8);
            if (!isk) {
#pragma unroll
                for (int i = 0; i < 32; ++i) v[i] *= qs_d;
                const float ss = store_vec<32>(WSP(bf16_t, WS_QD) + ((size_t)h * NT + tok) * 64 + m * 32, v);
                WSP(float, WS_QND)[((size_t)h * 2 + m) * NT + tok] = sqrtf(ss);
                __hip_atomic_fetch_max(KMX + 10 + hm, __float_as_uint(ss), __ATOMIC_RELAXED, __HIP_MEMORY_SCOPE_WORKGROUP);
            } else {
                const float ss = store_vec<32>(WSP(bf16_t, WS_KD) + ((size_t)h * NT + tok) * 64 + m * 32, v);
                __hip_atomic_fetch_max(KMX + hm, __float_as_uint(ss), __ATOMIC_RELAXED, __HIP_MEMORY_SCOPE_WORKGROUP);
            }
        } else {
            const bool isk = vi >= 20; const int h = isk ? vi - 20 : vi - 16;
            float v[64]; load_vec<64>(urow + (isk ? U_GK : U_GQ) + h * 64, v);
            float ss = 0.f;
#pragma unroll
            for (int i = 0; i < 64; ++i) ss += v[i] * v[i];
            const float rs = __builtin_amdgcn_rsqf(ss * (1.f / 64.f) + EPS);
            const float* nw = ((const float*)F.in[isk ? I_KNW : I_QNW]) + (size_t)l * 64;
#pragma unroll
            for (int i = 0; i < 64; ++i) v[i] = v[i] * rs * nw[i];
            if (lat) rope_vec<64>(v, ropeG + pr * 16, ropeG + pc * 16);
            if (!isk) {
#pragma unroll
                for (int i = 0; i < 64; ++i) v[i] *= qs_g;
                const float s2 = store_vec<64>(WSP(bf16_t, WS_QG) + ((size_t)h * NT + tok) * 64, v);
                WSP(float, WS_QNG)[(size_t)h * NT + tok] = sqrtf(s2);
                __hip_atomic_fetch_max(KMX + 18 + h, __float_as_uint(s2), __ATOMIC_RELAXED, __HIP_MEMORY_SCOPE_WORKGROUP);
            } else {
                const float s2 = store_vec<64>(WSP(bf16_t, WS_KG) + ((size_t)h * NT + tok) * 64, v);
                __hip_atomic_fetch_max(KMX + 8 + h, __float_as_uint(s2), __ATOMIC_RELAXED, __HIP_MEMORY_SCOPE_WORKGROUP);
            }
        }
    }
    for (int i = tid; i < 384 * 8; i += 512) { const int c = i >> 3, o = i & 7; u32x4 w;
#pragma unroll
        for (int j = 0; j < 4; ++j) { const unsigned lo = VS[(8 * o + 2 * j) * 384 + c], hi = VS[(8 * o + 2 * j + 1) * 384 + c]; w[j] = lo | (hi << 16); }
        bf16_t* dst = c < 256 ? WSP(bf16_t, WS_VTD) + (size_t)c * NT : WSP(bf16_t, WS_VTG) + (size_t)(c - 256) * NT;
        *(u32x4*)(dst + tok0 + 8 * o) = w; }
    __syncthreads();
    if (tid < 22) __hip_atomic_fetch_max(WSP(unsigned, WS_CTL) + CW_KMAX + l * 32 + tid, KMX[tid], __ATOMIC_RELAXED, __HIP_MEMORY_SCOPE_AGENT);
    __syncthreads();
}

constexpr int UBP = 1032;
template <bool FROM_U>
DI void s5_stage_u(const Frame& F, int g, int nt) {
    LAS bf16_t* UB = (LAS bf16_t*)F.lds;
    __syncthreads();
    for (int i = F.tid; i < 32 * 128; i += 512) { const int n = i >> 7, p = i & 127; const int chunk = nt * 32 + n, cc = chunk < NC5 ? chunk : NC5 - 1;
        if (FROM_U) { const int s = p >> 1, hh = p & 1; *(LAS u32x4*)(UB + n * UBP + s * 16 + 8 * hh) = *(const u32x4*)(WSP(bf16_t, WS_U) + (size_t)(cc * S5L + s) * NU + U_S5 + g * 16 + 8 * hh); }
        else *(LAS u32x4*)(UB + n * UBP + 8 * p) = *(const u32x4*)(WSP(bf16_t, WS_US5) + ((size_t)g * NT + (size_t)cc * S5L) * 16 + 8 * p); }
    __syncthreads();
}
constexpr int N_S5H = 16 * 9;
DI void p3_s5_hloc(const Frame& F, int l, int item) {
    const int g = item / 9, nt = item % 9, dir = F.wave >> 2, mt = F.wave & 3, lane = F.lane, r = lane & 31, h = lane >> 5;
    s5_stage_u<false>(F, g, nt);
    const LAS bf16_t* UB = (const LAS bf16_t*)F.lds + r * UBP + 8 * h;
    const bf16_t* E = WSP(bf16_t, WS_E5) + ((size_t)l * 16 + g) * 2 * 128 * 1024 + ((size_t)(dir * 4 + mt) * 64 * 64 + lane) * 8;
    f32x16 acc = splat16(0.f);
#pragma unroll 16
    for (int ks = 0; ks < 64; ++ks) acc = mfma32(ld8g(E + ks * 512), *(const LAS bf16x8*)(UB + ks * 16), acc);
    const int chunk = nt * 32 + r;
    if (chunk < NC5) { float* o = WSP(float, WS_HLOC) + (size_t)chunk * 4096 + (g * 2 + dir) * 128 + mt * 32;
#pragma unroll
        for (int i = 0; i < 16; ++i) o[crow(i, h)] = acc[i]; }
}

constexpr int SP = 136;
DI void p3_ssd_prep(const Frame& F, int l, int c) {
    LAS bf16_t* XT = (LAS bf16_t*)F.lds;
    LAS bf16_t* BT = XT + 256 * SP;
    LAS float* DTL = (LAS float*)(BT + 256 * SP);
    LAS float* CML = DTL + 8 * 128;
    LAS float* WG = CML + 8 * 128;
    const int tid = F.tid, lane = F.lane, tok0 = c * 128;
    const int seq_lo = c < 2 ? 0 : CTX, seq_hi = c < 2 ? CTX : NT;
    const bf16_t* U = WSP(bf16_t, WS_U);
    const float* cw = ((const float*)F.in[I_CONVW]) + (size_t)l * 3 * 768; const float* cb = ((const float*)F.in[I_CONVB]) + (size_t)l * 768;
    constexpr int RP = 264;
    LAS bf16_t* RAW = XT;
    LAS f32x4* CWS = (LAS f32x4*)(WG + 8 * 128);
#pragma unroll 1
    for (int sec = 1; sec < 3; ++sec) {
        __syncthreads();
        if (tid < 256) CWS[tid] = (f32x4){cw[sec * 256 + tid], cw[768 + sec * 256 + tid], cw[1536 + sec * 256 + tid], cb[sec * 256 + tid]};
        for (int i = tid; i < 130 * 32; i += 512) { const int rr = i >> 5, p = i & 31, tok = tok0 - 1 + rr;
            const u32x4 v = (tok >= seq_lo && tok < seq_hi) ? *(const u32x4*)(U + (size_t)tok * NU + U_XS + sec * 256 + 8 * p) : (u32x4){0u, 0u, 0u, 0u};
            *(LAS u32x4*)(RAW + rr * RP + 8 * p) = v; }
        __syncthreads();
        for (int task = tid; task < 128 * 32; task += 512) { const int t = task & 127, cg = task >> 7, tok = tok0 + t, chl = cg * 8, ch0 = sec * 256 + chl;
            const u32x4 xm = *(const LAS u32x4*)(RAW + t * RP + chl), x0 = *(const LAS u32x4*)(RAW + (t + 1) * RP + chl), xp = *(const LAS u32x4*)(RAW + (t + 2) * RP + chl);
            float y[8]; (void)ch0;
#pragma unroll
            for (int j = 0; j < 4; ++j) { const f32x4 c0 = CWS[chl + 2 * j], c1 = CWS[chl + 2 * j + 1];
                const float a0 = bflo(xm[j]) * c0[0] + bflo(x0[j]) * c0[1] + bflo(xp[j]) * c0[2] + c0[3];
                const float a1 = bfhi(xm[j]) * c1[0] + bfhi(x0[j]) * c1[1] + bfhi(xp[j]) * c1[2] + c1[3];
                y[2 * j] = silu_f(a0); y[2 * j + 1] = silu_f(a1); }
            u32x4 w;
#pragma unroll
            for (int j = 0; j < 4; ++j) w[j] = pk2(y[2 * j], y[2 * j + 1]);
            if (sec == 1) { *(u32x4*)(WSP(bf16_t, WS_BN) + (size_t)tok * 256 + chl) = w;
#pragma unroll
                for (int j = 0; j < 8; ++j) BT[(chl + j) * SP + t] = f2bf(y[j]);
            } else *(u32x4*)(WSP(bf16_t, WS_CN) + (size_t)tok * 256 + chl) = w; }
    }
    __syncthreads();
    if (tid < 256) CWS[tid] = (f32x4){cw[tid], cw[768 + tid], cw[1536 + tid], cb[tid]};
    __syncthreads();
    for (int task = tid; task < 128 * 32; task += 512) { const int t = task & 127, cg = task >> 7, tok = tok0 + t, ch0 = cg * 8;
        const u32x4 z4 = {0u, 0u, 0u, 0u};
        const u32x4 xm = (tok - 1 >= seq_lo) ? *(const u32x4*)(U + (size_t)(tok - 1) * NU + U_XS + ch0) : z4;
        const u32x4 x0 = *(const u32x4*)(U + (size_t)tok * NU + U_XS + ch0);
        const u32x4 xp = (tok + 1 < seq_hi) ? *(const u32x4*)(U + (size_t)(tok + 1) * NU + U_XS + ch0) : z4;
#pragma unroll
        for (int j = 0; j < 4; ++j) { const f32x4 c0 = CWS[ch0 + 2 * j], c1 = CWS[ch0 + 2 * j + 1];
            const float a0 = bflo(xm[j]) * c0[0] + bflo(x0[j]) * c0[1] + bflo(xp[j]) * c0[2] + c0[3];
            const float a1 = bfhi(xm[j]) * c1[0] + bfhi(x0[j]) * c1[1] + bfhi(xp[j]) * c1[2] + c1[3];
            XT[(ch0 + 2 * j) * SP + t] = f2bf(silu_f(a0)); XT[(ch0 + 2 * j + 1) * SP + t] = f2bf(silu_f(a1)); }
    }
    { const int j = F.wave, dir = j >> 2; const float bias = ((const float*)F.in[I_DTB])[(size_t)l * 8 + j], a = -__expf(((const float*)F.in[I_ALOG])[(size_t)l * 8 + j]);
      float e[2], dtv[2];
#pragma unroll
      for (int q = 0; q < 2; ++q) { const int li = 2 * lane + q, t = dir ? 127 - li : li;
          const float x = WSP(float, WS_DTRAW)[(size_t)(tok0 + t) * 8 + j] + bias; dtv[q] = x > 20.f ? x : log1pf(__expf(x)); e[q] = dtv[q] * a * LOG2E; }
      float s = e[0] + e[1];
#pragma unroll
      for (int o = 1; o < 64; o <<= 1) { const float tv = __shfl_up(s, o); if (lane >= o) s += tv; }
      const float c1 = s, c0 = s - e[1];
#pragma unroll
      for (int q = 0; q < 2; ++q) { const int li = 2 * lane + q, t = dir ? 127 - li : li; const float cv = q ? c1 : c0;
          DTL[j * 128 + t] = dtv[q]; CML[j * 128 + t] = cv;
          WSP(float, WS_DTV)[((size_t)c * 8 + j) * 128 + t] = dtv[q]; WSP(float, WS_CUM)[((size_t)c * 8 + j) * 128 + t] = cv; }
    }
    __syncthreads();
    for (int i = tid; i < 8 * 128; i += 512) { const int j = i >> 7; const float tot = CML[j * 128 + ((j >> 2) ? 0 : 127)]; WG[i] = DTL[i] * __builtin_amdgcn_exp2f(tot - CML[i]); }
    for (int i = tid; i < 256 * 16; i += 512) { const int ch = i >> 4, o = i & 15; *(u32x4*)(WSP(bf16_t, WS_XST) + ((size_t)c * 256 + ch) * 128 + 8 * o) = *(const LAS u32x4*)(XT + ch * SP + 8 * o); }
    __syncthreads();
    { const int j = F.wave, hh = j & 3, g = hh >> 1, r = lane & 31, h = lane >> 5;
      f32x16 acc[2][4];
#pragma unroll
      for (int a = 0; a < 2; ++a)
#pragma unroll
          for (int b = 0; b < 4; ++b) acc[a][b] = splat16(0.f);
#pragma unroll 1
      for (int ks = 0; ks < 8; ++ks) {
          const f32x4 w0 = *(const LAS f32x4*)(WG + j * 128 + ks * 16 + 8 * h), w1 = *(const LAS f32x4*)(WG + j * 128 + ks * 16 + 8 * h + 4);
          bf16x8 af[2], bfr[4];
#pragma unroll
          for (int a = 0; a < 2; ++a) { const u32x4 x = *(const LAS u32x4*)(XT + (hh * 64 + a * 32 + r) * SP + ks * 16 + 8 * h); u32x4 o;
              o[0] = pk2(bflo(x[0]) * w0[0], bfhi(x[0]) * w0[1]); o[1] = pk2(bflo(x[1]) * w0[2], bfhi(x[1]) * w0[3]);
              o[2] = pk2(bflo(x[2]) * w1[0], bfhi(x[2]) * w1[1]); o[3] = pk2(bflo(x[3]) * w1[2], bfhi(x[3]) * w1[3]); af[a] = __builtin_bit_cast(bf16x8, o); }
#pragma unroll
          for (int b = 0; b < 4; ++b) bfr[b] = *(const LAS bf16x8*)(BT + (g * 128 + b * 32 + r) * SP + ks * 16 + 8 * h);
#pragma unroll
          for (int a = 0; a < 2; ++a)
#pragma unroll
              for (int b = 0; b < 4; ++b) acc[a][b] = mfma32(af[a], bfr[b], acc[a][b]);
      }
      float* o = WSP(float, WS_SLOC) + ((size_t)c * 8 + j) * 64 * 128;
#pragma unroll
      for (int a = 0; a < 2; ++a)
#pragma unroll
          for (int b = 0; b < 4; ++b)
#pragma unroll
              for (int i = 0; i < 16; ++i) o[(a * 32 + crow(i, h)) * 128 + b * 32 + r] = acc[a][b][i];
    }
    __syncthreads();
}

DI void p4_s5_scan_el(const Frame& F, int l, int st);
DI void p4_ssd_scan(const Frame& F, int l) {
    if (F.tid >= 256) { if (F.tid < 264) { const int st = F.bid * 8 + (F.tid - 256); if (st < 2048) p4_s5_scan_el(F, l, st); } return; }
    const int el = F.bid * 256 + F.tid; if (el >= 65536) return;
    const int j = el >> 13;
    const int dir = j >> 2;
    const float* cum = WSP(float, WS_CUM); const float* sl = WSP(float, WS_SLOC); bf16_t* so = WSP(bf16_t, WS_SIN);
    const int eo = el & 8191;
    float s = 0.f;
#pragma unroll 26
    for (int i = 0; i < NCH; ++i) { const int c = dir ? (i < 2 ? 1 - i : NCH + 1 - i) : i;
        so[((size_t)c * 8 + j) * 8192 + eo] = f2bf(s);
        const float tot = cum[((size_t)c * 8 + j) * 128 + (dir ? 0 : 127)];
        s = s * __builtin_amdgcn_exp2f(tot) + sl[((size_t)c * 8 + j) * 8192 + eo]; }
}
DI void p4_s5_scan_el(const Frame& F, int l, int st) {
    const int g = st >> 7, dir = (st >> 6) & 1, p = st & 63;
    const f32x2 ap = WSP(f32x2, WS_APOW)[((size_t)l * 16 + g) * 128 + dir * 64 + p];
    const float* hl = WSP(float, WS_HLOC) + (g * 2 + dir) * 128 + p; bf16_t* ho = WSP(bf16_t, WS_HIN) + (g * 2 + dir) * 128 + p;
    f32x2 s = {0.f, 0.f};
#pragma unroll 26
    for (int i = 0; i < NC5; ++i) { const int c = dir ? (i < 4 ? 3 - i : NC5 + 3 - i) : i;
        ho[(size_t)c * 4096] = f2bf(s.x); ho[(size_t)c * 4096 + 64] = f2bf(s.y);
        const f32x2 loc = {hl[(size_t)c * 4096], hl[(size_t)c * 4096 + 64]};
        s = cmul(s, ap) + loc; }
}


constexpr int CVJ_LDS = 72 * 1024;
struct CvTile { const float* src; bf16_t* dst; int ld, c0, k0, mode; };
DI CvTile cv_decode(const Frame& F, int l, int m) {
    const int e = m / 1536, r = m % 1536; CvTile c;
    if (r < 1024) { c.src = ((const float*)F.in[I_WGU]) + (size_t)(l * NEXP + e) * DM * 2048; c.dst = WSP(bf16_t, WS_WGU) + (size_t)(l * NEXP + e) * 2048 * DM; c.ld = 2048; c.c0 = (r >> 4) * 32; c.k0 = (r & 15) * 64; c.mode = 2; }
    else { const int q = r - 1024; c.src = ((const float*)F.in[I_WDN]) + (size_t)(l * NEXP + e) * DM * DM; c.dst = WSP(bf16_t, WS_WDN) + (size_t)(l * NEXP + e) * DM * DM; c.ld = DM; c.c0 = (q >> 4) * 32; c.k0 = (q & 15) * 64; c.mode = 0; }
    return c;
}
DI void cv_issue(const Frame& F, int l, int j, f32x4 (&v)[8]) {
    const CvTile c = cv_decode(F, l, (F.bid * 8 + F.wave) + 2048 * j);
    const float* s = c.src + (size_t)(c.k0 + (F.lane >> 3)) * c.ld + c.c0 + 4 * (F.lane & 7);
#pragma unroll
    for (int i = 0; i < 8; ++i) v[i] = *(const f32x4*)(s + (size_t)(8 * i) * c.ld);
}
DI void cv_stage(const Frame& F, const f32x4 (&v)[8]) {
    LAS unsigned char* base = F.lds + CVJ_LDS + F.wave * 8192 + F.lane * 16;
#pragma unroll
    for (int i = 0; i < 8; ++i) *(LAS f32x4*)(base + i * 1024) = v[i];
}
DI void cv_finish(const Frame& F, int l, int j) {
    const CvTile c = cv_decode(F, l, (F.bid * 8 + F.wave) + 2048 * j);
    const LAS float* T = (const LAS float*)(F.lds + CVJ_LDS + F.wave * 8192);
    const int col = F.lane & 31, kh = F.lane >> 5, row = conv_dst_row(c.mode, c.c0 + col);
    bf16_t* o = c.dst + (size_t)row * DM + c.k0 + kh * 32;
#pragma unroll
    for (int q = 0; q < 4; ++q) { u32x4 w;
#pragma unroll
        for (int i = 0; i < 4; ++i) w[i] = pk2(T[(kh * 32 + 8 * q + 2 * i) * 32 + col], T[(kh * 32 + 8 * q + 2 * i + 1) * 32 + col]);
        *(u32x4*)(o + 8 * q) = w; }
}
constexpr int AP = 144;
struct AttnOut { bf16_t* mix; int col0; float lam, outscale; const float* subw; };
#ifndef DIFF_KT
#define DIFF_KT 64
#endif
#ifndef ATT_SCALAR_SUM
#define ATT_SCALAR_SUM 0
#endif
#ifndef ATT_STATIC_PRIO
#define ATT_STATIC_PRIO 0
#endif
#if ATT_STATIC_PRIO
#define ATT_PRIO_HI do { } while (0)
#define ATT_PRIO_LO do { } while (0)
#else
#define ATT_PRIO_HI __builtin_amdgcn_s_setprio(1)
#define ATT_PRIO_LO __builtin_amdgcn_s_setprio(0)
#endif
template <bool DIFF, int KT>
DI void attn_item(const Frame& F, const bf16_t* Q, const bf16_t* K, const bf16_t* Vt, const float* qn0, const float* qn1, float km0, float km1,
                  int q0, int nkeys, const AttnOut& ao, int cv_l = -1) {
    constexpr int KTB = KT * AP, VPB = KT * 2 + 16, VTB = 64 * VPB, NP = KT / 64;
    LAS unsigned char* KB = F.lds;
    LAS unsigned char* VB = F.lds + 2 * KTB;
    const int tid = F.tid, lane = F.lane, r = lane & 31, h = lane >> 5;
    const int qrow = q0 + F.wave * 32 + r;
    bf16x8 qf[4];
#pragma unroll
    for (int j = 0; j < 4; ++j) qf[j] = ld8g(Q + (size_t)qrow * 64 + j * 16 + 8 * h);
    const float sh0 = -qn0[qrow] * km0, sh1 = DIFF ? -qn1[qrow] * km1 : 0.f;
    f32x16 O0[2], O1[2];
#pragma unroll
    for (int d = 0; d < 2; ++d) { O0[d] = splat16(0.f); O1[d] = splat16(0.f); }
    f32x2 l0v = {0.f, 0.f}, l1v = {0.f, 0.f};
    const int srow = tid >> 3, sch = tid & 7;
    const bf16_t* kg = K + (size_t)srow * 64 + sch * 8; const bf16_t* vg = Vt + (size_t)srow * NT + sch * 8;
    const int ntile = nkeys / KT;
    u32x4 kreg[NP], vreg[NP];
#pragma unroll
    for (int i = 0; i < NP; ++i) { kreg[i] = *(const u32x4*)(kg + (size_t)i * 64 * 64); vreg[i] = *(const u32x4*)(vg + i * 64); }
    __syncthreads();
#pragma unroll
    for (int i = 0; i < NP; ++i) { *(LAS u32x4*)(KB + (srow + 64 * i) * AP + sch * 16) = kreg[i]; *(LAS u32x4*)(VB + srow * VPB + (sch + 8 * i) * 16) = vreg[i]; }
    __syncthreads();
    const int krow = kperm(r);
    f32x4 cvv[8];
#pragma unroll
    for (int i = 0; i < 8; ++i) cvv[i] = (f32x4){0.f, 0.f, 0.f, 0.f};
    asm volatile("" :: "v"(qf[0]), "v"(qf[1]), "v"(qf[2]), "v"(qf[3]), "v"(sh0), "v"(sh1));
#if ATT_STATIC_PRIO
    if (F.wave >= 4) __builtin_amdgcn_s_setprio(1);
#endif
#pragma clang loop unroll(disable)
    for (int t = 0; t < ntile; ++t) {
        const int buf = t & 1;
        constexpr int CVP = KT == 64 ? 10 : 5;
        const int cv_tt = t - (F.bid % CVP), cv_tq = cv_tt / CVP, cv_tr = cv_tt - CVP * cv_tq;
        const bool cv_on = !DIFF && cv_l >= 0 && cv_tt >= 0 && cv_tq < 24;
        if (cv_on && cv_tr == 2) cv_finish(F, cv_l, cv_tq);
        if (t + 1 < ntile) {
#pragma unroll
            for (int i = 0; i < NP; ++i) { kreg[i] = *(const u32x4*)(kg + ((size_t)(t + 1) * KT + i * 64) * 64); vreg[i] = *(const u32x4*)(vg + (size_t)(t + 1) * KT + i * 64); } }
        if (cv_on && cv_tr == 0) cv_issue(F, cv_l, cv_tq, cvv);
        const LAS unsigned char* kb = KB + buf * KTB; const LAS unsigned char* vb = VB + buf * VTB;
#pragma unroll
        for (int sub = 0; sub < KT / 32; ++sub) {
            bf16x8 kf[4];
#pragma unroll
            for (int j = 0; j < 4; ++j) kf[j] = *(const LAS bf16x8*)(kb + (sub * 32 + krow) * AP + j * 32 + h * 16);
            bf16x8 vf[2][2];
#pragma unroll
            for (int d = 0; d < 2; ++d)
#pragma unroll
                for (int s = 0; s < 2; ++s) vf[d][s] = *(const LAS bf16x8*)(vb + (d * 32 + r) * VPB + (sub * 32 + s * 16 + h * 8) * 2);
            {   f32x16 S = splat16(sh0);
                ATT_PRIO_HI;
                S = mfma32(kf[0], qf[0], S); S = mfma32(kf[1], qf[1], S);
                if (!DIFF) { S = mfma32(kf[2], qf[2], S); S = mfma32(kf[3], qf[3], S); }
                ATT_PRIO_LO;
#pragma unroll
                for (int i = 0; i < 16; ++i) {
#if defined(ATTN_DUP) && ATTN_DUP
                    float x2 = S[i]; asm volatile("" : "+v"(x2)); const float e2 = __builtin_amdgcn_exp2f(x2); S[i] = 0.5f * (__builtin_amdgcn_exp2f(S[i]) + e2);
#else
                    S[i] = __builtin_amdgcn_exp2f(S[i]);
#endif
                    }
#pragma unroll
#if ATT_SCALAR_SUM
                for (int i = 0; i < 16; i += 2) { asm("v_add_f32 %0, %0, %1" : "+v"(l0v.x) : "v"(S[i])); asm("v_add_f32 %0, %0, %1" : "+v"(l0v.y) : "v"(S[i + 1])); }
#else
                for (int i = 0; i < 16; i += 2) l0v += (f32x2){S[i], S[i + 1]};
#endif
                const bf16x8 p0 = pack_step<0>(S), p1 = pack_step<1>(S);
                ATT_PRIO_HI;
#pragma unroll
                for (int d = 0; d < 2; ++d) { O0[d] = mfma32(vf[d][0], p0, O0[d]); O0[d] = mfma32(vf[d][1], p1, O0[d]); }
                ATT_PRIO_LO; }
            if (DIFF) { f32x16 S = splat16(sh1);
                ATT_PRIO_HI;
                S = mfma32(kf[2], qf[2], S); S = mfma32(kf[3], qf[3], S);
                ATT_PRIO_LO;
#pragma unroll
                for (int i = 0; i < 16; ++i) {
#if defined(ATTN_DUP) && ATTN_DUP
                    float x2 = S[i]; asm volatile("" : "+v"(x2)); const float e2 = __builtin_amdgcn_exp2f(x2); S[i] = 0.5f * (__builtin_amdgcn_exp2f(S[i]) + e2);
#else
                    S[i] = __builtin_amdgcn_exp2f(S[i]);
#endif
                    }
#pragma unroll
#if ATT_SCALAR_SUM
                for (int i = 0; i < 16; i += 2) { asm("v_add_f32 %0, %0, %1" : "+v"(l1v.x) : "v"(S[i])); asm("v_add_f32 %0, %0, %1" : "+v"(l1v.y) : "v"(S[i + 1])); }
#else
                for (int i = 0; i < 16; i += 2) l1v += (f32x2){S[i], S[i + 1]};
#endif
                const bf16x8 p0 = pack_step<0>(S), p1 = pack_step<1>(S);
                ATT_PRIO_HI;
#pragma unroll
                for (int d = 0; d < 2; ++d) { O1[d] = mfma32(vf[d][0], p0, O1[d]); O1[d] = mfma32(vf[d][1], p1, O1[d]); }
                ATT_PRIO_LO; }
        }
        if (t + 1 < ntile) {
#pragma unroll
            for (int i = 0; i < NP; ++i) { *(LAS u32x4*)(KB + (buf ^ 1) * KTB + (srow + 64 * i) * AP + sch * 16) = kreg[i]; *(LAS u32x4*)(VB + (buf ^ 1) * VTB + srow * VPB + (sch + 8 * i) * 16) = vreg[i]; } }
        if (cv_on && cv_tr == 1) cv_stage(F, cvv);
        __syncthreads();
    }
#if ATT_STATIC_PRIO
    __builtin_amdgcn_s_setprio(0);
#endif
    const GAS float* subw = (const GAS float*)ao.subw; GAS bf16_t* mixp = (GAS bf16_t*)ao.mix;
    asm volatile("" : "+s"(subw)); asm volatile("" : "+s"(mixp));
    float l0 = l0v.x + l0v.y, l1 = l1v.x + l1v.y;
    l0 += __shfl_xor(l0, 32); const float i0 = 1.f / l0;
    float i1 = 0.f; if (DIFF) { l1 += __shfl_xor(l1, 32); i1 = ao.lam / l1; }
    float ss = 0.f;
#pragma unroll
    for (int d = 0; d < 2; ++d)
#pragma unroll
        for (int i = 0; i < 16; ++i) { float v = O0[d][i] * i0; if (DIFF) v -= O1[d][i] * i1; O0[d][i] = v; ss += v * v; }
    float sc = 1.f;
    if (DIFF) { ss += __shfl_xor(ss, 32); sc = __builtin_amdgcn_rsqf(ss * (1.f / 64.f) + EPS) * ao.outscale; }
    GAS bf16_t* orow = mixp + (size_t)qrow * DM + ao.col0;
#pragma unroll
    for (int d = 0; d < 2; ++d)
#pragma unroll
        for (int gq = 0; gq < 4; ++gq) { const int dd = d * 32 + 8 * gq + 4 * h; float o[4];
#pragma unroll
            for (int j = 0; j < 4; ++j) { o[j] = O0[d][4 * gq + j] * sc; if (DIFF) o[j] *= subw[dd + j]; }
            u32x2 w; w[0] = pk2(o[0], o[1]); w[1] = pk2(o[2], o[3]); *(GAS u32x2*)(orow + dd) = w; }
}
DI void attn_item_diff2(const Frame& F, const bf16_t* Q, const bf16_t* K, const bf16_t* Vt, int q0, int nkeys, const AttnOut& ao) {
    LAS unsigned char* KB = F.lds;
    LAS unsigned char* VB = F.lds + 2 * 64 * AP;
    const int tid = F.tid, lane = F.lane, r = lane & 31, h = lane >> 5;
    const int qrow = q0 + F.wave * 32 + r;
    bf16x8 qf[4];
#pragma unroll
    for (int j = 0; j < 4; ++j) qf[j] = ld8g(Q + (size_t)qrow * 64 + j * 16 + 8 * h);
    const f32x16 zero16 = splat16(0.f);
    f32x16 O0[2], O1[2]; float l0 = 0.f, l1 = 0.f;
#pragma unroll
    for (int dd = 0; dd < 2; ++dd) { O0[dd] = zero16; O1[dd] = zero16; }
    const int srow = tid >> 3, sch = tid & 7;
    const bf16_t* kg = K + (size_t)srow * 64 + sch * 8; const bf16_t* vg = Vt + (size_t)srow * NT + sch * 8;
    const int ntile = nkeys >> 6;
    u32x4 kreg = *(const u32x4*)kg, vreg = *(const u32x4*)vg;
    __syncthreads();
    *(LAS u32x4*)(KB + srow * AP + sch * 16) = kreg; *(LAS u32x4*)(VB + srow * AP + sch * 16) = vreg;
    __syncthreads();
    const int krow = kperm(r);
    asm volatile("" :: "v"(qf[0]), "v"(qf[1]), "v"(qf[2]), "v"(qf[3]));
#pragma clang loop unroll(disable)
    for (int t = 0; t < ntile; ++t) {
        const int buf = t & 1;
        if (t + 1 < ntile) { kreg = *(const u32x4*)(kg + (size_t)(t + 1) * 64 * 64); vreg = *(const u32x4*)(vg + (size_t)(t + 1) * 64); }
        const LAS unsigned char* kb = KB + buf * 64 * AP; const LAS unsigned char* vb = VB + buf * 64 * AP;
        bf16x8 kfa[4], kfb[4], vfa[2][2], vfb[2][2];
#pragma unroll
        for (int j = 0; j < 4; ++j) kfa[j] = *(const LAS bf16x8*)(kb + krow * AP + j * 32 + h * 16);
#pragma unroll
        for (int dd = 0; dd < 2; ++dd)
#pragma unroll
            for (int s = 0; s < 2; ++s) vfa[dd][s] = *(const LAS bf16x8*)(vb + (dd * 32 + r) * AP + (s * 16 + h * 8) * 2);
        {   f32x16 S = mfma32(kfa[0], qf[0], zero16); S = mfma32(kfa[1], qf[1], S);
#pragma unroll
            for (int j = 0; j < 4; ++j) kfb[j] = *(const LAS bf16x8*)(kb + (32 + krow) * AP + j * 32 + h * 16);
#pragma unroll
            for (int i = 0; i < 16; ++i) { S[i] = __builtin_amdgcn_exp2f(S[i]); l0 += S[i]; }
            const bf16x8 p0 = pack_step<0>(S), p1 = pack_step<1>(S);

#pragma unroll
            for (int dd = 0; dd < 2; ++dd) { O0[dd] = mfma32(vfa[dd][0], p0, O0[dd]); O0[dd] = mfma32(vfa[dd][1], p1, O0[dd]); } }
        {   f32x16 S = mfma32(kfa[2], qf[2], zero16); S = mfma32(kfa[3], qf[3], S);
#pragma unroll
            for (int dd = 0; dd < 2; ++dd)
#pragma unroll
                for (int s = 0; s < 2; ++s) vfb[dd][s] = *(const LAS bf16x8*)(vb + (dd * 32 + r) * AP + (32 + s * 16 + h * 8) * 2);
#pragma unroll
            for (int i = 0; i < 16; ++i) { S[i] = __builtin_amdgcn_exp2f(S[i]); l1 += S[i]; }
            const bf16x8 p0 = pack_step<0>(S), p1 = pack_step<1>(S);

#pragma unroll
            for (int dd = 0; dd < 2; ++dd) { O1[dd] = mfma32(vfa[dd][0], p0, O1[dd]); O1[dd] = mfma32(vfa[dd][1], p1, O1[dd]); } }
        {   f32x16 S = mfma32(kfb[0], qf[0], zero16); S = mfma32(kfb[1], qf[1], S);
#pragma unroll
            for (int i = 0; i < 16; ++i) { S[i] = __builtin_amdgcn_exp2f(S[i]); l0 += S[i]; }
            const bf16x8 p0 = pack_step<0>(S), p1 = pack_step<1>(S);

#pragma unroll
            for (int dd = 0; dd < 2; ++dd) { O0[dd] = mfma32(vfb[dd][0], p0, O0[dd]); O0[dd] = mfma32(vfb[dd][1], p1, O0[dd]); } }
        {   f32x16 S = mfma32(kfb[2], qf[2], zero16); S = mfma32(kfb[3], qf[3], S);
#pragma unroll
            for (int i = 0; i < 16; ++i) { S[i] = __builtin_amdgcn_exp2f(S[i]); l1 += S[i]; }
            const bf16x8 p0 = pack_step<0>(S), p1 = pack_step<1>(S);

#pragma unroll
            for (int dd = 0; dd < 2; ++dd) { O1[dd] = mfma32(vfb[dd][0], p0, O1[dd]); O1[dd] = mfma32(vfb[dd][1], p1, O1[dd]); } }
        if (t + 1 < ntile) { *(LAS u32x4*)(KB + (buf ^ 1) * 64 * AP + srow * AP + sch * 16) = kreg; *(LAS u32x4*)(VB + (buf ^ 1) * 64 * AP + srow * AP + sch * 16) = vreg; }
        __syncthreads();
    }
    const GAS float* subw = (const GAS float*)ao.subw; GAS bf16_t* mixp = (GAS bf16_t*)ao.mix;
    asm volatile("" : "+s"(subw)); asm volatile("" : "+s"(mixp));
    l0 += __shfl_xor(l0, 32); l1 += __shfl_xor(l1, 32);
    const float i0 = 1.f / l0, i1 = ao.lam / l1;
    float ss = 0.f;
#pragma unroll
    for (int dd = 0; dd < 2; ++dd)
#pragma unroll
        for (int i = 0; i < 16; ++i) { const float v = O0[dd][i] * i0 - O1[dd][i] * i1; O0[dd][i] = v; ss += v * v; }
    ss += __shfl_xor(ss, 32);
    const float sc = __builtin_amdgcn_rsqf(ss * (1.f / 64.f) + EPS) * ao.outscale;
    GAS bf16_t* orow = mixp + (size_t)qrow * DM + ao.col0;
#pragma unroll
    for (int dd = 0; dd < 2; ++dd)
#pragma unroll
        for (int gq = 0; gq < 4; ++gq) { const int dcol = dd * 32 + 8 * gq + 4 * h; float o[4];
#pragma unroll
            for (int j = 0; j < 4; ++j) o[j] = O0[dd][4 * gq + j] * sc * subw[dcol + j];
            u32x2 w; w[0] = pk2(o[0], o[1]); w[1] = pk2(o[2], o[3]); *(GAS u32x2*)(orow + dcol) = w; }
}
constexpr int G3_KP = 144, G3_VP = 528;
constexpr int G3_KB = 256 * G3_KP, G3_VB = 64 * G3_VP;
DI void attn_item_gqa3(const Frame& F, const bf16_t* Q, const bf16_t* K, const bf16_t* Vt, int q0, int nkeys, const AttnOut& ao) {
    LAS unsigned char* KB = F.lds;
    LAS unsigned char* VB = F.lds + 2 * G3_KB;
    const int tid = F.tid, lane = F.lane, r = lane & 31, h = lane >> 5;
    const int qrow = q0 + F.wave * 32 + r;
    bf16x8 qf[4];
#pragma unroll
    for (int j = 0; j < 4; ++j) qf[j] = ld8g(Q + (size_t)qrow * 64 + j * 16 + 8 * h);
    const f32x16 zero16 = splat16(0.f);
    f32x16 O[2]; O[0] = zero16; O[1] = zero16;
    float l0 = 0.f;
    const int kr = tid >> 3, kc = tid & 7, vr = tid >> 5, vc = tid & 31;
    const bf16_t* kg = K + (size_t)kr * 64 + kc * 8; const bf16_t* vg = Vt + (size_t)vr * NT + vc * 8;
    const int kdst = kr * G3_KP + kc * 16, vdst = vr * G3_VP + vc * 16;
    const int ntile = nkeys >> 8;
    u32x4 sreg[4];
    __syncthreads();
#pragma unroll
    for (int i = 0; i < 4; ++i) sreg[i] = *(const u32x4*)(kg + (size_t)i * 64 * 64);
#pragma unroll
    for (int i = 0; i < 4; ++i) *(LAS u32x4*)(KB + kdst + i * 64 * G3_KP) = sreg[i];
#pragma unroll
    for (int i = 0; i < 4; ++i) sreg[i] = *(const u32x4*)(vg + (size_t)i * 16 * NT);
#pragma unroll
    for (int i = 0; i < 4; ++i) *(LAS u32x4*)(VB + vdst + i * 16 * G3_VP) = sreg[i];
    __syncthreads();
    const int koff = kperm(r) * G3_KP + h * 16, voff = r * G3_VP + h * 16;
    asm volatile("" :: "v"(qf[0]), "v"(qf[1]), "v"(qf[2]), "v"(qf[3]));
#pragma clang loop unroll(disable)
    for (int t = 0; t < ntile; ++t) {
        const int buf = t & 1;
        const bool more = t + 1 < ntile;
        if (more) {
#pragma unroll
            for (int i = 0; i < 4; ++i) sreg[i] = *(const u32x4*)(kg + ((size_t)(t + 1) * 256 + i * 64) * 64); }
        const LAS unsigned char* kb = KB + buf * G3_KB + koff; const LAS unsigned char* vb = VB + buf * G3_VB + voff;
        f32x16 Sc = zero16; bf16x8 pp0, pp1;
#pragma unroll
        for (int j = 0; j < 4; ++j) Sc = mfma32(*(const LAS bf16x8*)(kb + j * 32), qf[j], j ? Sc : zero16);
#pragma unroll
        for (int u = 0; u < 8; ++u) {
            f32x16 Sn = zero16;
            if (u + 1 < 8) {
#pragma unroll
                for (int j = 0; j < 4; ++j) Sn = mfma32(*(const LAS bf16x8*)(kb + (u + 1) * 32 * G3_KP + j * 32), qf[j], j ? Sn : zero16); }
            float ls = 0.f;
#pragma unroll
            for (int i = 0; i < 16; ++i) { Sc[i] = __builtin_amdgcn_exp2f(Sc[i]); ls += Sc[i]; }
            l0 += ls;
            const bf16x8 pc0 = pack_step<0>(Sc), pc1 = pack_step<1>(Sc);
            if (u > 0) {
#pragma unroll
                for (int dd = 0; dd < 2; ++dd) { O[dd] = mfma32(*(const LAS bf16x8*)(vb + dd * 32 * G3_VP + (u - 1) * 64), pp0, O[dd]); O[dd] = mfma32(*(const LAS bf16x8*)(vb + dd * 32 * G3_VP + (u - 1) * 64 + 32), pp1, O[dd]); } }
#pragma unroll
            for (int g = 0; g < 8; ++g) { __builtin_amdgcn_sched_group_barrier(0x8, 1, 0); __builtin_amdgcn_sched_group_barrier(0x2, 5, 0); }
            pp0 = pc0; pp1 = pc1; Sc = Sn;
            if (u == 3 && more) {
#pragma unroll
                for (int i = 0; i < 4; ++i) *(LAS u32x4*)(KB + (buf ^ 1) * G3_KB + kdst + i * 64 * G3_KP) = sreg[i];
#pragma unroll
                for (int i = 0; i < 4; ++i) sreg[i] = *(const u32x4*)(vg + (size_t)(t + 1) * 256 + (size_t)i * 16 * NT); }
        }
#pragma unroll
        for (int dd = 0; dd < 2; ++dd) { O[dd] = mfma32(*(const LAS bf16x8*)(vb + dd * 32 * G3_VP + 7 * 64), pp0, O[dd]); O[dd] = mfma32(*(const LAS bf16x8*)(vb + dd * 32 * G3_VP + 7 * 64 + 32), pp1, O[dd]); }
        if (more) {
#pragma unroll
            for (int i = 0; i < 4; ++i) *(LAS u32x4*)(VB + (buf ^ 1) * G3_VB + vdst + i * 16 * G3_VP) = sreg[i]; }
        __syncthreads();
    }
    GAS bf16_t* mixp = (GAS bf16_t*)ao.mix;
    asm volatile("" : "+s"(mixp));
    l0 += __shfl_xor(l0, 32); const float i0 = 1.f / l0;
    GAS bf16_t* orow = mixp + (size_t)qrow * DM + ao.col0;
#pragma unroll
    for (int dd = 0; dd < 2; ++dd)
#pragma unroll
        for (int gq = 0; gq < 4; ++gq) { const int dcol = dd * 32 + 8 * gq + 4 * h;
            u32x2 w; w[0] = pk2(O[dd][4 * gq] * i0, O[dd][4 * gq + 1] * i0); w[1] = pk2(O[dd][4 * gq + 2] * i0, O[dd][4 * gq + 3] * i0); *(GAS u32x2*)(orow + dcol) = w; }
}
#define FENCE __builtin_amdgcn_sched_barrier(0)
#define G4_UNIT(u, HASQK, HASPV) do { \
            f32x16 Sn = zero16; \
            if (HASQK) Sn = mfma32(kfA[0], qf[0], zero16); \
            FENCE; Sc[0] = __builtin_amdgcn_exp2f(Sc[0]); Sc[1] = __builtin_amdgcn_exp2f(Sc[1]); Sc[2] = __builtin_amdgcn_exp2f(Sc[2]); FENCE; \
            if (HASQK) Sn = mfma32(kfA[1], qf[1], Sn); \
            FENCE; Sc[3] = __builtin_amdgcn_exp2f(Sc[3]); Sc[4] = __builtin_amdgcn_exp2f(Sc[4]); Sc[5] = __builtin_amdgcn_exp2f(Sc[5]); FENCE; \
            if (HASQK) Sn = mfma32(kfA[2], qf[2], Sn); \
            FENCE; Sc[6] = __builtin_amdgcn_exp2f(Sc[6]); Sc[7] = __builtin_amdgcn_exp2f(Sc[7]); Sc[8] = __builtin_amdgcn_exp2f(Sc[8]); FENCE; \
            if (HASQK) Sn = mfma32(kfA[3], qf[3], Sn); \
            FENCE; \
            if (HASQK) { _Pragma("unroll") for (int j = 0; j < 4; ++j) kfA[j] = *(const LAS bf16x8*)(kb + (((u) + 2) & 7) * 32 * G3_KP + j * 32); } \
            Sc[9] = __builtin_amdgcn_exp2f(Sc[9]); Sc[10] = __builtin_amdgcn_exp2f(Sc[10]); Sc[11] = __builtin_amdgcn_exp2f(Sc[11]); FENCE; \
            if (HASPV) O[0] = mfma32(vfA[0], pp0, O[0]); \
            FENCE; Sc[12] = __builtin_amdgcn_exp2f(Sc[12]); Sc[13] = __builtin_amdgcn_exp2f(Sc[13]); Sc[14] = __builtin_amdgcn_exp2f(Sc[14]); FENCE; \
            if (HASPV) O[0] = mfma32(vfA[1], pp1, O[0]); \
            FENCE; Sc[15] = __builtin_amdgcn_exp2f(Sc[15]); \
            l0 += (Sc[0] + Sc[1]) + (Sc[2] + Sc[3]); l1 += (Sc[4] + Sc[5]) + (Sc[6] + Sc[7]); FENCE; \
            if (HASPV) O[1] = mfma32(vfA[2], pp0, O[1]); \
            FENCE; l0 += (Sc[8] + Sc[9]) + (Sc[10] + Sc[11]); l1 += (Sc[12] + Sc[13]) + (Sc[14] + Sc[15]); \
            u32x4 pa; pa[0] = pk2(Sc[0], Sc[1]); pa[1] = pk2(Sc[2], Sc[3]); FENCE; \
            if (HASPV) O[1] = mfma32(vfA[3], pp1, O[1]); \
            FENCE; pa[2] = pk2(Sc[4], Sc[5]); pa[3] = pk2(Sc[6], Sc[7]); \
            u32x4 pb; pb[0] = pk2(Sc[8], Sc[9]); pb[1] = pk2(Sc[10], Sc[11]); pb[2] = pk2(Sc[12], Sc[13]); pb[3] = pk2(Sc[14], Sc[15]); FENCE; \
            pp0 = __builtin_bit_cast(bf16x8, pa); pp1 = __builtin_bit_cast(bf16x8, pb); Sc = Sn; \
            _Pragma("unroll") for (int j = 0; j < 4; ++j) vfA[j] = *(const LAS bf16x8*)(vb + (j >> 1) * 32 * G3_VP + (u) * 64 + (j & 1) * 32); \
            FENCE; } while (0)
DI void attn_item_gqa4(const Frame& F, const bf16_t* Q, const bf16_t* K, const bf16_t* Vt, int q0, int nkeys, const AttnOut& ao) {
    LAS unsigned char* KB = F.lds;
    LAS unsigned char* VB = F.lds + 2 * G3_KB;
    const int tid = F.tid, lane = F.lane, r = lane & 31, h = lane >> 5;
    const int qrow = q0 + F.wave * 32 + r;
    bf16x8 qf[4];
#pragma unroll
    for (int j = 0; j < 4; ++j) qf[j] = ld8g(Q + (size_t)qrow * 64 + j * 16 + 8 * h);
    const f32x16 zero16 = splat16(0.f);
    f32x16 O[2]; O[0] = zero16; O[1] = zero16;
    float l0 = 0.f, l1 = 0.f;
    const int kr = tid >> 3, kc = tid & 7, vr = tid >> 5, vc = tid & 31;
    const bf16_t* kg = K + (size_t)kr * 64 + kc * 8; const bf16_t* vg = Vt + (size_t)vr * NT + vc * 8;
    const int kdst = kr * G3_KP + kc * 16, vdst = vr * G3_VP + vc * 16;
    const int ntile = nkeys >> 8;
    u32x4 sreg[4];
    __syncthreads();
#pragma unroll
    for (int i = 0; i < 4; ++i) sreg[i] = *(const u32x4*)(kg + (size_t)i * 64 * 64);
#pragma unroll
    for (int i = 0; i < 4; ++i) *(LAS u32x4*)(KB + kdst + i * 64 * G3_KP) = sreg[i];
#pragma unroll
    for (int i = 0; i < 4; ++i) sreg[i] = *(const u32x4*)(vg + (size_t)i * 16 * NT);
#pragma unroll
    for (int i = 0; i < 4; ++i) *(LAS u32x4*)(VB + vdst + i * 16 * G3_VP) = sreg[i];
    __syncthreads();
    const int koff = kperm(r) * G3_KP + h * 16, voff = r * G3_VP + h * 16;
    asm volatile("" :: "v"(qf[0]), "v"(qf[1]), "v"(qf[2]), "v"(qf[3]));
#pragma clang loop unroll(disable)
    for (int t = 0; t < ntile; ++t) {
        const int buf = t & 1;
        const bool more = t + 1 < ntile;
        if (more) {
#pragma unroll
            for (int i = 0; i < 4; ++i) sreg[i] = *(const u32x4*)(kg + ((size_t)(t + 1) * 256 + i * 64) * 64); }
        const LAS unsigned char* kb = KB + buf * G3_KB + koff; const LAS unsigned char* vb = VB + buf * G3_VB + voff;
        bf16x8 kfA[4], kfB[4], vfA[4], pp0, pp1;
#pragma unroll
        for (int j = 0; j < 4; ++j) kfB[j] = *(const LAS bf16x8*)(kb + j * 32);
#pragma unroll
        for (int j = 0; j < 4; ++j) kfA[j] = *(const LAS bf16x8*)(kb + 32 * G3_KP + j * 32);
        f32x16 Sc = mfma32(kfB[0], qf[0], zero16); Sc = mfma32(kfB[1], qf[1], Sc); Sc = mfma32(kfB[2], qf[2], Sc); Sc = mfma32(kfB[3], qf[3], Sc);
        FENCE;
        G4_UNIT(0, true, false);
#pragma clang loop unroll(disable)
        for (int u = 1; u < 7; ++u) {
            G4_UNIT(u, true, true);
            if (u == 3 && more) {
#pragma unroll
                for (int i = 0; i < 4; ++i) *(LAS u32x4*)(KB + (buf ^ 1) * G3_KB + kdst + i * 64 * G3_KP) = sreg[i];
#pragma unroll
                for (int i = 0; i < 4; ++i) sreg[i] = *(const u32x4*)(vg + (size_t)(t + 1) * 256 + (size_t)i * 16 * NT); }
        }
        G4_UNIT(7, false, true);
        O[0] = mfma32(vfA[0], pp0, O[0]); O[0] = mfma32(vfA[1], pp1, O[0]); O[1] = mfma32(vfA[2], pp0, O[1]); O[1] = mfma32(vfA[3], pp1, O[1]);
        if (more) {
#pragma unroll
            for (int i = 0; i < 4; ++i) *(LAS u32x4*)(VB + (buf ^ 1) * G3_VB + vdst + i * 16 * G3_VP) = sreg[i]; }
        __syncthreads();
    }
    GAS bf16_t* mixp = (GAS bf16_t*)ao.mix;
    asm volatile("" : "+s"(mixp));
    int lz = 0; asm volatile("" : "+v"(lz));
    const int lane2 = (int)__builtin_amdgcn_mbcnt_hi(~0u, __builtin_amdgcn_mbcnt_lo(~0u, 0u)) + lz, h2 = lane2 >> 5, qrow2 = q0 + F.wave * 32 + (lane2 & 31);
    l0 += l1; l0 += __shfl_xor(l0, 32); const float i0 = 1.f / l0;
    GAS bf16_t* orow = mixp + (size_t)qrow2 * DM + ao.col0;
#pragma unroll
    for (int dd = 0; dd < 2; ++dd)
#pragma unroll
        for (int gq = 0; gq < 4; ++gq) { const int dcol = dd * 32 + 8 * gq + 4 * h2;
            u32x2 w; w[0] = pk2(O[dd][4 * gq] * i0, O[dd][4 * gq + 1] * i0); w[1] = pk2(O[dd][4 * gq + 2] * i0, O[dd][4 * gq + 3] * i0); *(GAS u32x2*)(orow + dcol) = w; }
}
DI void p4_attn_diff(const Frame& F, int l, int it) {
    const bool isctx = it >= 256; const int hd = isctx ? it - 256 : it & 3, qb = isctx ? 0 : it >> 2;
    const unsigned* km = WSP(unsigned, WS_CTL) + CW_KMAX + l * 32;
    const float km0 = sqrtf(__uint_as_float(__hip_atomic_load(km + hd * 2, __ATOMIC_RELAXED, __HIP_MEMORY_SCOPE_AGENT)));
    const float km1 = sqrtf(__uint_as_float(__hip_atomic_load(km + hd * 2 + 1, __ATOMIC_RELAXED, __HIP_MEMORY_SCOPE_AGENT)));
    const float lam_init = 0.8f - 0.6f * __expf(-0.3f * (float)l);
    AttnOut ao; ao.mix = WSP(bf16_t, WS_MIX); ao.col0 = hd * 64; ao.lam = WSP(float, WS_LAM)[l]; ao.outscale = 1.f - lam_init; ao.subw = ((const float*)F.in[I_SUBLN]) + (size_t)l * 64;
    const float qm0 = sqrtf(__uint_as_float(__hip_atomic_load(km + 10 + hd * 2, __ATOMIC_RELAXED, __HIP_MEMORY_SCOPE_AGENT))), qm1 = sqrtf(__uint_as_float(__hip_atomic_load(km + 10 + hd * 2 + 1, __ATOMIC_RELAXED, __HIP_MEMORY_SCOPE_AGENT)));
    if (false && qm0 * km0 <= 100.f && qm1 * km1 <= 100.f)
        attn_item_diff2(F, WSP(bf16_t, WS_QD) + (size_t)hd * NT * 64, WSP(bf16_t, WS_KD) + (size_t)hd * NT * 64, WSP(bf16_t, WS_VTD) + (size_t)hd * 64 * NT, isctx ? 0 : CTX + qb * 256, isctx ? CTX : NT, ao);
    else
    attn_item<true, DIFF_KT>(F, WSP(bf16_t, WS_QD) + (size_t)hd * NT * 64, WSP(bf16_t, WS_KD) + (size_t)hd * NT * 64, WSP(bf16_t, WS_VTD) + (size_t)hd * 64 * NT,
                    WSP(float, WS_QND) + (size_t)(hd * 2) * NT, WSP(float, WS_QND) + (size_t)(hd * 2 + 1) * NT, km0, km1, isctx ? 0 : CTX + qb * 256, isctx ? CTX : NT, ao);
}
#ifndef GQA_KT_V
#define GQA_KT_V 64
#endif
constexpr int GQA_KT = GQA_KT_V;
DI bool gqa_fast_ok(const Frame& F, int l) {
    const unsigned* km = WSP(unsigned, WS_CTL) + CW_KMAX + l * 32; bool ok = true;
    for (int hq = 0; hq < 4; ++hq) { const float k = sqrtf(__uint_as_float(__hip_atomic_load(km + 8 + (hq >> 1), __ATOMIC_RELAXED, __HIP_MEMORY_SCOPE_AGENT))), q = sqrtf(__uint_as_float(__hip_atomic_load(km + 18 + hq, __ATOMIC_RELAXED, __HIP_MEMORY_SCOPE_AGENT)));
        ok = ok && (q * k <= 100.f); }
    return ok;
}
template <bool FAST>
DI void p4_attn_gqa(const Frame& F, int l, int it) {
    const bool isctx = it >= 256; const int hq = isctx ? it - 256 : it & 3, qb = isctx ? 0 : it >> 2, g = hq >> 1;
    AttnOut ao; ao.mix = WSP(bf16_t, WS_MIX); ao.col0 = 768 + hq * 64; ao.lam = 0.f; ao.outscale = 1.f; ao.subw = nullptr;
    if (FAST) attn_item_gqa4(F, WSP(bf16_t, WS_QG) + (size_t)hq * NT * 64, WSP(bf16_t, WS_KG) + (size_t)g * NT * 64, WSP(bf16_t, WS_VTG) + (size_t)g * 64 * NT, isctx ? 0 : CTX + qb * 256, isctx ? CTX : NT, ao);
    else { const unsigned* km = WSP(unsigned, WS_CTL) + CW_KMAX + l * 32;
        const float km0 = sqrtf(__uint_as_float(__hip_atomic_load(km + 8 + g, __ATOMIC_RELAXED, __HIP_MEMORY_SCOPE_AGENT)));
        attn_item<false, GQA_KT>(F, WSP(bf16_t, WS_QG) + (size_t)hq * NT * 64, WSP(bf16_t, WS_KG) + (size_t)g * NT * 64, WSP(bf16_t, WS_VTG) + (size_t)g * 64 * NT,
                         WSP(float, WS_QNG) + (size_t)hq * NT, nullptr, km0, 0.f, isctx ? 0 : CTX + qb * 256, isctx ? CTX : NT, ao, isctx ? -1 : l); }
}

DI void p4_ssd_out(const Frame& F, int l, int item) {
    const int c = item >> 1, lh = item & 1;
    LAS float* DTL = (LAS float*)(F.lds + 96 * 1024);
    LAS float* CML = DTL + 8 * 128;
    const int tid = F.tid, lane = F.lane, r = lane & 31, h = lane >> 5, tok0 = c * 128;
    __syncthreads();
    for (int i = tid; i < 1024; i += 512) { DTL[i] = WSP(float, WS_DTV)[(size_t)c * 1024 + i]; CML[i] = WSP(float, WS_CUM)[(size_t)c * 1024 + i]; }
    __syncthreads();
    const int hh = F.wave >> 1, g = hh >> 1;
    const float Dh = ((const float*)F.in[I_SSDD])[(size_t)l * 4 + hh];
    const bf16_t* CN = WSP(bf16_t, WS_CN); const bf16_t* BN = WSP(bf16_t, WS_BN);
    const bf16_t* XS = WSP(bf16_t, WS_XST) + ((size_t)c * 256 + hh * 64) * 128;
    { const int lt = F.wave & 1;
        const int ll = 64 * lh + 32 * lt + r;
        bf16x8 cfr[8];
#pragma unroll
        for (int ks = 0; ks < 8; ++ks) cfr[ks] = ld8g(CN + (size_t)(tok0 + ll) * 256 + g * 128 + ks * 16 + 8 * h);
        const bf16_t* zr0 = WSP(bf16_t, WS_U) + (size_t)(tok0 + ll) * NU + U_Z + hh * 64;
        u32x2 zzv[2][4];
#pragma unroll
        for (int pt = 0; pt < 2; ++pt)
#pragma unroll
            for (int gq = 0; gq < 4; ++gq) zzv[pt][gq] = *(const u32x2*)(zr0 + pt * 32 + 8 * gq + 4 * h);
        const bf16_t* bnp = BN + (size_t)(tok0 + kperm(r)) * 256 + g * 128 + 8 * h;
        const bf16_t* xsp = XS + (size_t)r * 128 + 8 * h;
        bf16x8 bn[8], xs[4], bnn[8], xsn[4], sf0[2][8];
#pragma unroll
        for (int ks = 0; ks < 8; ++ks) bn[ks] = ld8g(bnp + ks * 16);
#pragma unroll
        for (int q = 0; q < 4; ++q) xs[q] = ld8g(xsp + (size_t)(q >> 1) * 32 * 128 + 16 * (q & 1));
        const float cfl = CML[hh * 128 + ll], cbl = CML[(4 + hh) * 128 + ll], dsum = DTL[hh * 128 + ll] + DTL[(4 + hh) * 128 + ll];
        f32x16 Y[2];
        Y[0] = splat16(0.f); Y[1] = splat16(0.f);
        const bf16_t* S0 = WSP(bf16_t, WS_SIN) + ((size_t)c * 8 + hh) * 8192 + (size_t)r * 128 + 8 * h;
#pragma unroll
        for (int st = 0; st < 4; ++st) {
            if (st < 3) {
#pragma unroll
                for (int ks = 0; ks < 8; ++ks) bnn[ks] = ld8g(bnp + (size_t)(st + 1) * 32 * 256 + ks * 16);
#pragma unroll
                for (int q = 0; q < 4; ++q) xsn[q] = ld8g(xsp + (size_t)(q >> 1) * 32 * 128 + 32 * (st + 1) + 16 * (q & 1));
            } else {
#pragma unroll
                for (int pt = 0; pt < 2; ++pt)
#pragma unroll
                    for (int ks = 0; ks < 8; ++ks) sf0[pt][ks] = ld8g(S0 + (size_t)pt * 32 * 128 + ks * 16);
            }
            f32x16 G = splat16(0.f);
#pragma unroll
            for (int ks = 0; ks < 8; ++ks) G = mfma32(bn[ks], cfr[ks], G);
#pragma unroll
            for (int i = 0; i < 16; ++i) { const int s = 32 * st + kperm(crow(i, h));
                const float cfs = CML[hh * 128 + s], cbs = CML[(4 + hh) * 128 + s], dfs = DTL[hh * 128 + s], dbs = DTL[(4 + hh) * 128 + s];
                float fac;
                if (s < ll) fac = dfs * __builtin_amdgcn_exp2f(cfl - cfs);
                else if (s > ll) fac = dbs * __builtin_amdgcn_exp2f(cbl - cbs);
                else fac = dsum;
                G[i] = G[i] * fac + (s == ll ? Dh : 0.f); }
            const bf16x8 m0 = pack_step<0>(G), m1 = pack_step<1>(G);
#pragma unroll
            for (int pt = 0; pt < 2; ++pt) { Y[pt] = mfma32(xs[pt * 2], m0, Y[pt]); Y[pt] = mfma32(xs[pt * 2 + 1], m1, Y[pt]); }
            if (st < 3) {
#pragma unroll
                for (int ks = 0; ks < 8; ++ks) bn[ks] = bnn[ks];
#pragma unroll
                for (int q = 0; q < 4; ++q) xs[q] = xsn[q]; }
        }
        { bf16x8 sf1[2][8];
#pragma unroll
          for (int pt = 0; pt < 2; ++pt)
#pragma unroll
              for (int ks = 0; ks < 8; ++ks) sf1[pt][ks] = ld8g(S0 + (size_t)4 * 8192 + (size_t)pt * 32 * 128 + ks * 16);
          const float e0 = __builtin_amdgcn_exp2f(cfl), e1 = __builtin_amdgcn_exp2f(cbl);
#pragma unroll
          for (int pt = 0; pt < 2; ++pt) { f32x16 Z = splat16(0.f);
#pragma unroll
              for (int ks = 0; ks < 8; ++ks) Z = mfma32(sf0[pt][ks], cfr[ks], Z);
              Y[pt] += Z * e0; }
#pragma unroll
          for (int pt = 0; pt < 2; ++pt) { f32x16 Z = splat16(0.f);
#pragma unroll
              for (int ks = 0; ks < 8; ++ks) Z = mfma32(sf1[pt][ks], cfr[ks], Z);
              Y[pt] += Z * e1; } }
        const int tok = tok0 + ll; float ssq = 0.f;
        bf16_t* yo = WSP(bf16_t, WS_YSSD) + (size_t)tok * 256 + hh * 64;
#pragma unroll
        for (int pt = 0; pt < 2; ++pt)
#pragma unroll
            for (int gq = 0; gq < 4; ++gq) { const int p = pt * 32 + 8 * gq + 4 * h; const u32x2 zz = zzv[pt][gq];
                const float z0 = bflo(zz[0]), z1 = bfhi(zz[0]), z2 = bflo(zz[1]), z3 = bfhi(zz[1]);
                const float y0 = Y[pt][4 * gq] * silu_f(z0), y1 = Y[pt][4 * gq + 1] * silu_f(z1), y2 = Y[pt][4 * gq + 2] * silu_f(z2), y3 = Y[pt][4 * gq + 3] * silu_f(z3);
                ssq += y0 * y0 + y1 * y1 + y2 * y2 + y3 * y3;
                u32x2 w; w[0] = pk2(y0, y1); w[1] = pk2(y2, y3); *(u32x2*)(yo + p) = w; }
        ssq += __shfl_xor(ssq, 32);
        if (h == 0) WSP(float, WS_SSQ)[(size_t)tok * 4 + hh] = ssq;
    }
}

constexpr int N_S5O = 16 * 9 * 2;
DI float gelu_tanh(float y) { const float u = 0.7978845608028654f * (y + 0.044715f * y * y * y); const float e = __builtin_amdgcn_exp2f(2.8853900817779268f * u); return y * (1.f - __builtin_amdgcn_rcpf(1.f + e)); }
constexpr int HBP = 264;
DI void p4_s5_out(const Frame& F, int l, int item) {
    const int mh = item & 1, nt = (item >> 1) % 9, g = (item >> 1) / 9, lane = F.lane, r = lane & 31, h = lane >> 5;
    s5_stage_u<false>(F, g, nt);
    LAS bf16_t* HB = (LAS bf16_t*)F.lds + 32 * UBP;
    LAS bf16_t* KTL = (LAS bf16_t*)(F.lds + 84 * 1024);
    { const bf16_t* ktg = WSP(bf16_t, WS_KTAB) + ((size_t)l * 16 + g) * 3 * 64 * 256;
      for (int i = F.tid; i < (2 * 64 * 256 + 256) / 8; i += 512) *(LAS u32x4*)(KTL + 8 * i) = *(const u32x4*)(ktg + 8 * i); }
    for (int i = F.tid; i < 32 * 32; i += 512) { const int n = i >> 5, p = i & 31; const int chunk = nt * 32 + n, cc = chunk < NC5 ? chunk : NC5 - 1;
        *(LAS u32x4*)(HB + n * HBP + 8 * p) = *(const u32x4*)(WSP(bf16_t, WS_HIN) + (size_t)cc * 4096 + g * 256 + 8 * p); }
    __syncthreads();
    const LAS bf16_t* UB = (const LAS bf16_t*)F.lds + r * UBP + 8 * h; const LAS bf16_t* HBr = HB + r * HBP + 8 * h;
    const int chunk = nt * 32 + r;
#pragma unroll 1
    for (int mi = 0; mi < 2; ++mi) {
        const int mt = mh * 16 + F.wave * 2 + mi, row = mt * 32 + r, t = row >> 4, ch = row & 15;
        const LAS bf16_t* KT = KTL + ch * 16 + 8 * h;
        const bf16_t* CC = WSP(bf16_t, WS_CC5) + ((size_t)l * 16 + g) * 1024 * 256 + ((size_t)mt * 16 * 64 + lane) * 8;
        bf16x8 ccf[16];
#pragma unroll
        for (int kc = 0; kc < 16; ++kc) ccf[kc] = ld8g(CC + kc * 512);
        f32x16 acc = splat16(0.f);
#pragma unroll 16
        for (int s = 0; s < 64; ++s) { const int sel = s < t ? 0 : (s > t ? 1 : 2), lag = s < t ? t - s : (s > t ? s - t : 0);
            acc = mfma32(*(const LAS bf16x8*)(KT + (sel * 64 + lag) * 256), *(const LAS bf16x8*)(UB + s * 16), acc); }
#pragma unroll
        for (int kc = 0; kc < 16; ++kc) acc = mfma32(ccf[kc], *(const LAS bf16x8*)(HBr + kc * 16), acc);
        if (chunk < NC5) {
#pragma unroll
            for (int gq = 0; gq < 4; ++gq) { const int rr = mt * 32 + 8 * gq + 4 * h, tt = rr >> 4, c0 = rr & 15;
                u32x2 w; w[0] = pk2(gelu_tanh(acc[4 * gq]), gelu_tanh(acc[4 * gq + 1])); w[1] = pk2(gelu_tanh(acc[4 * gq + 2]), gelu_tanh(acc[4 * gq + 3]));
                *(u32x2*)(WSP(bf16_t, WS_YS5) + (size_t)(chunk * S5L + tt) * 256 + g * 16 + c0) = w; } }
    }
}

DI void p5_finish(const Frame& F, int l) {
    const int lane = F.lane;
    { const f32x4 nw = *(const f32x4*)(((const float*)F.in[I_SSDNW]) + (size_t)l * 256 + 4 * lane);
      f32x4 q[9]; u32x2 y[9];
#pragma unroll
      for (int k = 0; k < 9; ++k) { const int r = F.wave + 8 * k, row = F.bid * RPB + (r < RPB ? r : RPB - 1), rc = row < NT ? row : NT - 1;
          q[k] = *(const f32x4*)(WSP(float, WS_SSQ) + (size_t)rc * 4); y[k] = *(const u32x2*)(WSP(bf16_t, WS_YSSD) + (size_t)rc * 256 + 4 * lane); }
#pragma unroll
      for (int k = 0; k < 9; ++k) { const int r = F.wave + 8 * k, row = F.bid * RPB + r;
          if (r < RPB && row < NT) { const float rs = __builtin_amdgcn_rsqf((q[k][0] + q[k][1] + q[k][2] + q[k][3]) * (1.f / 256.f) + EPS);
              u32x2 w; w[0] = pk2(bflo(y[k][0]) * rs * nw[0], bfhi(y[k][0]) * rs * nw[1]); w[1] = pk2(bflo(y[k][1]) * rs * nw[2], bfhi(y[k][1]) * rs * nw[3]);
              *(u32x2*)(WSP(bf16_t, WS_MIX) + (size_t)row * DM + 256 + 4 * lane) = w; } } }
    const int r = lane & 31, h = lane >> 5, nt = F.wave;
    const bf16_t* WG = WSP(bf16_t, WS_WGLU) + (size_t)l * 65536;
    bf16x8 wf[16];
#pragma unroll
    for (int ks = 0; ks < 16; ++ks) wf[ks] = ld8g(WG + (size_t)(nt * 32 + r) * 256 + ks * 16 + 8 * h);
    f32x4 bb[4];
#pragma unroll
    for (int gq = 0; gq < 4; ++gq) bb[gq] = *(const f32x4*)(((const float*)F.in[I_BGLU]) + (size_t)l * 256 + nt * 32 + 8 * gq + 4 * h);
    for (int mt = F.bid; mt < NT / 32; mt += F.G) {
        const bf16_t* Y = WSP(bf16_t, WS_YS5) + (size_t)(mt * 32) * 256;
        bf16x8 af[16]; u32x2 yy[4];
#pragma unroll
        for (int ks = 0; ks < 16; ++ks) af[ks] = ld8g(Y + (size_t)r * 256 + ks * 16 + 8 * h);
#pragma unroll
        for (int gq = 0; gq < 4; ++gq) yy[gq] = *(const u32x2*)(Y + (size_t)r * 256 + nt * 32 + 8 * gq + 4 * h);
        const int tok = mt * 32 + r;
        f32x16 acc = splat16(0.f);
#pragma unroll
        for (int ks = 0; ks < 16; ++ks) acc = mfma32(wf[ks], af[ks], acc);
#pragma unroll
        for (int gq = 0; gq < 4; ++gq) { const int n0 = nt * 32 + 8 * gq + 4 * h;
            u32x2 w; w[0] = pk2(bflo(yy[gq][0]) * sigmoid_f(acc[4 * gq] + bb[gq][0]), bfhi(yy[gq][0]) * sigmoid_f(acc[4 * gq + 1] + bb[gq][1]));
            w[1] = pk2(bflo(yy[gq][1]) * sigmoid_f(acc[4 * gq + 2] + bb[gq][2]), bfhi(yy[gq][1]) * sigmoid_f(acc[4 * gq + 3] + bb[gq][3]));
            *(u32x2*)(WSP(bf16_t, WS_MIX) + (size_t)tok * DM + 512 + n0) = w; }
    }
    __syncthreads();
}

#ifndef PH_MASK
#define PH_MASK 0xFFFF
#endif
#define PHEN(k) ((PH_MASK >> (k)) & 1)
#ifndef PH_REP
#define PH_REP 0
#endif
#define NREP(k) (((PH_REP >> (k)) & 1) ? 2 : 1)
#ifndef STAG_GU
#define STAG_GU 0
#endif
#ifndef STAG_DN
#define STAG_DN 0
#endif
#ifndef REP_SKIP_STORES
#define REP_SKIP_STORES 0
#endif
DI Frame launder(const Frame& F) { Frame G = F; int t = F.wave * 64 + (int)__builtin_amdgcn_mbcnt_hi(~0u, __builtin_amdgcn_mbcnt_lo(~0u, 0u)); GAS unsigned char* w = F.ws; const GAS float* const __attribute__((address_space(4)))* ip = F.in;
    int bb = F.bid, gg = F.G; LAS unsigned char* lp = F.lds; asm volatile("" : "+s"(lp)); G.lds = lp; asm volatile("" : "+v"(t)); asm volatile("" : "+s"(w)); asm volatile("" : "+s"(ip)); asm volatile("" : "+s"(bb)); asm volatile("" : "+s"(gg)); G.bid = bb; G.G = gg; G.tid = t; G.lane = t & 63; G.ws = w; G.in = ip; return G; }
DI int launder_s(int v) { asm volatile("" : "+s"(v)); return v; }
constexpr int NPL = 10, N_PHASES = 1 + DEPTH * NPL + 1;
__global__ void __launch_bounds__(512, 2) hybrid_fwd(Args args) {
    extern __shared__ __attribute__((aligned(16))) unsigned char lds_raw[];
    Frame F; F.lds = (LAS unsigned char*)lds_raw; F.in = (const GAS float* const __attribute__((address_space(4)))*)__builtin_amdgcn_kernarg_segment_ptr(); F.ws = (GAS unsigned char*)args.ws; F.out = args.out;
    F.tid = threadIdx.x; F.lane = F.tid & 63; F.wave = __builtin_amdgcn_readfirstlane(F.tid >> 6); F.G = gridDim.x; F.bid = blockIdx.x;
    const int lo = args.ph_lo, hi = args.ph_hi;
    volatile LAS unsigned* xbw = (volatile LAS unsigned*)(F.lds + LDS_BYTES - 64);
    if (F.tid == 0) { xbw[0] = 0u; xbw[1] = 0u; }
    __syncthreads();
    XcdBarrier bar; bar.bar = WSP(unsigned, WS_CTL) + CW_BAR; bar.x = 0; bar.st = xbw;
    if (hi - lo > 1) bar = xcd_barrier_post(WSP(unsigned, WS_CTL) + CW_BAR, xbw);
#define IN(k) (lo <= (k) && (k) < hi)
#ifndef DIAG
#define DIAG 0
#endif
#if DIAG
    volatile LAS unsigned* dg = (volatile LAS unsigned*)(F.lds + LDS_BYTES - 192);
    if (F.tid < 16) dg[F.tid] = 0u;
    unsigned long long t_prev = __builtin_amdgcn_s_memrealtime();
#define DIAG_ACC(kind) do { if (blockIdx.x == 0 && threadIdx.x == 0) { const unsigned long long t_now = __builtin_amdgcn_s_memrealtime(); dg[kind] += (unsigned)(t_now - t_prev); t_prev = t_now; } } while (0)
#else
#define DIAG_ACC(kind) do { } while (0)
#endif
#define SEAM(k) do { if (IN(k) && IN((k) + 1)) xcd_barrier(bar); } while (0)
#define WSQ(T, off) ((T*)(Fq.ws + (off)))
#define LAUNDERED for (int rep_ = 0; rep_ < nrep_; ++rep_) for (Frame Fq = launder(F), *once_ = &Fq; once_; once_ = nullptr) for (int lq = launder_s(l_cur), once2_ = 1; once2_; once2_ = 0)
    int ph = 0, l_cur = 0, nrep_ = 1;
    nrep_ = NREP(0); if (PHEN(0) && IN(ph)) LAUNDERED { (void)lq; p0_prologue(Fq, rep_); }
    SEAM(ph); ++ph; DIAG_ACC(0);
    { l_cur = 0;
        nrep_ = NREP(1); if (PHEN(1) && IN(ph)) LAUNDERED p1_norm<false>(Fq, lq);
        SEAM(ph); ++ph; DIAG_ACC(1);
        nrep_ = NREP(2); if (PHEN(2) && IN(ph)) LAUNDERED { pg8::Gemm gm{WSQ(pg8::bf16_t, WS_H), WSQ(pg8::bf16_t, WS_WIN) + (size_t)lq * NU * DM, NT, NU, DM}; pg8::StaticOrder S; S.init(NT, NU, Fq.G, Fq.bid);
            EpiU E{WSQ(bf16_t, WS_U), NU, WSQ(bf16_t, WS_US5)}; pg8::gemm_phase<EpiU, pg8::StaticOrder>((PG8_LAS unsigned char*)Fq.lds, gm, S, E); }
        SEAM(ph); ++ph; DIAG_ACC(2);
        nrep_ = NREP(3); if (PHEN(3) && IN(ph)) LAUNDERED {
            unsigned* qctr = WSQ(unsigned, WS_CTL) + CW_Q0 + 64 * (2 + 2 * lq + rep_ * 8);
            for (;;) { const int idx = q_next(Fq, qctr); if (idx >= NCH + 260 + N_S5H) break; const Frame Fi = launder(Fq);
                if (idx < NCH) { for (int q_ = 0; q_ < NREP(21); ++q_) p3_ssd_prep(Fi, lq, idx); }
                else if (idx < NCH + 260) { for (int q_ = 0; q_ < NREP(22); ++q_) p3_attn_prep(Fi, lq, idx - NCH); }
                else { for (int q_ = 0; q_ < NREP(23); ++q_) p3_s5_hloc(Fi, lq, idx - NCH - 260); }
            }
        }
        SEAM(ph); ++ph; DIAG_ACC(3);
        nrep_ = NREP(4); if (PHEN(4) && IN(ph)) LAUNDERED { for (int q_ = 0; q_ < NREP(16); ++q_) p4_ssd_scan(Fq, lq);
            for (int q_ = 0; q_ < NREP(17); ++q_) for (int it = Fq.bid; it < 256; it += Fq.G) { const Frame Fi = launder(Fq); p4_attn_diff(Fi, lq, it); }
            unsigned* qctr = WSQ(unsigned, WS_CTL) + CW_Q0 + 64 * (10 + lq + rep_ * 8);
            for (;;) { const int idx = q_next(Fq, qctr); if (idx >= 4) break; const Frame Fi = launder(Fq);
                p4_attn_diff(Fi, lq, 256 + idx); } }
        SEAM(ph); ++ph; DIAG_ACC(4);
        nrep_ = NREP(5); if (PHEN(5) && IN(ph)) LAUNDERED {
            if (false && gqa_fast_ok(Fq, lq)) { for (int q_ = 0; q_ < NREP(18); ++q_) for (int it = Fq.bid; it < 256; it += Fq.G) { const Frame Fi = launder(Fq); p4_attn_gqa<true>(Fi, lq, it); } }
            else { for (int q_ = 0; q_ < NREP(18); ++q_) for (int it = Fq.bid; it < 256; it += Fq.G) { const Frame Fi = launder(Fq); p4_attn_gqa<false>(Fi, lq, it); } }
            { unsigned* qctr = WSQ(unsigned, WS_CTL) + CW_Q0 + 64 * (3 + 2 * lq + rep_ * 8);
              for (;;) { const int idx = q_next(Fq, qctr); if (idx >= 2 * NCH + N_S5O + 4) break; const Frame Fi = launder(Fq);
                  if (idx < 2 * NCH) p4_ssd_out(Fi, lq, idx); else if (idx < 2 * NCH + N_S5O) p4_s5_out(Fi, lq, idx - 2 * NCH); else p4_attn_gqa<false>(Fi, lq, 256 + idx - 2 * NCH - N_S5O); } }
        }
        SEAM(ph); ++ph; DIAG_ACC(5);
        nrep_ = NREP(6); if (PHEN(6) && IN(ph)) LAUNDERED p5_finish(Fq, lq);
        SEAM(ph); ++ph; DIAG_ACC(6);
        nrep_ = NREP(7); if (PHEN(7) && IN(ph)) LAUNDERED { pg8::Gemm gm{WSQ(pg8::bf16_t, WS_MIX) + (size_t)CTX * DM, WSQ(pg8::bf16_t, WS_WOUT) + (size_t)lq * DM * DM, SEQ, DM, DM}; pg8::StaticOrder S; S.init(SEQ, DM, Fq.G, Fq.bid);
            EpiRes E; E.C = WSQ(float, WS_XA); E.g1 = WSQ(float, WS_MOD) + (size_t)lq * 2 * 6144 + 2 * 1024;
            if (lq == 0) { E.res_ctx = ((const float*)Fq.in[I_CTX]); E.res_lat = ((const float*)Fq.in[I_X]); } else { E.res_ctx = WSQ(float, WS_XB); E.res_lat = WSQ(float, WS_XB) + (size_t)CTX * DM; }
            pg8::gemm_phase<EpiRes, pg8::StaticOrder>((PG8_LAS unsigned char*)Fq.lds, gm, S, E);
            if (lq < DEPTH - 1) outproj_ctx(Fq, lq, E.res_ctx); }
        SEAM(ph); ++ph; DIAG_ACC(7);
        nrep_ = NREP(8); if (PHEN(8) && IN(ph)) LAUNDERED p7a_router(Fq, lq, rep_);
        SEAM(ph); ++ph; DIAG_ACC(8);
        nrep_ = NREP(10); if (PHEN(10) && IN(ph)) LAUNDERED { const int ntiles = moe_tables(Fq, lq); const LAS int* t2e = (const LAS int*)(Fq.lds + LDS_MISC) + 64;
            moe_rows(Fq, lq, ntiles, 8);
            pg8::Gemm gm{WSQ(pg8::bf16_t, WS_H), WSQ(pg8::bf16_t, WS_WGU) + (size_t)lq * NEXP * 2048 * DM, CAP, 2048, DM};
            MoeOrder S{8, ntiles, Fq.G, Fq.bid, t2e, (long)2048 * DM * 2};
            moe_bias(Fq, ntiles, 8, ((const float*)Fq.in[I_BGU]) + (size_t)lq * NEXP * 2048, 2048);
            EpiAct E{WSQ(bf16_t, WS_ACT), (const LAS float*)(Fq.lds + LDS_BIASL)};
            if (STAG_GU) xcd_stagger(Fq, STAG_GU);
            pg8::gemm_phase_gather<EpiAct, MoeOrder>((PG8_LAS unsigned char*)Fq.lds, gm, S, E, (const PG8_LAS int*)(Fq.lds + LDS_MISC + 2048)); }
        SEAM(ph); ++ph; DIAG_ACC(10);
        nrep_ = NREP(11); if (PHEN(11) && IN(ph)) LAUNDERED { const int ntiles = moe_tables(Fq, lq); const LAS int* t2e = (const LAS int*)(Fq.lds + LDS_MISC) + 64;
            pg8::Gemm gm{WSQ(pg8::bf16_t, WS_ACT), WSQ(pg8::bf16_t, WS_WDN) + (size_t)lq * NEXP * DM * DM, CAP, DM, DM};
            MoeOrder S{4, ntiles, Fq.G, Fq.bid, t2e, (long)DM * DM * 2};
            moe_bias(Fq, ntiles, 4, ((const float*)Fq.in[I_BDN]) + (size_t)lq * NEXP * DM, DM);
            EpiDown E{WSQ(bf16_t, WS_YB), (const LAS float*)(Fq.lds + LDS_BIASL), REP_SKIP_STORES * rep_, WSQ(bf16_t, WS_U)};
            if (STAG_DN) xcd_stagger(Fq, STAG_DN);
            pg8::gemm_phase<EpiDown, MoeOrder>((PG8_LAS unsigned char*)Fq.lds, gm, S, E); }
        SEAM(ph); ++ph; DIAG_ACC(11);
    }
    { l_cur = 1;
        nrep_ = NREP(1); if (PHEN(1) && IN(ph)) LAUNDERED p1_norm<false>(Fq, lq);
        SEAM(ph); ++ph; DIAG_ACC(1);
        nrep_ = NREP(2); if (PHEN(2) && IN(ph)) LAUNDERED { pg8::Gemm gm{WSQ(pg8::bf16_t, WS_H), WSQ(pg8::bf16_t, WS_WIN) + (size_t)lq * NU * DM, NT, NU, DM}; pg8::StaticOrder S; S.init(NT, NU, Fq.G, Fq.bid);
            EpiU E{WSQ(bf16_t, WS_U), NU, WSQ(bf16_t, WS_US5)}; pg8::gemm_phase<EpiU, pg8::StaticOrder>((PG8_LAS unsigned char*)Fq.lds, gm, S, E); }
        SEAM(ph); ++ph; DIAG_ACC(2);
        nrep_ = NREP(3); if (PHEN(3) && IN(ph)) LAUNDERED {
            unsigned* qctr = WSQ(unsigned, WS_CTL) + CW_Q0 + 64 * (2 + 2 * lq + rep_ * 8);
            for (;;) { const int idx = q_next(Fq, qctr); if (idx >= NCH + 260 + N_S5H) break; const Frame Fi = launder(Fq);
                if (idx < NCH) { for (int q_ = 0; q_ < NREP(21); ++q_) p3_ssd_prep(Fi, lq, idx); }
                else if (idx < NCH + 260) { for (int q_ = 0; q_ < NREP(22); ++q_) p3_attn_prep(Fi, lq, idx - NCH); }
                else { for (int q_ = 0; q_ < NREP(23); ++q_) p3_s5_hloc(Fi, lq, idx - NCH - 260); }
            }
        }
        SEAM(ph); ++ph; DIAG_ACC(3);
        nrep_ = NREP(4); if (PHEN(4) && IN(ph)) LAUNDERED { for (int q_ = 0; q_ < NREP(16); ++q_) p4_ssd_scan(Fq, lq);
            for (int q_ = 0; q_ < NREP(17); ++q_) for (int it = Fq.bid; it < 256; it += Fq.G) { const Frame Fi = launder(Fq); p4_attn_diff(Fi, lq, it); }
            unsigned* qctr = WSQ(unsigned, WS_CTL) + CW_Q0 + 64 * (10 + lq + rep_ * 8);
            for (;;) { const int idx = q_next(Fq, qctr); if (idx >= 4) break; const Frame Fi = launder(Fq);
                p4_attn_diff(Fi, lq, 256 + idx); } }
        SEAM(ph); ++ph; DIAG_ACC(4);
        nrep_ = NREP(5); if (PHEN(5) && IN(ph)) LAUNDERED {
            if (false && gqa_fast_ok(Fq, lq)) { for (int q_ = 0; q_ < NREP(18); ++q_) for (int it = Fq.bid; it < 256; it += Fq.G) { const Frame Fi = launder(Fq); p4_attn_gqa<true>(Fi, lq, it); } }
            else { for (int q_ = 0; q_ < NREP(18); ++q_) for (int it = Fq.bid; it < 256; it += Fq.G) { const Frame Fi = launder(Fq); p4_attn_gqa<false>(Fi, lq, it); } }
            { unsigned* qctr = WSQ(unsigned, WS_CTL) + CW_Q0 + 64 * (3 + 2 * lq + rep_ * 8);
              for (;;) { const int idx = q_next(Fq, qctr); if (idx >= 2 * NCH + N_S5O + 4) break; const Frame Fi = launder(Fq);
                  if (idx < 2 * NCH) p4_ssd_out(Fi, lq, idx); else if (idx < 2 * NCH + N_S5O) p4_s5_out(Fi, lq, idx - 2 * NCH); else p4_attn_gqa<false>(Fi, lq, 256 + idx - 2 * NCH - N_S5O); } }
        }
        SEAM(ph); ++ph; DIAG_ACC(5);
        nrep_ = NREP(6); if (PHEN(6) && IN(ph)) LAUNDERED p5_finish(Fq, lq);
        SEAM(ph); ++ph; DIAG_ACC(6);
        nrep_ = NREP(7); if (PHEN(7) && IN(ph)) LAUNDERED { pg8::Gemm gm{WSQ(pg8::bf16_t, WS_MIX) + (size_t)CTX * DM, WSQ(pg8::bf16_t, WS_WOUT) + (size_t)lq * DM * DM, SEQ, DM, DM}; pg8::StaticOrder S; S.init(SEQ, DM, Fq.G, Fq.bid);
            EpiRes E; E.C = WSQ(float, WS_XA); E.g1 = WSQ(float, WS_MOD) + (size_t)lq * 2 * 6144 + 2 * 1024;
            if (lq == 0) { E.res_ctx = ((const float*)Fq.in[I_CTX]); E.res_lat = ((const float*)Fq.in[I_X]); } else { E.res_ctx = WSQ(float, WS_XB); E.res_lat = WSQ(float, WS_XB) + (size_t)CTX * DM; }
            pg8::gemm_phase<EpiRes, pg8::StaticOrder>((PG8_LAS unsigned char*)Fq.lds, gm, S, E);
            if (lq < DEPTH - 1) outproj_ctx(Fq, lq, E.res_ctx); }
        SEAM(ph); ++ph; DIAG_ACC(7);
        nrep_ = NREP(8); if (PHEN(8) && IN(ph)) LAUNDERED p7a_router(Fq, lq, rep_);
        SEAM(ph); ++ph; DIAG_ACC(8);
        nrep_ = NREP(10); if (PHEN(10) && IN(ph)) LAUNDERED { const int ntiles = moe_tables(Fq, lq); const LAS int* t2e = (const LAS int*)(Fq.lds + LDS_MISC) + 64;
            moe_rows(Fq, lq, ntiles, 8);
            pg8::Gemm gm{WSQ(pg8::bf16_t, WS_H), WSQ(pg8::bf16_t, WS_WGU) + (size_t)lq * NEXP * 2048 * DM, CAP, 2048, DM};
            MoeOrder S{8, ntiles, Fq.G, Fq.bid, t2e, (long)2048 * DM * 2};
            moe_bias(Fq, ntiles, 8, ((const float*)Fq.in[I_BGU]) + (size_t)lq * NEXP * 2048, 2048);
            EpiAct E{WSQ(bf16_t, WS_ACT), (const LAS float*)(Fq.lds + LDS_BIASL)};
            if (STAG_GU) xcd_stagger(Fq, STAG_GU);
            pg8::gemm_phase_gather<EpiAct, MoeOrder>((PG8_LAS unsigned char*)Fq.lds, gm, S, E, (const PG8_LAS int*)(Fq.lds + LDS_MISC + 2048)); }
        SEAM(ph); ++ph; DIAG_ACC(10);
        nrep_ = NREP(11); if (PHEN(11) && IN(ph)) LAUNDERED { const int ntiles = moe_tables(Fq, lq); const LAS int* t2e = (const LAS int*)(Fq.lds + LDS_MISC) + 64;
            pg8::Gemm gm{WSQ(pg8::bf16_t, WS_ACT), WSQ(pg8::bf16_t, WS_WDN) + (size_t)lq * NEXP * DM * DM, CAP, DM, DM};
            MoeOrder S{4, ntiles, Fq.G, Fq.bid, t2e, (long)DM * DM * 2};
            moe_bias(Fq, ntiles, 4, ((const float*)Fq.in[I_BDN]) + (size_t)lq * NEXP * DM, DM);
            EpiDown E{WSQ(bf16_t, WS_YB), (const LAS float*)(Fq.lds + LDS_BIASL), REP_SKIP_STORES * rep_, WSQ(bf16_t, WS_U)};
            if (STAG_DN) xcd_stagger(Fq, STAG_DN);
            pg8::gemm_phase<EpiDown, MoeOrder>((PG8_LAS unsigned char*)Fq.lds, gm, S, E); }
        SEAM(ph); ++ph; DIAG_ACC(11);
    }
    { l_cur = 2;
        nrep_ = NREP(1); if (PHEN(1) && IN(ph)) LAUNDERED p1_norm<false>(Fq, lq);
        SEAM(ph); ++ph; DIAG_ACC(1);
        nrep_ = NREP(2); if (PHEN(2) && IN(ph)) LAUNDERED { pg8::Gemm gm{WSQ(pg8::bf16_t, WS_H), WSQ(pg8::bf16_t, WS_WIN) + (size_t)lq * NU * DM, NT, NU, DM}; pg8::StaticOrder S; S.init(NT, NU, Fq.G, Fq.bid);
            EpiU E{WSQ(bf16_t, WS_U), NU, WSQ(bf16_t, WS_US5)}; pg8::gemm_phase<EpiU, pg8::StaticOrder>((PG8_LAS unsigned char*)Fq.lds, gm, S, E); }
        SEAM(ph); ++ph; DIAG_ACC(2);
        nrep_ = NREP(3); if (PHEN(3) && IN(ph)) LAUNDERED {
            unsigned* qctr = WSQ(unsigned, WS_CTL) + CW_Q0 + 64 * (2 + 2 * lq + rep_ * 8);
            for (;;) { const int idx = q_next(Fq, qctr); if (idx >= NCH + 260 + N_S5H) break; const Frame Fi = launder(Fq);
                if (idx < NCH) { for (int q_ = 0; q_ < NREP(21); ++q_) p3_ssd_prep(Fi, lq, idx); }
                else if (idx < NCH + 260) { for (int q_ = 0; q_ < NREP(22); ++q_) p3_attn_prep(Fi, lq, idx - NCH); }
                else { for (int q_ = 0; q_ < NREP(23); ++q_) p3_s5_hloc(Fi, lq, idx - NCH - 260); }
            }
        }
        SEAM(ph); ++ph; DIAG_ACC(3);
        nrep_ = NREP(4); if (PHEN(4) && IN(ph)) LAUNDERED { for (int q_ = 0; q_ < NREP(16); ++q_) p4_ssd_scan(Fq, lq);
            for (int q_ = 0; q_ < NREP(17); ++q_) for (int it = Fq.bid; it < 256; it += Fq.G) { const Frame Fi = launder(Fq); p4_attn_diff(Fi, lq, it); }
            unsigned* qctr = WSQ(unsigned, WS_CTL) + CW_Q0 + 64 * (10 + lq + rep_ * 8);
            for (;;) { const int idx = q_next(Fq, qctr); if (idx >= 4) break; const Frame Fi = launder(Fq);
                p4_attn_diff(Fi, lq, 256 + idx); } }
        SEAM(ph); ++ph; DIAG_ACC(4);
        nrep_ = NREP(5); if (PHEN(5) && IN(ph)) LAUNDERED {
            if (false && gqa_fast_ok(Fq, lq)) { for (int q_ = 0; q_ < NREP(18); ++q_) for (int it = Fq.bid; it < 256; it += Fq.G) { const Frame Fi = launder(Fq); p4_attn_gqa<true>(Fi, lq, it); } }
            else { for (int q_ = 0; q_ < NREP(18); ++q_) for (int it = Fq.bid; it < 256; it += Fq.G) { const Frame Fi = launder(Fq); p4_attn_gqa<false>(Fi, lq, it); } }
            { unsigned* qctr = WSQ(unsigned, WS_CTL) + CW_Q0 + 64 * (3 + 2 * lq + rep_ * 8);
              for (;;) { const int idx = q_next(Fq, qctr); if (idx >= 2 * NCH + N_S5O + 4) break; const Frame Fi = launder(Fq);
                  if (idx < 2 * NCH) p4_ssd_out(Fi, lq, idx); else if (idx < 2 * NCH + N_S5O) p4_s5_out(Fi, lq, idx - 2 * NCH); else p4_attn_gqa<false>(Fi, lq, 256 + idx - 2 * NCH - N_S5O); } }
        }
        SEAM(ph); ++ph; DIAG_ACC(5);
        nrep_ = NREP(6); if (PHEN(6) && IN(ph)) LAUNDERED p5_finish(Fq, lq);
        SEAM(ph); ++ph; DIAG_ACC(6);
        nrep_ = NREP(7); if (PHEN(7) && IN(ph)) LAUNDERED { pg8::Gemm gm{WSQ(pg8::bf16_t, WS_MIX) + (size_t)CTX * DM, WSQ(pg8::bf16_t, WS_WOUT) + (size_t)lq * DM * DM, SEQ, DM, DM}; pg8::StaticOrder S; S.init(SEQ, DM, Fq.G, Fq.bid);
            EpiRes E; E.C = WSQ(float, WS_XA); E.g1 = WSQ(float, WS_MOD) + (size_t)lq * 2 * 6144 + 2 * 1024;
            if (lq == 0) { E.res_ctx = ((const float*)Fq.in[I_CTX]); E.res_lat = ((const float*)Fq.in[I_X]); } else { E.res_ctx = WSQ(float, WS_XB); E.res_lat = WSQ(float, WS_XB) + (size_t)CTX * DM; }
            pg8::gemm_phase<EpiRes, pg8::StaticOrder>((PG8_LAS unsigned char*)Fq.lds, gm, S, E);
            if (lq < DEPTH - 1) outproj_ctx(Fq, lq, E.res_ctx); }
        SEAM(ph); ++ph; DIAG_ACC(7);
        nrep_ = NREP(8); if (PHEN(8) && IN(ph)) LAUNDERED p7a_router(Fq, lq, rep_);
        SEAM(ph); ++ph; DIAG_ACC(8);
        nrep_ = NREP(10); if (PHEN(10) && IN(ph)) LAUNDERED { const int ntiles = moe_tables(Fq, lq); const LAS int* t2e = (const LAS int*)(Fq.lds + LDS_MISC) + 64;
            moe_rows(Fq, lq, ntiles, 8);
            pg8::Gemm gm{WSQ(pg8::bf16_t, WS_H), WSQ(pg8::bf16_t, WS_WGU) + (size_t)lq * NEXP * 2048 * DM, CAP, 2048, DM};
            MoeOrder S{8, ntiles, Fq.G, Fq.bid, t2e, (long)2048 * DM * 2};
            moe_bias(Fq, ntiles, 8, ((const float*)Fq.in[I_BGU]) + (size_t)lq * NEXP * 2048, 2048);
            EpiAct E{WSQ(bf16_t, WS_ACT), (const LAS float*)(Fq.lds + LDS_BIASL)};
            if (STAG_GU) xcd_stagger(Fq, STAG_GU);
            pg8::gemm_phase_gather<EpiAct, MoeOrder>((PG8_LAS unsigned char*)Fq.lds, gm, S, E, (const PG8_LAS int*)(Fq.lds + LDS_MISC + 2048)); }
        SEAM(ph); ++ph; DIAG_ACC(10);
        nrep_ = NREP(11); if (PHEN(11) && IN(ph)) LAUNDERED { const int ntiles = moe_tables(Fq, lq); const LAS int* t2e = (const LAS int*)(Fq.lds + LDS_MISC) + 64;
            pg8::Gemm gm{WSQ(pg8::bf16_t, WS_ACT), WSQ(pg8::bf16_t, WS_WDN) + (size_t)lq * NEXP * DM * DM, CAP, DM, DM};
            MoeOrder S{4, ntiles, Fq.G, Fq.bid, t2e, (long)DM * DM * 2};
            moe_bias(Fq, ntiles, 4, ((const float*)Fq.in[I_BDN]) + (size_t)lq * NEXP * DM, DM);
            EpiDown E{WSQ(bf16_t, WS_YB), (const LAS float*)(Fq.lds + LDS_BIASL), REP_SKIP_STORES * rep_, WSQ(bf16_t, WS_U)};
            if (STAG_DN) xcd_stagger(Fq, STAG_DN);
            pg8::gemm_phase<EpiDown, MoeOrder>((PG8_LAS unsigned char*)Fq.lds, gm, S, E); }
        SEAM(ph); ++ph; DIAG_ACC(11);
    }
    { l_cur = 3;
        nrep_ = NREP(1); if (PHEN(1) && IN(ph)) LAUNDERED p1_norm<false>(Fq, lq);
        SEAM(ph); ++ph; DIAG_ACC(1);
        nrep_ = NREP(2); if (PHEN(2) && IN(ph)) LAUNDERED { pg8::Gemm gm{WSQ(pg8::bf16_t, WS_H), WSQ(pg8::bf16_t, WS_WIN) + (size_t)lq * NU * DM, NT, NU, DM}; pg8::StaticOrder S; S.init(NT, NU, Fq.G, Fq.bid);
            EpiU E{WSQ(bf16_t, WS_U), NU, WSQ(bf16_t, WS_US5)}; pg8::gemm_phase<EpiU, pg8::StaticOrder>((PG8_LAS unsigned char*)Fq.lds, gm, S, E); }
        SEAM(ph); ++ph; DIAG_ACC(2);
        nrep_ = NREP(3); if (PHEN(3) && IN(ph)) LAUNDERED {
            unsigned* qctr = WSQ(unsigned, WS_CTL) + CW_Q0 + 64 * (2 + 2 * lq + rep_ * 8);
            for (;;) { const int idx = q_next(Fq, qctr); if (idx >= NCH + 260 + N_S5H) break; const Frame Fi = launder(Fq);
                if (idx < NCH) { for (int q_ = 0; q_ < NREP(21); ++q_) p3_ssd_prep(Fi, lq, idx); }
                else if (idx < NCH + 260) { for (int q_ = 0; q_ < NREP(22); ++q_) p3_attn_prep(Fi, lq, idx - NCH); }
                else { for (int q_ = 0; q_ < NREP(23); ++q_) p3_s5_hloc(Fi, lq, idx - NCH - 260); }
            }
        }
        SEAM(ph); ++ph; DIAG_ACC(3);
        nrep_ = NREP(4); if (PHEN(4) && IN(ph)) LAUNDERED { for (int q_ = 0; q_ < NREP(16); ++q_) p4_ssd_scan(Fq, lq);
            for (int q_ = 0; q_ < NREP(17); ++q_) for (int it = Fq.bid; it < 256; it += Fq.G) { const Frame Fi = launder(Fq); p4_attn_diff(Fi, lq, it); }
            unsigned* qctr = WSQ(unsigned, WS_CTL) + CW_Q0 + 64 * (10 + lq + rep_ * 8);
            for (;;) { const int idx = q_next(Fq, qctr); if (idx >= 4) break; const Frame Fi = launder(Fq);
                p4_attn_diff(Fi, lq, 256 + idx); } }
        SEAM(ph); ++ph; DIAG_ACC(4);
        nrep_ = NREP(5); if (PHEN(5) && IN(ph)) LAUNDERED {
            if (false && gqa_fast_ok(Fq, lq)) { for (int q_ = 0; q_ < NREP(18); ++q_) for (int it = Fq.bid; it < 256; it += Fq.G) { const Frame Fi = launder(Fq); p4_attn_gqa<true>(Fi, lq, it); } }
            else { for (int q_ = 0; q_ < NREP(18); ++q_) for (int it = Fq.bid; it < 256; it += Fq.G) { const Frame Fi = launder(Fq); p4_attn_gqa<false>(Fi, lq, it); } }
            { unsigned* qctr = WSQ(unsigned, WS_CTL) + CW_Q0 + 64 * (3 + 2 * lq + rep_ * 8);
              for (;;) { const int idx = q_next(Fq, qctr); if (idx >= 2 * NCH + N_S5O + 4) break; const Frame Fi = launder(Fq);
                  if (idx < 2 * NCH) p4_ssd_out(Fi, lq, idx); else if (idx < 2 * NCH + N_S5O) p4_s5_out(Fi, lq, idx - 2 * NCH); else p4_attn_gqa<false>(Fi, lq, 256 + idx - 2 * NCH - N_S5O); } }
        }
        SEAM(ph); ++ph; DIAG_ACC(5);
        nrep_ = NREP(6); if (PHEN(6) && IN(ph)) LAUNDERED p5_finish(Fq, lq);
        SEAM(ph); ++ph; DIAG_ACC(6);
        nrep_ = NREP(7); if (PHEN(7) && IN(ph)) LAUNDERED { pg8::Gemm gm{WSQ(pg8::bf16_t, WS_MIX) + (size_t)CTX * DM, WSQ(pg8::bf16_t, WS_WOUT) + (size_t)lq * DM * DM, SEQ, DM, DM}; pg8::StaticOrder S; S.init(SEQ, DM, Fq.G, Fq.bid);
            EpiRes E; E.C = WSQ(float, WS_XA); E.g1 = WSQ(float, WS_MOD) + (size_t)lq * 2 * 6144 + 2 * 1024;
            if (lq == 0) { E.res_ctx = ((const float*)Fq.in[I_CTX]); E.res_lat = ((const float*)Fq.in[I_X]); } else { E.res_ctx = WSQ(float, WS_XB); E.res_lat = WSQ(float, WS_XB) + (size_t)CTX * DM; }
            pg8::gemm_phase<EpiRes, pg8::StaticOrder>((PG8_LAS unsigned char*)Fq.lds, gm, S, E);
            if (lq < DEPTH - 1) outproj_ctx(Fq, lq, E.res_ctx); }
        SEAM(ph); ++ph; DIAG_ACC(7);
        nrep_ = NREP(8); if (PHEN(8) && IN(ph)) LAUNDERED p7a_router(Fq, lq, rep_);
        SEAM(ph); ++ph; DIAG_ACC(8);
        nrep_ = NREP(10); if (PHEN(10) && IN(ph)) LAUNDERED { const int ntiles = moe_tables(Fq, lq); const LAS int* t2e = (const LAS int*)(Fq.lds + LDS_MISC) + 64;
            moe_rows(Fq, lq, ntiles, 8);
            pg8::Gemm gm{WSQ(pg8::bf16_t, WS_H), WSQ(pg8::bf16_t, WS_WGU) + (size_t)lq * NEXP * 2048 * DM, CAP, 2048, DM};
            MoeOrder S{8, ntiles, Fq.G, Fq.bid, t2e, (long)2048 * DM * 2};
            moe_bias(Fq, ntiles, 8, ((const float*)Fq.in[I_BGU]) + (size_t)lq * NEXP * 2048, 2048);
            EpiAct E{WSQ(bf16_t, WS_ACT), (const LAS float*)(Fq.lds + LDS_BIASL)};
            if (STAG_GU) xcd_stagger(Fq, STAG_GU);
            pg8::gemm_phase_gather<EpiAct, MoeOrder>((PG8_LAS unsigned char*)Fq.lds, gm, S, E, (const PG8_LAS int*)(Fq.lds + LDS_MISC + 2048)); }
        SEAM(ph); ++ph; DIAG_ACC(10);
        nrep_ = NREP(11); if (PHEN(11) && IN(ph)) LAUNDERED { const int ntiles = moe_tables(Fq, lq); const LAS int* t2e = (const LAS int*)(Fq.lds + LDS_MISC) + 64;
            pg8::Gemm gm{WSQ(pg8::bf16_t, WS_ACT), WSQ(pg8::bf16_t, WS_WDN) + (size_t)lq * NEXP * DM * DM, CAP, DM, DM};
            MoeOrder S{4, ntiles, Fq.G, Fq.bid, t2e, (long)DM * DM * 2};
            moe_bias(Fq, ntiles, 4, ((const float*)Fq.in[I_BDN]) + (size_t)lq * NEXP * DM, DM);
            EpiDown E{WSQ(bf16_t, WS_YB), (const LAS float*)(Fq.lds + LDS_BIASL), REP_SKIP_STORES * rep_, WSQ(bf16_t, WS_U)};
            if (STAG_DN) xcd_stagger(Fq, STAG_DN);
            pg8::gemm_phase<EpiDown, MoeOrder>((PG8_LAS unsigned char*)Fq.lds, gm, S, E); }
        SEAM(ph); ++ph; DIAG_ACC(11);
    }
#if DIAG
    if (blockIdx.x == 0 && threadIdx.x < 16) __hip_atomic_store((unsigned*)(F.ws + WS_CTL) + 5000 + threadIdx.x, dg[threadIdx.x], __ATOMIC_RELAXED, __HIP_MEMORY_SCOPE_AGENT);
    xcd_barrier(bar);
    { const unsigned* dgw = (const unsigned*)(F.ws + WS_CTL) + 5000;
      const float ta = (float)__hip_atomic_load(dgw + DIAG_A, __ATOMIC_RELAXED, __HIP_MEMORY_SCOPE_AGENT) * 0.01f;
      const float cval = sqrtf(ta * (1.f / DIAG_DIV));
      for (size_t i = (size_t)blockIdx.x * 512 + threadIdx.x; i < (size_t)SEQ * DM; i += (size_t)gridDim.x * 512) F.out[i] = cval; }
#else
    nrep_ = NREP(12); if (PHEN(12) && IN(ph)) LAUNDERED { (void)lq; p1_norm<true>(Fq, DEPTH); }
#endif
#undef IN
#undef SEAM
}

#ifndef N_LAUNCH_MODE
#define N_LAUNCH_MODE 1
#endif
extern "C" void kernel_launch(void* const* d_in, const int* in_sizes, int n_in, void* d_out, int out_size, void* d_ws, size_t ws_size, hipStream_t stream) {
    static int grid = 0;
    if (grid == 0) {
        if (n_in != N_IN || out_size != SEQ * DM || ws_size < WS_END) { fprintf(stderr, "kernel_launch: unexpected shapes (n_in %d, out %d, ws %zu < %zu)\n", n_in, out_size, ws_size, (size_t)WS_END); grid = -1; return; }
        int dev = 0, cus = 0, per_cu = 0;
        if (hipGetDevice(&dev) != hipSuccess || hipDeviceGetAttribute(&cus, hipDeviceAttributeMultiprocessorCount, dev) != hipSuccess) { grid = -1; return; }
        if (hipFuncSetAttribute((const void*)hybrid_fwd, hipFuncAttributeMaxDynamicSharedMemorySize, LDS_BYTES) != hipSuccess) { fprintf(stderr, "kernel_launch: hipFuncSetAttribute failed\n"); grid = -1; return; }
        if (hipOccupancyMaxActiveBlocksPerMultiprocessor(&per_cu, (const void*)hybrid_fwd, 512, LDS_BYTES) != hipSuccess || per_cu < 1) { fprintf(stderr, "kernel_launch: occupancy query says %d\n", per_cu); }
        (void)hipGetLastError();
        grid = cus;
    }
    if (grid < 0) return;
    (void)hipMemsetAsync((char*)d_ws + WS_CTL, 0, CTL_BYTES, stream);
    Args a{};
    for (int i = 0; i < N_IN; ++i) a.in[i] = (const float*)d_in[i];
    a.out = (float*)d_out; a.ws = (unsigned char*)d_ws;
#if N_LAUNCH_MODE == 1
    a.ph_lo = 0; a.ph_hi = N_PHASES;
    hipLaunchKernelGGL(hybrid_fwd, dim3(grid), dim3(512), LDS_BYTES, stream, a);
#else
    for (int p = 0; p < N_PHASES; ++p) { a.ph_lo = p; a.ph_hi = p + 1; hipLaunchKernelGGL(hybrid_fwd, dim3(grid), dim3(512), LDS_BYTES, stream, a); }
#endif
}
```

```cpp
#include <hip/hip_runtime.h>
#include <cstdio>
#include <cstdint>

#define DI __device__ __forceinline__
typedef float f32x2 __attribute__((ext_vector_type(2)));
typedef float f32x16 __attribute__((ext_vector_type(16)));
typedef unsigned u32x2 __attribute__((ext_vector_type(2)));
typedef __bf16 hbf2 __attribute__((ext_vector_type(2)));

constexpr int DM = 1024, SEQ = 16384, CTX = 256, NT = SEQ + CTX, DEPTH = 4;
constexpr int DIN = 2568, NU = 2560;
constexpr int DT_COL = 1792;
constexpr int NEXP = 32, TOPK = 4;
constexpr int CAP = 292 * 256;
constexpr float EPS = 1e-6f;
constexpr float LOG2E = 1.4426950408889634f;
constexpr int NCH = NT / 128;
constexpr int S5L = 64, NC5 = NT / S5L;
constexpr int U_DQ = 0, U_DK = 256, U_DV = 512, U_Z = 768, U_XS = 1024, U_B = 1280, U_C = 1536, U_S5 = 1792, U_GQ = 2048, U_GK = 2304, U_GV = 2432;

enum { I_X = 0, I_C, I_CTX, I_CCTX, I_WADA, I_BADA, I_N1W, I_N2W, I_WIN, I_WOUT, I_LQ1, I_LK1, I_LQ2, I_LK2, I_SUBLN,
       I_CONVW, I_CONVB, I_DTB, I_ALOG, I_SSDD, I_SSDNW, I_LAMRE, I_LAMIM, I_LOGDT, I_BRE, I_BIM, I_CRE, I_CIM, I_S5D, I_WGLU, I_BGLU,
       I_QNW, I_KNW, I_WR, I_BR, I_WGU, I_BGU, I_WDN, I_BDN, I_FNW, N_IN };

constexpr size_t al256(size_t x) { return (x + 255) & ~(size_t)255; }
constexpr size_t WS_CTL   = 0;
constexpr size_t CTL_BYTES = 65536;
constexpr int CW_BAR = 0;
constexpr int CW_KMAX = 4096;
constexpr int CW_CNT = 4096 + 128;
constexpr int CW_Q0 = 4096 + 128 + 128;
constexpr size_t WS_MOD   = WS_CTL + CTL_BYTES;
constexpr size_t WS_ROPE  = al256(WS_MOD + (size_t)DEPTH * 2 * 6144 * 4);
constexpr size_t WS_LAM   = al256(WS_ROPE + 256 * 8 * 8 + 256 * 16 * 8);
constexpr size_t WS_WIN   = al256(WS_LAM + 256);
constexpr size_t WS_WOUT  = al256(WS_WIN + (size_t)DEPTH * NU * DM * 2);
constexpr size_t WS_WGU   = al256(WS_WOUT + (size_t)DEPTH * DM * DM * 2);
constexpr size_t WS_WDN   = al256(WS_WGU + (size_t)DEPTH * NEXP * 2048 * DM * 2);
constexpr size_t WS_WGLU  = al256(WS_WDN + (size_t)DEPTH * NEXP * DM * DM * 2);
constexpr size_t WS_KTAB  = al256(WS_WGLU + (size_t)DEPTH * 256 * 256 * 2);
constexpr size_t WS_CC5   = al256(WS_KTAB + (size_t)DEPTH * 16 * 3 * 64 * 256 * 2);
constexpr size_t WS_E5    = al256(WS_CC5 + (size_t)DEPTH * 16 * 1024 * 256 * 2);
constexpr size_t WS_APOW  = al256(WS_E5 + (size_t)DEPTH * 16 * 2 * 128 * 1024 * 2);
constexpr size_t WS_XA    = al256(WS_APOW + (size_t)DEPTH * 16 * 2 * 64 * 8);
constexpr size_t WS_XB    = al256(WS_XA + (size_t)NT * DM * 4);
constexpr size_t WS_H     = al256(WS_XB + (size_t)NT * DM * 4);
constexpr size_t WS_U     = al256(WS_H + (size_t)NT * DM * 2);
constexpr size_t WS_DTRAW = al256(WS_U + (size_t)NT * NU * 2);
constexpr size_t WS_QD    = al256(WS_DTRAW + (size_t)NT * 8 * 4);
constexpr size_t WS_KD    = al256(WS_QD + (size_t)4 * NT * 64 * 2);
constexpr size_t WS_VTD   = al256(WS_KD + (size_t)4 * NT * 64 * 2);
constexpr size_t WS_QG    = al256(WS_VTD + (size_t)4 * NT * 64 * 2);
constexpr size_t WS_KG    = al256(WS_QG + (size_t)4 * NT * 64 * 2);
constexpr size_t WS_VTG   = al256(WS_KG + (size_t)2 * NT * 64 * 2);
constexpr size_t WS_QND   = al256(WS_VTG + (size_t)2 * NT * 64 * 2);
constexpr size_t WS_QNG   = al256(WS_QND + (size_t)8 * NT * 4);
constexpr size_t WS_XST   = al256(WS_QNG + (size_t)4 * NT * 4);
constexpr size_t WS_BN    = al256(WS_XST + (size_t)NT * 256 * 2);
constexpr size_t WS_CN    = al256(WS_BN + (size_t)NT * 256 * 2);
constexpr size_t WS_DTV   = al256(WS_CN + (size_t)NT * 256 * 2);
constexpr size_t WS_CUM   = al256(WS_DTV + (size_t)NT * 8 * 4);
constexpr size_t WS_SLOC  = al256(WS_CUM + (size_t)NT * 8 * 4);
constexpr size_t WS_SIN   = al256(WS_SLOC + (size_t)NCH * 8 * 64 * 128 * 4);
constexpr size_t WS_YSSD  = al256(WS_SIN + (size_t)NCH * 8 * 64 * 128 * 2);
constexpr size_t WS_SSQ   = al256(WS_YSSD + (size_t)NT * 256 * 2);
constexpr size_t WS_HLOC  = al256(WS_SSQ + (size_t)NT * 4 * 4);
constexpr size_t WS_HIN   = al256(WS_HLOC + (size_t)NC5 * 4096 * 4);
constexpr size_t WS_YS5   = al256(WS_HIN + (size_t)NC5 * 4096 * 2);
constexpr size_t WS_US5   = al256(WS_YS5 + (size_t)NT * 256 * 2);
constexpr size_t WS_MIX   = al256(WS_US5 + (size_t)NT * 256 * 2);
constexpr size_t WS_TOPE  = al256(WS_MIX + (size_t)NT * DM * 2);
constexpr size_t WS_TOPP  = al256(WS_TOPE + (size_t)NT * 16);
constexpr size_t WS_TOPG  = al256(WS_TOPP + (size_t)NT * 16);
constexpr size_t WS_TOPS  = al256(WS_TOPG + (size_t)NT * 16);
constexpr size_t WS_ASLOT = al256(WS_TOPS + (size_t)NEXP * NT * 4);
constexpr size_t WS_ACT   = al256(WS_ASLOT + (size_t)CAP * DM * 2);
constexpr size_t WS_YB    = al256(WS_ACT + (size_t)CAP * DM * 2);
constexpr size_t WS_END   = al256(WS_YB + (size_t)CAP * DM * 2);

constexpr int LDS_BYTES = 160 * 1024;
constexpr int LDS_MISC = 128 * 1024;
#define LAS __attribute__((address_space(3)))
#define GAS __attribute__((address_space(1)))

struct Args { const float* in[N_IN]; float* out; unsigned char* ws; int ph_lo, ph_hi; };

typedef unsigned short bf16_t;
typedef short bf16x8 __attribute__((ext_vector_type(8)));
typedef float f32x4 __attribute__((ext_vector_type(4)));
typedef unsigned u32x4 __attribute__((ext_vector_type(4)));

DI unsigned pk2(float lo, float hi) { f32x2 v = {lo, hi}; hbf2 b = __builtin_convertvector(v, hbf2); return __builtin_bit_cast(unsigned, b); }
DI bf16_t f2bf(float f) { return (bf16_t)(pk2(f, 0.f) & 0xffffu); }
DI float bf2f(bf16_t b) { return __uint_as_float(((unsigned)b) << 16); }
DI float bflo(unsigned u) { return __uint_as_float(u << 16); }
DI float bfhi(unsigned u) { return __uint_as_float(u & 0xffff0000u); }
DI f32x16 mfma32(bf16x8 a, bf16x8 b, f32x16 c) { return __builtin_amdgcn_mfma_f32_32x32x16_bf16(a, b, c, 0, 0, 0); }
DI int kperm(int m) { return (m & 0x13) | ((m & 4) << 1) | ((m & 8) >> 1); }
DI int crow(int i, int h) { return (i & 3) + 8 * (i >> 2) + 4 * h; }
DI bf16x8 ld8g(const bf16_t* p) { return *(const bf16x8*)p; }
template <int CTRL> DI float dppf(float v) { return __builtin_bit_cast(float, __builtin_amdgcn_update_dpp(0, __builtin_bit_cast(int, v), CTRL, 0xF, 0xF, true)); }
DI float rlane(float v, int l) { return __builtin_bit_cast(float, __builtin_amdgcn_readlane(__builtin_bit_cast(int, v), l)); }
DI float wave_sum(float v) {
    v += dppf<0xB1>(v); v += dppf<0x4E>(v); v += dppf<0x141>(v); v += dppf<0x140>(v);
    return (rlane(v, 0) + rlane(v, 16)) + (rlane(v, 32) + rlane(v, 48));
}
DI float wave_max(float v) {
    v = fmaxf(v, dppf<0xB1>(v)); v = fmaxf(v, dppf<0x4E>(v)); v = fmaxf(v, dppf<0x141>(v)); v = fmaxf(v, dppf<0x140>(v));
    return fmaxf(fmaxf(rlane(v, 0), rlane(v, 16)), fmaxf(rlane(v, 32), rlane(v, 48)));
}
DI float silu_f(float x) { return x * __builtin_amdgcn_rcpf(1.f + __builtin_amdgcn_exp2f(-1.4426950408889634f * x)); }
DI float sigmoid_f(float x) { return __builtin_amdgcn_rcpf(1.f + __builtin_amdgcn_exp2f(-1.4426950408889634f * x)); }
template <int S> DI bf16x8 pack_step(const f32x16& x) {
    u32x4 p;
    p[0] = pk2(x[8 * S + 0], x[8 * S + 1]); p[1] = pk2(x[8 * S + 2], x[8 * S + 3]);
    p[2] = pk2(x[8 * S + 4], x[8 * S + 5]); p[3] = pk2(x[8 * S + 6], x[8 * S + 7]);
    return __builtin_bit_cast(bf16x8, p);
}
DI f32x16 splat16(float v) { f32x16 r;
#pragma unroll
    for (int i = 0; i < 16; ++i) r[i] = v; return r; }
#define XB_TMO      128
#define XB_XCNT(j)  (256  + 64 * (j))
#define XB_XSUB(j)  (1280 + 64 * (j))
#define XB_XGEN(j)  (2304 + 64 * (j))
#define XB_TOP      3328
#define XB_TOPGEN   3392
#define XCD_BAR_WORDS 3456
#define XB_SPIN_CAP (1u << 18)
#define LAS __attribute__((address_space(3)))

__device__ __forceinline__ unsigned xb_ld(unsigned* p)              { return __hip_atomic_load(p, __ATOMIC_RELAXED, __HIP_MEMORY_SCOPE_AGENT); }
__device__ __forceinline__ unsigned xb_add(unsigned* p, unsigned v) { return __hip_atomic_fetch_add(p, v, __ATOMIC_RELAXED, __HIP_MEMORY_SCOPE_AGENT); }
__device__ __forceinline__ unsigned xb_xcc_id() { return (unsigned)__builtin_amdgcn_s_getreg((3 << 11) | 20) & 0xFu; }
#define XB_SPIN(cond, bar) do { unsigned _sp = 0; while (cond) { __builtin_amdgcn_s_sleep(1); \
    if ((++_sp & 255u) == 0u) { if (xb_ld(&(bar)[XB_TMO])) break; if (_sp > XB_SPIN_CAP) { atomicAdd(&(bar)[XB_TMO], 1u); break; } } } } while (0)

struct XcdBarrier {
    unsigned* bar; unsigned x;
    volatile LAS unsigned* st;
};

__device__ __forceinline__ XcdBarrier xcd_barrier_post(unsigned* bar, volatile LAS unsigned* st) {
    XcdBarrier b; b.bar = bar; b.x = xb_xcc_id(); b.st = st;
    if (threadIdx.x == 0) (void)xb_add(&bar[XB_XCNT(b.x)], 1u);
    return b;
}
__device__ __forceinline__ void xcd_barrier_complete(unsigned* bar, unsigned x, unsigned& nloc, unsigned& nx) {
    const unsigned G = gridDim.x * gridDim.y * gridDim.z;
    unsigned sum, cnt, mine, sp = 0u;
    for (;;) {
        sum = 0u; cnt = 0u; mine = 0u;
#pragma unroll
        for (unsigned j = 0; j < 16; ++j) { const unsigned c = xb_ld(&bar[XB_XCNT(j)]); sum += c; cnt += (c > 0u) ? 1u : 0u; mine = (j == x) ? c : mine; }
        if (sum == G) break;
        __builtin_amdgcn_s_sleep(1);
        if ((++sp & 255u) == 0u) { if (xb_ld(&bar[XB_TMO])) break; if (sp > XB_SPIN_CAP) { atomicAdd(&bar[XB_TMO], 1u); break; } }
    }
    nloc = mine > 0u ? mine : 1u; nx = cnt > 0u ? cnt : 1u;
}

__device__ __forceinline__ void xcd_barrier(const XcdBarrier& b) {
    asm volatile("s_waitcnt vmcnt(0)" ::: "memory");
    __syncthreads();
    if (threadIdx.x == 0) {
        unsigned* bar = b.bar;
        __builtin_amdgcn_s_waitcnt(0);
        unsigned nloc = b.st[0], nx = b.st[1];
        if (nloc == 0u) { xcd_barrier_complete(bar, b.x, nloc, nx); b.st[0] = nloc; b.st[1] = nx; }
        const unsigned old = xb_add(&bar[XB_XSUB(b.x)], 1u);
        const unsigned gen = old / nloc;
        if (old + 1u == (gen + 1u) * nloc) {
            __builtin_amdgcn_fence(__ATOMIC_RELEASE, "agent");
            asm volatile("s_waitcnt vmcnt(0)" ::: "memory");
            const unsigned og = xb_add(&bar[XB_TOP], 1u);
            const unsigned tg = og / nx;
            if (og + 1u == (tg + 1u) * nx) xb_add(&bar[XB_TOPGEN], 1u);
            else XB_SPIN(xb_ld(&bar[XB_TOPGEN]) == tg, bar);
            __builtin_amdgcn_fence(__ATOMIC_ACQUIRE, "agent");
            xb_add(&bar[XB_XGEN(b.x)], 1u);
            asm volatile("s_waitcnt vmcnt(0)" ::: "memory");
        } else {
            XB_SPIN(xb_ld(&bar[XB_XGEN(b.x)]) == gen, bar);
            __builtin_amdgcn_fence(__ATOMIC_ACQUIRE, "agent");
            asm volatile("s_waitcnt vmcnt(0)" ::: "memory");
        }
    }
    __syncthreads();
}
namespace pg8 {
#define PG8_LAS __attribute__((address_space(3)))
typedef unsigned short bf16_t;
typedef short bf16x8 __attribute__((ext_vector_type(8)));
typedef float f32x4 __attribute__((ext_vector_type(4)));
typedef unsigned u32x4 __attribute__((ext_vector_type(4)));
constexpr int BM = 256, BK = 64, HALF = 128, HTB = HALF * BK * 2  , STAGE_BYTES = 8 * HTB, NXCD = 8, WGM = 8;

__host__ __device__ __forceinline__ int lds_byte(int r, int c) { const int st = (r >> 4) * 2 + (c >> 5), rr = r & 15, cc = c & 31, ob = rr * 64 + cc * 2; return st * 1024 + (ob ^ (((ob >> 9) & 1) << 5)); }
__host__ __device__ __forceinline__ void stage_rc(int b, int& R, int& C) { const int st = b / 1024, sb = b % 1024, swz = sb ^ (((sb >> 9) & 1) << 5); R = (st >> 1) * 16 + swz / 64; C = (st & 1) * 32 + (swz % 64) / 2; }
__host__ __device__ __forceinline__ int perm32(int rho) { const int n = rho >> 4, i = rho & 15; return 8 * (i >> 2) + 4 * n + (i & 3); }

struct Unit { int pm, pn; long boff; };
struct Gemm { const bf16_t* A; const bf16_t* Bt; int M, N, K; };

struct StaticOrder {
    int nM, nN, nwg, G, c;
    __host__ __device__ void init(int M, int N, int G_, int c_) { nM = M / BM; nN = N / BM; nwg = nM * nN; G = G_; c = c_; }
    __host__ __device__ bool next(int i, Unit& u) const {
        const long L = (long)i * G + c; if (L >= nwg) return false;
        int wgid = (int)L; { const int q = nwg / NXCD, r = nwg % NXCD, xcd = wgid % NXCD, off = wgid / NXCD; wgid = (xcd < r ? xcd * (q + 1) : r * (q + 1) + (xcd - r) * q) + off; }
        const int nig = WGM * nN, gid = wgid / nig, fm = gid * WGM, gsz = (nM - fm) < WGM ? (nM - fm) : WGM;
        u.pm = fm + ((wgid % nig) % gsz); u.pn = (wgid % nig) / gsz; u.boff = 0; return true;
    }
    __device__ __forceinline__ void a_ready(const Unit&) const {}
    __device__ __forceinline__ void done(const Unit&) const {}
};
__device__ __forceinline__ unsigned cvt_pk_bf16(float lo, float hi) { unsigned r; asm volatile("v_cvt_pk_bf16_f32 %0, %1, %2" : "=v"(r) : "v"(lo), "v"(hi)); return r; }
template <class Epi, class Sched, bool STAMP = false>
__device__ __forceinline__ void gemm_phase(PG8_LAS unsigned char* lds, const Gemm g, const Sched& S, const Epi& E, unsigned long long* stamps = nullptr) {
    int tid_l = threadIdx.x; asm volatile("" : "+v"(tid_l)); const int tid = tid_l, wid = __builtin_amdgcn_readfirstlane(tid >> 6), lane = tid & 63, wr = wid >> 2, wc = wid & 3, fr = lane & 15, fq = lane >> 4;
    const int K = g.K, nt = K / BK;
    int ts_lo = 0, ts_hi = 0, nts = 0; const unsigned long long rt_entry = STAMP ? (unsigned long long)wall_clock64() : 0ull;
#define PG8_STAMP() do { if (STAMP && wid == 0 && nts < 64) { const unsigned long long _c = (unsigned long long)clock64(); \
        ts_lo = (lane == nts) ? (int)(unsigned)_c : ts_lo; ts_hi = (lane == nts) ? (int)(unsigned)(_c >> 32) : ts_hi; ++nts; } } while (0)
    PG8_STAMP();
    unsigned voffA[2], voffB[2];
#pragma unroll
    for (int i = 0; i < 2; ++i) { int R, C; stage_rc(tid * 16 + i * 8192, R, C); const int Rb = Epi::PERM ? ((R & ~31) + perm32(R & 31)) : R;
        voffA[i] = (unsigned)(R * K + C) * 2u; voffB[i] = (unsigned)(Rb * K + C) * 2u; }
    const size_t kstep = (size_t)(BK * 2);
    const size_t hstep = (size_t)HALF * K * 2;
    const size_t tstep = 2 * hstep;
    const unsigned ldsw = (unsigned)wid * 1024u;
    const int aoff = lds_byte(wr * 64 + fr, fq * 8), boff = lds_byte(wc * 32 + fr, fq * 8);
#define PG8_SA(b, h) (((b) * 2 + (h)) * HTB)
#define PG8_SB(b, h) ((4 + (b) * 2 + (h)) * HTB)
#define PG8_STAGE(bufoff, gbase, voff) do { _Pragma("unroll") for (int _i = 0; _i < 2; ++_i) \
        __builtin_amdgcn_global_load_lds((const unsigned*)((const char*)(gbase) + (voff)[_i]), (PG8_LAS unsigned*)(lds + (bufoff) + ldsw + _i * 8192), 16, 0, 0); } while (0)
#define PG8_LDA(dst, b, h) do { _Pragma("unroll") for (int m = 0; m < 4; ++m) _Pragma("unroll") for (int k = 0; k < 2; ++k) dst[m][k] = *(const PG8_LAS bf16x8*)(lds + PG8_SA(b, h) + aoff + m * 2048 + k * 1024); } while (0)
#define PG8_LDB(dst, b, h) do { _Pragma("unroll") for (int n = 0; n < 2; ++n) _Pragma("unroll") for (int k = 0; k < 2; ++k) dst[n][k] = *(const PG8_LAS bf16x8*)(lds + PG8_SB(b, h) + boff + n * 2048 + k * 1024); } while (0)
#define PG8_MMA(ai, bj, At, Bt) do { __builtin_amdgcn_s_setprio(1); _Pragma("unroll") for (int m = 0; m < 4; ++m) _Pragma("unroll") for (int n = 0; n < 2; ++n) _Pragma("unroll") for (int k = 0; k < 2; ++k) \
        acc[ai][bj][m][n] = __builtin_amdgcn_mfma_f32_16x16x32_bf16(Bt[n][k], At[m][k], acc[ai][bj][m][n], 0, 0, 0); __builtin_amdgcn_s_setprio(0); } while (0)
#define PG8_WAIT_V(n) asm volatile("s_waitcnt vmcnt(" #n ")" ::: "memory")
#define PG8_WAIT_L(n) asm volatile("s_waitcnt lgkmcnt(" #n ")" ::: "memory")
#define PG8_BAR __builtin_amdgcn_s_barrier()
#define PG8_SCHED __builtin_amdgcn_sched_barrier(0)
    Unit cur, nxt; int ui = 0;
    if (!S.next(0, cur)) return;
    f32x4 acc[2][2][4][2];
#pragma unroll
    for (int a = 0; a < 2; ++a)
#pragma unroll
        for (int b = 0; b < 2; ++b)
#pragma unroll
            for (int m = 0; m < 4; ++m)
#pragma unroll
                for (int n = 0; n < 2; ++n) acc[a][b][m][n] = (f32x4){0.f, 0.f, 0.f, 0.f};
    bf16x8 At[4][2], B0[2][2], B1[2][2];
    const char* cA = (const char*)g.A + (size_t)cur.pm * tstep; const char* cB = (const char*)g.Bt + (size_t)cur.pn * tstep + cur.boff;
    S.a_ready(cur);
    PG8_STAGE(PG8_SB(0, 0), cB, voffB); PG8_STAGE(PG8_SA(0, 0), cA, voffA); PG8_STAGE(PG8_SB(0, 1), cB + hstep, voffB); PG8_STAGE(PG8_SA(0, 1), cA + hstep, voffA);
    if (wr == 1) PG8_BAR;
    PG8_WAIT_V(4); PG8_BAR;
    PG8_STAGE(PG8_SB(1, 0), cB + kstep, voffB); PG8_STAGE(PG8_SA(1, 0), cA + kstep, voffA); PG8_STAGE(PG8_SB(1, 1), cB + hstep + kstep, voffB);
    PG8_WAIT_V(6); PG8_BAR;
    PG8_STAMP();
    for (;;) {
        const bool has_next = S.next(ui + 1, nxt);
        const char* nA = has_next ? (const char*)g.A + (size_t)nxt.pm * tstep : cA; const char* nB = has_next ? (const char*)g.Bt + (size_t)nxt.pn * tstep + nxt.boff : cB;
        for (int t = 0; t < nt; t += 2) {
            const bool last = (t == nt - 2);
            const char* a1 = cA + (size_t)(t + 1) * kstep;
            const char* a2 = last ? nA : cA + (size_t)(t + 2) * kstep; const char* b2 = last ? nB : cB + (size_t)(t + 2) * kstep;
            const char* a3 = a2 + kstep; const char* b3 = b2 + kstep;
            if (last && has_next) S.a_ready(nxt);
            PG8_LDB(B0, 0, 0); PG8_SCHED; PG8_LDA(At, 0, 0); PG8_STAGE(PG8_SA(1, 1), a1 + hstep, voffA);
            PG8_WAIT_L(8); PG8_BAR; PG8_WAIT_L(0); PG8_MMA(0, 0, At, B0); PG8_BAR; PG8_SCHED;
            PG8_LDB(B1, 0, 1); PG8_STAGE(PG8_SB(0, 0), b2, voffB);
            PG8_BAR; PG8_WAIT_L(0); PG8_MMA(0, 1, At, B1); PG8_BAR;
            PG8_LDA(At, 0, 1); PG8_STAGE(PG8_SA(0, 0), a2, voffA);
            PG8_BAR; PG8_WAIT_L(0); PG8_MMA(1, 0, At, B0); PG8_BAR; PG8_SCHED;
            PG8_STAGE(PG8_SB(0, 1), b2 + hstep, voffB);
            PG8_WAIT_V(6); PG8_BAR; PG8_MMA(1, 1, At, B1); PG8_BAR;
            PG8_LDB(B0, 1, 0); PG8_SCHED; PG8_LDA(At, 1, 0); PG8_STAGE(PG8_SA(0, 1), a2 + hstep, voffA);
            PG8_WAIT_L(8); PG8_BAR; PG8_WAIT_L(0); PG8_MMA(0, 0, At, B0); PG8_BAR; PG8_SCHED;
            PG8_LDB(B1, 1, 1); PG8_STAGE(PG8_SB(1, 0), b3, voffB);
            PG8_BAR; PG8_WAIT_L(0); PG8_MMA(0, 1, At, B1); PG8_BAR;
            PG8_LDA(At, 1, 1); PG8_STAGE(PG8_SA(1, 0), a3, voffA);
            PG8_BAR; PG8_WAIT_L(0); PG8_MMA(1, 0, At, B0); PG8_BAR; PG8_SCHED;
            PG8_STAGE(PG8_SB(1, 1), b3 + hstep, voffB);
            PG8_WAIT_V(6); PG8_BAR; PG8_MMA(1, 1, At, B1); PG8_BAR;
        }
        PG8_STAMP();
        if constexpr (!Epi::AFTER_DRAIN) { E(acc, cur, wr, wc, fr, fq); S.done(cur); }
        PG8_STAMP();
        if (!has_next) break;
#pragma unroll
        for (int a = 0; a < 2; ++a)
#pragma unroll
            for (int b = 0; b < 2; ++b)
#pragma unroll
                for (int m = 0; m < 4; ++m)
#pragma unroll
                    for (int n = 0; n < 2; ++n) acc[a][b][m][n] = (f32x4){0.f, 0.f, 0.f, 0.f};
        cur = nxt; cA = nA; cB = nB; ++ui;
    }
    PG8_WAIT_V(0);
    if (wr == 0) PG8_BAR;
    PG8_BAR;
    if constexpr (Epi::AFTER_DRAIN) { E.fused(acc, cur, wr, wc, fr, fq, lds, wid, lane); S.done(cur); }
    PG8_STAMP();
    if (STAMP && wid == 0) { stamps[lane] = lane < nts ? (((unsigned long long)(unsigned)ts_hi << 32) | (unsigned)ts_lo) : 0ull;
        if (lane == 62) stamps[62] = rt_entry; if (lane == 63) stamps[63] = (unsigned long long)wall_clock64(); }
#undef PG8_STAMP
#undef PG8_SA
#undef PG8_SB
#undef PG8_STAGE
#undef PG8_LDA
#undef PG8_LDB
#undef PG8_MMA
#undef PG8_WAIT_V
#undef PG8_WAIT_L
#undef PG8_BAR
#undef PG8_SCHED
}
template <class Epi, class Sched, bool STAMP = false>
__device__ __forceinline__ void gemm_phase_gather(PG8_LAS unsigned char* lds, const Gemm g, const Sched& S, const Epi& E, const PG8_LAS int* rows, unsigned long long* stamps = nullptr) {
    int tid_l = threadIdx.x; asm volatile("" : "+v"(tid_l)); const int tid = tid_l, wid = __builtin_amdgcn_readfirstlane(tid >> 6), lane = tid & 63, wr = wid >> 2, wc = wid & 3, fr = lane & 15, fq = lane >> 4;
    const int K = g.K, nt = K / BK;
    int ts_lo = 0, ts_hi = 0, nts = 0; const unsigned long long rt_entry = STAMP ? (unsigned long long)wall_clock64() : 0ull;
#define PG8_STAMP() do { if (STAMP && wid == 0 && nts < 64) { const unsigned long long _c = (unsigned long long)clock64(); \
        ts_lo = (lane == nts) ? (int)(unsigned)_c : ts_lo; ts_hi = (lane == nts) ? (int)(unsigned)(_c >> 32) : ts_hi; ++nts; } } while (0)
    PG8_STAMP();
    unsigned voffA[2], voffB[2];
#pragma unroll
    for (int i = 0; i < 2; ++i) { int R, C; stage_rc(tid * 16 + i * 8192, R, C); const int Rb = Epi::PERM ? ((R & ~31) + perm32(R & 31)) : R;
        voffA[i] = (unsigned)(R * K + C) * 2u; voffB[i] = (unsigned)(Rb * K + C) * 2u; }
    int RA[2]; { int R_, C_; stage_rc(tid * 16, R_, C_); RA[0] = R_; stage_rc(tid * 16 + 8192, R_, C_); RA[1] = R_; }
    unsigned caoff[2]; { int R_, C_; stage_rc(tid * 16, R_, C_); caoff[0] = (unsigned)C_ * 2u; stage_rc(tid * 16 + 8192, R_, C_); caoff[1] = (unsigned)C_ * 2u; }
    unsigned offC[2][2], offN[2][2];
#define PG8_ROWOFF(dst, uidx) do { _Pragma("unroll") for (int _h = 0; _h < 2; ++_h) _Pragma("unroll") for (int _i = 0; _i < 2; ++_i) (dst)[_h][_i] = (unsigned)rows[(uidx) * 256 + _h * HALF + RA[_i]] * (unsigned)(K * 2) + caoff[_i]; } while (0)
    const size_t kstep = (size_t)(BK * 2);
    const size_t hstep = (size_t)HALF * K * 2;
    const size_t tstep = 2 * hstep;
    const unsigned ldsw = (unsigned)wid * 1024u;
    const int aoff = lds_byte(wr * 64 + fr, fq * 8), boff = lds_byte(wc * 32 + fr, fq * 8);
#define PG8_SA(b, h) (((b) * 2 + (h)) * HTB)
#define PG8_SB(b, h) ((4 + (b) * 2 + (h)) * HTB)
#define PG8_STAGE(bufoff, gbase, voff) do { _Pragma("unroll") for (int _i = 0; _i < 2; ++_i) \
        __builtin_amdgcn_global_load_lds((const unsigned*)((const char*)(gbase) + (voff)[_i]), (PG8_LAS unsigned*)(lds + (bufoff) + ldsw + _i * 8192), 16, 0, 0); } while (0)
#define PG8_LDA(dst, b, h) do { _Pragma("unroll") for (int m = 0; m < 4; ++m) _Pragma("unroll") for (int k = 0; k < 2; ++k) dst[m][k] = *(const PG8_LAS bf16x8*)(lds + PG8_SA(b, h) + aoff + m * 2048 + k * 1024); } while (0)
#define PG8_LDB(dst, b, h) do { _Pragma("unroll") for (int n = 0; n < 2; ++n) _Pragma("unroll") for (int k = 0; k < 2; ++k) dst[n][k] = *(const PG8_LAS bf16x8*)(lds + PG8_SB(b, h) + boff + n * 2048 + k * 1024); } while (0)
#define PG8_MMA(ai, bj, At, Bt) do { __builtin_amdgcn_s_setprio(1); _Pragma("unroll") for (int m = 0; m < 4; ++m) _Pragma("unroll") for (int n = 0; n < 2; ++n) _Pragma("unroll") for (int k = 0; k < 2; ++k) \
        acc[ai][bj][m][n] = __builtin_amdgcn_mfma_f32_16x16x32_bf16(Bt[n][k], At[m][k], acc[ai][bj][m][n], 0, 0, 0); __builtin_amdgcn_s_setprio(0); } while (0)
#define PG8_WAIT_V(n) asm volatile("s_waitcnt vmcnt(" #n ")" ::: "memory")
#define PG8_WAIT_L(n) asm volatile("s_waitcnt lgkmcnt(" #n ")" ::: "memory")
#define PG8_BAR __builtin_amdgcn_s_barrier()
#define PG8_SCHED __builtin_amdgcn_sched_barrier(0)
    Unit cur, nxt; int ui = 0;
    if (!S.next(0, cur)) return;
    f32x4 acc[2][2][4][2];
#pragma unroll
    for (int a = 0; a < 2; ++a)
#pragma unroll
        for (int b = 0; b < 2; ++b)
#pragma unroll
            for (int m = 0; m < 4; ++m)
#pragma unroll
                for (int n = 0; n < 2; ++n) acc[a][b][m][n] = (f32x4){0.f, 0.f, 0.f, 0.f};
    bf16x8 At[4][2], B0[2][2], B1[2][2];
    const char* cA = (const char*)g.A; PG8_ROWOFF(offC, 0); const char* cB = (const char*)g.Bt + (size_t)cur.pn * tstep + cur.boff;
    S.a_ready(cur);
    PG8_STAGE(PG8_SB(0, 0), cB, voffB); PG8_STAGE(PG8_SA(0, 0), cA, offC[0]); PG8_STAGE(PG8_SB(0, 1), cB + hstep, voffB); PG8_STAGE(PG8_SA(0, 1), cA, offC[1]);
    if (wr == 1) PG8_BAR;
    PG8_WAIT_V(4); PG8_BAR;
    PG8_STAGE(PG8_SB(1, 0), cB + kstep, voffB); PG8_STAGE(PG8_SA(1, 0), cA + kstep, offC[0]); PG8_STAGE(PG8_SB(1, 1), cB + hstep + kstep, voffB);
    PG8_WAIT_V(6); PG8_BAR;
    PG8_STAMP();
    for (;;) {
        const bool has_next = S.next(ui + 1, nxt);
        const char* nA = cA; if (has_next) PG8_ROWOFF(offN, ui + 1); else { offN[0][0] = offC[0][0]; offN[0][1] = offC[0][1]; offN[1][0] = offC[1][0]; offN[1][1] = offC[1][1]; } const char* nB = has_next ? (const char*)g.Bt + (size_t)nxt.pn * tstep + nxt.boff : cB;
        for (int t = 0; t < nt; t += 2) {
            const bool last = (t == nt - 2);
            const char* a1 = cA + (size_t)(t + 1) * kstep;
            const char* a2 = last ? nA : cA + (size_t)(t + 2) * kstep; const char* b2 = last ? nB : cB + (size_t)(t + 2) * kstep;
            const char* a3 = a2 + kstep; const char* b3 = b2 + kstep;
            if (last && has_next) S.a_ready(nxt);
            PG8_LDB(B0, 0, 0); PG8_SCHED; PG8_LDA(At, 0, 0); PG8_STAGE(PG8_SA(1, 1), a1, offC[1]);
            PG8_WAIT_L(8); PG8_BAR; PG8_WAIT_L(0); PG8_MMA(0, 0, At, B0); PG8_BAR; PG8_SCHED;
            PG8_LDB(B1, 0, 1); PG8_STAGE(PG8_SB(0, 0), b2, voffB);
            PG8_BAR; PG8_WAIT_L(0); PG8_MMA(0, 1, At, B1); PG8_BAR;
            PG8_LDA(At, 0, 1); { unsigned o2[2] = {last ? offN[0][0] : offC[0][0], last ? offN[0][1] : offC[0][1]}; PG8_STAGE(PG8_SA(0, 0), a2, o2); }
            PG8_BAR; PG8_WAIT_L(0); PG8_MMA(1, 0, At, B0); PG8_BAR; PG8_SCHED;
            PG8_STAGE(PG8_SB(0, 1), b2 + hstep, voffB);
            PG8_WAIT_V(6); PG8_BAR; PG8_MMA(1, 1, At, B1); PG8_BAR;
            PG8_LDB(B0, 1, 0); PG8_SCHED; PG8_LDA(At, 1, 0); { unsigned o2[2] = {last ? offN[1][0] : offC[1][0], last ? offN[1][1] : offC[1][1]}; PG8_STAGE(PG8_SA(0, 1), a2, o2); }
            PG8_WAIT_L(8); PG8_BAR; PG8_WAIT_L(0); PG8_MMA(0, 0, At, B0); PG8_BAR; PG8_SCHED;
            PG8_LDB(B1, 1, 1); PG8_STAGE(PG8_SB(1, 0), b3, voffB);
            PG8_BAR; PG8_WAIT_L(0); PG8_MMA(0, 1, At, B1); PG8_BAR;
            PG8_LDA(At, 1, 1); { unsigned o2[2] = {last ? offN[0][0] : offC[0][0], last ? offN[0][1] : offC[0][1]}; PG8_STAGE(PG8_SA(1, 0), a3, o2); }
            PG8_BAR; PG8_WAIT_L(0); PG8_MMA(1, 0, At, B0); PG8_BAR; PG8_SCHED;
            PG8_STAGE(PG8_SB(1, 1), b3 + hstep, voffB);
            PG8_WAIT_V(6); PG8_BAR; PG8_MMA(1, 1, At, B1); PG8_BAR;
        }
        PG8_STAMP();
        if constexpr (!Epi::AFTER_DRAIN) { E(acc, cur, wr, wc, fr, fq); S.done(cur); }
        PG8_STAMP();
        if (!has_next) break;
#pragma unroll
        for (int a = 0; a < 2; ++a)
#pragma unroll
            for (int b = 0; b < 2; ++b)
#pragma unroll
                for (int m = 0; m < 4; ++m)
#pragma unroll
                    for (int n = 0; n < 2; ++n) acc[a][b][m][n] = (f32x4){0.f, 0.f, 0.f, 0.f};
        cur = nxt; cA = nA; cB = nB; ++ui; offC[0][0] = offN[0][0]; offC[0][1] = offN[0][1]; offC[1][0] = offN[1][0]; offC[1][1] = offN[1][1];
    }
    PG8_WAIT_V(0);
    if (wr == 0) PG8_BAR;
    PG8_BAR;
    if constexpr (Epi::AFTER_DRAIN) { E.fused(acc, cur, wr, wc, fr, fq, lds, wid, lane); S.done(cur); }
    PG8_STAMP();
    if (STAMP && wid == 0) { stamps[lane] = lane < nts ? (((unsigned long long)(unsigned)ts_hi << 32) | (unsigned)ts_lo) : 0ull;
        if (lane == 62) stamps[62] = rt_entry; if (lane == 63) stamps[63] = (unsigned long long)wall_clock64(); }
#undef PG8_STAMP
#undef PG8_SA
#undef PG8_SB
#undef PG8_STAGE
#undef PG8_LDA
#undef PG8_LDB
#undef PG8_MMA
#undef PG8_WAIT_V
#undef PG8_WAIT_L
#undef PG8_BAR
#undef PG8_SCHED
#undef PG8_ROWOFF
}
}

struct Frame {
    LAS unsigned char* lds;
    const GAS float* const __attribute__((address_space(4)))* in;
    GAS unsigned char* ws;
    float* out;
    int tid, lane, wave, G, bid;
};
#define WSP(T, off) ((T*)(F.ws + (off)))

struct ConvItem { const float* src; bf16_t* dst; int ld, ncols, c0, k0, mode, kdim; };
DI int conv_dst_row(int mode, int c) {
    if (mode == 1) return c < DT_COL ? c : (c < DT_COL + 8 ? -1 : c - 8);
    if (mode == 2) { const int j = c >> 1, up = c & 1; return (j >> 7) * 256 + up * 128 + (j & 127); }
    return c;
}
constexpr int N_S5I = DEPTH * 16 * 4, N_ADA = DEPTH * 48, N_CV_WIN = DEPTH * 41 * 4, N_CV_WOUT = DEPTH * 16 * 4, N_CV_GU = DEPTH * NEXP * 32 * 4,
              N_CV_DN = DEPTH * NEXP * 16 * 4, N_CV_GLU = DEPTH * 4;
constexpr int N_CONV = N_CV_WIN + N_CV_WOUT + N_CV_GLU;
DI ConvItem conv_decode(const Frame& F, int it) {
    ConvItem c; c.kdim = DM;
    if (it < N_CV_WIN) { const int l = it / 164, r = it % 164; c.src = ((const float*)F.in[I_WIN]) + (size_t)l * DM * DIN; c.dst = WSP(bf16_t, WS_WIN) + (size_t)l * NU * DM;
        c.ld = DIN; c.ncols = DIN; c.c0 = (r >> 2) * 64; c.k0 = (r & 3) * 256; c.mode = 1; return c; }
    it -= N_CV_WIN;
    if (it < N_CV_WOUT) { const int l = it / 64, r = it % 64; c.src = ((const float*)F.in[I_WOUT]) + (size_t)l * DM * DM; c.dst = WSP(bf16_t, WS_WOUT) + (size_t)l * DM * DM;
        c.ld = DM; c.ncols = DM; c.c0 = (r >> 2) * 64; c.k0 = (r & 3) * 256; c.mode = 0; return c; }
    it -= N_CV_WOUT;
    { const int l = it / 4, r = it % 4; c.src = ((const float*)F.in[I_WGLU]) + (size_t)l * 256 * 256; c.dst = WSP(bf16_t, WS_WGLU) + (size_t)l * 256 * 256;
      c.ld = 256; c.ncols = 256; c.c0 = r * 64; c.k0 = 0; c.mode = 0; c.kdim = 256; return c; }
}
DI void conv_load(const ConvItem& c, int tid, f32x4 (&v)[8]) {
#pragma unroll
    for (int i = 0; i < 8; ++i) { const int idx = tid + 512 * i, k = idx >> 4, c4 = idx & 15; const int col = c.c0 + 4 * c4;
        v[i] = (col < c.ncols) ? *(const f32x4*)(c.src + (size_t)(c.k0 + k) * c.ld + col) : (f32x4){0.f, 0.f, 0.f, 0.f}; }
}
DI int q_next(const Frame& F, unsigned* ctr) {
    LAS int* slot = (LAS int*)(F.lds + LDS_BYTES - 16);
    __syncthreads();
    if (F.tid == 0) *slot = (int)__hip_atomic_fetch_add(ctr, 1u, __ATOMIC_RELAXED, __HIP_MEMORY_SCOPE_AGENT);
    __syncthreads();
    return *slot;
}
DI void p0_convert(const Frame& F, unsigned* ctr) {
    LAS float* T = (LAS float*)F.lds;
    const int tid = F.tid;
    f32x4 v[8];
    int it = q_next(F, ctr);
    if (it >= N_CONV) return;
    ConvItem cur = conv_decode(F, it);
    conv_load(cur, tid, v);
    for (;;) {
#pragma unroll
        for (int i = 0; i < 8; ++i) { const int idx = tid + 512 * i, k = idx >> 4, c4 = idx & 15;
            T[k * 65 + 4 * c4 + 0] = v[i][0]; T[k * 65 + 4 * c4 + 1] = v[i][1]; T[k * 65 + 4 * c4 + 2] = v[i][2]; T[k * 65 + 4 * c4 + 3] = v[i][3]; }
        __syncthreads();
        const int nit = q_next(F, ctr); const bool has_next = nit < N_CONV;
        ConvItem nxt = cur;
        if (has_next) { nxt = conv_decode(F, nit); conv_load(nxt, tid, v); }
#pragma unroll
        for (int i = 0; i < 4; ++i) { const int task = tid + 512 * i, c = task & 63, kc = task >> 6;
            const int col = cur.c0 + c; const int row = (col < cur.ncols) ? conv_dst_row(cur.mode, col) : -1;
            u32x4 o;
#pragma unroll
            for (int j = 0; j < 4; ++j) o[j] = pk2(T[(8 * kc + 2 * j) * 65 + c], T[(8 * kc + 2 * j + 1) * 65 + c]);
            if (row >= 0) *(u32x4*)(cur.dst + (size_t)row * cur.kdim + cur.k0 + 8 * kc) = o; }
        __syncthreads();
        if (!has_next) break;
        cur = nxt; it = nit;
    }
}
DI void p0_adaln(const Frame& F, int item) {
    const int l = item / 48, col0 = (item % 48) * 128, tid = F.tid, part = tid >> 5, ct = tid & 31;
    const float* W = ((const float*)F.in[I_WADA]) + (size_t)l * DM * 6144 + col0 + 4 * ct;
    const float* cl = ((const float*)F.in[I_C]); const float* cc = ((const float*)F.in[I_CCTX]);
    f32x4 al = {0.f, 0.f, 0.f, 0.f}, ac = {0.f, 0.f, 0.f, 0.f};
#pragma unroll 8
    for (int kk = 0; kk < 64; ++kk) { const int k = part * 64 + kk; const f32x4 w = *(const f32x4*)(W + (size_t)k * 6144);
        const float sl = silu_f(cl[k]), sc = silu_f(cc[k]); al += w * sl; ac += w * sc; }
    LAS float* R = (LAS float*)F.lds;
#pragma unroll
    for (int j = 0; j < 4; ++j) { R[(part * 32 + ct) * 8 + j] = al[j]; R[(part * 32 + ct) * 8 + 4 + j] = ac[j]; }
    __syncthreads();
    if (tid < 256) { const int v = tid >> 7, col = tid & 127; float s = 0.f;
#pragma unroll
        for (int p = 0; p < 16; ++p) s += R[(p * 32 + (col >> 2)) * 8 + v * 4 + (col & 3)];
        WSP(float, WS_MOD)[((size_t)l * 2 + v) * 6144 + col0 + col] = s + ((const float*)F.in[I_BADA])[(size_t)l * 6144 + col0 + col]; }
    __syncthreads();
}
DI void p0_rope(const Frame& F) {
    f32x2* rd = WSP(f32x2, WS_ROPE); f32x2* rg = rd + 256 * 8;
    for (int i = F.tid; i < 256 * 8; i += 512) { const int pos = i >> 3, f = i & 7; const float inv = exp2f(-(float)(2 * f) / 16.f * 13.287712379549449f);
        float s, c; sincosf((float)pos * inv, &s, &c); rd[i] = (f32x2){c, s}; }
    if (F.tid < DEPTH) { const int l = F.tid; float s1 = 0.f, s2 = 0.f;
        for (int i = 0; i < 32; ++i) { s1 += ((const float*)F.in[I_LQ1])[l * 32 + i] * ((const float*)F.in[I_LK1])[l * 32 + i]; s2 += ((const float*)F.in[I_LQ2])[l * 32 + i] * ((const float*)F.in[I_LK2])[l * 32 + i]; }
        WSP(float, WS_LAM)[l] = __expf(s1) - __expf(s2) + (0.8f - 0.6f * __expf(-0.3f * (float)l)); }
    for (int i = F.tid; i < 256 * 16; i += 512) { const int pos = i >> 4, f = i & 15; const float inv = exp2f(-(float)(2 * f) / 32.f * 13.287712379549449f);
        float s, c; sincosf((float)pos * inv, &s, &c); rg[i] = (f32x2){c, s}; }
}
DI f32x2 cmul(f32x2 a, f32x2 b) { return (f32x2){a.x * b.x - a.y * b.y, a.x * b.y + a.y * b.x}; }
DI void p0_s5(const Frame& F, int item4) {
    const int item = item4 >> 2, part = item4 & 3;
    const int l = item >> 4, g = item & 15, tid = F.tid;
    LAS f32x2* PW = (LAS f32x2*)F.lds;
    LAS f32x2* BB = PW + 2 * 65 * 64;
    LAS f32x2* CM = BB + 2 * 64 * 16;
    LAS float* D0 = (LAS float*)(CM + 2 * 16 * 64);
    for (int i = tid; i < 2 * 65 * 64; i += 512) { const int dir = i / (65 * 64), n = (i / 64) % 65, p = i & 63;
        const size_t li = (((size_t)l * 2 + dir) * 16 + g) * 64 + p;
        const float step = __expf(((const float*)F.in[I_LOGDT])[((size_t)l * 2 + dir) * 16 + g]);
        const float tr = ((const float*)F.in[I_LAMRE])[li] * step, ti = ((const float*)F.in[I_LAMIM])[li] * step;
        float s, c; sincosf((float)n * ti, &s, &c); const float m = __expf((float)n * tr); PW[i] = (f32x2){m * c, m * s}; }
    __syncthreads();
    for (int i = tid; i < 2 * 64 * 16; i += 512) { const int dir = i >> 10, p = (i >> 4) & 63, c = i & 15;
        const size_t li = (((size_t)l * 2 + dir) * 16 + g) * 64 + p;
        const f32x2 lam = {((const float*)F.in[I_LAMRE])[li], ((const float*)F.in[I_LAMIM])[li]}; const f32x2 a = PW[(dir * 65 + 1) * 64 + p];
        const f32x2 num = {a.x - 1.f, a.y}; const float den = lam.x * lam.x + lam.y * lam.y;
        const f32x2 q = {(num.x * lam.x + num.y * lam.y) / den, (num.y * lam.x - num.x * lam.y) / den};
        const size_t bi = (((size_t)l * 16 + g) * 64 + p) * 16 + c;
        BB[i] = cmul(q, (f32x2){((const float*)F.in[I_BRE])[bi], ((const float*)F.in[I_BIM])[bi]}); }
    for (int i = tid; i < 2 * 16 * 64; i += 512) { const int dir = i >> 10, c = (i >> 6) & 15, p = i & 63;
        const size_t ci = ((((size_t)l * 2 + dir) * 16 + g) * 16 + c) * 64 + p; CM[i] = (f32x2){((const float*)F.in[I_CRE])[ci], ((const float*)F.in[I_CIM])[ci]}; }
    __syncthreads();
    bf16_t* kt = WSP(bf16_t, WS_KTAB) + ((size_t)l * 16 + g) * 3 * 64 * 256;
    {
        const int dir = part >> 1, lag0 = (part & 1) * 32 + (tid >> 8), c = (tid >> 4) & 15, cp = tid & 15;
        float sk[16];
#pragma unroll
        for (int k = 0; k < 16; ++k) sk[k] = 0.f;
#pragma unroll 2
        for (int p = 0; p < 64; ++p) { const f32x2 tq = cmul(CM[(dir * 16 + c) * 64 + p], BB[(dir * 64 + p) * 16 + cp]);
#pragma unroll
            for (int k = 0; k < 16; ++k) { const f32x2 pw = PW[(dir * 65 + lag0 + 2 * k) * 64 + p]; sk[k] += tq.x * pw.x - tq.y * pw.y; } }
#pragma unroll
        for (int k = 0; k < 16; ++k) kt[part * 8192 + tid + 512 * k] = f2bf(sk[k]); }
    __syncthreads();
    if (part == 0) for (int i = tid; i < 256; i += 512) { const int c = i >> 4, cp = i & 15; float s = 0.f;
        for (int dir = 0; dir < 2; ++dir) for (int p = 0; p < 64; ++p) { const f32x2 w = BB[(dir * 64 + p) * 16 + cp]; const f32x2 cm = CM[(dir * 16 + c) * 64 + p]; s += cm.x * w.x - cm.y * w.y; }
        kt[2 * 64 * 256 + i] = f2bf(s + (c == cp ? ((const float*)F.in[I_S5D])[(size_t)l * 256 + g * 16 + c] : 0.f)); }
    bf16_t* e5 = WSP(bf16_t, WS_E5) + ((size_t)l * 16 + g) * 2 * 128 * 1024;
    for (int k = 0; k < 16; ++k) { const int j = part * 8192 + tid + 512 * k, cp0 = (j & 1) * 8, sq = (j >> 1) & 63, m = (j >> 7) & 127, dir = j >> 14, p = m & 63;
        const int n = dir ? sq : 63 - sq; const f32x2 pw = PW[(dir * 65 + n) * 64 + p];
        const LAS f32x4* b4 = (const LAS f32x4*)(BB + (dir * 64 + p) * 16 + cp0); float o[8];
#pragma unroll
        for (int q = 0; q < 4; ++q) { const f32x4 bv = b4[q];
            o[2 * q] = m < 64 ? pw.x * bv[0] - pw.y * bv[1] : pw.x * bv[1] + pw.y * bv[0]; o[2 * q + 1] = m < 64 ? pw.x * bv[2] - pw.y * bv[3] : pw.x * bv[3] + pw.y * bv[2]; }
        u32x4 w; w[0] = pk2(o[0], o[1]); w[1] = pk2(o[2], o[3]); w[2] = pk2(o[4], o[5]); w[3] = pk2(o[6], o[7]); *(u32x4*)(e5 + ((((size_t)(dir * 4 + (m >> 5)) * 64 + sq) * 64 + ((cp0 >> 3) * 32 + (m & 31))) * 8)) = w; }
    bf16_t* cc5 = WSP(bf16_t, WS_CC5) + ((size_t)l * 16 + g) * 1024 * 256;
    for (int k = 0; k < 16; ++k) { const int j = part * 8192 + tid + 512 * k, p0 = (j & 7) * 8, im = (j >> 3) & 1, dir = (j >> 4) & 1, row = j >> 5, t = row >> 4, c = row & 15;
        const int n = dir ? 64 - t : t + 1;
        const LAS f32x4* c4 = (const LAS f32x4*)(CM + (dir * 16 + c) * 64 + p0); const LAS f32x4* p4 = (const LAS f32x4*)(PW + (dir * 65 + n) * 64 + p0); float o[8];
#pragma unroll
        for (int q = 0; q < 4; ++q) { const f32x4 cv = c4[q], pv = p4[q];
            o[2 * q] = im ? -(cv[0] * pv[1] + cv[1] * pv[0]) : cv[0] * pv[0] - cv[1] * pv[1]; o[2 * q + 1] = im ? -(cv[2] * pv[3] + cv[3] * pv[2]) : cv[2] * pv[2] - cv[3] * pv[3]; }
        u32x4 w; w[0] = pk2(o[0], o[1]); w[1] = pk2(o[2], o[3]); w[2] = pk2(o[4], o[5]); w[3] = pk2(o[6], o[7]); *(u32x4*)(cc5 + ((((size_t)(row >> 5) * 16 + (p0 >> 4) + 4 * im + 8 * dir) * 64 + (((p0 >> 3) & 1) * 32 + (row & 31))) * 8)) = w; }
    f32x2* ap = WSP(f32x2, WS_APOW) + ((size_t)l * 16 + g) * 128;
    if (part == 0) for (int i = tid; i < 128; i += 512) ap[i] = PW[((i >> 6) * 65 + 64) * 64 + (i & 63)];
    __syncthreads();
}
DI void p0_prologue(const Frame& F, int rep = 0) {
    for (int it = F.bid; it < N_S5I; it += F.G) p0_s5(F, it);
    unsigned* qa = WSP(unsigned, WS_CTL) + CW_Q0 + 64 * (20 + rep);
    for (;;) { const int it = q_next(F, qa); if (it > N_ADA) break; if (it < N_ADA) p0_adaln(F, it); else p0_rope(F); }
    __syncthreads();
    p0_convert(F, WSP(unsigned, WS_CTL) + CW_Q0 + 64 * rep);
}

constexpr int RPB = 65;
DI int moe_tables(const Frame& F, int l);
template <bool FINAL>
DI void p1_norm(const Frame& F, int l) {
    if (l > 0) (void)moe_tables(F, l - 1);
    const LAS int* PSTL = (const LAS int*)(F.lds + LDS_MISC);
    LAS float* WDT = (LAS float*)F.lds;
    if (!FINAL) {
        for (int i = F.tid; i < 1024 * 8; i += 512) WDT[i] = ((const float*)F.in[I_WIN])[(size_t)l * DM * DIN + (size_t)(i >> 3) * DIN + DT_COL + (i & 7)];
        __syncthreads();
    }
    const float* mod_cur = WSP(float, WS_MOD) + (size_t)(FINAL ? 0 : l) * 2 * 6144;
    const float* mod_prev = WSP(float, WS_MOD) + (size_t)(l > 0 ? l - 1 : 0) * 2 * 6144;
    const int lane = F.lane;
    int slv = 0, gav = 0;
    if (l > 0 && lane < 36) { const int rr = F.wave + 8 * (lane >> 2), rw = F.bid * RPB + rr;
        if (rr < RPB && rw < NT) { slv = PSTL[WSP(int, WS_TOPE)[(size_t)rw * 4 + (lane & 3)]] + WSP(int, WS_TOPP)[(size_t)rw * 4 + (lane & 3)]; gav = WSP(int, WS_TOPG)[(size_t)rw * 4 + (lane & 3)]; } }
    f32x4 xn[4]; u32x2 yn[4][4];
    auto issue_row = [&](int n) __attribute__((always_inline)) {
        const int rr = F.wave + 8 * n, rw0 = F.bid * RPB + rr, rw = (rr < RPB && rw0 < NT) ? rw0 : F.bid * RPB + F.wave;
        if (l == 0) { const float* src = rw < CTX ? ((const float*)F.in[I_CTX]) + (size_t)rw * DM : ((const float*)F.in[I_X]) + (size_t)(rw - CTX) * DM;
#pragma unroll
            for (int i = 0; i < 4; ++i) xn[i] = *(const f32x4*)(src + 256 * i + 4 * lane);
        } else { const float* x1 = WSP(float, WS_XA) + (size_t)rw * DM;
#pragma unroll
            for (int i = 0; i < 4; ++i) xn[i] = *(const f32x4*)(x1 + 256 * i + 4 * lane);
#pragma unroll
            for (int k = 0; k < 4; ++k) { const int slk = __builtin_amdgcn_readlane(slv, 4 * n + k);
#pragma unroll
                for (int i = 0; i < 4; ++i) yn[i][k] = *(const u32x2*)(WSP(bf16_t, WS_YB) + (size_t)slk * DM + 256 * i + 4 * lane); } } };
    issue_row(0);
#pragma unroll 1
    for (int n = 0; n < 9; ++n) {
        const int r = F.wave + 8 * n; if (r >= RPB) break;
        const int row = F.bid * RPB + r; if (row >= NT) break;
        const int v = row < CTX ? 1 : 0;
        f32x4 x[4]; u32x2 yc[4][4];
#pragma unroll
        for (int i = 0; i < 4; ++i) { x[i] = xn[i];
#pragma unroll
            for (int k = 0; k < 4; ++k) yc[i][k] = yn[i][k]; }
        float ga[4];
#pragma unroll
        for (int k = 0; k < 4; ++k) ga[k] = __int_as_float(__builtin_amdgcn_readlane(gav, 4 * n + k));
        asm volatile("" :: "v"(x[0]), "v"(x[1]), "v"(x[2]), "v"(x[3]));
        if (n < 8) issue_row(n + 1);
        if (FINAL && v) continue;
        if (l > 0) {
            const float* g2 = mod_prev + (size_t)v * 6144 + 5 * 1024;
#pragma unroll
            for (int i = 0; i < 4; ++i) { const int col = 256 * i + 4 * lane; f32x4 acc = {0.f, 0.f, 0.f, 0.f};
#pragma unroll
                for (int k = 0; k < 4; ++k) { const u32x2 y = yc[i][k];
                    acc[0] += ga[k] * bflo(y[0]); acc[1] += ga[k] * bfhi(y[0]); acc[2] += ga[k] * bflo(y[1]); acc[3] += ga[k] * bfhi(y[1]); }
                x[i] = x[i] + *(const f32x4*)(g2 + col) * acc;
                if (!FINAL) *(f32x4*)(WSP(float, WS_XB) + (size_t)row * DM + col) = x[i]; }
        }
        float ss = 0.f;
#pragma unroll
        for (int i = 0; i < 4; ++i) ss += x[i][0] * x[i][0] + x[i][1] * x[i][1] + x[i][2] * x[i][2] + x[i][3] * x[i][3];
        ss = wave_sum(ss);
        const float rs = __builtin_amdgcn_rsqf(ss * (1.f / 1024.f) + EPS);
        if (FINAL) {
#pragma unroll
            for (int i = 0; i < 4; ++i) { const int col = 256 * i + 4 * lane; *(f32x4*)(F.out + (size_t)(row - CTX) * DM + col) = x[i] * rs * *(const f32x4*)(((const float*)F.in[I_FNW]) + col); }
        } else {
            const float* nw = ((const float*)F.in[I_N1W]) + (size_t)l * DM; const float* sh = mod_cur + (size_t)v * 6144; const float* sc = sh + 1024;
            float d[8] = {0.f, 0.f, 0.f, 0.f, 0.f, 0.f, 0.f, 0.f};
#pragma unroll
            for (int i = 0; i < 4; ++i) { const int col = 256 * i + 4 * lane;
                const f32x4 h = x[i] * rs * *(const f32x4*)(nw + col) * (*(const f32x4*)(sc + col) + 1.f) + *(const f32x4*)(sh + col);
                u32x2 o; o[0] = pk2(h[0], h[1]); o[1] = pk2(h[2], h[3]);
                *(u32x2*)(WSP(bf16_t, WS_H) + (size_t)row * DM + col) = o;
#pragma unroll
                for (int c = 0; c < 4; ++c) { const f32x4 w0 = *(const LAS f32x4*)(WDT + (col + c) * 8), w1 = *(const LAS f32x4*)(WDT + (col + c) * 8 + 4);
#pragma unroll
                    for (int j = 0; j < 4; ++j) { d[j] += h[c] * w0[j]; d[4 + j] += h[c] * w1[j]; } } }
#pragma unroll
            for (int j = 0; j < 8; ++j) d[j] = wave_sum(d[j]);
            if (lane == 0) { float* o = WSP(float, WS_DTRAW) + (size_t)row * 8;
                *(f32x4*)o = (f32x4){d[0], d[1], d[2], d[3]}; *(f32x4*)(o + 4) = (f32x4){d[4], d[5], d[6], d[7]}; }
        }
    }
    __syncthreads();
}

constexpr int WR_PITCH = 36;
DI void p7a_router(const Frame& F, int l, int rep = 0) {
    LAS float* WR = (LAS float*)F.lds;
    LAS int* CNT = (LAS int*)(F.lds + 1024 * WR_PITCH * 4);
    LAS int* BASE = CNT + 32;
    LAS int* RI = BASE + 32;
    for (int i = F.tid; i < 1024 * 8; i += 512) *(LAS f32x4*)(WR + (i >> 3) * WR_PITCH + 4 * (i & 7)) = *(const f32x4*)(((const float*)F.in[I_WR]) + (size_t)l * DM * 32 + 4 * i);
    if (F.tid < 32) CNT[F.tid] = 0;
    __syncthreads();
    const int lane = F.lane;
    const float* mod = WSP(float, WS_MOD) + (size_t)l * 2 * 6144;
    const float* nw = ((const float*)F.in[I_N2W]) + (size_t)l * DM;
    const float br = ((const float*)F.in[I_BR])[(size_t)l * 32 + ((((lane >> 3) & 1) << 4) | (((lane >> 2) & 1) << 3) | (((lane >> 1) & 1) << 2) | ((lane & 1) << 1) | ((lane >> 5) & 1))];
    auto finish_row = [&](const f32x4 (&lgv)[8], int r, bool valid) __attribute__((always_inline)) {
        float lg[32];
#pragma unroll
        for (int q = 0; q < 8; ++q) { lg[4 * q] = lgv[q][0]; lg[4 * q + 1] = lgv[q][1]; lg[4 * q + 2] = lgv[q][2]; lg[4 * q + 3] = lgv[q][3]; }
        float a16[16], a8[8], a4[4], a2[2], a1;
        { const bool up = lane & 8;
#pragma unroll
          for (int j = 0; j < 16; ++j) { const float send = up ? lg[j] : lg[16 + j]; const float keep = up ? lg[16 + j] : lg[j]; a16[j] = keep + dppf<0x140>(send); } }
        { const bool up = lane & 4;
#pragma unroll
          for (int j = 0; j < 8; ++j) { const float send = up ? a16[j] : a16[8 + j]; const float keep = up ? a16[8 + j] : a16[j]; a8[j] = keep + dppf<0x141>(send); } }
        { const bool up = lane & 2;
#pragma unroll
          for (int j = 0; j < 4; ++j) { const float send = up ? a8[j] : a8[4 + j]; const float keep = up ? a8[4 + j] : a8[j]; a4[j] = keep + dppf<0x4E>(send); } }
        { const bool up = lane & 1;
#pragma unroll
          for (int j = 0; j < 2; ++j) { const float send = up ? a4[j] : a4[2 + j]; const float keep = up ? a4[2 + j] : a4[j]; a2[j] = keep + dppf<0xB1>(send); } }
        { const bool up = lane & 32; const float send = up ? a2[0] : a2[1]; const float keep = up ? a2[1] : a2[0]; a1 = keep + __shfl_xor(send, 32); }
        a1 += __shfl_xor(a1, 16);
        const int myexp = (((lane >> 3) & 1) << 4) | (((lane >> 2) & 1) << 3) | (((lane >> 1) & 1) << 2) | ((lane & 1) << 1) | ((lane >> 5) & 1);
        float val = a1 + br;
        int te[4]; float tv[4];
#pragma unroll
        for (int k = 0; k < 4; ++k) { const float m = wave_max(val); const unsigned long long bal = __ballot(val == m); const int sel = (int)__ffsll((long long)bal) - 1;
            te[k] = (((sel >> 3) & 1) << 4) | (((sel >> 2) & 1) << 3) | (((sel >> 1) & 1) << 2) | ((sel & 1) << 1) | ((sel >> 5) & 1); tv[k] = m; if (myexp == te[k]) val = -INFINITY; }
        if (lane == 0 && valid) { float g[4], s = 0.f;
#pragma unroll
            for (int k = 0; k < 4; ++k) { g[k] = __expf(tv[k] - tv[0]); s += g[k]; }
#pragma unroll
            for (int k = 0; k < 4; ++k) { const int pos = atomicAdd((int*)&CNT[te[k]], 1); RI[(r * 4 + k) * 3 + 0] = te[k]; RI[(r * 4 + k) * 3 + 1] = pos; RI[(r * 4 + k) * 3 + 2] = __float_as_int(g[k] / s); } }
    };
    for (int r0 = F.wave; r0 < RPB; r0 += 16) {
        const int rowA = F.bid * RPB + r0; if (rowA >= NT) break;
        const bool hasB = (r0 + 8 < RPB) && (rowA + 8 < NT);
        const int rowB = hasB ? rowA + 8 : rowA;
        const float* xA = WSP(float, WS_XA) + (size_t)rowA * DM; const float* shA = mod + (size_t)(rowA < CTX ? 1 : 0) * 6144 + 3 * 1024; const float* scA = shA + 1024;
        const float* xB = WSP(float, WS_XA) + (size_t)rowB * DM; const float* shB = mod + (size_t)(rowB < CTX ? 1 : 0) * 6144 + 3 * 1024; const float* scB = shB + 1024;
        f32x4 xa[4], xb[4]; float ssA = 0.f, ssB = 0.f;
#pragma unroll
        for (int i = 0; i < 4; ++i) { xa[i] = *(const f32x4*)(xA + 256 * i + 4 * lane); xb[i] = *(const f32x4*)(xB + 256 * i + 4 * lane);
            ssA += xa[i][0] * xa[i][0] + xa[i][1] * xa[i][1] + xa[i][2] * xa[i][2] + xa[i][3] * xa[i][3];
            ssB += xb[i][0] * xb[i][0] + xb[i][1] * xb[i][1] + xb[i][2] * xb[i][2] + xb[i][3] * xb[i][3]; }
        ssA = wave_sum(ssA); ssB = wave_sum(ssB);
        const float rsA = __builtin_amdgcn_rsqf(ssA * (1.f / 1024.f) + EPS), rsB = __builtin_amdgcn_rsqf(ssB * (1.f / 1024.f) + EPS);
        f32x4 lgA[8], lgB[8];
#pragma unroll
        for (int q = 0; q < 8; ++q) { lgA[q] = (f32x4){0.f, 0.f, 0.f, 0.f}; lgB[q] = (f32x4){0.f, 0.f, 0.f, 0.f}; }
#pragma unroll
        for (int i = 0; i < 4; ++i) { const int col = 256 * i + 4 * lane; const f32x4 nwv = *(const f32x4*)(nw + col);
            xa[i] = xa[i] * rsA * nwv * (*(const f32x4*)(scA + col) + 1.f) + *(const f32x4*)(shA + col);
            xb[i] = xb[i] * rsB * nwv * (*(const f32x4*)(scB + col) + 1.f) + *(const f32x4*)(shB + col);
            { u32x2 o; o[0] = pk2(xa[i][0], xa[i][1]); o[1] = pk2(xa[i][2], xa[i][3]); *(u32x2*)(WSP(bf16_t, WS_H) + (size_t)rowA * DM + col) = o; }
            if (hasB) { u32x2 o; o[0] = pk2(xb[i][0], xb[i][1]); o[1] = pk2(xb[i][2], xb[i][3]); *(u32x2*)(WSP(bf16_t, WS_H) + (size_t)rowB * DM + col) = o; } }
        __builtin_amdgcn_sched_barrier(0);
#pragma unroll
        for (int i = 0; i < 4; ++i) { const int col = 256 * i + 4 * lane;
#pragma unroll
            for (int c = 0; c < 4; ++c) {
                f32x4 w0[8];
#pragma unroll
                for (int q = 0; q < 8; ++q) w0[q] = *(const LAS f32x4*)(WR + (col + c) * WR_PITCH + 4 * q);
#pragma unroll
                for (int q = 0; q < 8; ++q) { lgA[q] += w0[q] * xa[i][c]; lgB[q] += w0[q] * xb[i][c]; }
#pragma unroll
                for (int q = 0; q < 8; ++q) asm volatile("" : "+v"(lgA[q]), "+v"(lgB[q]));
                } }
        finish_row(lgA, r0, true);
        finish_row(lgB, r0 + 8, hasB);
    }
    __syncthreads();
    if (F.tid < 32) BASE[F.tid] = (int)__hip_atomic_fetch_add(WSP(unsigned, WS_CTL) + (rep ? 4500 : CW_CNT) + l * 32 + F.tid, (unsigned)CNT[F.tid], __ATOMIC_RELAXED, __HIP_MEMORY_SCOPE_AGENT);
    __syncthreads();
    if (F.tid < RPB * 4) { const int r = F.tid >> 2, row = F.bid * RPB + r;
        if (row < NT) { const int e = RI[F.tid * 3], pos = RI[F.tid * 3 + 1];
            WSP(int, WS_TOPE)[(size_t)row * 4 + (F.tid & 3)] = e; WSP(int, WS_TOPP)[(size_t)row * 4 + (F.tid & 3)] = BASE[e] + pos; WSP(int, WS_TOPS)[(size_t)e * NT + BASE[e] + pos] = row; WSP(int, WS_TOPG)[(size_t)row * 4 + (F.tid & 3)] = RI[F.tid * 3 + 2]; } }
    __syncthreads();
}

DI int moe_tables(const Frame& F, int l) {
    LAS int* PST = (LAS int*)(F.lds + LDS_MISC);
    LAS int* T2E = PST + 64;
    __syncthreads();
    if (F.tid < 64) { const int e = F.tid & 31; const int c = (int)__hip_atomic_load(WSP(unsigned, WS_CTL) + CW_CNT + l * 32 + e, __ATOMIC_RELAXED, __HIP_MEMORY_SCOPE_AGENT);
        const int pad = (c + 255) & ~255; int incl = pad;
#pragma unroll
        for (int o = 1; o < 32; o <<= 1) { const int t = __shfl_up(incl, o, 32); if (e >= o) incl += t; }
        if (F.tid < 32) { PST[e] = incl - pad; if (e == 31) PST[32] = incl; PST[64 + 300 + e] = c; } }
    __syncthreads();
    const int ntiles = PST[32] >> 8;
    for (int r = F.tid; r < ntiles; r += 512) { int e = 0;
        for (int q = 1; q < 32; ++q) if (PST[q] <= r * 256) e = q;
        T2E[r] = e; }
    __syncthreads();
    return ntiles;
}
struct MoeOrder {
    int nN, ntiles, G, c; const LAS int* t2e; long estride;
#ifndef MOE_XMAJOR
#define MOE_XMAJOR 1
#endif
    DI bool unit(int i, int& pm, int& pn) const { const int j = c >> 3, per = G / nN, sh = (nN == 8) ? 3 : 2;
        pm = MOE_XMAJOR ? i * per + (c & 7) * (per >> 3) + (j >> sh) : i * per + (j >> sh) * 8 + (c & 7); pn = j & (nN - 1); return pm < ntiles; }
    DI bool next(int i, pg8::Unit& u) const { int pm, pn; if (!unit(i, pm, pn)) return false; u.pm = pm; u.pn = pn; u.boff = (long)t2e[pm] * estride; return true; }
    DI void a_ready(const pg8::Unit&) const {}
    DI void done(const pg8::Unit&) const {}
};
#ifndef STAG_INTRA
#define STAG_INTRA 1
#endif
DI void xcd_stagger(const Frame& F, int step_ticks) {
    const unsigned dl = (unsigned)(STAG_INTRA ? (F.bid >> 3) : (F.bid & 7)) * (unsigned)step_ticks;
    const unsigned long long t0 = __builtin_amdgcn_s_memrealtime();
    while ((unsigned)(__builtin_amdgcn_s_memrealtime() - t0) < dl) __builtin_amdgcn_s_sleep(32);
}
DI void moe_rows(const Frame& F, int l, int ntiles, int nN) {
    const LAS int* PST = (const LAS int*)(F.lds + LDS_MISC); const LAS int* T2E = PST + 64; const LAS int* CNTL = PST + 64 + 300;
    LAS int* ROWS = (LAS int*)(F.lds + LDS_MISC + 2048);
    const MoeOrder S{nN, ntiles, F.G, F.bid, T2E, 0};
    (void)l;
    int val[5]; bool ok[5], inb[5];
#pragma unroll
    for (int k = 0; k < 5; ++k) { const int idx = F.tid + 512 * k, i = idx >> 8, r = idx & 255; int pm, pn;
        ok[k] = S.unit(i, pm, pn); const int e = T2E[ok[k] ? pm : 0], p = ((ok[k] ? pm : 0) - (PST[e] >> 8)) * 256 + r;
        inb[k] = ok[k] && p < CNTL[e]; val[k] = WSP(int, WS_TOPS)[(size_t)e * NT + (inb[k] ? p : 0)]; }
#pragma unroll
    for (int k = 0; k < 5; ++k) if (ok[k]) ROWS[F.tid + 512 * k] = inb[k] ? val[k] : 0;
    __syncthreads();
}

constexpr int LDS_BIASL = LDS_MISC + 2048 + 10 * 1024;
DI void moe_bias(const Frame& F, int ntiles, int nN, const float* bias, int estride) {
    const LAS int* PST = (const LAS int*)(F.lds + LDS_MISC); const LAS int* T2E = PST + 64;
    LAS float* BL = (LAS float*)(F.lds + LDS_BIASL);
    const MoeOrder S{nN, ntiles, F.G, F.bid, T2E, 0};
    float val[5]; bool ok[5];
#pragma unroll
    for (int k = 0; k < 5; ++k) { const int idx = F.tid + 512 * k, i = idx >> 8, r = idx & 255; int pm, pn;
        ok[k] = S.unit(i, pm, pn); val[k] = bias[(size_t)T2E[ok[k] ? pm : 0] * estride + (ok[k] ? pn : 0) * 256 + r]; }
#pragma unroll
    for (int k = 0; k < 5; ++k) if (ok[k]) BL[F.tid + 512 * k] = val[k];
    __syncthreads();
}

#ifndef EPI_NT
#define EPI_NT 0
#endif
#if EPI_NT
#define EPI_STORE(p, v) __builtin_nontemporal_store((v), (p))
#else
#define EPI_STORE(p, v) (*(p) = (v))
#endif
struct EpiU {
    static constexpr bool PERM = true, AFTER_DRAIN = false;
    bf16_t* O; int ldc; bf16_t* us5;
    DI void operator()(const pg8::f32x4 (&acc)[2][2][4][2], const pg8::Unit& u, int wr, int wc, int fr, int fq) const {
        const int row0 = u.pm * 256 + wr * 64 + fr, col0 = u.pn * 256 + wc * 32 + 8 * fq;
        const bool s5 = (u.pn == U_S5 / 256);
#pragma unroll
        for (int ai = 0; ai < 2; ++ai)
#pragma unroll
            for (int m = 0; m < 4; ++m) { const int row = row0 + ai * 128 + m * 16; bf16_t* rowp = O + (size_t)row * ldc + col0;
#pragma unroll
                for (int bj = 0; bj < 2; ++bj) { const pg8::f32x4 v0 = acc[ai][bj][m][0], v1 = acc[ai][bj][m][1];
                    u32x4 w; w[0] = pk2(v0[0], v0[1]); w[1] = pk2(v0[2], v0[3]); w[2] = pk2(v1[0], v1[1]); w[3] = pk2(v1[2], v1[3]);
                    const int cl = wc * 32 + 8 * fq + bj * 128;
                    bf16_t* dst = s5 ? us5 + ((size_t)(cl >> 4) * NT + row) * 16 + (cl & 15) : rowp + bj * 128;
                    EPI_STORE((u32x4*)dst, w); } }
    }
};
struct EpiRes {
    static constexpr bool PERM = false, AFTER_DRAIN = false;
    float* C; const float* res_lat; const float* res_ctx; const float* g1;
    DI void operator()(const pg8::f32x4 (&acc)[2][2][4][2], const pg8::Unit& u, int wr, int wc, int fr, int fq) const {
        const int row0 = CTX + u.pm * 256 + wr * 64 + fr, col0 = u.pn * 256 + wc * 32 + 4 * fq;
        const float* g = g1; (void)res_ctx;
        pg8::f32x4 gv[2][2];
#pragma unroll
        for (int bj = 0; bj < 2; ++bj)
#pragma unroll
            for (int n = 0; n < 2; ++n) gv[bj][n] = *(const pg8::f32x4*)(g + col0 + bj * 128 + n * 16);
#pragma unroll
        for (int ai = 0; ai < 2; ++ai) {
            pg8::f32x4 rv[4][2][2];
#pragma unroll
            for (int m = 0; m < 4; ++m) { const float* rp = res_lat + (size_t)(row0 + ai * 128 + m * 16 - CTX) * DM + col0;
#pragma unroll
                for (int bj = 0; bj < 2; ++bj)
#pragma unroll
                    for (int n = 0; n < 2; ++n) rv[m][bj][n] = *(const pg8::f32x4*)(rp + bj * 128 + n * 16); }
            asm volatile("" :: "v"(rv[0][0][0]), "v"(rv[1][0][0]), "v"(rv[2][0][0]), "v"(rv[3][0][0]), "v"(rv[0][1][1]), "v"(rv[1][1][1]), "v"(rv[2][1][1]), "v"(rv[3][1][1]));
#pragma unroll
            for (int m = 0; m < 4; ++m) { float* cp = C + (size_t)(row0 + ai * 128 + m * 16) * DM + col0;
#pragma unroll
                for (int bj = 0; bj < 2; ++bj)
#pragma unroll
                    for (int n = 0; n < 2; ++n) *(pg8::f32x4*)(cp + bj * 128 + n * 16) = rv[m][bj][n] + gv[bj][n] * acc[ai][bj][m][n]; }
        }
    }
};
struct EpiAct {
    static constexpr bool PERM = true, AFTER_DRAIN = false;
    bf16_t* O; const LAS float* biasl;
    mutable int cnt = 0;
    DI void operator()(const pg8::f32x4 (&acc)[2][2][4][2], const pg8::Unit& u, int wr, int wc, int fr, int fq) const {
        const int row0 = u.pm * 256 + wr * 64 + fr, j0 = u.pn * 128 + wc * 32 + 8 * fq;
        const LAS float* b = biasl + cnt * 256 + 2 * (wc * 32 + 8 * fq); ++cnt;
        pg8::f32x4 bg[2], bu[2];
#pragma unroll
        for (int n = 0; n < 2; ++n) { const pg8::f32x4 t0 = *(const LAS pg8::f32x4*)(b + 8 * n), t1 = *(const LAS pg8::f32x4*)(b + 8 * n + 4);
            bg[n] = (pg8::f32x4){t0[0], t0[2], t1[0], t1[2]}; bu[n] = (pg8::f32x4){t0[1], t0[3], t1[1], t1[3]}; }
#pragma unroll
        for (int ai = 0; ai < 2; ++ai)
#pragma unroll
            for (int m = 0; m < 4; ++m) { bf16_t* rowp = O + (size_t)(row0 + ai * 128 + m * 16) * DM + j0; float a[8];
#pragma unroll
                for (int n = 0; n < 2; ++n) { const pg8::f32x4 gq = acc[ai][0][m][n] + bg[n], uq = acc[ai][1][m][n] + bu[n];
#pragma unroll
                    for (int j = 0; j < 4; ++j) { const float gg = fminf(gq[j], 7.f), uu = fminf(fmaxf(uq[j], -7.f), 7.f); a[4 * n + j] = gg * sigmoid_f(1.702f * gg) * (uu + 1.f); } }
                u32x4 w; w[0] = pk2(a[0], a[1]); w[1] = pk2(a[2], a[3]); w[2] = pk2(a[4], a[5]); w[3] = pk2(a[6], a[7]); EPI_STORE((u32x4*)rowp, w); }
    }
};
struct EpiDown {
    static constexpr bool PERM = true, AFTER_DRAIN = false;
    bf16_t* O; const LAS float* biasl;
    int skip = 0;
    bf16_t* dump = nullptr;
    mutable int cnt = 0;
    DI void operator()(const pg8::f32x4 (&acc)[2][2][4][2], const pg8::Unit& u, int wr, int wc, int fr, int fq) const {
#ifdef PH_REP
        if (skip == 3) {
            bf16_t* dp = dump + ((size_t)(blockIdx.x * 8 + wr * 4 + wc) * 1024 + (fq * 16 + fr)) * 8;
#pragma unroll
            for (int a = 0; a < 2; ++a)
#pragma unroll
                for (int m = 0; m < 4; ++m)
#pragma unroll
                    for (int b = 0; b < 2; ++b) { const pg8::f32x4 v0 = acc[a][b][m][0], v1 = acc[a][b][m][1];
                        u32x4 w; w[0] = pk2(v0[0], v0[1]); w[1] = pk2(v0[2], v0[3]); w[2] = pk2(v1[0], v1[1]); w[3] = pk2(v1[2], v1[3]);
                        *(u32x4*)(dp + ((a * 4 + m) * 2 + b) * 512) = w; }
            return; }
        if (skip == 4) {
            bf16_t* dp = dump + (size_t)blockIdx.x * 65536 + (wr * 64 + fr) * 256 + wc * 32 + 8 * fq;
#pragma unroll
            for (int a = 0; a < 2; ++a)
#pragma unroll
                for (int m = 0; m < 4; ++m)
#pragma unroll
                    for (int b = 0; b < 2; ++b) { const pg8::f32x4 v0 = acc[a][b][m][0], v1 = acc[a][b][m][1];
                        u32x4 w; w[0] = pk2(v0[0], v0[1]); w[1] = pk2(v0[2], v0[3]); w[2] = pk2(v1[0], v1[1]); w[3] = pk2(v1[2], v1[3]);
                        *(u32x4*)(dp + (a * 128 + m * 16) * 256 + b * 128) = w; }
            return; }
        if (skip == 1) {
#pragma unroll
            for (int a = 0; a < 2; ++a)
#pragma unroll
                for (int b = 0; b < 2; ++b)
#pragma unroll
                    for (int m = 0; m < 4; ++m) asm volatile("" :: "v"(acc[a][b][m][0]), "v"(acc[a][b][m][1]));
            return; }
#endif
        const int row0 = u.pm * 256 + wr * 64 + fr, col0 = u.pn * 256 + wc * 32 + 8 * fq;
        const LAS float* b = biasl + cnt * 256 - u.pn * 256; ++cnt;
        pg8::f32x4 bv[2][2];
#pragma unroll
        for (int bj = 0; bj < 2; ++bj)
#pragma unroll
            for (int n = 0; n < 2; ++n) bv[bj][n] = *(const LAS pg8::f32x4*)(b + col0 + bj * 128 + 4 * n);
#pragma unroll
        for (int ai = 0; ai < 2; ++ai)
#pragma unroll
            for (int m = 0; m < 4; ++m) { bf16_t* rowp = O + (size_t)(row0 + ai * 128 + m * 16) * DM + col0;
#pragma unroll
                for (int bj = 0; bj < 2; ++bj) { const pg8::f32x4 v0 = acc[ai][bj][m][0] + bv[bj][0], v1 = acc[ai][bj][m][1] + bv[bj][1];
                    u32x4 w; w[0] = pk2(v0[0], v0[1]); w[1] = pk2(v0[2], v0[3]); w[2] = pk2(v1[0], v1[1]); w[3] = pk2(v1[2], v1[3]);
                    if (skip == 2) asm volatile("" :: "v"(w)); else EPI_STORE((u32x4*)(rowp + bj * 128), w); } }
    }
};

DI void outproj_ctx(const Frame& F, int l, const float* res_ctx) {
    if (F.bid >= 256) return;
    const int mt = F.bid >> 5, nt = F.bid & 31, lane = F.lane, r = lane & 31, h = lane >> 5;
    const bf16_t* A = WSP(bf16_t, WS_MIX) + (size_t)(mt * 32 + r) * DM + F.wave * 128 + 8 * h;
    const bf16_t* B = WSP(bf16_t, WS_WOUT) + (size_t)l * DM * DM + (size_t)(nt * 32 + r) * DM + F.wave * 128 + 8 * h;
    f32x16 acc = splat16(0.f);
#pragma unroll
    for (int ks = 0; ks < 8; ++ks) acc = mfma32(ld8g(A + ks * 16), ld8g(B + ks * 16), acc);
    LAS float* R = (LAS float*)F.lds;
    __syncthreads();
#pragma unroll
    for (int i = 0; i < 16; ++i) R[(F.wave * 16 + i) * 64 + lane] = acc[i];
    __syncthreads();
    for (int e = F.tid; e < 1024; e += 512) { const int i = e >> 6, ln = e & 63; float s = 0.f;
#pragma unroll
        for (int w = 0; w < 8; ++w) s += R[(w * 16 + i) * 64 + ln];
        const int row = mt * 32 + crow(i, ln >> 5), col = nt * 32 + (ln & 31);
        WSP(float, WS_XA)[(size_t)row * DM + col] = res_ctx[(size_t)row * DM + col] + WSP(float, WS_MOD)[(size_t)l * 2 * 6144 + 6144 + 2 * 1024 + col] * s; }
    __syncthreads();
}

template <int DIM> DI void rope_vec(float (&v)[DIM], const f32x2* tab_row, const f32x2* tab_col) {
    constexpr int Q = DIM / 4;
#pragma unroll
    for (int i = 0; i < Q; ++i) { const f32x2 r = tab_row[i], c = tab_col[i];
        const float a = v[i], b = v[Q + i]; v[i] = a * r.x - b * r.y; v[Q + i] = a * r.y + b * r.x;
        const float a2 = v[2 * Q + i], b2 = v[3 * Q + i]; v[2 * Q + i] = a2 * c.x - b2 * c.y; v[3 * Q + i] = a2 * c.y + b2 * c.x; }
}
template <int DIM> DI void load_vec(const bf16_t* p, float (&v)[DIM]) {
#pragma unroll
    for (int i = 0; i < DIM / 8; ++i) { const u32x4 w = *(const u32x4*)(p + 8 * i);
#pragma unroll
        for (int j = 0; j < 4; ++j) { v[8 * i + 2 * j] = bflo(w[j]); v[8 * i + 2 * j + 1] = bfhi(w[j]); } }
}
template <int DIM> DI float store_vec(bf16_t* p, const float (&v)[DIM]) {
    float ss = 0.f;
#pragma unroll
    for (int i = 0; i < DIM / 8; ++i) { u32x4 w;
#pragma unroll
        for (int j = 0; j < 4; ++j) { w[j] = pk2(v[8 * i + 2 * j], v[8 * i + 2 * j + 1]); const float a = bflo(w[j]), b = bfhi(w[j]); ss += a * a + b * b; }
        *(u32x4*)(p + 8 * i) = w; }
    return ss;
}
DI void p3_attn_prep(const Frame& F, int l, int item) {
    LAS unsigned* KMX = (LAS unsigned*)(F.lds + LDS_MISC);
    LAS bf16_t* VS = (LAS bf16_t*)F.lds;
    const int tid = F.tid, tok0 = item * 64;
    if (tid < 32) KMX[tid] = 0u;
    const bf16_t* U = WSP(bf16_t, WS_U);
    for (int i = tid; i < 64 * 48; i += 512) { const int t = i / 48, c8 = i % 48; const int col = c8 < 32 ? U_DV + 8 * c8 : U_GV + 8 * (c8 - 32);
        *(LAS u32x4*)(VS + t * 384 + 8 * c8) = *(const u32x4*)(U + (size_t)(tok0 + t) * NU + col); }
    __syncthreads();
    const f32x2* ropeD = WSP(f32x2, WS_ROPE); const f32x2* ropeG = ropeD + 256 * 8;
    const float qs_d = 0.17677669529663687f * LOG2E, qs_g = 0.125f * LOG2E;
    for (int task = tid; task < 64 * 22; task += 512) {
        int t, vi;
        if (task < 1024) { t = task & 63; vi = task >> 6; } else if (task < 1280) { t = task & 63; vi = 16 + ((task - 1024) >> 6); } else { t = task & 63; vi = 20 + ((task - 1280) >> 6); }
        const int tok = tok0 + t; const bool lat = tok >= CTX; const int pos = tok - CTX, pr = lat ? pos >> 6 : 0, pc = lat ? pos & 63 : 0;
        const bf16_t* urow = U + (size_t)tok * NU;
        if (vi < 16) {
            const bool isk = vi >= 8; const int hm = vi & 7, h = hm >> 1, m = hm & 1;
            float v[32]; load_vec<32>(urow + (isk ? U_DK : U_DQ) + hm * 32, v);
            if (lat) rope_vec<32>(v, ropeD + pr * 8, ropeD + pc * 8);
            if (!isk) {
#pragma unroll
                for (int i = 0; i < 32; ++i) v[i] *= qs_d;
                const float ss = store_vec<32>(WSP(bf16_t, WS_QD) + ((size_t)h * NT + tok) * 64 + m * 32, v);
                WSP(float, WS_QND)[((size_t)h * 2 + m) * NT + tok] = sqrtf(ss);
                __hip_atomic_fetch_max(KMX + 10 + hm, __float_as_uint(ss), __ATOMIC_RELAXED, __HIP_MEMORY_SCOPE_WORKGROUP);
            } else {
                const float ss = store_vec<32>(WSP(bf16_t, WS_KD) + ((size_t)h * NT + tok) * 64 + m * 32, v);
                __hip_atomic_fetch_max(KMX + hm, __float_as_uint(ss), __ATOMIC_RELAXED, __HIP_MEMORY_SCOPE_WORKGROUP);
            }
        } else {
            const bool isk = vi >= 20; const int h = isk ? vi - 20 : vi - 16;
            float v[64]; load_vec<64>(urow + (isk ? U_GK : U_GQ) + h * 64, v);
            float ss = 0.f;
#pragma unroll
            for (int i = 0; i < 64; ++i) ss += v[i] * v[i];
            const float rs = __builtin_amdgcn_rsqf(ss * (1.f / 64.f) + EPS);
            const float* nw = ((const float*)F.in[isk ? I_KNW : I_QNW]) + (size_t)l * 64;
#pragma unroll
            for (int i = 0; i < 64; ++i) v[i] = v[i] * rs * nw[i];
            if (lat) rope_vec<64>(v, ropeG + pr * 16, ropeG + pc * 16);
            if (!isk) {
#pragma unroll
                for (int i = 0; i < 64; ++i) v[i] *= qs_g;
                const float s2 = store_vec<64>(WSP(bf16_t, WS_QG) + ((size_t)h * NT + tok) * 64, v);
                WSP(float, WS_QNG)[(size_t)h * NT + tok] = sqrtf(s2);
                __hip_atomic_fetch_max(KMX + 18 + h, __float_as_uint(s2), __ATOMIC_RELAXED, __HIP_MEMORY_SCOPE_WORKGROUP);
            } else {
                const float s2 = store_vec<64>(WSP(bf16_t, WS_KG) + ((size_t)h * NT + tok) * 64, v);
                __hip_atomic_fetch_max(KMX + 8 + h, __float_as_uint(s2), __ATOMIC_RELAXED, __HIP_MEMORY_SCOPE_WORKGROUP);
            }
        }
    }
    for (int i = tid; i < 384 * 8; i += 512) { const int c = i >> 3, o = i & 7; u32x4 w;
#pragma unroll
        for (int j = 0; j < 4; ++j) { const unsigned lo = VS[(8 * o + 2 * j) * 384 + c], hi = VS[(8 * o + 2 * j + 1) * 384 + c]; w[j] = lo | (hi << 16); }
        bf16_t* dst = c < 256 ? WSP(bf16_t, WS_VTD) + (size_t)c * NT : WSP(bf16_t, WS_VTG) + (size_t)(c - 256) * NT;
        *(u32x4*)(dst + tok0 + 8 * o) = w; }
    __syncthreads();
    if (tid < 22) __hip_atomic_fetch_max(WSP(unsigned, WS_CTL) + CW_KMAX + l * 32 + tid, KMX[tid], __ATOMIC_RELAXED, __HIP_MEMORY_SCOPE_AGENT);
    __syncthreads();
}

constexpr int UBP = 1032;
template <bool FROM_U>
DI void s5_stage_u(const Frame& F, int g, int nt) {
    LAS bf16_t* UB = (LAS bf16_t*)F.lds;
    __syncthreads();
    for (int i = F.tid; i < 32 * 128; i += 512) { const int n = i >> 7, p = i & 127; const int chunk = nt * 32 + n, cc = chunk < NC5 ? chunk : NC5 - 1;
        if (FROM_U) { const int s = p >> 1, hh = p & 1; *(LAS u32x4*)(UB + n * UBP + s * 16 + 8 * hh) = *(const u32x4*)(WSP(bf16_t, WS_U) + (size_t)(cc * S5L + s) * NU + U_S5 + g * 16 + 8 * hh); }
        else *(LAS u32x4*)(UB + n * UBP + 8 * p) = *(const u32x4*)(WSP(bf16_t, WS_US5) + ((size_t)g * NT + (size_t)cc * S5L) * 16 + 8 * p); }
    __syncthreads();
}
constexpr int N_S5H = 16 * 9;
DI void p3_s5_hloc(const Frame& F, int l, int item) {
    const int g = item / 9, nt = item % 9, dir = F.wave >> 2, mt = F.wave & 3, lane = F.lane, r = lane & 31, h = lane >> 5;
    s5_stage_u<false>(F, g, nt);
    const LAS bf16_t* UB = (const LAS bf16_t*)F.lds + r * UBP + 8 * h;
    const bf16_t* E = WSP(bf16_t, WS_E5) + ((size_t)l * 16 + g) * 2 * 128 * 1024 + ((size_t)(dir * 4 + mt) * 64 * 64 + lane) * 8;
    f32x16 acc = splat16(0.f);
#pragma unroll 16
    for (int ks = 0; ks < 64; ++ks) acc = mfma32(ld8g(E + ks * 512), *(const LAS bf16x8*)(UB + ks * 16), acc);
    const int chunk = nt * 32 + r;
    if (chunk < NC5) { float* o = WSP(float, WS_HLOC) + (size_t)chunk * 4096 + (g * 2 + dir) * 128 + mt * 32;
#pragma unroll
        for (int i = 0; i < 16; ++i) o[crow(i, h)] = acc[i]; }
}

constexpr int SP = 136;
DI void p3_ssd_prep(const Frame& F, int l, int c) {
    LAS bf16_t* XT = (LAS bf16_t*)F.lds;
    LAS bf16_t* BT = XT + 256 * SP;
    LAS float* DTL = (LAS float*)(BT + 256 * SP);
    LAS float* CML = DTL + 8 * 128;
    LAS float* WG = CML + 8 * 128;
    const int tid = F.tid, lane = F.lane, tok0 = c * 128;
    const int seq_lo = c < 2 ? 0 : CTX, seq_hi = c < 2 ? CTX : NT;
    const bf16_t* U = WSP(bf16_t, WS_U);
    const float* cw = ((const float*)F.in[I_CONVW]) + (size_t)l * 3 * 768; const float* cb = ((const float*)F.in[I_CONVB]) + (size_t)l * 768;
    constexpr int RP = 264;
    LAS bf16_t* RAW = XT;
    LAS f32x4* CWS = (LAS f32x4*)(WG + 8 * 128);
#pragma unroll 1
    for (int sec = 1; sec < 3; ++sec) {
        __syncthreads();
        if (tid < 256) CWS[tid] = (f32x4){cw[sec * 256 + tid], cw[768 + sec * 256 + tid], cw[1536 + sec * 256 + tid], cb[sec * 256 + tid]};
        for (int i = tid; i < 130 * 32; i += 512) { const int rr = i >> 5, p = i & 31, tok = tok0 - 1 + rr;
            const u32x4 v = (tok >= seq_lo && tok < seq_hi) ? *(const u32x4*)(U + (size_t)tok * NU + U_XS + sec * 256 + 8 * p) : (u32x4){0u, 0u, 0u, 0u};
            *(LAS u32x4*)(RAW + rr * RP + 8 * p) = v; }
        __syncthreads();
        for (int task = tid; task < 128 * 32; task += 512) { const int t = task & 127, cg = task >> 7, tok = tok0 + t, chl = cg * 8, ch0 = sec * 256 + chl;
            const u32x4 xm = *(const LAS u32x4*)(RAW + t * RP + chl), x0 = *(const LAS u32x4*)(RAW + (t + 1) * RP + chl), xp = *(const LAS u32x4*)(RAW + (t + 2) * RP + chl);
            float y[8]; (void)ch0;
#pragma unroll
            for (int j = 0; j < 4; ++j) { const f32x4 c0 = CWS[chl + 2 * j], c1 = CWS[chl + 2 * j + 1];
                const float a0 = bflo(xm[j]) * c0[0] + bflo(x0[j]) * c0[1] + bflo(xp[j]) * c0[2] + c0[3];
                const float a1 = bfhi(xm[j]) * c1[0] + bfhi(x0[j]) * c1[1] + bfhi(xp[j]) * c1[2] + c1[3];
                y[2 * j] = silu_f(a0); y[2 * j + 1] = silu_f(a1); }
            u32x4 w;
#pragma unroll
            for (int j = 0; j < 4; ++j) w[j] = pk2(y[2 * j], y[2 * j + 1]);
            if (sec == 1) { *(u32x4*)(WSP(bf16_t, WS_BN) + (size_t)tok * 256 + chl) = w;
#pragma unroll
                for (int j = 0; j < 8; ++j) BT[(chl + j) * SP + t] = f2bf(y[j]);
            } else *(u32x4*)(WSP(bf16_t, WS_CN) + (size_t)tok * 256 + chl) = w; }
    }
    __syncthreads();
    if (tid < 256) CWS[tid] = (f32x4){cw[tid], cw[768 + tid], cw[1536 + tid], cb[tid]};
    __syncthreads();
    for (int task = tid; task < 128 * 32; task += 512) { const int t = task & 127, cg = task >> 7, tok = tok0 + t, ch0 = cg * 8;
        const u32x4 z4 = {0u, 0u, 0u, 0u};
        const u32x4 xm = (tok - 1 >= seq_lo) ? *(const u32x4*)(U + (size_t)(tok - 1) * NU + U_XS + ch0) : z4;
        const u32x4 x0 = *(const u32x4*)(U + (size_t)tok * NU + U_XS + ch0);
        const u32x4 xp = (tok + 1 < seq_hi) ? *(const u32x4*)(U + (size_t)(tok + 1) * NU + U_XS + ch0) : z4;
#pragma unroll
        for (int j = 0; j < 4; ++j) { const f32x4 c0 = CWS[ch0 + 2 * j], c1 = CWS[ch0 + 2 * j + 1];
            const float a0 = bflo(xm[j]) * c0[0] + bflo(x0[j]) * c0[1] + bflo(xp[j]) * c0[2] + c0[3];
            const float a1 = bfhi(xm[j]) * c1[0] + bfhi(x0[j]) * c1[1] + bfhi(xp[j]) * c1[2] + c1[3];
            XT[(ch0 + 2 * j) * SP + t] = f2bf(silu_f(a0)); XT[(ch0 + 2 * j + 1) * SP + t] = f2bf(silu_f(a1)); }
    }
    { const int j = F.wave, dir = j >> 2; const float bias = ((const float*)F.in[I_DTB])[(size_t)l * 8 + j], a = -__expf(((const float*)F.in[I_ALOG])[(size_t)l * 8 + j]);
      float e[2], dtv[2];
#pragma unroll
      for (int q = 0; q < 2; ++q) { const int li = 2 * lane + q, t = dir ? 127 - li : li;
          const float x = WSP(float, WS_DTRAW)[(size_t)(tok0 + t) * 8 + j] + bias; dtv[q] = x > 20.f ? x : log1pf(__expf(x)); e[q] = dtv[q] * a * LOG2E; }
      float s = e[0] + e[1];
#pragma unroll
      for (int o = 1; o < 64; o <<= 1) { const float tv = __shfl_up(s, o); if (lane >= o) s += tv; }
      const float c1 = s, c0 = s - e[1];
#pragma unroll
      for (int q = 0; q < 2; ++q) { const int li = 2 * lane + q, t = dir ? 127 - li : li; const float cv = q ? c1 : c0;
          DTL[j * 128 + t] = dtv[q]; CML[j * 128 + t] = cv;
          WSP(float, WS_DTV)[((size_t)c * 8 + j) * 128 + t] = dtv[q]; WSP(float, WS_CUM)[((size_t)c * 8 + j) * 128 + t] = cv; }
    }
    __syncthreads();
    for (int i = tid; i < 8 * 128; i += 512) { const int j = i >> 7; const float tot = CML[j * 128 + ((j >> 2) ? 0 : 127)]; WG[i] = DTL[i] * __builtin_amdgcn_exp2f(tot - CML[i]); }
    for (int i = tid; i < 256 * 16; i += 512) { const int ch = i >> 4, o = i & 15; *(u32x4*)(WSP(bf16_t, WS_XST) + ((size_t)c * 256 + ch) * 128 + 8 * o) = *(const LAS u32x4*)(XT + ch * SP + 8 * o); }
    __syncthreads();
    { const int j = F.wave, hh = j & 3, g = hh >> 1, r = lane & 31, h = lane >> 5;
      f32x16 acc[2][4];
#pragma unroll
      for (int a = 0; a < 2; ++a)
#pragma unroll
          for (int b = 0; b < 4; ++b) acc[a][b] = splat16(0.f);
#pragma unroll 1
      for (int ks = 0; ks < 8; ++ks) {
          const f32x4 w0 = *(const LAS f32x4*)(WG + j * 128 + ks * 16 + 8 * h), w1 = *(const LAS f32x4*)(WG + j * 128 + ks * 16 + 8 * h + 4);
          bf16x8 af[2], bfr[4];
#pragma unroll
          for (int a = 0; a < 2; ++a) { const u32x4 x = *(const LAS u32x4*)(XT + (hh * 64 + a * 32 + r) * SP + ks * 16 + 8 * h); u32x4 o;
              o[0] = pk2(bflo(x[0]) * w0[0], bfhi(x[0]) * w0[1]); o[1] = pk2(bflo(x[1]) * w0[2], bfhi(x[1]) * w0[3]);
              o[2] = pk2(bflo(x[2]) * w1[0], bfhi(x[2]) * w1[1]); o[3] = pk2(bflo(x[3]) * w1[2], bfhi(x[3]) * w1[3]); af[a] = __builtin_bit_cast(bf16x8, o); }
#pragma unroll
          for (int b = 0; b < 4; ++b) bfr[b] = *(const LAS bf16x8*)(BT + (g * 128 + b * 32 + r) * SP + ks * 16 + 8 * h);
#pragma unroll
          for (int a = 0; a < 2; ++a)
#pragma unroll
              for (int b = 0; b < 4; ++b) acc[a][b] = mfma32(af[a], bfr[b], acc[a][b]);
      }
      float* o = WSP(float, WS_SLOC) + ((size_t)c * 8 + j) * 64 * 128;
#pragma unroll
      for (int a = 0; a < 2; ++a)
#pragma unroll
          for (int b = 0; b < 4; ++b)
#pragma unroll
              for (int i = 0; i < 16; ++i) o[(a * 32 + crow(i, h)) * 128 + b * 32 + r] = acc[a][b][i];
    }
    __syncthreads();
}

DI void p4_s5_scan_el(const Frame& F, int l, int st);
DI void p4_ssd_scan(const Frame& F, int l) {
    if (F.tid >= 256) { if (F.tid < 264) { const int st = F.bid * 8 + (F.tid - 256); if (st < 2048) p4_s5_scan_el(F, l, st); } return; }
    const int el = F.bid * 256 + F.tid; if (el >= 65536) return;
    const int j = el >> 13;
    const int dir = j >> 2;
    const float* cum = WSP(float, WS_CUM); const float* sl = WSP(float, WS_SLOC); bf16_t* so = WSP(bf16_t, WS_SIN);
    const int eo = el & 8191;
    float s = 0.f;
#pragma unroll 26
    for (int i = 0; i < NCH; ++i) { const int c = dir ? (i < 2 ? 1 - i : NCH + 1 - i) : i;
        so[((size_t)c * 8 + j) * 8192 + eo] = f2bf(s);
        const float tot = cum[((size_t)c * 8 + j) * 128 + (dir ? 0 : 127)];
        s = s * __builtin_amdgcn_exp2f(tot) + sl[((size_t)c * 8 + j) * 8192 + eo]; }
}
DI void p4_s5_scan_el(const Frame& F, int l, int st) {
    const int g = st >> 7, dir = (st >> 6) & 1, p = st & 63;
    const f32x2 ap = WSP(f32x2, WS_APOW)[((size_t)l * 16 + g) * 128 + dir * 64 + p];
    const float* hl = WSP(float, WS_HLOC) + (g * 2 + dir) * 128 + p; bf16_t* ho = WSP(bf16_t, WS_HIN) + (g * 2 + dir) * 128 + p;
    f32x2 s = {0.f, 0.f};
#pragma unroll 26
    for (int i = 0; i < NC5; ++i) { const int c = dir ? (i < 4 ? 3 - i : NC5 + 3 - i) : i;
        ho[(size_t)c * 4096] = f2bf(s.x); ho[(size_t)c * 4096 + 64] = f2bf(s.y);
        const f32x2 loc = {hl[(size_t)c * 4096], hl[(size_t)c * 4096 + 64]};
        s = cmul(s, ap) + loc; }
}


constexpr int CVJ_LDS = 72 * 1024;
struct CvTile { const float* src; bf16_t* dst; int ld, c0, k0, mode; };
DI CvTile cv_decode(const Frame& F, int l, int m) {
    const int e = m / 1536, r = m % 1536; CvTile c;
    if (r < 1024) { c.src = ((const float*)F.in[I_WGU]) + (size_t)(l * NEXP + e) * DM * 2048; c.dst = WSP(bf16_t, WS_WGU) + (size_t)(l * NEXP + e) * 2048 * DM; c.ld = 2048; c.c0 = (r >> 4) * 32; c.k0 = (r & 15) * 64; c.mode = 2; }
    else { const int q = r - 1024; c.src = ((const float*)F.in[I_WDN]) + (size_t)(l * NEXP + e) * DM * DM; c.dst = WSP(bf16_t, WS_WDN) + (size_t)(l * NEXP + e) * DM * DM; c.ld = DM; c.c0 = (q >> 4) * 32; c.k0 = (q & 15) * 64; c.mode = 0; }
    return c;
}
DI void cv_issue(const Frame& F, int l, int j, f32x4 (&v)[8]) {
    (void)v;
    const CvTile c = cv_decode(F, l, (F.bid * 8 + F.wave) + 2048 * j);
    const float* s = c.src + (size_t)(c.k0 + (F.lane >> 3)) * c.ld + c.c0 + 4 * (F.lane & 7);
    LAS unsigned char* base = F.lds + CVJ_LDS + __builtin_amdgcn_readfirstlane(F.wave) * 8192;
#pragma unroll
    for (int i = 0; i < 8; ++i) __builtin_amdgcn_global_load_lds((const unsigned*)(s + (size_t)(8 * i) * c.ld), (LAS unsigned*)(base + i * 1024), 16, 0, 0);
}
DI void cv_stage(const Frame& F, const f32x4 (&v)[8]) { (void)F; (void)v; }
DI void cv_finish(const Frame& F, int l, int j) {
    const CvTile c = cv_decode(F, l, (F.bid * 8 + F.wave) + 2048 * j);
    const LAS float* T = (const LAS float*)(F.lds + CVJ_LDS + F.wave * 8192);
    const int col = F.lane & 31, kh = F.lane >> 5, row = conv_dst_row(c.mode, c.c0 + col);
    bf16_t* o = c.dst + (size_t)row * DM + c.k0 + kh * 32;
#pragma unroll
    for (int q = 0; q < 4; ++q) { u32x4 w;
#pragma unroll
        for (int i = 0; i < 4; ++i) w[i] = pk2(T[(kh * 32 + 8 * q + 2 * i) * 32 + col], T[(kh * 32 + 8 * q + 2 * i + 1) * 32 + col]);
        *(u32x4*)(o + 8 * q) = w; }
}
constexpr int AP = 144;
struct AttnOut { bf16_t* mix; int col0; float lam, outscale; const float* subw; float* po = nullptr; float* pl = nullptr; };
#ifndef DIFF_KT
#define DIFF_KT 64
#endif
#ifndef ATT_SCALAR_SUM
#define ATT_SCALAR_SUM 0
#endif
#ifndef ATT_STATIC_PRIO
#define ATT_STATIC_PRIO 0
#endif
#if ATT_STATIC_PRIO
#define ATT_PRIO_HI do { } while (0)
#define ATT_PRIO_LO do { } while (0)
#else
#define ATT_PRIO_HI __builtin_amdgcn_s_setprio(1)
#define ATT_PRIO_LO __builtin_amdgcn_s_setprio(0)
#endif
template <bool DIFF, int KT, bool G2 = false>
DI void attn_item(const Frame& F, const bf16_t* Q, const bf16_t* K, const bf16_t* Vt, const float* qn0, const float* qn1, float km0, float km1,
                  int q0, int nkeys, const AttnOut& ao, int cv_l = -1) {
    constexpr int KTB = KT * AP, VPB = KT * 2 + 16, VTB = 64 * VPB, NP = KT / 64;
    LAS unsigned char* KB = F.lds;
    LAS unsigned char* VB = F.lds + 2 * KTB;
    const int tid = F.tid, lane = F.lane, r = lane & 31, h = lane >> 5;
    const int qrow = q0 + F.wave * 32 + r;
    bf16x8 qf[4];
#pragma unroll
    for (int j = 0; j < 4; ++j) qf[j] = ld8g(Q + (size_t)qrow * 64 + j * 16 + 8 * h);
    LAS unsigned char* QL = F.lds + 40 * 1024 + F.wave * 4096 + lane * 16;
    LAS unsigned char* QA = F.lds + 136 * 1024 + F.wave * 2048 + lane * 16;
    if (G2) {
#pragma unroll
        for (int j = 0; j < 4; ++j) *(LAS bf16x8*)(QL + j * 1024) = ld8g(Q + (size_t)NT * 64 + (size_t)qrow * 64 + j * 16 + 8 * h);
        *(LAS bf16x8*)(QA) = qf[2]; *(LAS bf16x8*)(QA + 1024) = qf[3]; }
    const float sh0 = -qn0[qrow] * km0, sh1 = DIFF ? -qn1[qrow] * km1 : 0.f;
    f32x16 O0[2], O1[2];
#pragma unroll
    for (int d = 0; d < 2; ++d) { O0[d] = splat16(0.f); O1[d] = splat16(0.f); }
    f32x2 l0v = {0.f, 0.f}, l1v = {0.f, 0.f};
    const int srow = tid >> 3, sch = tid & 7;
    const bf16_t* kg = K + (size_t)srow * 64 + sch * 8; const bf16_t* vg = Vt + (size_t)srow * NT + sch * 8;
    const int ntile = nkeys / KT;
    u32x4 kreg[NP], vreg[NP];
#pragma unroll
    for (int i = 0; i < NP; ++i) { kreg[i] = *(const u32x4*)(kg + (size_t)i * 64 * 64); vreg[i] = *(const u32x4*)(vg + i * 64); }
    __syncthreads();
#pragma unroll
    for (int i = 0; i < NP; ++i) { *(LAS u32x4*)(KB + (srow + 64 * i) * AP + sch * 16) = kreg[i]; *(LAS u32x4*)(VB + srow * VPB + (sch + 8 * i) * 16) = vreg[i]; }
    __syncthreads();
    const int krow = kperm(r);
    f32x4 cvv[8];
#pragma unroll
    for (int i = 0; i < 8; ++i) cvv[i] = (f32x4){0.f, 0.f, 0.f, 0.f};
        if (G2) asm volatile("" :: "v"(qf[0]), "v"(qf[1]), "v"(sh0), "v"(sh1)); else asm volatile("" :: "v"(qf[0]), "v"(qf[1]), "v"(qf[2]), "v"(qf[3]), "v"(sh0), "v"(sh1));
#if ATT_STATIC_PRIO
    if (F.wave >= 4) __builtin_amdgcn_s_setprio(1);
#endif
#pragma clang loop unroll(disable)
    for (int t = 0; t < ntile; ++t) {
        const int buf = t & 1;
        constexpr int CVP = 5;
        const int cv_tt = t - (F.bid % CVP), cv_tq = cv_tt / CVP, cv_tr = cv_tt - CVP * cv_tq;
        const bool cv_on = G2 && cv_l >= 0 && cv_tt >= 0 && cv_tq < 24;
        if (cv_on && cv_tr == 2) cv_finish(F, cv_l, cv_tq);
        if (t + 1 < ntile) {
#pragma unroll
            for (int i = 0; i < NP; ++i) { kreg[i] = *(const u32x4*)(kg + ((size_t)(t + 1) * KT + i * 64) * 64); vreg[i] = *(const u32x4*)(vg + (size_t)(t + 1) * KT + i * 64); } }
        if (cv_on && cv_tr == 0) cv_issue(F, cv_l, cv_tq, cvv);
        const LAS unsigned char* kb = KB + buf * KTB; const LAS unsigned char* vb = VB + buf * VTB;
#pragma unroll
        for (int sub = 0; sub < KT / 32; ++sub) {
            bf16x8 kf[4];
#pragma unroll
            for (int j = 0; j < 4; ++j) kf[j] = *(const LAS bf16x8*)(kb + (sub * 32 + krow) * AP + j * 32 + h * 16);
            bf16x8 vf[2][2];
#pragma unroll
            for (int d = 0; d < 2; ++d)
#pragma unroll
                for (int s = 0; s < 2; ++s) vf[d][s] = *(const LAS bf16x8*)(vb + (d * 32 + r) * VPB + (sub * 32 + s * 16 + h * 8) * 2);
            {   f32x16 S = splat16(sh0);
                ATT_PRIO_HI;
                S = mfma32(kf[0], qf[0], S); S = mfma32(kf[1], qf[1], S);
                if (G2) { S = mfma32(kf[2], *(const LAS bf16x8*)(QA), S); S = mfma32(kf[3], *(const LAS bf16x8*)(QA + 1024), S); }
                else if (!DIFF) { S = mfma32(kf[2], qf[2], S); S = mfma32(kf[3], qf[3], S); }
                ATT_PRIO_LO;
#pragma unroll
                for (int i = 0; i < 16; ++i) {
#if defined(ATTN_DUP) && ATTN_DUP
                    float x2 = S[i]; asm volatile("" : "+v"(x2)); const float e2 = __builtin_amdgcn_exp2f(x2); S[i] = 0.5f * (__builtin_amdgcn_exp2f(S[i]) + e2);
#else
                    S[i] = __builtin_amdgcn_exp2f(S[i]);
#endif
                    }
#pragma unroll
#if ATT_SCALAR_SUM
                for (int i = 0; i < 16; i += 2) { asm("v_add_f32 %0, %0, %1" : "+v"(l0v.x) : "v"(S[i])); asm("v_add_f32 %0, %0, %1" : "+v"(l0v.y) : "v"(S[i + 1])); }
#else
                for (int i = 0; i < 16; i += 2) l0v += (f32x2){S[i], S[i + 1]};
#endif
                const bf16x8 p0 = pack_step<0>(S), p1 = pack_step<1>(S);
                ATT_PRIO_HI;
#pragma unroll
                for (int d = 0; d < 2; ++d) { O0[d] = mfma32(vf[d][0], p0, O0[d]); O0[d] = mfma32(vf[d][1], p1, O0[d]); }
                ATT_PRIO_LO; }
            if (DIFF) { f32x16 S = splat16(sh1);
                ATT_PRIO_HI;
                if (G2) {
#pragma unroll
                    for (int j = 0; j < 4; ++j) S = mfma32(kf[j], *(const LAS bf16x8*)(QL + j * 1024), S); }
                else { S = mfma32(kf[2], qf[2], S); S = mfma32(kf[3], qf[3], S); }
                ATT_PRIO_LO;
#pragma unroll
                for (int i = 0; i < 16; ++i) {
#if defined(ATTN_DUP) && ATTN_DUP
                    float x2 = S[i]; asm volatile("" : "+v"(x2)); const float e2 = __builtin_amdgcn_exp2f(x2); S[i] = 0.5f * (__builtin_amdgcn_exp2f(S[i]) + e2);
#else
                    S[i] = __builtin_amdgcn_exp2f(S[i]);
#endif
                    }
#pragma unroll
#if ATT_SCALAR_SUM
                for (int i = 0; i < 16; i += 2) { asm("v_add_f32 %0, %0, %1" : "+v"(l1v.x) : "v"(S[i])); asm("v_add_f32 %0, %0, %1" : "+v"(l1v.y) : "v"(S[i + 1])); }
#else
                for (int i = 0; i < 16; i += 2) l1v += (f32x2){S[i], S[i + 1]};
#endif
                const bf16x8 p0 = pack_step<0>(S), p1 = pack_step<1>(S);
                ATT_PRIO_HI;
#pragma unroll
                for (int d = 0; d < 2; ++d) { O1[d] = mfma32(vf[d][0], p0, O1[d]); O1[d] = mfma32(vf[d][1], p1, O1[d]); }
                ATT_PRIO_LO; }
        }
        if (t + 1 < ntile) {
#pragma unroll
            for (int i = 0; i < NP; ++i) { *(LAS u32x4*)(KB + (buf ^ 1) * KTB + (srow + 64 * i) * AP + sch * 16) = kreg[i]; *(LAS u32x4*)(VB + (buf ^ 1) * VTB + srow * VPB + (sch + 8 * i) * 16) = vreg[i]; } }
        if (cv_on && cv_tr == 1) cv_stage(F, cvv);
        __syncthreads();
    }
#if ATT_STATIC_PRIO
    __builtin_amdgcn_s_setprio(0);
#endif
    const GAS float* subw = (const GAS float*)ao.subw; GAS bf16_t* mixp = (GAS bf16_t*)ao.mix;
    asm volatile("" : "+s"(subw)); asm volatile("" : "+s"(mixp));
    float l0 = l0v.x + l0v.y, l1 = l1v.x + l1v.y;
    if (G2) {
        l0 += __shfl_xor(l0, 32); l1 += __shfl_xor(l1, 32);
        GAS float* po = (GAS float*)ao.po; GAS float* pl = (GAS float*)ao.pl;
        asm volatile("" : "+s"(po)); asm volatile("" : "+s"(pl));
        if (h == 0) { pl[qrow] = l0; pl[(size_t)NT + qrow] = l1; }
#pragma unroll
        for (int d = 0; d < 2; ++d)
#pragma unroll
            for (int gq = 0; gq < 4; ++gq) { const int dd = d * 32 + 8 * gq + 4 * h;
                *(GAS f32x4*)(po + (size_t)qrow * 64 + dd) = (f32x4){O0[d][4 * gq], O0[d][4 * gq + 1], O0[d][4 * gq + 2], O0[d][4 * gq + 3]};
                *(GAS f32x4*)(po + (size_t)NT * 64 + (size_t)qrow * 64 + dd) = (f32x4){O1[d][4 * gq], O1[d][4 * gq + 1], O1[d][4 * gq + 2], O1[d][4 * gq + 3]}; }
        return; }
    l0 += __shfl_xor(l0, 32); const float i0 = 1.f / l0;
    float i1 = 0.f; if (DIFF) { l1 += __shfl_xor(l1, 32); i1 = ao.lam / l1; }
    float ss = 0.f;
#pragma unroll
    for (int d = 0; d < 2; ++d)
#pragma unroll
        for (int i = 0; i < 16; ++i) { float v = O0[d][i] * i0; if (DIFF) v -= O1[d][i] * i1; O0[d][i] = v; ss += v * v; }
    float sc = 1.f;
    if (DIFF) { ss += __shfl_xor(ss, 32); sc = __builtin_amdgcn_rsqf(ss * (1.f / 64.f) + EPS) * ao.outscale; }
    GAS bf16_t* orow = mixp + (size_t)qrow * DM + ao.col0;
#pragma unroll
    for (int d = 0; d < 2; ++d)
#pragma unroll
        for (int gq = 0; gq < 4; ++gq) { const int dd = d * 32 + 8 * gq + 4 * h; float o[4];
#pragma unroll
            for (int j = 0; j < 4; ++j) { o[j] = O0[d][4 * gq + j] * sc; if (DIFF) o[j] *= subw[dd + j]; }
            u32x2 w; w[0] = pk2(o[0], o[1]); w[1] = pk2(o[2], o[3]); *(GAS u32x2*)(orow + dd) = w; }
}
DI void attn_item_diff2(const Frame& F, const bf16_t* Q, const bf16_t* K, const bf16_t* Vt, int q0, int nkeys, const AttnOut& ao) {
    LAS unsigned char* KB = F.lds;
    LAS unsigned char* VB = F.lds + 2 * 64 * AP;
    const int tid = F.tid, lane = F.lane, r = lane & 31, h = lane >> 5;
    const int qrow = q0 + F.wave * 32 + r;
    bf16x8 qf[4];
#pragma unroll
    for (int j = 0; j < 4; ++j) qf[j] = ld8g(Q + (size_t)qrow * 64 + j * 16 + 8 * h);
    const f32x16 zero16 = splat16(0.f);
    f32x16 O0[2], O1[2]; float l0 = 0.f, l1 = 0.f;
#pragma unroll
    for (int dd = 0; dd < 2; ++dd) { O0[dd] = zero16; O1[dd] = zero16; }
    const int srow = tid >> 3, sch = tid & 7;
    const bf16_t* kg = K + (size_t)srow * 64 + sch * 8; const bf16_t* vg = Vt + (size_t)srow * NT + sch * 8;
    const int ntile = nkeys >> 6;
    u32x4 kreg = *(const u32x4*)kg, vreg = *(const u32x4*)vg;
    __syncthreads();
    *(LAS u32x4*)(KB + srow * AP + sch * 16) = kreg; *(LAS u32x4*)(VB + srow * AP + sch * 16) = vreg;
    __syncthreads();
    const int krow = kperm(r);
    asm volatile("" :: "v"(qf[0]), "v"(qf[1]), "v"(qf[2]), "v"(qf[3]));
#pragma clang loop unroll(disable)
    for (int t = 0; t < ntile; ++t) {
        const int buf = t & 1;
        if (t + 1 < ntile) { kreg = *(const u32x4*)(kg + (size_t)(t + 1) * 64 * 64); vreg = *(const u32x4*)(vg + (size_t)(t + 1) * 64); }
        const LAS unsigned char* kb = KB + buf * 64 * AP; const LAS unsigned char* vb = VB + buf * 64 * AP;
        bf16x8 kfa[4], kfb[4], vfa[2][2], vfb[2][2];
#pragma unroll
        for (int j = 0; j < 4; ++j) kfa[j] = *(const LAS bf16x8*)(kb + krow * AP + j * 32 + h * 16);
#pragma unroll
        for (int dd = 0; dd < 2; ++dd)
#pragma unroll
            for (int s = 0; s < 2; ++s) vfa[dd][s] = *(const LAS bf16x8*)(vb + (dd * 32 + r) * AP + (s * 16 + h * 8) * 2);
        {   f32x16 S = mfma32(kfa[0], qf[0], zero16); S = mfma32(kfa[1], qf[1], S);
#pragma unroll
            for (int j = 0; j < 4; ++j) kfb[j] = *(const LAS bf16x8*)(kb + (32 + krow) * AP + j * 32 + h * 16);
#pragma unroll
            for (int i = 0; i < 16; ++i) { S[i] = __builtin_amdgcn_exp2f(S[i]); l0 += S[i]; }
            const bf16x8 p0 = pack_step<0>(S), p1 = pack_step<1>(S);

#pragma unroll
            for (int dd = 0; dd < 2; ++dd) { O0[dd] = mfma32(vfa[dd][0], p0, O0[dd]); O0[dd] = mfma32(vfa[dd][1], p1, O0[dd]); } }
        {   f32x16 S = mfma32(kfa[2], qf[2], zero16); S = mfma32(kfa[3], qf[3], S);
#pragma unroll
            for (int dd = 0; dd < 2; ++dd)
#pragma unroll
                for (int s = 0; s < 2; ++s) vfb[dd][s] = *(const LAS bf16x8*)(vb + (dd * 32 + r) * AP + (32 + s * 16 + h * 8) * 2);
#pragma unroll
            for (int i = 0; i < 16; ++i) { S[i] = __builtin_amdgcn_exp2f(S[i]); l1 += S[i]; }
            const bf16x8 p0 = pack_step<0>(S), p1 = pack_step<1>(S);

#pragma unroll
            for (int dd = 0; dd < 2; ++dd) { O1[dd] = mfma32(vfa[dd][0], p0, O1[dd]); O1[dd] = mfma32(vfa[dd][1], p1, O1[dd]); } }
        {   f32x16 S = mfma32(kfb[0], qf[0], zero16); S = mfma32(kfb[1], qf[1], S);
#pragma unroll
            for (int i = 0; i < 16; ++i) { S[i] = __builtin_amdgcn_exp2f(S[i]); l0 += S[i]; }
            const bf16x8 p0 = pack_step<0>(S), p1 = pack_step<1>(S);

#pragma unroll
            for (int dd = 0; dd < 2; ++dd) { O0[dd] = mfma32(vfb[dd][0], p0, O0[dd]); O0[dd] = mfma32(vfb[dd][1], p1, O0[dd]); } }
        {   f32x16 S = mfma32(kfb[2], qf[2], zero16); S = mfma32(kfb[3], qf[3], S);
#pragma unroll
            for (int i = 0; i < 16; ++i) { S[i] = __builtin_amdgcn_exp2f(S[i]); l1 += S[i]; }
            const bf16x8 p0 = pack_step<0>(S), p1 = pack_step<1>(S);

#pragma unroll
            for (int dd = 0; dd < 2; ++dd) { O1[dd] = mfma32(vfb[dd][0], p0, O1[dd]); O1[dd] = mfma32(vfb[dd][1], p1, O1[dd]); } }
        if (t + 1 < ntile) { *(LAS u32x4*)(KB + (buf ^ 1) * 64 * AP + srow * AP + sch * 16) = kreg; *(LAS u32x4*)(VB + (buf ^ 1) * 64 * AP + srow * AP + sch * 16) = vreg; }
        __syncthreads();
    }
    const GAS float* subw = (const GAS float*)ao.subw; GAS bf16_t* mixp = (GAS bf16_t*)ao.mix;
    asm volatile("" : "+s"(subw)); asm volatile("" : "+s"(mixp));
    l0 += __shfl_xor(l0, 32); l1 += __shfl_xor(l1, 32);
    const float i0 = 1.f / l0, i1 = ao.lam / l1;
    float ss = 0.f;
#pragma unroll
    for (int dd = 0; dd < 2; ++dd)
#pragma unroll
        for (int i = 0; i < 16; ++i) { const float v = O0[dd][i] * i0 - O1[dd][i] * i1; O0[dd][i] = v; ss += v * v; }
    ss += __shfl_xor(ss, 32);
    const float sc = __builtin_amdgcn_rsqf(ss * (1.f / 64.f) + EPS) * ao.outscale;
    GAS bf16_t* orow = mixp + (size_t)qrow * DM + ao.col0;
#pragma unroll
    for (int dd = 0; dd < 2; ++dd)
#pragma unroll
        for (int gq = 0; gq < 4; ++gq) { const int dcol = dd * 32 + 8 * gq + 4 * h; float o[4];
#pragma unroll
            for (int j = 0; j < 4; ++j) o[j] = O0[dd][4 * gq + j] * sc * subw[dcol + j];
            u32x2 w; w[0] = pk2(o[0], o[1]); w[1] = pk2(o[2], o[3]); *(GAS u32x2*)(orow + dcol) = w; }
}
constexpr int G3_KP = 144, G3_VP = 528;
constexpr int G3_KB = 256 * G3_KP, G3_VB = 64 * G3_VP;
DI void attn_item_gqa3(const Frame& F, const bf16_t* Q, const bf16_t* K, const bf16_t* Vt, int q0, int nkeys, const AttnOut& ao) {
    LAS unsigned char* KB = F.lds;
    LAS unsigned char* VB = F.lds + 2 * G3_KB;
    const int tid = F.tid, lane = F.lane, r = lane & 31, h = lane >> 5;
    const int qrow = q0 + F.wave * 32 + r;
    bf16x8 qf[4];
#pragma unroll
    for (int j = 0; j < 4; ++j) qf[j] = ld8g(Q + (size_t)qrow * 64 + j * 16 + 8 * h);
    const f32x16 zero16 = splat16(0.f);
    f32x16 O[2]; O[0] = zero16; O[1] = zero16;
    float l0 = 0.f;
    const int kr = tid >> 3, kc = tid & 7, vr = tid >> 5, vc = tid & 31;
    const bf16_t* kg = K + (size_t)kr * 64 + kc * 8; const bf16_t* vg = Vt + (size_t)vr * NT + vc * 8;
    const int kdst = kr * G3_KP + kc * 16, vdst = vr * G3_VP + vc * 16;
    const int ntile = nkeys >> 8;
    u32x4 sreg[4];
    __syncthreads();
#pragma unroll
    for (int i = 0; i < 4; ++i) sreg[i] = *(const u32x4*)(kg + (size_t)i * 64 * 64);
#pragma unroll
    for (int i = 0; i < 4; ++i) *(LAS u32x4*)(KB + kdst + i * 64 * G3_KP) = sreg[i];
#pragma unroll
    for (int i = 0; i < 4; ++i) sreg[i] = *(const u32x4*)(vg + (size_t)i * 16 * NT);
#pragma unroll
    for (int i = 0; i < 4; ++i) *(LAS u32x4*)(VB + vdst + i * 16 * G3_VP) = sreg[i];
    __syncthreads();
    const int koff = kperm(r) * G3_KP + h * 16, voff = r * G3_VP + h * 16;
    asm volatile("" :: "v"(qf[0]), "v"(qf[1]), "v"(qf[2]), "v"(qf[3]));
#pragma clang loop unroll(disable)
    for (int t = 0; t < ntile; ++t) {
        const int buf = t & 1;
        const bool more = t + 1 < ntile;
        if (more) {
#pragma unroll
            for (int i = 0; i < 4; ++i) sreg[i] = *(const u32x4*)(kg + ((size_t)(t + 1) * 256 + i * 64) * 64); }
        const LAS unsigned char* kb = KB + buf * G3_KB + koff; const LAS unsigned char* vb = VB + buf * G3_VB + voff;
        f32x16 Sc = zero16; bf16x8 pp0, pp1;
#pragma unroll
        for (int j = 0; j < 4; ++j) Sc = mfma32(*(const LAS bf16x8*)(kb + j * 32), qf[j], j ? Sc : zero16);
#pragma unroll
        for (int u = 0; u < 8; ++u) {
            f32x16 Sn = zero16;
            if (u + 1 < 8) {
#pragma unroll
                for (int j = 0; j < 4; ++j) Sn = mfma32(*(const LAS bf16x8*)(kb + (u + 1) * 32 * G3_KP + j * 32), qf[j], j ? Sn : zero16); }
            float ls = 0.f;
#pragma unroll
            for (int i = 0; i < 16; ++i) { Sc[i] = __builtin_amdgcn_exp2f(Sc[i]); ls += Sc[i]; }
            l0 += ls;
            const bf16x8 pc0 = pack_step<0>(Sc), pc1 = pack_step<1>(Sc);
            if (u > 0) {
#pragma unroll
                for (int dd = 0; dd < 2; ++dd) { O[dd] = mfma32(*(const LAS bf16x8*)(vb + dd * 32 * G3_VP + (u - 1) * 64), pp0, O[dd]); O[dd] = mfma32(*(const LAS bf16x8*)(vb + dd * 32 * G3_VP + (u - 1) * 64 + 32), pp1, O[dd]); } }
#pragma unroll
            for (int g = 0; g < 8; ++g) { __builtin_amdgcn_sched_group_barrier(0x8, 1, 0); __builtin_amdgcn_sched_group_barrier(0x2, 5, 0); }
            pp0 = pc0; pp1 = pc1; Sc = Sn;
            if (u == 3 && more) {
#pragma unroll
                for (int i = 0; i < 4; ++i) *(LAS u32x4*)(KB + (buf ^ 1) * G3_KB + kdst + i * 64 * G3_KP) = sreg[i];
#pragma unroll
                for (int i = 0; i < 4; ++i) sreg[i] = *(const u32x4*)(vg + (size_t)(t + 1) * 256 + (size_t)i * 16 * NT); }
        }
#pragma unroll
        for (int dd = 0; dd < 2; ++dd) { O[dd] = mfma32(*(const LAS bf16x8*)(vb + dd * 32 * G3_VP + 7 * 64), pp0, O[dd]); O[dd] = mfma32(*(const LAS bf16x8*)(vb + dd * 32 * G3_VP + 7 * 64 + 32), pp1, O[dd]); }
        if (more) {
#pragma unroll
            for (int i = 0; i < 4; ++i) *(LAS u32x4*)(VB + (buf ^ 1) * G3_VB + vdst + i * 16 * G3_VP) = sreg[i]; }
        __syncthreads();
    }
    GAS bf16_t* mixp = (GAS bf16_t*)ao.mix;
    asm volatile("" : "+s"(mixp));
    l0 += __shfl_xor(l0, 32); const float i0 = 1.f / l0;
    GAS bf16_t* orow = mixp + (size_t)qrow * DM + ao.col0;
#pragma unroll
    for (int dd = 0; dd < 2; ++dd)
#pragma unroll
        for (int gq = 0; gq < 4; ++gq) { const int dcol = dd * 32 + 8 * gq + 4 * h;
            u32x2 w; w[0] = pk2(O[dd][4 * gq] * i0, O[dd][4 * gq + 1] * i0); w[1] = pk2(O[dd][4 * gq + 2] * i0, O[dd][4 * gq + 3] * i0); *(GAS u32x2*)(orow + dcol) = w; }
}
#define FENCE __builtin_amdgcn_sched_barrier(0)
#define G4_UNIT(u, HASQK, HASPV) do { \
            f32x16 Sn = zero16; \
            if (HASQK) Sn = mfma32(kfA[0], qf[0], zero16); \
            FENCE; Sc[0] = __builtin_amdgcn_exp2f(Sc[0]); Sc[1] = __builtin_amdgcn_exp2f(Sc[1]); Sc[2] = __builtin_amdgcn_exp2f(Sc[2]); FENCE; \
            if (HASQK) Sn = mfma32(kfA[1], qf[1], Sn); \
            FENCE; Sc[3] = __builtin_amdgcn_exp2f(Sc[3]); Sc[4] = __builtin_amdgcn_exp2f(Sc[4]); Sc[5] = __builtin_amdgcn_exp2f(Sc[5]); FENCE; \
            if (HASQK) Sn = mfma32(kfA[2], qf[2], Sn); \
            FENCE; Sc[6] = __builtin_amdgcn_exp2f(Sc[6]); Sc[7] = __builtin_amdgcn_exp2f(Sc[7]); Sc[8] = __builtin_amdgcn_exp2f(Sc[8]); FENCE; \
            if (HASQK) Sn = mfma32(kfA[3], qf[3], Sn); \
            FENCE; \
            if (HASQK) { _Pragma("unroll") for (int j = 0; j < 4; ++j) kfA[j] = *(const LAS bf16x8*)(kb + (((u) + 2) & 7) * 32 * G3_KP + j * 32); } \
            Sc[9] = __builtin_amdgcn_exp2f(Sc[9]); Sc[10] = __builtin_amdgcn_exp2f(Sc[10]); Sc[11] = __builtin_amdgcn_exp2f(Sc[11]); FENCE; \
            if (HASPV) O[0] = mfma32(vfA[0], pp0, O[0]); \
            FENCE; Sc[12] = __builtin_amdgcn_exp2f(Sc[12]); Sc[13] = __builtin_amdgcn_exp2f(Sc[13]); Sc[14] = __builtin_amdgcn_exp2f(Sc[14]); FENCE; \
            if (HASPV) O[0] = mfma32(vfA[1], pp1, O[0]); \
            FENCE; Sc[15] = __builtin_amdgcn_exp2f(Sc[15]); \
            l0 += (Sc[0] + Sc[1]) + (Sc[2] + Sc[3]); l1 += (Sc[4] + Sc[5]) + (Sc[6] + Sc[7]); FENCE; \
            if (HASPV) O[1] = mfma32(vfA[2], pp0, O[1]); \
            FENCE; l0 += (Sc[8] + Sc[9]) + (Sc[10] + Sc[11]); l1 += (Sc[12] + Sc[13]) + (Sc[14] + Sc[15]); \
            u32x4 pa; pa[0] = pk2(Sc[0], Sc[1]); pa[1] = pk2(Sc[2], Sc[3]); FENCE; \
            if (HASPV) O[1] = mfma32(vfA[3], pp1, O[1]); \
            FENCE; pa[2] = pk2(Sc[4], Sc[5]); pa[3] = pk2(Sc[6], Sc[7]); \
            u32x4 pb; pb[0] = pk2(Sc[8], Sc[9]); pb[1] = pk2(Sc[10], Sc[11]); pb[2] = pk2(Sc[12], Sc[13]); pb[3] = pk2(Sc[14], Sc[15]); FENCE; \
            pp0 = __builtin_bit_cast(bf16x8, pa); pp1 = __builtin_bit_cast(bf16x8, pb); Sc = Sn; \
            _Pragma("unroll") for (int j = 0; j < 4; ++j) vfA[j] = *(const LAS bf16x8*)(vb + (j >> 1) * 32 * G3_VP + (u) * 64 + (j & 1) * 32); \
            FENCE; } while (0)
DI void attn_item_gqa4(const Frame& F, const bf16_t* Q, const bf16_t* K, const bf16_t* Vt, int q0, int nkeys, const AttnOut& ao) {
    LAS unsigned char* KB = F.lds;
    LAS unsigned char* VB = F.lds + 2 * G3_KB;
    const int tid = F.tid, lane = F.lane, r = lane & 31, h = lane >> 5;
    const int qrow = q0 + F.wave * 32 + r;
    bf16x8 qf[4];
#pragma unroll
    for (int j = 0; j < 4; ++j) qf[j] = ld8g(Q + (size_t)qrow * 64 + j * 16 + 8 * h);
    const f32x16 zero16 = splat16(0.f);
    f32x16 O[2]; O[0] = zero16; O[1] = zero16;
    float l0 = 0.f, l1 = 0.f;
    const int kr = tid >> 3, kc = tid & 7, vr = tid >> 5, vc = tid & 31;
    const bf16_t* kg = K + (size_t)kr * 64 + kc * 8; const bf16_t* vg = Vt + (size_t)vr * NT + vc * 8;
    const int kdst = kr * G3_KP + kc * 16, vdst = vr * G3_VP + vc * 16;
    const int ntile = nkeys >> 8;
    u32x4 sreg[4];
    __syncthreads();
#pragma unroll
    for (int i = 0; i < 4; ++i) sreg[i] = *(const u32x4*)(kg + (size_t)i * 64 * 64);
#pragma unroll
    for (int i = 0; i < 4; ++i) *(LAS u32x4*)(KB + kdst + i * 64 * G3_KP) = sreg[i];
#pragma unroll
    for (int i = 0; i < 4; ++i) sreg[i] = *(const u32x4*)(vg + (size_t)i * 16 * NT);
#pragma unroll
    for (int i = 0; i < 4; ++i) *(LAS u32x4*)(VB + vdst + i * 16 * G3_VP) = sreg[i];
    __syncthreads();
    const int koff = kperm(r) * G3_KP + h * 16, voff = r * G3_VP + h * 16;
    asm volatile("" :: "v"(qf[0]), "v"(qf[1]), "v"(qf[2]), "v"(qf[3]));
#pragma clang loop unroll(disable)
    for (int t = 0; t < ntile; ++t) {
        const int buf = t & 1;
        const bool more = t + 1 < ntile;
        if (more) {
#pragma unroll
            for (int i = 0; i < 4; ++i) sreg[i] = *(const u32x4*)(kg + ((size_t)(t + 1) * 256 + i * 64) * 64); }
        const LAS unsigned char* kb = KB + buf * G3_KB + koff; const LAS unsigned char* vb = VB + buf * G3_VB + voff;
        bf16x8 kfA[4], kfB[4], vfA[4], pp0, pp1;
#pragma unroll
        for (int j = 0; j < 4; ++j) kfB[j] = *(const LAS bf16x8*)(kb + j * 32);
#pragma unroll
        for (int j = 0; j < 4; ++j) kfA[j] = *(const LAS bf16x8*)(kb + 32 * G3_KP + j * 32);
        f32x16 Sc = mfma32(kfB[0], qf[0], zero16); Sc = mfma32(kfB[1], qf[1], Sc); Sc = mfma32(kfB[2], qf[2], Sc); Sc = mfma32(kfB[3], qf[3], Sc);
        FENCE;
        G4_UNIT(0, true, false);
#pragma clang loop unroll(disable)
        for (int u = 1; u < 7; ++u) {
            G4_UNIT(u, true, true);
            if (u == 3 && more) {
#pragma unroll
                for (int i = 0; i < 4; ++i) *(LAS u32x4*)(KB + (buf ^ 1) * G3_KB + kdst + i * 64 * G3_KP) = sreg[i];
#pragma unroll
                for (int i = 0; i < 4; ++i) sreg[i] = *(const u32x4*)(vg + (size_t)(t + 1) * 256 + (size_t)i * 16 * NT); }
        }
        G4_UNIT(7, false, true);
        O[0] = mfma32(vfA[0], pp0, O[0]); O[0] = mfma32(vfA[1], pp1, O[0]); O[1] = mfma32(vfA[2], pp0, O[1]); O[1] = mfma32(vfA[3], pp1, O[1]);
        if (more) {
#pragma unroll
            for (int i = 0; i < 4; ++i) *(LAS u32x4*)(VB + (buf ^ 1) * G3_VB + vdst + i * 16 * G3_VP) = sreg[i]; }
        __syncthreads();
    }
    GAS bf16_t* mixp = (GAS bf16_t*)ao.mix;
    asm volatile("" : "+s"(mixp));
    int lz = 0; asm volatile("" : "+v"(lz));
    const int lane2 = (int)__builtin_amdgcn_mbcnt_hi(~0u, __builtin_amdgcn_mbcnt_lo(~0u, 0u)) + lz, h2 = lane2 >> 5, qrow2 = q0 + F.wave * 32 + (lane2 & 31);
    l0 += l1; l0 += __shfl_xor(l0, 32); const float i0 = 1.f / l0;
    GAS bf16_t* orow = mixp + (size_t)qrow2 * DM + ao.col0;
#pragma unroll
    for (int dd = 0; dd < 2; ++dd)
#pragma unroll
        for (int gq = 0; gq < 4; ++gq) { const int dcol = dd * 32 + 8 * gq + 4 * h2;
            u32x2 w; w[0] = pk2(O[dd][4 * gq] * i0, O[dd][4 * gq + 1] * i0); w[1] = pk2(O[dd][4 * gq + 2] * i0, O[dd][4 * gq + 3] * i0); *(GAS u32x2*)(orow + dcol) = w; }
}
DI void p4_attn_diff(const Frame& F, int l, int it) {
    const bool isctx = it >= 256; const int hd = isctx ? it - 256 : it & 3, qb = isctx ? 0 : it >> 2;
    const unsigned* km = WSP(unsigned, WS_CTL) + CW_KMAX + l * 32;
    const float km0 = sqrtf(__uint_as_float(__hip_atomic_load(km + hd * 2, __ATOMIC_RELAXED, __HIP_MEMORY_SCOPE_AGENT)));
    const float km1 = sqrtf(__uint_as_float(__hip_atomic_load(km + hd * 2 + 1, __ATOMIC_RELAXED, __HIP_MEMORY_SCOPE_AGENT)));
    const float lam_init = 0.8f - 0.6f * __expf(-0.3f * (float)l);
    AttnOut ao; ao.mix = WSP(bf16_t, WS_MIX); ao.col0 = hd * 64; ao.lam = WSP(float, WS_LAM)[l]; ao.outscale = 1.f - lam_init; ao.subw = ((const float*)F.in[I_SUBLN]) + (size_t)l * 64;
    const float qm0 = sqrtf(__uint_as_float(__hip_atomic_load(km + 10 + hd * 2, __ATOMIC_RELAXED, __HIP_MEMORY_SCOPE_AGENT))), qm1 = sqrtf(__uint_as_float(__hip_atomic_load(km + 10 + hd * 2 + 1, __ATOMIC_RELAXED, __HIP_MEMORY_SCOPE_AGENT)));
    if (false && qm0 * km0 <= 100.f && qm1 * km1 <= 100.f)
        attn_item_diff2(F, WSP(bf16_t, WS_QD) + (size_t)hd * NT * 64, WSP(bf16_t, WS_KD) + (size_t)hd * NT * 64, WSP(bf16_t, WS_VTD) + (size_t)hd * 64 * NT, isctx ? 0 : CTX + qb * 256, isctx ? CTX : NT, ao);
    else
    attn_item<true, DIFF_KT>(F, WSP(bf16_t, WS_QD) + (size_t)hd * NT * 64, WSP(bf16_t, WS_KD) + (size_t)hd * NT * 64, WSP(bf16_t, WS_VTD) + (size_t)hd * 64 * NT,
                    WSP(float, WS_QND) + (size_t)(hd * 2) * NT, WSP(float, WS_QND) + (size_t)(hd * 2 + 1) * NT, km0, km1, isctx ? 0 : CTX + qb * 256, isctx ? CTX : NT, ao);
}
#ifndef GQA_KT_V
#define GQA_KT_V 64
#endif
constexpr int GQA_KT = GQA_KT_V;
DI bool gqa_fast_ok(const Frame& F, int l) {
    const unsigned* km = WSP(unsigned, WS_CTL) + CW_KMAX + l * 32; bool ok = true;
    for (int hq = 0; hq < 4; ++hq) { const float k = sqrtf(__uint_as_float(__hip_atomic_load(km + 8 + (hq >> 1), __ATOMIC_RELAXED, __HIP_MEMORY_SCOPE_AGENT))), q = sqrtf(__uint_as_float(__hip_atomic_load(km + 18 + hq, __ATOMIC_RELAXED, __HIP_MEMORY_SCOPE_AGENT)));
        ok = ok && (q * k <= 100.f); }
    return ok;
}
constexpr size_t GQ_PL_OFF = (size_t)2 * 4 * NT * 64 * 4;
DI void p4_attn_gqa2(const Frame& F, int l, int it) {
    const int qb = it >> 2, g = (it >> 1) & 1, kh = it & 1, k0 = kh * (NT / 2);
    AttnOut ao; ao.mix = nullptr; ao.col0 = 0; ao.lam = 0.f; ao.outscale = 1.f; ao.subw = nullptr;
    ao.po = WSP(float, WS_ACT) + ((size_t)(kh * 4 + 2 * g) * NT) * 64; ao.pl = (float*)(F.ws + WS_ACT + GQ_PL_OFF) + (size_t)(kh * 4 + 2 * g) * NT;
    const unsigned* km = WSP(unsigned, WS_CTL) + CW_KMAX + l * 32;
    const float km0 = sqrtf(__uint_as_float(__hip_atomic_load(km + 8 + g, __ATOMIC_RELAXED, __HIP_MEMORY_SCOPE_AGENT)));
    attn_item<true, 64, true>(F, WSP(bf16_t, WS_QG) + (size_t)(2 * g) * NT * 64, WSP(bf16_t, WS_KG) + (size_t)g * NT * 64 + (size_t)k0 * 64, WSP(bf16_t, WS_VTG) + (size_t)g * 64 * NT + k0,
                              WSP(float, WS_QNG) + (size_t)(2 * g) * NT, WSP(float, WS_QNG) + (size_t)(2 * g + 1) * NT, km0, km0, CTX + qb * 256, NT / 2, ao, l);
}
template <bool FAST>
DI void p4_attn_gqa(const Frame& F, int l, int it) {
    const bool isctx = it >= 256; const int hq = isctx ? it - 256 : it & 3, qb = isctx ? 0 : it >> 2, g = hq >> 1;
    AttnOut ao; ao.mix = WSP(bf16_t, WS_MIX); ao.col0 = 768 + hq * 64; ao.lam = 0.f; ao.outscale = 1.f; ao.subw = nullptr;
    if (FAST) attn_item_gqa4(F, WSP(bf16_t, WS_QG) + (size_t)hq * NT * 64, WSP(bf16_t, WS_KG) + (size_t)g * NT * 64, WSP(bf16_t, WS_VTG) + (size_t)g * 64 * NT, isctx ? 0 : CTX + qb * 256, isctx ? CTX : NT, ao);
    else { const unsigned* km = WSP(unsigned, WS_CTL) + CW_KMAX + l * 32;
        const float km0 = sqrtf(__uint_as_float(__hip_atomic_load(km + 8 + g, __ATOMIC_RELAXED, __HIP_MEMORY_SCOPE_AGENT)));
        attn_item<false, GQA_KT>(F, WSP(bf16_t, WS_QG) + (size_t)hq * NT * 64, WSP(bf16_t, WS_KG) + (size_t)g * NT * 64, WSP(bf16_t, WS_VTG) + (size_t)g * 64 * NT,
                         WSP(float, WS_QNG) + (size_t)hq * NT, nullptr, km0, 0.f, isctx ? 0 : CTX + qb * 256, isctx ? CTX : NT, ao, isctx ? -1 : l); }
}

DI void p4_ssd_out(const Frame& F, int l, int item) {
    const int c = item >> 1, lh = item & 1;
    LAS float* DTL = (LAS float*)(F.lds + 96 * 1024);
    LAS float* CML = DTL + 8 * 128;
    const int tid = F.tid, lane = F.lane, r = lane & 31, h = lane >> 5, tok0 = c * 128;
    __syncthreads();
    for (int i = tid; i < 1024; i += 512) { DTL[i] = WSP(float, WS_DTV)[(size_t)c * 1024 + i]; CML[i] = WSP(float, WS_CUM)[(size_t)c * 1024 + i]; }
    __syncthreads();
    const int hh = F.wave >> 1, g = hh >> 1;
    const float Dh = ((const float*)F.in[I_SSDD])[(size_t)l * 4 + hh];
    const bf16_t* CN = WSP(bf16_t, WS_CN); const bf16_t* BN = WSP(bf16_t, WS_BN);
    const bf16_t* XS = WSP(bf16_t, WS_XST) + ((size_t)c * 256 + hh * 64) * 128;
    { const int lt = F.wave & 1;
        const int ll = 64 * lh + 32 * lt + r;
        bf16x8 cfr[8];
#pragma unroll
        for (int ks = 0; ks < 8; ++ks) cfr[ks] = ld8g(CN + (size_t)(tok0 + ll) * 256 + g * 128 + ks * 16 + 8 * h);
        const bf16_t* zr0 = WSP(bf16_t, WS_U) + (size_t)(tok0 + ll) * NU + U_Z + hh * 64;
        u32x2 zzv[2][4];
#pragma unroll
        for (int pt = 0; pt < 2; ++pt)
#pragma unroll
            for (int gq = 0; gq < 4; ++gq) zzv[pt][gq] = *(const u32x2*)(zr0 + pt * 32 + 8 * gq + 4 * h);
        const bf16_t* bnp = BN + (size_t)(tok0 + kperm(r)) * 256 + g * 128 + 8 * h;
        const bf16_t* xsp = XS + (size_t)r * 128 + 8 * h;
        bf16x8 bn[8], xs[4], bnn[8], xsn[4], sf0[2][8];
#pragma unroll
        for (int ks = 0; ks < 8; ++ks) bn[ks] = ld8g(bnp + ks * 16);
#pragma unroll
        for (int q = 0; q < 4; ++q) xs[q] = ld8g(xsp + (size_t)(q >> 1) * 32 * 128 + 16 * (q & 1));
        const float cfl = CML[hh * 128 + ll], cbl = CML[(4 + hh) * 128 + ll], dsum = DTL[hh * 128 + ll] + DTL[(4 + hh) * 128 + ll];
        f32x16 Y[2];
        Y[0] = splat16(0.f); Y[1] = splat16(0.f);
        const bf16_t* S0 = WSP(bf16_t, WS_SIN) + ((size_t)c * 8 + hh) * 8192 + (size_t)r * 128 + 8 * h;
#pragma unroll
        for (int st = 0; st < 4; ++st) {
            if (st < 3) {
#pragma unroll
                for (int ks = 0; ks < 8; ++ks) bnn[ks] = ld8g(bnp + (size_t)(st + 1) * 32 * 256 + ks * 16);
#pragma unroll
                for (int q = 0; q < 4; ++q) xsn[q] = ld8g(xsp + (size_t)(q >> 1) * 32 * 128 + 32 * (st + 1) + 16 * (q & 1));
            } else {
#pragma unroll
                for (int pt = 0; pt < 2; ++pt)
#pragma unroll
                    for (int ks = 0; ks < 8; ++ks) sf0[pt][ks] = ld8g(S0 + (size_t)pt * 32 * 128 + ks * 16);
            }
            f32x16 G = splat16(0.f);
#pragma unroll
            for (int ks = 0; ks < 8; ++ks) G = mfma32(bn[ks], cfr[ks], G);
#pragma unroll
            for (int i = 0; i < 16; ++i) { const int s = 32 * st + kperm(crow(i, h));
                const float cfs = CML[hh * 128 + s], cbs = CML[(4 + hh) * 128 + s], dfs = DTL[hh * 128 + s], dbs = DTL[(4 + hh) * 128 + s];
                float fac;
                if (s < ll) fac = dfs * __builtin_amdgcn_exp2f(cfl - cfs);
                else if (s > ll) fac = dbs * __builtin_amdgcn_exp2f(cbl - cbs);
                else fac = dsum;
                G[i] = G[i] * fac + (s == ll ? Dh : 0.f); }
            const bf16x8 m0 = pack_step<0>(G), m1 = pack_step<1>(G);
#pragma unroll
            for (int pt = 0; pt < 2; ++pt) { Y[pt] = mfma32(xs[pt * 2], m0, Y[pt]); Y[pt] = mfma32(xs[pt * 2 + 1], m1, Y[pt]); }
            if (st < 3) {
#pragma unroll
                for (int ks = 0; ks < 8; ++ks) bn[ks] = bnn[ks];
#pragma unroll
                for (int q = 0; q < 4; ++q) xs[q] = xsn[q]; }
        }
        { bf16x8 sf1[2][8];
#pragma unroll
          for (int pt = 0; pt < 2; ++pt)
#pragma unroll
              for (int ks = 0; ks < 8; ++ks) sf1[pt][ks] = ld8g(S0 + (size_t)4 * 8192 + (size_t)pt * 32 * 128 + ks * 16);
          const float e0 = __builtin_amdgcn_exp2f(cfl), e1 = __builtin_amdgcn_exp2f(cbl);
#pragma unroll
          for (int pt = 0; pt < 2; ++pt) { f32x16 Z = splat16(0.f);
#pragma unroll
              for (int ks = 0; ks < 8; ++ks) Z = mfma32(sf0[pt][ks], cfr[ks], Z);
              Y[pt] += Z * e0; }
#pragma unroll
          for (int pt = 0; pt < 2; ++pt) { f32x16 Z = splat16(0.f);
#pragma unroll
              for (int ks = 0; ks < 8; ++ks) Z = mfma32(sf1[pt][ks], cfr[ks], Z);
              Y[pt] += Z * e1; } }
        const int tok = tok0 + ll; float ssq = 0.f;
        bf16_t* yo = WSP(bf16_t, WS_YSSD) + (size_t)tok * 256 + hh * 64;
#pragma unroll
        for (int pt = 0; pt < 2; ++pt)
#pragma unroll
            for (int gq = 0; gq < 4; ++gq) { const int p = pt * 32 + 8 * gq + 4 * h; const u32x2 zz = zzv[pt][gq];
                const float z0 = bflo(zz[0]), z1 = bfhi(zz[0]), z2 = bflo(zz[1]), z3 = bfhi(zz[1]);
                const float y0 = Y[pt][4 * gq] * silu_f(z0), y1 = Y[pt][4 * gq + 1] * silu_f(z1), y2 = Y[pt][4 * gq + 2] * silu_f(z2), y3 = Y[pt][4 * gq + 3] * silu_f(z3);
                ssq += y0 * y0 + y1 * y1 + y2 * y2 + y3 * y3;
                u32x2 w; w[0] = pk2(y0, y1); w[1] = pk2(y2, y3); *(u32x2*)(yo + p) = w; }
        ssq += __shfl_xor(ssq, 32);
        if (h == 0) WSP(float, WS_SSQ)[(size_t)tok * 4 + hh] = ssq;
    }
}

constexpr int N_S5O = 16 * 9 * 2;
DI float gelu_tanh(float y) { const float u = 0.7978845608028654f * (y + 0.044715f * y * y * y); const float e = __builtin_amdgcn_exp2f(2.8853900817779268f * u); return y * (1.f - __builtin_amdgcn_rcpf(1.f + e)); }
constexpr int HBP = 264;
DI void p4_s5_out(const Frame& F, int l, int item) {
    const int mh = item & 1, nt = (item >> 1) % 9, g = (item >> 1) / 9, lane = F.lane, r = lane & 31, h = lane >> 5;
    s5_stage_u<false>(F, g, nt);
    LAS bf16_t* HB = (LAS bf16_t*)F.lds + 32 * UBP;
    LAS bf16_t* KTL = (LAS bf16_t*)(F.lds + 84 * 1024);
    { const bf16_t* ktg = WSP(bf16_t, WS_KTAB) + ((size_t)l * 16 + g) * 3 * 64 * 256;
      for (int i = F.tid; i < (2 * 64 * 256 + 256) / 8; i += 512) *(LAS u32x4*)(KTL + 8 * i) = *(const u32x4*)(ktg + 8 * i); }
    for (int i = F.tid; i < 32 * 32; i += 512) { const int n = i >> 5, p = i & 31; const int chunk = nt * 32 + n, cc = chunk < NC5 ? chunk : NC5 - 1;
        *(LAS u32x4*)(HB + n * HBP + 8 * p) = *(const u32x4*)(WSP(bf16_t, WS_HIN) + (size_t)cc * 4096 + g * 256 + 8 * p); }
    __syncthreads();
    const LAS bf16_t* UB = (const LAS bf16_t*)F.lds + r * UBP + 8 * h; const LAS bf16_t* HBr = HB + r * HBP + 8 * h;
    const int chunk = nt * 32 + r;
#pragma unroll 1
    for (int mi = 0; mi < 2; ++mi) {
        const int mt = mh * 16 + F.wave * 2 + mi, row = mt * 32 + r, t = row >> 4, ch = row & 15;
        const LAS bf16_t* KT = KTL + ch * 16 + 8 * h;
        const bf16_t* CC = WSP(bf16_t, WS_CC5) + ((size_t)l * 16 + g) * 1024 * 256 + ((size_t)mt * 16 * 64 + lane) * 8;
        bf16x8 ccf[16];
#pragma unroll
        for (int kc = 0; kc < 16; ++kc) ccf[kc] = ld8g(CC + kc * 512);
        f32x16 acc = splat16(0.f);
#pragma unroll 16
        for (int s = 0; s < 64; ++s) { const int sel = s < t ? 0 : (s > t ? 1 : 2), lag = s < t ? t - s : (s > t ? s - t : 0);
            acc = mfma32(*(const LAS bf16x8*)(KT + (sel * 64 + lag) * 256), *(const LAS bf16x8*)(UB + s * 16), acc); }
#pragma unroll
        for (int kc = 0; kc < 16; ++kc) acc = mfma32(ccf[kc], *(const LAS bf16x8*)(HBr + kc * 16), acc);
        if (chunk < NC5) {
#pragma unroll
            for (int gq = 0; gq < 4; ++gq) { const int rr = mt * 32 + 8 * gq + 4 * h, tt = rr >> 4, c0 = rr & 15;
                u32x2 w; w[0] = pk2(gelu_tanh(acc[4 * gq]), gelu_tanh(acc[4 * gq + 1])); w[1] = pk2(gelu_tanh(acc[4 * gq + 2]), gelu_tanh(acc[4 * gq + 3]));
                *(u32x2*)(WSP(bf16_t, WS_YS5) + (size_t)(chunk * S5L + tt) * 256 + g * 16 + c0) = w; } }
    }
}

DI void p5_finish(const Frame& F, int l) {
    const int lane = F.lane;
    { const f32x4 nw = *(const f32x4*)(((const float*)F.in[I_SSDNW]) + (size_t)l * 256 + 4 * lane);
      f32x4 q[9]; u32x2 y[9];
#pragma unroll
      for (int k = 0; k < 9; ++k) { const int r = F.wave + 8 * k, row = F.bid * RPB + (r < RPB ? r : RPB - 1), rc = row < NT ? row : NT - 1;
          q[k] = *(const f32x4*)(WSP(float, WS_SSQ) + (size_t)rc * 4); y[k] = *(const u32x2*)(WSP(bf16_t, WS_YSSD) + (size_t)rc * 256 + 4 * lane); }
#pragma unroll
      for (int k = 0; k < 9; ++k) { const int r = F.wave + 8 * k, row = F.bid * RPB + r;
          if (r < RPB && row < NT) { const float rs = __builtin_amdgcn_rsqf((q[k][0] + q[k][1] + q[k][2] + q[k][3]) * (1.f / 256.f) + EPS);
              u32x2 w; w[0] = pk2(bflo(y[k][0]) * rs * nw[0], bfhi(y[k][0]) * rs * nw[1]); w[1] = pk2(bflo(y[k][1]) * rs * nw[2], bfhi(y[k][1]) * rs * nw[3]);
              *(u32x2*)(WSP(bf16_t, WS_MIX) + (size_t)row * DM + 256 + 4 * lane) = w; } } }
    { const int hd = lane >> 4, d0 = (lane & 15) * 4;
      const float* PO = WSP(float, WS_ACT); const float* PL = (const float*)(F.ws + WS_ACT + GQ_PL_OFF);
      f32x4 oa[8], ob[8]; float la[8], lb[8];
#pragma unroll
      for (int k = 0; k < 8; ++k) { const int tok = CTX + (F.bid * 8 + F.wave) * 8 + k, tc = tok < NT ? tok : NT - 1;
          oa[k] = *(const f32x4*)(PO + ((size_t)hd * NT + tc) * 64 + d0); ob[k] = *(const f32x4*)(PO + ((size_t)(4 + hd) * NT + tc) * 64 + d0);
          la[k] = PL[(size_t)hd * NT + tc]; lb[k] = PL[(size_t)(4 + hd) * NT + tc]; }
#pragma unroll
      for (int k = 0; k < 8; ++k) { const int tok = CTX + (F.bid * 8 + F.wave) * 8 + k;
          if (tok < NT) { const float inv = __builtin_amdgcn_rcpf(la[k] + lb[k]); const f32x4 o = (oa[k] + ob[k]) * inv;
              u32x2 w; w[0] = pk2(o[0], o[1]); w[1] = pk2(o[2], o[3]);
              *(u32x2*)(WSP(bf16_t, WS_MIX) + (size_t)tok * DM + 768 + hd * 64 + d0) = w; } } }
    const int r = lane & 31, h = lane >> 5, nt = F.wave;
    const bf16_t* WG = WSP(bf16_t, WS_WGLU) + (size_t)l * 65536;
    bf16x8 wf[16];
#pragma unroll
    for (int ks = 0; ks < 16; ++ks) wf[ks] = ld8g(WG + (size_t)(nt * 32 + r) * 256 + ks * 16 + 8 * h);
    f32x4 bb[4];
#pragma unroll
    for (int gq = 0; gq < 4; ++gq) bb[gq] = *(const f32x4*)(((const float*)F.in[I_BGLU]) + (size_t)l * 256 + nt * 32 + 8 * gq + 4 * h);
    for (int mt = F.bid; mt < NT / 32; mt += F.G) {
        const bf16_t* Y = WSP(bf16_t, WS_YS5) + (size_t)(mt * 32) * 256;
        bf16x8 af[16]; u32x2 yy[4];
#pragma unroll
        for (int ks = 0; ks < 16; ++ks) af[ks] = ld8g(Y + (size_t)r * 256 + ks * 16 + 8 * h);
#pragma unroll
        for (int gq = 0; gq < 4; ++gq) yy[gq] = *(const u32x2*)(Y + (size_t)r * 256 + nt * 32 + 8 * gq + 4 * h);
        const int tok = mt * 32 + r;
        f32x16 acc = splat16(0.f);
#pragma unroll
        for (int ks = 0; ks < 16; ++ks) acc = mfma32(wf[ks], af[ks], acc);
#pragma unroll
        for (int gq = 0; gq < 4; ++gq) { const int n0 = nt * 32 + 8 * gq + 4 * h;
            u32x2 w; w[0] = pk2(bflo(yy[gq][0]) * sigmoid_f(acc[4 * gq] + bb[gq][0]), bfhi(yy[gq][0]) * sigmoid_f(acc[4 * gq + 1] + bb[gq][1]));
            w[1] = pk2(bflo(yy[gq][1]) * sigmoid_f(acc[4 * gq + 2] + bb[gq][2]), bfhi(yy[gq][1]) * sigmoid_f(acc[4 * gq + 3] + bb[gq][3]));
            *(u32x2*)(WSP(bf16_t, WS_MIX) + (size_t)tok * DM + 512 + n0) = w; }
    }
    __syncthreads();
}

#ifndef PH_MASK
#define PH_MASK 0xFFFF
#endif
#define PHEN(k) ((PH_MASK >> (k)) & 1)
#ifndef PH_REP
#define PH_REP 0
#endif
#define NREP(k) (((PH_REP >> (k)) & 1) ? 2 : 1)
#ifndef STAG_GU
#define STAG_GU 0
#endif
#ifndef STAG_DN
#define STAG_DN 0
#endif
#ifndef REP_SKIP_STORES
#define REP_SKIP_STORES 0
#endif
DI Frame launder(const Frame& F) { Frame G = F; int t = F.wave * 64 + (int)__builtin_amdgcn_mbcnt_hi(~0u, __builtin_amdgcn_mbcnt_lo(~0u, 0u)); GAS unsigned char* w = F.ws; const GAS float* const __attribute__((address_space(4)))* ip = F.in;
    int bb = F.bid, gg = F.G; LAS unsigned char* lp = F.lds; asm volatile("" : "+s"(lp)); G.lds = lp; asm volatile("" : "+v"(t)); asm volatile("" : "+s"(w)); asm volatile("" : "+s"(ip)); asm volatile("" : "+s"(bb)); asm volatile("" : "+s"(gg)); G.bid = bb; G.G = gg; G.tid = t; G.lane = t & 63; G.ws = w; G.in = ip; return G; }
DI int launder_s(int v) { asm volatile("" : "+s"(v)); return v; }
constexpr int NPL = 10, N_PHASES = 1 + DEPTH * NPL + 1;
__global__ void __launch_bounds__(512, 2) hybrid_fwd(Args args) {
    extern __shared__ __attribute__((aligned(16))) unsigned char lds_raw[];
    Frame F; F.lds = (LAS unsigned char*)lds_raw; F.in = (const GAS float* const __attribute__((address_space(4)))*)__builtin_amdgcn_kernarg_segment_ptr(); F.ws = (GAS unsigned char*)args.ws; F.out = args.out;
    F.tid = threadIdx.x; F.lane = F.tid & 63; F.wave = __builtin_amdgcn_readfirstlane(F.tid >> 6); F.G = gridDim.x; F.bid = blockIdx.x;
    const int lo = args.ph_lo, hi = args.ph_hi;
    volatile LAS unsigned* xbw = (volatile LAS unsigned*)(F.lds + LDS_BYTES - 64);
    if (F.tid == 0) { xbw[0] = 0u; xbw[1] = 0u; }
    __syncthreads();
    XcdBarrier bar; bar.bar = WSP(unsigned, WS_CTL) + CW_BAR; bar.x = 0; bar.st = xbw;
    if (hi - lo > 1) bar = xcd_barrier_post(WSP(unsigned, WS_CTL) + CW_BAR, xbw);
#define IN(k) (lo <= (k) && (k) < hi)
#ifndef DIAG
#define DIAG 0
#endif
#if DIAG
    volatile LAS unsigned* dg = (volatile LAS unsigned*)(F.lds + LDS_BYTES - 192);
    if (F.tid < 16) dg[F.tid] = 0u;
    unsigned long long t_prev = __builtin_amdgcn_s_memrealtime();
#define DIAG_ACC(kind) do { if (blockIdx.x == 0 && threadIdx.x == 0) { const unsigned long long t_now = __builtin_amdgcn_s_memrealtime(); dg[kind] += (unsigned)(t_now - t_prev); t_prev = t_now; } } while (0)
#else
#define DIAG_ACC(kind) do { } while (0)
#endif
#define SEAM(k) do { if (IN(k) && IN((k) + 1)) xcd_barrier(bar); } while (0)
#define WSQ(T, off) ((T*)(Fq.ws + (off)))
#define LAUNDERED for (int rep_ = 0; rep_ < nrep_; ++rep_) for (Frame Fq = launder(F), *once_ = &Fq; once_; once_ = nullptr) for (int lq = launder_s(l_cur), once2_ = 1; once2_; once2_ = 0)
    int ph = 0, l_cur = 0, nrep_ = 1;
    nrep_ = NREP(0); if (PHEN(0) && IN(ph)) LAUNDERED { (void)lq; p0_prologue(Fq, rep_); }
    SEAM(ph); ++ph; DIAG_ACC(0);
    { l_cur = 0;
        nrep_ = NREP(1); if (PHEN(1) && IN(ph)) LAUNDERED p1_norm<false>(Fq, lq);
        SEAM(ph); ++ph; DIAG_ACC(1);
        nrep_ = NREP(2); if (PHEN(2) && IN(ph)) LAUNDERED { pg8::Gemm gm{WSQ(pg8::bf16_t, WS_H), WSQ(pg8::bf16_t, WS_WIN) + (size_t)lq * NU * DM, NT, NU, DM}; pg8::StaticOrder S; S.init(NT, NU, Fq.G, Fq.bid);
            EpiU E{WSQ(bf16_t, WS_U), NU, WSQ(bf16_t, WS_US5)}; pg8::gemm_phase<EpiU, pg8::StaticOrder>((PG8_LAS unsigned char*)Fq.lds, gm, S, E); }
        SEAM(ph); ++ph; DIAG_ACC(2);
        nrep_ = NREP(3); if (PHEN(3) && IN(ph)) LAUNDERED {
            unsigned* qctr = WSQ(unsigned, WS_CTL) + CW_Q0 + 64 * (2 + 2 * lq + rep_ * 8);
            for (;;) { const int idx = q_next(Fq, qctr); if (idx >= NCH + 260 + N_S5H) break; const Frame Fi = launder(Fq);
                if (idx < NCH) { for (int q_ = 0; q_ < NREP(21); ++q_) p3_ssd_prep(Fi, lq, idx); }
                else if (idx < NCH + 260) { for (int q_ = 0; q_ < NREP(22); ++q_) p3_attn_prep(Fi, lq, idx - NCH); }
                else { for (int q_ = 0; q_ < NREP(23); ++q_) p3_s5_hloc(Fi, lq, idx - NCH - 260); }
            }
        }
        SEAM(ph); ++ph; DIAG_ACC(3);
        nrep_ = NREP(4); if (PHEN(4) && IN(ph)) LAUNDERED { for (int q_ = 0; q_ < NREP(16); ++q_) p4_ssd_scan(Fq, lq);
            for (int q_ = 0; q_ < NREP(17); ++q_) for (int it = Fq.bid; it < 256; it += Fq.G) { const Frame Fi = launder(Fq); p4_attn_diff(Fi, lq, it); }
            unsigned* qctr = WSQ(unsigned, WS_CTL) + CW_Q0 + 64 * (10 + lq + rep_ * 8);
            for (;;) { const int idx = q_next(Fq, qctr); if (idx >= 4) break; const Frame Fi = launder(Fq);
                p4_attn_diff(Fi, lq, 256 + idx); } }
        SEAM(ph); ++ph; DIAG_ACC(4);
        nrep_ = NREP(5); if (PHEN(5) && IN(ph)) LAUNDERED {
            if (false && gqa_fast_ok(Fq, lq)) { for (int q_ = 0; q_ < NREP(18); ++q_) for (int it = Fq.bid; it < 256; it += Fq.G) { const Frame Fi = launder(Fq); p4_attn_gqa<true>(Fi, lq, it); } }
            else { for (int q_ = 0; q_ < NREP(18); ++q_) for (int it = Fq.bid; it < 256; it += Fq.G) { const Frame Fi = launder(Fq); p4_attn_gqa2(Fi, lq, it); } }
            { unsigned* qctr = WSQ(unsigned, WS_CTL) + CW_Q0 + 64 * (3 + 2 * lq + rep_ * 8);
              for (;;) { const int idx = q_next(Fq, qctr); if (idx >= 2 * NCH + N_S5O + 4) break; const Frame Fi = launder(Fq);
                  if (idx < 2 * NCH) p4_ssd_out(Fi, lq, idx); else if (idx < 2 * NCH + N_S5O) p4_s5_out(Fi, lq, idx - 2 * NCH); else p4_attn_gqa<false>(Fi, lq, 256 + idx - 2 * NCH - N_S5O); } }
        }
        SEAM(ph); ++ph; DIAG_ACC(5);
        nrep_ = NREP(6); if (PHEN(6) && IN(ph)) LAUNDERED p5_finish(Fq, lq);
        SEAM(ph); ++ph; DIAG_ACC(6);
        nrep_ = NREP(7); if (PHEN(7) && IN(ph)) LAUNDERED { pg8::Gemm gm{WSQ(pg8::bf16_t, WS_MIX) + (size_t)CTX * DM, WSQ(pg8::bf16_t, WS_WOUT) + (size_t)lq * DM * DM, SEQ, DM, DM}; pg8::StaticOrder S; S.init(SEQ, DM, Fq.G, Fq.bid);
            EpiRes E; E.C = WSQ(float, WS_XA); E.g1 = WSQ(float, WS_MOD) + (size_t)lq * 2 * 6144 + 2 * 1024;
            if (lq == 0) { E.res_ctx = ((const float*)Fq.in[I_CTX]); E.res_lat = ((const float*)Fq.in[I_X]); } else { E.res_ctx = WSQ(float, WS_XB); E.res_lat = WSQ(float, WS_XB) + (size_t)CTX * DM; }
            pg8::gemm_phase<EpiRes, pg8::StaticOrder>((PG8_LAS unsigned char*)Fq.lds, gm, S, E);
            if (lq < DEPTH - 1) outproj_ctx(Fq, lq, E.res_ctx); }
        SEAM(ph); ++ph; DIAG_ACC(7);
        nrep_ = NREP(8); if (PHEN(8) && IN(ph)) LAUNDERED p7a_router(Fq, lq, rep_);
        SEAM(ph); ++ph; DIAG_ACC(8);
        nrep_ = NREP(10); if (PHEN(10) && IN(ph)) LAUNDERED { const int ntiles = moe_tables(Fq, lq); const LAS int* t2e = (const LAS int*)(Fq.lds + LDS_MISC) + 64;
            moe_rows(Fq, lq, ntiles, 8);
            pg8::Gemm gm{WSQ(pg8::bf16_t, WS_H), WSQ(pg8::bf16_t, WS_WGU) + (size_t)lq * NEXP * 2048 * DM, CAP, 2048, DM};
            MoeOrder S{8, ntiles, Fq.G, Fq.bid, t2e, (long)2048 * DM * 2};
            moe_bias(Fq, ntiles, 8, ((const float*)Fq.in[I_BGU]) + (size_t)lq * NEXP * 2048, 2048);
            EpiAct E{WSQ(bf16_t, WS_ACT), (const LAS float*)(Fq.lds + LDS_BIASL)};
            if (STAG_GU) xcd_stagger(Fq, STAG_GU);
            pg8::gemm_phase_gather<EpiAct, MoeOrder>((PG8_LAS unsigned char*)Fq.lds, gm, S, E, (const PG8_LAS int*)(Fq.lds + LDS_MISC + 2048)); }
        SEAM(ph); ++ph; DIAG_ACC(10);
        nrep_ = NREP(11); if (PHEN(11) && IN(ph)) LAUNDERED { const int ntiles = moe_tables(Fq, lq); const LAS int* t2e = (const LAS int*)(Fq.lds + LDS_MISC) + 64;
            pg8::Gemm gm{WSQ(pg8::bf16_t, WS_ACT), WSQ(pg8::bf16_t, WS_WDN) + (size_t)lq * NEXP * DM * DM, CAP, DM, DM};
            MoeOrder S{4, ntiles, Fq.G, Fq.bid, t2e, (long)DM * DM * 2};
            moe_bias(Fq, ntiles, 4, ((const float*)Fq.in[I_BDN]) + (size_t)lq * NEXP * DM, DM);
            EpiDown E{WSQ(bf16_t, WS_YB), (const LAS float*)(Fq.lds + LDS_BIASL), REP_SKIP_STORES * rep_, WSQ(bf16_t, WS_U)};
            if (STAG_DN) xcd_stagger(Fq, STAG_DN);
            pg8::gemm_phase<EpiDown, MoeOrder>((PG8_LAS unsigned char*)Fq.lds, gm, S, E); }
        SEAM(ph); ++ph; DIAG_ACC(11);
    }
    { l_cur = 1;
        nrep_ = NREP(1); if (PHEN(1) && IN(ph)) LAUNDERED p1_norm<false>(Fq, lq);
        SEAM(ph); ++ph; DIAG_ACC(1);
        nrep_ = NREP(2); if (PHEN(2) && IN(ph)) LAUNDERED { pg8::Gemm gm{WSQ(pg8::bf16_t, WS_H), WSQ(pg8::bf16_t, WS_WIN) + (size_t)lq * NU * DM, NT, NU, DM}; pg8::StaticOrder S; S.init(NT, NU, Fq.G, Fq.bid);
            EpiU E{WSQ(bf16_t, WS_U), NU, WSQ(bf16_t, WS_US5)}; pg8::gemm_phase<EpiU, pg8::StaticOrder>((PG8_LAS unsigned char*)Fq.lds, gm, S, E); }
        SEAM(ph); ++ph; DIAG_ACC(2);
        nrep_ = NREP(3); if (PHEN(3) && IN(ph)) LAUNDERED {
            unsigned* qctr = WSQ(unsigned, WS_CTL) + CW_Q0 + 64 * (2 + 2 * lq + rep_ * 8);
            for (;;) { const int idx = q_next(Fq, qctr); if (idx >= NCH + 260 + N_S5H) break; const Frame Fi = launder(Fq);
                if (idx < NCH) { for (int q_ = 0; q_ < NREP(21); ++q_) p3_ssd_prep(Fi, lq, idx); }
                else if (idx < NCH + 260) { for (int q_ = 0; q_ < NREP(22); ++q_) p3_attn_prep(Fi, lq, idx - NCH); }
                else { for (int q_ = 0; q_ < NREP(23); ++q_) p3_s5_hloc(Fi, lq, idx - NCH - 260); }
            }
        }
        SEAM(ph); ++ph; DIAG_ACC(3);
        nrep_ = NREP(4); if (PHEN(4) && IN(ph)) LAUNDERED { for (int q_ = 0; q_ < NREP(16); ++q_) p4_ssd_scan(Fq, lq);
            for (int q_ = 0; q_ < NREP(17); ++q_) for (int it = Fq.bid; it < 256; it += Fq.G) { const Frame Fi = launder(Fq); p4_attn_diff(Fi, lq, it); }
            unsigned* qctr = WSQ(unsigned, WS_CTL) + CW_Q0 + 64 * (10 + lq + rep_ * 8);
            for (;;) { const int idx = q_next(Fq, qctr); if (idx >= 4) break; const Frame Fi = launder(Fq);
                p4_attn_diff(Fi, lq, 256 + idx); } }
        SEAM(ph); ++ph; DIAG_ACC(4);
        nrep_ = NREP(5); if (PHEN(5) && IN(ph)) LAUNDERED {
            if (false && gqa_fast_ok(Fq, lq)) { for (int q_ = 0; q_ < NREP(18); ++q_) for (int it = Fq.bid; it < 256; it += Fq.G) { const Frame Fi = launder(Fq); p4_attn_gqa<true>(Fi, lq, it); } }
            else { for (int q_ = 0; q_ < NREP(18); ++q_) for (int it = Fq.bid; it < 256; it += Fq.G) { const Frame Fi = launder(Fq); p4_attn_gqa2(Fi, lq, it); } }
            { unsigned* qctr = WSQ(unsigned, WS_CTL) + CW_Q0 + 64 * (3 + 2 * lq + rep_ * 8);
              for (;;) { const int idx = q_next(Fq, qctr); if (idx >= 2 * NCH + N_S5O + 4) break; const Frame Fi = launder(Fq);
                  if (idx < 2 * NCH) p4_ssd_out(Fi, lq, idx); else if (idx < 2 * NCH + N_S5O) p4_s5_out(Fi, lq, idx - 2 * NCH); else p4_attn_gqa<false>(Fi, lq, 256 + idx - 2 * NCH - N_S5O); } }
        }
        SEAM(ph); ++ph; DIAG_ACC(5);
        nrep_ = NREP(6); if (PHEN(6) && IN(ph)) LAUNDERED p5_finish(Fq, lq);
        SEAM(ph); ++ph; DIAG_ACC(6);
        nrep_ = NREP(7); if (PHEN(7) && IN(ph)) LAUNDERED { pg8::Gemm gm{WSQ(pg8::bf16_t, WS_MIX) + (size_t)CTX * DM, WSQ(pg8::bf16_t, WS_WOUT) + (size_t)lq * DM * DM, SEQ, DM, DM}; pg8::StaticOrder S; S.init(SEQ, DM, Fq.G, Fq.bid);
            EpiRes E; E.C = WSQ(float, WS_XA); E.g1 = WSQ(float, WS_MOD) + (size_t)lq * 2 * 6144 + 2 * 1024;
            if (lq == 0) { E.res_ctx = ((const float*)Fq.in[I_CTX]); E.res_lat = ((const float*)Fq.in[I_X]); } else { E.res_ctx = WSQ(float, WS_XB); E.res_lat = WSQ(float, WS_XB) + (size_t)CTX * DM; }
            pg8::gemm_phase<EpiRes, pg8::StaticOrder>((PG8_LAS unsigned char*)Fq.lds, gm, S, E);
            if (lq < DEPTH - 1) outproj_ctx(Fq, lq, E.res_ctx); }
        SEAM(ph); ++ph; DIAG_ACC(7);
        nrep_ = NREP(8); if (PHEN(8) && IN(ph)) LAUNDERED p7a_router(Fq, lq, rep_);
        SEAM(ph); ++ph; DIAG_ACC(8);
        nrep_ = NREP(10); if (PHEN(10) && IN(ph)) LAUNDERED { const int ntiles = moe_tables(Fq, lq); const LAS int* t2e = (const LAS int*)(Fq.lds + LDS_MISC) + 64;
            moe_rows(Fq, lq, ntiles, 8);
            pg8::Gemm gm{WSQ(pg8::bf16_t, WS_H), WSQ(pg8::bf16_t, WS_WGU) + (size_t)lq * NEXP * 2048 * DM, CAP, 2048, DM};
            MoeOrder S{8, ntiles, Fq.G, Fq.bid, t2e, (long)2048 * DM * 2};
            moe_bias(Fq, ntiles, 8, ((const float*)Fq.in[I_BGU]) + (size_t)lq * NEXP * 2048, 2048);
            EpiAct E{WSQ(bf16_t, WS_ACT), (const LAS float*)(Fq.lds + LDS_BIASL)};
            if (STAG_GU) xcd_stagger(Fq, STAG_GU);
            pg8::gemm_phase_gather<EpiAct, MoeOrder>((PG8_LAS unsigned char*)Fq.lds, gm, S, E, (const PG8_LAS int*)(Fq.lds + LDS_MISC + 2048)); }
        SEAM(ph); ++ph; DIAG_ACC(10);
        nrep_ = NREP(11); if (PHEN(11) && IN(ph)) LAUNDERED { const int ntiles = moe_tables(Fq, lq); const LAS int* t2e = (const LAS int*)(Fq.lds + LDS_MISC) + 64;
            pg8::Gemm gm{WSQ(pg8::bf16_t, WS_ACT), WSQ(pg8::bf16_t, WS_WDN) + (size_t)lq * NEXP * DM * DM, CAP, DM, DM};
            MoeOrder S{4, ntiles, Fq.G, Fq.bid, t2e, (long)DM * DM * 2};
            moe_bias(Fq, ntiles, 4, ((const float*)Fq.in[I_BDN]) + (size_t)lq * NEXP * DM, DM);
            EpiDown E{WSQ(bf16_t, WS_YB), (const LAS float*)(Fq.lds + LDS_BIASL), REP_SKIP_STORES * rep_, WSQ(bf16_t, WS_U)};
            if (STAG_DN) xcd_stagger(Fq, STAG_DN);
            pg8::gemm_phase<EpiDown, MoeOrder>((PG8_LAS unsigned char*)Fq.lds, gm, S, E); }
        SEAM(ph); ++ph; DIAG_ACC(11);
    }
    { l_cur = 2;
        nrep_ = NREP(1); if (PHEN(1) && IN(ph)) LAUNDERED p1_norm<false>(Fq, lq);
        SEAM(ph); ++ph; DIAG_ACC(1);
        nrep_ = NREP(2); if (PHEN(2) && IN(ph)) LAUNDERED { pg8::Gemm gm{WSQ(pg8::bf16_t, WS_H), WSQ(pg8::bf16_t, WS_WIN) + (size_t)lq * NU * DM, NT, NU, DM}; pg8::StaticOrder S; S.init(NT, NU, Fq.G, Fq.bid);
            EpiU E{WSQ(bf16_t, WS_U), NU, WSQ(bf16_t, WS_US5)}; pg8::gemm_phase<EpiU, pg8::StaticOrder>((PG8_LAS unsigned char*)Fq.lds, gm, S, E); }
        SEAM(ph); ++ph; DIAG_ACC(2);
        nrep_ = NREP(3); if (PHEN(3) && IN(ph)) LAUNDERED {
            unsigned* qctr = WSQ(unsigned, WS_CTL) + CW_Q0 + 64 * (2 + 2 * lq + rep_ * 8);
            for (;;) { const int idx = q_next(Fq, qctr); if (idx >= NCH + 260 + N_S5H) break; const Frame Fi = launder(Fq);
                if (idx < NCH) { for (int q_ = 0; q_ < NREP(21); ++q_) p3_ssd_prep(Fi, lq, idx); }
                else if (idx < NCH + 260) { for (int q_ = 0; q_ < NREP(22); ++q_) p3_attn_prep(Fi, lq, idx - NCH); }
                else { for (int q_ = 0; q_ < NREP(23); ++q_) p3_s5_hloc(Fi, lq, idx - NCH - 260); }
            }
        }
        SEAM(ph); ++ph; DIAG_ACC(3);
        nrep_ = NREP(4); if (PHEN(4) && IN(ph)) LAUNDERED { for (int q_ = 0; q_ < NREP(16); ++q_) p4_ssd_scan(Fq, lq);
            for (int q_ = 0; q_ < NREP(17); ++q_) for (int it = Fq.bid; it < 256; it += Fq.G) { const Frame Fi = launder(Fq); p4_attn_diff(Fi, lq, it); }
            unsigned* qctr = WSQ(unsigned, WS_CTL) + CW_Q0 + 64 * (10 + lq + rep_ * 8);
            for (;;) { const int idx = q_next(Fq, qctr); if (idx >= 4) break; const Frame Fi = launder(Fq);
                p4_attn_diff(Fi, lq, 256 + idx); } }
        SEAM(ph); ++ph; DIAG_ACC(4);
        nrep_ = NREP(5); if (PHEN(5) && IN(ph)) LAUNDERED {
            if (false && gqa_fast_ok(Fq, lq)) { for (int q_ = 0; q_ < NREP(18); ++q_) for (int it = Fq.bid; it < 256; it += Fq.G) { const Frame Fi = launder(Fq); p4_attn_gqa<true>(Fi, lq, it); } }
            else { for (int q_ = 0; q_ < NREP(18); ++q_) for (int it = Fq.bid; it < 256; it += Fq.G) { const Frame Fi = launder(Fq); p4_attn_gqa2(Fi, lq, it); } }
            { unsigned* qctr = WSQ(unsigned, WS_CTL) + CW_Q0 + 64 * (3 + 2 * lq + rep_ * 8);
              for (;;) { const int idx = q_next(Fq, qctr); if (idx >= 2 * NCH + N_S5O + 4) break; const Frame Fi = launder(Fq);
                  if (idx < 2 * NCH) p4_ssd_out(Fi, lq, idx); else if (idx < 2 * NCH + N_S5O) p4_s5_out(Fi, lq, idx - 2 * NCH); else p4_attn_gqa<false>(Fi, lq, 256 + idx - 2 * NCH - N_S5O); } }
        }
        SEAM(ph); ++ph; DIAG_ACC(5);
        nrep_ = NREP(6); if (PHEN(6) && IN(ph)) LAUNDERED p5_finish(Fq, lq);
        SEAM(ph); ++ph; DIAG_ACC(6);
        nrep_ = NREP(7); if (PHEN(7) && IN(ph)) LAUNDERED { pg8::Gemm gm{WSQ(pg8::bf16_t, WS_MIX) + (size_t)CTX * DM, WSQ(pg8::bf16_t, WS_WOUT) + (size_t)lq * DM * DM, SEQ, DM, DM}; pg8::StaticOrder S; S.init(SEQ, DM, Fq.G, Fq.bid);
            EpiRes E; E.C = WSQ(float, WS_XA); E.g1 = WSQ(float, WS_MOD) + (size_t)lq * 2 * 6144 + 2 * 1024;
            if (lq == 0) { E.res_ctx = ((const float*)Fq.in[I_CTX]); E.res_lat = ((const float*)Fq.in[I_X]); } else { E.res_ctx = WSQ(float, WS_XB); E.res_lat = WSQ(float, WS_XB) + (size_t)CTX * DM; }
            pg8::gemm_phase<EpiRes, pg8::StaticOrder>((PG8_LAS unsigned char*)Fq.lds, gm, S, E);
            if (lq < DEPTH - 1) outproj_ctx(Fq, lq, E.res_ctx); }
        SEAM(ph); ++ph; DIAG_ACC(7);
        nrep_ = NREP(8); if (PHEN(8) && IN(ph)) LAUNDERED p7a_router(Fq, lq, rep_);
        SEAM(ph); ++ph; DIAG_ACC(8);
        nrep_ = NREP(10); if (PHEN(10) && IN(ph)) LAUNDERED { const int ntiles = moe_tables(Fq, lq); const LAS int* t2e = (const LAS int*)(Fq.lds + LDS_MISC) + 64;
            moe_rows(Fq, lq, ntiles, 8);
            pg8::Gemm gm{WSQ(pg8::bf16_t, WS_H), WSQ(pg8::bf16_t, WS_WGU) + (size_t)lq * NEXP * 2048 * DM, CAP, 2048, DM};
            MoeOrder S{8, ntiles, Fq.G, Fq.bid, t2e, (long)2048 * DM * 2};
            moe_bias(Fq, ntiles, 8, ((const float*)Fq.in[I_BGU]) + (size_t)lq * NEXP * 2048, 2048);
            EpiAct E{WSQ(bf16_t, WS_ACT), (const LAS float*)(Fq.lds + LDS_BIASL)};
            if (STAG_GU) xcd_stagger(Fq, STAG_GU);
            pg8::gemm_phase_gather<EpiAct, MoeOrder>((PG8_LAS unsigned char*)Fq.lds, gm, S, E, (const PG8_LAS int*)(Fq.lds + LDS_MISC + 2048)); }
        SEAM(ph); ++ph; DIAG_ACC(10);
        nrep_ = NREP(11); if (PHEN(11) && IN(ph)) LAUNDERED { const int ntiles = moe_tables(Fq, lq); const LAS int* t2e = (const LAS int*)(Fq.lds + LDS_MISC) + 64;
            pg8::Gemm gm{WSQ(pg8::bf16_t, WS_ACT), WSQ(pg8::bf16_t, WS_WDN) + (size_t)lq * NEXP * DM * DM, CAP, DM, DM};
            MoeOrder S{4, ntiles, Fq.G, Fq.bid, t2e, (long)DM * DM * 2};
            moe_bias(Fq, ntiles, 4, ((const float*)Fq.in[I_BDN]) + (size_t)lq * NEXP * DM, DM);
            EpiDown E{WSQ(bf16_t, WS_YB), (const LAS float*)(Fq.lds + LDS_BIASL), REP_SKIP_STORES * rep_, WSQ(bf16_t, WS_U)};
            if (STAG_DN) xcd_stagger(Fq, STAG_DN);
            pg8::gemm_phase<EpiDown, MoeOrder>((PG8_LAS unsigned char*)Fq.lds, gm, S, E); }
        SEAM(ph); ++ph; DIAG_ACC(11);
    }
    { l_cur = 3;
        nrep_ = NREP(1); if (PHEN(1) && IN(ph)) LAUNDERED p1_norm<false>(Fq, lq);
        SEAM(ph); ++ph; DIAG_ACC(1);
        nrep_ = NREP(2); if (PHEN(2) && IN(ph)) LAUNDERED { pg8::Gemm gm{WSQ(pg8::bf16_t, WS_H), WSQ(pg8::bf16_t, WS_WIN) + (size_t)lq * NU * DM, NT, NU, DM}; pg8::StaticOrder S; S.init(NT, NU, Fq.G, Fq.bid);
            EpiU E{WSQ(bf16_t, WS_U), NU, WSQ(bf16_t, WS_US5)}; pg8::gemm_phase<EpiU, pg8::StaticOrder>((PG8_LAS unsigned char*)Fq.lds, gm, S, E); }
        SEAM(ph); ++ph; DIAG_ACC(2);
        nrep_ = NREP(3); if (PHEN(3) && IN(ph)) LAUNDERED {
            unsigned* qctr = WSQ(unsigned, WS_CTL) + CW_Q0 + 64 * (2 + 2 * lq + rep_ * 8);
            for (;;) { const int idx = q_next(Fq, qctr); if (idx >= NCH + 260 + N_S5H) break; const Frame Fi = launder(Fq);
                if (idx < NCH) { for (int q_ = 0; q_ < NREP(21); ++q_) p3_ssd_prep(Fi, lq, idx); }
                else if (idx < NCH + 260) { for (int q_ = 0; q_ < NREP(22); ++q_) p3_attn_prep(Fi, lq, idx - NCH); }
                else { for (int q_ = 0; q_ < NREP(23); ++q_) p3_s5_hloc(Fi, lq, idx - NCH - 260); }
            }
        }
        SEAM(ph); ++ph; DIAG_ACC(3);
        nrep_ = NREP(4); if (PHEN(4) && IN(ph)) LAUNDERED { for (int q_ = 0; q_ < NREP(16); ++q_) p4_ssd_scan(Fq, lq);
            for (int q_ = 0; q_ < NREP(17); ++q_) for (int it = Fq.bid; it < 256; it += Fq.G) { const Frame Fi = launder(Fq); p4_attn_diff(Fi, lq, it); }
            unsigned* qctr = WSQ(unsigned, WS_CTL) + CW_Q0 + 64 * (10 + lq + rep_ * 8);
            for (;;) { const int idx = q_next(Fq, qctr); if (idx >= 4) break; const Frame Fi = launder(Fq);
                p4_attn_diff(Fi, lq, 256 + idx); } }
        SEAM(ph); ++ph; DIAG_ACC(4);
        nrep_ = NREP(5); if (PHEN(5) && IN(ph)) LAUNDERED {
            if (false && gqa_fast_ok(Fq, lq)) { for (int q_ = 0; q_ < NREP(18); ++q_) for (int it = Fq.bid; it < 256; it += Fq.G) { const Frame Fi = launder(Fq); p4_attn_gqa<true>(Fi, lq, it); } }
            else { for (int q_ = 0; q_ < NREP(18); ++q_) for (int it = Fq.bid; it < 256; it += Fq.G) { const Frame Fi = launder(Fq); p4_attn_gqa2(Fi, lq, it); } }
            { unsigned* qctr = WSQ(unsigned, WS_CTL) + CW_Q0 + 64 * (3 + 2 * lq + rep_ * 8);
              for (;;) { const int idx = q_next(Fq, qctr); if (idx >= 2 * NCH + N_S5O + 4) break; const Frame Fi = launder(Fq);
                  if (idx < 2 * NCH) p4_ssd_out(Fi, lq, idx); else if (idx < 2 * NCH + N_S5O) p4_s5_out(Fi, lq, idx - 2 * NCH); else p4_attn_gqa<false>(Fi, lq, 256 + idx - 2 * NCH - N_S5O); } }
        }
        SEAM(ph); ++ph; DIAG_ACC(5);
        nrep_ = NREP(6); if (PHEN(6) && IN(ph)) LAUNDERED p5_finish(Fq, lq);
        SEAM(ph); ++ph; DIAG_ACC(6);
        nrep_ = NREP(7); if (PHEN(7) && IN(ph)) LAUNDERED { pg8::Gemm gm{WSQ(pg8::bf16_t, WS_MIX) + (size_t)CTX * DM, WSQ(pg8::bf16_t, WS_WOUT) + (size_t)lq * DM * DM, SEQ, DM, DM}; pg8::StaticOrder S; S.init(SEQ, DM, Fq.G, Fq.bid);
            EpiRes E; E.C = WSQ(float, WS_XA); E.g1 = WSQ(float, WS_MOD) + (size_t)lq * 2 * 6144 + 2 * 1024;
            if (lq == 0) { E.res_ctx = ((const float*)Fq.in[I_CTX]); E.res_lat = ((const float*)Fq.in[I_X]); } else { E.res_ctx = WSQ(float, WS_XB); E.res_lat = WSQ(float, WS_XB) + (size_t)CTX * DM; }
            pg8::gemm_phase<EpiRes, pg8::StaticOrder>((PG8_LAS unsigned char*)Fq.lds, gm, S, E);
            if (lq < DEPTH - 1) outproj_ctx(Fq, lq, E.res_ctx); }
        SEAM(ph); ++ph; DIAG_ACC(7);
        nrep_ = NREP(8); if (PHEN(8) && IN(ph)) LAUNDERED p7a_router(Fq, lq, rep_);
        SEAM(ph); ++ph; DIAG_ACC(8);
        nrep_ = NREP(10); if (PHEN(10) && IN(ph)) LAUNDERED { const int ntiles = moe_tables(Fq, lq); const LAS int* t2e = (const LAS int*)(Fq.lds + LDS_MISC) + 64;
            moe_rows(Fq, lq, ntiles, 8);
            pg8::Gemm gm{WSQ(pg8::bf16_t, WS_H), WSQ(pg8::bf16_t, WS_WGU) + (size_t)lq * NEXP * 2048 * DM, CAP, 2048, DM};
            MoeOrder S{8, ntiles, Fq.G, Fq.bid, t2e, (long)2048 * DM * 2};
            moe_bias(Fq, ntiles, 8, ((const float*)Fq.in[I_BGU]) + (size_t)lq * NEXP * 2048, 2048);
            EpiAct E{WSQ(bf16_t, WS_ACT), (const LAS float*)(Fq.lds + LDS_BIASL)};
            if (STAG_GU) xcd_stagger(Fq, STAG_GU);
            pg8::gemm_phase_gather<EpiAct, MoeOrder>((PG8_LAS unsigned char*)Fq.lds, gm, S, E, (const PG8_LAS int*)(Fq.lds + LDS_MISC + 2048)); }
        SEAM(ph); ++ph; DIAG_ACC(10);
        nrep_ = NREP(11); if (PHEN(11) && IN(ph)) LAUNDERED { const int ntiles = moe_tables(Fq, lq); const LAS int* t2e = (const LAS int*)(Fq.lds + LDS_MISC) + 64;
            pg8::Gemm gm{WSQ(pg8::bf16_t, WS_ACT), WSQ(pg8::bf16_t, WS_WDN) + (size_t)lq * NEXP * DM * DM, CAP, DM, DM};
            MoeOrder S{4, ntiles, Fq.G, Fq.bid, t2e, (long)DM * DM * 2};
            moe_bias(Fq, ntiles, 4, ((const float*)Fq.in[I_BDN]) + (size_t)lq * NEXP * DM, DM);
            EpiDown E{WSQ(bf16_t, WS_YB), (const LAS float*)(Fq.lds + LDS_BIASL), REP_SKIP_STORES * rep_, WSQ(bf16_t, WS_U)};
            if (STAG_DN) xcd_stagger(Fq, STAG_DN);
            pg8::gemm_phase<EpiDown, MoeOrder>((PG8_LAS unsigned char*)Fq.lds, gm, S, E); }
        SEAM(ph); ++ph; DIAG_ACC(11);
    }
#if DIAG
    if (blockIdx.x == 0 && threadIdx.x < 16) __hip_atomic_store((unsigned*)(F.ws + WS_CTL) + 5000 + threadIdx.x, dg[threadIdx.x], __ATOMIC_RELAXED, __HIP_MEMORY_SCOPE_AGENT);
    xcd_barrier(bar);
    { const unsigned* dgw = (const unsigned*)(F.ws + WS_CTL) + 5000;
      const float ta = (float)__hip_atomic_load(dgw + DIAG_A, __ATOMIC_RELAXED, __HIP_MEMORY_SCOPE_AGENT) * 0.01f;
      const float cval = sqrtf(ta * (1.f / DIAG_DIV));
      for (size_t i = (size_t)blockIdx.x * 512 + threadIdx.x; i < (size_t)SEQ * DM; i += (size_t)gridDim.x * 512) F.out[i] = cval; }
#else
    nrep_ = NREP(12); if (PHEN(12) && IN(ph)) LAUNDERED { (void)lq; p1_norm<true>(Fq, DEPTH); }
#endif
#undef IN
#undef SEAM
}

#ifndef N_LAUNCH_MODE
#define N_LAUNCH_MODE 1
#endif
extern "C" void kernel_launch(void* const* d_in, const int* in_sizes, int n_in, void* d_out, int out_size, void* d_ws, size_t ws_size, hipStream_t stream) {
    static int grid = 0;
    if (grid == 0) {
        if (n_in != N_IN || out_size != SEQ * DM || ws_size < WS_END) { fprintf(stderr, "kernel_launch: unexpected shapes (n_in %d, out %d, ws %zu < %zu)\n", n_in, out_size, ws_size, (size_t)WS_END); grid = -1; return; }
        int dev = 0, cus = 0, per_cu = 0;
        if (hipGetDevice(&dev) != hipSuccess || hipDeviceGetAttribute(&cus, hipDeviceAttributeMultiprocessorCount, dev) != hipSuccess) { grid = -1; return; }
        if (hipFuncSetAttribute((const void*)hybrid_fwd, hipFuncAttributeMaxDynamicSharedMemorySize, LDS_BYTES) != hipSuccess) { fprintf(stderr, "kernel_launch: hipFuncSetAttribute failed\n"); grid = -1; return; }
        if (hipOccupancyMaxActiveBlocksPerMultiprocessor(&per_cu, (const void*)hybrid_fwd, 512, LDS_BYTES) != hipSuccess || per_cu < 1) { fprintf(stderr, "kernel_launch: occupancy query says %d\n", per_cu); }
        (void)hipGetLastError();
        grid = cus;
    }
    if (grid < 0) return;
    (void)hipMemsetAsync((char*)d_ws + WS_CTL, 0, CTL_BYTES, stream);
    Args a{};
    for (int i = 0; i < N_IN; ++i) a.in[i] = (const float*)d_in[i];
    a.out = (float*)d_out; a.ws = (unsigned char*)d_ws;
#if N_LAUNCH_MODE == 1
    a.ph_lo = 0; a.ph_hi = N_PHASES;
    hipLaunchKernelGGL(hybrid_fwd, dim3(grid), dim3(512), LDS_BYTES, stream, a);
#else
    for (int p = 0; p < N_PHASES; ++p) { a.ph_lo = p; a.ph_hi = p + 1; hipLaunchKernelGGL(hybrid_fwd, dim3(grid), dim3(512), LDS_BYTES, stream, a); }
#endif
}
```
